# Optimizing an MI355X kernel written in HIP

```python
import jax
import jax.numpy as jnp
from jax import lax
import numpy as np

D_MODEL = 1024
BATCH = 8
SEQ = 2048
DEPTH = 1

GRID_W = 64
CTX_LEN = 256
FNET_DIM = 512
FNET_GROUPS = 4
FNET_GROUP_DIM = FNET_DIM // FNET_GROUPS
HG_DIM = 512
HG_HEADS = 4
HG_HEAD_DIM = HG_DIM // HG_HEADS
HG_CHUNK = 16
D_FF = 2816
CONV_K = 3
N_MOD = 6
EPS = 1e-6

OFF_FNET = 0
OFF_Q = OFF_FNET + FNET_DIM
OFF_FF = OFF_Q + HG_DIM
OFF_FB = OFF_FF + HG_DIM
OFF_I = OFF_FB + HG_DIM
OFF_G = OFF_I + HG_DIM
OFF_GA = OFF_G + HG_DIM
OFF_GB = OFF_GA + D_MODEL
IN_DIM = OFF_GB + D_MODEL

kernel_name = 'fnet_hgrn2_convffn_hybrid_dit'


def rmsnorm(x, g):
    xf = x.astype(jnp.float32)
    y = xf * lax.rsqrt(jnp.mean(xf * xf, axis=-1, keepdims=True) + EPS) * g.astype(jnp.float32)
    return y.astype(x.dtype)


def modulate(h, shift, scale):
    return h * (1.0 + scale) + shift


def fourier_mix(u):
    b, l, _ = u.shape
    ug = u.astype(jnp.float32).reshape(b, l, FNET_GROUPS, FNET_GROUP_DIM)
    y = jnp.fft.fft2(ug, axes=(1, 3), norm='ortho').real
    return y.reshape(b, l, FNET_DIM).astype(u.dtype)


def hgrn_chunk_scan(q, k, v, logf, s0):
    b, l, h, _ = q.shape
    dv = v.shape[-1]
    n = l // HG_CHUNK

    def to_chunks(t):
        return t.reshape(b, n, HG_CHUNK, h, t.shape[-1]).transpose(1, 0, 3, 2, 4)

    qc, kc, vc, gc = to_chunks(q), to_chunks(k), to_chunks(v), to_chunks(logf)
    lower = jnp.tril(jnp.ones((HG_CHUNK, HG_CHUNK), dtype=bool))[:, :, None]

    def step(state, inp):
        qi, ki, vi, gi = inp
        cum = jnp.cumsum(gi, axis=-2)
        total = cum[..., -1:, :]
        rel = cum[..., :, None, :] - cum[..., None, :, :]
        decay = jnp.exp(jnp.where(lower, rel, -jnp.inf))
        attn = jnp.einsum('bhtd,bhsd,bhtsd->bhts', qi, ki, decay)
        o = (jnp.einsum('bhts,bhsv->bhtv', attn, vi)
             + jnp.einsum('bhtd,bhdv->bhtv', qi * jnp.exp(cum), state))
        k_dec = ki * jnp.exp(total - cum)
        new_state = state * jnp.exp(total)[..., 0, :, None] + jnp.einsum('bhsd,bhsv->bhdv', k_dec, vi)
        return new_state, o

    s_final, o = lax.scan(step, s0, (qc, kc, vc, gc))
    o = o.transpose(1, 0, 3, 2, 4).reshape(b, l, h, dv)
    return o, s_final


def hgrn_inputs(u, lb):
    uf = u.astype(jnp.float32)
    b, l, _ = u.shape

    def heads(t):
        return t.reshape(b, l, HG_HEADS, HG_HEAD_DIM)

    q = heads(jax.nn.silu(uf[..., OFF_Q:OFF_Q + HG_DIM]))
    v = heads(uf[..., OFF_I:OFF_I + HG_DIM])
    f_fwd = lb + (1.0 - lb) * jax.nn.sigmoid(uf[..., OFF_FF:OFF_FF + HG_DIM])
    f_bwd = lb + (1.0 - lb) * jax.nn.sigmoid(uf[..., OFF_FB:OFF_FB + HG_DIM])
    return (q, v, heads(1.0 - f_fwd), heads(jnp.log(f_fwd)), heads(1.0 - f_bwd), heads(jnp.log(f_bwd)))


def hgrn_bidir(q, v, k_f, g_f, k_b, g_b, s0_f, s0_b):
    o_f, s_f = hgrn_chunk_scan(q, k_f, v, g_f, s0_f)
    flip = lambda t: jnp.flip(t, axis=1)
    o_b, s_b = hgrn_chunk_scan(flip(q), flip(k_b), flip(v), flip(g_b), s0_b)
    return o_f + flip(o_b), s_f, s_b


def hgrn_readout(u, o, onorm_g):
    b, l = o.shape[0], o.shape[1]
    on = o * lax.rsqrt(jnp.mean(o * o, axis=-1, keepdims=True) + EPS)
    on = on.reshape(b, l, HG_DIM) * onorm_g.astype(jnp.float32)
    on = on * jax.nn.silu(u[..., OFF_G:OFF_G + HG_DIM].astype(jnp.float32))
    return on.astype(u.dtype)


def merge_branches(u, y_hgrn, w_a, w_b, w_out):
    y_a = fourier_mix(u[..., OFF_FNET:OFF_FNET + FNET_DIM]) @ w_a
    y_b = y_hgrn @ w_b
    g_a = jax.nn.sigmoid(u[..., OFF_GA:OFF_GB])
    g_b = jax.nn.sigmoid(u[..., OFF_GB:IN_DIM])
    return (g_a * y_a + g_b * y_b) @ w_out


def conv_ffn(h, w_up, conv_w, conv_b, w_down, rows, cols):
    b, l, _ = h.shape
    z = (h @ w_up).reshape(b, rows, cols, 2 * D_FF)
    z = lax.conv_general_dilated(z, conv_w[:, :, None, :], window_strides=(1, 1), padding='SAME',
                                 dimension_numbers=('NHWC', 'HWIO', 'NHWC'),
                                 feature_group_count=2 * D_FF)
    z = z.reshape(b, l, 2 * D_FF) + conv_b
    return (jax.nn.silu(z[..., :D_FF]) * z[..., D_FF:]) @ w_down


def setup_inputs(seed: int = 0) -> dict:
    key = jax.random.key(seed)
    ks = jax.random.split(key, 19)

    def nrm(k, shape):
        return jax.random.normal(k, shape, jnp.float32)

    def w(k, shape, fan_in, scale=1.0):
        return nrm(k, shape) * (scale * fan_in ** -0.5)

    def gain(k, shape):
        return 1.0 + 0.1 * nrm(k, shape)

    return {
        'x': nrm(ks[0], (BATCH, SEQ, D_MODEL)),
        'c': nrm(ks[1], (BATCH, D_MODEL)),
        'ctx': nrm(ks[2], (BATCH, CTX_LEN, D_MODEL)),
        'c_ctx': nrm(ks[3], (D_MODEL,)),
        'ada_w': w(ks[4], (DEPTH, D_MODEL, N_MOD * D_MODEL), D_MODEL, 0.5),
        'ada_b': 0.02 * nrm(ks[5], (DEPTH, N_MOD * D_MODEL)),
        'norm1_g': gain(ks[6], (DEPTH, D_MODEL)),
        'w_in': w(ks[7], (DEPTH, D_MODEL, IN_DIM), D_MODEL),
        'hg_lb': 0.1 * nrm(ks[8], (DEPTH + 1, HG_DIM)),
        'hg_onorm_g': gain(ks[9], (DEPTH, HG_DIM)),
        'w_a': w(ks[10], (DEPTH, FNET_DIM, D_MODEL), FNET_DIM),
        'w_b': w(ks[11], (DEPTH, HG_DIM, D_MODEL), HG_DIM),
        'w_out': w(ks[12], (DEPTH, D_MODEL, D_MODEL), D_MODEL),
        'norm2_g': gain(ks[13], (DEPTH, D_MODEL)),
        'ffn_up': w(ks[14], (DEPTH, D_MODEL, 2 * D_FF), D_MODEL),
        'ffn_conv_w': w(ks[15], (DEPTH, CONV_K, CONV_K, 2 * D_FF), CONV_K * CONV_K),
        'ffn_conv_b': 0.02 * nrm(ks[16], (DEPTH, 2 * D_FF)),
        'ffn_down': w(ks[17], (DEPTH, D_FF, D_MODEL), D_FF),
        'final_g': gain(ks[18], (D_MODEL,)),
    }


def reference(x, c, ctx, c_ctx, ada_w, ada_b, norm1_g, w_in, hg_lb, hg_onorm_g, w_a, w_b, w_out,
              norm2_g, ffn_up, ffn_conv_w, ffn_conv_b, ffn_down, final_g):
    b, seq, _ = x.shape
    rows = seq // GRID_W
    ctx_len = ctx.shape[1]
    lb_all = jnp.cumsum(jax.nn.softmax(hg_lb.astype(jnp.float32), axis=0), axis=0)
    s_zero = jnp.zeros((b, HG_HEADS, HG_HEAD_DIM, HG_HEAD_DIM), jnp.float32)
    for layer in range(DEPTH):
        last = layer == DEPTH - 1
        mx = (jax.nn.silu(c) @ ada_w[layer] + ada_b[layer]).reshape(b, 1, N_MOD, D_MODEL)
        mc = (jax.nn.silu(c_ctx) @ ada_w[layer] + ada_b[layer]).reshape(N_MOD, D_MODEL)
        lb = lb_all[layer]

        hx = modulate(rmsnorm(x, norm1_g[layer]), mx[:, :, 0], mx[:, :, 1])
        hc = modulate(rmsnorm(ctx, norm1_g[layer]), mc[0], mc[1])
        ux = hx @ w_in[layer]
        uc = hc @ w_in[layer]
        oc, sc_f, sc_b = hgrn_bidir(*hgrn_inputs(uc, lb), s_zero, s_zero)
        ox, _, _ = hgrn_bidir(*hgrn_inputs(ux, lb), sc_f, sc_b)
        yx = merge_branches(ux, hgrn_readout(ux, ox, hg_onorm_g[layer]), w_a[layer], w_b[layer], w_out[layer])
        x = x + mx[:, :, 2] * yx
        if not last:
            yc = merge_branches(uc, hgrn_readout(uc, oc, hg_onorm_g[layer]), w_a[layer], w_b[layer], w_out[layer])
            ctx = ctx + mc[2] * yc

        h2 = modulate(rmsnorm(x, norm2_g[layer]), mx[:, :, 3], mx[:, :, 4])
        x = x + mx[:, :, 5] * conv_ffn(h2, ffn_up[layer], ffn_conv_w[layer], ffn_conv_b[layer],
                                       ffn_down[layer], rows, GRID_W)
        if not last:
            h2c = modulate(rmsnorm(ctx, norm2_g[layer]), mc[3], mc[4])
            ctx = ctx + mc[5] * conv_ffn(h2c, ffn_up[layer], ffn_conv_w[layer], ffn_conv_b[layer],
                                         ffn_down[layer], 1, ctx_len)
    return rmsnorm(x, final_g)
```

```cpp
#include <hip/hip_runtime.h>
#include <hip/hip_cooperative_groups.h>
#include <cstdio>
#include <cstdint>
namespace cg = cooperative_groups;

namespace pg8 {
#define PG8_LAS __attribute__((address_space(3)))
typedef unsigned short bf16_t;
typedef short bf16x8 __attribute__((ext_vector_type(8)));
typedef float f32x4 __attribute__((ext_vector_type(4)));
typedef unsigned u32x4 __attribute__((ext_vector_type(4)));
typedef unsigned u32x2 __attribute__((ext_vector_type(2)));
constexpr int BM = 256, BK = 64, HALF = 128, HTB = HALF * BK * 2  , STAGE_BYTES = 8 * HTB, NXCD = 8, WGM = 8;

__host__ __device__ __forceinline__ int lds_byte(int r, int c) { const int st = (r >> 4) * 2 + (c >> 5), rr = r & 15, cc = c & 31, ob = rr * 64 + cc * 2; return st * 1024 + (ob ^ (((ob >> 9) & 1) << 5)); }
__host__ __device__ __forceinline__ void stage_rc(int b, int& R, int& C) { const int st = b / 1024, sb = b % 1024, swz = sb ^ (((sb >> 9) & 1) << 5); R = (st >> 1) * 16 + swz / 64; C = (st & 1) * 32 + (swz % 64) / 2; }
__host__ __device__ __forceinline__ int perm32(int rho) { const int n = rho >> 4, i = rho & 15; return 8 * (i >> 2) + 4 * n + (i & 3); }

struct Unit { int pm, pn, z; };
struct Gemm { const bf16_t* A; const bf16_t* Bt; int K, lda, ldb; };

__device__ __forceinline__ void tile_of(int wgid, int nM, int nN, int& pm, int& pn) {
    const int nwg = nM * nN;
    { const int q = nwg / NXCD, r = nwg % NXCD, xcd = wgid % NXCD, off = wgid / NXCD; wgid = (xcd < r ? xcd * (q + 1) : r * (q + 1) + (xcd - r) * q) + off; }
    const int nig = WGM * nN, gid = wgid / nig, fm = gid * WGM, gsz = (nM - fm) < WGM ? (nM - fm) : WGM;
    pm = fm + ((wgid % nig) % gsz); pn = (wgid % nig) / gsz;
}
struct StaticOrder {
    int nM, nN, nwg, G, c; size_t a_tile, b_tile;
    __device__ __forceinline__ void init(int nM_, int nN_, int G_, int c_, int lda, int ldb) { nM = nM_; nN = nN_; nwg = nM * nN; G = G_; c = c_; a_tile = (size_t)BM * lda * 2; b_tile = (size_t)BM * ldb * 2; }
    __device__ __forceinline__ bool next(int i, Unit& u) const {
        const long L = (long)i * G + c; if (L >= nwg) return false;
        tile_of((int)L, nM, nN, u.pm, u.pn); u.z = 0; return true;
    }
    __device__ __forceinline__ size_t a_off(const Unit& u) const { return (size_t)u.pm * a_tile; }
    __device__ __forceinline__ size_t b_off(const Unit& u) const { return (size_t)u.pn * b_tile; }
};
struct InOrder {
    int G, c; size_t a_tile, b_tile;
    __device__ __forceinline__ bool next(int i, Unit& u) const {
        const long L = (long)i * G + c; if (L >= 1152 + 48) return false;
        if (L < 1152) { tile_of((int)L, 64, 18, u.pm, u.pn); } else { const int j = (int)L - 1152; u.pm = 64 + (j & 7); u.pn = 2 + (j >> 3); }
        u.z = 0; return true;
    }
    __device__ __forceinline__ size_t a_off(const Unit& u) const { return (size_t)u.pm * a_tile; }
    __device__ __forceinline__ size_t b_off(const Unit& u) const { return (size_t)u.pn * b_tile; }
};
struct DftOrder {
    int G, c; size_t a_tile, b_tile;
    __device__ __forceinline__ bool next(int i, Unit& u) const {
        const long L = (long)i * G + c; if (L >= 128) return false;
        u.z = (int)L >> 4; u.pm = ((int)L >> 1) & 7; u.pn = (int)L & 1; return true;
    }
    __device__ __forceinline__ size_t a_off(const Unit& u) const { return (size_t)u.pm * a_tile; }
    __device__ __forceinline__ size_t b_off(const Unit& u) const { return (size_t)u.pn * b_tile + (size_t)u.z * 4096 * 2; }
};

__device__ __forceinline__ unsigned cvt_pk_bf16(float lo, float hi) { unsigned r; asm volatile("v_cvt_pk_bf16_f32 %0, %1, %2" : "=v"(r) : "v"(lo), "v"(hi)); return r; }

template <class F> struct Epi8 {
    static constexpr bool PERM = true;
    F f;
    __device__ __forceinline__ void operator()(const f32x4 (&acc)[2][2][4][2], const Unit& u, int wr, int wc, int fr, int fq) const {
        const int row0 = u.pm * BM + wr * 64 + fr, col0 = u.pn * BM + wc * 32 + 8 * fq;
#pragma unroll
        for (int ai = 0; ai < 2; ++ai)
#pragma unroll
            for (int m = 0; m < 4; ++m) {
#pragma unroll
                for (int bj = 0; bj < 2; ++bj) f(u, row0 + ai * HALF + m * 16, col0 + bj * HALF, acc[ai][bj][m][0], acc[ai][bj][m][1]);
                asm volatile("" ::: "memory");
            }
    }
};

template <class Epi, class Sched, bool ALIGN_EPI = false, bool SP2 = false>
__device__ __forceinline__ void gemm_phase(PG8_LAS unsigned char* lds, const Gemm g, const Sched& S, const Epi& E) {
    int tid_ = threadIdx.x; asm volatile("" : "+v"(tid_));
    const int tid = tid_, wid = __builtin_amdgcn_readfirstlane(tid >> 6), lane = tid & 63, wr = wid >> 2, wc = wid & 3, fr = lane & 15, fq = lane >> 4;
    const int K = g.K, nt = K / BK;
    unsigned voffA[2], voffB[2];
#pragma unroll
    for (int i = 0; i < 2; ++i) { int R, C; stage_rc(tid * 16 + i * 8192, R, C); const int Rb = Epi::PERM ? ((R & ~31) + perm32(R & 31)) : R;
        voffA[i] = (unsigned)(R * g.lda + C) * 2u; voffB[i] = (unsigned)(Rb * g.ldb + C) * 2u; }
    const size_t kstep = (size_t)(BK * 2);
    const size_t hstepA = (size_t)HALF * g.lda * 2, hstepB = (size_t)HALF * g.ldb * 2;
    const unsigned ldsw = (unsigned)wid * 1024u;
    const int aoff = lds_byte(wr * 64 + fr, fq * 8), boff = lds_byte(wc * 32 + fr, fq * 8);
#define PG8_SA(b, h) (((b) * 2 + (h)) * HTB)
#define PG8_SB(b, h) ((4 + (b) * 2 + (h)) * HTB)
#define PG8_STAGE(bufoff, gbase, voff) do { _Pragma("unroll") for (int _i = 0; _i < 2; ++_i) \
        __builtin_amdgcn_global_load_lds((const unsigned*)((const char*)(gbase) + (voff)[_i]), (PG8_LAS unsigned*)(lds + (bufoff) + ldsw + _i * 8192), 16, 0, 0); } while (0)
#define PG8_LDA(dst, b, h) do { _Pragma("unroll") for (int m = 0; m < 4; ++m) _Pragma("unroll") for (int k = 0; k < 2; ++k) dst[m][k] = *(const PG8_LAS bf16x8*)(lds + PG8_SA(b, h) + aoff + m * 2048 + k * 1024); } while (0)
#define PG8_LDB(dst, b, h) do { _Pragma("unroll") for (int n = 0; n < 2; ++n) _Pragma("unroll") for (int k = 0; k < 2; ++k) dst[n][k] = *(const PG8_LAS bf16x8*)(lds + PG8_SB(b, h) + boff + n * 2048 + k * 1024); } while (0)
#define PG8_MMA(ai, bj, At, Bt) do { __builtin_amdgcn_s_setprio(1); _Pragma("unroll") for (int m = 0; m < 4; ++m) _Pragma("unroll") for (int n = 0; n < 2; ++n) _Pragma("unroll") for (int k = 0; k < 2; ++k) \
        acc[ai][bj][m][n] = __builtin_amdgcn_mfma_f32_16x16x32_bf16(Bt[n][k], At[m][k], acc[ai][bj][m][n], 0, 0, 0); __builtin_amdgcn_s_setprio(0); } while (0)
#define PG8_WAIT_V(n) asm volatile("s_waitcnt vmcnt(" #n ")" ::: "memory")
#define PG8_WAIT_L(n) asm volatile("s_waitcnt lgkmcnt(" #n ")" ::: "memory")
#define PG8_BAR __builtin_amdgcn_s_barrier()
#define PG8_SCHED __builtin_amdgcn_sched_barrier(0)
    Unit cur, nxt; int ui = 0;
    if (!S.next(0, cur)) return;
    f32x4 acc[2][2][4][2];
#pragma unroll
    for (int a = 0; a < 2; ++a)
#pragma unroll
        for (int b = 0; b < 2; ++b)
#pragma unroll
            for (int m = 0; m < 4; ++m)
#pragma unroll
                for (int n = 0; n < 2; ++n) acc[a][b][m][n] = (f32x4){0.f, 0.f, 0.f, 0.f};
    bf16x8 At[4][2], B0[2][2], B1[2][2];
    const char* cA = (const char*)g.A + S.a_off(cur); const char* cB = (const char*)g.Bt + S.b_off(cur);
    if constexpr (SP2) {
        PG8_STAGE(PG8_SB(0, 0), cB, voffB); PG8_STAGE(PG8_SB(0, 1), cB + hstepB, voffB); PG8_STAGE(PG8_SA(0, 0), cA, voffA); PG8_STAGE(PG8_SA(0, 1), cA + hstepA, voffA);
        if (wr == 1) PG8_BAR;
        PG8_WAIT_V(2); PG8_BAR;
        PG8_STAGE(PG8_SB(1, 0), cB + kstep, voffB); PG8_STAGE(PG8_SA(1, 0), cA + kstep, voffA); PG8_STAGE(PG8_SB(1, 1), cB + hstepB + kstep, voffB);
        PG8_WAIT_V(6); PG8_BAR;
    } else {
        PG8_STAGE(PG8_SB(0, 0), cB, voffB); PG8_STAGE(PG8_SA(0, 0), cA, voffA); PG8_STAGE(PG8_SB(0, 1), cB + hstepB, voffB); PG8_STAGE(PG8_SA(0, 1), cA + hstepA, voffA);
        if (wr == 1) PG8_BAR;
        PG8_WAIT_V(4); PG8_BAR;
        PG8_STAGE(PG8_SB(1, 0), cB + kstep, voffB); PG8_STAGE(PG8_SA(1, 0), cA + kstep, voffA); PG8_STAGE(PG8_SB(1, 1), cB + hstepB + kstep, voffB);
        PG8_WAIT_V(6); PG8_BAR;
    }
    for (;;) {
        const bool has_next = S.next(ui + 1, nxt);
        const char* nA = has_next ? (const char*)g.A + S.a_off(nxt) : cA; const char* nB = has_next ? (const char*)g.Bt + S.b_off(nxt) : cB;
        for (int t = 0; t < nt; t += 2) {
            const bool last = (t == nt - 2);
            const char* a1 = cA + (size_t)(t + 1) * kstep;
            const char* a2 = last ? nA : cA + (size_t)(t + 2) * kstep; const char* b2 = last ? nB : cB + (size_t)(t + 2) * kstep;
            const char* a3 = a2 + kstep; const char* b3 = b2 + kstep;
            if constexpr (SP2) {
            PG8_LDB(B0, 0, 0); PG8_LDB(B1, 0, 1); PG8_SCHED; PG8_LDA(At, 0, 0); PG8_STAGE(PG8_SA(1, 1), a1 + hstepA, voffA);
            PG8_WAIT_V(8); PG8_WAIT_L(0); PG8_BAR; PG8_MMA(0, 0, At, B0); PG8_MMA(0, 1, At, B1); PG8_BAR; PG8_SCHED;
            PG8_LDA(At, 0, 1); PG8_STAGE(PG8_SB(0, 0), b2, voffB); PG8_STAGE(PG8_SB(0, 1), b2 + hstepB, voffB); PG8_STAGE(PG8_SA(0, 0), a2, voffA);
            PG8_WAIT_V(8); PG8_WAIT_L(0); PG8_BAR; PG8_MMA(1, 0, At, B0); PG8_MMA(1, 1, At, B1); PG8_BAR; PG8_SCHED;
            PG8_LDB(B0, 1, 0); PG8_LDB(B1, 1, 1); PG8_SCHED; PG8_LDA(At, 1, 0); PG8_STAGE(PG8_SA(0, 1), a2 + hstepA, voffA);
            PG8_WAIT_V(8); PG8_WAIT_L(0); PG8_BAR; PG8_MMA(0, 0, At, B0); PG8_MMA(0, 1, At, B1); PG8_BAR; PG8_SCHED;
            PG8_LDA(At, 1, 1); PG8_STAGE(PG8_SB(1, 0), b3, voffB); PG8_STAGE(PG8_SB(1, 1), b3 + hstepB, voffB); PG8_STAGE(PG8_SA(1, 0), a3, voffA);
            PG8_WAIT_V(8); PG8_WAIT_L(0); PG8_BAR; PG8_MMA(1, 0, At, B0); PG8_MMA(1, 1, At, B1); PG8_BAR; PG8_SCHED;
            } else {
            PG8_LDB(B0, 0, 0); PG8_SCHED; PG8_LDA(At, 0, 0); PG8_STAGE(PG8_SA(1, 1), a1 + hstepA, voffA);
            PG8_WAIT_L(8); PG8_BAR; PG8_WAIT_L(0); PG8_MMA(0, 0, At, B0); PG8_BAR; PG8_SCHED;
            PG8_LDB(B1, 0, 1); PG8_STAGE(PG8_SB(0, 0), b2, voffB);
            PG8_BAR; PG8_WAIT_L(0); PG8_MMA(0, 1, At, B1); PG8_BAR;
            PG8_LDA(At, 0, 1); PG8_STAGE(PG8_SA(0, 0), a2, voffA);
            PG8_BAR; PG8_WAIT_L(0); PG8_MMA(1, 0, At, B0); PG8_BAR; PG8_SCHED;
            PG8_STAGE(PG8_SB(0, 1), b2 + hstepB, voffB);
            PG8_WAIT_V(6); PG8_BAR; PG8_MMA(1, 1, At, B1); PG8_BAR;
            PG8_LDB(B0, 1, 0); PG8_SCHED; PG8_LDA(At, 1, 0); PG8_STAGE(PG8_SA(0, 1), a2 + hstepA, voffA);
            PG8_WAIT_L(8); PG8_BAR; PG8_WAIT_L(0); PG8_MMA(0, 0, At, B0); PG8_BAR; PG8_SCHED;
            PG8_LDB(B1, 1, 1); PG8_STAGE(PG8_SB(1, 0), b3, voffB);
            PG8_BAR; PG8_WAIT_L(0); PG8_MMA(0, 1, At, B1); PG8_BAR;
            PG8_LDA(At, 1, 1); PG8_STAGE(PG8_SA(1, 0), a3, voffA);
            PG8_BAR; PG8_WAIT_L(0); PG8_MMA(1, 0, At, B0); PG8_BAR; PG8_SCHED;
            PG8_STAGE(PG8_SB(1, 1), b3 + hstepB, voffB);
            PG8_WAIT_V(6); PG8_BAR; PG8_MMA(1, 1, At, B1); PG8_BAR;
            }
        }
        if constexpr (ALIGN_EPI) { if (wr == 0) PG8_BAR; }
        E(acc, cur, wr, wc, fr, fq);
        if (!has_next) break;
#pragma unroll
        for (int a = 0; a < 2; ++a)
#pragma unroll
            for (int b = 0; b < 2; ++b)
#pragma unroll
                for (int m = 0; m < 4; ++m)
#pragma unroll
                    for (int n = 0; n < 2; ++n) acc[a][b][m][n] = (f32x4){0.f, 0.f, 0.f, 0.f};
        cur = nxt; cA = nA; cB = nB; ++ui;
        if constexpr (ALIGN_EPI) { if (wr == 1) PG8_BAR; }
    }
    PG8_WAIT_V(0);
    if constexpr (!ALIGN_EPI) { if (wr == 0) PG8_BAR; }
    PG8_BAR;
#undef PG8_SA
#undef PG8_SB
#undef PG8_STAGE
#undef PG8_LDA
#undef PG8_LDB
#undef PG8_MMA
#undef PG8_WAIT_V
#undef PG8_WAIT_L
#undef PG8_BAR
#undef PG8_SCHED
}
}

constexpr int DM = 1024, NB = 8, SEQ = 2048, MTOK = NB * SEQ, CTXL = 256, MCTX = NB * CTXL;
constexpr int HGD = 512, DFF = 2816, DFF2 = 5632, INDIM = 5120, NMOD = 6;
constexpr float EPSN = 1e-6f;
constexpr int NWAVES = 8, NTHR = 512;
constexpr int LDS_BYTES = 147456;
#ifndef PH_MASK
#define PH_MASK 0xFFFF
#endif

constexpr size_t MiB = 1u << 20;
constexpr size_t WS_MX = 0;
constexpr size_t WS_LB = 256 * 1024;
constexpr size_t WS_WIN = 6 * MiB;
constexpr size_t WS_WPQ = 16 * MiB;
constexpr size_t WS_WA = 18 * MiB, WS_WB = 19 * MiB, WS_WOUT = 20 * MiB;
constexpr size_t WS_CS = 22 * MiB;
constexpr size_t WS_WUP = 6 * MiB;
constexpr size_t WS_WDN = 17 * MiB;
constexpr size_t WS_HX = 38 * MiB;
constexpr size_t WS_OF = 38 * MiB, WS_OB = 54 * MiB;
constexpr size_t WS_TMP = 38 * MiB;
constexpr size_t WS_H2 = 38 * MiB;
constexpr size_t WS_Q = 74 * MiB, WS_V = 90 * MiB, WS_OG = 106 * MiB, WS_GA = 122 * MiB, WS_GBG = 154 * MiB, WS_PQT = 186 * MiB;
constexpr size_t WS_GFC = 218 * MiB, WS_GBC = 222 * MiB, WS_VC = 226 * MiB;
constexpr size_t WS_YF = 228 * MiB;
constexpr size_t WS_YH = 74 * MiB;
constexpr size_t WS_MRG = 186 * MiB;
constexpr size_t WS_Z = 74 * MiB;
constexpr size_t WS_A2 = 162 * MiB;
constexpr size_t WS_END = 256 * MiB;

typedef unsigned short bf16;
typedef float f32x4 __attribute__((ext_vector_type(4)));
typedef unsigned u32x4 __attribute__((ext_vector_type(4)));
typedef unsigned u32x2 __attribute__((ext_vector_type(2)));
#define LAS __attribute__((address_space(3)))

struct Params {
    const float* in[19];
    float* out;
    unsigned char* ws;
};

__device__ __forceinline__ float bf2f(unsigned short b) { return __uint_as_float(((unsigned)b) << 16); }
__device__ __forceinline__ float bflo(unsigned w) { return __uint_as_float(w << 16); }
__device__ __forceinline__ float bfhi(unsigned w) { return __uint_as_float(w & 0xffff0000u); }
__device__ __forceinline__ unsigned f2bf(float f) { unsigned u = __float_as_uint(f); return (u + 0x7fffu + ((u >> 16) & 1u)) >> 16; }
__device__ __forceinline__ unsigned pk2(float lo, float hi) { return f2bf(lo) | (f2bf(hi) << 16); }
__device__ __forceinline__ float sigmoidf_(float x) { return 1.f / (1.f + __expf(-x)); }
__device__ __forceinline__ float siluf_(float x) { return x / (1.f + __expf(-x)); }
__device__ __forceinline__ float wave_sum(float v) {
#pragma unroll
    for (int o = 1; o < 64; o <<= 1) v += __shfl_xor(v, o);
    return v;
}
__device__ __forceinline__ u32x4 pack8(const f32x4 a, const f32x4 b) { u32x4 w; w.x = pk2(a[0], a[1]); w.y = pk2(a[2], a[3]); w.z = pk2(b[0], b[1]); w.w = pk2(b[2], b[3]); return w; }

struct FIn {
    unsigned char* ws; float* out;
    __device__ __forceinline__ void operator()(const pg8::Unit& u, int row, int col, f32x4 v0, f32x4 v1) const {
        const int seg = u.pn >> 1, c = col & 511;
        if (seg == 0 || seg == 4) { f32x4 a, b;
#pragma unroll
            for (int i = 0; i < 4; ++i) { a[i] = siluf_(v0[i]); b[i] = siluf_(v1[i]); }
            bf16* dst = (bf16*)(ws + (seg == 0 ? WS_Q : WS_OG));
            *(u32x4*)(dst + (size_t)row * 512 + c) = pack8(a, b);
        } else if (seg == 1 || seg == 2) {
            const float* lb = (const float*)(ws + WS_LB);
            const f32x4 l0 = *(const f32x4*)(lb + c), l1 = *(const f32x4*)(lb + c + 4); f32x4 a, b;
#pragma unroll
            for (int i = 0; i < 4; ++i) { a[i] = __logf(l0[i] + (1.f - l0[i]) * sigmoidf_(v0[i])); b[i] = __logf(l1[i] + (1.f - l1[i]) * sigmoidf_(v1[i])); }
            float* dst;
            if (u.pm < 64) dst = out + (seg == 1 ? (size_t)0 : (size_t)MTOK * 512) + (size_t)row * 512 + c;
            else dst = (float*)(ws + (seg == 1 ? WS_GFC : WS_GBC)) + (size_t)(row - MTOK) * 512 + c;
            *(f32x4*)dst = a; *(f32x4*)(dst + 4) = b;
        } else if (seg == 3) {
            bf16* dst;
            if (u.pm < 64) dst = (bf16*)(ws + WS_V) + (size_t)row * 512 + c; else dst = (bf16*)(ws + WS_VC) + (size_t)(row - MTOK) * 512 + c;
            *(u32x4*)dst = pack8(v0, v1);
        } else { f32x4 a, b;
#pragma unroll
            for (int i = 0; i < 4; ++i) { a[i] = sigmoidf_(v0[i]); b[i] = sigmoidf_(v1[i]); }
            bf16* dst = (seg < 7) ? ((bf16*)(ws + WS_GA) + (size_t)row * 1024 + (col - 5 * 512)) : ((bf16*)(ws + WS_GBG) + (size_t)row * 1024 + (col - 7 * 512));
            *(u32x4*)dst = pack8(a, b);
        }
    }
};
struct FPQ {
    bf16* pqt;
    __device__ __forceinline__ void operator()(const pg8::Unit&, int row, int col, f32x4 v0, f32x4 v1) const {
        *(u32x4*)(pqt + (size_t)(row & 511) * 32768 + (size_t)(col >> 11) * 4096 + (size_t)(row >> 9) * 2048 + (col & 2047)) = pack8(v0, v1);
    }
};
struct FDft {
    bf16* yf;
    __device__ __forceinline__ void operator()(const pg8::Unit& u, int row, int col, f32x4 v0, f32x4 v1) const {
        *(u32x4*)(yf + ((size_t)u.z * SEQ + row) * 512 + col) = pack8(v0 * (1.f / 512.f), v1 * (1.f / 512.f));
    }
};
struct FYa {
    const bf16* ga; bf16* tmp;
    __device__ __forceinline__ void operator()(const pg8::Unit&, int row, int col, f32x4 v0, f32x4 v1) const {
        const size_t o = (size_t)row * 1024 + col; const u32x4 g = *(const u32x4*)(ga + o);
        f32x4 a, b; a[0] = v0[0] * bflo(g.x); a[1] = v0[1] * bfhi(g.x); a[2] = v0[2] * bflo(g.y); a[3] = v0[3] * bfhi(g.y);
        b[0] = v1[0] * bflo(g.z); b[1] = v1[1] * bfhi(g.z); b[2] = v1[2] * bflo(g.w); b[3] = v1[3] * bfhi(g.w);
        *(u32x4*)(tmp + o) = pack8(a, b);
    }
};
struct FYb {
    const bf16* gbg; const bf16* tmp; bf16* mrg;
    __device__ __forceinline__ void operator()(const pg8::Unit&, int row, int col, f32x4 v0, f32x4 v1) const {
        const size_t o = (size_t)row * 1024 + col; const u32x4 g = *(const u32x4*)(gbg + o); const u32x4 t = *(const u32x4*)(tmp + o);
        f32x4 a, b; a[0] = bflo(t.x) + v0[0] * bflo(g.x); a[1] = bfhi(t.x) + v0[1] * bfhi(g.x); a[2] = bflo(t.y) + v0[2] * bflo(g.y); a[3] = bfhi(t.y) + v0[3] * bfhi(g.y);
        b[0] = bflo(t.z) + v1[0] * bflo(g.z); b[1] = bfhi(t.z) + v1[1] * bfhi(g.z); b[2] = bflo(t.w) + v1[2] * bflo(g.w); b[3] = bfhi(t.w) + v1[3] * bfhi(g.w);
        *(u32x4*)(mrg + o) = pack8(a, b);
    }
};
struct FRes {
    const float* src; float* dst; const float* mx; int mod;
    __device__ __forceinline__ void operator()(const pg8::Unit&, int row, int col, f32x4 v0, f32x4 v1) const {
        const size_t o = (size_t)row * 1024 + col; const float* m = mx + (size_t)(row >> 11) * (NMOD * DM) + mod * DM + col;
        const f32x4 m0 = *(const f32x4*)m, m1 = *(const f32x4*)(m + 4), s0 = *(const f32x4*)(src + o), s1 = *(const f32x4*)(src + o + 4);
        *(f32x4*)(dst + o) = s0 + m0 * v0; *(f32x4*)(dst + o + 4) = s1 + m1 * v1;
    }
};
struct FUp {
    bf16* z;
    __device__ __forceinline__ void operator()(const pg8::Unit&, int row, int col, f32x4 v0, f32x4 v1) const {
        *(u32x4*)(z + (size_t)row * DFF2 + col) = pack8(v0, v1);
    }
};

__device__ __forceinline__ void transpose_item(const float* W, int K, int N, bf16* WT, LAS float* scr, int item, int lane) {
    const int nblk = N / 32, kb = item / nblk, nb = item % nblk, k0 = 64 * kb, n0 = 32 * nb;
#pragma unroll 8
    for (int i = 0; i < 32; ++i) { const int kk = 2 * i + (lane >> 5); scr[kk * 33 + (lane & 31)] = W[(size_t)(k0 + kk) * N + n0 + (lane & 31)]; }
    asm volatile("s_waitcnt lgkmcnt(0)" ::: "memory");
    const int c = lane & 7;
#pragma unroll
    for (int j = 0; j < 4; ++j) { const int n = (lane >> 3) + 8 * j; const LAS float* s = scr + (8 * c) * 33 + n;
        u32x4 o; o.x = pk2(s[0 * 33], s[1 * 33]); o.y = pk2(s[2 * 33], s[3 * 33]); o.z = pk2(s[4 * 33], s[5 * 33]); o.w = pk2(s[6 * 33], s[7 * 33]);
        *(u32x4*)(WT + (size_t)(n0 + n) * K + k0 + 8 * c) = o; }
    asm volatile("s_waitcnt lgkmcnt(0)" ::: "memory");
}

__device__ __forceinline__ void norm_mod_row(const float* xrow, const float* g, const float* shift, const float* scale, bf16* orow, int lane) {
    f32x4 v[4]; float s = 0.f;
#pragma unroll
    for (int j = 0; j < 4; ++j) { v[j] = *(const f32x4*)(xrow + (lane + 64 * j) * 4); s += (v[j][0] * v[j][0] + v[j][1] * v[j][1]) + (v[j][2] * v[j][2] + v[j][3] * v[j][3]); }
    const float rinv = rsqrtf(wave_sum(s) * (1.f / DM) + EPSN);
#pragma unroll
    for (int j = 0; j < 4; ++j) { const int e = (lane + 64 * j) * 4;
        const f32x4 gg = *(const f32x4*)(g + e), sh = *(const f32x4*)(shift + e), sc = *(const f32x4*)(scale + e);
        const f32x4 h = v[j] * rinv * gg * (sc + 1.f) + sh;
        u32x2 w; w.x = pk2(h[0], h[1]); w.y = pk2(h[2], h[3]); *(u32x2*)(orow + e) = w; }
}

__device__ __forceinline__ void phase0(const Params& p, unsigned char* lds, int tid, int lane, int wave, int G) {
    float* ldsf = (float*)lds;
    float* mxo = (float*)(p.ws + WS_MX);
    for (int it = blockIdx.x; it < 256; it += G) {
        __syncthreads();
        if (it < 192) {
            const float* c = p.in[1]; const float* cc = p.in[3]; const float* aw = p.in[4]; const float* ab = p.in[5];
            float* sc = ldsf;
            float* red = ldsf + 9 * 1024;
            for (int i = tid; i < 9 * 1024; i += NTHR) { const int r = i >> 10, k = i & 1023; const float cv = (r < 8) ? c[r * 1024 + k] : cc[k]; sc[i] = cv / (1.f + __expf(-cv)); }
            __syncthreads();
            const int n0 = it * 32, col = tid & 31, ks = tid >> 5;
            float a[9];
#pragma unroll
            for (int r = 0; r < 9; ++r) a[r] = 0.f;
            for (int k = ks * 64; k < ks * 64 + 64; ++k) { const float w = aw[(size_t)k * (NMOD * DM) + n0 + col];
#pragma unroll
                for (int r = 0; r < 9; ++r) a[r] += sc[r * 1024 + k] * w; }
#pragma unroll
            for (int r = 0; r < 9; ++r) red[(ks * 9 + r) * 32 + col] = a[r];
            __syncthreads();
            if (tid < 288) { const int r = tid >> 5, cl = tid & 31; float s = ab[n0 + cl];
                for (int k2 = 0; k2 < 16; ++k2) s += red[(k2 * 9 + r) * 32 + cl];
                mxo[r * (NMOD * DM) + n0 + cl] = s; }
        } else {
            const int w = it - 192, kb = w >> 2, g = w & 3, k0 = kb * 64;
            const float* win = p.in[7];
            float* wt = ldsf;
            float* tabc = ldsf + 64 * 129; float* tabs = tabc + 128;
            for (int i = tid; i < 64 * 128; i += NTHR) { const int kk = i >> 7, cc = i & 127; wt[kk * 129 + cc] = win[(size_t)(k0 + kk) * INDIM + g * 128 + cc]; }
            if (tid < 128) { tabc[tid] = cospif((float)tid * (1.f / 64.f)); tabs[tid] = sinpif((float)tid * (1.f / 64.f)); }
            __syncthreads();
            bf16* wpq = (bf16*)(p.ws + WS_WPQ);
            const int kk = tid & 63, jj = tid >> 6;
            for (int j = jj; j < 128; j += 8) { float aP = 0.f, aQ = 0.f;
                for (int cI = 0; cI < 128; ++cI) { const float wv = wt[kk * 129 + cI]; const int idx = (cI * j) & 127; aP += wv * tabc[idx]; aQ += wv * tabs[idx]; }
                wpq[(size_t)(g * 128 + j) * 1024 + k0 + kk] = (bf16)f2bf(aP);
                wpq[(size_t)(512 + g * 128 + j) * 1024 + k0 + kk] = (bf16)f2bf(aQ); }
        }
    }
    __syncthreads();
    if (blockIdx.x == 0) { const float* hl = p.in[8]; float* lbo = (float*)(p.ws + WS_LB);
        if (tid < 512) { const float a = hl[tid], b = hl[512 + tid]; lbo[tid] = 1.f / (1.f + expf(b - a)); } }
    { bf16* cs = (bf16*)(p.ws + WS_CS);
      for (int i = blockIdx.x * NTHR + tid; i < 2048 * 512; i += G * NTHR) { const int l = i >> 9, kc = (i & 511) * 8; float vv[8];
#pragma unroll
          for (int e = 0; e < 8; ++e) { const int k = kc + e, s = k >> 11, kk = k & 2047, ph = (l * kk) & 2047; const float ang = (float)ph * (1.f / 1024.f); vv[e] = s ? -sinpif(ang) : cospif(ang); }
          u32x4 w; w.x = pk2(vv[0], vv[1]); w.y = pk2(vv[2], vv[3]); w.z = pk2(vv[4], vv[5]); w.w = pk2(vv[6], vv[7]);
          *(u32x4*)(cs + (size_t)l * 4096 + kc) = w; } }
    { LAS float* scr = (LAS float*)((LAS unsigned char*)lds + wave * 16384);
      const int gw = blockIdx.x * NWAVES + wave, NGW = G * NWAVES;
      constexpr int I_IN = 16 * 160, I_A = 8 * 32, I_B = 8 * 32, I_O = 16 * 32;
      for (int it = gw; it < I_IN + I_A + I_B + I_O; it += NGW) { int r = it;
          if (r < I_IN) { transpose_item(p.in[7], 1024, INDIM, (bf16*)(p.ws + WS_WIN), scr, r, lane); continue; } r -= I_IN;
          if (r < I_A) { transpose_item(p.in[10], 512, 1024, (bf16*)(p.ws + WS_WA), scr, r, lane); continue; } r -= I_A;
          if (r < I_B) { transpose_item(p.in[11], 512, 1024, (bf16*)(p.ws + WS_WB), scr, r, lane); continue; } r -= I_B;
          transpose_item(p.in[12], 1024, 1024, (bf16*)(p.ws + WS_WOUT), scr, r, lane); } }
}

__device__ __forceinline__ void hgrn_naive_item(const Params& p, unsigned char* lds, int item, int tid) {
    const int dir = item & 1, h = (item >> 1) & 3, b = item >> 3;
    float* Fs = (float*)lds;
    float* Ks = Fs + 16 * 144; float* Qs = Ks + 16 * 144;
    float* Vs = Qs + 16 * 144;
    float* Os = Vs + 16 * 128;
    float S[32];
#pragma unroll
    for (int j = 0; j < 32; ++j) S[j] = 0.f;
    const int ds = tid & 3, vcol = tid >> 2;
    const int stt = tid >> 5, sd4 = (tid & 31) * 4, sdl = (sd4 >> 5) * 36 + (sd4 & 31);
    for (int seg = 0; seg < 2; ++seg) {
        const int nsteps = seg ? SEQ : CTXL;
        const float* gptr = seg ? ((const float*)p.out + (dir ? (size_t)MTOK * 512 : 0) + (size_t)b * SEQ * 512)
                                : ((const float*)(p.ws + (dir ? WS_GBC : WS_GFC)) + (size_t)b * CTXL * 512);
        const bf16* vptr = seg ? ((const bf16*)(p.ws + WS_V) + (size_t)b * SEQ * 512) : ((const bf16*)(p.ws + WS_VC) + (size_t)b * CTXL * 512);
        const bf16* qptr = (const bf16*)(p.ws + WS_Q) + (size_t)b * SEQ * 512;
        bf16* optr = (bf16*)(p.ws + (dir ? WS_OB : WS_OF)) + (size_t)b * SEQ * 512;
        for (int c0 = 0; c0 < nsteps; c0 += 16) {
            __syncthreads();
            { const int s = c0 + stt, pos = dir ? (nsteps - 1 - s) : s; const size_t o = (size_t)pos * 512 + h * 128 + sd4;
              const f32x4 g4 = *(const f32x4*)(gptr + o); f32x4 f4, k4;
#pragma unroll
              for (int i = 0; i < 4; ++i) { f4[i] = __expf(g4[i]); k4[i] = 1.f - f4[i]; }
              *(f32x4*)(Fs + stt * 144 + sdl) = f4; *(f32x4*)(Ks + stt * 144 + sdl) = k4;
              const u32x2 vv = *(const u32x2*)(vptr + o); f32x4 v4; v4[0] = bflo(vv.x); v4[1] = bfhi(vv.x); v4[2] = bflo(vv.y); v4[3] = bfhi(vv.y);
              *(f32x4*)(Vs + stt * 128 + sd4) = v4;
              if (seg) { const u32x2 qq = *(const u32x2*)(qptr + o); f32x4 q4; q4[0] = bflo(qq.x); q4[1] = bfhi(qq.x); q4[2] = bflo(qq.y); q4[3] = bfhi(qq.y);
                  *(f32x4*)(Qs + stt * 144 + sdl) = q4; } }
            __syncthreads();
            for (int tt = 0; tt < 16; ++tt) {
                const float vv = Vs[tt * 128 + vcol]; float acc = 0.f;
#pragma unroll
                for (int j4 = 0; j4 < 8; ++j4) {
                    const f32x4 f4 = *(const f32x4*)(Fs + tt * 144 + ds * 36 + j4 * 4), k4 = *(const f32x4*)(Ks + tt * 144 + ds * 36 + j4 * 4);
                    f32x4 q4 = (f32x4){0.f, 0.f, 0.f, 0.f}; if (seg) q4 = *(const f32x4*)(Qs + tt * 144 + ds * 36 + j4 * 4);
#pragma unroll
                    for (int i = 0; i < 4; ++i) { S[j4 * 4 + i] = f4[i] * S[j4 * 4 + i] + k4[i] * vv; acc += S[j4 * 4 + i] * q4[i]; }
                }
                if (seg) { acc += __shfl_xor(acc, 1); acc += __shfl_xor(acc, 2); if (ds == 0) Os[tt * 128 + vcol] = acc; }
            }
            if (seg) { __syncthreads();
                const int s = c0 + stt, pos = dir ? (nsteps - 1 - s) : s; const f32x4 o4 = *(const f32x4*)(Os + stt * 128 + sd4);
                u32x2 w; w.x = pk2(o4[0], o4[1]); w.y = pk2(o4[2], o4[3]);
                *(u32x2*)(optr + (size_t)pos * 512 + h * 128 + sd4) = w; }
        }
    }
    __syncthreads();
}

__device__ __forceinline__ void phase_yh(const Params& p, int lane, int gw, int NGW) {
    const bf16* of = (const bf16*)(p.ws + WS_OF); const bf16* ob = (const bf16*)(p.ws + WS_OB); const bf16* og = (const bf16*)(p.ws + WS_OG);
    bf16* yh = (bf16*)(p.ws + WS_YH); const float* on = p.in[9];
    for (int m = gw; m < MTOK; m += NGW) { const size_t o = (size_t)m * 512 + lane * 8;
        const u32x4 a = *(const u32x4*)(of + o), b = *(const u32x4*)(ob + o), gg = *(const u32x4*)(og + o);
        float v[8]; v[0] = bflo(a.x) + bflo(b.x); v[1] = bfhi(a.x) + bfhi(b.x); v[2] = bflo(a.y) + bflo(b.y); v[3] = bfhi(a.y) + bfhi(b.y);
        v[4] = bflo(a.z) + bflo(b.z); v[5] = bfhi(a.z) + bfhi(b.z); v[6] = bflo(a.w) + bflo(b.w); v[7] = bfhi(a.w) + bfhi(b.w);
        float s = 0.f;
#pragma unroll
        for (int i = 0; i < 8; ++i) s += v[i] * v[i];
        s += __shfl_xor(s, 1); s += __shfl_xor(s, 2); s += __shfl_xor(s, 4); s += __shfl_xor(s, 8);
        const float rinv = rsqrtf(s * (1.f / 128.f) + EPSN);
        const f32x4 n0 = *(const f32x4*)(on + lane * 8), n1 = *(const f32x4*)(on + lane * 8 + 4);
        float gv[8]; gv[0] = bflo(gg.x); gv[1] = bfhi(gg.x); gv[2] = bflo(gg.y); gv[3] = bfhi(gg.y); gv[4] = bflo(gg.z); gv[5] = bfhi(gg.z); gv[6] = bflo(gg.w); gv[7] = bfhi(gg.w);
        f32x4 r0, r1;
#pragma unroll
        for (int i = 0; i < 4; ++i) { r0[i] = v[i] * rinv * n0[i] * gv[i]; r1[i] = v[4 + i] * rinv * n1[i] * gv[4 + i]; }
        *(u32x4*)(yh + o) = pack8(r0, r1); }
}

__device__ __forceinline__ void phase_conv(const Params& p, int hf, int tid, int G) {
    const bf16* z = (const bf16*)(p.ws + WS_Z); bf16* a2 = (bf16*)(p.ws + WS_A2) + (size_t)hf * 8192 * DFF;
    const float* cw = p.in[15]; const float* cb = p.in[16];
    for (int i = blockIdx.x * NTHR + tid; i < 8192 * 352; i += G * NTHR) {
        const int c8 = i % 352, tokr = i / 352, ch = c8 * 8, l = tokr & 2047, r = l >> 6, c = l & 63;
        float a1[8], ag[8];
        { const f32x4 b0 = *(const f32x4*)(cb + ch), b1 = *(const f32x4*)(cb + ch + 4), b2 = *(const f32x4*)(cb + DFF + ch), b3 = *(const f32x4*)(cb + DFF + ch + 4);
#pragma unroll
          for (int e = 0; e < 4; ++e) { a1[e] = b0[e]; a1[4 + e] = b1[e]; ag[e] = b2[e]; ag[4 + e] = b3[e]; } }
#pragma unroll
        for (int di = -1; di <= 1; ++di) { const int rr = r + di; if (rr < 0 || rr >= 32) continue;
#pragma unroll
            for (int dj = -1; dj <= 1; ++dj) { const int c2 = c + dj; if (c2 < 0 || c2 >= 64) continue;
                const size_t zo = (size_t)(tokr + di * 64 + dj) * DFF2 + ch;
                const u32x4 z1 = *(const u32x4*)(z + zo), z2 = *(const u32x4*)(z + zo + DFF);
                const float* w = cw + (size_t)((di + 1) * 3 + (dj + 1)) * DFF2 + ch;
                const f32x4 w0 = *(const f32x4*)w, w1 = *(const f32x4*)(w + 4), w2 = *(const f32x4*)(w + DFF), w3 = *(const f32x4*)(w + DFF + 4);
                a1[0] += bflo(z1.x) * w0[0]; a1[1] += bfhi(z1.x) * w0[1]; a1[2] += bflo(z1.y) * w0[2]; a1[3] += bfhi(z1.y) * w0[3];
                a1[4] += bflo(z1.z) * w1[0]; a1[5] += bfhi(z1.z) * w1[1]; a1[6] += bflo(z1.w) * w1[2]; a1[7] += bfhi(z1.w) * w1[3];
                ag[0] += bflo(z2.x) * w2[0]; ag[1] += bfhi(z2.x) * w2[1]; ag[2] += bflo(z2.y) * w2[2]; ag[3] += bfhi(z2.y) * w2[3];
                ag[4] += bflo(z2.z) * w3[0]; ag[5] += bfhi(z2.z) * w3[1]; ag[6] += bflo(z2.w) * w3[2]; ag[7] += bfhi(z2.w) * w3[3]; } }
        f32x4 r0, r1;
#pragma unroll
        for (int e = 0; e < 4; ++e) { r0[e] = siluf_(a1[e]) * ag[e]; r1[e] = siluf_(a1[4 + e]) * ag[4 + e]; }
        *(u32x4*)(a2 + (size_t)tokr * DFF + ch) = pack8(r0, r1);
    }
}

__global__ void __launch_bounds__(NTHR, 2) fwd_mega(Params p) {
    extern __shared__ __attribute__((aligned(16))) unsigned char lds[];
    cg::grid_group grid = cg::this_grid();
    const int tid = threadIdx.x, lane = tid & 63, wave = __builtin_amdgcn_readfirstlane(tid >> 6);
    const int G = gridDim.x, gw = blockIdx.x * NWAVES + wave, NGW = G * NWAVES;
    PG8_LAS unsigned char* ldsl = (PG8_LAS unsigned char*)lds;
    unsigned char* ws = p.ws;
    const float* mx = (const float*)(ws + WS_MX);

    if constexpr ((PH_MASK >> 0) & 1) {
    phase0(p, lds, tid, lane, wave, G);
    }
    grid.sync();
    if constexpr ((PH_MASK >> 1) & 1) {
    for (int m = gw; m < MTOK + MCTX; m += NGW) {
        const float* src = (m < MTOK) ? p.in[0] + (size_t)m * DM : p.in[2] + (size_t)(m - MTOK) * DM;
        const int mr = (m < MTOK) ? (m >> 11) : 8;
        norm_mod_row(src, p.in[6], mx + mr * (NMOD * DM), mx + mr * (NMOD * DM) + DM, (bf16*)(ws + WS_HX) + (size_t)m * DM, lane);
    }
    }
    grid.sync();
    if constexpr ((PH_MASK >> 2) & 1) {
    {
        pg8::Gemm g{(const bf16*)(ws + WS_HX), (const bf16*)(ws + WS_WIN) + (size_t)512 * 1024, 1024, 1024, 1024};
        pg8::InOrder S; S.G = G; S.c = blockIdx.x; S.a_tile = (size_t)256 * 1024 * 2; S.b_tile = (size_t)256 * 1024 * 2;
        pg8::Epi8<FIn> E{FIn{ws, p.out}};
        pg8::gemm_phase<pg8::Epi8<FIn>, pg8::InOrder, true, true>(ldsl, g, S, E);
    }
    {
        pg8::Gemm g{(const bf16*)(ws + WS_WPQ), (const bf16*)(ws + WS_HX), 1024, 1024, 1024};
        pg8::StaticOrder S; S.init(4, 64, G, blockIdx.x, 1024, 1024);
        pg8::Epi8<FPQ> E{FPQ{(bf16*)(ws + WS_PQT)}};
        pg8::gemm_phase<pg8::Epi8<FPQ>, pg8::StaticOrder, true, true>(ldsl, g, S, E);
    }
    }
    grid.sync();
    if constexpr ((PH_MASK >> 3) & 1) {
    if (blockIdx.x < 128 && G >= 192) {
        pg8::Gemm g{(const bf16*)(ws + WS_CS), (const bf16*)(ws + WS_PQT), 4096, 4096, 32768};
        pg8::DftOrder S; S.G = 128; S.c = blockIdx.x; S.a_tile = (size_t)256 * 4096 * 2; S.b_tile = (size_t)256 * 32768 * 2;
        pg8::Epi8<FDft> E{FDft{(bf16*)(ws + WS_YF)}};
        pg8::gemm_phase<pg8::Epi8<FDft>, pg8::DftOrder, true, true>(ldsl, g, S, E);
    } else if (G >= 192) {
        for (int it = blockIdx.x - 128; it < 64; it += G - 128) hgrn_naive_item(p, lds, it, tid);
    } else {
        pg8::Gemm g{(const bf16*)(ws + WS_CS), (const bf16*)(ws + WS_PQT), 4096, 4096, 32768};
        pg8::DftOrder S; S.G = G; S.c = blockIdx.x; S.a_tile = (size_t)256 * 4096 * 2; S.b_tile = (size_t)256 * 32768 * 2;
        pg8::Epi8<FDft> E{FDft{(bf16*)(ws + WS_YF)}};
        pg8::gemm_phase<pg8::Epi8<FDft>, pg8::DftOrder, true, true>(ldsl, g, S, E);
        for (int it = blockIdx.x; it < 64; it += G) hgrn_naive_item(p, lds, it, tid);
    }
    }
    grid.sync();
    if constexpr ((PH_MASK >> 4) & 1) {
    phase_yh(p, lane, gw, NGW);
    }
    grid.sync();
    if constexpr ((PH_MASK >> 5) & 1) {
    {
        pg8::Gemm g{(const bf16*)(ws + WS_YF), (const bf16*)(ws + WS_WA), 512, 512, 512};
        pg8::StaticOrder S; S.init(64, 4, G, blockIdx.x, 512, 512);
        pg8::Epi8<FYa> E{FYa{(const bf16*)(ws + WS_GA), (bf16*)(ws + WS_TMP)}};
        pg8::gemm_phase<pg8::Epi8<FYa>, pg8::StaticOrder, true, true>(ldsl, g, S, E);
    }
    {
        pg8::Gemm g{(const bf16*)(ws + WS_YH), (const bf16*)(ws + WS_WB), 512, 512, 512};
        pg8::StaticOrder S; S.init(64, 4, G, blockIdx.x, 512, 512);
        pg8::Epi8<FYb> E{FYb{(const bf16*)(ws + WS_GBG), (const bf16*)(ws + WS_TMP), (bf16*)(ws + WS_MRG)}};
        pg8::gemm_phase<pg8::Epi8<FYb>, pg8::StaticOrder, true, true>(ldsl, g, S, E);
    }
    }
    grid.sync();
    if constexpr ((PH_MASK >> 6) & 1) {
    {
        pg8::Gemm g{(const bf16*)(ws + WS_MRG), (const bf16*)(ws + WS_WOUT), 1024, 1024, 1024};
        pg8::StaticOrder S; S.init(64, 4, G, blockIdx.x, 1024, 1024);
        pg8::Epi8<FRes> E{FRes{p.in[0], p.out, mx, 2}};
        pg8::gemm_phase<pg8::Epi8<FRes>, pg8::StaticOrder, true, true>(ldsl, g, S, E);
    }
    }
    grid.sync();
    if constexpr ((PH_MASK >> 7) & 1) {
    for (int m = gw; m < MTOK; m += NGW) {
        const int mr = m >> 11;
        norm_mod_row(p.out + (size_t)m * DM, p.in[13], mx + mr * (NMOD * DM) + 3 * DM, mx + mr * (NMOD * DM) + 4 * DM, (bf16*)(ws + WS_H2) + (size_t)m * DM, lane);
    }
    { LAS float* scr = (LAS float*)((LAS unsigned char*)lds + wave * 16384);
      constexpr int I_UP = 16 * 176, I_DN = 44 * 32;
      for (int it = gw; it < I_UP + I_DN; it += NGW) {
          if (it < I_UP) transpose_item(p.in[14], 1024, DFF2, (bf16*)(ws + WS_WUP), scr, it, lane);
          else transpose_item(p.in[17], DFF, 1024, (bf16*)(ws + WS_WDN), scr, it - I_UP, lane); } }
    }
    grid.sync();
    if constexpr ((PH_MASK >> 8) & 1) {
    for (int hf = 0; hf < 2; ++hf) {
        {
            pg8::Gemm g{(const bf16*)(ws + WS_H2) + (size_t)hf * 8192 * 1024, (const bf16*)(ws + WS_WUP), 1024, 1024, 1024};
            pg8::StaticOrder S; S.init(32, 22, G, blockIdx.x, 1024, 1024);
            pg8::Epi8<FUp> E{FUp{(bf16*)(ws + WS_Z)}};
            pg8::gemm_phase<pg8::Epi8<FUp>, pg8::StaticOrder, true, true>(ldsl, g, S, E);
        }
        grid.sync();
        phase_conv(p, hf, tid, G);
        grid.sync();
    }
    }
    if constexpr ((PH_MASK >> 10) & 1) {
    {
        pg8::Gemm g{(const bf16*)(ws + WS_A2), (const bf16*)(ws + WS_WDN), DFF, DFF, DFF};
        pg8::StaticOrder S; S.init(64, 4, G, blockIdx.x, DFF, DFF);
        pg8::Epi8<FRes> E{FRes{p.out, p.out, mx, 5}};
        pg8::gemm_phase<pg8::Epi8<FRes>, pg8::StaticOrder, true, true>(ldsl, g, S, E);
    }
    }
    grid.sync();
    if constexpr ((PH_MASK >> 11) & 1) {
    for (int m = gw; m < MTOK; m += NGW) {
        float* row = p.out + (size_t)m * DM; const float* fg = p.in[18];
        f32x4 v[4]; float s = 0.f;
#pragma unroll
        for (int j = 0; j < 4; ++j) { v[j] = *(const f32x4*)(row + (lane + 64 * j) * 4); s += (v[j][0] * v[j][0] + v[j][1] * v[j][1]) + (v[j][2] * v[j][2] + v[j][3] * v[j][3]); }
        const float rinv = rsqrtf(wave_sum(s) * (1.f / DM) + EPSN);
#pragma unroll
        for (int j = 0; j < 4; ++j) { const int e = (lane + 64 * j) * 4; *(f32x4*)(row + e) = v[j] * rinv * *(const f32x4*)(fg + e); }
    }
    }
}

extern "C" void kernel_launch(void* const* d_in, const int* in_sizes, int n_in, void* d_out, int out_size, void* d_ws, size_t ws_size, hipStream_t stream) {
    static int grid = 0;
    if (grid == 0) {
        if (n_in != 19 || out_size != MTOK * DM || ws_size < WS_END) { fprintf(stderr, "kernel_launch: unexpected problem: n_in %d out %d ws %zu\n", n_in, out_size, ws_size); grid = -1; return; }
        int dev = 0, cus = 0, per_cu = 0;
        hipGetDevice(&dev);
        hipDeviceGetAttribute(&cus, hipDeviceAttributeMultiprocessorCount, dev);
        if (hipFuncSetAttribute((const void*)fwd_mega, hipFuncAttributeMaxDynamicSharedMemorySize, LDS_BYTES) != hipSuccess) { fprintf(stderr, "kernel_launch: hipFuncSetAttribute failed\n"); grid = -1; return; }
        if (hipOccupancyMaxActiveBlocksPerMultiprocessor(&per_cu, (const void*)fwd_mega, NTHR, LDS_BYTES) != hipSuccess || per_cu < 1) { fprintf(stderr, "kernel_launch: occupancy query says %d\n", per_cu); per_cu = 1; }
        (void)hipGetLastError();
        grid = cus * (per_cu > 1 ? 1 : per_cu);
        fprintf(stderr, "kernel_launch: grid %d (cus %d, per_cu %d), ws %zu\n", grid, cus, per_cu, ws_size);
    }
    if (grid < 0) return;
    Params p{};
    for (int i = 0; i < 19; ++i) p.in[i] = (const float*)d_in[i];
    p.out = (float*)d_out; p.ws = (unsigned char*)d_ws;
    void* args[] = {&p};
    hipError_t e = hipLaunchCooperativeKernel((const void*)fwd_mega, dim3(grid), dim3(NTHR), args, LDS_BYTES, stream);
    if (e != hipSuccess) fprintf(stderr, "kernel_launch: cooperative launch failed: %s (grid %d)\n", hipGetErrorString(e), grid);
}
```

```cpp
#include <hip/hip_runtime.h>
#include <hip/hip_cooperative_groups.h>
#include <cstdio>
#include <cstdint>
namespace cg = cooperative_groups;

namespace pg8 {
#define PG8_LAS __attribute__((address_space(3)))
typedef unsigned short bf16_t;
typedef short bf16x8 __attribute__((ext_vector_type(8)));
typedef float f32x4 __attribute__((ext_vector_type(4)));
typedef unsigned u32x4 __attribute__((ext_vector_type(4)));
typedef unsigned u32x2 __attribute__((ext_vector_type(2)));
constexpr int BM = 256, BK = 64, HALF = 128, HTB = HALF * BK * 2  , STAGE_BYTES = 8 * HTB, NXCD = 8, WGM = 8;

__host__ __device__ __forceinline__ int lds_byte(int r, int c) { const int st = (r >> 4) * 2 + (c >> 5), rr = r & 15, cc = c & 31, ob = rr * 64 + cc * 2; return st * 1024 + (ob ^ (((ob >> 9) & 1) << 5)); }
__host__ __device__ __forceinline__ void stage_rc(int b, int& R, int& C) { const int st = b / 1024, sb = b % 1024, swz = sb ^ (((sb >> 9) & 1) << 5); R = (st >> 1) * 16 + swz / 64; C = (st & 1) * 32 + (swz % 64) / 2; }
__host__ __device__ __forceinline__ int perm32(int rho) { const int n = rho >> 4, i = rho & 15; return 8 * (i >> 2) + 4 * n + (i & 3); }

struct Unit { int pm, pn, z; };
struct Gemm { const bf16_t* A; const bf16_t* Bt; int K, lda, ldb; };

__device__ __forceinline__ void tile_of(int wgid, int nM, int nN, int& pm, int& pn) {
    const int nwg = nM * nN;
    { const int q = nwg / NXCD, r = nwg % NXCD, xcd = wgid % NXCD, off = wgid / NXCD; wgid = (xcd < r ? xcd * (q + 1) : r * (q + 1) + (xcd - r) * q) + off; }
    const int nig = WGM * nN, gid = wgid / nig, fm = gid * WGM, gsz = (nM - fm) < WGM ? (nM - fm) : WGM;
    pm = fm + ((wgid % nig) % gsz); pn = (wgid % nig) / gsz;
}
struct StaticOrder {
    int nM, nN, nwg, G, c; size_t a_tile, b_tile;
    __device__ __forceinline__ void init(int nM_, int nN_, int G_, int c_, int lda, int ldb) { nM = nM_; nN = nN_; nwg = nM * nN; G = G_; c = c_; a_tile = (size_t)BM * lda * 2; b_tile = (size_t)BM * ldb * 2; }
    __device__ __forceinline__ bool next(int i, Unit& u) const {
        const long L = (long)i * G + c; if (L >= nwg) return false;
        tile_of((int)L, nM, nN, u.pm, u.pn); u.z = 0; return true;
    }
    __device__ __forceinline__ size_t a_off(const Unit& u) const { return (size_t)u.pm * a_tile; }
    __device__ __forceinline__ size_t b_off(const Unit& u) const { return (size_t)u.pn * b_tile; }
};
struct InOrder {
    int G, c; size_t a_tile, b_tile;
    __device__ __forceinline__ bool next(int i, Unit& u) const {
        const long L = (long)i * G + c; if (L >= 1152 + 48) return false;
        if (L < 1152) { tile_of((int)L, 64, 18, u.pm, u.pn); } else { const int j = (int)L - 1152; u.pm = 64 + (j & 7); u.pn = 2 + (j >> 3); }
        u.z = 0; return true;
    }
    __device__ __forceinline__ size_t a_off(const Unit& u) const { return (size_t)u.pm * a_tile; }
    __device__ __forceinline__ size_t b_off(const Unit& u) const { return (size_t)u.pn * b_tile; }
};
struct DftOrder {
    int G, c; size_t a_tile, b_tile;
    __device__ __forceinline__ bool next(int i, Unit& u) const {
        const long L = (long)i * G + c; if (L >= 128) return false;
        u.z = (int)L >> 4; u.pm = ((int)L >> 1) & 7; u.pn = (int)L & 1; return true;
    }
    __device__ __forceinline__ size_t a_off(const Unit& u) const { return (size_t)u.pm * a_tile; }
    __device__ __forceinline__ size_t b_off(const Unit& u) const { return (size_t)u.pn * b_tile + (size_t)u.z * 4096 * 2; }
};

__device__ __forceinline__ unsigned cvt_pk_bf16(float lo, float hi) { unsigned r; asm volatile("v_cvt_pk_bf16_f32 %0, %1, %2" : "=v"(r) : "v"(lo), "v"(hi)); return r; }

template <class F> struct Epi8 {
    static constexpr bool PERM = true;
    F f;
    __device__ __forceinline__ void operator()(const f32x4 (&acc)[2][2][4][2], const Unit& u, int wr, int wc, int fr, int fq) const {
        const int row0 = u.pm * BM + wr * 64 + fr, col0 = u.pn * BM + wc * 32 + 8 * fq;
#pragma unroll
        for (int ai = 0; ai < 2; ++ai)
#pragma unroll
            for (int m = 0; m < 4; ++m) {
#pragma unroll
                for (int bj = 0; bj < 2; ++bj) f(u, row0 + ai * HALF + m * 16, col0 + bj * HALF, acc[ai][bj][m][0], acc[ai][bj][m][1]);
                asm volatile("" ::: "memory");
            }
    }
};

template <class Epi, class Sched, bool ALIGN_EPI = false, bool SP2 = false>
__device__ __forceinline__ void gemm_phase(PG8_LAS unsigned char* lds, const Gemm g, const Sched& S, const Epi& E) {
    int tid_ = threadIdx.x; asm volatile("" : "+v"(tid_));
    const int tid = tid_, wid = __builtin_amdgcn_readfirstlane(tid >> 6), lane = tid & 63, wr = wid >> 2, wc = wid & 3, fr = lane & 15, fq = lane >> 4;
    const int K = g.K, nt = K / BK;
    unsigned voffA[2], voffB[2];
#pragma unroll
    for (int i = 0; i < 2; ++i) { int R, C; stage_rc(tid * 16 + i * 8192, R, C); const int Rb = Epi::PERM ? ((R & ~31) + perm32(R & 31)) : R;
        voffA[i] = (unsigned)(R * g.lda + C) * 2u; voffB[i] = (unsigned)(Rb * g.ldb + C) * 2u; }
    const size_t kstep = (size_t)(BK * 2);
    const size_t hstepA = (size_t)HALF * g.lda * 2, hstepB = (size_t)HALF * g.ldb * 2;
    const unsigned ldsw = (unsigned)wid * 1024u;
    const int aoff = lds_byte(wr * 64 + fr, fq * 8), boff = lds_byte(wc * 32 + fr, fq * 8);
#define PG8_SA(b, h) (((b) * 2 + (h)) * HTB)
#define PG8_SB(b, h) ((4 + (b) * 2 + (h)) * HTB)
#define PG8_STAGE(bufoff, gbase, voff) do { _Pragma("unroll") for (int _i = 0; _i < 2; ++_i) \
        __builtin_amdgcn_global_load_lds((const unsigned*)((const char*)(gbase) + (voff)[_i]), (PG8_LAS unsigned*)(lds + (bufoff) + ldsw + _i * 8192), 16, 0, 0); } while (0)
#define PG8_LDA(dst, b, h) do { _Pragma("unroll") for (int m = 0; m < 4; ++m) _Pragma("unroll") for (int k = 0; k < 2; ++k) dst[m][k] = *(const PG8_LAS bf16x8*)(lds + PG8_SA(b, h) + aoff + m * 2048 + k * 1024); } while (0)
#define PG8_LDB(dst, b, h) do { _Pragma("unroll") for (int n = 0; n < 2; ++n) _Pragma("unroll") for (int k = 0; k < 2; ++k) dst[n][k] = *(const PG8_LAS bf16x8*)(lds + PG8_SB(b, h) + boff + n * 2048 + k * 1024); } while (0)
#define PG8_MMA(ai, bj, At, Bt) do { __builtin_amdgcn_s_setprio(1); _Pragma("unroll") for (int m = 0; m < 4; ++m) _Pragma("unroll") for (int n = 0; n < 2; ++n) _Pragma("unroll") for (int k = 0; k < 2; ++k) \
        acc[ai][bj][m][n] = __builtin_amdgcn_mfma_f32_16x16x32_bf16(Bt[n][k], At[m][k], acc[ai][bj][m][n], 0, 0, 0); __builtin_amdgcn_s_setprio(0); } while (0)
#define PG8_WAIT_V(n) asm volatile("s_waitcnt vmcnt(" #n ")" ::: "memory")
#define PG8_WAIT_L(n) asm volatile("s_waitcnt lgkmcnt(" #n ")" ::: "memory")
#define PG8_BAR __builtin_amdgcn_s_barrier()
#define PG8_SCHED __builtin_amdgcn_sched_barrier(0)
    Unit cur, nxt; int ui = 0;
    if (!S.next(0, cur)) return;
    f32x4 acc[2][2][4][2];
#pragma unroll
    for (int a = 0; a < 2; ++a)
#pragma unroll
        for (int b = 0; b < 2; ++b)
#pragma unroll
            for (int m = 0; m < 4; ++m)
#pragma unroll
                for (int n = 0; n < 2; ++n) acc[a][b][m][n] = (f32x4){0.f, 0.f, 0.f, 0.f};
    bf16x8 At[4][2], B0[2][2], B1[2][2];
    const char* cA = (const char*)g.A + S.a_off(cur); const char* cB = (const char*)g.Bt + S.b_off(cur);
    if constexpr (SP2) {
        PG8_STAGE(PG8_SB(0, 0), cB, voffB); PG8_STAGE(PG8_SB(0, 1), cB + hstepB, voffB); PG8_STAGE(PG8_SA(0, 0), cA, voffA); PG8_STAGE(PG8_SA(0, 1), cA + hstepA, voffA);
        if (wr == 1) PG8_BAR;
        PG8_WAIT_V(2); PG8_BAR;
        PG8_STAGE(PG8_SB(1, 0), cB + kstep, voffB); PG8_STAGE(PG8_SA(1, 0), cA + kstep, voffA); PG8_STAGE(PG8_SB(1, 1), cB + hstepB + kstep, voffB);
        PG8_WAIT_V(6); PG8_BAR;
    } else {
        PG8_STAGE(PG8_SB(0, 0), cB, voffB); PG8_STAGE(PG8_SA(0, 0), cA, voffA); PG8_STAGE(PG8_SB(0, 1), cB + hstepB, voffB); PG8_STAGE(PG8_SA(0, 1), cA + hstepA, voffA);
        if (wr == 1) PG8_BAR;
        PG8_WAIT_V(4); PG8_BAR;
        PG8_STAGE(PG8_SB(1, 0), cB + kstep, voffB); PG8_STAGE(PG8_SA(1, 0), cA + kstep, voffA); PG8_STAGE(PG8_SB(1, 1), cB + hstepB + kstep, voffB);
        PG8_WAIT_V(6); PG8_BAR;
    }
    for (;;) {
        const bool has_next = S.next(ui + 1, nxt);
        const char* nA = has_next ? (const char*)g.A + S.a_off(nxt) : cA; const char* nB = has_next ? (const char*)g.Bt + S.b_off(nxt) : cB;
        for (int t = 0; t < nt; t += 2) {
            const bool last = (t == nt - 2);
            const char* a1 = cA + (size_t)(t + 1) * kstep;
            const char* a2 = last ? nA : cA + (size_t)(t + 2) * kstep; const char* b2 = last ? nB : cB + (size_t)(t + 2) * kstep;
            const char* a3 = a2 + kstep; const char* b3 = b2 + kstep;
            if constexpr (SP2) {
            PG8_LDB(B0, 0, 0); PG8_LDB(B1, 0, 1); PG8_SCHED; PG8_LDA(At, 0, 0); PG8_STAGE(PG8_SA(1, 1), a1 + hstepA, voffA);
            PG8_WAIT_V(8); PG8_WAIT_L(0); PG8_BAR; PG8_MMA(0, 0, At, B0); PG8_MMA(0, 1, At, B1); PG8_BAR; PG8_SCHED;
            PG8_LDA(At, 0, 1); PG8_STAGE(PG8_SB(0, 0), b2, voffB); PG8_STAGE(PG8_SB(0, 1), b2 + hstepB, voffB); PG8_STAGE(PG8_SA(0, 0), a2, voffA);
            PG8_WAIT_V(8); PG8_WAIT_L(0); PG8_BAR; PG8_MMA(1, 0, At, B0); PG8_MMA(1, 1, At, B1); PG8_BAR; PG8_SCHED;
            PG8_LDB(B0, 1, 0); PG8_LDB(B1, 1, 1); PG8_SCHED; PG8_LDA(At, 1, 0); PG8_STAGE(PG8_SA(0, 1), a2 + hstepA, voffA);
            PG8_WAIT_V(8); PG8_WAIT_L(0); PG8_BAR; PG8_MMA(0, 0, At, B0); PG8_MMA(0, 1, At, B1); PG8_BAR; PG8_SCHED;
            PG8_LDA(At, 1, 1); PG8_STAGE(PG8_SB(1, 0), b3, voffB); PG8_STAGE(PG8_SB(1, 1), b3 + hstepB, voffB); PG8_STAGE(PG8_SA(1, 0), a3, voffA);
            PG8_WAIT_V(8); PG8_WAIT_L(0); PG8_BAR; PG8_MMA(1, 0, At, B0); PG8_MMA(1, 1, At, B1); PG8_BAR; PG8_SCHED;
            } else {
            PG8_LDB(B0, 0, 0); PG8_SCHED; PG8_LDA(At, 0, 0); PG8_STAGE(PG8_SA(1, 1), a1 + hstepA, voffA);
            PG8_WAIT_L(8); PG8_BAR; PG8_WAIT_L(0); PG8_MMA(0, 0, At, B0); PG8_BAR; PG8_SCHED;
            PG8_LDB(B1, 0, 1); PG8_STAGE(PG8_SB(0, 0), b2, voffB);
            PG8_BAR; PG8_WAIT_L(0); PG8_MMA(0, 1, At, B1); PG8_BAR;
            PG8_LDA(At, 0, 1); PG8_STAGE(PG8_SA(0, 0), a2, voffA);
            PG8_BAR; PG8_WAIT_L(0); PG8_MMA(1, 0, At, B0); PG8_BAR; PG8_SCHED;
            PG8_STAGE(PG8_SB(0, 1), b2 + hstepB, voffB);
            PG8_WAIT_V(6); PG8_BAR; PG8_MMA(1, 1, At, B1); PG8_BAR;
            PG8_LDB(B0, 1, 0); PG8_SCHED; PG8_LDA(At, 1, 0); PG8_STAGE(PG8_SA(0, 1), a2 + hstepA, voffA);
            PG8_WAIT_L(8); PG8_BAR; PG8_WAIT_L(0); PG8_MMA(0, 0, At, B0); PG8_BAR; PG8_SCHED;
            PG8_LDB(B1, 1, 1); PG8_STAGE(PG8_SB(1, 0), b3, voffB);
            PG8_BAR; PG8_WAIT_L(0); PG8_MMA(0, 1, At, B1); PG8_BAR;
            PG8_LDA(At, 1, 1); PG8_STAGE(PG8_SA(1, 0), a3, voffA);
            PG8_BAR; PG8_WAIT_L(0); PG8_MMA(1, 0, At, B0); PG8_BAR; PG8_SCHED;
            PG8_STAGE(PG8_SB(1, 1), b3 + hstepB, voffB);
            PG8_WAIT_V(6); PG8_BAR; PG8_MMA(1, 1, At, B1); PG8_BAR;
            }
        }
        if constexpr (ALIGN_EPI) { if (wr == 0) PG8_BAR; }
        E(acc, cur, wr, wc, fr, fq);
        if (!has_next) break;
#pragma unroll
        for (int a = 0; a < 2; ++a)
#pragma unroll
            for (int b = 0; b < 2; ++b)
#pragma unroll
                for (int m = 0; m < 4; ++m)
#pragma unroll
                    for (int n = 0; n < 2; ++n) acc[a][b][m][n] = (f32x4){0.f, 0.f, 0.f, 0.f};
        cur = nxt; cA = nA; cB = nB; ++ui;
        if constexpr (ALIGN_EPI) { if (wr == 1) PG8_BAR; }
    }
    PG8_WAIT_V(0);
    if constexpr (!ALIGN_EPI) { if (wr == 0) PG8_BAR; }
    PG8_BAR;
#undef PG8_SA
#undef PG8_SB
#undef PG8_STAGE
#undef PG8_LDA
#undef PG8_LDB
#undef PG8_MMA
#undef PG8_WAIT_V
#undef PG8_WAIT_L
#undef PG8_BAR
#undef PG8_SCHED
}
}

constexpr int DM = 1024, NB = 8, SEQ = 2048, MTOK = NB * SEQ, CTXL = 256, MCTX = NB * CTXL;
constexpr int HGD = 512, DFF = 2816, DFF2 = 5632, INDIM = 5120, NMOD = 6;
constexpr float EPSN = 1e-6f;
constexpr int NWAVES = 8, NTHR = 512;
constexpr int LDS_BYTES = 147456;
#ifndef PH_MASK
#define PH_MASK 0xFFFF
#endif

constexpr size_t MiB = 1u << 20;
constexpr size_t WS_MX = 0;
constexpr size_t WS_LB = 256 * 1024;
constexpr size_t WS_WIN = 6 * MiB;
constexpr size_t WS_WPQ = 16 * MiB;
constexpr size_t WS_WA = 18 * MiB, WS_WB = 19 * MiB, WS_WOUT = 20 * MiB;
constexpr size_t WS_CS = 22 * MiB;
constexpr size_t WS_WUP = 6 * MiB;
constexpr size_t WS_WDN = 17 * MiB;
constexpr size_t WS_HX = 38 * MiB;
constexpr size_t WS_OF = 38 * MiB, WS_OB = 54 * MiB;
constexpr size_t WS_TMP = 38 * MiB;
constexpr size_t WS_H2 = 38 * MiB;
constexpr size_t WS_Q = 74 * MiB, WS_V = 90 * MiB, WS_OG = 106 * MiB, WS_GA = 122 * MiB, WS_GBG = 154 * MiB, WS_PQT = 186 * MiB;
constexpr size_t WS_GFC = 218 * MiB, WS_GBC = 222 * MiB, WS_VC = 226 * MiB;
constexpr size_t WS_YF = 228 * MiB;
constexpr size_t WS_YH = 74 * MiB;
constexpr size_t WS_MRG = 186 * MiB;
constexpr size_t WS_Z = 74 * MiB;
constexpr size_t WS_A2 = 162 * MiB;
constexpr size_t WS_END = 256 * MiB;

typedef unsigned short bf16;
typedef float f32x4 __attribute__((ext_vector_type(4)));
typedef unsigned u32x4 __attribute__((ext_vector_type(4)));
typedef unsigned u32x2 __attribute__((ext_vector_type(2)));
#define LAS __attribute__((address_space(3)))

struct Params {
    const float* in[19];
    float* out;
    unsigned char* ws;
};

__device__ __forceinline__ float bf2f(unsigned short b) { return __uint_as_float(((unsigned)b) << 16); }
__device__ __forceinline__ float bflo(unsigned w) { return __uint_as_float(w << 16); }
__device__ __forceinline__ float bfhi(unsigned w) { return __uint_as_float(w & 0xffff0000u); }
__device__ __forceinline__ unsigned f2bf(float f) { unsigned u = __float_as_uint(f); return (u + 0x7fffu + ((u >> 16) & 1u)) >> 16; }
__device__ __forceinline__ unsigned pk2(float lo, float hi) { return f2bf(lo) | (f2bf(hi) << 16); }
__device__ __forceinline__ float sigmoidf_(float x) { return 1.f / (1.f + __expf(-x)); }
__device__ __forceinline__ float siluf_(float x) { return x / (1.f + __expf(-x)); }
__device__ __forceinline__ float wave_sum(float v) {
#pragma unroll
    for (int o = 1; o < 64; o <<= 1) v += __shfl_xor(v, o);
    return v;
}
__device__ __forceinline__ u32x4 pack8(const f32x4 a, const f32x4 b) { u32x4 w; w.x = pk2(a[0], a[1]); w.y = pk2(a[2], a[3]); w.z = pk2(b[0], b[1]); w.w = pk2(b[2], b[3]); return w; }

struct FIn {
    unsigned char* ws; float* out;
    __device__ __forceinline__ void operator()(const pg8::Unit& u, int row, int col, f32x4 v0, f32x4 v1) const {
        const int seg = u.pn >> 1, c = col & 511;
        if (seg == 0 || seg == 4) { f32x4 a, b;
#pragma unroll
            for (int i = 0; i < 4; ++i) { a[i] = siluf_(v0[i]); b[i] = siluf_(v1[i]); }
            bf16* dst = (bf16*)(ws + (seg == 0 ? WS_Q : WS_OG));
            *(u32x4*)(dst + (size_t)row * 512 + c) = pack8(a, b);
        } else if (seg == 1 || seg == 2) {
            const float* lb = (const float*)(ws + WS_LB);
            const f32x4 l0 = *(const f32x4*)(lb + c), l1 = *(const f32x4*)(lb + c + 4); f32x4 a, b;
#pragma unroll
            for (int i = 0; i < 4; ++i) { a[i] = l0[i] + (1.f - l0[i]) * sigmoidf_(v0[i]); b[i] = l1[i] + (1.f - l1[i]) * sigmoidf_(v1[i]); }
            float* dst;
            if (u.pm < 64) dst = out + (seg == 1 ? (size_t)0 : (size_t)MTOK * 512) + (size_t)row * 512 + c;
            else dst = (float*)(ws + (seg == 1 ? WS_GFC : WS_GBC)) + (size_t)(row - MTOK) * 512 + c;
            *(f32x4*)dst = a; *(f32x4*)(dst + 4) = b;
        } else if (seg == 3) {
            bf16* dst;
            if (u.pm < 64) dst = (bf16*)(ws + WS_V) + (size_t)row * 512 + c; else dst = (bf16*)(ws + WS_VC) + (size_t)(row - MTOK) * 512 + c;
            *(u32x4*)dst = pack8(v0, v1);
        } else { f32x4 a, b;
#pragma unroll
            for (int i = 0; i < 4; ++i) { a[i] = sigmoidf_(v0[i]); b[i] = sigmoidf_(v1[i]); }
            bf16* dst = (seg < 7) ? ((bf16*)(ws + WS_GA) + (size_t)row * 1024 + (col - 5 * 512)) : ((bf16*)(ws + WS_GBG) + (size_t)row * 1024 + (col - 7 * 512));
            *(u32x4*)dst = pack8(a, b);
        }
    }
};
struct FPQ {
    bf16* pqt;
    __device__ __forceinline__ void operator()(const pg8::Unit&, int row, int col, f32x4 v0, f32x4 v1) const {
        *(u32x4*)(pqt + (size_t)(row & 511) * 32768 + (size_t)(col >> 11) * 4096 + (size_t)(row >> 9) * 2048 + (col & 2047)) = pack8(v0, v1);
    }
};
struct FDft {
    bf16* yf;
    __device__ __forceinline__ void operator()(const pg8::Unit& u, int row, int col, f32x4 v0, f32x4 v1) const {
        *(u32x4*)(yf + ((size_t)u.z * SEQ + row) * 512 + col) = pack8(v0 * (1.f / 512.f), v1 * (1.f / 512.f));
    }
};
struct FYa {
    const bf16* ga; bf16* tmp;
    __device__ __forceinline__ void operator()(const pg8::Unit&, int row, int col, f32x4 v0, f32x4 v1) const {
        const size_t o = (size_t)row * 1024 + col; const u32x4 g = *(const u32x4*)(ga + o);
        f32x4 a, b; a[0] = v0[0] * bflo(g.x); a[1] = v0[1] * bfhi(g.x); a[2] = v0[2] * bflo(g.y); a[3] = v0[3] * bfhi(g.y);
        b[0] = v1[0] * bflo(g.z); b[1] = v1[1] * bfhi(g.z); b[2] = v1[2] * bflo(g.w); b[3] = v1[3] * bfhi(g.w);
        *(u32x4*)(tmp + o) = pack8(a, b);
    }
};
struct FYb {
    const bf16* gbg; const bf16* tmp; bf16* mrg;
    __device__ __forceinline__ void operator()(const pg8::Unit&, int row, int col, f32x4 v0, f32x4 v1) const {
        const size_t o = (size_t)row * 1024 + col; const u32x4 g = *(const u32x4*)(gbg + o); const u32x4 t = *(const u32x4*)(tmp + o);
        f32x4 a, b; a[0] = bflo(t.x) + v0[0] * bflo(g.x); a[1] = bfhi(t.x) + v0[1] * bfhi(g.x); a[2] = bflo(t.y) + v0[2] * bflo(g.y); a[3] = bfhi(t.y) + v0[3] * bfhi(g.y);
        b[0] = bflo(t.z) + v1[0] * bflo(g.z); b[1] = bfhi(t.z) + v1[1] * bfhi(g.z); b[2] = bflo(t.w) + v1[2] * bflo(g.w); b[3] = bfhi(t.w) + v1[3] * bfhi(g.w);
        *(u32x4*)(mrg + o) = pack8(a, b);
    }
};
struct FRes {
    const float* src; float* dst; const float* mx; int mod;
    __device__ __forceinline__ void operator()(const pg8::Unit&, int row, int col, f32x4 v0, f32x4 v1) const {
        const size_t o = (size_t)row * 1024 + col; const float* m = mx + (size_t)(row >> 11) * (NMOD * DM) + mod * DM + col;
        const f32x4 m0 = *(const f32x4*)m, m1 = *(const f32x4*)(m + 4), s0 = *(const f32x4*)(src + o), s1 = *(const f32x4*)(src + o + 4);
        *(f32x4*)(dst + o) = s0 + m0 * v0; *(f32x4*)(dst + o + 4) = s1 + m1 * v1;
    }
};
struct FUp {
    bf16* z;
    __device__ __forceinline__ void operator()(const pg8::Unit&, int row, int col, f32x4 v0, f32x4 v1) const {
        *(u32x4*)(z + (size_t)row * DFF2 + col) = pack8(v0, v1);
    }
};

__device__ __forceinline__ void transpose_item(const float* W, int K, int N, bf16* WT, LAS float* scr, int item, int lane) {
    const int nblk = N / 32, kb = item / nblk, nb = item % nblk, k0 = 64 * kb, n0 = 32 * nb;
#pragma unroll 8
    for (int i = 0; i < 32; ++i) { const int kk = 2 * i + (lane >> 5); scr[kk * 33 + (lane & 31)] = W[(size_t)(k0 + kk) * N + n0 + (lane & 31)]; }
    asm volatile("s_waitcnt lgkmcnt(0)" ::: "memory");
    const int c = lane & 7;
#pragma unroll
    for (int j = 0; j < 4; ++j) { const int n = (lane >> 3) + 8 * j; const LAS float* s = scr + (8 * c) * 33 + n;
        u32x4 o; o.x = pk2(s[0 * 33], s[1 * 33]); o.y = pk2(s[2 * 33], s[3 * 33]); o.z = pk2(s[4 * 33], s[5 * 33]); o.w = pk2(s[6 * 33], s[7 * 33]);
        *(u32x4*)(WT + (size_t)(n0 + n) * K + k0 + 8 * c) = o; }
    asm volatile("s_waitcnt lgkmcnt(0)" ::: "memory");
}

__device__ __forceinline__ void norm_mod_row(const float* xrow, const float* g, const float* shift, const float* scale, bf16* orow, int lane) {
    f32x4 v[4]; float s = 0.f;
#pragma unroll
    for (int j = 0; j < 4; ++j) { v[j] = *(const f32x4*)(xrow + (lane + 64 * j) * 4); s += (v[j][0] * v[j][0] + v[j][1] * v[j][1]) + (v[j][2] * v[j][2] + v[j][3] * v[j][3]); }
    const float rinv = rsqrtf(wave_sum(s) * (1.f / DM) + EPSN);
#pragma unroll
    for (int j = 0; j < 4; ++j) { const int e = (lane + 64 * j) * 4;
        const f32x4 gg = *(const f32x4*)(g + e), sh = *(const f32x4*)(shift + e), sc = *(const f32x4*)(scale + e);
        const f32x4 h = v[j] * rinv * gg * (sc + 1.f) + sh;
        u32x2 w; w.x = pk2(h[0], h[1]); w.y = pk2(h[2], h[3]); *(u32x2*)(orow + e) = w; }
}

__device__ __forceinline__ void phase0(const Params& p, unsigned char* lds, int tid, int lane, int wave, int G) {
    float* ldsf = (float*)lds;
    float* mxo = (float*)(p.ws + WS_MX);
    for (int it = blockIdx.x; it < 256; it += G) {
        __syncthreads();
        if (it < 192) {
            const float* c = p.in[1]; const float* cc = p.in[3]; const float* aw = p.in[4]; const float* ab = p.in[5];
            float* sc = ldsf;
            float* red = ldsf + 9 * 1024;
            for (int i = tid; i < 9 * 1024; i += NTHR) { const int r = i >> 10, k = i & 1023; const float cv = (r < 8) ? c[r * 1024 + k] : cc[k]; sc[i] = cv / (1.f + __expf(-cv)); }
            __syncthreads();
            const int n0 = it * 32, col = tid & 31, ks = tid >> 5;
            float a[9];
#pragma unroll
            for (int r = 0; r < 9; ++r) a[r] = 0.f;
            for (int k = ks * 64; k < ks * 64 + 64; ++k) { const float w = aw[(size_t)k * (NMOD * DM) + n0 + col];
#pragma unroll
                for (int r = 0; r < 9; ++r) a[r] += sc[r * 1024 + k] * w; }
#pragma unroll
            for (int r = 0; r < 9; ++r) red[(ks * 9 + r) * 32 + col] = a[r];
            __syncthreads();
            if (tid < 288) { const int r = tid >> 5, cl = tid & 31; float s = ab[n0 + cl];
                for (int k2 = 0; k2 < 16; ++k2) s += red[(k2 * 9 + r) * 32 + cl];
                mxo[r * (NMOD * DM) + n0 + cl] = s; }
        } else {
            const int w = it - 192, kb = w >> 2, g = w & 3, k0 = kb * 64;
            const float* win = p.in[7];
            float* wt = ldsf;
            float* tabc = ldsf + 64 * 129; float* tabs = tabc + 128;
            for (int i = tid; i < 64 * 128; i += NTHR) { const int kk = i >> 7, cc = i & 127; wt[kk * 129 + cc] = win[(size_t)(k0 + kk) * INDIM + g * 128 + cc]; }
            if (tid < 128) { tabc[tid] = cospif((float)tid * (1.f / 64.f)); tabs[tid] = sinpif((float)tid * (1.f / 64.f)); }
            __syncthreads();
            bf16* wpq = (bf16*)(p.ws + WS_WPQ);
            const int kk = tid & 63, jj = tid >> 6;
            for (int j = jj; j < 128; j += 8) { float aP = 0.f, aQ = 0.f;
                for (int cI = 0; cI < 128; ++cI) { const float wv = wt[kk * 129 + cI]; const int idx = (cI * j) & 127; aP += wv * tabc[idx]; aQ += wv * tabs[idx]; }
                wpq[(size_t)(g * 128 + j) * 1024 + k0 + kk] = (bf16)f2bf(aP);
                wpq[(size_t)(512 + g * 128 + j) * 1024 + k0 + kk] = (bf16)f2bf(aQ); }
        }
    }
    __syncthreads();
    if (blockIdx.x == 0) { const float* hl = p.in[8]; float* lbo = (float*)(p.ws + WS_LB);
        if (tid < 512) { const float a = hl[tid], b = hl[512 + tid]; lbo[tid] = 1.f / (1.f + expf(b - a)); } }
    { bf16* cs = (bf16*)(p.ws + WS_CS);
      for (int i = blockIdx.x * NTHR + tid; i < 2048 * 512; i += G * NTHR) { const int l = i >> 9, kc = (i & 511) * 8; float vv[8];
#pragma unroll
          for (int e = 0; e < 8; ++e) { const int k = kc + e, s = k >> 11, kk = k & 2047, ph = (l * kk) & 2047; const float ang = (float)ph * (1.f / 1024.f); vv[e] = s ? -sinpif(ang) : cospif(ang); }
          u32x4 w; w.x = pk2(vv[0], vv[1]); w.y = pk2(vv[2], vv[3]); w.z = pk2(vv[4], vv[5]); w.w = pk2(vv[6], vv[7]);
          *(u32x4*)(cs + (size_t)l * 4096 + kc) = w; } }
    { LAS float* scr = (LAS float*)((LAS unsigned char*)lds + wave * 16384);
      const int gw = blockIdx.x * NWAVES + wave, NGW = G * NWAVES;
      constexpr int I_IN = 16 * 160, I_A = 8 * 32, I_B = 8 * 32, I_O = 16 * 32;
      for (int it = gw; it < I_IN + I_A + I_B + I_O; it += NGW) { int r = it;
          if (r < I_IN) { transpose_item(p.in[7], 1024, INDIM, (bf16*)(p.ws + WS_WIN), scr, r, lane); continue; } r -= I_IN;
          if (r < I_A) { transpose_item(p.in[10], 512, 1024, (bf16*)(p.ws + WS_WA), scr, r, lane); continue; } r -= I_A;
          if (r < I_B) { transpose_item(p.in[11], 512, 1024, (bf16*)(p.ws + WS_WB), scr, r, lane); continue; } r -= I_B;
          transpose_item(p.in[12], 1024, 1024, (bf16*)(p.ws + WS_WOUT), scr, r, lane); } }
}

__device__ __forceinline__ void hgrn_mfma_item(const Params& p, unsigned char* lds, int item) {
    int tid_ = threadIdx.x; asm volatile("" : "+v"(tid_));
    const int tid = tid_, lane = tid & 63, w = __builtin_amdgcn_readfirstlane(tid >> 6), fr = lane & 15, fq = lane >> 4;
    const int vh = item & 1, dir = (item >> 1) & 1, h = (item >> 2) & 3, b = item >> 4;
    bf16* Qs = (bf16*)lds;
    bf16* Ks = Qs + 64 * 136;
    bf16* St = Ks + 64 * 136;
    bf16* Kh = St + 2 * 64 * 136;
    bf16* Vt = Kh + 128 * 72;
    bf16* Ps = Vt + 64 * 72;
    float* Et = (float*)(Ps + 64 * 72);
    const int d = 16 * w + fr;
    const float* fL = p.out + (dir ? (size_t)MTOK * 512 : 0) + (size_t)b * SEQ * 512 + h * 128 + d;
    const float* fC = (const float*)(p.ws + (dir ? WS_GBC : WS_GFC)) + (size_t)b * CTXL * 512 + h * 128 + d;
    const bf16* qL = (const bf16*)(p.ws + WS_Q) + (size_t)b * SEQ * 512 + h * 128 + d;
    const bf16* vL = (const bf16*)(p.ws + WS_V) + (size_t)b * SEQ * 512 + h * 128 + vh * 64 + lane;
    const bf16* vC = (const bf16*)(p.ws + WS_VC) + (size_t)b * CTXL * 512 + h * 128 + vh * 64 + lane;
    bf16* oL = (bf16*)(p.ws + (dir ? WS_OB : WS_OF)) + (size_t)b * SEQ * 512 + h * 128 + vh * 64;
    f32x4 Sa[4];
#pragma unroll
    for (int i = 0; i < 4; ++i) Sa[i] = (f32x4){0.f, 0.f, 0.f, 0.f};
    float fr_[16]; unsigned short qr_[16], vr_[8];
#define HG_LOAD(cc_) do { const int _cc = (cc_); const bool _lat = _cc >= 4; const int _c = _lat ? _cc - 4 : _cc, _n = _lat ? SEQ : CTXL; \
        const float* _f = _lat ? fL : fC; const bf16* _v = _lat ? vL : vC; \
        _Pragma("unroll") for (int i = 0; i < 16; ++i) { const int _s = _c * 64 + fq * 16 + i, _pos = dir ? (_n - 1 - _s) : _s; fr_[i] = _f[(size_t)_pos * 512]; qr_[i] = _lat ? qL[(size_t)_pos * 512] : (unsigned short)0; } \
        _Pragma("unroll") for (int j = 0; j < 8; ++j) { const int _s = _c * 64 + w * 8 + j, _pos = dir ? (_n - 1 - _s) : _s; vr_[j] = _v[(size_t)_pos * 512]; } } while (0)
    HG_LOAD(0);
    for (int cc = 0; cc < 36; ++cc) {
        const bool lat = cc >= 4; const int c = lat ? cc - 4 : cc;
        bf16* Scur = St + (cc & 1) * (64 * 136); bf16* Snxt = St + ((cc & 1) ^ 1) * (64 * 136);
        {
            float ce[16]; float e = 1.f;
#pragma unroll
            for (int i = 0; i < 16; ++i) { e *= fr_[i]; ce[i] = e; }
            const float T0 = __shfl(e, fr), T1 = __shfl(e, fr + 16), T2 = __shfl(e, fr + 32), T3 = __shfl(e, fr + 48);
            const float pre = (fq == 0) ? 1.f : (fq == 1) ? T0 : (fq == 2) ? T0 * T1 : T0 * T1 * T2;
            const float tot = T0 * T1 * T2 * T3;
            if (fq == 0) Et[d] = tot;
            unsigned khw[8];
#pragma unroll
            for (int i = 0; i < 16; i += 2) { float kh2[2];
#pragma unroll
                for (int u = 0; u < 2; ++u) { const float cm = fmaxf(pre * ce[i + u], 1e-30f), ie = __builtin_amdgcn_rcpf(cm), kt = (1.f - fr_[i + u]) * ie; const int sl = fq * 16 + i + u;
                    if (lat) { Qs[sl * 136 + d] = (bf16)f2bf(bf2f(qr_[i + u]) * cm); Ks[sl * 136 + d] = (bf16)f2bf(kt); }
                    kh2[u] = kt * tot; }
                khw[i >> 1] = pk2(kh2[0], kh2[1]); }
            u32x4 k0; k0.x = khw[0]; k0.y = khw[1]; k0.z = khw[2]; k0.w = khw[3]; u32x4 k1; k1.x = khw[4]; k1.y = khw[5]; k1.z = khw[6]; k1.w = khw[7];
            *(u32x4*)(Kh + d * 72 + fq * 16) = k0; *(u32x4*)(Kh + d * 72 + fq * 16 + 8) = k1;
            u32x4 vv; vv.x = (unsigned)vr_[0] | ((unsigned)vr_[1] << 16); vv.y = (unsigned)vr_[2] | ((unsigned)vr_[3] << 16); vv.z = (unsigned)vr_[4] | ((unsigned)vr_[5] << 16); vv.w = (unsigned)vr_[6] | ((unsigned)vr_[7] << 16);
            *(u32x4*)(Vt + lane * 72 + w * 8) = vv;
        }
        if (cc + 1 < 36) HG_LOAD(cc + 1);
        __syncthreads();
        const int ti = w >> 1, x2 = 2 * (w & 1);
        if (lat) {
#pragma unroll
            for (int u2 = 0; u2 < 2; ++u2) { const int si = x2 + u2; f32x4 acc = (f32x4){0.f, 0.f, 0.f, 0.f};
                if (si <= ti) {
#pragma unroll
                    for (int kk = 0; kk < 4; ++kk) { const pg8::bf16x8 a = *(const pg8::bf16x8*)(Ks + (si * 16 + fr) * 136 + kk * 32 + fq * 8), bq = *(const pg8::bf16x8*)(Qs + (ti * 16 + fr) * 136 + kk * 32 + fq * 8);
                        acc = __builtin_amdgcn_mfma_f32_16x16x32_bf16(a, bq, acc, 0, 0, 0); }
                    if (si == ti) {
#pragma unroll
                        for (int r = 0; r < 4; ++r) if (4 * fq + r > fr) acc[r] = 0.f; } }
                u32x2 pw; pw.x = pk2(acc[0], acc[1]); pw.y = pk2(acc[2], acc[3]);
                *(u32x2*)(Ps + (ti * 16 + fr) * 72 + si * 16 + 4 * fq) = pw; }
        }
        {
            const f32x4 et = *(const f32x4*)(Et + w * 16 + 4 * fq);
            pg8::bf16x8 ka[2];
#pragma unroll
            for (int kk = 0; kk < 2; ++kk) ka[kk] = *(const pg8::bf16x8*)(Kh + (w * 16 + fr) * 72 + kk * 32 + fq * 8);
#pragma unroll
            for (int vi = 0; vi < 4; ++vi) { Sa[vi] = Sa[vi] * et;
#pragma unroll
                for (int kk = 0; kk < 2; ++kk) { const pg8::bf16x8 bv = *(const pg8::bf16x8*)(Vt + (vi * 16 + fr) * 72 + kk * 32 + fq * 8);
                    Sa[vi] = __builtin_amdgcn_mfma_f32_16x16x32_bf16(ka[kk], bv, Sa[vi], 0, 0, 0); }
                u32x2 sw; sw.x = pk2(Sa[vi][0], Sa[vi][1]); sw.y = pk2(Sa[vi][2], Sa[vi][3]);
                *(u32x2*)(Snxt + (vi * 16 + fr) * 136 + w * 16 + 4 * fq) = sw; }
        }
        f32x4 Oa[2];
        Oa[0] = (f32x4){0.f, 0.f, 0.f, 0.f}; Oa[1] = (f32x4){0.f, 0.f, 0.f, 0.f};
        if (lat) {
#pragma unroll
            for (int kk = 0; kk < 4; ++kk) { const pg8::bf16x8 bq = *(const pg8::bf16x8*)(Qs + (ti * 16 + fr) * 136 + kk * 32 + fq * 8);
#pragma unroll
                for (int u2 = 0; u2 < 2; ++u2) { const pg8::bf16x8 a = *(const pg8::bf16x8*)(Scur + ((x2 + u2) * 16 + fr) * 136 + kk * 32 + fq * 8);
                    Oa[u2] = __builtin_amdgcn_mfma_f32_16x16x32_bf16(a, bq, Oa[u2], 0, 0, 0); } }
        }
        __syncthreads();
        if (lat) {
#pragma unroll
            for (int kk = 0; kk < 2; ++kk) { const pg8::bf16x8 bp = *(const pg8::bf16x8*)(Ps + (ti * 16 + fr) * 72 + kk * 32 + fq * 8);
#pragma unroll
                for (int u2 = 0; u2 < 2; ++u2) { const pg8::bf16x8 a = *(const pg8::bf16x8*)(Vt + ((x2 + u2) * 16 + fr) * 72 + kk * 32 + fq * 8);
                    Oa[u2] = __builtin_amdgcn_mfma_f32_16x16x32_bf16(a, bp, Oa[u2], 0, 0, 0); } }
            const int sg = c * 64 + ti * 16 + fr, pos = dir ? (SEQ - 1 - sg) : sg;
#pragma unroll
            for (int u2 = 0; u2 < 2; ++u2) { u32x2 ow; ow.x = pk2(Oa[u2][0], Oa[u2][1]); ow.y = pk2(Oa[u2][2], Oa[u2][3]);
                *(u32x2*)(oL + (size_t)pos * 512 + (x2 + u2) * 16 + 4 * fq) = ow; }
        }
        __syncthreads();
    }
#undef HG_LOAD
}

__device__ __forceinline__ void phase_yh(const Params& p, int lane, int gw, int NGW) {
    const bf16* of = (const bf16*)(p.ws + WS_OF); const bf16* ob = (const bf16*)(p.ws + WS_OB); const bf16* og = (const bf16*)(p.ws + WS_OG);
    bf16* yh = (bf16*)(p.ws + WS_YH); const float* on = p.in[9];
    for (int m = gw; m < MTOK; m += NGW) { const size_t o = (size_t)m * 512 + lane * 8;
        const u32x4 a = *(const u32x4*)(of + o), b = *(const u32x4*)(ob + o), gg = *(const u32x4*)(og + o);
        float v[8]; v[0] = bflo(a.x) + bflo(b.x); v[1] = bfhi(a.x) + bfhi(b.x); v[2] = bflo(a.y) + bflo(b.y); v[3] = bfhi(a.y) + bfhi(b.y);
        v[4] = bflo(a.z) + bflo(b.z); v[5] = bfhi(a.z) + bfhi(b.z); v[6] = bflo(a.w) + bflo(b.w); v[7] = bfhi(a.w) + bfhi(b.w);
        float s = 0.f;
#pragma unroll
        for (int i = 0; i < 8; ++i) s += v[i] * v[i];
        s += __shfl_xor(s, 1); s += __shfl_xor(s, 2); s += __shfl_xor(s, 4); s += __shfl_xor(s, 8);
        const float rinv = rsqrtf(s * (1.f / 128.f) + EPSN);
        const f32x4 n0 = *(const f32x4*)(on + lane * 8), n1 = *(const f32x4*)(on + lane * 8 + 4);
        float gv[8]; gv[0] = bflo(gg.x); gv[1] = bfhi(gg.x); gv[2] = bflo(gg.y); gv[3] = bfhi(gg.y); gv[4] = bflo(gg.z); gv[5] = bfhi(gg.z); gv[6] = bflo(gg.w); gv[7] = bfhi(gg.w);
        f32x4 r0, r1;
#pragma unroll
        for (int i = 0; i < 4; ++i) { r0[i] = v[i] * rinv * n0[i] * gv[i]; r1[i] = v[4 + i] * rinv * n1[i] * gv[4 + i]; }
        *(u32x4*)(yh + o) = pack8(r0, r1); }
}

__device__ __forceinline__ void phase_conv(const Params& p, int hf, int tid, int G) {
    const bf16* z = (const bf16*)(p.ws + WS_Z); bf16* a2 = (bf16*)(p.ws + WS_A2) + (size_t)hf * 8192 * DFF;
    const float* cw = p.in[15]; const float* cb = p.in[16];
    for (int i = blockIdx.x * NTHR + tid; i < 8192 * 352; i += G * NTHR) {
        const int c8 = i % 352, tokr = i / 352, ch = c8 * 8, l = tokr & 2047, r = l >> 6, c = l & 63;
        float a1[8], ag[8];
        { const f32x4 b0 = *(const f32x4*)(cb + ch), b1 = *(const f32x4*)(cb + ch + 4), b2 = *(const f32x4*)(cb + DFF + ch), b3 = *(const f32x4*)(cb + DFF + ch + 4);
#pragma unroll
          for (int e = 0; e < 4; ++e) { a1[e] = b0[e]; a1[4 + e] = b1[e]; ag[e] = b2[e]; ag[4 + e] = b3[e]; } }
#pragma unroll
        for (int di = -1; di <= 1; ++di) { const int rr = r + di; if (rr < 0 || rr >= 32) continue;
#pragma unroll
            for (int dj = -1; dj <= 1; ++dj) { const int c2 = c + dj; if (c2 < 0 || c2 >= 64) continue;
                const size_t zo = (size_t)(tokr + di * 64 + dj) * DFF2 + ch;
                const u32x4 z1 = *(const u32x4*)(z + zo), z2 = *(const u32x4*)(z + zo + DFF);
                const float* w = cw + (size_t)((di + 1) * 3 + (dj + 1)) * DFF2 + ch;
                const f32x4 w0 = *(const f32x4*)w, w1 = *(const f32x4*)(w + 4), w2 = *(const f32x4*)(w + DFF), w3 = *(const f32x4*)(w + DFF + 4);
                a1[0] += bflo(z1.x) * w0[0]; a1[1] += bfhi(z1.x) * w0[1]; a1[2] += bflo(z1.y) * w0[2]; a1[3] += bfhi(z1.y) * w0[3];
                a1[4] += bflo(z1.z) * w1[0]; a1[5] += bfhi(z1.z) * w1[1]; a1[6] += bflo(z1.w) * w1[2]; a1[7] += bfhi(z1.w) * w1[3];
                ag[0] += bflo(z2.x) * w2[0]; ag[1] += bfhi(z2.x) * w2[1]; ag[2] += bflo(z2.y) * w2[2]; ag[3] += bfhi(z2.y) * w2[3];
                ag[4] += bflo(z2.z) * w3[0]; ag[5] += bfhi(z2.z) * w3[1]; ag[6] += bflo(z2.w) * w3[2]; ag[7] += bfhi(z2.w) * w3[3]; } }
        f32x4 r0, r1;
#pragma unroll
        for (int e = 0; e < 4; ++e) { r0[e] = siluf_(a1[e]) * ag[e]; r1[e] = siluf_(a1[4 + e]) * ag[4 + e]; }
        *(u32x4*)(a2 + (size_t)tokr * DFF + ch) = pack8(r0, r1);
    }
}

__global__ void __launch_bounds__(NTHR, 2) fwd_mega(Params p) {
    extern __shared__ __attribute__((aligned(16))) unsigned char lds[];
    cg::grid_group grid = cg::this_grid();
    const int tid = threadIdx.x, lane = tid & 63, wave = __builtin_amdgcn_readfirstlane(tid >> 6);
    const int G = gridDim.x, gw = blockIdx.x * NWAVES + wave, NGW = G * NWAVES;
    PG8_LAS unsigned char* ldsl = (PG8_LAS unsigned char*)lds;
    unsigned char* ws = p.ws;
    const float* mx = (const float*)(ws + WS_MX);

    if constexpr ((PH_MASK >> 0) & 1) {
    phase0(p, lds, tid, lane, wave, G);
    }
    grid.sync();
    if constexpr ((PH_MASK >> 1) & 1) {
    for (int m = gw; m < MTOK + MCTX; m += NGW) {
        const float* src = (m < MTOK) ? p.in[0] + (size_t)m * DM : p.in[2] + (size_t)(m - MTOK) * DM;
        const int mr = (m < MTOK) ? (m >> 11) : 8;
        norm_mod_row(src, p.in[6], mx + mr * (NMOD * DM), mx + mr * (NMOD * DM) + DM, (bf16*)(ws + WS_HX) + (size_t)m * DM, lane);
    }
    }
    grid.sync();
    if constexpr ((PH_MASK >> 2) & 1) {
    {
        pg8::Gemm g{(const bf16*)(ws + WS_HX), (const bf16*)(ws + WS_WIN) + (size_t)512 * 1024, 1024, 1024, 1024};
        pg8::InOrder S; S.G = G; S.c = blockIdx.x; S.a_tile = (size_t)256 * 1024 * 2; S.b_tile = (size_t)256 * 1024 * 2;
        pg8::Epi8<FIn> E{FIn{ws, p.out}};
        pg8::gemm_phase<pg8::Epi8<FIn>, pg8::InOrder, true, true>(ldsl, g, S, E);
    }
    {
        pg8::Gemm g{(const bf16*)(ws + WS_WPQ), (const bf16*)(ws + WS_HX), 1024, 1024, 1024};
        pg8::StaticOrder S; S.init(4, 64, G, blockIdx.x, 1024, 1024);
        pg8::Epi8<FPQ> E{FPQ{(bf16*)(ws + WS_PQT)}};
        pg8::gemm_phase<pg8::Epi8<FPQ>, pg8::StaticOrder, true, true>(ldsl, g, S, E);
    }
    }
    grid.sync();
    if constexpr ((PH_MASK >> 3) & 1) {
    if (blockIdx.x < 128 && G >= 192) {
        pg8::Gemm g{(const bf16*)(ws + WS_CS), (const bf16*)(ws + WS_PQT), 4096, 4096, 32768};
        pg8::DftOrder S; S.G = 128; S.c = blockIdx.x; S.a_tile = (size_t)256 * 4096 * 2; S.b_tile = (size_t)256 * 32768 * 2;
        pg8::Epi8<FDft> E{FDft{(bf16*)(ws + WS_YF)}};
        pg8::gemm_phase<pg8::Epi8<FDft>, pg8::DftOrder, true, true>(ldsl, g, S, E);
    } else if (G >= 192) {
        for (int it = blockIdx.x - 128; it < 128; it += G - 128) hgrn_mfma_item(p, lds, it);
    } else {
        pg8::Gemm g{(const bf16*)(ws + WS_CS), (const bf16*)(ws + WS_PQT), 4096, 4096, 32768};
        pg8::DftOrder S; S.G = G; S.c = blockIdx.x; S.a_tile = (size_t)256 * 4096 * 2; S.b_tile = (size_t)256 * 32768 * 2;
        pg8::Epi8<FDft> E{FDft{(bf16*)(ws + WS_YF)}};
        pg8::gemm_phase<pg8::Epi8<FDft>, pg8::DftOrder, true, true>(ldsl, g, S, E);
        for (int it = blockIdx.x; it < 128; it += G) hgrn_mfma_item(p, lds, it);
    }
    }
    grid.sync();
    if constexpr ((PH_MASK >> 4) & 1) {
    phase_yh(p, lane, gw, NGW);
    }
    grid.sync();
    if constexpr ((PH_MASK >> 5) & 1) {
    {
        pg8::Gemm g{(const bf16*)(ws + WS_YF), (const bf16*)(ws + WS_WA), 512, 512, 512};
        pg8::StaticOrder S; S.init(64, 4, G, blockIdx.x, 512, 512);
        pg8::Epi8<FYa> E{FYa{(const bf16*)(ws + WS_GA), (bf16*)(ws + WS_TMP)}};
        pg8::gemm_phase<pg8::Epi8<FYa>, pg8::StaticOrder, true, true>(ldsl, g, S, E);
    }
    {
        pg8::Gemm g{(const bf16*)(ws + WS_YH), (const bf16*)(ws + WS_WB), 512, 512, 512};
        pg8::StaticOrder S; S.init(64, 4, G, blockIdx.x, 512, 512);
        pg8::Epi8<FYb> E{FYb{(const bf16*)(ws + WS_GBG), (const bf16*)(ws + WS_TMP), (bf16*)(ws + WS_MRG)}};
        pg8::gemm_phase<pg8::Epi8<FYb>, pg8::StaticOrder, true, true>(ldsl, g, S, E);
    }
    }
    grid.sync();
    if constexpr ((PH_MASK >> 6) & 1) {
    {
        pg8::Gemm g{(const bf16*)(ws + WS_MRG), (const bf16*)(ws + WS_WOUT), 1024, 1024, 1024};
        pg8::StaticOrder S; S.init(64, 4, G, blockIdx.x, 1024, 1024);
        pg8::Epi8<FRes> E{FRes{p.in[0], p.out, mx, 2}};
        pg8::gemm_phase<pg8::Epi8<FRes>, pg8::StaticOrder, true, true>(ldsl, g, S, E);
    }
    }
    grid.sync();
    if constexpr ((PH_MASK >> 7) & 1) {
    for (int m = gw; m < MTOK; m += NGW) {
        const int mr = m >> 11;
        norm_mod_row(p.out + (size_t)m * DM, p.in[13], mx + mr * (NMOD * DM) + 3 * DM, mx + mr * (NMOD * DM) + 4 * DM, (bf16*)(ws + WS_H2) + (size_t)m * DM, lane);
    }
    { LAS float* scr = (LAS float*)((LAS unsigned char*)lds + wave * 16384);
      constexpr int I_UP = 16 * 176, I_DN = 44 * 32;
      for (int it = gw; it < I_UP + I_DN; it += NGW) {
          if (it < I_UP) transpose_item(p.in[14], 1024, DFF2, (bf16*)(ws + WS_WUP), scr, it, lane);
          else transpose_item(p.in[17], DFF, 1024, (bf16*)(ws + WS_WDN), scr, it - I_UP, lane); } }
    }
    grid.sync();
    if constexpr ((PH_MASK >> 8) & 1) {
    for (int hf = 0; hf < 2; ++hf) {
        {
            pg8::Gemm g{(const bf16*)(ws + WS_H2) + (size_t)hf * 8192 * 1024, (const bf16*)(ws + WS_WUP), 1024, 1024, 1024};
            pg8::StaticOrder S; S.init(32, 22, G, blockIdx.x, 1024, 1024);
            pg8::Epi8<FUp> E{FUp{(bf16*)(ws + WS_Z)}};
            pg8::gemm_phase<pg8::Epi8<FUp>, pg8::StaticOrder, true, true>(ldsl, g, S, E);
        }
        grid.sync();
        phase_conv(p, hf, tid, G);
        grid.sync();
    }
    }
    if constexpr ((PH_MASK >> 10) & 1) {
    {
        pg8::Gemm g{(const bf16*)(ws + WS_A2), (const bf16*)(ws + WS_WDN), DFF, DFF, DFF};
        pg8::StaticOrder S; S.init(64, 4, G, blockIdx.x, DFF, DFF);
        pg8::Epi8<FRes> E{FRes{p.out, p.out, mx, 5}};
        pg8::gemm_phase<pg8::Epi8<FRes>, pg8::StaticOrder, true, true>(ldsl, g, S, E);
    }
    }
    grid.sync();
    if constexpr ((PH_MASK >> 11) & 1) {
    for (int m = gw; m < MTOK; m += NGW) {
        float* row = p.out + (size_t)m * DM; const float* fg = p.in[18];
        f32x4 v[4]; float s = 0.f;
#pragma unroll
        for (int j = 0; j < 4; ++j) { v[j] = *(const f32x4*)(row + (lane + 64 * j) * 4); s += (v[j][0] * v[j][0] + v[j][1] * v[j][1]) + (v[j][2] * v[j][2] + v[j][3] * v[j][3]); }
        const float rinv = rsqrtf(wave_sum(s) * (1.f / DM) + EPSN);
#pragma unroll
        for (int j = 0; j < 4; ++j) { const int e = (lane + 64 * j) * 4; *(f32x4*)(row + e) = v[j] * rinv * *(const f32x4*)(fg + e); }
    }
    }
}

extern "C" void kernel_launch(void* const* d_in, const int* in_sizes, int n_in, void* d_out, int out_size, void* d_ws, size_t ws_size, hipStream_t stream) {
    static int grid = 0;
    if (grid == 0) {
        if (n_in != 19 || out_size != MTOK * DM || ws_size < WS_END) { fprintf(stderr, "kernel_launch: unexpected problem: n_in %d out %d ws %zu\n", n_in, out_size, ws_size); grid = -1; return; }
        int dev = 0, cus = 0, per_cu = 0;
        hipGetDevice(&dev);
        hipDeviceGetAttribute(&cus, hipDeviceAttributeMultiprocessorCount, dev);
        if (hipFuncSetAttribute((const void*)fwd_mega, hipFuncAttributeMaxDynamicSharedMemorySize, LDS_BYTES) != hipSuccess) { fprintf(stderr, "kernel_launch: hipFuncSetAttribute failed\n"); grid = -1; return; }
        if (hipOccupancyMaxActiveBlocksPerMultiprocessor(&per_cu, (const void*)fwd_mega, NTHR, LDS_BYTES) != hipSuccess || per_cu < 1) { fprintf(stderr, "kernel_launch: occupancy query says %d\n", per_cu); per_cu = 1; }
        (void)hipGetLastError();
        grid = cus * (per_cu > 1 ? 1 : per_cu);
        fprintf(stderr, "kernel_launch: grid %d (cus %d, per_cu %d), ws %zu\n", grid, cus, per_cu, ws_size);
    }
    if (grid < 0) return;
    Params p{};
    for (int i = 0; i < 19; ++i) p.in[i] = (const float*)d_in[i];
    p.out = (float*)d_out; p.ws = (unsigned char*)d_ws;
    void* args[] = {&p};
    hipError_t e = hipLaunchCooperativeKernel((const void*)fwd_mega, dim3(grid), dim3(NTHR), args, LDS_BYTES, stream);
    if (e != hipSuccess) fprintf(stderr, "kernel_launch: cooperative launch failed: %s (grid %d)\n", hipGetErrorString(e), grid);
}
```

```cpp
#include <hip/hip_runtime.h>
#include <hip/hip_cooperative_groups.h>
#include <cstdio>
#include <cstdint>
namespace cg = cooperative_groups;

namespace pg8 {
#define PG8_LAS __attribute__((address_space(3)))
typedef unsigned short bf16_t;
typedef short bf16x8 __attribute__((ext_vector_type(8)));
typedef float f32x4 __attribute__((ext_vector_type(4)));
typedef unsigned u32x4 __attribute__((ext_vector_type(4)));
typedef unsigned u32x2 __attribute__((ext_vector_type(2)));
constexpr int BM = 256, BK = 64, HALF = 128, HTB = HALF * BK * 2  , STAGE_BYTES = 8 * HTB, NXCD = 8, WGM = 8;

__host__ __device__ __forceinline__ int lds_byte(int r, int c) { const int st = (r >> 4) * 2 + (c >> 5), rr = r & 15, cc = c & 31, ob = rr * 64 + cc * 2; return st * 1024 + (ob ^ (((ob >> 9) & 1) << 5)); }
__host__ __device__ __forceinline__ void stage_rc(int b, int& R, int& C) { const int st = b / 1024, sb = b % 1024, swz = sb ^ (((sb >> 9) & 1) << 5); R = (st >> 1) * 16 + swz / 64; C = (st & 1) * 32 + (swz % 64) / 2; }
__host__ __device__ __forceinline__ int perm32(int rho) { const int n = rho >> 4, i = rho & 15; return 8 * (i >> 2) + 4 * n + (i & 3); }

struct Unit { int pm, pn, z; };
struct Gemm { const bf16_t* A; const bf16_t* Bt; int K, lda, ldb; };

__device__ __forceinline__ void tile_of(int wgid, int nM, int nN, int& pm, int& pn) {
    const int nwg = nM * nN;
    { const int q = nwg / NXCD, r = nwg % NXCD, xcd = wgid % NXCD, off = wgid / NXCD; wgid = (xcd < r ? xcd * (q + 1) : r * (q + 1) + (xcd - r) * q) + off; }
    const int nig = WGM * nN, gid = wgid / nig, fm = gid * WGM, gsz = (nM - fm) < WGM ? (nM - fm) : WGM;
    pm = fm + ((wgid % nig) % gsz); pn = (wgid % nig) / gsz;
}
struct StaticOrder {
    int nM, nN, nwg, G, c; size_t a_tile, b_tile;
    __device__ __forceinline__ void init(int nM_, int nN_, int G_, int c_, int lda, int ldb) { nM = nM_; nN = nN_; nwg = nM * nN; G = G_; c = c_; a_tile = (size_t)BM * lda * 2; b_tile = (size_t)BM * ldb * 2; }
    __device__ __forceinline__ bool next(int i, Unit& u) const {
        const long L = (long)i * G + c; if (L >= nwg) return false;
        tile_of((int)L, nM, nN, u.pm, u.pn); u.z = 0; return true;
    }
    __device__ __forceinline__ size_t a_off(const Unit& u) const { return (size_t)u.pm * a_tile; }
    __device__ __forceinline__ size_t b_off(const Unit& u) const { return (size_t)u.pn * b_tile; }
};
struct InOrder {
    int G, c; size_t a_tile, b_tile;
    __device__ __forceinline__ bool next(int i, Unit& u) const {
        const long L = (long)i * G + c; if (L >= 1152 + 48) return false;
        if (L < 1152) { tile_of((int)L, 64, 18, u.pm, u.pn); } else { const int j = (int)L - 1152; u.pm = 64 + (j & 7); u.pn = 2 + (j >> 3); }
        u.z = 0; return true;
    }
    __device__ __forceinline__ size_t a_off(const Unit& u) const { return (size_t)u.pm * a_tile; }
    __device__ __forceinline__ size_t b_off(const Unit& u) const { return (size_t)u.pn * b_tile; }
};
struct DftOrder {
    int G, c; size_t a_tile, b_tile;
    __device__ __forceinline__ bool next(int i, Unit& u) const {
        const long L = (long)i * G + c; if (L >= 128) return false;
        u.z = (int)L >> 4; u.pm = ((int)L >> 1) & 7; u.pn = (int)L & 1; return true;
    }
    __device__ __forceinline__ size_t a_off(const Unit& u) const { return (size_t)u.pm * a_tile; }
    __device__ __forceinline__ size_t b_off(const Unit& u) const { return (size_t)u.pn * b_tile + (size_t)u.z * 4096 * 2; }
};

__device__ __forceinline__ unsigned cvt_pk_bf16(float lo, float hi) { unsigned r; asm volatile("v_cvt_pk_bf16_f32 %0, %1, %2" : "=v"(r) : "v"(lo), "v"(hi)); return r; }

template <class F> struct Epi8 {
    static constexpr bool PERM = true;
    F f;
    __device__ __forceinline__ void operator()(const f32x4 (&acc)[2][2][4][2], const Unit& u, int wr, int wc, int fr, int fq) const {
        const int row0 = u.pm * BM + wr * 64 + fr, col0 = u.pn * BM + wc * 32 + 8 * fq;
#pragma unroll
        for (int ai = 0; ai < 2; ++ai)
#pragma unroll
            for (int m = 0; m < 4; ++m) {
#pragma unroll
                for (int bj = 0; bj < 2; ++bj) f(u, row0 + ai * HALF + m * 16, col0 + bj * HALF, acc[ai][bj][m][0], acc[ai][bj][m][1]);
                asm volatile("" ::: "memory");
            }
    }
};

template <class Epi, class Sched, bool ALIGN_EPI = false, bool SP2 = false>
__device__ __forceinline__ void gemm_phase(PG8_LAS unsigned char* lds, const Gemm g, const Sched& S, const Epi& E) {
    int tid_ = threadIdx.x; asm volatile("" : "+v"(tid_));
    const int tid = tid_, wid = __builtin_amdgcn_readfirstlane(tid >> 6), lane = tid & 63, wr = wid >> 2, wc = wid & 3, fr = lane & 15, fq = lane >> 4;
    const int K = g.K, nt = K / BK;
    unsigned voffA[2], voffB[2];
#pragma unroll
    for (int i = 0; i < 2; ++i) { int R, C; stage_rc(tid * 16 + i * 8192, R, C); const int Rb = Epi::PERM ? ((R & ~31) + perm32(R & 31)) : R;
        voffA[i] = (unsigned)(R * g.lda + C) * 2u; voffB[i] = (unsigned)(Rb * g.ldb + C) * 2u; }
    const size_t kstep = (size_t)(BK * 2);
    const size_t hstepA = (size_t)HALF * g.lda * 2, hstepB = (size_t)HALF * g.ldb * 2;
    const unsigned ldsw = (unsigned)wid * 1024u;
    const int aoff = lds_byte(wr * 64 + fr, fq * 8), boff = lds_byte(wc * 32 + fr, fq * 8);
#define PG8_SA(b, h) (((b) * 2 + (h)) * HTB)
#define PG8_SB(b, h) ((4 + (b) * 2 + (h)) * HTB)
#define PG8_STAGE(bufoff, gbase, voff) do { _Pragma("unroll") for (int _i = 0; _i < 2; ++_i) \
        __builtin_amdgcn_global_load_lds((const unsigned*)((const char*)(gbase) + (voff)[_i]), (PG8_LAS unsigned*)(lds + (bufoff) + ldsw + _i * 8192), 16, 0, 0); } while (0)
#define PG8_LDA(dst, b, h) do { _Pragma("unroll") for (int m = 0; m < 4; ++m) _Pragma("unroll") for (int k = 0; k < 2; ++k) dst[m][k] = *(const PG8_LAS bf16x8*)(lds + PG8_SA(b, h) + aoff + m * 2048 + k * 1024); } while (0)
#define PG8_LDB(dst, b, h) do { _Pragma("unroll") for (int n = 0; n < 2; ++n) _Pragma("unroll") for (int k = 0; k < 2; ++k) dst[n][k] = *(const PG8_LAS bf16x8*)(lds + PG8_SB(b, h) + boff + n * 2048 + k * 1024); } while (0)
#define PG8_MMA(ai, bj, At, Bt) do { __builtin_amdgcn_s_setprio(1); _Pragma("unroll") for (int m = 0; m < 4; ++m) _Pragma("unroll") for (int n = 0; n < 2; ++n) _Pragma("unroll") for (int k = 0; k < 2; ++k) \
        acc[ai][bj][m][n] = __builtin_amdgcn_mfma_f32_16x16x32_bf16(Bt[n][k], At[m][k], acc[ai][bj][m][n], 0, 0, 0); __builtin_amdgcn_s_setprio(0); } while (0)
#define PG8_WAIT_V(n) asm volatile("s_waitcnt vmcnt(" #n ")" ::: "memory")
#define PG8_WAIT_L(n) asm volatile("s_waitcnt lgkmcnt(" #n ")" ::: "memory")
#define PG8_BAR __builtin_amdgcn_s_barrier()
#define PG8_SCHED __builtin_amdgcn_sched_barrier(0)
    Unit cur, nxt; int ui = 0;
    if (!S.next(0, cur)) return;
    f32x4 acc[2][2][4][2];
#pragma unroll
    for (int a = 0; a < 2; ++a)
#pragma unroll
        for (int b = 0; b < 2; ++b)
#pragma unroll
            for (int m = 0; m < 4; ++m)
#pragma unroll
                for (int n = 0; n < 2; ++n) acc[a][b][m][n] = (f32x4){0.f, 0.f, 0.f, 0.f};
    bf16x8 At[4][2], B0[2][2], B1[2][2];
    const char* cA = (const char*)g.A + S.a_off(cur); const char* cB = (const char*)g.Bt + S.b_off(cur);
    if constexpr (SP2) {
        PG8_STAGE(PG8_SB(0, 0), cB, voffB); PG8_STAGE(PG8_SB(0, 1), cB + hstepB, voffB); PG8_STAGE(PG8_SA(0, 0), cA, voffA); PG8_STAGE(PG8_SA(0, 1), cA + hstepA, voffA);
        if (wr == 1) PG8_BAR;
        PG8_WAIT_V(2); PG8_BAR;
        PG8_STAGE(PG8_SB(1, 0), cB + kstep, voffB); PG8_STAGE(PG8_SA(1, 0), cA + kstep, voffA); PG8_STAGE(PG8_SB(1, 1), cB + hstepB + kstep, voffB);
        PG8_WAIT_V(6); PG8_BAR;
    } else {
        PG8_STAGE(PG8_SB(0, 0), cB, voffB); PG8_STAGE(PG8_SA(0, 0), cA, voffA); PG8_STAGE(PG8_SB(0, 1), cB + hstepB, voffB); PG8_STAGE(PG8_SA(0, 1), cA + hstepA, voffA);
        if (wr == 1) PG8_BAR;
        PG8_WAIT_V(4); PG8_BAR;
        PG8_STAGE(PG8_SB(1, 0), cB + kstep, voffB); PG8_STAGE(PG8_SA(1, 0), cA + kstep, voffA); PG8_STAGE(PG8_SB(1, 1), cB + hstepB + kstep, voffB);
        PG8_WAIT_V(6); PG8_BAR;
    }
    for (;;) {
        const bool has_next = S.next(ui + 1, nxt);
        const char* nA = has_next ? (const char*)g.A + S.a_off(nxt) : cA; const char* nB = has_next ? (const char*)g.Bt + S.b_off(nxt) : cB;
        for (int t = 0; t < nt; t += 2) {
            const bool last = (t == nt - 2);
            const char* a1 = cA + (size_t)(t + 1) * kstep;
            const char* a2 = last ? nA : cA + (size_t)(t + 2) * kstep; const char* b2 = last ? nB : cB + (size_t)(t + 2) * kstep;
            const char* a3 = a2 + kstep; const char* b3 = b2 + kstep;
            if constexpr (SP2) {
            PG8_LDB(B0, 0, 0); PG8_LDB(B1, 0, 1); PG8_SCHED; PG8_LDA(At, 0, 0); PG8_STAGE(PG8_SA(1, 1), a1 + hstepA, voffA);
            PG8_WAIT_V(8); PG8_WAIT_L(0); PG8_BAR; PG8_MMA(0, 0, At, B0); PG8_MMA(0, 1, At, B1); PG8_BAR; PG8_SCHED;
            PG8_LDA(At, 0, 1); PG8_STAGE(PG8_SB(0, 0), b2, voffB); PG8_STAGE(PG8_SB(0, 1), b2 + hstepB, voffB); PG8_STAGE(PG8_SA(0, 0), a2, voffA);
            PG8_WAIT_V(8); PG8_WAIT_L(0); PG8_BAR; PG8_MMA(1, 0, At, B0); PG8_MMA(1, 1, At, B1); PG8_BAR; PG8_SCHED;
            PG8_LDB(B0, 1, 0); PG8_LDB(B1, 1, 1); PG8_SCHED; PG8_LDA(At, 1, 0); PG8_STAGE(PG8_SA(0, 1), a2 + hstepA, voffA);
            PG8_WAIT_V(8); PG8_WAIT_L(0); PG8_BAR; PG8_MMA(0, 0, At, B0); PG8_MMA(0, 1, At, B1); PG8_BAR; PG8_SCHED;
            PG8_LDA(At, 1, 1); PG8_STAGE(PG8_SB(1, 0), b3, voffB); PG8_STAGE(PG8_SB(1, 1), b3 + hstepB, voffB); PG8_STAGE(PG8_SA(1, 0), a3, voffA);
            PG8_WAIT_V(8); PG8_WAIT_L(0); PG8_BAR; PG8_MMA(1, 0, At, B0); PG8_MMA(1, 1, At, B1); PG8_BAR; PG8_SCHED;
            } else {
            PG8_LDB(B0, 0, 0); PG8_SCHED; PG8_LDA(At, 0, 0); PG8_STAGE(PG8_SA(1, 1), a1 + hstepA, voffA);
            PG8_WAIT_L(8); PG8_BAR; PG8_WAIT_L(0); PG8_MMA(0, 0, At, B0); PG8_BAR; PG8_SCHED;
            PG8_LDB(B1, 0, 1); PG8_STAGE(PG8_SB(0, 0), b2, voffB);
            PG8_BAR; PG8_WAIT_L(0); PG8_MMA(0, 1, At, B1); PG8_BAR;
            PG8_LDA(At, 0, 1); PG8_STAGE(PG8_SA(0, 0), a2, voffA);
            PG8_BAR; PG8_WAIT_L(0); PG8_MMA(1, 0, At, B0); PG8_BAR; PG8_SCHED;
            PG8_STAGE(PG8_SB(0, 1), b2 + hstepB, voffB);
            PG8_WAIT_V(6); PG8_BAR; PG8_MMA(1, 1, At, B1); PG8_BAR;
            PG8_LDB(B0, 1, 0); PG8_SCHED; PG8_LDA(At, 1, 0); PG8_STAGE(PG8_SA(0, 1), a2 + hstepA, voffA);
            PG8_WAIT_L(8); PG8_BAR; PG8_WAIT_L(0); PG8_MMA(0, 0, At, B0); PG8_BAR; PG8_SCHED;
            PG8_LDB(B1, 1, 1); PG8_STAGE(PG8_SB(1, 0), b3, voffB);
            PG8_BAR; PG8_WAIT_L(0); PG8_MMA(0, 1, At, B1); PG8_BAR;
            PG8_LDA(At, 1, 1); PG8_STAGE(PG8_SA(1, 0), a3, voffA);
            PG8_BAR; PG8_WAIT_L(0); PG8_MMA(1, 0, At, B0); PG8_BAR; PG8_SCHED;
            PG8_STAGE(PG8_SB(1, 1), b3 + hstepB, voffB);
            PG8_WAIT_V(6); PG8_BAR; PG8_MMA(1, 1, At, B1); PG8_BAR;
            }
        }
        if constexpr (ALIGN_EPI) { if (wr == 0) PG8_BAR; }
        E(acc, cur, wr, wc, fr, fq);
        if (!has_next) break;
#pragma unroll
        for (int a = 0; a < 2; ++a)
#pragma unroll
            for (int b = 0; b < 2; ++b)
#pragma unroll
                for (int m = 0; m < 4; ++m)
#pragma unroll
                    for (int n = 0; n < 2; ++n) acc[a][b][m][n] = (f32x4){0.f, 0.f, 0.f, 0.f};
        cur = nxt; cA = nA; cB = nB; ++ui;
        if constexpr (ALIGN_EPI) { if (wr == 1) PG8_BAR; }
    }
    PG8_WAIT_V(0);
    if constexpr (!ALIGN_EPI) { if (wr == 0) PG8_BAR; }
    PG8_BAR;
#undef PG8_SA
#undef PG8_SB
#undef PG8_STAGE
#undef PG8_LDA
#undef PG8_LDB
#undef PG8_MMA
#undef PG8_WAIT_V
#undef PG8_WAIT_L
#undef PG8_BAR
#undef PG8_SCHED
}
}

constexpr int DM = 1024, NB = 8, SEQ = 2048, MTOK = NB * SEQ, CTXL = 256, MCTX = NB * CTXL;
constexpr int HGD = 512, DFF = 2816, DFF2 = 5632, INDIM = 5120, NMOD = 6;
constexpr float EPSN = 1e-6f;
constexpr int NWAVES = 8, NTHR = 512;
constexpr int LDS_BYTES = 147456;
#ifndef DUP_MASK
#define DUP_MASK 0
#endif
#define REPS(k) ((((DUP_MASK) >> (k)) & 1) ? 2 : 1)

constexpr size_t MiB = 1u << 20;
constexpr size_t WS_MX = 0;
constexpr size_t WS_LB = 256 * 1024;
constexpr size_t WS_WIN = 6 * MiB;
constexpr size_t WS_WPQ = 16 * MiB;
constexpr size_t WS_WA = 18 * MiB, WS_WB = 19 * MiB, WS_WOUT = 20 * MiB;
constexpr size_t WS_CS = 22 * MiB;
constexpr size_t WS_WUP = 6 * MiB;
constexpr size_t WS_WDN = 17 * MiB;
constexpr size_t WS_HX = 38 * MiB;
constexpr size_t WS_OF = 38 * MiB, WS_OB = 54 * MiB;
constexpr size_t WS_TMP = 38 * MiB;
constexpr size_t WS_H2 = 38 * MiB;
constexpr size_t WS_Q = 74 * MiB, WS_V = 90 * MiB, WS_OG = 106 * MiB, WS_GA = 122 * MiB, WS_GBG = 154 * MiB, WS_PQT = 186 * MiB;
constexpr size_t WS_GFC = 218 * MiB, WS_GBC = 222 * MiB, WS_VC = 226 * MiB;
constexpr size_t WS_YF = 228 * MiB;
constexpr size_t WS_YH = 74 * MiB;
constexpr size_t WS_MRG = 186 * MiB;
constexpr size_t WS_Z = 74 * MiB;
constexpr size_t WS_A2 = 162 * MiB;
constexpr size_t WS_END = 256 * MiB;

typedef unsigned short bf16;
typedef float f32x4 __attribute__((ext_vector_type(4)));
typedef unsigned u32x4 __attribute__((ext_vector_type(4)));
typedef unsigned u32x2 __attribute__((ext_vector_type(2)));
#define LAS __attribute__((address_space(3)))

struct Params {
    const float* in[19];
    float* out;
    unsigned char* ws;
};

__device__ __forceinline__ float bf2f(unsigned short b) { return __uint_as_float(((unsigned)b) << 16); }
__device__ __forceinline__ float bflo(unsigned w) { return __uint_as_float(w << 16); }
__device__ __forceinline__ float bfhi(unsigned w) { return __uint_as_float(w & 0xffff0000u); }
__device__ __forceinline__ unsigned f2bf(float f) { unsigned u = __float_as_uint(f); return (u + 0x7fffu + ((u >> 16) & 1u)) >> 16; }
__device__ __forceinline__ unsigned pk2(float lo, float hi) { return f2bf(lo) | (f2bf(hi) << 16); }
__device__ __forceinline__ float sigmoidf_(float x) { return 1.f / (1.f + __expf(-x)); }
__device__ __forceinline__ float siluf_(float x) { return x / (1.f + __expf(-x)); }
__device__ __forceinline__ float wave_sum(float v) {
#pragma unroll
    for (int o = 1; o < 64; o <<= 1) v += __shfl_xor(v, o);
    return v;
}
__device__ __forceinline__ u32x4 pack8(const f32x4 a, const f32x4 b) { u32x4 w; w.x = pk2(a[0], a[1]); w.y = pk2(a[2], a[3]); w.z = pk2(b[0], b[1]); w.w = pk2(b[2], b[3]); return w; }

struct FIn {
    unsigned char* ws; float* out;
    __device__ __forceinline__ void operator()(const pg8::Unit& u, int row, int col, f32x4 v0, f32x4 v1) const {
        const int seg = u.pn >> 1, c = col & 511;
        if (seg == 0 || seg == 4) { f32x4 a, b;
#pragma unroll
            for (int i = 0; i < 4; ++i) { a[i] = siluf_(v0[i]); b[i] = siluf_(v1[i]); }
            bf16* dst = (bf16*)(ws + (seg == 0 ? WS_Q : WS_OG));
            *(u32x4*)(dst + (size_t)row * 512 + c) = pack8(a, b);
        } else if (seg == 1 || seg == 2) {
            const float* lb = (const float*)(ws + WS_LB);
            const f32x4 l0 = *(const f32x4*)(lb + c), l1 = *(const f32x4*)(lb + c + 4); f32x4 a, b;
#pragma unroll
            for (int i = 0; i < 4; ++i) { a[i] = l0[i] + (1.f - l0[i]) * sigmoidf_(v0[i]); b[i] = l1[i] + (1.f - l1[i]) * sigmoidf_(v1[i]); }
            float* dst;
            if (u.pm < 64) dst = out + (seg == 1 ? (size_t)0 : (size_t)MTOK * 512) + (size_t)row * 512 + c;
            else dst = (float*)(ws + (seg == 1 ? WS_GFC : WS_GBC)) + (size_t)(row - MTOK) * 512 + c;
            *(f32x4*)dst = a; *(f32x4*)(dst + 4) = b;
        } else if (seg == 3) {
            bf16* dst;
            if (u.pm < 64) dst = (bf16*)(ws + WS_V) + (size_t)row * 512 + c; else dst = (bf16*)(ws + WS_VC) + (size_t)(row - MTOK) * 512 + c;
            *(u32x4*)dst = pack8(v0, v1);
        } else { f32x4 a, b;
#pragma unroll
            for (int i = 0; i < 4; ++i) { a[i] = sigmoidf_(v0[i]); b[i] = sigmoidf_(v1[i]); }
            bf16* dst = (seg < 7) ? ((bf16*)(ws + WS_GA) + (size_t)row * 1024 + (col - 5 * 512)) : ((bf16*)(ws + WS_GBG) + (size_t)row * 1024 + (col - 7 * 512));
            *(u32x4*)dst = pack8(a, b);
        }
    }
};
struct FPQ {
    bf16* pqt;
    __device__ __forceinline__ void operator()(const pg8::Unit&, int row, int col, f32x4 v0, f32x4 v1) const {
        *(u32x4*)(pqt + (size_t)(row & 511) * 32768 + (size_t)(col >> 11) * 4096 + (size_t)(row >> 9) * 2048 + (col & 2047)) = pack8(v0, v1);
    }
};
struct FDft {
    bf16* yf;
    __device__ __forceinline__ void operator()(const pg8::Unit& u, int row, int col, f32x4 v0, f32x4 v1) const {
        *(u32x4*)(yf + ((size_t)u.z * SEQ + row) * 512 + col) = pack8(v0 * (1.f / 512.f), v1 * (1.f / 512.f));
    }
};
struct FYa {
    const bf16* ga; bf16* tmp;
    __device__ __forceinline__ void operator()(const pg8::Unit&, int row, int col, f32x4 v0, f32x4 v1) const {
        const size_t o = (size_t)row * 1024 + col; const u32x4 g = *(const u32x4*)(ga + o);
        f32x4 a, b; a[0] = v0[0] * bflo(g.x); a[1] = v0[1] * bfhi(g.x); a[2] = v0[2] * bflo(g.y); a[3] = v0[3] * bfhi(g.y);
        b[0] = v1[0] * bflo(g.z); b[1] = v1[1] * bfhi(g.z); b[2] = v1[2] * bflo(g.w); b[3] = v1[3] * bfhi(g.w);
        *(u32x4*)(tmp + o) = pack8(a, b);
    }
};
struct FYb {
    const bf16* gbg; const bf16* tmp; bf16* mrg;
    __device__ __forceinline__ void operator()(const pg8::Unit&, int row, int col, f32x4 v0, f32x4 v1) const {
        const size_t o = (size_t)row * 1024 + col; const u32x4 g = *(const u32x4*)(gbg + o); const u32x4 t = *(const u32x4*)(tmp + o);
        f32x4 a, b; a[0] = bflo(t.x) + v0[0] * bflo(g.x); a[1] = bfhi(t.x) + v0[1] * bfhi(g.x); a[2] = bflo(t.y) + v0[2] * bflo(g.y); a[3] = bfhi(t.y) + v0[3] * bfhi(g.y);
        b[0] = bflo(t.z) + v1[0] * bflo(g.z); b[1] = bfhi(t.z) + v1[1] * bfhi(g.z); b[2] = bflo(t.w) + v1[2] * bflo(g.w); b[3] = bfhi(t.w) + v1[3] * bfhi(g.w);
        *(u32x4*)(mrg + o) = pack8(a, b);
    }
};
struct FRes {
    const float* src; float* dst; const float* mx; int mod;
    __device__ __forceinline__ void operator()(const pg8::Unit&, int row, int col, f32x4 v0, f32x4 v1) const {
        const size_t o = (size_t)row * 1024 + col; const float* m = mx + (size_t)(row >> 11) * (NMOD * DM) + mod * DM + col;
        const f32x4 m0 = *(const f32x4*)m, m1 = *(const f32x4*)(m + 4), s0 = *(const f32x4*)(src + o), s1 = *(const f32x4*)(src + o + 4);
        *(f32x4*)(dst + o) = s0 + m0 * v0; *(f32x4*)(dst + o + 4) = s1 + m1 * v1;
    }
};
struct FUp {
    bf16* z;
    __device__ __forceinline__ void operator()(const pg8::Unit&, int row, int col, f32x4 v0, f32x4 v1) const {
        *(u32x4*)(z + (size_t)row * DFF2 + col) = pack8(v0, v1);
    }
};

__device__ __forceinline__ void transpose_item(const float* W, int K, int N, bf16* WT, LAS float* scr, int item, int lane) {
    const int nblk = N / 32, kb = item / nblk, nb = item % nblk, k0 = 64 * kb, n0 = 32 * nb;
#pragma unroll 8
    for (int i = 0; i < 32; ++i) { const int kk = 2 * i + (lane >> 5); scr[kk * 33 + (lane & 31)] = W[(size_t)(k0 + kk) * N + n0 + (lane & 31)]; }
    asm volatile("s_waitcnt lgkmcnt(0)" ::: "memory");
    const int c = lane & 7;
#pragma unroll
    for (int j = 0; j < 4; ++j) { const int n = (lane >> 3) + 8 * j; const LAS float* s = scr + (8 * c) * 33 + n;
        u32x4 o; o.x = pk2(s[0 * 33], s[1 * 33]); o.y = pk2(s[2 * 33], s[3 * 33]); o.z = pk2(s[4 * 33], s[5 * 33]); o.w = pk2(s[6 * 33], s[7 * 33]);
        *(u32x4*)(WT + (size_t)(n0 + n) * K + k0 + 8 * c) = o; }
    asm volatile("s_waitcnt lgkmcnt(0)" ::: "memory");
}

__device__ __forceinline__ void norm_mod_row(const float* xrow, const float* g, const float* shift, const float* scale, bf16* orow, int lane) {
    f32x4 v[4]; float s = 0.f;
#pragma unroll
    for (int j = 0; j < 4; ++j) { v[j] = *(const f32x4*)(xrow + (lane + 64 * j) * 4); s += (v[j][0] * v[j][0] + v[j][1] * v[j][1]) + (v[j][2] * v[j][2] + v[j][3] * v[j][3]); }
    const float rinv = rsqrtf(wave_sum(s) * (1.f / DM) + EPSN);
#pragma unroll
    for (int j = 0; j < 4; ++j) { const int e = (lane + 64 * j) * 4;
        const f32x4 gg = *(const f32x4*)(g + e), sh = *(const f32x4*)(shift + e), sc = *(const f32x4*)(scale + e);
        const f32x4 h = v[j] * rinv * gg * (sc + 1.f) + sh;
        u32x2 w; w.x = pk2(h[0], h[1]); w.y = pk2(h[2], h[3]); *(u32x2*)(orow + e) = w; }
}

__device__ __forceinline__ void phase0(const Params& p, unsigned char* lds, int tid, int lane, int wave, int G) {
    float* ldsf = (float*)lds;
    float* mxo = (float*)(p.ws + WS_MX);
    for (int it = blockIdx.x; it < 256; it += G) {
        __syncthreads();
        if (it < 192) {
            const float* c = p.in[1]; const float* cc = p.in[3]; const float* aw = p.in[4]; const float* ab = p.in[5];
            float* sc = ldsf;
            float* red = ldsf + 9 * 1024;
            for (int i = tid; i < 9 * 1024; i += NTHR) { const int r = i >> 10, k = i & 1023; const float cv = (r < 8) ? c[r * 1024 + k] : cc[k]; sc[i] = cv / (1.f + __expf(-cv)); }
            __syncthreads();
            const int n0 = it * 32, col = tid & 31, ks = tid >> 5;
            float a[9];
#pragma unroll
            for (int r = 0; r < 9; ++r) a[r] = 0.f;
            for (int k = ks * 64; k < ks * 64 + 64; ++k) { const float w = aw[(size_t)k * (NMOD * DM) + n0 + col];
#pragma unroll
                for (int r = 0; r < 9; ++r) a[r] += sc[r * 1024 + k] * w; }
#pragma unroll
            for (int r = 0; r < 9; ++r) red[(ks * 9 + r) * 32 + col] = a[r];
            __syncthreads();
            if (tid < 288) { const int r = tid >> 5, cl = tid & 31; float s = ab[n0 + cl];
                for (int k2 = 0; k2 < 16; ++k2) s += red[(k2 * 9 + r) * 32 + cl];
                mxo[r * (NMOD * DM) + n0 + cl] = s; }
        } else {
            const int w = it - 192, kb = w >> 2, g = w & 3, k0 = kb * 64;
            const float* win = p.in[7];
            float* wt = ldsf;
            float* tabc = ldsf + 64 * 129; float* tabs = tabc + 128;
            for (int i = tid; i < 64 * 128; i += NTHR) { const int kk = i >> 7, cc = i & 127; wt[kk * 129 + cc] = win[(size_t)(k0 + kk) * INDIM + g * 128 + cc]; }
            if (tid < 128) { tabc[tid] = cospif((float)tid * (1.f / 64.f)); tabs[tid] = sinpif((float)tid * (1.f / 64.f)); }
            __syncthreads();
            bf16* wpq = (bf16*)(p.ws + WS_WPQ);
            const int kk = tid & 63, jj = tid >> 6;
            for (int j = jj; j < 128; j += 8) { float aP = 0.f, aQ = 0.f;
                for (int cI = 0; cI < 128; ++cI) { const float wv = wt[kk * 129 + cI]; const int idx = (cI * j) & 127; aP += wv * tabc[idx]; aQ += wv * tabs[idx]; }
                wpq[(size_t)(g * 128 + j) * 1024 + k0 + kk] = (bf16)f2bf(aP);
                wpq[(size_t)(512 + g * 128 + j) * 1024 + k0 + kk] = (bf16)f2bf(aQ); }
        }
    }
    __syncthreads();
    if (blockIdx.x == 0) { const float* hl = p.in[8]; float* lbo = (float*)(p.ws + WS_LB);
        if (tid < 512) { const float a = hl[tid], b = hl[512 + tid]; lbo[tid] = 1.f / (1.f + expf(b - a)); } }
    { bf16* cs = (bf16*)(p.ws + WS_CS);
      for (int i = blockIdx.x * NTHR + tid; i < 2048 * 512; i += G * NTHR) { const int l = i >> 9, kc = (i & 511) * 8; float vv[8];
#pragma unroll
          for (int e = 0; e < 8; ++e) { const int k = kc + e, s = k >> 11, kk = k & 2047, ph = (l * kk) & 2047; const float ang = (float)ph * (1.f / 1024.f); vv[e] = s ? -sinpif(ang) : cospif(ang); }
          u32x4 w; w.x = pk2(vv[0], vv[1]); w.y = pk2(vv[2], vv[3]); w.z = pk2(vv[4], vv[5]); w.w = pk2(vv[6], vv[7]);
          *(u32x4*)(cs + (size_t)l * 4096 + kc) = w; } }
    { LAS float* scr = (LAS float*)((LAS unsigned char*)lds + wave * 16384);
      const int gw = blockIdx.x * NWAVES + wave, NGW = G * NWAVES;
      constexpr int I_IN = 16 * 160, I_A = 8 * 32, I_B = 8 * 32, I_O = 16 * 32;
      for (int it = gw; it < I_IN + I_A + I_B + I_O; it += NGW) { int r = it;
          if (r < I_IN) { transpose_item(p.in[7], 1024, INDIM, (bf16*)(p.ws + WS_WIN), scr, r, lane); continue; } r -= I_IN;
          if (r < I_A) { transpose_item(p.in[10], 512, 1024, (bf16*)(p.ws + WS_WA), scr, r, lane); continue; } r -= I_A;
          if (r < I_B) { transpose_item(p.in[11], 512, 1024, (bf16*)(p.ws + WS_WB), scr, r, lane); continue; } r -= I_B;
          transpose_item(p.in[12], 1024, 1024, (bf16*)(p.ws + WS_WOUT), scr, r, lane); } }
}

__device__ __forceinline__ void hgrn_mfma_item(const Params& p, unsigned char* lds, int item) {
    int tid_ = threadIdx.x; asm volatile("" : "+v"(tid_));
    const int tid = tid_, lane = tid & 63, w = __builtin_amdgcn_readfirstlane(tid >> 6), fr = lane & 15, fq = lane >> 4;
    const int vh = item & 1, dir = (item >> 1) & 1, h = (item >> 2) & 3, b = item >> 4;
    bf16* Qs = (bf16*)lds;
    bf16* Ks = Qs + 64 * 136;
    bf16* St = Ks + 64 * 136;
    bf16* Kh = St + 2 * 64 * 136;
    bf16* Vt = Kh + 128 * 72;
    bf16* Ps = Vt + 64 * 72;
    float* Et = (float*)(Ps + 64 * 72);
    const int d = 16 * w + fr;
    const float* fL = p.out + (dir ? (size_t)MTOK * 512 : 0) + (size_t)b * SEQ * 512 + h * 128 + d;
    const float* fC = (const float*)(p.ws + (dir ? WS_GBC : WS_GFC)) + (size_t)b * CTXL * 512 + h * 128 + d;
    const bf16* qL = (const bf16*)(p.ws + WS_Q) + (size_t)b * SEQ * 512 + h * 128 + d;
    const bf16* vL = (const bf16*)(p.ws + WS_V) + (size_t)b * SEQ * 512 + h * 128 + vh * 64 + lane;
    const bf16* vC = (const bf16*)(p.ws + WS_VC) + (size_t)b * CTXL * 512 + h * 128 + vh * 64 + lane;
    bf16* oL = (bf16*)(p.ws + (dir ? WS_OB : WS_OF)) + (size_t)b * SEQ * 512 + h * 128 + vh * 64;
    f32x4 Sa[4];
#pragma unroll
    for (int i = 0; i < 4; ++i) Sa[i] = (f32x4){0.f, 0.f, 0.f, 0.f};
    float fr_[16]; unsigned short qr_[16], vr_[8];
#define HG_LOAD(cc_) do { const int _cc = (cc_); const bool _lat = _cc >= 4; const int _c = _lat ? _cc - 4 : _cc, _n = _lat ? SEQ : CTXL; \
        const float* _f = _lat ? fL : fC; const bf16* _v = _lat ? vL : vC; \
        _Pragma("unroll") for (int i = 0; i < 16; ++i) { const int _s = _c * 64 + fq * 16 + i, _pos = dir ? (_n - 1 - _s) : _s; fr_[i] = _f[(size_t)_pos * 512]; qr_[i] = _lat ? qL[(size_t)_pos * 512] : (unsigned short)0; } \
        _Pragma("unroll") for (int j = 0; j < 8; ++j) { const int _s = _c * 64 + w * 8 + j, _pos = dir ? (_n - 1 - _s) : _s; vr_[j] = _v[(size_t)_pos * 512]; } } while (0)
    HG_LOAD(0);
    for (int cc = 0; cc < 36; ++cc) {
        const bool lat = cc >= 4; const int c = lat ? cc - 4 : cc;
        bf16* Scur = St + (cc & 1) * (64 * 136); bf16* Snxt = St + ((cc & 1) ^ 1) * (64 * 136);
        {
            float ce[16]; float e = 1.f;
#pragma unroll
            for (int i = 0; i < 16; ++i) { e *= fr_[i]; ce[i] = e; }
            const float T0 = __shfl(e, fr), T1 = __shfl(e, fr + 16), T2 = __shfl(e, fr + 32), T3 = __shfl(e, fr + 48);
            const float pre = (fq == 0) ? 1.f : (fq == 1) ? T0 : (fq == 2) ? T0 * T1 : T0 * T1 * T2;
            const float tot = T0 * T1 * T2 * T3;
            if (fq == 0) Et[d] = tot;
            unsigned khw[8];
#pragma unroll
            for (int i = 0; i < 16; i += 2) { float kh2[2];
#pragma unroll
                for (int u = 0; u < 2; ++u) { const float cm = fmaxf(pre * ce[i + u], 1e-30f), ie = __builtin_amdgcn_rcpf(cm), kt = (1.f - fr_[i + u]) * ie; const int sl = fq * 16 + i + u;
                    if (lat) { Qs[sl * 136 + d] = (bf16)f2bf(bf2f(qr_[i + u]) * cm); Ks[sl * 136 + d] = (bf16)f2bf(kt); }
                    kh2[u] = kt * tot; }
                khw[i >> 1] = pk2(kh2[0], kh2[1]); }
            u32x4 k0; k0.x = khw[0]; k0.y = khw[1]; k0.z = khw[2]; k0.w = khw[3]; u32x4 k1; k1.x = khw[4]; k1.y = khw[5]; k1.z = khw[6]; k1.w = khw[7];
            *(u32x4*)(Kh + d * 72 + fq * 16) = k0; *(u32x4*)(Kh + d * 72 + fq * 16 + 8) = k1;
            u32x4 vv; vv.x = (unsigned)vr_[0] | ((unsigned)vr_[1] << 16); vv.y = (unsigned)vr_[2] | ((unsigned)vr_[3] << 16); vv.z = (unsigned)vr_[4] | ((unsigned)vr_[5] << 16); vv.w = (unsigned)vr_[6] | ((unsigned)vr_[7] << 16);
            *(u32x4*)(Vt + lane * 72 + w * 8) = vv;
        }
        if (cc + 1 < 36) HG_LOAD(cc + 1);
        __syncthreads();
        const int ti = w >> 1, x2 = 2 * (w & 1);
        if (lat) {
#pragma unroll
            for (int u2 = 0; u2 < 2; ++u2) { const int si = x2 + u2; f32x4 acc = (f32x4){0.f, 0.f, 0.f, 0.f};
                if (si <= ti) {
#pragma unroll
                    for (int kk = 0; kk < 4; ++kk) { const pg8::bf16x8 a = *(const pg8::bf16x8*)(Ks + (si * 16 + fr) * 136 + kk * 32 + fq * 8), bq = *(const pg8::bf16x8*)(Qs + (ti * 16 + fr) * 136 + kk * 32 + fq * 8);
                        acc = __builtin_amdgcn_mfma_f32_16x16x32_bf16(a, bq, acc, 0, 0, 0); }
                    if (si == ti) {
#pragma unroll
                        for (int r = 0; r < 4; ++r) if (4 * fq + r > fr) acc[r] = 0.f; } }
                u32x2 pw; pw.x = pk2(acc[0], acc[1]); pw.y = pk2(acc[2], acc[3]);
                *(u32x2*)(Ps + (ti * 16 + fr) * 72 + si * 16 + 4 * fq) = pw; }
        }
        {
            const f32x4 et = *(const f32x4*)(Et + w * 16 + 4 * fq);
            pg8::bf16x8 ka[2];
#pragma unroll
            for (int kk = 0; kk < 2; ++kk) ka[kk] = *(const pg8::bf16x8*)(Kh + (w * 16 + fr) * 72 + kk * 32 + fq * 8);
#pragma unroll
            for (int vi = 0; vi < 4; ++vi) { Sa[vi] = Sa[vi] * et;
#pragma unroll
                for (int kk = 0; kk < 2; ++kk) { const pg8::bf16x8 bv = *(const pg8::bf16x8*)(Vt + (vi * 16 + fr) * 72 + kk * 32 + fq * 8);
                    Sa[vi] = __builtin_amdgcn_mfma_f32_16x16x32_bf16(ka[kk], bv, Sa[vi], 0, 0, 0); }
                u32x2 sw; sw.x = pk2(Sa[vi][0], Sa[vi][1]); sw.y = pk2(Sa[vi][2], Sa[vi][3]);
                *(u32x2*)(Snxt + (vi * 16 + fr) * 136 + w * 16 + 4 * fq) = sw; }
        }
        f32x4 Oa[2];
        Oa[0] = (f32x4){0.f, 0.f, 0.f, 0.f}; Oa[1] = (f32x4){0.f, 0.f, 0.f, 0.f};
        if (lat) {
#pragma unroll
            for (int kk = 0; kk < 4; ++kk) { const pg8::bf16x8 bq = *(const pg8::bf16x8*)(Qs + (ti * 16 + fr) * 136 + kk * 32 + fq * 8);
#pragma unroll
                for (int u2 = 0; u2 < 2; ++u2) { const pg8::bf16x8 a = *(const pg8::bf16x8*)(Scur + ((x2 + u2) * 16 + fr) * 136 + kk * 32 + fq * 8);
                    Oa[u2] = __builtin_amdgcn_mfma_f32_16x16x32_bf16(a, bq, Oa[u2], 0, 0, 0); } }
        }
        __syncthreads();
        if (lat) {
#pragma unroll
            for (int kk = 0; kk < 2; ++kk) { const pg8::bf16x8 bp = *(const pg8::bf16x8*)(Ps + (ti * 16 + fr) * 72 + kk * 32 + fq * 8);
#pragma unroll
                for (int u2 = 0; u2 < 2; ++u2) { const pg8::bf16x8 a = *(const pg8::bf16x8*)(Vt + ((x2 + u2) * 16 + fr) * 72 + kk * 32 + fq * 8);
                    Oa[u2] = __builtin_amdgcn_mfma_f32_16x16x32_bf16(a, bp, Oa[u2], 0, 0, 0); } }
            const int sg = c * 64 + ti * 16 + fr, pos = dir ? (SEQ - 1 - sg) : sg;
#pragma unroll
            for (int u2 = 0; u2 < 2; ++u2) { u32x2 ow; ow.x = pk2(Oa[u2][0], Oa[u2][1]); ow.y = pk2(Oa[u2][2], Oa[u2][3]);
                *(u32x2*)(oL + (size_t)pos * 512 + (x2 + u2) * 16 + 4 * fq) = ow; }
        }
        __syncthreads();
    }
#undef HG_LOAD
}

__device__ __forceinline__ void phase_yh(const Params& p, int lane, int gw, int NGW) {
    const bf16* of = (const bf16*)(p.ws + WS_OF); const bf16* ob = (const bf16*)(p.ws + WS_OB); const bf16* og = (const bf16*)(p.ws + WS_OG);
    bf16* yh = (bf16*)(p.ws + WS_YH); const float* on = p.in[9];
    for (int m = gw; m < MTOK; m += NGW) { const size_t o = (size_t)m * 512 + lane * 8;
        const u32x4 a = *(const u32x4*)(of + o), b = *(const u32x4*)(ob + o), gg = *(const u32x4*)(og + o);
        float v[8]; v[0] = bflo(a.x) + bflo(b.x); v[1] = bfhi(a.x) + bfhi(b.x); v[2] = bflo(a.y) + bflo(b.y); v[3] = bfhi(a.y) + bfhi(b.y);
        v[4] = bflo(a.z) + bflo(b.z); v[5] = bfhi(a.z) + bfhi(b.z); v[6] = bflo(a.w) + bflo(b.w); v[7] = bfhi(a.w) + bfhi(b.w);
        float s = 0.f;
#pragma unroll
        for (int i = 0; i < 8; ++i) s += v[i] * v[i];
        s += __shfl_xor(s, 1); s += __shfl_xor(s, 2); s += __shfl_xor(s, 4); s += __shfl_xor(s, 8);
        const float rinv = rsqrtf(s * (1.f / 128.f) + EPSN);
        const f32x4 n0 = *(const f32x4*)(on + lane * 8), n1 = *(const f32x4*)(on + lane * 8 + 4);
        float gv[8]; gv[0] = bflo(gg.x); gv[1] = bfhi(gg.x); gv[2] = bflo(gg.y); gv[3] = bfhi(gg.y); gv[4] = bflo(gg.z); gv[5] = bfhi(gg.z); gv[6] = bflo(gg.w); gv[7] = bfhi(gg.w);
        f32x4 r0, r1;
#pragma unroll
        for (int i = 0; i < 4; ++i) { r0[i] = v[i] * rinv * n0[i] * gv[i]; r1[i] = v[4 + i] * rinv * n1[i] * gv[4 + i]; }
        *(u32x4*)(yh + o) = pack8(r0, r1); }
}

struct ConvRaw { u32x2 a[3], g[3]; };
__device__ __forceinline__ void conv_issue(const bf16* z, int tokbase, int r, int cc, int ch, ConvRaw& q) {
#pragma unroll
    for (int i = 0; i < 3; ++i) { const int rr = r + i - 1;
        if (rr >= 0 && rr < 32 && cc >= 0 && cc < 64) { const size_t zo = (size_t)(tokbase + rr * 64 + cc) * DFF2 + ch;
            q.a[i] = *(const u32x2*)(z + zo); q.g[i] = *(const u32x2*)(z + zo + DFF);
        } else { q.a[i] = (u32x2){0u, 0u}; q.g[i] = (u32x2){0u, 0u}; } }
}
__device__ __forceinline__ void phase_conv(const Params& p, int hf, int tid, int G) {
    const bf16* z = (const bf16*)(p.ws + WS_Z); bf16* a2 = (bf16*)(p.ws + WS_A2) + (size_t)hf * 8192 * DFF;
    const float* cw = p.in[15]; const float* cb = p.in[16];
    for (int it = blockIdx.x * NTHR + tid; it < 4 * 32 * 4 * 704; it += G * NTHR) {
        const int cg4 = it % 704, rest = it / 704, strip = rest & 3, r = (rest >> 2) & 31, img = rest >> 7, ch = cg4 * 4, c0 = strip * 16, tokbase = img * 2048;
        ConvRaw ring[4];
#pragma unroll
        for (int j = 0; j < 4; ++j) conv_issue(z, tokbase, r, c0 - 1 + j, ch, ring[j]);
        float w1[9][4], w2[9][4];
#pragma unroll
        for (int t = 0; t < 9; ++t) { const f32x4 a = *(const f32x4*)(cw + (size_t)t * DFF2 + ch), g = *(const f32x4*)(cw + (size_t)t * DFF2 + DFF + ch);
#pragma unroll
            for (int e = 0; e < 4; ++e) { w1[t][e] = a[e]; w2[t][e] = g[e]; } }
        const f32x4 b1 = *(const f32x4*)(cb + ch), b2 = *(const f32x4*)(cb + DFF + ch);
        float W1[3][3][4], W2[3][3][4];
#pragma unroll
        for (int j = 0; j < 18; ++j) {
            const int sl = j % 3;
#pragma unroll
            for (int i = 0; i < 3; ++i) { const u32x2 a = ring[j & 3].a[i], g = ring[j & 3].g[i];
                W1[sl][i][0] = bflo(a.x); W1[sl][i][1] = bfhi(a.x); W1[sl][i][2] = bflo(a.y); W1[sl][i][3] = bfhi(a.y);
                W2[sl][i][0] = bflo(g.x); W2[sl][i][1] = bfhi(g.x); W2[sl][i][2] = bflo(g.y); W2[sl][i][3] = bfhi(g.y); }
            if (j + 4 < 18) conv_issue(z, tokbase, r, c0 - 1 + j + 4, ch, ring[j & 3]);
            if (j >= 2) {
                const int sL = (j - 2) % 3, sC = (j - 1) % 3, sR = j % 3;
                float o1[4], o2[4];
#pragma unroll
                for (int e = 0; e < 4; ++e) { o1[e] = b1[e]; o2[e] = b2[e]; }
#pragma unroll
                for (int i = 0; i < 3; ++i)
#pragma unroll
                    for (int e = 0; e < 4; ++e) {
                        o1[e] += W1[sL][i][e] * w1[i * 3 + 0][e] + W1[sC][i][e] * w1[i * 3 + 1][e] + W1[sR][i][e] * w1[i * 3 + 2][e];
                        o2[e] += W2[sL][i][e] * w2[i * 3 + 0][e] + W2[sC][i][e] * w2[i * 3 + 1][e] + W2[sR][i][e] * w2[i * 3 + 2][e]; }
                u32x2 ow; ow.x = pk2(siluf_(o1[0]) * o2[0], siluf_(o1[1]) * o2[1]); ow.y = pk2(siluf_(o1[2]) * o2[2], siluf_(o1[3]) * o2[3]);
                *(u32x2*)(a2 + (size_t)(tokbase + r * 64 + c0 + j - 2) * DFF + ch) = ow;
            }
        }
    }
}

__global__ void __launch_bounds__(NTHR, 2) fwd_mega(Params p) {
    extern __shared__ __attribute__((aligned(16))) unsigned char lds[];
    cg::grid_group grid = cg::this_grid();
    const int tid = threadIdx.x, lane = tid & 63, wave = __builtin_amdgcn_readfirstlane(tid >> 6);
    const int G = gridDim.x, gw = blockIdx.x * NWAVES + wave, NGW = G * NWAVES;
    PG8_LAS unsigned char* ldsl = (PG8_LAS unsigned char*)lds;
    unsigned char* ws = p.ws;
    const float* mx = (const float*)(ws + WS_MX);

    for (int rep_ = 0; rep_ < REPS(0); ++rep_) {
    phase0(p, lds, tid, lane, wave, G);
    grid.sync();
    }
    for (int rep_ = 0; rep_ < REPS(1); ++rep_) {
    for (int m = gw; m < MTOK + MCTX; m += NGW) {
        const float* src = (m < MTOK) ? p.in[0] + (size_t)m * DM : p.in[2] + (size_t)(m - MTOK) * DM;
        const int mr = (m < MTOK) ? (m >> 11) : 8;
        norm_mod_row(src, p.in[6], mx + mr * (NMOD * DM), mx + mr * (NMOD * DM) + DM, (bf16*)(ws + WS_HX) + (size_t)m * DM, lane);
    }
    grid.sync();
    }
    for (int rep_ = 0; rep_ < REPS(2); ++rep_) {
    {
        pg8::Gemm g{(const bf16*)(ws + WS_HX), (const bf16*)(ws + WS_WIN) + (size_t)512 * 1024, 1024, 1024, 1024};
        pg8::InOrder S; S.G = G; S.c = blockIdx.x; S.a_tile = (size_t)256 * 1024 * 2; S.b_tile = (size_t)256 * 1024 * 2;
        pg8::Epi8<FIn> E{FIn{ws, p.out}};
        pg8::gemm_phase<pg8::Epi8<FIn>, pg8::InOrder, true, true>(ldsl, g, S, E);
    }
    {
        pg8::Gemm g{(const bf16*)(ws + WS_WPQ), (const bf16*)(ws + WS_HX), 1024, 1024, 1024};
        pg8::StaticOrder S; S.init(4, 64, G, blockIdx.x, 1024, 1024);
        pg8::Epi8<FPQ> E{FPQ{(bf16*)(ws + WS_PQT)}};
        pg8::gemm_phase<pg8::Epi8<FPQ>, pg8::StaticOrder, true, true>(ldsl, g, S, E);
    }
    grid.sync();
    }
    for (int rep_ = 0; rep_ < REPS(3); ++rep_) {
    if (blockIdx.x < 128 && G >= 192) {
        pg8::Gemm g{(const bf16*)(ws + WS_CS), (const bf16*)(ws + WS_PQT), 4096, 4096, 32768};
        pg8::DftOrder S; S.G = 128; S.c = blockIdx.x; S.a_tile = (size_t)256 * 4096 * 2; S.b_tile = (size_t)256 * 32768 * 2;
        pg8::Epi8<FDft> E{FDft{(bf16*)(ws + WS_YF)}};
        pg8::gemm_phase<pg8::Epi8<FDft>, pg8::DftOrder, true, true>(ldsl, g, S, E);
    } else if (G >= 192) {
        for (int it = blockIdx.x - 128; it < 128; it += G - 128) hgrn_mfma_item(p, lds, it);
    } else {
        pg8::Gemm g{(const bf16*)(ws + WS_CS), (const bf16*)(ws + WS_PQT), 4096, 4096, 32768};
        pg8::DftOrder S; S.G = G; S.c = blockIdx.x; S.a_tile = (size_t)256 * 4096 * 2; S.b_tile = (size_t)256 * 32768 * 2;
        pg8::Epi8<FDft> E{FDft{(bf16*)(ws + WS_YF)}};
        pg8::gemm_phase<pg8::Epi8<FDft>, pg8::DftOrder, true, true>(ldsl, g, S, E);
        for (int it = blockIdx.x; it < 128; it += G) hgrn_mfma_item(p, lds, it);
    }
    grid.sync();
    }
    for (int rep_ = 0; rep_ < REPS(4); ++rep_) {
    phase_yh(p, lane, gw, NGW);
    grid.sync();
    }
    for (int rep_ = 0; rep_ < REPS(5); ++rep_) {
    {
        pg8::Gemm g{(const bf16*)(ws + WS_YF), (const bf16*)(ws + WS_WA), 512, 512, 512};
        pg8::StaticOrder S; S.init(64, 4, G, blockIdx.x, 512, 512);
        pg8::Epi8<FYa> E{FYa{(const bf16*)(ws + WS_GA), (bf16*)(ws + WS_TMP)}};
        pg8::gemm_phase<pg8::Epi8<FYa>, pg8::StaticOrder, true, true>(ldsl, g, S, E);
    }
    {
        pg8::Gemm g{(const bf16*)(ws + WS_YH), (const bf16*)(ws + WS_WB), 512, 512, 512};
        pg8::StaticOrder S; S.init(64, 4, G, blockIdx.x, 512, 512);
        pg8::Epi8<FYb> E{FYb{(const bf16*)(ws + WS_GBG), (const bf16*)(ws + WS_TMP), (bf16*)(ws + WS_MRG)}};
        pg8::gemm_phase<pg8::Epi8<FYb>, pg8::StaticOrder, true, true>(ldsl, g, S, E);
    }
    grid.sync();
    }
    for (int rep_ = 0; rep_ < REPS(6); ++rep_) {
    {
        pg8::Gemm g{(const bf16*)(ws + WS_MRG), (const bf16*)(ws + WS_WOUT), 1024, 1024, 1024};
        pg8::StaticOrder S; S.init(64, 4, G, blockIdx.x, 1024, 1024);
        pg8::Epi8<FRes> E{FRes{p.in[0], p.out, mx, 2}};
        pg8::gemm_phase<pg8::Epi8<FRes>, pg8::StaticOrder, true, true>(ldsl, g, S, E);
    }
    grid.sync();
    }
    for (int rep_ = 0; rep_ < REPS(7); ++rep_) {
    for (int m = gw; m < MTOK; m += NGW) {
        const int mr = m >> 11;
        norm_mod_row(p.out + (size_t)m * DM, p.in[13], mx + mr * (NMOD * DM) + 3 * DM, mx + mr * (NMOD * DM) + 4 * DM, (bf16*)(ws + WS_H2) + (size_t)m * DM, lane);
    }
    { LAS float* scr = (LAS float*)((LAS unsigned char*)lds + wave * 16384);
      constexpr int I_UP = 16 * 176, I_DN = 44 * 32;
      for (int it = gw; it < I_UP + I_DN; it += NGW) {
          if (it < I_UP) transpose_item(p.in[14], 1024, DFF2, (bf16*)(ws + WS_WUP), scr, it, lane);
          else transpose_item(p.in[17], DFF, 1024, (bf16*)(ws + WS_WDN), scr, it - I_UP, lane); } }
    grid.sync();
    }
    {
    for (int hf = 0; hf < 2; ++hf) {
        for (int rep_ = 0; rep_ < REPS(8); ++rep_) {
            pg8::Gemm g{(const bf16*)(ws + WS_H2) + (size_t)hf * 8192 * 1024, (const bf16*)(ws + WS_WUP), 1024, 1024, 1024};
            pg8::StaticOrder S; S.init(32, 22, G, blockIdx.x, 1024, 1024);
            pg8::Epi8<FUp> E{FUp{(bf16*)(ws + WS_Z)}};
            pg8::gemm_phase<pg8::Epi8<FUp>, pg8::StaticOrder, true, true>(ldsl, g, S, E);
        grid.sync();
        }
        for (int rep_ = 0; rep_ < REPS(9); ++rep_) {
        phase_conv(p, hf, tid, G);
        grid.sync();
        }
    }
    }
    {
    {
        pg8::Gemm g{(const bf16*)(ws + WS_A2), (const bf16*)(ws + WS_WDN), DFF, DFF, DFF};
        pg8::StaticOrder S; S.init(64, 4, G, blockIdx.x, DFF, DFF);
        pg8::Epi8<FRes> E{FRes{p.out, p.out, mx, 5}};
        pg8::gemm_phase<pg8::Epi8<FRes>, pg8::StaticOrder, true, true>(ldsl, g, S, E);
    }
    }
    grid.sync();
    {
    for (int m = gw; m < MTOK; m += NGW) {
        float* row = p.out + (size_t)m * DM; const float* fg = p.in[18];
        f32x4 v[4]; float s = 0.f;
#pragma unroll
        for (int j = 0; j < 4; ++j) { v[j] = *(const f32x4*)(row + (lane + 64 * j) * 4); s += (v[j][0] * v[j][0] + v[j][1] * v[j][1]) + (v[j][2] * v[j][2] + v[j][3] * v[j][3]); }
        const float rinv = rsqrtf(wave_sum(s) * (1.f / DM) + EPSN);
#pragma unroll
        for (int j = 0; j < 4; ++j) { const int e = (lane + 64 * j) * 4; *(f32x4*)(row + e) = v[j] * rinv * *(const f32x4*)(fg + e); }
    }
    }
}

extern "C" void kernel_launch(void* const* d_in, const int* in_sizes, int n_in, void* d_out, int out_size, void* d_ws, size_t ws_size, hipStream_t stream) {
    static int grid = 0;
    if (grid == 0) {
        if (n_in != 19 || out_size != MTOK * DM || ws_size < WS_END) { fprintf(stderr, "kernel_launch: unexpected problem: n_in %d out %d ws %zu\n", n_in, out_size, ws_size); grid = -1; return; }
        int dev = 0, cus = 0, per_cu = 0;
        hipGetDevice(&dev);
        hipDeviceGetAttribute(&cus, hipDeviceAttributeMultiprocessorCount, dev);
        if (hipFuncSetAttribute((const void*)fwd_mega, hipFuncAttributeMaxDynamicSharedMemorySize, LDS_BYTES) != hipSuccess) { fprintf(stderr, "kernel_launch: hipFuncSetAttribute failed\n"); grid = -1; return; }
        if (hipOccupancyMaxActiveBlocksPerMultiprocessor(&per_cu, (const void*)fwd_mega, NTHR, LDS_BYTES) != hipSuccess || per_cu < 1) { fprintf(stderr, "kernel_launch: occupancy query says %d\n", per_cu); per_cu = 1; }
        (void)hipGetLastError();
        grid = cus * (per_cu > 1 ? 1 : per_cu);
        fprintf(stderr, "kernel_launch: grid %d (cus %d, per_cu %d), ws %zu\n", grid, cus, per_cu, ws_size);
    }
    if (grid < 0) return;
    Params p{};
    for (int i = 0; i < 19; ++i) p.in[i] = (const float*)d_in[i];
    p.out = (float*)d_out; p.ws = (unsigned char*)d_ws;
    void* args[] = {&p};
    hipError_t e = hipLaunchCooperativeKernel((const void*)fwd_mega, dim3(grid), dim3(NTHR), args, LDS_BYTES, stream);
    if (e != hipSuccess) fprintf(stderr, "kernel_launch: cooperative launch failed: %s (grid %d)\n", hipGetErrorString(e), grid);
}
```

```cpp
#include <hip/hip_runtime.h>
#include <hip/hip_cooperative_groups.h>
#include <cstdio>
#include <cstdint>
namespace cg = cooperative_groups;

namespace pg8 {
#define PG8_LAS __attribute__((address_space(3)))
typedef unsigned short bf16_t;
typedef short bf16x8 __attribute__((ext_vector_type(8)));
typedef float f32x4 __attribute__((ext_vector_type(4)));
typedef unsigned u32x4 __attribute__((ext_vector_type(4)));
typedef unsigned u32x2 __attribute__((ext_vector_type(2)));
constexpr int BM = 256, BK = 64, HALF = 128, HTB = HALF * BK * 2  , STAGE_BYTES = 8 * HTB, NXCD = 8, WGM = 8;

__host__ __device__ __forceinline__ int lds_byte(int r, int c) { const int st = (r >> 4) * 2 + (c >> 5), rr = r & 15, cc = c & 31, ob = rr * 64 + cc * 2; return st * 1024 + (ob ^ (((ob >> 9) & 1) << 5)); }
__host__ __device__ __forceinline__ void stage_rc(int b, int& R, int& C) { const int st = b / 1024, sb = b % 1024, swz = sb ^ (((sb >> 9) & 1) << 5); R = (st >> 1) * 16 + swz / 64; C = (st & 1) * 32 + (swz % 64) / 2; }
__host__ __device__ __forceinline__ int perm32(int rho) { const int n = rho >> 4, i = rho & 15; return 8 * (i >> 2) + 4 * n + (i & 3); }

struct Unit { int pm, pn, z; };
struct Gemm { const bf16_t* A; const bf16_t* Bt; int K, lda, ldb; };

__device__ __forceinline__ void tile_of(int wgid, int nM, int nN, int& pm, int& pn) {
    const int nwg = nM * nN;
    { const int q = nwg / NXCD, r = nwg % NXCD, xcd = wgid % NXCD, off = wgid / NXCD; wgid = (xcd < r ? xcd * (q + 1) : r * (q + 1) + (xcd - r) * q) + off; }
    const int nig = WGM * nN, gid = wgid / nig, fm = gid * WGM, gsz = (nM - fm) < WGM ? (nM - fm) : WGM;
    pm = fm + ((wgid % nig) % gsz); pn = (wgid % nig) / gsz;
}
struct StaticOrder {
    int nM, nN, nwg, G, c; size_t a_tile, b_tile;
    __device__ __forceinline__ void init(int nM_, int nN_, int G_, int c_, int lda, int ldb) { nM = nM_; nN = nN_; nwg = nM * nN; G = G_; c = c_; a_tile = (size_t)BM * lda * 2; b_tile = (size_t)BM * ldb * 2; }
    __device__ __forceinline__ bool next(int i, Unit& u) const {
        const long L = (long)i * G + c; if (L >= nwg) return false;
        tile_of((int)L, nM, nN, u.pm, u.pn); u.z = 0; return true;
    }
    __device__ __forceinline__ size_t a_off(const Unit& u) const { return (size_t)u.pm * a_tile; }
    __device__ __forceinline__ size_t b_off(const Unit& u) const { return (size_t)u.pn * b_tile; }
};
struct InOrder {
    int G, c; size_t a_tile, b_tile;
    __device__ __forceinline__ bool next(int i, Unit& u) const {
        const long L = (long)i * G + c; if (L >= 1152 + 48) return false;
        if (L < 1152) { tile_of((int)L, 64, 18, u.pm, u.pn); } else { const int j = (int)L - 1152; u.pm = 64 + (j & 7); u.pn = 2 + (j >> 3); }
        u.z = 0; return true;
    }
    __device__ __forceinline__ size_t a_off(const Unit& u) const { return (size_t)u.pm * a_tile; }
    __device__ __forceinline__ size_t b_off(const Unit& u) const { return (size_t)u.pn * b_tile; }
};
struct DftOrder {
    int G, c; size_t a_tile, b_tile;
    __device__ __forceinline__ bool next(int i, Unit& u) const {
        const long L = (long)i * G + c; if (L >= 128) return false;
        u.z = (int)L >> 4; u.pm = ((int)L >> 1) & 7; u.pn = (int)L & 1; return true;
    }
    __device__ __forceinline__ size_t a_off(const Unit& u) const { return (size_t)u.pm * a_tile; }
    __device__ __forceinline__ size_t b_off(const Unit& u) const { return (size_t)u.pn * b_tile + (size_t)u.z * 4096 * 2; }
};

__device__ __forceinline__ unsigned cvt_pk_bf16(float lo, float hi) { unsigned r; asm volatile("v_cvt_pk_bf16_f32 %0, %1, %2" : "=v"(r) : "v"(lo), "v"(hi)); return r; }

template <class F> struct Epi8 {
    static constexpr bool PERM = true;
    F f;
    __device__ __forceinline__ void operator()(const f32x4 (&acc)[2][2][4][2], const Unit& u, int wr, int wc, int fr, int fq) const {
        const int row0 = u.pm * BM + wr * 64 + fr, col0 = u.pn * BM + wc * 32 + 8 * fq;
#pragma unroll
        for (int ai = 0; ai < 2; ++ai)
#pragma unroll
            for (int m = 0; m < 4; ++m) {
#pragma unroll
                for (int bj = 0; bj < 2; ++bj) f(u, row0 + ai * HALF + m * 16, col0 + bj * HALF, acc[ai][bj][m][0], acc[ai][bj][m][1]);
                asm volatile("" ::: "memory");
            }
    }
};

template <class Epi, class Sched, bool ALIGN_EPI = false, bool SP2 = false>
__device__ __forceinline__ void gemm_phase(PG8_LAS unsigned char* lds, const Gemm g, const Sched& S, const Epi& E) {
    int tid_ = threadIdx.x; asm volatile("" : "+v"(tid_));
    const int tid = tid_, wid = __builtin_amdgcn_readfirstlane(tid >> 6), lane = tid & 63, wr = wid >> 2, wc = wid & 3, fr = lane & 15, fq = lane >> 4;
    const int K = g.K, nt = K / BK;
    unsigned voffA[2], voffB[2];
#pragma unroll
    for (int i = 0; i < 2; ++i) { int R, C; stage_rc(tid * 16 + i * 8192, R, C); const int Rb = Epi::PERM ? ((R & ~31) + perm32(R & 31)) : R;
        voffA[i] = (unsigned)(R * g.lda + C) * 2u; voffB[i] = (unsigned)(Rb * g.ldb + C) * 2u; }
    const size_t kstep = (size_t)(BK * 2);
    const size_t hstepA = (size_t)HALF * g.lda * 2, hstepB = (size_t)HALF * g.ldb * 2;
    const unsigned ldsw = (unsigned)wid * 1024u;
    const int aoff = lds_byte(wr * 64 + fr, fq * 8), boff = lds_byte(wc * 32 + fr, fq * 8);
#define PG8_SA(b, h) (((b) * 2 + (h)) * HTB)
#define PG8_SB(b, h) ((4 + (b) * 2 + (h)) * HTB)
#define PG8_STAGE(bufoff, gbase, voff) do { _Pragma("unroll") for (int _i = 0; _i < 2; ++_i) \
        __builtin_amdgcn_global_load_lds((const unsigned*)((const char*)(gbase) + (voff)[_i]), (PG8_LAS unsigned*)(lds + (bufoff) + ldsw + _i * 8192), 16, 0, 0); } while (0)
#define PG8_LDA(dst, b, h) do { _Pragma("unroll") for (int m = 0; m < 4; ++m) _Pragma("unroll") for (int k = 0; k < 2; ++k) dst[m][k] = *(const PG8_LAS bf16x8*)(lds + PG8_SA(b, h) + aoff + m * 2048 + k * 1024); } while (0)
#define PG8_LDB(dst, b, h) do { _Pragma("unroll") for (int n = 0; n < 2; ++n) _Pragma("unroll") for (int k = 0; k < 2; ++k) dst[n][k] = *(const PG8_LAS bf16x8*)(lds + PG8_SB(b, h) + boff + n * 2048 + k * 1024); } while (0)
#define PG8_MMA(ai, bj, At, Bt) do { __builtin_amdgcn_s_setprio(1); _Pragma("unroll") for (int m = 0; m < 4; ++m) _Pragma("unroll") for (int n = 0; n < 2; ++n) _Pragma("unroll") for (int k = 0; k < 2; ++k) \
        acc[ai][bj][m][n] = __builtin_amdgcn_mfma_f32_16x16x32_bf16(Bt[n][k], At[m][k], acc[ai][bj][m][n], 0, 0, 0); __builtin_amdgcn_s_setprio(0); } while (0)
#define PG8_WAIT_V(n) asm volatile("s_waitcnt vmcnt(" #n ")" ::: "memory")
#define PG8_WAIT_L(n) asm volatile("s_waitcnt lgkmcnt(" #n ")" ::: "memory")
#define PG8_BAR __builtin_amdgcn_s_barrier()
#define PG8_SCHED __builtin_amdgcn_sched_barrier(0)
    Unit cur, nxt; int ui = 0;
    if (!S.next(0, cur)) return;
    f32x4 acc[2][2][4][2];
#pragma unroll
    for (int a = 0; a < 2; ++a)
#pragma unroll
        for (int b = 0; b < 2; ++b)
#pragma unroll
            for (int m = 0; m < 4; ++m)
#pragma unroll
                for (int n = 0; n < 2; ++n) acc[a][b][m][n] = (f32x4){0.f, 0.f, 0.f, 0.f};
    bf16x8 At[4][2], B0[2][2], B1[2][2];
    const char* cA = (const char*)g.A + S.a_off(cur); const char* cB = (const char*)g.Bt + S.b_off(cur);
    if constexpr (SP2) {
        PG8_STAGE(PG8_SB(0, 0), cB, voffB); PG8_STAGE(PG8_SB(0, 1), cB + hstepB, voffB); PG8_STAGE(PG8_SA(0, 0), cA, voffA); PG8_STAGE(PG8_SA(0, 1), cA + hstepA, voffA);
        if (wr == 1) PG8_BAR;
        PG8_WAIT_V(2); PG8_BAR;
        PG8_STAGE(PG8_SB(1, 0), cB + kstep, voffB); PG8_STAGE(PG8_SA(1, 0), cA + kstep, voffA); PG8_STAGE(PG8_SB(1, 1), cB + hstepB + kstep, voffB);
        PG8_WAIT_V(6); PG8_BAR;
    } else {
        PG8_STAGE(PG8_SB(0, 0), cB, voffB); PG8_STAGE(PG8_SA(0, 0), cA, voffA); PG8_STAGE(PG8_SB(0, 1), cB + hstepB, voffB); PG8_STAGE(PG8_SA(0, 1), cA + hstepA, voffA);
        if (wr == 1) PG8_BAR;
        PG8_WAIT_V(4); PG8_BAR;
        PG8_STAGE(PG8_SB(1, 0), cB + kstep, voffB); PG8_STAGE(PG8_SA(1, 0), cA + kstep, voffA); PG8_STAGE(PG8_SB(1, 1), cB + hstepB + kstep, voffB);
        PG8_WAIT_V(6); PG8_BAR;
    }
    for (;;) {
        const bool has_next = S.next(ui + 1, nxt);
        const char* nA = has_next ? (const char*)g.A + S.a_off(nxt) : cA; const char* nB = has_next ? (const char*)g.Bt + S.b_off(nxt) : cB;
        for (int t = 0; t < nt; t += 2) {
            const bool last = (t == nt - 2);
            const char* a1 = cA + (size_t)(t + 1) * kstep;
            const char* a2 = last ? nA : cA + (size_t)(t + 2) * kstep; const char* b2 = last ? nB : cB + (size_t)(t + 2) * kstep;
            const char* a3 = a2 + kstep; const char* b3 = b2 + kstep;
            if constexpr (SP2) {
            PG8_LDB(B0, 0, 0); PG8_LDB(B1, 0, 1); PG8_SCHED; PG8_LDA(At, 0, 0); PG8_STAGE(PG8_SA(1, 1), a1 + hstepA, voffA);
            PG8_WAIT_V(8); PG8_WAIT_L(0); PG8_BAR; PG8_MMA(0, 0, At, B0); PG8_MMA(0, 1, At, B1); PG8_BAR; PG8_SCHED;
            PG8_LDA(At, 0, 1); PG8_STAGE(PG8_SB(0, 0), b2, voffB); PG8_STAGE(PG8_SB(0, 1), b2 + hstepB, voffB); PG8_STAGE(PG8_SA(0, 0), a2, voffA);
            PG8_WAIT_V(8); PG8_WAIT_L(0); PG8_BAR; PG8_MMA(1, 0, At, B0); PG8_MMA(1, 1, At, B1); PG8_BAR; PG8_SCHED;
            PG8_LDB(B0, 1, 0); PG8_LDB(B1, 1, 1); PG8_SCHED; PG8_LDA(At, 1, 0); PG8_STAGE(PG8_SA(0, 1), a2 + hstepA, voffA);
            PG8_WAIT_V(8); PG8_WAIT_L(0); PG8_BAR; PG8_MMA(0, 0, At, B0); PG8_MMA(0, 1, At, B1); PG8_BAR; PG8_SCHED;
            PG8_LDA(At, 1, 1); PG8_STAGE(PG8_SB(1, 0), b3, voffB); PG8_STAGE(PG8_SB(1, 1), b3 + hstepB, voffB); PG8_STAGE(PG8_SA(1, 0), a3, voffA);
            PG8_WAIT_V(8); PG8_WAIT_L(0); PG8_BAR; PG8_MMA(1, 0, At, B0); PG8_MMA(1, 1, At, B1); PG8_BAR; PG8_SCHED;
            } else {
            PG8_LDB(B0, 0, 0); PG8_SCHED; PG8_LDA(At, 0, 0); PG8_STAGE(PG8_SA(1, 1), a1 + hstepA, voffA);
            PG8_WAIT_L(8); PG8_BAR; PG8_WAIT_L(0); PG8_MMA(0, 0, At, B0); PG8_BAR; PG8_SCHED;
            PG8_LDB(B1, 0, 1); PG8_STAGE(PG8_SB(0, 0), b2, voffB);
            PG8_BAR; PG8_WAIT_L(0); PG8_MMA(0, 1, At, B1); PG8_BAR;
            PG8_LDA(At, 0, 1); PG8_STAGE(PG8_SA(0, 0), a2, voffA);
            PG8_BAR; PG8_WAIT_L(0); PG8_MMA(1, 0, At, B0); PG8_BAR; PG8_SCHED;
            PG8_STAGE(PG8_SB(0, 1), b2 + hstepB, voffB);
            PG8_WAIT_V(6); PG8_BAR; PG8_MMA(1, 1, At, B1); PG8_BAR;
            PG8_LDB(B0, 1, 0); PG8_SCHED; PG8_LDA(At, 1, 0); PG8_STAGE(PG8_SA(0, 1), a2 + hstepA, voffA);
            PG8_WAIT_L(8); PG8_BAR; PG8_WAIT_L(0); PG8_MMA(0, 0, At, B0); PG8_BAR; PG8_SCHED;
            PG8_LDB(B1, 1, 1); PG8_STAGE(PG8_SB(1, 0), b3, voffB);
            PG8_BAR; PG8_WAIT_L(0); PG8_MMA(0, 1, At, B1); PG8_BAR;
            PG8_LDA(At, 1, 1); PG8_STAGE(PG8_SA(1, 0), a3, voffA);
            PG8_BAR; PG8_WAIT_L(0); PG8_MMA(1, 0, At, B0); PG8_BAR; PG8_SCHED;
            PG8_STAGE(PG8_SB(1, 1), b3 + hstepB, voffB);
            PG8_WAIT_V(6); PG8_BAR; PG8_MMA(1, 1, At, B1); PG8_BAR;
            }
        }
        if constexpr (ALIGN_EPI) { if (wr == 0) PG8_BAR; }
        E(acc, cur, wr, wc, fr, fq);
        if (!has_next) break;
#pragma unroll
        for (int a = 0; a < 2; ++a)
#pragma unroll
            for (int b = 0; b < 2; ++b)
#pragma unroll
                for (int m = 0; m < 4; ++m)
#pragma unroll
                    for (int n = 0; n < 2; ++n) acc[a][b][m][n] = (f32x4){0.f, 0.f, 0.f, 0.f};
        cur = nxt; cA = nA; cB = nB; ++ui;
        if constexpr (ALIGN_EPI) { if (wr == 1) PG8_BAR; }
    }
    PG8_WAIT_V(0);
    if constexpr (!ALIGN_EPI) { if (wr == 0) PG8_BAR; }
    PG8_BAR;
#undef PG8_SA
#undef PG8_SB
#undef PG8_STAGE
#undef PG8_LDA
#undef PG8_LDB
#undef PG8_MMA
#undef PG8_WAIT_V
#undef PG8_WAIT_L
#undef PG8_BAR
#undef PG8_SCHED
}
}

constexpr int DM = 1024, NB = 8, SEQ = 2048, MTOK = NB * SEQ, CTXL = 256, MCTX = NB * CTXL;
constexpr int HGD = 512, DFF = 2816, DFF2 = 5632, INDIM = 5120, NMOD = 6;
constexpr float EPSN = 1e-6f;
constexpr int NWAVES = 8, NTHR = 512;
constexpr int LDS_BYTES = 147456;
#ifndef DUP_MASK
#define DUP_MASK 0
#endif
#define REPS(k) ((((DUP_MASK) >> (k)) & 1) ? 2 : 1)
#ifndef EXTRA_SYNCS
#define EXTRA_SYNCS 0
#endif

constexpr size_t MiB = 1u << 20;
constexpr size_t WS_MX = 0;
constexpr size_t WS_LB = 256 * 1024;
constexpr size_t WS_BAR = 512 * 1024, BAR_BYTES = 16384;
constexpr int MISC_OFF = 131072 + 320;
constexpr size_t WS_WIN = 6 * MiB;
constexpr size_t WS_WPQ = 16 * MiB;
constexpr size_t WS_WA = 18 * MiB, WS_WB = 19 * MiB, WS_WOUT = 20 * MiB;
constexpr size_t WS_CS = 22 * MiB;
constexpr size_t WS_WUP = 6 * MiB;
constexpr size_t WS_WDN = 17 * MiB;
constexpr size_t WS_HX = 38 * MiB;
constexpr size_t WS_OF = 38 * MiB, WS_OB = 54 * MiB;
constexpr size_t WS_TMP = 38 * MiB;
constexpr size_t WS_H2 = 38 * MiB;
constexpr size_t WS_Q = 74 * MiB, WS_V = 90 * MiB, WS_OG = 106 * MiB, WS_GA = 122 * MiB, WS_GBG = 154 * MiB, WS_PQT = 186 * MiB;
constexpr size_t WS_GFC = 218 * MiB, WS_GBC = 222 * MiB, WS_VC = 226 * MiB;
constexpr size_t WS_YF = 228 * MiB;
constexpr size_t WS_YH = 74 * MiB;
constexpr size_t WS_MRG = 186 * MiB;
constexpr size_t WS_Z = 74 * MiB;
constexpr size_t WS_A2 = 162 * MiB;
constexpr size_t WS_END = 256 * MiB;

typedef unsigned short bf16;
typedef float f32x4 __attribute__((ext_vector_type(4)));
typedef unsigned u32x4 __attribute__((ext_vector_type(4)));
typedef unsigned u32x2 __attribute__((ext_vector_type(2)));
#define LAS __attribute__((address_space(3)))

struct Params {
    const float* in[19];
    float* out;
    unsigned char* ws;
};

__device__ __forceinline__ float bf2f(unsigned short b) { return __uint_as_float(((unsigned)b) << 16); }
__device__ __forceinline__ float bflo(unsigned w) { return __uint_as_float(w << 16); }
__device__ __forceinline__ float bfhi(unsigned w) { return __uint_as_float(w & 0xffff0000u); }
__device__ __forceinline__ unsigned f2bf(float f) { unsigned u = __float_as_uint(f); return (u + 0x7fffu + ((u >> 16) & 1u)) >> 16; }
__device__ __forceinline__ unsigned pk2(float lo, float hi) { return f2bf(lo) | (f2bf(hi) << 16); }
__device__ __forceinline__ float sigmoidf_(float x) { return 1.f / (1.f + __expf(-x)); }
__device__ __forceinline__ float siluf_(float x) { return x / (1.f + __expf(-x)); }
__device__ __forceinline__ float wave_sum(float v) {
#pragma unroll
    for (int o = 1; o < 64; o <<= 1) v += __shfl_xor(v, o);
    return v;
}
__device__ __forceinline__ u32x4 pack8(const f32x4 a, const f32x4 b) { u32x4 w; w.x = pk2(a[0], a[1]); w.y = pk2(a[2], a[3]); w.z = pk2(b[0], b[1]); w.w = pk2(b[2], b[3]); return w; }

typedef __attribute__((address_space(1))) unsigned gu32;
#define XB_TMO      128
#define XB_XCNT(j)  (256  + 64 * (j))
#define XB_XSUB(j)  (1280 + 64 * (j))
#define XB_XGEN(j)  (2304 + 64 * (j))
#define XB_TOP      3328
#define XB_TOPGEN   3392
#define XCD_BAR_WORDS 3456
#define XB_SPIN_CAP (1u << 18)

__device__ __forceinline__ unsigned xb_ld(unsigned* p)              { return __hip_atomic_load(p, __ATOMIC_RELAXED, __HIP_MEMORY_SCOPE_AGENT); }
__device__ __forceinline__ unsigned xb_add(unsigned* p, unsigned v) { return __hip_atomic_fetch_add(p, v, __ATOMIC_RELAXED, __HIP_MEMORY_SCOPE_AGENT); }
__device__ __forceinline__ unsigned xb_xcc_id() { return (unsigned)__builtin_amdgcn_s_getreg((3 << 11) | 20) & 0xFu; }
#define XB_SPIN(cond, bar) do { unsigned _sp = 0; while (cond) { __builtin_amdgcn_s_sleep(1); \
    if ((++_sp & 255u) == 0u) { if (xb_ld(&(bar)[XB_TMO])) break; if (_sp > XB_SPIN_CAP) { atomicAdd(&(bar)[XB_TMO], 1u); break; } } } } while (0)

struct XcdBarrier {
    unsigned* bar; unsigned x;
    volatile LAS unsigned* st;
};

__device__ __forceinline__ XcdBarrier xcd_barrier_post(unsigned* bar, volatile LAS unsigned* st) {
    XcdBarrier b; b.bar = bar; b.x = xb_xcc_id(); b.st = st;
    if (threadIdx.x == 0) (void)xb_add(&bar[XB_XCNT(b.x)], 1u);
    return b;
}
__device__ __forceinline__ void xcd_barrier_complete(unsigned* bar, unsigned x, unsigned& nloc, unsigned& nx) {
    const unsigned G = gridDim.x * gridDim.y * gridDim.z;
    unsigned sum, cnt, mine, sp = 0u;
    for (;;) {
        sum = 0u; cnt = 0u; mine = 0u;
#pragma unroll
        for (unsigned j = 0; j < 16; ++j) { const unsigned c = xb_ld(&bar[XB_XCNT(j)]); sum += c; cnt += (c > 0u) ? 1u : 0u; mine = (j == x) ? c : mine; }
        if (sum == G) break;
        __builtin_amdgcn_s_sleep(1);
        if ((++sp & 255u) == 0u) { if (xb_ld(&bar[XB_TMO])) break; if (sp > XB_SPIN_CAP) { atomicAdd(&bar[XB_TMO], 1u); break; } }
    }
    nloc = mine > 0u ? mine : 1u; nx = cnt > 0u ? cnt : 1u;
}

__device__ __forceinline__ void xcd_barrier(const XcdBarrier& b) {
    asm volatile("s_waitcnt vmcnt(0)" ::: "memory");
    __syncthreads();
    if (threadIdx.x == 0) {
        unsigned* bar = b.bar;
        __builtin_amdgcn_s_waitcnt(0);
        unsigned nloc = b.st[0], nx = b.st[1];
        if (nloc == 0u) { xcd_barrier_complete(bar, b.x, nloc, nx); b.st[0] = nloc; b.st[1] = nx; }
        const unsigned old = xb_add(&bar[XB_XSUB(b.x)], 1u);
        const unsigned gen = old / nloc;
        if (old + 1u == (gen + 1u) * nloc) {
            __builtin_amdgcn_fence(__ATOMIC_RELEASE, "agent");
            asm volatile("s_waitcnt vmcnt(0)" ::: "memory");
            const unsigned og = xb_add(&bar[XB_TOP], 1u);
            const unsigned tg = og / nx;
            if (og + 1u == (tg + 1u) * nx) xb_add(&bar[XB_TOPGEN], 1u);
            else XB_SPIN(xb_ld(&bar[XB_TOPGEN]) == tg, bar);
            __builtin_amdgcn_fence(__ATOMIC_ACQUIRE, "agent");
            xb_add(&bar[XB_XGEN(b.x)], 1u);
            asm volatile("s_waitcnt vmcnt(0)" ::: "memory");
        } else {
            XB_SPIN(xb_ld(&bar[XB_XGEN(b.x)]) == gen, bar);
            __builtin_amdgcn_fence(__ATOMIC_ACQUIRE, "agent");
            asm volatile("s_waitcnt vmcnt(0)" ::: "memory");
        }
    }
    __syncthreads();
}


struct FIn {
    unsigned char* ws; float* out;
    __device__ __forceinline__ void operator()(const pg8::Unit& u, int row, int col, f32x4 v0, f32x4 v1) const {
        const int seg = u.pn >> 1, c = col & 511;
        if (seg == 0 || seg == 4) { f32x4 a, b;
#pragma unroll
            for (int i = 0; i < 4; ++i) { a[i] = siluf_(v0[i]); b[i] = siluf_(v1[i]); }
            bf16* dst = (bf16*)(ws + (seg == 0 ? WS_Q : WS_OG));
            *(u32x4*)(dst + (size_t)row * 512 + c) = pack8(a, b);
        } else if (seg == 1 || seg == 2) {
            const float* lb = (const float*)(ws + WS_LB);
            const f32x4 l0 = *(const f32x4*)(lb + c), l1 = *(const f32x4*)(lb + c + 4); f32x4 a, b;
#pragma unroll
            for (int i = 0; i < 4; ++i) { a[i] = l0[i] + (1.f - l0[i]) * sigmoidf_(v0[i]); b[i] = l1[i] + (1.f - l1[i]) * sigmoidf_(v1[i]); }
            float* dst;
            if (u.pm < 64) dst = out + (seg == 1 ? (size_t)0 : (size_t)MTOK * 512) + (size_t)row * 512 + c;
            else dst = (float*)(ws + (seg == 1 ? WS_GFC : WS_GBC)) + (size_t)(row - MTOK) * 512 + c;
            *(f32x4*)dst = a; *(f32x4*)(dst + 4) = b;
        } else if (seg == 3) {
            bf16* dst;
            if (u.pm < 64) dst = (bf16*)(ws + WS_V) + (size_t)row * 512 + c; else dst = (bf16*)(ws + WS_VC) + (size_t)(row - MTOK) * 512 + c;
            *(u32x4*)dst = pack8(v0, v1);
        } else { f32x4 a, b;
#pragma unroll
            for (int i = 0; i < 4; ++i) { a[i] = sigmoidf_(v0[i]); b[i] = sigmoidf_(v1[i]); }
            bf16* dst = (seg < 7) ? ((bf16*)(ws + WS_GA) + (size_t)row * 1024 + (col - 5 * 512)) : ((bf16*)(ws + WS_GBG) + (size_t)row * 1024 + (col - 7 * 512));
            *(u32x4*)dst = pack8(a, b);
        }
    }
};
struct FPQ {
    bf16* pqt;
    __device__ __forceinline__ void operator()(const pg8::Unit&, int row, int col, f32x4 v0, f32x4 v1) const {
        *(u32x4*)(pqt + (size_t)(row & 511) * 32768 + (size_t)(col >> 11) * 4096 + (size_t)(row >> 9) * 2048 + (col & 2047)) = pack8(v0, v1);
    }
};
struct FDft {
    bf16* yf;
    __device__ __forceinline__ void operator()(const pg8::Unit& u, int row, int col, f32x4 v0, f32x4 v1) const {
        *(u32x4*)(yf + ((size_t)u.z * SEQ + row) * 512 + col) = pack8(v0 * (1.f / 512.f), v1 * (1.f / 512.f));
    }
};
struct FYa {
    const bf16* ga; bf16* tmp;
    __device__ __forceinline__ void operator()(const pg8::Unit&, int row, int col, f32x4 v0, f32x4 v1) const {
        const size_t o = (size_t)row * 1024 + col; const u32x4 g = *(const u32x4*)(ga + o);
        f32x4 a, b; a[0] = v0[0] * bflo(g.x); a[1] = v0[1] * bfhi(g.x); a[2] = v0[2] * bflo(g.y); a[3] = v0[3] * bfhi(g.y);
        b[0] = v1[0] * bflo(g.z); b[1] = v1[1] * bfhi(g.z); b[2] = v1[2] * bflo(g.w); b[3] = v1[3] * bfhi(g.w);
        *(u32x4*)(tmp + o) = pack8(a, b);
    }
};
struct FYb {
    const bf16* gbg; const bf16* tmp; bf16* mrg;
    __device__ __forceinline__ void operator()(const pg8::Unit&, int row, int col, f32x4 v0, f32x4 v1) const {
        const size_t o = (size_t)row * 1024 + col; const u32x4 g = *(const u32x4*)(gbg + o); const u32x4 t = *(const u32x4*)(tmp + o);
        f32x4 a, b; a[0] = bflo(t.x) + v0[0] * bflo(g.x); a[1] = bfhi(t.x) + v0[1] * bfhi(g.x); a[2] = bflo(t.y) + v0[2] * bflo(g.y); a[3] = bfhi(t.y) + v0[3] * bfhi(g.y);
        b[0] = bflo(t.z) + v1[0] * bflo(g.z); b[1] = bfhi(t.z) + v1[1] * bfhi(g.z); b[2] = bflo(t.w) + v1[2] * bflo(g.w); b[3] = bfhi(t.w) + v1[3] * bfhi(g.w);
        *(u32x4*)(mrg + o) = pack8(a, b);
    }
};
struct FRes {
    const float* src; float* dst; const float* mx; int mod;
    __device__ __forceinline__ void operator()(const pg8::Unit&, int row, int col, f32x4 v0, f32x4 v1) const {
        const size_t o = (size_t)row * 1024 + col; const float* m = mx + (size_t)(row >> 11) * (NMOD * DM) + mod * DM + col;
        const f32x4 m0 = *(const f32x4*)m, m1 = *(const f32x4*)(m + 4), s0 = *(const f32x4*)(src + o), s1 = *(const f32x4*)(src + o + 4);
        *(f32x4*)(dst + o) = s0 + m0 * v0; *(f32x4*)(dst + o + 4) = s1 + m1 * v1;
    }
};
struct FUp {
    bf16* z;
    __device__ __forceinline__ void operator()(const pg8::Unit&, int row, int col, f32x4 v0, f32x4 v1) const {
        *(u32x4*)(z + (size_t)row * DFF2 + col) = pack8(v0, v1);
    }
};

__device__ __forceinline__ void transpose_item(const float* W, int K, int N, bf16* WT, LAS float* scr, int item, int lane) {
    const int nblk = N / 32, kb = item / nblk, nb = item % nblk, k0 = 64 * kb, n0 = 32 * nb;
#pragma unroll 8
    for (int i = 0; i < 32; ++i) { const int kk = 2 * i + (lane >> 5); scr[kk * 33 + (lane & 31)] = W[(size_t)(k0 + kk) * N + n0 + (lane & 31)]; }
    asm volatile("s_waitcnt lgkmcnt(0)" ::: "memory");
    const int c = lane & 7;
#pragma unroll
    for (int j = 0; j < 4; ++j) { const int n = (lane >> 3) + 8 * j; const LAS float* s = scr + (8 * c) * 33 + n;
        u32x4 o; o.x = pk2(s[0 * 33], s[1 * 33]); o.y = pk2(s[2 * 33], s[3 * 33]); o.z = pk2(s[4 * 33], s[5 * 33]); o.w = pk2(s[6 * 33], s[7 * 33]);
        *(u32x4*)(WT + (size_t)(n0 + n) * K + k0 + 8 * c) = o; }
    asm volatile("s_waitcnt lgkmcnt(0)" ::: "memory");
}

__device__ __forceinline__ void norm_mod_row(const float* xrow, const float* g, const float* shift, const float* scale, bf16* orow, int lane) {
    f32x4 v[4]; float s = 0.f;
#pragma unroll
    for (int j = 0; j < 4; ++j) { v[j] = *(const f32x4*)(xrow + (lane + 64 * j) * 4); s += (v[j][0] * v[j][0] + v[j][1] * v[j][1]) + (v[j][2] * v[j][2] + v[j][3] * v[j][3]); }
    const float rinv = rsqrtf(wave_sum(s) * (1.f / DM) + EPSN);
#pragma unroll
    for (int j = 0; j < 4; ++j) { const int e = (lane + 64 * j) * 4;
        const f32x4 gg = *(const f32x4*)(g + e), sh = *(const f32x4*)(shift + e), sc = *(const f32x4*)(scale + e);
        const f32x4 h = v[j] * rinv * gg * (sc + 1.f) + sh;
        u32x2 w; w.x = pk2(h[0], h[1]); w.y = pk2(h[2], h[3]); *(u32x2*)(orow + e) = w; }
}

__device__ __forceinline__ void phase0(const Params& p, unsigned char* lds, int tid, int lane, int wave, int G) {
    float* ldsf = (float*)lds;
    float* mxo = (float*)(p.ws + WS_MX);
    for (int it = blockIdx.x; it < 256; it += G) {
        __syncthreads();
        if (it < 192) {
            const float* c = p.in[1]; const float* cc = p.in[3]; const float* aw = p.in[4]; const float* ab = p.in[5];
            float* sc = ldsf;
            float* red = ldsf + 9 * 1024;
            for (int i = tid; i < 9 * 1024; i += NTHR) { const int r = i >> 10, k = i & 1023; const float cv = (r < 8) ? c[r * 1024 + k] : cc[k]; sc[i] = cv / (1.f + __expf(-cv)); }
            __syncthreads();
            const int n0 = it * 32, col = tid & 31, ks = tid >> 5;
            float a[9];
#pragma unroll
            for (int r = 0; r < 9; ++r) a[r] = 0.f;
            for (int k = ks * 64; k < ks * 64 + 64; ++k) { const float w = aw[(size_t)k * (NMOD * DM) + n0 + col];
#pragma unroll
                for (int r = 0; r < 9; ++r) a[r] += sc[r * 1024 + k] * w; }
#pragma unroll
            for (int r = 0; r < 9; ++r) red[(ks * 9 + r) * 32 + col] = a[r];
            __syncthreads();
            if (tid < 288) { const int r = tid >> 5, cl = tid & 31; float s = ab[n0 + cl];
                for (int k2 = 0; k2 < 16; ++k2) s += red[(k2 * 9 + r) * 32 + cl];
                mxo[r * (NMOD * DM) + n0 + cl] = s; }
        } else {
            const int w = it - 192, kb = w >> 2, g = w & 3, k0 = kb * 64;
            const float* win = p.in[7];
            float* wt = ldsf;
            float* tabc = ldsf + 64 * 129; float* tabs = tabc + 128;
            for (int i = tid; i < 64 * 128; i += NTHR) { const int kk = i >> 7, cc = i & 127; wt[kk * 129 + cc] = win[(size_t)(k0 + kk) * INDIM + g * 128 + cc]; }
            if (tid < 128) { tabc[tid] = cospif((float)tid * (1.f / 64.f)); tabs[tid] = sinpif((float)tid * (1.f / 64.f)); }
            __syncthreads();
            bf16* wpq = (bf16*)(p.ws + WS_WPQ);
            const int kk = tid & 63, jj = tid >> 6;
            for (int j = jj; j < 128; j += 8) { float aP = 0.f, aQ = 0.f;
                for (int cI = 0; cI < 128; ++cI) { const float wv = wt[kk * 129 + cI]; const int idx = (cI * j) & 127; aP += wv * tabc[idx]; aQ += wv * tabs[idx]; }
                wpq[(size_t)(g * 128 + j) * 1024 + k0 + kk] = (bf16)f2bf(aP);
                wpq[(size_t)(512 + g * 128 + j) * 1024 + k0 + kk] = (bf16)f2bf(aQ); }
        }
    }
    __syncthreads();
    if (blockIdx.x == 0) { const float* hl = p.in[8]; float* lbo = (float*)(p.ws + WS_LB);
        if (tid < 512) { const float a = hl[tid], b = hl[512 + tid]; lbo[tid] = 1.f / (1.f + expf(b - a)); } }
    { bf16* cs = (bf16*)(p.ws + WS_CS);
      for (int i = blockIdx.x * NTHR + tid; i < 2048 * 512; i += G * NTHR) { const int l = i >> 9, kc = (i & 511) * 8; float vv[8];
#pragma unroll
          for (int e = 0; e < 8; ++e) { const int k = kc + e, s = k >> 11, kk = k & 2047, ph = (l * kk) & 2047; const float ang = (float)ph * (1.f / 1024.f); vv[e] = s ? -sinpif(ang) : cospif(ang); }
          u32x4 w; w.x = pk2(vv[0], vv[1]); w.y = pk2(vv[2], vv[3]); w.z = pk2(vv[4], vv[5]); w.w = pk2(vv[6], vv[7]);
          *(u32x4*)(cs + (size_t)l * 4096 + kc) = w; } }
    { LAS float* scr = (LAS float*)((LAS unsigned char*)lds + wave * 16384);
      const int gw = blockIdx.x * NWAVES + wave, NGW = G * NWAVES;
      constexpr int I_IN = 16 * 160, I_A = 8 * 32, I_B = 8 * 32, I_O = 16 * 32;
      for (int it = gw; it < I_IN + I_A + I_B + I_O; it += NGW) { int r = it;
          if (r < I_IN) { transpose_item(p.in[7], 1024, INDIM, (bf16*)(p.ws + WS_WIN), scr, r, lane); continue; } r -= I_IN;
          if (r < I_A) { transpose_item(p.in[10], 512, 1024, (bf16*)(p.ws + WS_WA), scr, r, lane); continue; } r -= I_A;
          if (r < I_B) { transpose_item(p.in[11], 512, 1024, (bf16*)(p.ws + WS_WB), scr, r, lane); continue; } r -= I_B;
          transpose_item(p.in[12], 1024, 1024, (bf16*)(p.ws + WS_WOUT), scr, r, lane); } }
}

__device__ __forceinline__ void hgrn_mfma_item(const Params& p, unsigned char* lds, int item) {
    int tid_ = threadIdx.x; asm volatile("" : "+v"(tid_));
    const int tid = tid_, lane = tid & 63, w = __builtin_amdgcn_readfirstlane(tid >> 6), fr = lane & 15, fq = lane >> 4;
    const int vh = item & 1, dir = (item >> 1) & 1, h = (item >> 2) & 3, b = item >> 4;
    bf16* Qs = (bf16*)lds;
    bf16* Ks = Qs + 64 * 136;
    bf16* St = Ks + 64 * 136;
    bf16* Kh = St + 2 * 64 * 136;
    bf16* Vt = Kh + 128 * 72;
    bf16* Ps = Vt + 64 * 72;
    float* Et = (float*)(Ps + 64 * 72);
    const int d = 16 * w + fr;
    const float* fL = p.out + (dir ? (size_t)MTOK * 512 : 0) + (size_t)b * SEQ * 512 + h * 128 + d;
    const float* fC = (const float*)(p.ws + (dir ? WS_GBC : WS_GFC)) + (size_t)b * CTXL * 512 + h * 128 + d;
    const bf16* qL = (const bf16*)(p.ws + WS_Q) + (size_t)b * SEQ * 512 + h * 128 + d;
    const bf16* vL = (const bf16*)(p.ws + WS_V) + (size_t)b * SEQ * 512 + h * 128 + vh * 64 + lane;
    const bf16* vC = (const bf16*)(p.ws + WS_VC) + (size_t)b * CTXL * 512 + h * 128 + vh * 64 + lane;
    bf16* oL = (bf16*)(p.ws + (dir ? WS_OB : WS_OF)) + (size_t)b * SEQ * 512 + h * 128 + vh * 64;
    f32x4 Sa[4];
#pragma unroll
    for (int i = 0; i < 4; ++i) Sa[i] = (f32x4){0.f, 0.f, 0.f, 0.f};
    float fr_[16]; unsigned short qr_[16], vr_[8];
#define HG_LOAD(cc_) do { const int _cc = (cc_); const bool _lat = _cc >= 4; const int _c = _lat ? _cc - 4 : _cc, _n = _lat ? SEQ : CTXL; \
        const float* _f = _lat ? fL : fC; const bf16* _v = _lat ? vL : vC; \
        _Pragma("unroll") for (int i = 0; i < 16; ++i) { const int _s = _c * 64 + fq * 16 + i, _pos = dir ? (_n - 1 - _s) : _s; fr_[i] = _f[(size_t)_pos * 512]; qr_[i] = _lat ? qL[(size_t)_pos * 512] : (unsigned short)0; } \
        _Pragma("unroll") for (int j = 0; j < 8; ++j) { const int _s = _c * 64 + w * 8 + j, _pos = dir ? (_n - 1 - _s) : _s; vr_[j] = _v[(size_t)_pos * 512]; } } while (0)
    HG_LOAD(0);
    for (int cc = 0; cc < 36; ++cc) {
        const bool lat = cc >= 4; const int c = lat ? cc - 4 : cc;
        bf16* Scur = St + (cc & 1) * (64 * 136); bf16* Snxt = St + ((cc & 1) ^ 1) * (64 * 136);
        {
            float ce[16]; float e = 1.f;
#pragma unroll
            for (int i = 0; i < 16; ++i) { e *= fr_[i]; ce[i] = e; }
            const float T0 = __shfl(e, fr), T1 = __shfl(e, fr + 16), T2 = __shfl(e, fr + 32), T3 = __shfl(e, fr + 48);
            const float pre = (fq == 0) ? 1.f : (fq == 1) ? T0 : (fq == 2) ? T0 * T1 : T0 * T1 * T2;
            const float tot = T0 * T1 * T2 * T3;
            if (fq == 0) Et[d] = tot;
            unsigned khw[8];
#pragma unroll
            for (int i = 0; i < 16; i += 2) { float kh2[2];
#pragma unroll
                for (int u = 0; u < 2; ++u) { const float cm = fmaxf(pre * ce[i + u], 1e-30f), ie = __builtin_amdgcn_rcpf(cm), kt = (1.f - fr_[i + u]) * ie; const int sl = fq * 16 + i + u;
                    if (lat) { Qs[sl * 136 + d] = (bf16)f2bf(bf2f(qr_[i + u]) * cm); Ks[sl * 136 + d] = (bf16)f2bf(kt); }
                    kh2[u] = kt * tot; }
                khw[i >> 1] = pk2(kh2[0], kh2[1]); }
            u32x4 k0; k0.x = khw[0]; k0.y = khw[1]; k0.z = khw[2]; k0.w = khw[3]; u32x4 k1; k1.x = khw[4]; k1.y = khw[5]; k1.z = khw[6]; k1.w = khw[7];
            *(u32x4*)(Kh + d * 72 + fq * 16) = k0; *(u32x4*)(Kh + d * 72 + fq * 16 + 8) = k1;
            u32x4 vv; vv.x = (unsigned)vr_[0] | ((unsigned)vr_[1] << 16); vv.y = (unsigned)vr_[2] | ((unsigned)vr_[3] << 16); vv.z = (unsigned)vr_[4] | ((unsigned)vr_[5] << 16); vv.w = (unsigned)vr_[6] | ((unsigned)vr_[7] << 16);
            *(u32x4*)(Vt + lane * 72 + w * 8) = vv;
        }
        if (cc + 1 < 36) HG_LOAD(cc + 1);
        __syncthreads();
        const int ti = w >> 1, x2 = 2 * (w & 1);
        if (lat) {
#pragma unroll
            for (int u2 = 0; u2 < 2; ++u2) { const int si = x2 + u2; f32x4 acc = (f32x4){0.f, 0.f, 0.f, 0.f};
                if (si <= ti) {
#pragma unroll
                    for (int kk = 0; kk < 4; ++kk) { const pg8::bf16x8 a = *(const pg8::bf16x8*)(Ks + (si * 16 + fr) * 136 + kk * 32 + fq * 8), bq = *(const pg8::bf16x8*)(Qs + (ti * 16 + fr) * 136 + kk * 32 + fq * 8);
                        acc = __builtin_amdgcn_mfma_f32_16x16x32_bf16(a, bq, acc, 0, 0, 0); }
                    if (si == ti) {
#pragma unroll
                        for (int r = 0; r < 4; ++r) if (4 * fq + r > fr) acc[r] = 0.f; } }
                u32x2 pw; pw.x = pk2(acc[0], acc[1]); pw.y = pk2(acc[2], acc[3]);
                *(u32x2*)(Ps + (ti * 16 + fr) * 72 + si * 16 + 4 * fq) = pw; }
        }
        {
            const f32x4 et = *(const f32x4*)(Et + w * 16 + 4 * fq);
            pg8::bf16x8 ka[2];
#pragma unroll
            for (int kk = 0; kk < 2; ++kk) ka[kk] = *(const pg8::bf16x8*)(Kh + (w * 16 + fr) * 72 + kk * 32 + fq * 8);
#pragma unroll
            for (int vi = 0; vi < 4; ++vi) { Sa[vi] = Sa[vi] * et;
#pragma unroll
                for (int kk = 0; kk < 2; ++kk) { const pg8::bf16x8 bv = *(const pg8::bf16x8*)(Vt + (vi * 16 + fr) * 72 + kk * 32 + fq * 8);
                    Sa[vi] = __builtin_amdgcn_mfma_f32_16x16x32_bf16(ka[kk], bv, Sa[vi], 0, 0, 0); }
                u32x2 sw; sw.x = pk2(Sa[vi][0], Sa[vi][1]); sw.y = pk2(Sa[vi][2], Sa[vi][3]);
                *(u32x2*)(Snxt + (vi * 16 + fr) * 136 + w * 16 + 4 * fq) = sw; }
        }
        f32x4 Oa[2];
        Oa[0] = (f32x4){0.f, 0.f, 0.f, 0.f}; Oa[1] = (f32x4){0.f, 0.f, 0.f, 0.f};
        if (lat) {
#pragma unroll
            for (int kk = 0; kk < 4; ++kk) { const pg8::bf16x8 bq = *(const pg8::bf16x8*)(Qs + (ti * 16 + fr) * 136 + kk * 32 + fq * 8);
#pragma unroll
                for (int u2 = 0; u2 < 2; ++u2) { const pg8::bf16x8 a = *(const pg8::bf16x8*)(Scur + ((x2 + u2) * 16 + fr) * 136 + kk * 32 + fq * 8);
                    Oa[u2] = __builtin_amdgcn_mfma_f32_16x16x32_bf16(a, bq, Oa[u2], 0, 0, 0); } }
        }
        __syncthreads();
        if (lat) {
#pragma unroll
            for (int kk = 0; kk < 2; ++kk) { const pg8::bf16x8 bp = *(const pg8::bf16x8*)(Ps + (ti * 16 + fr) * 72 + kk * 32 + fq * 8);
#pragma unroll
                for (int u2 = 0; u2 < 2; ++u2) { const pg8::bf16x8 a = *(const pg8::bf16x8*)(Vt + ((x2 + u2) * 16 + fr) * 72 + kk * 32 + fq * 8);
                    Oa[u2] = __builtin_amdgcn_mfma_f32_16x16x32_bf16(a, bp, Oa[u2], 0, 0, 0); } }
            const int sg = c * 64 + ti * 16 + fr, pos = dir ? (SEQ - 1 - sg) : sg;
#pragma unroll
            for (int u2 = 0; u2 < 2; ++u2) { u32x2 ow; ow.x = pk2(Oa[u2][0], Oa[u2][1]); ow.y = pk2(Oa[u2][2], Oa[u2][3]);
                *(u32x2*)(oL + (size_t)pos * 512 + (x2 + u2) * 16 + 4 * fq) = ow; }
        }
        __syncthreads();
    }
#undef HG_LOAD
}

__device__ __forceinline__ void phase_yh(const Params& p, int lane, int gw, int NGW) {
    const bf16* of = (const bf16*)(p.ws + WS_OF); const bf16* ob = (const bf16*)(p.ws + WS_OB); const bf16* og = (const bf16*)(p.ws + WS_OG);
    bf16* yh = (bf16*)(p.ws + WS_YH); const float* on = p.in[9];
    for (int m = gw; m < MTOK; m += NGW) { const size_t o = (size_t)m * 512 + lane * 8;
        const u32x4 a = *(const u32x4*)(of + o), b = *(const u32x4*)(ob + o), gg = *(const u32x4*)(og + o);
        float v[8]; v[0] = bflo(a.x) + bflo(b.x); v[1] = bfhi(a.x) + bfhi(b.x); v[2] = bflo(a.y) + bflo(b.y); v[3] = bfhi(a.y) + bfhi(b.y);
        v[4] = bflo(a.z) + bflo(b.z); v[5] = bfhi(a.z) + bfhi(b.z); v[6] = bflo(a.w) + bflo(b.w); v[7] = bfhi(a.w) + bfhi(b.w);
        float s = 0.f;
#pragma unroll
        for (int i = 0; i < 8; ++i) s += v[i] * v[i];
        s += __shfl_xor(s, 1); s += __shfl_xor(s, 2); s += __shfl_xor(s, 4); s += __shfl_xor(s, 8);
        const float rinv = rsqrtf(s * (1.f / 128.f) + EPSN);
        const f32x4 n0 = *(const f32x4*)(on + lane * 8), n1 = *(const f32x4*)(on + lane * 8 + 4);
        float gv[8]; gv[0] = bflo(gg.x); gv[1] = bfhi(gg.x); gv[2] = bflo(gg.y); gv[3] = bfhi(gg.y); gv[4] = bflo(gg.z); gv[5] = bfhi(gg.z); gv[6] = bflo(gg.w); gv[7] = bfhi(gg.w);
        f32x4 r0, r1;
#pragma unroll
        for (int i = 0; i < 4; ++i) { r0[i] = v[i] * rinv * n0[i] * gv[i]; r1[i] = v[4 + i] * rinv * n1[i] * gv[4 + i]; }
        *(u32x4*)(yh + o) = pack8(r0, r1); }
}

struct ConvRaw { u32x2 a[3], g[3]; };
__device__ __forceinline__ void conv_issue(const bf16* z, int tokbase, int r, int cc, int ch, ConvRaw& q) {
#pragma unroll
    for (int i = 0; i < 3; ++i) { const int rr = r + i - 1;
        if (rr >= 0 && rr < 32 && cc >= 0 && cc < 64) { const size_t zo = (size_t)(tokbase + rr * 64 + cc) * DFF2 + ch;
            q.a[i] = *(const u32x2*)(z + zo); q.g[i] = *(const u32x2*)(z + zo + DFF);
        } else { q.a[i] = (u32x2){0u, 0u}; q.g[i] = (u32x2){0u, 0u}; } }
}
__device__ __forceinline__ void phase_conv(const Params& p, int hf, int tid, int G) {
    const bf16* z = (const bf16*)(p.ws + WS_Z); bf16* a2 = (bf16*)(p.ws + WS_A2) + (size_t)hf * 8192 * DFF;
    const float* cw = p.in[15]; const float* cb = p.in[16];
    for (int it = blockIdx.x * NTHR + tid; it < 4 * 32 * 4 * 704; it += G * NTHR) {
        const int cg4 = it % 704, rest = it / 704, strip = rest & 3, r = (rest >> 2) & 31, img = rest >> 7, ch = cg4 * 4, c0 = strip * 16, tokbase = img * 2048;
        ConvRaw ring[3];
#pragma unroll
        for (int j = 0; j < 3; ++j) conv_issue(z, tokbase, r, c0 - 1 + j, ch, ring[j]);
        float w1[9][4], w2[9][4];
#pragma unroll
        for (int t = 0; t < 9; ++t) { const f32x4 a = *(const f32x4*)(cw + (size_t)t * DFF2 + ch), g = *(const f32x4*)(cw + (size_t)t * DFF2 + DFF + ch);
#pragma unroll
            for (int e = 0; e < 4; ++e) { w1[t][e] = a[e]; w2[t][e] = g[e]; } }
        const f32x4 b1 = *(const f32x4*)(cb + ch), b2 = *(const f32x4*)(cb + DFF + ch);
        float W1[3][3][4], W2[3][3][4];
#pragma unroll
        for (int j = 0; j < 18; ++j) {
            const int sl = j % 3;
#pragma unroll
            for (int i = 0; i < 3; ++i) { const u32x2 a = ring[j % 3].a[i], g = ring[j % 3].g[i];
                W1[sl][i][0] = bflo(a.x); W1[sl][i][1] = bfhi(a.x); W1[sl][i][2] = bflo(a.y); W1[sl][i][3] = bfhi(a.y);
                W2[sl][i][0] = bflo(g.x); W2[sl][i][1] = bfhi(g.x); W2[sl][i][2] = bflo(g.y); W2[sl][i][3] = bfhi(g.y); }
            if (j + 3 < 18) conv_issue(z, tokbase, r, c0 - 1 + j + 3, ch, ring[j % 3]);
            if (j >= 2) {
                const int sL = (j - 2) % 3, sC = (j - 1) % 3, sR = j % 3;
                float o1[4], o2[4];
#pragma unroll
                for (int e = 0; e < 4; ++e) { o1[e] = b1[e]; o2[e] = b2[e]; }
#pragma unroll
                for (int i = 0; i < 3; ++i)
#pragma unroll
                    for (int e = 0; e < 4; ++e) {
                        o1[e] += W1[sL][i][e] * w1[i * 3 + 0][e] + W1[sC][i][e] * w1[i * 3 + 1][e] + W1[sR][i][e] * w1[i * 3 + 2][e];
                        o2[e] += W2[sL][i][e] * w2[i * 3 + 0][e] + W2[sC][i][e] * w2[i * 3 + 1][e] + W2[sR][i][e] * w2[i * 3 + 2][e]; }
                u32x2 ow; ow.x = pk2(siluf_(o1[0]) * o2[0], siluf_(o1[1]) * o2[1]); ow.y = pk2(siluf_(o1[2]) * o2[2], siluf_(o1[3]) * o2[3]);
                *(u32x2*)(a2 + (size_t)(tokbase + r * 64 + c0 + j - 2) * DFF + ch) = ow;
            }
        }
    }
}

__global__ void __launch_bounds__(NTHR, 2) fwd_mega(Params p) {
    extern __shared__ __attribute__((aligned(16))) unsigned char lds[];
    cg::grid_group grid = cg::this_grid();
    const int tid = threadIdx.x, lane = tid & 63, wave = __builtin_amdgcn_readfirstlane(tid >> 6);
    const int G = gridDim.x, gw = blockIdx.x * NWAVES + wave, NGW = G * NWAVES;
    PG8_LAS unsigned char* ldsl = (PG8_LAS unsigned char*)lds;
    unsigned char* ws = p.ws;
    const float* mx = (const float*)(ws + WS_MX);
    volatile LAS unsigned* misc = (volatile LAS unsigned*)((LAS unsigned char*)lds + MISC_OFF);
    if (tid < 16) misc[tid] = 0u;
    __syncthreads();
    const XcdBarrier xbar = xcd_barrier_post((unsigned*)(ws + WS_BAR), misc + 8);

    for (int rep_ = 0; rep_ < REPS(0); ++rep_) {
    phase0(p, lds, tid, lane, wave, G);
    grid.sync();
    }
    for (int xs_ = 0; xs_ < EXTRA_SYNCS; ++xs_) xcd_barrier(xbar);
    for (int rep_ = 0; rep_ < REPS(1); ++rep_) {
    for (int m = gw; m < MTOK + MCTX; m += NGW) {
        const float* src = (m < MTOK) ? p.in[0] + (size_t)m * DM : p.in[2] + (size_t)(m - MTOK) * DM;
        const int mr = (m < MTOK) ? (m >> 11) : 8;
        norm_mod_row(src, p.in[6], mx + mr * (NMOD * DM), mx + mr * (NMOD * DM) + DM, (bf16*)(ws + WS_HX) + (size_t)m * DM, lane);
    }
    xcd_barrier(xbar);
    }
    for (int rep_ = 0; rep_ < REPS(2); ++rep_) {
    {
        pg8::Gemm g{(const bf16*)(ws + WS_HX), (const bf16*)(ws + WS_WIN) + (size_t)512 * 1024, 1024, 1024, 1024};
        pg8::InOrder S; S.G = G; S.c = blockIdx.x; S.a_tile = (size_t)256 * 1024 * 2; S.b_tile = (size_t)256 * 1024 * 2;
        pg8::Epi8<FIn> E{FIn{ws, p.out}};
        pg8::gemm_phase<pg8::Epi8<FIn>, pg8::InOrder, true, true>(ldsl, g, S, E);
    }
    {
        pg8::Gemm g{(const bf16*)(ws + WS_WPQ), (const bf16*)(ws + WS_HX), 1024, 1024, 1024};
        pg8::StaticOrder S; S.init(4, 64, G, blockIdx.x, 1024, 1024);
        pg8::Epi8<FPQ> E{FPQ{(bf16*)(ws + WS_PQT)}};
        pg8::gemm_phase<pg8::Epi8<FPQ>, pg8::StaticOrder, true, true>(ldsl, g, S, E);
    }
    xcd_barrier(xbar);
    }
    for (int rep_ = 0; rep_ < REPS(3); ++rep_) {
    if (blockIdx.x < 128 && G >= 192) {
        pg8::Gemm g{(const bf16*)(ws + WS_CS), (const bf16*)(ws + WS_PQT), 4096, 4096, 32768};
        pg8::DftOrder S; S.G = 128; S.c = blockIdx.x; S.a_tile = (size_t)256 * 4096 * 2; S.b_tile = (size_t)256 * 32768 * 2;
        pg8::Epi8<FDft> E{FDft{(bf16*)(ws + WS_YF)}};
        pg8::gemm_phase<pg8::Epi8<FDft>, pg8::DftOrder, true, true>(ldsl, g, S, E);
    } else if (G >= 192) {
        for (int it = blockIdx.x - 128; it < 128; it += G - 128) hgrn_mfma_item(p, lds, it);
    } else {
        pg8::Gemm g{(const bf16*)(ws + WS_CS), (const bf16*)(ws + WS_PQT), 4096, 4096, 32768};
        pg8::DftOrder S; S.G = G; S.c = blockIdx.x; S.a_tile = (size_t)256 * 4096 * 2; S.b_tile = (size_t)256 * 32768 * 2;
        pg8::Epi8<FDft> E{FDft{(bf16*)(ws + WS_YF)}};
        pg8::gemm_phase<pg8::Epi8<FDft>, pg8::DftOrder, true, true>(ldsl, g, S, E);
        for (int it = blockIdx.x; it < 128; it += G) hgrn_mfma_item(p, lds, it);
    }
    xcd_barrier(xbar);
    }
    for (int rep_ = 0; rep_ < REPS(4); ++rep_) {
    phase_yh(p, lane, gw, NGW);
    xcd_barrier(xbar);
    }
    for (int rep_ = 0; rep_ < REPS(5); ++rep_) {
    {
        pg8::Gemm g{(const bf16*)(ws + WS_YF), (const bf16*)(ws + WS_WA), 512, 512, 512};
        pg8::StaticOrder S; S.init(64, 4, G, blockIdx.x, 512, 512);
        pg8::Epi8<FYa> E{FYa{(const bf16*)(ws + WS_GA), (bf16*)(ws + WS_TMP)}};
        pg8::gemm_phase<pg8::Epi8<FYa>, pg8::StaticOrder, true, true>(ldsl, g, S, E);
    }
    {
        pg8::Gemm g{(const bf16*)(ws + WS_YH), (const bf16*)(ws + WS_WB), 512, 512, 512};
        pg8::StaticOrder S; S.init(64, 4, G, blockIdx.x, 512, 512);
        pg8::Epi8<FYb> E{FYb{(const bf16*)(ws + WS_GBG), (const bf16*)(ws + WS_TMP), (bf16*)(ws + WS_MRG)}};
        pg8::gemm_phase<pg8::Epi8<FYb>, pg8::StaticOrder, true, true>(ldsl, g, S, E);
    }
    xcd_barrier(xbar);
    }
    for (int rep_ = 0; rep_ < REPS(6); ++rep_) {
    {
        pg8::Gemm g{(const bf16*)(ws + WS_MRG), (const bf16*)(ws + WS_WOUT), 1024, 1024, 1024};
        pg8::StaticOrder S; S.init(64, 4, G, blockIdx.x, 1024, 1024);
        pg8::Epi8<FRes> E{FRes{p.in[0], p.out, mx, 2}};
        pg8::gemm_phase<pg8::Epi8<FRes>, pg8::StaticOrder, true, true>(ldsl, g, S, E);
    }
    xcd_barrier(xbar);
    }
    for (int rep_ = 0; rep_ < REPS(7); ++rep_) {
    for (int m = gw; m < MTOK; m += NGW) {
        const int mr = m >> 11;
        norm_mod_row(p.out + (size_t)m * DM, p.in[13], mx + mr * (NMOD * DM) + 3 * DM, mx + mr * (NMOD * DM) + 4 * DM, (bf16*)(ws + WS_H2) + (size_t)m * DM, lane);
    }
    { LAS float* scr = (LAS float*)((LAS unsigned char*)lds + wave * 16384);
      constexpr int I_UP = 16 * 176, I_DN = 44 * 32;
      for (int it = gw; it < I_UP + I_DN; it += NGW) {
          if (it < I_UP) transpose_item(p.in[14], 1024, DFF2, (bf16*)(ws + WS_WUP), scr, it, lane);
          else transpose_item(p.in[17], DFF, 1024, (bf16*)(ws + WS_WDN), scr, it - I_UP, lane); } }
    xcd_barrier(xbar);
    }
    {
    for (int hf = 0; hf < 2; ++hf) {
        for (int rep_ = 0; rep_ < REPS(8); ++rep_) {
            pg8::Gemm g{(const bf16*)(ws + WS_H2) + (size_t)hf * 8192 * 1024, (const bf16*)(ws + WS_WUP), 1024, 1024, 1024};
            pg8::StaticOrder S; S.init(32, 22, G, blockIdx.x, 1024, 1024);
            pg8::Epi8<FUp> E{FUp{(bf16*)(ws + WS_Z)}};
            pg8::gemm_phase<pg8::Epi8<FUp>, pg8::StaticOrder, true, true>(ldsl, g, S, E);
        xcd_barrier(xbar);
        }
        for (int rep_ = 0; rep_ < REPS(9); ++rep_) {
        phase_conv(p, hf, tid, G);
        xcd_barrier(xbar);
        }
    }
    }
    {
    {
        pg8::Gemm g{(const bf16*)(ws + WS_A2), (const bf16*)(ws + WS_WDN), DFF, DFF, DFF};
        pg8::StaticOrder S; S.init(64, 4, G, blockIdx.x, DFF, DFF);
        pg8::Epi8<FRes> E{FRes{p.out, p.out, mx, 5}};
        pg8::gemm_phase<pg8::Epi8<FRes>, pg8::StaticOrder, true, true>(ldsl, g, S, E);
    }
    }
    xcd_barrier(xbar);
    {
    for (int m = gw; m < MTOK; m += NGW) {
        float* row = p.out + (size_t)m * DM; const float* fg = p.in[18];
        f32x4 v[4]; float s = 0.f;
#pragma unroll
        for (int j = 0; j < 4; ++j) { v[j] = *(const f32x4*)(row + (lane + 64 * j) * 4); s += (v[j][0] * v[j][0] + v[j][1] * v[j][1]) + (v[j][2] * v[j][2] + v[j][3] * v[j][3]); }
        const float rinv = rsqrtf(wave_sum(s) * (1.f / DM) + EPSN);
#pragma unroll
        for (int j = 0; j < 4; ++j) { const int e = (lane + 64 * j) * 4; *(f32x4*)(row + e) = v[j] * rinv * *(const f32x4*)(fg + e); }
    }
    }
}

extern "C" void kernel_launch(void* const* d_in, const int* in_sizes, int n_in, void* d_out, int out_size, void* d_ws, size_t ws_size, hipStream_t stream) {
    static int grid = 0;
    if (grid == 0) {
        if (n_in != 19 || out_size != MTOK * DM || ws_size < WS_END) { fprintf(stderr, "kernel_launch: unexpected problem: n_in %d out %d ws %zu\n", n_in, out_size, ws_size); grid = -1; return; }
        int dev = 0, cus = 0, per_cu = 0;
        hipGetDevice(&dev);
        hipDeviceGetAttribute(&cus, hipDeviceAttributeMultiprocessorCount, dev);
        if (hipFuncSetAttribute((const void*)fwd_mega, hipFuncAttributeMaxDynamicSharedMemorySize, LDS_BYTES) != hipSuccess) { fprintf(stderr, "kernel_launch: hipFuncSetAttribute failed\n"); grid = -1; return; }
        if (hipOccupancyMaxActiveBlocksPerMultiprocessor(&per_cu, (const void*)fwd_mega, NTHR, LDS_BYTES) != hipSuccess || per_cu < 1) { fprintf(stderr, "kernel_launch: occupancy query says %d\n", per_cu); per_cu = 1; }
        (void)hipGetLastError();
        grid = cus * (per_cu > 1 ? 1 : per_cu);
        fprintf(stderr, "kernel_launch: grid %d (cus %d, per_cu %d), ws %zu\n", grid, cus, per_cu, ws_size);
    }
    if (grid < 0) return;
    Params p{};
    for (int i = 0; i < 19; ++i) p.in[i] = (const float*)d_in[i];
    p.out = (float*)d_out; p.ws = (unsigned char*)d_ws;
    if (hipMemsetAsync((char*)d_ws + WS_BAR, 0, BAR_BYTES, stream) != hipSuccess) { fprintf(stderr, "kernel_launch: memset failed\n"); return; }
    void* args[] = {&p};
    hipError_t e = hipLaunchCooperativeKernel((const void*)fwd_mega, dim3(grid), dim3(NTHR), args, LDS_BYTES, stream);
    if (e != hipSuccess) fprintf(stderr, "kernel_launch: cooperative launch failed: %s (grid %d)\n", hipGetErrorString(e), grid);
}
```

```cpp
#include <hip/hip_runtime.h>
#include <hip/hip_cooperative_groups.h>
#include <cstdio>
#include <cstdint>
namespace cg = cooperative_groups;

namespace pg8 {
#define PG8_LAS __attribute__((address_space(3)))
typedef unsigned short bf16_t;
typedef short bf16x8 __attribute__((ext_vector_type(8)));
typedef float f32x4 __attribute__((ext_vector_type(4)));
typedef unsigned u32x4 __attribute__((ext_vector_type(4)));
typedef unsigned u32x2 __attribute__((ext_vector_type(2)));
constexpr int BM = 256, BK = 64, HALF = 128, HTB = HALF * BK * 2  , STAGE_BYTES = 8 * HTB, NXCD = 8, WGM = 8;

__host__ __device__ __forceinline__ int lds_byte(int r, int c) { const int st = (r >> 4) * 2 + (c >> 5), rr = r & 15, cc = c & 31, ob = rr * 64 + cc * 2; return st * 1024 + (ob ^ (((ob >> 9) & 1) << 5)); }
__host__ __device__ __forceinline__ void stage_rc(int b, int& R, int& C) { const int st = b / 1024, sb = b % 1024, swz = sb ^ (((sb >> 9) & 1) << 5); R = (st >> 1) * 16 + swz / 64; C = (st & 1) * 32 + (swz % 64) / 2; }
__host__ __device__ __forceinline__ int perm32(int rho) { const int n = rho >> 4, i = rho & 15; return 8 * (i >> 2) + 4 * n + (i & 3); }

struct Unit { int pm, pn, z; };
struct Gemm { const bf16_t* A; const bf16_t* Bt; int K, lda, ldb; };

__device__ __forceinline__ void tile_of(int wgid, int nM, int nN, int& pm, int& pn) {
    const int nwg = nM * nN;
    { const int q = nwg / NXCD, r = nwg % NXCD, xcd = wgid % NXCD, off = wgid / NXCD; wgid = (xcd < r ? xcd * (q + 1) : r * (q + 1) + (xcd - r) * q) + off; }
    const int nig = WGM * nN, gid = wgid / nig, fm = gid * WGM, gsz = (nM - fm) < WGM ? (nM - fm) : WGM;
    pm = fm + ((wgid % nig) % gsz); pn = (wgid % nig) / gsz;
}
struct StaticOrder {
    int nM, nN, nwg, G, c; size_t a_tile, b_tile;
    __device__ __forceinline__ void init(int nM_, int nN_, int G_, int c_, int lda, int ldb) { nM = nM_; nN = nN_; nwg = nM * nN; G = G_; c = c_; a_tile = (size_t)BM * lda * 2; b_tile = (size_t)BM * ldb * 2; }
    __device__ __forceinline__ bool next(int i, Unit& u) const {
        const long L = (long)i * G + c; if (L >= nwg) return false;
        tile_of((int)L, nM, nN, u.pm, u.pn); u.z = 0; return true;
    }
    __device__ __forceinline__ size_t a_off(const Unit& u) const { return (size_t)u.pm * a_tile; }
    __device__ __forceinline__ size_t b_off(const Unit& u) const { return (size_t)u.pn * b_tile; }
};
struct InOrder {
    int G, c; size_t a_tile, b_tile;
    __device__ __forceinline__ bool next(int i, Unit& u) const {
        const long L = (long)i * G + c; if (L >= 1152 + 48) return false;
        if (L < 1152) { tile_of((int)L, 64, 18, u.pm, u.pn); } else { const int j = (int)L - 1152; u.pm = 64 + (j & 7); u.pn = 2 + (j >> 3); }
        u.z = 0; return true;
    }
    __device__ __forceinline__ size_t a_off(const Unit& u) const { return (size_t)u.pm * a_tile; }
    __device__ __forceinline__ size_t b_off(const Unit& u) const { return (size_t)u.pn * b_tile; }
};
struct DftOrder {
    int G, c; size_t a_tile, b_tile;
    __device__ __forceinline__ bool next(int i, Unit& u) const {
        const long L = (long)i * G + c; if (L >= 128) return false;
        u.z = (int)L >> 4; u.pm = ((int)L >> 1) & 7; u.pn = (int)L & 1; return true;
    }
    __device__ __forceinline__ size_t a_off(const Unit& u) const { return (size_t)u.pm * a_tile; }
    __device__ __forceinline__ size_t b_off(const Unit& u) const { return (size_t)u.pn * b_tile + (size_t)u.z * 4096 * 2; }
};

__device__ __forceinline__ unsigned cvt_pk_bf16(float lo, float hi) { unsigned r; asm volatile("v_cvt_pk_bf16_f32 %0, %1, %2" : "=v"(r) : "v"(lo), "v"(hi)); return r; }

template <class F> struct Epi8 {
    static constexpr bool PERM = true;
    F f;
    __device__ __forceinline__ void operator()(const f32x4 (&acc)[2][2][4][2], const Unit& u, int wr, int wc, int fr, int fq) const {
        const int row0 = u.pm * BM + wr * 64 + fr, col0 = u.pn * BM + wc * 32 + 8 * fq;
#pragma unroll
        for (int ai = 0; ai < 2; ++ai)
#pragma unroll
            for (int m = 0; m < 4; ++m) {
#pragma unroll
                for (int bj = 0; bj < 2; ++bj) f(u, row0 + ai * HALF + m * 16, col0 + bj * HALF, acc[ai][bj][m][0], acc[ai][bj][m][1]);
                asm volatile("" ::: "memory");
            }
    }
};

template <class Epi, class Sched, bool ALIGN_EPI = false, bool SP2 = false>
__device__ __forceinline__ void gemm_phase(PG8_LAS unsigned char* lds, const Gemm g, const Sched& S, const Epi& E) {
    int tid_ = threadIdx.x; asm volatile("" : "+v"(tid_));
    const int tid = tid_, wid = __builtin_amdgcn_readfirstlane(tid >> 6), lane = tid & 63, wr = wid >> 2, wc = wid & 3, fr = lane & 15, fq = lane >> 4;
    const int K = g.K, nt = K / BK;
    unsigned voffA[2], voffB[2];
#pragma unroll
    for (int i = 0; i < 2; ++i) { int R, C; stage_rc(tid * 16 + i * 8192, R, C); const int Rb = Epi::PERM ? ((R & ~31) + perm32(R & 31)) : R;
        voffA[i] = (unsigned)(R * g.lda + C) * 2u; voffB[i] = (unsigned)(Rb * g.ldb + C) * 2u; }
    const size_t kstep = (size_t)(BK * 2);
    const size_t hstepA = (size_t)HALF * g.lda * 2, hstepB = (size_t)HALF * g.ldb * 2;
    const unsigned ldsw = (unsigned)wid * 1024u;
    const int aoff = lds_byte(wr * 64 + fr, fq * 8), boff = lds_byte(wc * 32 + fr, fq * 8);
#define PG8_SA(b, h) (((b) * 2 + (h)) * HTB)
#define PG8_SB(b, h) ((4 + (b) * 2 + (h)) * HTB)
#define PG8_STAGE(bufoff, gbase, voff) do { _Pragma("unroll") for (int _i = 0; _i < 2; ++_i) \
        __builtin_amdgcn_global_load_lds((const unsigned*)((const char*)(gbase) + (voff)[_i]), (PG8_LAS unsigned*)(lds + (bufoff) + ldsw + _i * 8192), 16, 0, 0); } while (0)
#define PG8_LDA(dst, b, h) do { _Pragma("unroll") for (int m = 0; m < 4; ++m) _Pragma("unroll") for (int k = 0; k < 2; ++k) dst[m][k] = *(const PG8_LAS bf16x8*)(lds + PG8_SA(b, h) + aoff + m * 2048 + k * 1024); } while (0)
#define PG8_LDB(dst, b, h) do { _Pragma("unroll") for (int n = 0; n < 2; ++n) _Pragma("unroll") for (int k = 0; k < 2; ++k) dst[n][k] = *(const PG8_LAS bf16x8*)(lds + PG8_SB(b, h) + boff + n * 2048 + k * 1024); } while (0)
#define PG8_MMA(ai, bj, At, Bt) do { __builtin_amdgcn_s_setprio(1); _Pragma("unroll") for (int m = 0; m < 4; ++m) _Pragma("unroll") for (int n = 0; n < 2; ++n) _Pragma("unroll") for (int k = 0; k < 2; ++k) \
        acc[ai][bj][m][n] = __builtin_amdgcn_mfma_f32_16x16x32_bf16(Bt[n][k], At[m][k], acc[ai][bj][m][n], 0, 0, 0); __builtin_amdgcn_s_setprio(0); } while (0)
#define PG8_WAIT_V(n) asm volatile("s_waitcnt vmcnt(" #n ")" ::: "memory")
#define PG8_WAIT_L(n) asm volatile("s_waitcnt lgkmcnt(" #n ")" ::: "memory")
#define PG8_BAR __builtin_amdgcn_s_barrier()
#define PG8_SCHED __builtin_amdgcn_sched_barrier(0)
    Unit cur, nxt; int ui = 0;
    if (!S.next(0, cur)) return;
    f32x4 acc[2][2][4][2];
#pragma unroll
    for (int a = 0; a < 2; ++a)
#pragma unroll
        for (int b = 0; b < 2; ++b)
#pragma unroll
            for (int m = 0; m < 4; ++m)
#pragma unroll
                for (int n = 0; n < 2; ++n) acc[a][b][m][n] = (f32x4){0.f, 0.f, 0.f, 0.f};
    bf16x8 At[4][2], B0[2][2], B1[2][2];
    const char* cA = (const char*)g.A + S.a_off(cur); const char* cB = (const char*)g.Bt + S.b_off(cur);
    if constexpr (SP2) {
        PG8_STAGE(PG8_SB(0, 0), cB, voffB); PG8_STAGE(PG8_SB(0, 1), cB + hstepB, voffB); PG8_STAGE(PG8_SA(0, 0), cA, voffA); PG8_STAGE(PG8_SA(0, 1), cA + hstepA, voffA);
        if (wr == 1) PG8_BAR;
        PG8_WAIT_V(2); PG8_BAR;
        PG8_STAGE(PG8_SB(1, 0), cB + kstep, voffB); PG8_STAGE(PG8_SA(1, 0), cA + kstep, voffA); PG8_STAGE(PG8_SB(1, 1), cB + hstepB + kstep, voffB);
        PG8_WAIT_V(6); PG8_BAR;
    } else {
        PG8_STAGE(PG8_SB(0, 0), cB, voffB); PG8_STAGE(PG8_SA(0, 0), cA, voffA); PG8_STAGE(PG8_SB(0, 1), cB + hstepB, voffB); PG8_STAGE(PG8_SA(0, 1), cA + hstepA, voffA);
        if (wr == 1) PG8_BAR;
        PG8_WAIT_V(4); PG8_BAR;
        PG8_STAGE(PG8_SB(1, 0), cB + kstep, voffB); PG8_STAGE(PG8_SA(1, 0), cA + kstep, voffA); PG8_STAGE(PG8_SB(1, 1), cB + hstepB + kstep, voffB);
        PG8_WAIT_V(6); PG8_BAR;
    }
    for (;;) {
        const bool has_next = S.next(ui + 1, nxt);
        const char* nA = has_next ? (const char*)g.A + S.a_off(nxt) : cA; const char* nB = has_next ? (const char*)g.Bt + S.b_off(nxt) : cB;
        for (int t = 0; t < nt; t += 2) {
            const bool last = (t == nt - 2);
            const char* a1 = cA + (size_t)(t + 1) * kstep;
            const char* a2 = last ? nA : cA + (size_t)(t + 2) * kstep; const char* b2 = last ? nB : cB + (size_t)(t + 2) * kstep;
            const char* a3 = a2 + kstep; const char* b3 = b2 + kstep;
            if constexpr (SP2) {
            PG8_LDB(B0, 0, 0); PG8_LDB(B1, 0, 1); PG8_SCHED; PG8_LDA(At, 0, 0); PG8_STAGE(PG8_SA(1, 1), a1 + hstepA, voffA);
            PG8_WAIT_V(8); PG8_WAIT_L(0); PG8_BAR; PG8_MMA(0, 0, At, B0); PG8_MMA(0, 1, At, B1); PG8_BAR; PG8_SCHED;
            PG8_LDA(At, 0, 1); PG8_STAGE(PG8_SB(0, 0), b2, voffB); PG8_STAGE(PG8_SB(0, 1), b2 + hstepB, voffB); PG8_STAGE(PG8_SA(0, 0), a2, voffA);
            PG8_WAIT_V(8); PG8_WAIT_L(0); PG8_BAR; PG8_MMA(1, 0, At, B0); PG8_MMA(1, 1, At, B1); PG8_BAR; PG8_SCHED;
            PG8_LDB(B0, 1, 0); PG8_LDB(B1, 1, 1); PG8_SCHED; PG8_LDA(At, 1, 0); PG8_STAGE(PG8_SA(0, 1), a2 + hstepA, voffA);
            PG8_WAIT_V(8); PG8_WAIT_L(0); PG8_BAR; PG8_MMA(0, 0, At, B0); PG8_MMA(0, 1, At, B1); PG8_BAR; PG8_SCHED;
            PG8_LDA(At, 1, 1); PG8_STAGE(PG8_SB(1, 0), b3, voffB); PG8_STAGE(PG8_SB(1, 1), b3 + hstepB, voffB); PG8_STAGE(PG8_SA(1, 0), a3, voffA);
            PG8_WAIT_V(8); PG8_WAIT_L(0); PG8_BAR; PG8_MMA(1, 0, At, B0); PG8_MMA(1, 1, At, B1); PG8_BAR; PG8_SCHED;
            } else {
            PG8_LDB(B0, 0, 0); PG8_SCHED; PG8_LDA(At, 0, 0); PG8_STAGE(PG8_SA(1, 1), a1 + hstepA, voffA);
            PG8_WAIT_L(8); PG8_BAR; PG8_WAIT_L(0); PG8_MMA(0, 0, At, B0); PG8_BAR; PG8_SCHED;
            PG8_LDB(B1, 0, 1); PG8_STAGE(PG8_SB(0, 0), b2, voffB);
            PG8_BAR; PG8_WAIT_L(0); PG8_MMA(0, 1, At, B1); PG8_BAR;
            PG8_LDA(At, 0, 1); PG8_STAGE(PG8_SA(0, 0), a2, voffA);
            PG8_BAR; PG8_WAIT_L(0); PG8_MMA(1, 0, At, B0); PG8_BAR; PG8_SCHED;
            PG8_STAGE(PG8_SB(0, 1), b2 + hstepB, voffB);
            PG8_WAIT_V(6); PG8_BAR; PG8_MMA(1, 1, At, B1); PG8_BAR;
            PG8_LDB(B0, 1, 0); PG8_SCHED; PG8_LDA(At, 1, 0); PG8_STAGE(PG8_SA(0, 1), a2 + hstepA, voffA);
            PG8_WAIT_L(8); PG8_BAR; PG8_WAIT_L(0); PG8_MMA(0, 0, At, B0); PG8_BAR; PG8_SCHED;
            PG8_LDB(B1, 1, 1); PG8_STAGE(PG8_SB(1, 0), b3, voffB);
            PG8_BAR; PG8_WAIT_L(0); PG8_MMA(0, 1, At, B1); PG8_BAR;
            PG8_LDA(At, 1, 1); PG8_STAGE(PG8_SA(1, 0), a3, voffA);
            PG8_BAR; PG8_WAIT_L(0); PG8_MMA(1, 0, At, B0); PG8_BAR; PG8_SCHED;
            PG8_STAGE(PG8_SB(1, 1), b3 + hstepB, voffB);
            PG8_WAIT_V(6); PG8_BAR; PG8_MMA(1, 1, At, B1); PG8_BAR;
            }
        }
        if constexpr (ALIGN_EPI) { if (wr == 0) PG8_BAR; }
        E(acc, cur, wr, wc, fr, fq);
        if (!has_next) break;
#pragma unroll
        for (int a = 0; a < 2; ++a)
#pragma unroll
            for (int b = 0; b < 2; ++b)
#pragma unroll
                for (int m = 0; m < 4; ++m)
#pragma unroll
                    for (int n = 0; n < 2; ++n) acc[a][b][m][n] = (f32x4){0.f, 0.f, 0.f, 0.f};
        cur = nxt; cA = nA; cB = nB; ++ui;
        if constexpr (ALIGN_EPI) { if (wr == 1) PG8_BAR; }
    }
    PG8_WAIT_V(0);
    if constexpr (!ALIGN_EPI) { if (wr == 0) PG8_BAR; }
    PG8_BAR;
#undef PG8_SA
#undef PG8_SB
#undef PG8_STAGE
#undef PG8_LDA
#undef PG8_LDB
#undef PG8_MMA
#undef PG8_WAIT_V
#undef PG8_WAIT_L
#undef PG8_BAR
#undef PG8_SCHED
}
}

constexpr int DM = 1024, NB = 8, SEQ = 2048, MTOK = NB * SEQ, CTXL = 256, MCTX = NB * CTXL;
constexpr int HGD = 512, DFF = 2816, DFF2 = 5632, INDIM = 5120, NMOD = 6;
constexpr float EPSN = 1e-6f;
constexpr int NWAVES = 8, NTHR = 512;
constexpr int LDS_BYTES = 147456;
#ifndef DUP_MASK
#define DUP_MASK 0
#endif
#define REPS(k) ((((DUP_MASK) >> (k)) & 1) ? 2 : 1)
#ifndef PROBE_K
#define PROBE_K -1
#endif
#ifndef EXTRA_SYNCS
#define EXTRA_SYNCS 0
#endif

constexpr size_t MiB = 1u << 20;
constexpr size_t WS_MX = 0;
constexpr size_t WS_LB = 256 * 1024;
constexpr size_t WS_WFS = 2 * MiB, WS_TCH = 3 * MiB;
constexpr size_t WS_BAR = 512 * 1024, BAR_BYTES = 16384;
constexpr int MISC_OFF = 131072 + 320;
constexpr size_t WS_WIN = 6 * MiB;
constexpr size_t WS_WPQ = 16 * MiB;
constexpr size_t WS_WA = 18 * MiB, WS_WB = 19 * MiB, WS_WOUT = 20 * MiB;
constexpr size_t WS_CS = 22 * MiB;
constexpr size_t WS_WUP = 6 * MiB;
constexpr size_t WS_WDN = 250 * MiB;
constexpr size_t WS_HX = 38 * MiB;
constexpr size_t WS_OF = 38 * MiB, WS_OB = 54 * MiB;
constexpr size_t WS_TMP = 38 * MiB;
constexpr size_t WS_H2 = 38 * MiB;
constexpr size_t WS_Q = 74 * MiB, WS_V = 90 * MiB, WS_OG = 106 * MiB, WS_GA = 122 * MiB, WS_GBG = 154 * MiB, WS_PQT = 186 * MiB;
constexpr size_t WS_GFC = 218 * MiB, WS_GBC = 222 * MiB, WS_VC = 226 * MiB;
constexpr size_t WS_YF = 228 * MiB;
constexpr size_t WS_YH = 74 * MiB;
constexpr size_t WS_MRG = 186 * MiB;
constexpr size_t WS_Z = 74 * MiB;
constexpr size_t WS_A2 = 162 * MiB;
constexpr size_t WS_XO = 38 * MiB;
constexpr size_t WS_END = 256 * MiB;

typedef unsigned short bf16;
typedef float f32x4 __attribute__((ext_vector_type(4)));
typedef unsigned u32x4 __attribute__((ext_vector_type(4)));
typedef unsigned u32x2 __attribute__((ext_vector_type(2)));
#define LAS __attribute__((address_space(3)))

struct Params {
    const float* in[19];
    float* out;
    unsigned char* ws;
};

__device__ __forceinline__ float bf2f(unsigned short b) { return __uint_as_float(((unsigned)b) << 16); }
__device__ __forceinline__ float bflo(unsigned w) { return __uint_as_float(w << 16); }
__device__ __forceinline__ float bfhi(unsigned w) { return __uint_as_float(w & 0xffff0000u); }
__device__ __forceinline__ unsigned f2bf(float f) { unsigned u = __float_as_uint(f); return (u + 0x7fffu + ((u >> 16) & 1u)) >> 16; }
__device__ __forceinline__ unsigned pk2(float lo, float hi) { return f2bf(lo) | (f2bf(hi) << 16); }
__device__ __forceinline__ float sigmoidf_(float x) { return 1.f / (1.f + __expf(-x)); }
__device__ __forceinline__ float siluf_(float x) { return x / (1.f + __expf(-x)); }
__device__ __forceinline__ float wave_sum(float v) {
#pragma unroll
    for (int o = 1; o < 64; o <<= 1) v += __shfl_xor(v, o);
    return v;
}
__device__ __forceinline__ u32x4 pack8(const f32x4 a, const f32x4 b) { u32x4 w; w.x = pk2(a[0], a[1]); w.y = pk2(a[2], a[3]); w.z = pk2(b[0], b[1]); w.w = pk2(b[2], b[3]); return w; }

typedef __attribute__((address_space(1))) unsigned gu32;
#define XB_TMO      128
#define XB_XCNT(j)  (256  + 64 * (j))
#define XB_XSUB(j)  (1280 + 64 * (j))
#define XB_XGEN(j)  (2304 + 64 * (j))
#define XB_TOP      3328
#define XB_TOPGEN   3392
#define XCD_BAR_WORDS 3456
#define XB_SPIN_CAP (1u << 18)

__device__ __forceinline__ unsigned xb_ld(unsigned* p)              { return __hip_atomic_load(p, __ATOMIC_RELAXED, __HIP_MEMORY_SCOPE_AGENT); }
__device__ __forceinline__ unsigned xb_add(unsigned* p, unsigned v) { return __hip_atomic_fetch_add(p, v, __ATOMIC_RELAXED, __HIP_MEMORY_SCOPE_AGENT); }
__device__ __forceinline__ unsigned xb_xcc_id() { return (unsigned)__builtin_amdgcn_s_getreg((3 << 11) | 20) & 0xFu; }
#define XB_SPIN(cond, bar) do { unsigned _sp = 0; while (cond) { __builtin_amdgcn_s_sleep(1); \
    if ((++_sp & 255u) == 0u) { if (xb_ld(&(bar)[XB_TMO])) break; if (_sp > XB_SPIN_CAP) { atomicAdd(&(bar)[XB_TMO], 1u); break; } } } } while (0)

struct XcdBarrier {
    unsigned* bar; unsigned x;
    volatile LAS unsigned* st;
};

__device__ __forceinline__ XcdBarrier xcd_barrier_post(unsigned* bar, volatile LAS unsigned* st) {
    XcdBarrier b; b.bar = bar; b.x = xb_xcc_id(); b.st = st;
    if (threadIdx.x == 0) (void)xb_add(&bar[XB_XCNT(b.x)], 1u);
    return b;
}
__device__ __forceinline__ void xcd_barrier_complete(unsigned* bar, unsigned x, unsigned& nloc, unsigned& nx) {
    const unsigned G = gridDim.x * gridDim.y * gridDim.z;
    unsigned sum, cnt, mine, sp = 0u;
    for (;;) {
        sum = 0u; cnt = 0u; mine = 0u;
#pragma unroll
        for (unsigned j = 0; j < 16; ++j) { const unsigned c = xb_ld(&bar[XB_XCNT(j)]); sum += c; cnt += (c > 0u) ? 1u : 0u; mine = (j == x) ? c : mine; }
        if (sum == G) break;
        __builtin_amdgcn_s_sleep(1);
        if ((++sp & 255u) == 0u) { if (xb_ld(&bar[XB_TMO])) break; if (sp > XB_SPIN_CAP) { atomicAdd(&bar[XB_TMO], 1u); break; } }
    }
    nloc = mine > 0u ? mine : 1u; nx = cnt > 0u ? cnt : 1u;
}

__device__ __forceinline__ void xcd_barrier(const XcdBarrier& b) {
    asm volatile("s_waitcnt vmcnt(0)" ::: "memory");
    __syncthreads();
    if (threadIdx.x == 0) {
        unsigned* bar = b.bar;
        __builtin_amdgcn_s_waitcnt(0);
        unsigned nloc = b.st[0], nx = b.st[1];
        if (nloc == 0u) { xcd_barrier_complete(bar, b.x, nloc, nx); b.st[0] = nloc; b.st[1] = nx; }
        const unsigned old = xb_add(&bar[XB_XSUB(b.x)], 1u);
        const unsigned gen = old / nloc;
        if (old + 1u == (gen + 1u) * nloc) {
            __builtin_amdgcn_fence(__ATOMIC_RELEASE, "agent");
            asm volatile("s_waitcnt vmcnt(0)" ::: "memory");
            const unsigned og = xb_add(&bar[XB_TOP], 1u);
            const unsigned tg = og / nx;
            if (og + 1u == (tg + 1u) * nx) xb_add(&bar[XB_TOPGEN], 1u);
            else XB_SPIN(xb_ld(&bar[XB_TOPGEN]) == tg, bar);
            __builtin_amdgcn_fence(__ATOMIC_ACQUIRE, "agent");
            xb_add(&bar[XB_XGEN(b.x)], 1u);
            asm volatile("s_waitcnt vmcnt(0)" ::: "memory");
        } else {
            XB_SPIN(xb_ld(&bar[XB_XGEN(b.x)]) == gen, bar);
            __builtin_amdgcn_fence(__ATOMIC_ACQUIRE, "agent");
            asm volatile("s_waitcnt vmcnt(0)" ::: "memory");
        }
    }
    __syncthreads();
}


struct FIn {
    unsigned char* ws; float* out;
    __device__ __forceinline__ void operator()(const pg8::Unit& u, int row, int col, f32x4 v0, f32x4 v1) const {
        const int seg = u.pn >> 1, c = col & 511;
        if (seg == 0 || seg == 4) { f32x4 a, b;
#pragma unroll
            for (int i = 0; i < 4; ++i) { a[i] = siluf_(v0[i]); b[i] = siluf_(v1[i]); }
            bf16* dst = (bf16*)(ws + (seg == 0 ? WS_Q : WS_OG));
            *(u32x4*)(dst + (size_t)row * 512 + c) = pack8(a, b);
        } else if (seg == 1 || seg == 2) {
            const float* lb = (const float*)(ws + WS_LB);
            const f32x4 l0 = *(const f32x4*)(lb + c), l1 = *(const f32x4*)(lb + c + 4); f32x4 a, b;
#pragma unroll
            for (int i = 0; i < 4; ++i) { a[i] = l0[i] + (1.f - l0[i]) * sigmoidf_(v0[i]); b[i] = l1[i] + (1.f - l1[i]) * sigmoidf_(v1[i]); }
            float* dst;
            if (u.pm < 64) dst = out + (seg == 1 ? (size_t)0 : (size_t)MTOK * 512) + (size_t)row * 512 + c;
            else dst = (float*)(ws + (seg == 1 ? WS_GFC : WS_GBC)) + (size_t)(row - MTOK) * 512 + c;
            *(f32x4*)dst = a; *(f32x4*)(dst + 4) = b;
        } else if (seg == 3) {
            bf16* dst;
            if (u.pm < 64) dst = (bf16*)(ws + WS_V) + (size_t)row * 512 + c; else dst = (bf16*)(ws + WS_VC) + (size_t)(row - MTOK) * 512 + c;
            *(u32x4*)dst = pack8(v0, v1);
        } else { f32x4 a, b;
#pragma unroll
            for (int i = 0; i < 4; ++i) { a[i] = sigmoidf_(v0[i]); b[i] = sigmoidf_(v1[i]); }
            bf16* dst = (seg < 7) ? ((bf16*)(ws + WS_GA) + (size_t)row * 1024 + (col - 5 * 512)) : ((bf16*)(ws + WS_GBG) + (size_t)row * 1024 + (col - 7 * 512));
            *(u32x4*)dst = pack8(a, b);
        }
    }
};
struct FPQ {
    bf16* pqt;
    __device__ __forceinline__ void operator()(const pg8::Unit&, int row, int col, f32x4 v0, f32x4 v1) const {
        *(u32x4*)(pqt + (size_t)(row & 511) * 32768 + (size_t)(col >> 11) * 4096 + (size_t)(row >> 9) * 2048 + (col & 2047)) = pack8(v0, v1);
    }
};
struct FDft {
    bf16* yf;
    __device__ __forceinline__ void operator()(const pg8::Unit& u, int row, int col, f32x4 v0, f32x4 v1) const {
        *(u32x4*)(yf + ((size_t)u.z * SEQ + row) * 512 + col) = pack8(v0 * (1.f / 512.f), v1 * (1.f / 512.f));
    }
};
struct FYa {
    const bf16* ga; bf16* tmp;
    __device__ __forceinline__ void operator()(const pg8::Unit&, int row, int col, f32x4 v0, f32x4 v1) const {
        const size_t o = (size_t)row * 1024 + col; const u32x4 g = *(const u32x4*)(ga + o);
        f32x4 a, b; a[0] = v0[0] * bflo(g.x); a[1] = v0[1] * bfhi(g.x); a[2] = v0[2] * bflo(g.y); a[3] = v0[3] * bfhi(g.y);
        b[0] = v1[0] * bflo(g.z); b[1] = v1[1] * bfhi(g.z); b[2] = v1[2] * bflo(g.w); b[3] = v1[3] * bfhi(g.w);
        *(u32x4*)(tmp + o) = pack8(a, b);
    }
};
struct FYb {
    const bf16* gbg; const bf16* tmp; bf16* mrg;
    __device__ __forceinline__ void operator()(const pg8::Unit&, int row, int col, f32x4 v0, f32x4 v1) const {
        const size_t o = (size_t)row * 1024 + col; const u32x4 g = *(const u32x4*)(gbg + o); const u32x4 t = *(const u32x4*)(tmp + o);
        f32x4 a, b; a[0] = bflo(t.x) + v0[0] * bflo(g.x); a[1] = bfhi(t.x) + v0[1] * bfhi(g.x); a[2] = bflo(t.y) + v0[2] * bflo(g.y); a[3] = bfhi(t.y) + v0[3] * bfhi(g.y);
        b[0] = bflo(t.z) + v1[0] * bflo(g.z); b[1] = bfhi(t.z) + v1[1] * bfhi(g.z); b[2] = bflo(t.w) + v1[2] * bflo(g.w); b[3] = bfhi(t.w) + v1[3] * bfhi(g.w);
        *(u32x4*)(mrg + o) = pack8(a, b);
    }
};
struct FRes {
    const float* src; float* dst; const float* mx; int mod;
    __device__ __forceinline__ void operator()(const pg8::Unit&, int row, int col, f32x4 v0, f32x4 v1) const {
        const size_t o = (size_t)row * 1024 + col; const float* m = mx + (size_t)(row >> 11) * (NMOD * DM) + mod * DM + col;
        const f32x4 m0 = *(const f32x4*)m, m1 = *(const f32x4*)(m + 4), s0 = *(const f32x4*)(src + o), s1 = *(const f32x4*)(src + o + 4);
        *(f32x4*)(dst + o) = s0 + m0 * v0; *(f32x4*)(dst + o + 4) = s1 + m1 * v1;
    }
};
struct FUp {
    bf16* z; int ld;
    __device__ __forceinline__ void operator()(const pg8::Unit&, int row, int col, f32x4 v0, f32x4 v1) const {
        *(u32x4*)(z + (size_t)row * ld + col) = pack8(v0, v1);
    }
};

__device__ __forceinline__ void transpose_item(const float* W, int K, int N, bf16* WT, LAS float* scr, int item, int lane) {
    const int nblk = N / 32, kb = item / nblk, nb = item % nblk, k0 = 64 * kb, n0 = 32 * nb;
#pragma unroll 8
    for (int i = 0; i < 32; ++i) { const int kk = 2 * i + (lane >> 5); scr[kk * 33 + (lane & 31)] = W[(size_t)(k0 + kk) * N + n0 + (lane & 31)]; }
    asm volatile("s_waitcnt lgkmcnt(0)" ::: "memory");
    const int c = lane & 7;
#pragma unroll
    for (int j = 0; j < 4; ++j) { const int n = (lane >> 3) + 8 * j; const LAS float* s = scr + (8 * c) * 33 + n;
        u32x4 o; o.x = pk2(s[0 * 33], s[1 * 33]); o.y = pk2(s[2 * 33], s[3 * 33]); o.z = pk2(s[4 * 33], s[5 * 33]); o.w = pk2(s[6 * 33], s[7 * 33]);
        *(u32x4*)(WT + (size_t)(n0 + n) * K + k0 + 8 * c) = o; }
    asm volatile("s_waitcnt lgkmcnt(0)" ::: "memory");
}

template <bool MOD>
__device__ __forceinline__ void norm_rows(const float* srcA, const float* srcB, int nA, const float* g, const float* mx, int shift_mod, int scale_mod,
                                          bf16* outb, float* outf, int r0, int nr, int lane) {
    f32x4 G[4], SH[4], cur[4], nxt[4];
    int curmod = -1;
    { const float* s0 = (r0 < nA) ? srcA + (size_t)r0 * DM : srcB + (size_t)(r0 - nA) * DM;
#pragma unroll
      for (int j = 0; j < 4; ++j) cur[j] = *(const f32x4*)(s0 + (lane + 64 * j) * 4); }
#pragma unroll 1
    for (int i = 0; i < nr; ++i) {
        const int m = r0 + i;
        if (i + 1 < nr) { const int m1 = m + 1; const float* s1 = (m1 < nA) ? srcA + (size_t)m1 * DM : srcB + (size_t)(m1 - nA) * DM;
#pragma unroll
            for (int j = 0; j < 4; ++j) nxt[j] = *(const f32x4*)(s1 + (lane + 64 * j) * 4); }
        const int mr = MOD ? ((m < nA) ? (m >> 11) : 8) : 0;
        if (mr != curmod) { curmod = mr;
#pragma unroll
            for (int j = 0; j < 4; ++j) { const int e = (lane + 64 * j) * 4; const f32x4 gg = *(const f32x4*)(g + e);
                if (MOD) { const f32x4 sc = *(const f32x4*)(mx + (size_t)mr * (NMOD * DM) + scale_mod * DM + e); SH[j] = *(const f32x4*)(mx + (size_t)mr * (NMOD * DM) + shift_mod * DM + e); G[j] = gg * (sc + 1.f); }
                else { G[j] = gg; SH[j] = (f32x4){0.f, 0.f, 0.f, 0.f}; } } }
        float s = 0.f;
#pragma unroll
        for (int j = 0; j < 4; ++j) s += (cur[j][0] * cur[j][0] + cur[j][1] * cur[j][1]) + (cur[j][2] * cur[j][2] + cur[j][3] * cur[j][3]);
        const float rinv = rsqrtf(wave_sum(s) * (1.f / DM) + EPSN);
#pragma unroll
        for (int j = 0; j < 4; ++j) { const int e = (lane + 64 * j) * 4; const f32x4 h = cur[j] * rinv * G[j] + SH[j];
            if (MOD) { u32x2 w; w.x = pk2(h[0], h[1]); w.y = pk2(h[2], h[3]); *(u32x2*)(outb + (size_t)m * DM + e) = w; }
            else *(f32x4*)(outf + (size_t)m * DM + e) = h; }
#pragma unroll
        for (int j = 0; j < 4; ++j) cur[j] = nxt[j];
    }
}

__device__ __forceinline__ void phase0(const Params& p, unsigned char* lds, int tid, int lane, int wave, int G, const int part) {
    float* ldsf = (float*)lds;
    float* mxo = (float*)(p.ws + WS_MX);
    if (part == 0) {
    for (int it = blockIdx.x; it < 192; it += G) {
        __syncthreads();
        {
            const float* c = p.in[1]; const float* cc = p.in[3]; const float* aw = p.in[4]; const float* ab = p.in[5];
            float* sc = ldsf;
            float* red = ldsf + 9 * 1024;
            for (int i = tid; i < 9 * 1024; i += NTHR) { const int r = i >> 10, k = i & 1023; const float cv = (r < 8) ? c[r * 1024 + k] : cc[k]; sc[i] = cv / (1.f + __expf(-cv)); }
            __syncthreads();
            const int n0 = it * 32, col = tid & 31, ks = tid >> 5;
            float a[9];
#pragma unroll
            for (int r = 0; r < 9; ++r) a[r] = 0.f;
            for (int k = ks * 64; k < ks * 64 + 64; ++k) { const float w = aw[(size_t)k * (NMOD * DM) + n0 + col];
#pragma unroll
                for (int r = 0; r < 9; ++r) a[r] += sc[r * 1024 + k] * w; }
#pragma unroll
            for (int r = 0; r < 9; ++r) red[(ks * 9 + r) * 32 + col] = a[r];
            __syncthreads();
            if (tid < 288) { const int r = tid >> 5, cl = tid & 31; float s = ab[n0 + cl];
                for (int k2 = 0; k2 < 16; ++k2) s += red[(k2 * 9 + r) * 32 + cl];
                mxo[r * (NMOD * DM) + n0 + cl] = s; }
        }
    }
    __syncthreads();
    { bf16* tch = (bf16*)(p.ws + WS_TCH); bf16* wfs = (bf16*)(p.ws + WS_WFS); const float* win = p.in[7];
      for (int i = blockIdx.x * NTHR + tid; i < 1024 * 64; i += G * NTHR) { const int n = i >> 6, c8 = (i & 63) * 8, gn = (n & 511) >> 7, j = n & 127; float vv[8];
#pragma unroll
          for (int e = 0; e < 8; ++e) { const int cp = c8 + e, idx = ((cp & 127) * j) & 127; const float ang = (float)idx * (1.f / 64.f);
              vv[e] = ((cp >> 7) == gn) ? ((n < 512) ? cospif(ang) : sinpif(ang)) : 0.f; }
          u32x4 w; w.x = pk2(vv[0], vv[1]); w.y = pk2(vv[2], vv[3]); w.z = pk2(vv[4], vv[5]); w.w = pk2(vv[6], vv[7]);
          *(u32x4*)(tch + (size_t)n * 512 + c8) = w;
          const f32x4 a = *(const f32x4*)(win + (size_t)n * INDIM + c8), b2 = *(const f32x4*)(win + (size_t)n * INDIM + c8 + 4);
          *(u32x4*)(wfs + (size_t)n * 512 + c8) = pack8(a, b2); } }
    }
    if (part == 0 && blockIdx.x == G - 1) { const float* hl = p.in[8]; float* lbo = (float*)(p.ws + WS_LB);
        if (tid < 512) { const float a = hl[tid], b = hl[512 + tid]; lbo[tid] = 1.f / (1.f + expf(b - a)); } }
    if (part == 0) return;
    { bf16* cs = (bf16*)(p.ws + WS_CS);
      for (int i = blockIdx.x * NTHR + tid; i < 2048 * 512; i += G * NTHR) { const int l = i >> 9, kc = (i & 511) * 8; float vv[8];
#pragma unroll
          for (int e = 0; e < 8; ++e) { const int k = kc + e, s = k >> 11, kk = k & 2047, ph = (l * kk) & 2047; const float ang = (float)ph * (1.f / 1024.f); vv[e] = s ? -sinpif(ang) : cospif(ang); }
          u32x4 w; w.x = pk2(vv[0], vv[1]); w.y = pk2(vv[2], vv[3]); w.z = pk2(vv[4], vv[5]); w.w = pk2(vv[6], vv[7]);
          *(u32x4*)(cs + (size_t)l * 4096 + kc) = w; } }
    { LAS float* scr = (LAS float*)((LAS unsigned char*)lds + wave * 16384);
      const int gw = blockIdx.x * NWAVES + wave, NGW = G * NWAVES;
      constexpr int I_IN = 16 * 160, I_A = 8 * 32, I_B = 8 * 32, I_O = 16 * 32;
      for (int it = gw; it < I_IN + I_A + I_B + I_O; it += NGW) { int r = it;
          if (r < I_IN) { transpose_item(p.in[7], 1024, INDIM, (bf16*)(p.ws + WS_WIN), scr, r, lane); continue; } r -= I_IN;
          if (r < I_A) { transpose_item(p.in[10], 512, 1024, (bf16*)(p.ws + WS_WA), scr, r, lane); continue; } r -= I_A;
          if (r < I_B) { transpose_item(p.in[11], 512, 1024, (bf16*)(p.ws + WS_WB), scr, r, lane); continue; } r -= I_B;
          transpose_item(p.in[12], 1024, 1024, (bf16*)(p.ws + WS_WOUT), scr, r, lane); } }
}

__device__ __forceinline__ void hgrn_mfma_item(const Params& p, unsigned char* lds, int item) {
    int tid_ = threadIdx.x; asm volatile("" : "+v"(tid_));
    const int tid = tid_, lane = tid & 63, w = __builtin_amdgcn_readfirstlane(tid >> 6), fr = lane & 15, fq = lane >> 4;
    const int vh = item & 1, dir = (item >> 1) & 1, h = (item >> 2) & 3, b = item >> 4;
    bf16* Qs = (bf16*)lds;
    bf16* Ks = Qs + 64 * 136;
    bf16* St = Ks + 64 * 136;
    bf16* Kh = St + 2 * 64 * 136;
    bf16* Vt = Kh + 128 * 72;
    bf16* Ps = Vt + 64 * 72;
    float* Et = (float*)(Ps + 64 * 72);
    const int d = 16 * w + fr;
    const float* fL = p.out + (dir ? (size_t)MTOK * 512 : 0) + (size_t)b * SEQ * 512 + h * 128 + d;
    const float* fC = (const float*)(p.ws + (dir ? WS_GBC : WS_GFC)) + (size_t)b * CTXL * 512 + h * 128 + d;
    const bf16* qL = (const bf16*)(p.ws + WS_Q) + (size_t)b * SEQ * 512 + h * 128 + d;
    const bf16* vL = (const bf16*)(p.ws + WS_V) + (size_t)b * SEQ * 512 + h * 128 + vh * 64 + lane;
    const bf16* vC = (const bf16*)(p.ws + WS_VC) + (size_t)b * CTXL * 512 + h * 128 + vh * 64 + lane;
    bf16* oL = (bf16*)(p.ws + (dir ? WS_OB : WS_OF)) + (size_t)b * SEQ * 512 + h * 128 + vh * 64;
    f32x4 Sa[4];
#pragma unroll
    for (int i = 0; i < 4; ++i) Sa[i] = (f32x4){0.f, 0.f, 0.f, 0.f};
    float fr_[16]; unsigned short qr_[16], vr_[8];
#define HG_LOAD(cc_) do { const int _cc = (cc_); const bool _lat = _cc >= 4; const int _c = _lat ? _cc - 4 : _cc, _n = _lat ? SEQ : CTXL; \
        const float* _f = _lat ? fL : fC; const bf16* _v = _lat ? vL : vC; \
        _Pragma("unroll") for (int i = 0; i < 16; ++i) { const int _s = _c * 64 + fq * 16 + i, _pos = dir ? (_n - 1 - _s) : _s; fr_[i] = _f[(size_t)_pos * 512]; qr_[i] = _lat ? qL[(size_t)_pos * 512] : (unsigned short)0; } \
        _Pragma("unroll") for (int j = 0; j < 8; ++j) { const int _s = _c * 64 + w * 8 + j, _pos = dir ? (_n - 1 - _s) : _s; vr_[j] = _v[(size_t)_pos * 512]; } } while (0)
    HG_LOAD(0);
    for (int cc = 0; cc < 36; ++cc) {
        const bool lat = cc >= 4; const int c = lat ? cc - 4 : cc;
        bf16* Scur = St + (cc & 1) * (64 * 136); bf16* Snxt = St + ((cc & 1) ^ 1) * (64 * 136);
        {
            float ce[16]; float e = 1.f;
#pragma unroll
            for (int i = 0; i < 16; ++i) { e *= fr_[i]; ce[i] = e; }
            const float T0 = __shfl(e, fr), T1 = __shfl(e, fr + 16), T2 = __shfl(e, fr + 32), T3 = __shfl(e, fr + 48);
            const float pre = (fq == 0) ? 1.f : (fq == 1) ? T0 : (fq == 2) ? T0 * T1 : T0 * T1 * T2;
            const float tot = T0 * T1 * T2 * T3;
            if (fq == 0) Et[d] = tot;
            unsigned khw[8];
#pragma unroll
            for (int i = 0; i < 16; i += 2) { float kh2[2];
#pragma unroll
                for (int u = 0; u < 2; ++u) { const float cm = fmaxf(pre * ce[i + u], 1e-30f), ie = __builtin_amdgcn_rcpf(cm), kt = (1.f - fr_[i + u]) * ie; const int sl = fq * 16 + i + u;
                    if (lat) { Qs[sl * 136 + d] = (bf16)f2bf(bf2f(qr_[i + u]) * cm); Ks[sl * 136 + d] = (bf16)f2bf(kt); }
                    kh2[u] = kt * tot; }
                khw[i >> 1] = pk2(kh2[0], kh2[1]); }
            u32x4 k0; k0.x = khw[0]; k0.y = khw[1]; k0.z = khw[2]; k0.w = khw[3]; u32x4 k1; k1.x = khw[4]; k1.y = khw[5]; k1.z = khw[6]; k1.w = khw[7];
            *(u32x4*)(Kh + d * 72 + fq * 16) = k0; *(u32x4*)(Kh + d * 72 + fq * 16 + 8) = k1;
            u32x4 vv; vv.x = (unsigned)vr_[0] | ((unsigned)vr_[1] << 16); vv.y = (unsigned)vr_[2] | ((unsigned)vr_[3] << 16); vv.z = (unsigned)vr_[4] | ((unsigned)vr_[5] << 16); vv.w = (unsigned)vr_[6] | ((unsigned)vr_[7] << 16);
            *(u32x4*)(Vt + lane * 72 + w * 8) = vv;
        }
        if (cc + 1 < 36) HG_LOAD(cc + 1);
        __syncthreads();
        const int ti = w >> 1, x2 = 2 * (w & 1);
        if (lat) {
#pragma unroll
            for (int u2 = 0; u2 < 2; ++u2) { const int si = x2 + u2; f32x4 acc = (f32x4){0.f, 0.f, 0.f, 0.f};
                if (si <= ti) {
#pragma unroll
                    for (int kk = 0; kk < 4; ++kk) { const pg8::bf16x8 a = *(const pg8::bf16x8*)(Ks + (si * 16 + fr) * 136 + kk * 32 + fq * 8), bq = *(const pg8::bf16x8*)(Qs + (ti * 16 + fr) * 136 + kk * 32 + fq * 8);
                        acc = __builtin_amdgcn_mfma_f32_16x16x32_bf16(a, bq, acc, 0, 0, 0); }
                    if (si == ti) {
#pragma unroll
                        for (int r = 0; r < 4; ++r) if (4 * fq + r > fr) acc[r] = 0.f; } }
                u32x2 pw; pw.x = pk2(acc[0], acc[1]); pw.y = pk2(acc[2], acc[3]);
                *(u32x2*)(Ps + (ti * 16 + fr) * 72 + si * 16 + 4 * fq) = pw; }
        }
        {
            const f32x4 et = *(const f32x4*)(Et + w * 16 + 4 * fq);
            pg8::bf16x8 ka[2];
#pragma unroll
            for (int kk = 0; kk < 2; ++kk) ka[kk] = *(const pg8::bf16x8*)(Kh + (w * 16 + fr) * 72 + kk * 32 + fq * 8);
#pragma unroll
            for (int vi = 0; vi < 4; ++vi) { Sa[vi] = Sa[vi] * et;
#pragma unroll
                for (int kk = 0; kk < 2; ++kk) { const pg8::bf16x8 bv = *(const pg8::bf16x8*)(Vt + (vi * 16 + fr) * 72 + kk * 32 + fq * 8);
                    Sa[vi] = __builtin_amdgcn_mfma_f32_16x16x32_bf16(ka[kk], bv, Sa[vi], 0, 0, 0); }
                u32x2 sw; sw.x = pk2(Sa[vi][0], Sa[vi][1]); sw.y = pk2(Sa[vi][2], Sa[vi][3]);
                *(u32x2*)(Snxt + (vi * 16 + fr) * 136 + w * 16 + 4 * fq) = sw; }
        }
        f32x4 Oa[2];
        Oa[0] = (f32x4){0.f, 0.f, 0.f, 0.f}; Oa[1] = (f32x4){0.f, 0.f, 0.f, 0.f};
        if (lat) {
#pragma unroll
            for (int kk = 0; kk < 4; ++kk) { const pg8::bf16x8 bq = *(const pg8::bf16x8*)(Qs + (ti * 16 + fr) * 136 + kk * 32 + fq * 8);
#pragma unroll
                for (int u2 = 0; u2 < 2; ++u2) { const pg8::bf16x8 a = *(const pg8::bf16x8*)(Scur + ((x2 + u2) * 16 + fr) * 136 + kk * 32 + fq * 8);
                    Oa[u2] = __builtin_amdgcn_mfma_f32_16x16x32_bf16(a, bq, Oa[u2], 0, 0, 0); } }
        }
        __syncthreads();
        if (lat) {
#pragma unroll
            for (int kk = 0; kk < 2; ++kk) { const pg8::bf16x8 bp = *(const pg8::bf16x8*)(Ps + (ti * 16 + fr) * 72 + kk * 32 + fq * 8);
#pragma unroll
                for (int u2 = 0; u2 < 2; ++u2) { const pg8::bf16x8 a = *(const pg8::bf16x8*)(Vt + ((x2 + u2) * 16 + fr) * 72 + kk * 32 + fq * 8);
                    Oa[u2] = __builtin_amdgcn_mfma_f32_16x16x32_bf16(a, bp, Oa[u2], 0, 0, 0); } }
            const int sg = c * 64 + ti * 16 + fr, pos = dir ? (SEQ - 1 - sg) : sg;
#pragma unroll
            for (int u2 = 0; u2 < 2; ++u2) { u32x2 ow; ow.x = pk2(Oa[u2][0], Oa[u2][1]); ow.y = pk2(Oa[u2][2], Oa[u2][3]);
                *(u32x2*)(oL + (size_t)pos * 512 + (x2 + u2) * 16 + 4 * fq) = ow; }
        }
        __syncthreads();
    }
#undef HG_LOAD
}

__device__ __forceinline__ void phase_yh(const Params& p, int lane, int gw, int NGW) {
    const bf16* of = (const bf16*)(p.ws + WS_OF); const bf16* ob = (const bf16*)(p.ws + WS_OB); const bf16* og = (const bf16*)(p.ws + WS_OG);
    bf16* yh = (bf16*)(p.ws + WS_YH); const float* on = p.in[9];
    const f32x4 n0 = *(const f32x4*)(on + lane * 8), n1 = *(const f32x4*)(on + lane * 8 + 4);
    const int per = (MTOK + NGW - 1) / NGW, r0 = gw * per, nr = min(per, MTOK - r0);
    if (nr <= 0) return;
    u32x4 a = *(const u32x4*)(of + (size_t)r0 * 512 + lane * 8), b = *(const u32x4*)(ob + (size_t)r0 * 512 + lane * 8), gg = *(const u32x4*)(og + (size_t)r0 * 512 + lane * 8);
#pragma unroll 1
    for (int i = 0; i < nr; ++i) { const size_t o = (size_t)(r0 + i) * 512 + lane * 8;
        u32x4 a1 = a, b1 = b, g1 = gg;
        if (i + 1 < nr) { a1 = *(const u32x4*)(of + o + 512); b1 = *(const u32x4*)(ob + o + 512); g1 = *(const u32x4*)(og + o + 512); }
        float v[8]; v[0] = bflo(a.x) + bflo(b.x); v[1] = bfhi(a.x) + bfhi(b.x); v[2] = bflo(a.y) + bflo(b.y); v[3] = bfhi(a.y) + bfhi(b.y);
        v[4] = bflo(a.z) + bflo(b.z); v[5] = bfhi(a.z) + bfhi(b.z); v[6] = bflo(a.w) + bflo(b.w); v[7] = bfhi(a.w) + bfhi(b.w);
        float s = 0.f;
#pragma unroll
        for (int k = 0; k < 8; ++k) s += v[k] * v[k];
        s += __shfl_xor(s, 1); s += __shfl_xor(s, 2); s += __shfl_xor(s, 4); s += __shfl_xor(s, 8);
        const float rinv = rsqrtf(s * (1.f / 128.f) + EPSN);
        float gv[8]; gv[0] = bflo(gg.x); gv[1] = bfhi(gg.x); gv[2] = bflo(gg.y); gv[3] = bfhi(gg.y); gv[4] = bflo(gg.z); gv[5] = bfhi(gg.z); gv[6] = bflo(gg.w); gv[7] = bfhi(gg.w);
        f32x4 q0, q1;
#pragma unroll
        for (int k = 0; k < 4; ++k) { q0[k] = v[k] * rinv * n0[k] * gv[k]; q1[k] = v[4 + k] * rinv * n1[k] * gv[4 + k]; }
        *(u32x4*)(yh + o) = pack8(q0, q1);
        a = a1; b = b1; gg = g1; }
}

struct ConvRaw { u32x2 a[3], g[3]; };
__device__ __forceinline__ void conv_issue(const bf16* z, int tokbase, int r, int cc, int ch, ConvRaw& q) {
#pragma unroll
    for (int i = 0; i < 3; ++i) { const int rr = r + i - 1;
        if (rr >= 0 && rr < 32 && cc >= 0 && cc < 64) { const size_t zo = (size_t)(tokbase + rr * 64 + cc) * DFF2 + ch;
            q.a[i] = *(const u32x2*)(z + zo); q.g[i] = *(const u32x2*)(z + zo + DFF);
        } else { q.a[i] = (u32x2){0u, 0u}; q.g[i] = (u32x2){0u, 0u}; } }
}
__device__ __forceinline__ void phase_conv(const Params& p, int hf, int tid, int G) {
    const bf16* z = (const bf16*)(p.ws + WS_Z); bf16* a2 = (bf16*)(p.ws + WS_A2) + (size_t)hf * 8192 * DFF;
    const float* cw = p.in[15]; const float* cb = p.in[16];
    for (int it = blockIdx.x * NTHR + tid; it < 4 * 32 * 4 * 704; it += G * NTHR) {
        const int cg4 = it % 704, rest = it / 704, strip = rest & 3, r = (rest >> 2) & 31, img = rest >> 7, ch = cg4 * 4, c0 = strip * 16, tokbase = img * 2048;
        ConvRaw ring[3];
#pragma unroll
        for (int j = 0; j < 3; ++j) conv_issue(z, tokbase, r, c0 - 1 + j, ch, ring[j]);
        float w1[9][4], w2[9][4];
#pragma unroll
        for (int t = 0; t < 9; ++t) { const f32x4 a = *(const f32x4*)(cw + (size_t)t * DFF2 + ch), g = *(const f32x4*)(cw + (size_t)t * DFF2 + DFF + ch);
#pragma unroll
            for (int e = 0; e < 4; ++e) { w1[t][e] = a[e]; w2[t][e] = g[e]; } }
        const f32x4 b1 = *(const f32x4*)(cb + ch), b2 = *(const f32x4*)(cb + DFF + ch);
        float W1[3][3][4], W2[3][3][4];
#pragma unroll
        for (int j = 0; j < 18; ++j) {
            const int sl = j % 3;
#pragma unroll
            for (int i = 0; i < 3; ++i) { const u32x2 a = ring[j % 3].a[i], g = ring[j % 3].g[i];
                W1[sl][i][0] = bflo(a.x); W1[sl][i][1] = bfhi(a.x); W1[sl][i][2] = bflo(a.y); W1[sl][i][3] = bfhi(a.y);
                W2[sl][i][0] = bflo(g.x); W2[sl][i][1] = bfhi(g.x); W2[sl][i][2] = bflo(g.y); W2[sl][i][3] = bfhi(g.y); }
            if (j + 3 < 18) conv_issue(z, tokbase, r, c0 - 1 + j + 3, ch, ring[j % 3]);
            if (j >= 2) {
                const int sL = (j - 2) % 3, sC = (j - 1) % 3, sR = j % 3;
                float o1[4], o2[4];
#pragma unroll
                for (int e = 0; e < 4; ++e) { o1[e] = b1[e]; o2[e] = b2[e]; }
#pragma unroll
                for (int i = 0; i < 3; ++i)
#pragma unroll
                    for (int e = 0; e < 4; ++e) {
                        o1[e] += W1[sL][i][e] * w1[i * 3 + 0][e] + W1[sC][i][e] * w1[i * 3 + 1][e] + W1[sR][i][e] * w1[i * 3 + 2][e];
                        o2[e] += W2[sL][i][e] * w2[i * 3 + 0][e] + W2[sC][i][e] * w2[i * 3 + 1][e] + W2[sR][i][e] * w2[i * 3 + 2][e]; }
                u32x2 ow; ow.x = pk2(siluf_(o1[0]) * o2[0], siluf_(o1[1]) * o2[1]); ow.y = pk2(siluf_(o1[2]) * o2[2], siluf_(o1[3]) * o2[3]);
                *(u32x2*)(a2 + (size_t)(tokbase + r * 64 + c0 + j - 2) * DFF + ch) = ow;
            }
        }
    }
}

__global__ void __launch_bounds__(NTHR, 2) fwd_mega(Params p) {
    extern __shared__ __attribute__((aligned(16))) unsigned char lds[];
    cg::grid_group grid = cg::this_grid();
    const int tid = threadIdx.x, lane = tid & 63, wave = __builtin_amdgcn_readfirstlane(tid >> 6);
    const int G = gridDim.x, gw = blockIdx.x * NWAVES + wave, NGW = G * NWAVES;
    PG8_LAS unsigned char* ldsl = (PG8_LAS unsigned char*)lds;
    unsigned char* ws = p.ws;
    const float* mx = (const float*)(ws + WS_MX);
    volatile LAS unsigned* misc = (volatile LAS unsigned*)((LAS unsigned char*)lds + MISC_OFF);
    if (tid < 16) misc[tid] = 0u;
    __syncthreads();
    const XcdBarrier xbar = xcd_barrier_post((unsigned*)(ws + WS_BAR), misc + 8);
    const unsigned long long t0_ = (PROBE_K >= 0) ? __builtin_amdgcn_s_memrealtime() : 0ull;
#define PROBE_POINT(k) do { if (PROBE_K == (k) && tid == 0) { const unsigned long long _n = __builtin_amdgcn_s_memrealtime(), _d = _n - t0_; while (__builtin_amdgcn_s_memrealtime() - _n < _d) __builtin_amdgcn_s_sleep(8); } } while (0)

    for (int rep_ = 0; rep_ < REPS(0); ++rep_) {
    phase0(p, lds, tid, lane, wave, G, 0);
    xcd_barrier(xbar);
    if (G == 0x7fffffff) grid.sync();
    }
    for (int xs_ = 0; xs_ < EXTRA_SYNCS; ++xs_) xcd_barrier(xbar);
    PROBE_POINT(0);
    for (int rep_ = 0; rep_ < REPS(1); ++rep_) {
    if (blockIdx.x < 16 && G >= 16) {
        pg8::Gemm g{(const bf16*)(ws + WS_TCH), (const bf16*)(ws + WS_WFS), 512, 512, 512};
        pg8::StaticOrder S; S.init(4, 4, 16, blockIdx.x, 512, 512);
        pg8::Epi8<FUp> E{FUp{(bf16*)(ws + WS_WPQ), 1024}};
        pg8::gemm_phase<pg8::Epi8<FUp>, pg8::StaticOrder, true, true>(ldsl, g, S, E);
    }
    phase0(p, lds, tid, lane, wave, G, 1);
    { const int per = (MTOK + MCTX + NGW - 1) / NGW, r0 = gw * per, nr = min(per, MTOK + MCTX - r0);
      if (nr > 0) norm_rows<true>(p.in[0], p.in[2], MTOK, p.in[6], mx, 0, 1, (bf16*)(ws + WS_HX), nullptr, r0, nr, lane); }
    xcd_barrier(xbar);
    }
    PROBE_POINT(1);
    for (int rep_ = 0; rep_ < REPS(2); ++rep_) {
    {
        pg8::Gemm g{(const bf16*)(ws + WS_HX), (const bf16*)(ws + WS_WIN) + (size_t)512 * 1024, 1024, 1024, 1024};
        pg8::InOrder S; S.G = G; S.c = blockIdx.x; S.a_tile = (size_t)256 * 1024 * 2; S.b_tile = (size_t)256 * 1024 * 2;
        pg8::Epi8<FIn> E{FIn{ws, p.out}};
        pg8::gemm_phase<pg8::Epi8<FIn>, pg8::InOrder, true, true>(ldsl, g, S, E);
    }
    {
        pg8::Gemm g{(const bf16*)(ws + WS_WPQ), (const bf16*)(ws + WS_HX), 1024, 1024, 1024};
        pg8::StaticOrder S; S.init(4, 64, G, blockIdx.x, 1024, 1024);
        pg8::Epi8<FPQ> E{FPQ{(bf16*)(ws + WS_PQT)}};
        pg8::gemm_phase<pg8::Epi8<FPQ>, pg8::StaticOrder, true, true>(ldsl, g, S, E);
    }
    xcd_barrier(xbar);
    }
    PROBE_POINT(2);
    for (int rep_ = 0; rep_ < REPS(3); ++rep_) {
    if (blockIdx.x < 128 && G >= 192) {
        pg8::Gemm g{(const bf16*)(ws + WS_CS), (const bf16*)(ws + WS_PQT), 4096, 4096, 32768};
        pg8::DftOrder S; S.G = 128; S.c = blockIdx.x; S.a_tile = (size_t)256 * 4096 * 2; S.b_tile = (size_t)256 * 32768 * 2;
        pg8::Epi8<FDft> E{FDft{(bf16*)(ws + WS_YF)}};
        pg8::gemm_phase<pg8::Epi8<FDft>, pg8::DftOrder, true, true>(ldsl, g, S, E);
    } else if (G >= 192) {
        for (int it = blockIdx.x - 128; it < 128; it += G - 128) hgrn_mfma_item(p, lds, it);
    } else {
        pg8::Gemm g{(const bf16*)(ws + WS_CS), (const bf16*)(ws + WS_PQT), 4096, 4096, 32768};
        pg8::DftOrder S; S.G = G; S.c = blockIdx.x; S.a_tile = (size_t)256 * 4096 * 2; S.b_tile = (size_t)256 * 32768 * 2;
        pg8::Epi8<FDft> E{FDft{(bf16*)(ws + WS_YF)}};
        pg8::gemm_phase<pg8::Epi8<FDft>, pg8::DftOrder, true, true>(ldsl, g, S, E);
        for (int it = blockIdx.x; it < 128; it += G) hgrn_mfma_item(p, lds, it);
    }
    xcd_barrier(xbar);
    }
    PROBE_POINT(3);
    for (int rep_ = 0; rep_ < REPS(4); ++rep_) {
    phase_yh(p, lane, gw, NGW);
    { LAS float* scr = (LAS float*)((LAS unsigned char*)lds + wave * 16384);
      constexpr int I_UP = 16 * 176, I_DN = 44 * 32;
      for (int it = gw; it < I_UP + I_DN; it += NGW) {
          if (it < I_UP) transpose_item(p.in[14], 1024, DFF2, (bf16*)(ws + WS_WUP), scr, it, lane);
          else transpose_item(p.in[17], DFF, 1024, (bf16*)(ws + WS_WDN), scr, it - I_UP, lane); } }
    xcd_barrier(xbar);
    }
    PROBE_POINT(4);
    for (int rep_ = 0; rep_ < REPS(5); ++rep_) {
    {
        pg8::Gemm g{(const bf16*)(ws + WS_YF), (const bf16*)(ws + WS_WA), 512, 512, 512};
        pg8::StaticOrder S; S.init(64, 4, G, blockIdx.x, 512, 512);
        pg8::Epi8<FYa> E{FYa{(const bf16*)(ws + WS_GA), (bf16*)(ws + WS_TMP)}};
        pg8::gemm_phase<pg8::Epi8<FYa>, pg8::StaticOrder, true, true>(ldsl, g, S, E);
    }
    {
        pg8::Gemm g{(const bf16*)(ws + WS_YH), (const bf16*)(ws + WS_WB), 512, 512, 512};
        pg8::StaticOrder S; S.init(64, 4, G, blockIdx.x, 512, 512);
        pg8::Epi8<FYb> E{FYb{(const bf16*)(ws + WS_GBG), (const bf16*)(ws + WS_TMP), (bf16*)(ws + WS_MRG)}};
        pg8::gemm_phase<pg8::Epi8<FYb>, pg8::StaticOrder, true, true>(ldsl, g, S, E);
    }
    xcd_barrier(xbar);
    }
    PROBE_POINT(5);
    for (int rep_ = 0; rep_ < REPS(6); ++rep_) {
    {
        pg8::Gemm g{(const bf16*)(ws + WS_MRG), (const bf16*)(ws + WS_WOUT), 1024, 1024, 1024};
        pg8::StaticOrder S; S.init(64, 4, G, blockIdx.x, 1024, 1024);
        pg8::Epi8<FRes> E{FRes{p.in[0], p.out, mx, 2}};
        pg8::gemm_phase<pg8::Epi8<FRes>, pg8::StaticOrder, true, true>(ldsl, g, S, E);
    }
    xcd_barrier(xbar);
    }
    PROBE_POINT(6);
    for (int rep_ = 0; rep_ < REPS(7); ++rep_) {
    { const int per = (MTOK + NGW - 1) / NGW, r0 = gw * per, nr = min(per, MTOK - r0);
      if (nr > 0) norm_rows<true>(p.out, p.out, MTOK, p.in[13], mx, 3, 4, (bf16*)(ws + WS_H2), nullptr, r0, nr, lane); }
    xcd_barrier(xbar);
    }
    PROBE_POINT(7);
    {
    for (int hf = 0; hf < 2; ++hf) {
        for (int rep_ = 0; rep_ < REPS(8); ++rep_) {
            pg8::Gemm g{(const bf16*)(ws + WS_H2) + (size_t)hf * 8192 * 1024, (const bf16*)(ws + WS_WUP), 1024, 1024, 1024};
            pg8::StaticOrder S; S.init(32, 22, G, blockIdx.x, 1024, 1024);
            pg8::Epi8<FUp> E{FUp{(bf16*)(ws + WS_Z), DFF2}};
            pg8::gemm_phase<pg8::Epi8<FUp>, pg8::StaticOrder, true, true>(ldsl, g, S, E);
        xcd_barrier(xbar);
        }
        for (int rep_ = 0; rep_ < REPS(9); ++rep_) {
        phase_conv(p, hf, tid, G);
        xcd_barrier(xbar);
        }
    }
    }
    PROBE_POINT(8);
    for (int rep_ = 0; rep_ < REPS(10); ++rep_) {
    {
        pg8::Gemm g{(const bf16*)(ws + WS_A2), (const bf16*)(ws + WS_WDN), DFF, DFF, DFF};
        pg8::StaticOrder S; S.init(64, 4, G, blockIdx.x, DFF, DFF);
        pg8::Epi8<FRes> E{FRes{p.out, (float*)(ws + WS_XO), mx, 5}};
        pg8::gemm_phase<pg8::Epi8<FRes>, pg8::StaticOrder, true, true>(ldsl, g, S, E);
    }
    xcd_barrier(xbar);
    }
    PROBE_POINT(10);
    for (int rep_ = 0; rep_ < REPS(11); ++rep_) {
    { const int per = (MTOK + NGW - 1) / NGW, r0 = gw * per, nr = min(per, MTOK - r0);
      if (nr > 0) norm_rows<false>((const float*)(ws + WS_XO), (const float*)(ws + WS_XO), MTOK, p.in[18], nullptr, 0, 0, nullptr, p.out, r0, nr, lane); }
    }
}

extern "C" void kernel_launch(void* const* d_in, const int* in_sizes, int n_in, void* d_out, int out_size, void* d_ws, size_t ws_size, hipStream_t stream) {
    static int grid = 0;
    if (grid == 0) {
        if (n_in != 19 || out_size != MTOK * DM || ws_size < WS_END) { fprintf(stderr, "kernel_launch: unexpected problem: n_in %d out %d ws %zu\n", n_in, out_size, ws_size); grid = -1; return; }
        int dev = 0, cus = 0, per_cu = 0;
        hipGetDevice(&dev);
        hipDeviceGetAttribute(&cus, hipDeviceAttributeMultiprocessorCount, dev);
        if (hipFuncSetAttribute((const void*)fwd_mega, hipFuncAttributeMaxDynamicSharedMemorySize, LDS_BYTES) != hipSuccess) { fprintf(stderr, "kernel_launch: hipFuncSetAttribute failed\n"); grid = -1; return; }
        if (hipOccupancyMaxActiveBlocksPerMultiprocessor(&per_cu, (const void*)fwd_mega, NTHR, LDS_BYTES) != hipSuccess || per_cu < 1) { fprintf(stderr, "kernel_launch: occupancy query says %d\n", per_cu); per_cu = 1; }
        (void)hipGetLastError();
        grid = cus * (per_cu > 1 ? 1 : per_cu);
        fprintf(stderr, "kernel_launch: grid %d (cus %d, per_cu %d), ws %zu\n", grid, cus, per_cu, ws_size);
    }
    if (grid < 0) return;
    Params p{};
    for (int i = 0; i < 19; ++i) p.in[i] = (const float*)d_in[i];
    p.out = (float*)d_out; p.ws = (unsigned char*)d_ws;
    if (hipMemsetAsync((char*)d_ws + WS_BAR, 0, BAR_BYTES, stream) != hipSuccess) { fprintf(stderr, "kernel_launch: memset failed\n"); return; }
    void* args[] = {&p};
    hipError_t e = hipLaunchCooperativeKernel((const void*)fwd_mega, dim3(grid), dim3(NTHR), args, LDS_BYTES, stream);
    if (e != hipSuccess) fprintf(stderr, "kernel_launch: cooperative launch failed: %s (grid %d)\n", hipGetErrorString(e), grid);
}
```

```cpp
#include <hip/hip_runtime.h>
#include <hip/hip_cooperative_groups.h>
#include <cstdio>
#include <cstdint>
namespace cg = cooperative_groups;

namespace pg8 {
#define PG8_LAS __attribute__((address_space(3)))
typedef unsigned short bf16_t;
typedef short bf16x8 __attribute__((ext_vector_type(8)));
typedef float f32x4 __attribute__((ext_vector_type(4)));
typedef unsigned u32x4 __attribute__((ext_vector_type(4)));
typedef unsigned u32x2 __attribute__((ext_vector_type(2)));
constexpr int BM = 256, BK = 64, HALF = 128, HTB = HALF * BK * 2  , STAGE_BYTES = 8 * HTB, NXCD = 8, WGM = 8;

__host__ __device__ __forceinline__ int lds_byte(int r, int c) { const int st = (r >> 4) * 2 + (c >> 5), rr = r & 15, cc = c & 31, ob = rr * 64 + cc * 2; return st * 1024 + (ob ^ (((ob >> 9) & 1) << 5)); }
__host__ __device__ __forceinline__ void stage_rc(int b, int& R, int& C) { const int st = b / 1024, sb = b % 1024, swz = sb ^ (((sb >> 9) & 1) << 5); R = (st >> 1) * 16 + swz / 64; C = (st & 1) * 32 + (swz % 64) / 2; }
__host__ __device__ __forceinline__ int perm32(int rho) { const int n = rho >> 4, i = rho & 15; return 8 * (i >> 2) + 4 * n + (i & 3); }

struct Unit { int pm, pn, z; };
struct Gemm { const bf16_t* A; const bf16_t* Bt; int K, lda, ldb; };

__device__ __forceinline__ void tile_of(int wgid, int nM, int nN, int& pm, int& pn) {
    const int nwg = nM * nN;
    { const int q = nwg / NXCD, r = nwg % NXCD, xcd = wgid % NXCD, off = wgid / NXCD; wgid = (xcd < r ? xcd * (q + 1) : r * (q + 1) + (xcd - r) * q) + off; }
    const int nig = WGM * nN, gid = wgid / nig, fm = gid * WGM, gsz = (nM - fm) < WGM ? (nM - fm) : WGM;
    pm = fm + ((wgid % nig) % gsz); pn = (wgid % nig) / gsz;
}
struct StaticOrder {
    int nM, nN, nwg, G, c; size_t a_tile, b_tile;
    __device__ __forceinline__ void init(int nM_, int nN_, int G_, int c_, int lda, int ldb) { nM = nM_; nN = nN_; nwg = nM * nN; G = G_; c = c_; a_tile = (size_t)BM * lda * 2; b_tile = (size_t)BM * ldb * 2; }
    __device__ __forceinline__ bool next(int i, Unit& u) const {
        const long L = (long)i * G + c; if (L >= nwg) return false;
        tile_of((int)L, nM, nN, u.pm, u.pn); u.z = 0; return true;
    }
    __device__ __forceinline__ size_t a_off(const Unit& u) const { return (size_t)u.pm * a_tile; }
    __device__ __forceinline__ size_t b_off(const Unit& u) const { return (size_t)u.pn * b_tile; }
};
struct InOrder {
    int G, c; size_t a_tile, b_tile;
    __device__ __forceinline__ bool next(int i, Unit& u) const {
        const long L = (long)i * G + c; if (L >= 1152 + 48) return false;
        if (L < 1152) { tile_of((int)L, 64, 18, u.pm, u.pn); } else { const int j = (int)L - 1152; u.pm = 64 + (j & 7); u.pn = 2 + (j >> 3); }
        u.z = 0; return true;
    }
    __device__ __forceinline__ size_t a_off(const Unit& u) const { return (size_t)u.pm * a_tile; }
    __device__ __forceinline__ size_t b_off(const Unit& u) const { return (size_t)u.pn * b_tile; }
};
struct DftOrder {
    int G, c; size_t a_tile, b_tile;
    __device__ __forceinline__ bool next(int i, Unit& u) const {
        const long L = (long)i * G + c; if (L >= 128) return false;
        u.z = (int)L >> 4; u.pm = ((int)L >> 1) & 7; u.pn = (int)L & 1; return true;
    }
    __device__ __forceinline__ size_t a_off(const Unit& u) const { return (size_t)u.pm * a_tile; }
    __device__ __forceinline__ size_t b_off(const Unit& u) const { return (size_t)u.pn * b_tile + (size_t)u.z * 4096 * 2; }
};

__device__ __forceinline__ unsigned cvt_pk_bf16(float lo, float hi) { unsigned r; asm volatile("v_cvt_pk_bf16_f32 %0, %1, %2" : "=v"(r) : "v"(lo), "v"(hi)); return r; }

template <class F> struct Epi8 {
    static constexpr bool PERM = true;
    F f;
    __device__ __forceinline__ void operator()(const f32x4 (&acc)[2][2][4][2], const Unit& u, int wr, int wc, int fr, int fq) const {
        const int row0 = u.pm * BM + wr * 64 + fr, col0 = u.pn * BM + wc * 32 + 8 * fq;
#pragma unroll
        for (int ai = 0; ai < 2; ++ai)
#pragma unroll
            for (int m = 0; m < 4; ++m) {
#pragma unroll
                for (int bj = 0; bj < 2; ++bj) f(u, row0 + ai * HALF + m * 16, col0 + bj * HALF, acc[ai][bj][m][0], acc[ai][bj][m][1]);
                asm volatile("" ::: "memory");
            }
    }
};

template <class Epi, class Sched, bool ALIGN_EPI = false, bool SP2 = false>
__device__ __forceinline__ void gemm_phase(PG8_LAS unsigned char* lds, const Gemm g, const Sched& S, const Epi& E) {
    int tid_ = threadIdx.x; asm volatile("" : "+v"(tid_));
    const int tid = tid_, wid = __builtin_amdgcn_readfirstlane(tid >> 6), lane = tid & 63, wr = wid >> 2, wc = wid & 3, fr = lane & 15, fq = lane >> 4;
    const int K = g.K, nt = K / BK;
    unsigned voffA[2], voffB[2];
#pragma unroll
    for (int i = 0; i < 2; ++i) { int R, C; stage_rc(tid * 16 + i * 8192, R, C); const int Rb = Epi::PERM ? ((R & ~31) + perm32(R & 31)) : R;
        voffA[i] = (unsigned)(R * g.lda + C) * 2u; voffB[i] = (unsigned)(Rb * g.ldb + C) * 2u; }
    const size_t kstep = (size_t)(BK * 2);
    const size_t hstepA = (size_t)HALF * g.lda * 2, hstepB = (size_t)HALF * g.ldb * 2;
    const unsigned ldsw = (unsigned)wid * 1024u;
    const int aoff = lds_byte(wr * 64 + fr, fq * 8), boff = lds_byte(wc * 32 + fr, fq * 8);
#define PG8_SA(b, h) (((b) * 2 + (h)) * HTB)
#define PG8_SB(b, h) ((4 + (b) * 2 + (h)) * HTB)
#define PG8_STAGE(bufoff, gbase, voff) do { _Pragma("unroll") for (int _i = 0; _i < 2; ++_i) \
        __builtin_amdgcn_global_load_lds((const unsigned*)((const char*)(gbase) + (voff)[_i]), (PG8_LAS unsigned*)(lds + (bufoff) + ldsw + _i * 8192), 16, 0, 0); } while (0)
#define PG8_LDA(dst, b, h) do { _Pragma("unroll") for (int m = 0; m < 4; ++m) _Pragma("unroll") for (int k = 0; k < 2; ++k) dst[m][k] = *(const PG8_LAS bf16x8*)(lds + PG8_SA(b, h) + aoff + m * 2048 + k * 1024); } while (0)
#define PG8_LDB(dst, b, h) do { _Pragma("unroll") for (int n = 0; n < 2; ++n) _Pragma("unroll") for (int k = 0; k < 2; ++k) dst[n][k] = *(const PG8_LAS bf16x8*)(lds + PG8_SB(b, h) + boff + n * 2048 + k * 1024); } while (0)
#define PG8_MMA(ai, bj, At, Bt) do { __builtin_amdgcn_s_setprio(1); _Pragma("unroll") for (int m = 0; m < 4; ++m) _Pragma("unroll") for (int n = 0; n < 2; ++n) _Pragma("unroll") for (int k = 0; k < 2; ++k) \
        acc[ai][bj][m][n] = __builtin_amdgcn_mfma_f32_16x16x32_bf16(Bt[n][k], At[m][k], acc[ai][bj][m][n], 0, 0, 0); __builtin_amdgcn_s_setprio(0); } while (0)
#define PG8_WAIT_V(n) asm volatile("s_waitcnt vmcnt(" #n ")" ::: "memory")
#define PG8_WAIT_L(n) asm volatile("s_waitcnt lgkmcnt(" #n ")" ::: "memory")
#define PG8_BAR __builtin_amdgcn_s_barrier()
#define PG8_SCHED __builtin_amdgcn_sched_barrier(0)
    Unit cur, nxt; int ui = 0;
    if (!S.next(0, cur)) return;
    f32x4 acc[2][2][4][2];
#pragma unroll
    for (int a = 0; a < 2; ++a)
#pragma unroll
        for (int b = 0; b < 2; ++b)
#pragma unroll
            for (int m = 0; m < 4; ++m)
#pragma unroll
                for (int n = 0; n < 2; ++n) acc[a][b][m][n] = (f32x4){0.f, 0.f, 0.f, 0.f};
    bf16x8 At[4][2], B0[2][2], B1[2][2];
    const char* cA = (const char*)g.A + S.a_off(cur); const char* cB = (const char*)g.Bt + S.b_off(cur);
    if constexpr (SP2) {
        PG8_STAGE(PG8_SB(0, 0), cB, voffB); PG8_STAGE(PG8_SB(0, 1), cB + hstepB, voffB); PG8_STAGE(PG8_SA(0, 0), cA, voffA); PG8_STAGE(PG8_SA(0, 1), cA + hstepA, voffA);
        if (wr == 1) PG8_BAR;
        PG8_WAIT_V(2); PG8_BAR;
        PG8_STAGE(PG8_SB(1, 0), cB + kstep, voffB); PG8_STAGE(PG8_SA(1, 0), cA + kstep, voffA); PG8_STAGE(PG8_SB(1, 1), cB + hstepB + kstep, voffB);
        PG8_WAIT_V(6); PG8_BAR;
    } else {
        PG8_STAGE(PG8_SB(0, 0), cB, voffB); PG8_STAGE(PG8_SA(0, 0), cA, voffA); PG8_STAGE(PG8_SB(0, 1), cB + hstepB, voffB); PG8_STAGE(PG8_SA(0, 1), cA + hstepA, voffA);
        if (wr == 1) PG8_BAR;
        PG8_WAIT_V(4); PG8_BAR;
        PG8_STAGE(PG8_SB(1, 0), cB + kstep, voffB); PG8_STAGE(PG8_SA(1, 0), cA + kstep, voffA); PG8_STAGE(PG8_SB(1, 1), cB + hstepB + kstep, voffB);
        PG8_WAIT_V(6); PG8_BAR;
    }
    for (;;) {
        const bool has_next = S.next(ui + 1, nxt);
        const char* nA = has_next ? (const char*)g.A + S.a_off(nxt) : cA; const char* nB = has_next ? (const char*)g.Bt + S.b_off(nxt) : cB;
        for (int t = 0; t < nt; t += 2) {
            const bool last = (t == nt - 2);
            const char* a1 = cA + (size_t)(t + 1) * kstep;
            const char* a2 = last ? nA : cA + (size_t)(t + 2) * kstep; const char* b2 = last ? nB : cB + (size_t)(t + 2) * kstep;
            const char* a3 = a2 + kstep; const char* b3 = b2 + kstep;
            if constexpr (SP2) {
            PG8_LDB(B0, 0, 0); PG8_LDB(B1, 0, 1); PG8_SCHED; PG8_LDA(At, 0, 0); PG8_STAGE(PG8_SA(1, 1), a1 + hstepA, voffA);
            PG8_WAIT_V(8); PG8_WAIT_L(0); PG8_BAR; PG8_MMA(0, 0, At, B0); PG8_MMA(0, 1, At, B1); PG8_BAR; PG8_SCHED;
            PG8_LDA(At, 0, 1); PG8_STAGE(PG8_SB(0, 0), b2, voffB); PG8_STAGE(PG8_SB(0, 1), b2 + hstepB, voffB); PG8_STAGE(PG8_SA(0, 0), a2, voffA);
            PG8_WAIT_V(8); PG8_WAIT_L(0); PG8_BAR; PG8_MMA(1, 0, At, B0); PG8_MMA(1, 1, At, B1); PG8_BAR; PG8_SCHED;
            PG8_LDB(B0, 1, 0); PG8_LDB(B1, 1, 1); PG8_SCHED; PG8_LDA(At, 1, 0); PG8_STAGE(PG8_SA(0, 1), a2 + hstepA, voffA);
            PG8_WAIT_V(8); PG8_WAIT_L(0); PG8_BAR; PG8_MMA(0, 0, At, B0); PG8_MMA(0, 1, At, B1); PG8_BAR; PG8_SCHED;
            PG8_LDA(At, 1, 1); PG8_STAGE(PG8_SB(1, 0), b3, voffB); PG8_STAGE(PG8_SB(1, 1), b3 + hstepB, voffB); PG8_STAGE(PG8_SA(1, 0), a3, voffA);
            PG8_WAIT_V(8); PG8_WAIT_L(0); PG8_BAR; PG8_MMA(1, 0, At, B0); PG8_MMA(1, 1, At, B1); PG8_BAR; PG8_SCHED;
            } else {
            PG8_LDB(B0, 0, 0); PG8_SCHED; PG8_LDA(At, 0, 0); PG8_STAGE(PG8_SA(1, 1), a1 + hstepA, voffA);
            PG8_WAIT_L(8); PG8_BAR; PG8_WAIT_L(0); PG8_MMA(0, 0, At, B0); PG8_BAR; PG8_SCHED;
            PG8_LDB(B1, 0, 1); PG8_STAGE(PG8_SB(0, 0), b2, voffB);
            PG8_BAR; PG8_WAIT_L(0); PG8_MMA(0, 1, At, B1); PG8_BAR;
            PG8_LDA(At, 0, 1); PG8_STAGE(PG8_SA(0, 0), a2, voffA);
            PG8_BAR; PG8_WAIT_L(0); PG8_MMA(1, 0, At, B0); PG8_BAR; PG8_SCHED;
            PG8_STAGE(PG8_SB(0, 1), b2 + hstepB, voffB);
            PG8_WAIT_V(6); PG8_BAR; PG8_MMA(1, 1, At, B1); PG8_BAR;
            PG8_LDB(B0, 1, 0); PG8_SCHED; PG8_LDA(At, 1, 0); PG8_STAGE(PG8_SA(0, 1), a2 + hstepA, voffA);
            PG8_WAIT_L(8); PG8_BAR; PG8_WAIT_L(0); PG8_MMA(0, 0, At, B0); PG8_BAR; PG8_SCHED;
            PG8_LDB(B1, 1, 1); PG8_STAGE(PG8_SB(1, 0), b3, voffB);
            PG8_BAR; PG8_WAIT_L(0); PG8_MMA(0, 1, At, B1); PG8_BAR;
            PG8_LDA(At, 1, 1); PG8_STAGE(PG8_SA(1, 0), a3, voffA);
            PG8_BAR; PG8_WAIT_L(0); PG8_MMA(1, 0, At, B0); PG8_BAR; PG8_SCHED;
            PG8_STAGE(PG8_SB(1, 1), b3 + hstepB, voffB);
            PG8_WAIT_V(6); PG8_BAR; PG8_MMA(1, 1, At, B1); PG8_BAR;
            }
        }
        if constexpr (ALIGN_EPI) { if (wr == 0) PG8_BAR; }
        E(acc, cur, wr, wc, fr, fq);
        if (!has_next) break;
#pragma unroll
        for (int a = 0; a < 2; ++a)
#pragma unroll
            for (int b = 0; b < 2; ++b)
#pragma unroll
                for (int m = 0; m < 4; ++m)
#pragma unroll
                    for (int n = 0; n < 2; ++n) acc[a][b][m][n] = (f32x4){0.f, 0.f, 0.f, 0.f};
        cur = nxt; cA = nA; cB = nB; ++ui;
        if constexpr (ALIGN_EPI) { if (wr == 1) PG8_BAR; }
    }
    PG8_WAIT_V(0);
    if constexpr (!ALIGN_EPI) { if (wr == 0) PG8_BAR; }
    PG8_BAR;
#undef PG8_SA
#undef PG8_SB
#undef PG8_STAGE
#undef PG8_LDA
#undef PG8_LDB
#undef PG8_MMA
#undef PG8_WAIT_V
#undef PG8_WAIT_L
#undef PG8_BAR
#undef PG8_SCHED
}
}

constexpr int DM = 1024, NB = 8, SEQ = 2048, MTOK = NB * SEQ, CTXL = 256, MCTX = NB * CTXL;
constexpr int HGD = 512, DFF = 2816, DFF2 = 5632, INDIM = 5120, NMOD = 6;
constexpr float EPSN = 1e-6f;
constexpr int NWAVES = 8, NTHR = 512;
constexpr int LDS_BYTES = 147456;
#ifndef DUP_MASK
#define DUP_MASK 0
#endif
#define REPS(k) ((((DUP_MASK) >> (k)) & 1) ? 2 : 1)
#ifndef PROBE_K
#define PROBE_K -1
#endif
#ifndef EXTRA_SYNCS
#define EXTRA_SYNCS 0
#endif

constexpr size_t MiB = 1u << 20;
constexpr size_t WS_MX = 0;
constexpr size_t WS_LB = 256 * 1024;
constexpr size_t WS_WFS = 2 * MiB, WS_TCH = 3 * MiB;
constexpr size_t WS_BAR = 512 * 1024, BAR_BYTES = 16384;
constexpr int MISC_OFF = 131072 + 320;
constexpr size_t WS_WIN = 6 * MiB;
constexpr size_t WS_WPQ = 16 * MiB;
constexpr size_t WS_WA = 18 * MiB, WS_WB = 19 * MiB, WS_WOUT = 20 * MiB;
constexpr size_t WS_CS = 22 * MiB;
constexpr size_t WS_WUP = 6 * MiB;
constexpr size_t WS_WDN = 250 * MiB;
constexpr size_t WS_HX = 38 * MiB;
constexpr size_t WS_OF = 38 * MiB, WS_OB = 54 * MiB;
constexpr size_t WS_TMP = 38 * MiB;
constexpr size_t WS_H2 = 38 * MiB;
constexpr size_t WS_Q = 74 * MiB, WS_V = 90 * MiB, WS_OG = 106 * MiB, WS_GA = 122 * MiB, WS_GBG = 154 * MiB, WS_PQT = 186 * MiB;
constexpr size_t WS_GFC = 218 * MiB, WS_GBC = 222 * MiB, WS_VC = 226 * MiB;
constexpr size_t WS_YF = 228 * MiB;
constexpr size_t WS_YH = 74 * MiB;
constexpr size_t WS_MRG = 186 * MiB;
constexpr size_t WS_Z = 74 * MiB;
constexpr size_t WS_A2 = 162 * MiB;
constexpr size_t WS_XO = 38 * MiB;
constexpr size_t WS_END = 256 * MiB;

typedef unsigned short bf16;
typedef float f32x4 __attribute__((ext_vector_type(4)));
typedef unsigned u32x4 __attribute__((ext_vector_type(4)));
typedef unsigned u32x2 __attribute__((ext_vector_type(2)));
typedef float f32x2 __attribute__((ext_vector_type(2)));
#define LAS __attribute__((address_space(3)))

struct Params {
    const float* in[19];
    float* out;
    unsigned char* ws;
};

__device__ __forceinline__ float bf2f(unsigned short b) { return __uint_as_float(((unsigned)b) << 16); }
__device__ __forceinline__ float bflo(unsigned w) { return __uint_as_float(w << 16); }
__device__ __forceinline__ float bfhi(unsigned w) { return __uint_as_float(w & 0xffff0000u); }
__device__ __forceinline__ unsigned f2bf(float f) { unsigned u = __float_as_uint(f); return (u + 0x7fffu + ((u >> 16) & 1u)) >> 16; }
__device__ __forceinline__ unsigned pk2(float lo, float hi) { return f2bf(lo) | (f2bf(hi) << 16); }
__device__ __forceinline__ float sigmoidf_(float x) { return 1.f / (1.f + __expf(-x)); }
__device__ __forceinline__ float siluf_(float x) { return x / (1.f + __expf(-x)); }
__device__ __forceinline__ float wave_sum(float v) {
#pragma unroll
    for (int o = 1; o < 64; o <<= 1) v += __shfl_xor(v, o);
    return v;
}
__device__ __forceinline__ u32x4 pack8(const f32x4 a, const f32x4 b) { u32x4 w; w.x = pk2(a[0], a[1]); w.y = pk2(a[2], a[3]); w.z = pk2(b[0], b[1]); w.w = pk2(b[2], b[3]); return w; }

typedef __attribute__((address_space(1))) unsigned gu32;
#define XB_TMO      128
#define XB_XCNT(j)  (256  + 64 * (j))
#define XB_XSUB(j)  (1280 + 64 * (j))
#define XB_XGEN(j)  (2304 + 64 * (j))
#define XB_TOP      3328
#define XB_TOPGEN   3392
#define XCD_BAR_WORDS 3456
#define XB_SPIN_CAP (1u << 18)

__device__ __forceinline__ unsigned xb_ld(unsigned* p)              { return __hip_atomic_load(p, __ATOMIC_RELAXED, __HIP_MEMORY_SCOPE_AGENT); }
__device__ __forceinline__ unsigned xb_add(unsigned* p, unsigned v) { return __hip_atomic_fetch_add(p, v, __ATOMIC_RELAXED, __HIP_MEMORY_SCOPE_AGENT); }
__device__ __forceinline__ unsigned xb_xcc_id() { return (unsigned)__builtin_amdgcn_s_getreg((3 << 11) | 20) & 0xFu; }
#define XB_SPIN(cond, bar) do { unsigned _sp = 0; while (cond) { __builtin_amdgcn_s_sleep(1); \
    if ((++_sp & 255u) == 0u) { if (xb_ld(&(bar)[XB_TMO])) break; if (_sp > XB_SPIN_CAP) { atomicAdd(&(bar)[XB_TMO], 1u); break; } } } } while (0)

struct XcdBarrier {
    unsigned* bar; unsigned x;
    volatile LAS unsigned* st;
};

__device__ __forceinline__ XcdBarrier xcd_barrier_post(unsigned* bar, volatile LAS unsigned* st) {
    XcdBarrier b; b.bar = bar; b.x = xb_xcc_id(); b.st = st;
    if (threadIdx.x == 0) (void)xb_add(&bar[XB_XCNT(b.x)], 1u);
    return b;
}
__device__ __forceinline__ void xcd_barrier_complete(unsigned* bar, unsigned x, unsigned& nloc, unsigned& nx) {
    const unsigned G = gridDim.x * gridDim.y * gridDim.z;
    unsigned sum, cnt, mine, sp = 0u;
    for (;;) {
        sum = 0u; cnt = 0u; mine = 0u;
#pragma unroll
        for (unsigned j = 0; j < 16; ++j) { const unsigned c = xb_ld(&bar[XB_XCNT(j)]); sum += c; cnt += (c > 0u) ? 1u : 0u; mine = (j == x) ? c : mine; }
        if (sum == G) break;
        __builtin_amdgcn_s_sleep(1);
        if ((++sp & 255u) == 0u) { if (xb_ld(&bar[XB_TMO])) break; if (sp > XB_SPIN_CAP) { atomicAdd(&bar[XB_TMO], 1u); break; } }
    }
    nloc = mine > 0u ? mine : 1u; nx = cnt > 0u ? cnt : 1u;
}

__device__ __forceinline__ void xcd_barrier(const XcdBarrier& b) {
    asm volatile("s_waitcnt vmcnt(0)" ::: "memory");
    __syncthreads();
    if (threadIdx.x == 0) {
        unsigned* bar = b.bar;
        __builtin_amdgcn_s_waitcnt(0);
        unsigned nloc = b.st[0], nx = b.st[1];
        if (nloc == 0u) { xcd_barrier_complete(bar, b.x, nloc, nx); b.st[0] = nloc; b.st[1] = nx; }
        const unsigned old = xb_add(&bar[XB_XSUB(b.x)], 1u);
        const unsigned gen = old / nloc;
        if (old + 1u == (gen + 1u) * nloc) {
            __builtin_amdgcn_fence(__ATOMIC_RELEASE, "agent");
            asm volatile("s_waitcnt vmcnt(0)" ::: "memory");
            const unsigned og = xb_add(&bar[XB_TOP], 1u);
            const unsigned tg = og / nx;
            if (og + 1u == (tg + 1u) * nx) xb_add(&bar[XB_TOPGEN], 1u);
            else XB_SPIN(xb_ld(&bar[XB_TOPGEN]) == tg, bar);
            __builtin_amdgcn_fence(__ATOMIC_ACQUIRE, "agent");
            xb_add(&bar[XB_XGEN(b.x)], 1u);
            asm volatile("s_waitcnt vmcnt(0)" ::: "memory");
        } else {
            XB_SPIN(xb_ld(&bar[XB_XGEN(b.x)]) == gen, bar);
            __builtin_amdgcn_fence(__ATOMIC_ACQUIRE, "agent");
            asm volatile("s_waitcnt vmcnt(0)" ::: "memory");
        }
    }
    __syncthreads();
}


struct FIn {
    unsigned char* ws; float* out;
    __device__ __forceinline__ void operator()(const pg8::Unit& u, int row, int col, f32x4 v0, f32x4 v1) const {
        const int seg = u.pn >> 1, c = col & 511;
        if (seg == 0 || seg == 4) { f32x4 a, b;
#pragma unroll
            for (int i = 0; i < 4; ++i) { a[i] = siluf_(v0[i]); b[i] = siluf_(v1[i]); }
            bf16* dst = (bf16*)(ws + (seg == 0 ? WS_Q : WS_OG));
            *(u32x4*)(dst + (size_t)row * 512 + c) = pack8(a, b);
        } else if (seg == 1 || seg == 2) {
            const float* lb = (const float*)(ws + WS_LB);
            const f32x4 l0 = *(const f32x4*)(lb + c), l1 = *(const f32x4*)(lb + c + 4); f32x4 a, b;
#pragma unroll
            for (int i = 0; i < 4; ++i) { a[i] = l0[i] + (1.f - l0[i]) * sigmoidf_(v0[i]); b[i] = l1[i] + (1.f - l1[i]) * sigmoidf_(v1[i]); }
            float* dst;
            if (u.pm < 64) dst = out + (seg == 1 ? (size_t)0 : (size_t)MTOK * 512) + (size_t)row * 512 + c;
            else dst = (float*)(ws + (seg == 1 ? WS_GFC : WS_GBC)) + (size_t)(row - MTOK) * 512 + c;
            *(f32x4*)dst = a; *(f32x4*)(dst + 4) = b;
        } else if (seg == 3) {
            bf16* dst;
            if (u.pm < 64) dst = (bf16*)(ws + WS_V) + (size_t)row * 512 + c; else dst = (bf16*)(ws + WS_VC) + (size_t)(row - MTOK) * 512 + c;
            *(u32x4*)dst = pack8(v0, v1);
        } else { f32x4 a, b;
#pragma unroll
            for (int i = 0; i < 4; ++i) { a[i] = sigmoidf_(v0[i]); b[i] = sigmoidf_(v1[i]); }
            bf16* dst = (seg < 7) ? ((bf16*)(ws + WS_GA) + (size_t)row * 1024 + (col - 5 * 512)) : ((bf16*)(ws + WS_GBG) + (size_t)row * 1024 + (col - 7 * 512));
            *(u32x4*)dst = pack8(a, b);
        }
    }
};
struct FPQ {
    bf16* pqt;
    __device__ __forceinline__ void operator()(const pg8::Unit&, int row, int col, f32x4 v0, f32x4 v1) const {
        *(u32x4*)(pqt + (size_t)(row & 511) * 32768 + (size_t)(col >> 11) * 4096 + (size_t)(row >> 9) * 2048 + (col & 2047)) = pack8(v0, v1);
    }
};
struct FDft {
    bf16* yf;
    __device__ __forceinline__ void operator()(const pg8::Unit& u, int row, int col, f32x4 v0, f32x4 v1) const {
        *(u32x4*)(yf + ((size_t)u.z * SEQ + row) * 512 + col) = pack8(v0 * (1.f / 512.f), v1 * (1.f / 512.f));
    }
};
struct FYa {
    const bf16* ga; bf16* tmp;
    __device__ __forceinline__ void operator()(const pg8::Unit&, int row, int col, f32x4 v0, f32x4 v1) const {
        const size_t o = (size_t)row * 1024 + col; const u32x4 g = *(const u32x4*)(ga + o);
        f32x4 a, b; a[0] = v0[0] * bflo(g.x); a[1] = v0[1] * bfhi(g.x); a[2] = v0[2] * bflo(g.y); a[3] = v0[3] * bfhi(g.y);
        b[0] = v1[0] * bflo(g.z); b[1] = v1[1] * bfhi(g.z); b[2] = v1[2] * bflo(g.w); b[3] = v1[3] * bfhi(g.w);
        *(u32x4*)(tmp + o) = pack8(a, b);
    }
};
struct FYb {
    const bf16* gbg; const bf16* tmp; bf16* mrg;
    __device__ __forceinline__ void operator()(const pg8::Unit&, int row, int col, f32x4 v0, f32x4 v1) const {
        const size_t o = (size_t)row * 1024 + col; const u32x4 g = *(const u32x4*)(gbg + o); const u32x4 t = *(const u32x4*)(tmp + o);
        f32x4 a, b; a[0] = bflo(t.x) + v0[0] * bflo(g.x); a[1] = bfhi(t.x) + v0[1] * bfhi(g.x); a[2] = bflo(t.y) + v0[2] * bflo(g.y); a[3] = bfhi(t.y) + v0[3] * bfhi(g.y);
        b[0] = bflo(t.z) + v1[0] * bflo(g.z); b[1] = bfhi(t.z) + v1[1] * bfhi(g.z); b[2] = bflo(t.w) + v1[2] * bflo(g.w); b[3] = bfhi(t.w) + v1[3] * bfhi(g.w);
        *(u32x4*)(mrg + o) = pack8(a, b);
    }
};
struct FRes {
    const float* src; float* dst; const float* mx; int mod;
    __device__ __forceinline__ void operator()(const pg8::Unit&, int row, int col, f32x4 v0, f32x4 v1) const {
        const size_t o = (size_t)row * 1024 + col; const float* m = mx + (size_t)(row >> 11) * (NMOD * DM) + mod * DM + col;
        const f32x4 m0 = *(const f32x4*)m, m1 = *(const f32x4*)(m + 4), s0 = *(const f32x4*)(src + o), s1 = *(const f32x4*)(src + o + 4);
        *(f32x4*)(dst + o) = s0 + m0 * v0; *(f32x4*)(dst + o + 4) = s1 + m1 * v1;
    }
};
struct FUp {
    bf16* z; int ld;
    __device__ __forceinline__ void operator()(const pg8::Unit&, int row, int col, f32x4 v0, f32x4 v1) const {
        *(u32x4*)(z + (size_t)row * ld + col) = pack8(v0, v1);
    }
};

__device__ __forceinline__ void transpose_item(const float* W, int K, int N, bf16* WT, LAS float* scr, int item, int lane) {
    const int nblk = N / 32, kb = item / nblk, nb = item % nblk, k0 = 64 * kb, n0 = 32 * nb;
#pragma unroll 8
    for (int i = 0; i < 32; ++i) { const int kk = 2 * i + (lane >> 5); scr[kk * 33 + (lane & 31)] = W[(size_t)(k0 + kk) * N + n0 + (lane & 31)]; }
    asm volatile("s_waitcnt lgkmcnt(0)" ::: "memory");
    const int c = lane & 7;
#pragma unroll
    for (int j = 0; j < 4; ++j) { const int n = (lane >> 3) + 8 * j; const LAS float* s = scr + (8 * c) * 33 + n;
        u32x4 o; o.x = pk2(s[0 * 33], s[1 * 33]); o.y = pk2(s[2 * 33], s[3 * 33]); o.z = pk2(s[4 * 33], s[5 * 33]); o.w = pk2(s[6 * 33], s[7 * 33]);
        *(u32x4*)(WT + (size_t)(n0 + n) * K + k0 + 8 * c) = o; }
    asm volatile("s_waitcnt lgkmcnt(0)" ::: "memory");
}

template <bool MOD>
__device__ __forceinline__ void norm_rows(const float* srcA, const float* srcB, int nA, const float* g, const float* mx, int shift_mod, int scale_mod,
                                          bf16* outb, float* outf, int r0, int nr, int lane) {
    f32x4 G[4], SH[4], cur[4], nxt[4];
    int curmod = -1;
    { const float* s0 = (r0 < nA) ? srcA + (size_t)r0 * DM : srcB + (size_t)(r0 - nA) * DM;
#pragma unroll
      for (int j = 0; j < 4; ++j) cur[j] = *(const f32x4*)(s0 + (lane + 64 * j) * 4); }
#pragma unroll 1
    for (int i = 0; i < nr; ++i) {
        const int m = r0 + i;
        if (i + 1 < nr) { const int m1 = m + 1; const float* s1 = (m1 < nA) ? srcA + (size_t)m1 * DM : srcB + (size_t)(m1 - nA) * DM;
#pragma unroll
            for (int j = 0; j < 4; ++j) nxt[j] = *(const f32x4*)(s1 + (lane + 64 * j) * 4); }
        const int mr = MOD ? ((m < nA) ? (m >> 11) : 8) : 0;
        if (mr != curmod) { curmod = mr;
#pragma unroll
            for (int j = 0; j < 4; ++j) { const int e = (lane + 64 * j) * 4; const f32x4 gg = *(const f32x4*)(g + e);
                if (MOD) { const f32x4 sc = *(const f32x4*)(mx + (size_t)mr * (NMOD * DM) + scale_mod * DM + e); SH[j] = *(const f32x4*)(mx + (size_t)mr * (NMOD * DM) + shift_mod * DM + e); G[j] = gg * (sc + 1.f); }
                else { G[j] = gg; SH[j] = (f32x4){0.f, 0.f, 0.f, 0.f}; } } }
        float s = 0.f;
#pragma unroll
        for (int j = 0; j < 4; ++j) s += (cur[j][0] * cur[j][0] + cur[j][1] * cur[j][1]) + (cur[j][2] * cur[j][2] + cur[j][3] * cur[j][3]);
        const float rinv = rsqrtf(wave_sum(s) * (1.f / DM) + EPSN);
#pragma unroll
        for (int j = 0; j < 4; ++j) { const int e = (lane + 64 * j) * 4; const f32x4 h = cur[j] * rinv * G[j] + SH[j];
            if (MOD) { u32x2 w; w.x = pk2(h[0], h[1]); w.y = pk2(h[2], h[3]); *(u32x2*)(outb + (size_t)m * DM + e) = w; }
            else *(f32x4*)(outf + (size_t)m * DM + e) = h; }
#pragma unroll
        for (int j = 0; j < 4; ++j) cur[j] = nxt[j];
    }
}

__device__ __forceinline__ void phase0(const Params& p, unsigned char* lds, int tid, int lane, int wave, int G, const int part) {
    float* ldsf = (float*)lds;
    float* mxo = (float*)(p.ws + WS_MX);
    if (part == 0) {
    for (int it = blockIdx.x; it < 192; it += G) {
        __syncthreads();
        {
            const float* c = p.in[1]; const float* cc = p.in[3]; const float* aw = p.in[4]; const float* ab = p.in[5];
            float* sc = ldsf;
            float* red = ldsf + 9 * 1024;
            for (int i = tid; i < 9 * 1024; i += NTHR) { const int r = i >> 10, k = i & 1023; const float cv = (r < 8) ? c[r * 1024 + k] : cc[k]; sc[i] = cv / (1.f + __expf(-cv)); }
            __syncthreads();
            const int n0 = it * 32, col = tid & 31, ks = tid >> 5;
            float a[9];
#pragma unroll
            for (int r = 0; r < 9; ++r) a[r] = 0.f;
            for (int k = ks * 64; k < ks * 64 + 64; ++k) { const float w = aw[(size_t)k * (NMOD * DM) + n0 + col];
#pragma unroll
                for (int r = 0; r < 9; ++r) a[r] += sc[r * 1024 + k] * w; }
#pragma unroll
            for (int r = 0; r < 9; ++r) red[(ks * 9 + r) * 32 + col] = a[r];
            __syncthreads();
            if (tid < 288) { const int r = tid >> 5, cl = tid & 31; float s = ab[n0 + cl];
                for (int k2 = 0; k2 < 16; ++k2) s += red[(k2 * 9 + r) * 32 + cl];
                mxo[r * (NMOD * DM) + n0 + cl] = s; }
        }
    }
    __syncthreads();
    { bf16* tch = (bf16*)(p.ws + WS_TCH); bf16* wfs = (bf16*)(p.ws + WS_WFS); const float* win = p.in[7];
      for (int i = blockIdx.x * NTHR + tid; i < 1024 * 64; i += G * NTHR) { const int n = i >> 6, c8 = (i & 63) * 8, gn = (n & 511) >> 7, j = n & 127; float vv[8];
#pragma unroll
          for (int e = 0; e < 8; ++e) { const int cp = c8 + e, idx = ((cp & 127) * j) & 127; const float ang = (float)idx * (1.f / 64.f);
              vv[e] = ((cp >> 7) == gn) ? ((n < 512) ? cospif(ang) : sinpif(ang)) : 0.f; }
          u32x4 w; w.x = pk2(vv[0], vv[1]); w.y = pk2(vv[2], vv[3]); w.z = pk2(vv[4], vv[5]); w.w = pk2(vv[6], vv[7]);
          *(u32x4*)(tch + (size_t)n * 512 + c8) = w;
          const f32x4 a = *(const f32x4*)(win + (size_t)n * INDIM + c8), b2 = *(const f32x4*)(win + (size_t)n * INDIM + c8 + 4);
          *(u32x4*)(wfs + (size_t)n * 512 + c8) = pack8(a, b2); } }
    }
    if (part == 0 && blockIdx.x == G - 1) { const float* hl = p.in[8]; float* lbo = (float*)(p.ws + WS_LB);
        if (tid < 512) { const float a = hl[tid], b = hl[512 + tid]; lbo[tid] = 1.f / (1.f + expf(b - a)); } }
    if (part == 0) return;
    { bf16* cs = (bf16*)(p.ws + WS_CS);
      for (int i = blockIdx.x * NTHR + tid; i < 2048 * 512; i += G * NTHR) { const int l = i >> 9, kc = (i & 511) * 8; float vv[8];
#pragma unroll
          for (int e = 0; e < 8; ++e) { const int k = kc + e, s = k >> 11, kk = k & 2047, ph = (l * kk) & 2047; const float ang = (float)ph * (1.f / 1024.f); vv[e] = s ? -sinpif(ang) : cospif(ang); }
          u32x4 w; w.x = pk2(vv[0], vv[1]); w.y = pk2(vv[2], vv[3]); w.z = pk2(vv[4], vv[5]); w.w = pk2(vv[6], vv[7]);
          *(u32x4*)(cs + (size_t)l * 4096 + kc) = w; } }
    { LAS float* scr = (LAS float*)((LAS unsigned char*)lds + wave * 16384);
      const int gw = blockIdx.x * NWAVES + wave, NGW = G * NWAVES;
      constexpr int I_IN = 16 * 160, I_A = 8 * 32, I_B = 8 * 32, I_O = 16 * 32;
      for (int it = gw; it < I_IN + I_A + I_B + I_O; it += NGW) { int r = it;
          if (r < I_IN) { transpose_item(p.in[7], 1024, INDIM, (bf16*)(p.ws + WS_WIN), scr, r, lane); continue; } r -= I_IN;
          if (r < I_A) { transpose_item(p.in[10], 512, 1024, (bf16*)(p.ws + WS_WA), scr, r, lane); continue; } r -= I_A;
          if (r < I_B) { transpose_item(p.in[11], 512, 1024, (bf16*)(p.ws + WS_WB), scr, r, lane); continue; } r -= I_B;
          transpose_item(p.in[12], 1024, 1024, (bf16*)(p.ws + WS_WOUT), scr, r, lane); } }
}

__device__ __forceinline__ void hgrn_mfma_item(const Params& p, unsigned char* lds, int item) {
    int tid_ = threadIdx.x; asm volatile("" : "+v"(tid_));
    const int tid = tid_, lane = tid & 63, w = __builtin_amdgcn_readfirstlane(tid >> 6), fr = lane & 15, fq = lane >> 4;
    const int vh = item & 1, dir = (item >> 1) & 1, h = (item >> 2) & 3, b = item >> 4;
    bf16* Qs = (bf16*)lds;
    bf16* Ks = Qs + 64 * 136;
    bf16* St = Ks + 64 * 136;
    bf16* Kh = St + 2 * 64 * 136;
    bf16* Vt = Kh + 128 * 72;
    bf16* Ps = Vt + 64 * 72;
    float* Et = (float*)(Ps + 64 * 72);
    const int d = 16 * w + fr;
    const float* fL = p.out + (dir ? (size_t)MTOK * 512 : 0) + (size_t)b * SEQ * 512 + h * 128 + d;
    const float* fC = (const float*)(p.ws + (dir ? WS_GBC : WS_GFC)) + (size_t)b * CTXL * 512 + h * 128 + d;
    const bf16* qL = (const bf16*)(p.ws + WS_Q) + (size_t)b * SEQ * 512 + h * 128 + d;
    const bf16* vL = (const bf16*)(p.ws + WS_V) + (size_t)b * SEQ * 512 + h * 128 + vh * 64 + lane;
    const bf16* vC = (const bf16*)(p.ws + WS_VC) + (size_t)b * CTXL * 512 + h * 128 + vh * 64 + lane;
    bf16* oL = (bf16*)(p.ws + (dir ? WS_OB : WS_OF)) + (size_t)b * SEQ * 512 + h * 128 + vh * 64;
    f32x4 Sa[4];
#pragma unroll
    for (int i = 0; i < 4; ++i) Sa[i] = (f32x4){0.f, 0.f, 0.f, 0.f};
    float fr_[16]; unsigned short qr_[16], vr_[8];
#define HG_LOAD(cc_) do { const int _cc = (cc_); const bool _lat = _cc >= 4; const int _c = _lat ? _cc - 4 : _cc, _n = _lat ? SEQ : CTXL; \
        const float* _f = _lat ? fL : fC; const bf16* _v = _lat ? vL : vC; \
        _Pragma("unroll") for (int i = 0; i < 16; ++i) { const int _s = _c * 64 + fq * 16 + i, _pos = dir ? (_n - 1 - _s) : _s; fr_[i] = _f[(size_t)_pos * 512]; qr_[i] = _lat ? qL[(size_t)_pos * 512] : (unsigned short)0; } \
        _Pragma("unroll") for (int j = 0; j < 8; ++j) { const int _s = _c * 64 + w * 8 + j, _pos = dir ? (_n - 1 - _s) : _s; vr_[j] = _v[(size_t)_pos * 512]; } } while (0)
    HG_LOAD(0);
    for (int cc = 0; cc < 36; ++cc) {
        const bool lat = cc >= 4; const int c = lat ? cc - 4 : cc;
        bf16* Scur = St + (cc & 1) * (64 * 136); bf16* Snxt = St + ((cc & 1) ^ 1) * (64 * 136);
        {
            float ce[16]; float e = 1.f;
#pragma unroll
            for (int i = 0; i < 16; ++i) { e *= fr_[i]; ce[i] = e; }
            const float T0 = __shfl(e, fr), T1 = __shfl(e, fr + 16), T2 = __shfl(e, fr + 32), T3 = __shfl(e, fr + 48);
            const float pre = (fq == 0) ? 1.f : (fq == 1) ? T0 : (fq == 2) ? T0 * T1 : T0 * T1 * T2;
            const float tot = T0 * T1 * T2 * T3;
            if (fq == 0) Et[d] = tot;
            unsigned khw[8];
#pragma unroll
            for (int i = 0; i < 16; i += 2) { float kh2[2];
#pragma unroll
                for (int u = 0; u < 2; ++u) { const float cm = fmaxf(pre * ce[i + u], 1e-30f), ie = __builtin_amdgcn_rcpf(cm), kt = (1.f - fr_[i + u]) * ie; const int sl = fq * 16 + i + u;
                    if (lat) { Qs[sl * 136 + d] = (bf16)f2bf(bf2f(qr_[i + u]) * cm); Ks[sl * 136 + d] = (bf16)f2bf(kt); }
                    kh2[u] = kt * tot; }
                khw[i >> 1] = pk2(kh2[0], kh2[1]); }
            u32x4 k0; k0.x = khw[0]; k0.y = khw[1]; k0.z = khw[2]; k0.w = khw[3]; u32x4 k1; k1.x = khw[4]; k1.y = khw[5]; k1.z = khw[6]; k1.w = khw[7];
            *(u32x4*)(Kh + d * 72 + fq * 16) = k0; *(u32x4*)(Kh + d * 72 + fq * 16 + 8) = k1;
            u32x4 vv; vv.x = (unsigned)vr_[0] | ((unsigned)vr_[1] << 16); vv.y = (unsigned)vr_[2] | ((unsigned)vr_[3] << 16); vv.z = (unsigned)vr_[4] | ((unsigned)vr_[5] << 16); vv.w = (unsigned)vr_[6] | ((unsigned)vr_[7] << 16);
            *(u32x4*)(Vt + lane * 72 + w * 8) = vv;
        }
        if (cc + 1 < 36) HG_LOAD(cc + 1);
        __syncthreads();
        const int ti = w >> 1, x2 = 2 * (w & 1);
        if (lat) {
#pragma unroll
            for (int u2 = 0; u2 < 2; ++u2) { const int si = x2 + u2; f32x4 acc = (f32x4){0.f, 0.f, 0.f, 0.f};
                if (si <= ti) {
#pragma unroll
                    for (int kk = 0; kk < 4; ++kk) { const pg8::bf16x8 a = *(const pg8::bf16x8*)(Ks + (si * 16 + fr) * 136 + kk * 32 + fq * 8), bq = *(const pg8::bf16x8*)(Qs + (ti * 16 + fr) * 136 + kk * 32 + fq * 8);
                        acc = __builtin_amdgcn_mfma_f32_16x16x32_bf16(a, bq, acc, 0, 0, 0); }
                    if (si == ti) {
#pragma unroll
                        for (int r = 0; r < 4; ++r) if (4 * fq + r > fr) acc[r] = 0.f; } }
                u32x2 pw; pw.x = pk2(acc[0], acc[1]); pw.y = pk2(acc[2], acc[3]);
                *(u32x2*)(Ps + (ti * 16 + fr) * 72 + si * 16 + 4 * fq) = pw; }
        }
        {
            const f32x4 et = *(const f32x4*)(Et + w * 16 + 4 * fq);
            pg8::bf16x8 ka[2];
#pragma unroll
            for (int kk = 0; kk < 2; ++kk) ka[kk] = *(const pg8::bf16x8*)(Kh + (w * 16 + fr) * 72 + kk * 32 + fq * 8);
#pragma unroll
            for (int vi = 0; vi < 4; ++vi) { Sa[vi] = Sa[vi] * et;
#pragma unroll
                for (int kk = 0; kk < 2; ++kk) { const pg8::bf16x8 bv = *(const pg8::bf16x8*)(Vt + (vi * 16 + fr) * 72 + kk * 32 + fq * 8);
                    Sa[vi] = __builtin_amdgcn_mfma_f32_16x16x32_bf16(ka[kk], bv, Sa[vi], 0, 0, 0); }
                u32x2 sw; sw.x = pk2(Sa[vi][0], Sa[vi][1]); sw.y = pk2(Sa[vi][2], Sa[vi][3]);
                *(u32x2*)(Snxt + (vi * 16 + fr) * 136 + w * 16 + 4 * fq) = sw; }
        }
        f32x4 Oa[2];
        Oa[0] = (f32x4){0.f, 0.f, 0.f, 0.f}; Oa[1] = (f32x4){0.f, 0.f, 0.f, 0.f};
        if (lat) {
#pragma unroll
            for (int kk = 0; kk < 4; ++kk) { const pg8::bf16x8 bq = *(const pg8::bf16x8*)(Qs + (ti * 16 + fr) * 136 + kk * 32 + fq * 8);
#pragma unroll
                for (int u2 = 0; u2 < 2; ++u2) { const pg8::bf16x8 a = *(const pg8::bf16x8*)(Scur + ((x2 + u2) * 16 + fr) * 136 + kk * 32 + fq * 8);
                    Oa[u2] = __builtin_amdgcn_mfma_f32_16x16x32_bf16(a, bq, Oa[u2], 0, 0, 0); } }
        }
        __syncthreads();
        if (lat) {
#pragma unroll
            for (int kk = 0; kk < 2; ++kk) { const pg8::bf16x8 bp = *(const pg8::bf16x8*)(Ps + (ti * 16 + fr) * 72 + kk * 32 + fq * 8);
#pragma unroll
                for (int u2 = 0; u2 < 2; ++u2) { const pg8::bf16x8 a = *(const pg8::bf16x8*)(Vt + ((x2 + u2) * 16 + fr) * 72 + kk * 32 + fq * 8);
                    Oa[u2] = __builtin_amdgcn_mfma_f32_16x16x32_bf16(a, bp, Oa[u2], 0, 0, 0); } }
            const int sg = c * 64 + ti * 16 + fr, pos = dir ? (SEQ - 1 - sg) : sg;
#pragma unroll
            for (int u2 = 0; u2 < 2; ++u2) { u32x2 ow; ow.x = pk2(Oa[u2][0], Oa[u2][1]); ow.y = pk2(Oa[u2][2], Oa[u2][3]);
                *(u32x2*)(oL + (size_t)pos * 512 + (x2 + u2) * 16 + 4 * fq) = ow; }
        }
        __syncthreads();
    }
#undef HG_LOAD
}

__device__ __forceinline__ void phase_yh(const Params& p, int lane, int gw, int NGW) {
    const bf16* of = (const bf16*)(p.ws + WS_OF); const bf16* ob = (const bf16*)(p.ws + WS_OB); const bf16* og = (const bf16*)(p.ws + WS_OG);
    bf16* yh = (bf16*)(p.ws + WS_YH); const float* on = p.in[9];
    const f32x4 n0 = *(const f32x4*)(on + lane * 8), n1 = *(const f32x4*)(on + lane * 8 + 4);
    const int per = (MTOK + NGW - 1) / NGW, r0 = gw * per, nr = min(per, MTOK - r0);
    if (nr <= 0) return;
    u32x4 a = *(const u32x4*)(of + (size_t)r0 * 512 + lane * 8), b = *(const u32x4*)(ob + (size_t)r0 * 512 + lane * 8), gg = *(const u32x4*)(og + (size_t)r0 * 512 + lane * 8);
#pragma unroll 1
    for (int i = 0; i < nr; ++i) { const size_t o = (size_t)(r0 + i) * 512 + lane * 8;
        u32x4 a1 = a, b1 = b, g1 = gg;
        if (i + 1 < nr) { a1 = *(const u32x4*)(of + o + 512); b1 = *(const u32x4*)(ob + o + 512); g1 = *(const u32x4*)(og + o + 512); }
        float v[8]; v[0] = bflo(a.x) + bflo(b.x); v[1] = bfhi(a.x) + bfhi(b.x); v[2] = bflo(a.y) + bflo(b.y); v[3] = bfhi(a.y) + bfhi(b.y);
        v[4] = bflo(a.z) + bflo(b.z); v[5] = bfhi(a.z) + bfhi(b.z); v[6] = bflo(a.w) + bflo(b.w); v[7] = bfhi(a.w) + bfhi(b.w);
        float s = 0.f;
#pragma unroll
        for (int k = 0; k < 8; ++k) s += v[k] * v[k];
        s += __shfl_xor(s, 1); s += __shfl_xor(s, 2); s += __shfl_xor(s, 4); s += __shfl_xor(s, 8);
        const float rinv = rsqrtf(s * (1.f / 128.f) + EPSN);
        float gv[8]; gv[0] = bflo(gg.x); gv[1] = bfhi(gg.x); gv[2] = bflo(gg.y); gv[3] = bfhi(gg.y); gv[4] = bflo(gg.z); gv[5] = bfhi(gg.z); gv[6] = bflo(gg.w); gv[7] = bfhi(gg.w);
        f32x4 q0, q1;
#pragma unroll
        for (int k = 0; k < 4; ++k) { q0[k] = v[k] * rinv * n0[k] * gv[k]; q1[k] = v[4 + k] * rinv * n1[k] * gv[4 + k]; }
        *(u32x4*)(yh + o) = pack8(q0, q1);
        a = a1; b = b1; gg = g1; }
}

struct ConvRaw { u32x2 a[3], g[3]; };
__device__ __forceinline__ void conv_issue(const bf16* z, int tokbase, int r, int cc, int ch, ConvRaw& q) {
#pragma unroll
    for (int i = 0; i < 3; ++i) { const int rr = r + i - 1;
        if (rr >= 0 && rr < 32 && cc >= 0 && cc < 64) { const size_t zo = (size_t)(tokbase + rr * 64 + cc) * DFF2 + ch;
            q.a[i] = *(const u32x2*)(z + zo); q.g[i] = *(const u32x2*)(z + zo + DFF);
        } else { q.a[i] = (u32x2){0u, 0u}; q.g[i] = (u32x2){0u, 0u}; } }
}
__device__ __forceinline__ void phase_conv(const Params& p, int hf, int tid, int G) {
    const bf16* z = (const bf16*)(p.ws + WS_Z); bf16* a2 = (bf16*)(p.ws + WS_A2) + (size_t)hf * 8192 * DFF;
    const float* cw = p.in[15]; const float* cb = p.in[16];
    for (int it = blockIdx.x * NTHR + tid; it < 4 * 32 * 4 * 704; it += G * NTHR) {
        const int cg4 = it % 704, rest = it / 704, strip = rest & 3, r = (rest >> 2) & 31, img = rest >> 7, ch = cg4 * 4, c0 = strip * 16, tokbase = img * 2048;
        ConvRaw ring[3];
#pragma unroll
        for (int j = 0; j < 3; ++j) conv_issue(z, tokbase, r, c0 - 1 + j, ch, ring[j]);
        f32x2 w1[9][2], w2[9][2];
#pragma unroll
        for (int t = 0; t < 9; ++t) { const f32x4 a = *(const f32x4*)(cw + (size_t)t * DFF2 + ch), g = *(const f32x4*)(cw + (size_t)t * DFF2 + DFF + ch);
            w1[t][0] = (f32x2){a[0], a[1]}; w1[t][1] = (f32x2){a[2], a[3]}; w2[t][0] = (f32x2){g[0], g[1]}; w2[t][1] = (f32x2){g[2], g[3]}; }
        const f32x4 b1 = *(const f32x4*)(cb + ch), b2 = *(const f32x4*)(cb + DFF + ch);
        f32x2 W1[3][3][2], W2[3][3][2];
#pragma unroll
        for (int j = 0; j < 18; ++j) {
            const int sl = j % 3;
#pragma unroll
            for (int i = 0; i < 3; ++i) { const u32x2 a = ring[j % 3].a[i], g = ring[j % 3].g[i];
                W1[sl][i][0] = (f32x2){bflo(a.x), bfhi(a.x)}; W1[sl][i][1] = (f32x2){bflo(a.y), bfhi(a.y)};
                W2[sl][i][0] = (f32x2){bflo(g.x), bfhi(g.x)}; W2[sl][i][1] = (f32x2){bflo(g.y), bfhi(g.y)}; }
            if (j + 3 < 18) conv_issue(z, tokbase, r, c0 - 1 + j + 3, ch, ring[j % 3]);
            if (j >= 2) {
                const int sL = (j - 2) % 3, sC = (j - 1) % 3, sR = j % 3;
                f32x2 o1[2], o2[2];
                o1[0] = (f32x2){b1[0], b1[1]}; o1[1] = (f32x2){b1[2], b1[3]}; o2[0] = (f32x2){b2[0], b2[1]}; o2[1] = (f32x2){b2[2], b2[3]};
#pragma unroll
                for (int i = 0; i < 3; ++i)
#pragma unroll
                    for (int e = 0; e < 2; ++e) {
                        o1[e] = __builtin_elementwise_fma(W1[sL][i][e], w1[i * 3 + 0][e], o1[e]); o1[e] = __builtin_elementwise_fma(W1[sC][i][e], w1[i * 3 + 1][e], o1[e]); o1[e] = __builtin_elementwise_fma(W1[sR][i][e], w1[i * 3 + 2][e], o1[e]);
                        o2[e] = __builtin_elementwise_fma(W2[sL][i][e], w2[i * 3 + 0][e], o2[e]); o2[e] = __builtin_elementwise_fma(W2[sC][i][e], w2[i * 3 + 1][e], o2[e]); o2[e] = __builtin_elementwise_fma(W2[sR][i][e], w2[i * 3 + 2][e], o2[e]); }
                u32x2 ow; ow.x = pk2(siluf_(o1[0][0]) * o2[0][0], siluf_(o1[0][1]) * o2[0][1]); ow.y = pk2(siluf_(o1[1][0]) * o2[1][0], siluf_(o1[1][1]) * o2[1][1]);
                *(u32x2*)(a2 + (size_t)(tokbase + r * 64 + c0 + j - 2) * DFF + ch) = ow;
            }
        }
    }
}

__global__ void __launch_bounds__(NTHR, 2) fwd_mega(Params p) {
    extern __shared__ __attribute__((aligned(16))) unsigned char lds[];
    cg::grid_group grid = cg::this_grid();
    const int tid = threadIdx.x, lane = tid & 63, wave = __builtin_amdgcn_readfirstlane(tid >> 6);
    const int G = gridDim.x, gw = blockIdx.x * NWAVES + wave, NGW = G * NWAVES;
    PG8_LAS unsigned char* ldsl = (PG8_LAS unsigned char*)lds;
    unsigned char* ws = p.ws;
    const float* mx = (const float*)(ws + WS_MX);
    volatile LAS unsigned* misc = (volatile LAS unsigned*)((LAS unsigned char*)lds + MISC_OFF);
    if (tid < 16) misc[tid] = 0u;
    __syncthreads();
    const XcdBarrier xbar = xcd_barrier_post((unsigned*)(ws + WS_BAR), misc + 8);
    const unsigned long long t0_ = (PROBE_K >= 0) ? __builtin_amdgcn_s_memrealtime() : 0ull;
#define PROBE_POINT(k) do { if (PROBE_K == (k) && tid == 0) { const unsigned long long _n = __builtin_amdgcn_s_memrealtime(), _d = _n - t0_; while (__builtin_amdgcn_s_memrealtime() - _n < _d) __builtin_amdgcn_s_sleep(8); } } while (0)

    for (int rep_ = 0; rep_ < REPS(0); ++rep_) {
    phase0(p, lds, tid, lane, wave, G, 0);
    phase0(p, lds, tid, lane, wave, G, 1);
    xcd_barrier(xbar);
    if (G == 0x7fffffff) grid.sync();
    }
    for (int xs_ = 0; xs_ < EXTRA_SYNCS; ++xs_) xcd_barrier(xbar);
    PROBE_POINT(0);
    for (int rep_ = 0; rep_ < REPS(1); ++rep_) {
    if (blockIdx.x < 16 && G >= 16) {
        pg8::Gemm g{(const bf16*)(ws + WS_TCH), (const bf16*)(ws + WS_WFS), 512, 512, 512};
        pg8::StaticOrder S; S.init(4, 4, 16, blockIdx.x, 512, 512);
        pg8::Epi8<FUp> E{FUp{(bf16*)(ws + WS_WPQ), 1024}};
        pg8::gemm_phase<pg8::Epi8<FUp>, pg8::StaticOrder, true, true>(ldsl, g, S, E);
    }
    { const int per = (MTOK + MCTX + NGW - 1) / NGW, r0 = gw * per, nr = min(per, MTOK + MCTX - r0);
      if (nr > 0) norm_rows<true>(p.in[0], p.in[2], MTOK, p.in[6], mx, 0, 1, (bf16*)(ws + WS_HX), nullptr, r0, nr, lane); }
    xcd_barrier(xbar);
    }
    PROBE_POINT(1);
    for (int rep_ = 0; rep_ < REPS(2); ++rep_) {
    {
        pg8::Gemm g{(const bf16*)(ws + WS_HX), (const bf16*)(ws + WS_WIN) + (size_t)512 * 1024, 1024, 1024, 1024};
        pg8::InOrder S; S.G = G; S.c = blockIdx.x; S.a_tile = (size_t)256 * 1024 * 2; S.b_tile = (size_t)256 * 1024 * 2;
        pg8::Epi8<FIn> E{FIn{ws, p.out}};
        pg8::gemm_phase<pg8::Epi8<FIn>, pg8::InOrder, true, true>(ldsl, g, S, E);
    }
    {
        pg8::Gemm g{(const bf16*)(ws + WS_WPQ), (const bf16*)(ws + WS_HX), 1024, 1024, 1024};
        pg8::StaticOrder S; S.init(4, 64, G, blockIdx.x, 1024, 1024);
        pg8::Epi8<FPQ> E{FPQ{(bf16*)(ws + WS_PQT)}};
        pg8::gemm_phase<pg8::Epi8<FPQ>, pg8::StaticOrder, true, true>(ldsl, g, S, E);
    }
    xcd_barrier(xbar);
    }
    PROBE_POINT(2);
    for (int rep_ = 0; rep_ < REPS(3); ++rep_) {
    if (blockIdx.x < 128 && G >= 192) {
        pg8::Gemm g{(const bf16*)(ws + WS_CS), (const bf16*)(ws + WS_PQT), 4096, 4096, 32768};
        pg8::DftOrder S; S.G = 128; S.c = blockIdx.x; S.a_tile = (size_t)256 * 4096 * 2; S.b_tile = (size_t)256 * 32768 * 2;
        pg8::Epi8<FDft> E{FDft{(bf16*)(ws + WS_YF)}};
        pg8::gemm_phase<pg8::Epi8<FDft>, pg8::DftOrder, true, true>(ldsl, g, S, E);
    } else if (G >= 192) {
        for (int it = blockIdx.x - 128; it < 128; it += G - 128) hgrn_mfma_item(p, lds, it);
    } else {
        pg8::Gemm g{(const bf16*)(ws + WS_CS), (const bf16*)(ws + WS_PQT), 4096, 4096, 32768};
        pg8::DftOrder S; S.G = G; S.c = blockIdx.x; S.a_tile = (size_t)256 * 4096 * 2; S.b_tile = (size_t)256 * 32768 * 2;
        pg8::Epi8<FDft> E{FDft{(bf16*)(ws + WS_YF)}};
        pg8::gemm_phase<pg8::Epi8<FDft>, pg8::DftOrder, true, true>(ldsl, g, S, E);
        for (int it = blockIdx.x; it < 128; it += G) hgrn_mfma_item(p, lds, it);
    }
    xcd_barrier(xbar);
    }
    PROBE_POINT(3);
    for (int rep_ = 0; rep_ < REPS(4); ++rep_) {
    phase_yh(p, lane, gw, NGW);
    { LAS float* scr = (LAS float*)((LAS unsigned char*)lds + wave * 16384);
      constexpr int I_UP = 16 * 176, I_DN = 44 * 32;
      for (int it = gw; it < I_UP + I_DN; it += NGW) {
          if (it < I_UP) transpose_item(p.in[14], 1024, DFF2, (bf16*)(ws + WS_WUP), scr, it, lane);
          else transpose_item(p.in[17], DFF, 1024, (bf16*)(ws + WS_WDN), scr, it - I_UP, lane); } }
    xcd_barrier(xbar);
    }
    PROBE_POINT(4);
    for (int rep_ = 0; rep_ < REPS(5); ++rep_) {
    {
        pg8::Gemm g{(const bf16*)(ws + WS_YF), (const bf16*)(ws + WS_WA), 512, 512, 512};
        pg8::StaticOrder S; S.init(64, 4, G, blockIdx.x, 512, 512);
        pg8::Epi8<FYa> E{FYa{(const bf16*)(ws + WS_GA), (bf16*)(ws + WS_TMP)}};
        pg8::gemm_phase<pg8::Epi8<FYa>, pg8::StaticOrder, true, true>(ldsl, g, S, E);
    }
    {
        pg8::Gemm g{(const bf16*)(ws + WS_YH), (const bf16*)(ws + WS_WB), 512, 512, 512};
        pg8::StaticOrder S; S.init(64, 4, G, blockIdx.x, 512, 512);
        pg8::Epi8<FYb> E{FYb{(const bf16*)(ws + WS_GBG), (const bf16*)(ws + WS_TMP), (bf16*)(ws + WS_MRG)}};
        pg8::gemm_phase<pg8::Epi8<FYb>, pg8::StaticOrder, true, true>(ldsl, g, S, E);
    }
    xcd_barrier(xbar);
    }
    PROBE_POINT(5);
    for (int rep_ = 0; rep_ < REPS(6); ++rep_) {
    {
        pg8::Gemm g{(const bf16*)(ws + WS_MRG), (const bf16*)(ws + WS_WOUT), 1024, 1024, 1024};
        pg8::StaticOrder S; S.init(64, 4, G, blockIdx.x, 1024, 1024);
        pg8::Epi8<FRes> E{FRes{p.in[0], p.out, mx, 2}};
        pg8::gemm_phase<pg8::Epi8<FRes>, pg8::StaticOrder, true, true>(ldsl, g, S, E);
    }
    xcd_barrier(xbar);
    }
    PROBE_POINT(6);
    for (int rep_ = 0; rep_ < REPS(7); ++rep_) {
    { const int per = (MTOK + NGW - 1) / NGW, r0 = gw * per, nr = min(per, MTOK - r0);
      if (nr > 0) norm_rows<true>(p.out, p.out, MTOK, p.in[13], mx, 3, 4, (bf16*)(ws + WS_H2), nullptr, r0, nr, lane); }
    xcd_barrier(xbar);
    }
    PROBE_POINT(7);
    {
    for (int hf = 0; hf < 2; ++hf) {
        for (int rep_ = 0; rep_ < REPS(8); ++rep_) {
            pg8::Gemm g{(const bf16*)(ws + WS_H2) + (size_t)hf * 8192 * 1024, (const bf16*)(ws + WS_WUP), 1024, 1024, 1024};
            pg8::StaticOrder S; S.init(32, 22, G, blockIdx.x, 1024, 1024);
            pg8::Epi8<FUp> E{FUp{(bf16*)(ws + WS_Z), DFF2}};
            pg8::gemm_phase<pg8::Epi8<FUp>, pg8::StaticOrder, true, true>(ldsl, g, S, E);
        xcd_barrier(xbar);
        }
        for (int rep_ = 0; rep_ < REPS(9); ++rep_) {
        phase_conv(p, hf, tid, G);
        xcd_barrier(xbar);
        }
    }
    }
    PROBE_POINT(8);
    for (int rep_ = 0; rep_ < REPS(10); ++rep_) {
    {
        pg8::Gemm g{(const bf16*)(ws + WS_A2), (const bf16*)(ws + WS_WDN), DFF, DFF, DFF};
        pg8::StaticOrder S; S.init(64, 4, G, blockIdx.x, DFF, DFF);
        pg8::Epi8<FRes> E{FRes{p.out, (float*)(ws + WS_XO), mx, 5}};
        pg8::gemm_phase<pg8::Epi8<FRes>, pg8::StaticOrder, true, true>(ldsl, g, S, E);
    }
    xcd_barrier(xbar);
    }
    PROBE_POINT(10);
    for (int rep_ = 0; rep_ < REPS(11); ++rep_) {
    { const int per = (MTOK + NGW - 1) / NGW, r0 = gw * per, nr = min(per, MTOK - r0);
      if (nr > 0) norm_rows<false>((const float*)(ws + WS_XO), (const float*)(ws + WS_XO), MTOK, p.in[18], nullptr, 0, 0, nullptr, p.out, r0, nr, lane); }
    }
}

extern "C" void kernel_launch(void* const* d_in, const int* in_sizes, int n_in, void* d_out, int out_size, void* d_ws, size_t ws_size, hipStream_t stream) {
    static int grid = 0;
    if (grid == 0) {
        if (n_in != 19 || out_size != MTOK * DM || ws_size < WS_END) { fprintf(stderr, "kernel_launch: unexpected problem: n_in %d out %d ws %zu\n", n_in, out_size, ws_size); grid = -1; return; }
        int dev = 0, cus = 0, per_cu = 0;
        hipGetDevice(&dev);
        hipDeviceGetAttribute(&cus, hipDeviceAttributeMultiprocessorCount, dev);
        if (hipFuncSetAttribute((const void*)fwd_mega, hipFuncAttributeMaxDynamicSharedMemorySize, LDS_BYTES) != hipSuccess) { fprintf(stderr, "kernel_launch: hipFuncSetAttribute failed\n"); grid = -1; return; }
        if (hipOccupancyMaxActiveBlocksPerMultiprocessor(&per_cu, (const void*)fwd_mega, NTHR, LDS_BYTES) != hipSuccess || per_cu < 1) { fprintf(stderr, "kernel_launch: occupancy query says %d\n", per_cu); per_cu = 1; }
        (void)hipGetLastError();
        grid = cus * (per_cu > 1 ? 1 : per_cu);
        fprintf(stderr, "kernel_launch: grid %d (cus %d, per_cu %d), ws %zu\n", grid, cus, per_cu, ws_size);
    }
    if (grid < 0) return;
    Params p{};
    for (int i = 0; i < 19; ++i) p.in[i] = (const float*)d_in[i];
    p.out = (float*)d_out; p.ws = (unsigned char*)d_ws;
    if (hipMemsetAsync((char*)d_ws + WS_BAR, 0, BAR_BYTES, stream) != hipSuccess) { fprintf(stderr, "kernel_launch: memset failed\n"); return; }
    void* args[] = {&p};
    hipError_t e = hipLaunchCooperativeKernel((const void*)fwd_mega, dim3(grid), dim3(NTHR), args, LDS_BYTES, stream);
    if (e != hipSuccess) fprintf(stderr, "kernel_launch: cooperative launch failed: %s (grid %d)\n", hipGetErrorString(e), grid);
}
```

```cpp
#include <hip/hip_runtime.h>
#include <hip/hip_cooperative_groups.h>
#include <cstdio>
#include <cstdint>
namespace cg = cooperative_groups;

namespace pg8 {
#define PG8_LAS __attribute__((address_space(3)))
typedef unsigned short bf16_t;
typedef short bf16x8 __attribute__((ext_vector_type(8)));
typedef float f32x4 __attribute__((ext_vector_type(4)));
typedef unsigned u32x4 __attribute__((ext_vector_type(4)));
typedef unsigned u32x2 __attribute__((ext_vector_type(2)));
constexpr int BM = 256, BK = 64, HALF = 128, HTB = HALF * BK * 2  , STAGE_BYTES = 8 * HTB, NXCD = 8, WGM = 8;

__host__ __device__ __forceinline__ int lds_byte(int r, int c) { const int st = (r >> 4) * 2 + (c >> 5), rr = r & 15, cc = c & 31, ob = rr * 64 + cc * 2; return st * 1024 + (ob ^ (((ob >> 9) & 1) << 5)); }
__host__ __device__ __forceinline__ void stage_rc(int b, int& R, int& C) { const int st = b / 1024, sb = b % 1024, swz = sb ^ (((sb >> 9) & 1) << 5); R = (st >> 1) * 16 + swz / 64; C = (st & 1) * 32 + (swz % 64) / 2; }
__host__ __device__ __forceinline__ int perm32(int rho) { const int n = rho >> 4, i = rho & 15; return 8 * (i >> 2) + 4 * n + (i & 3); }

struct Unit { int pm, pn, z; };
struct Gemm { const bf16_t* A; const bf16_t* Bt; int K, lda, ldb; };

__device__ __forceinline__ void tile_of(int wgid, int nM, int nN, int& pm, int& pn) {
    const int nwg = nM * nN;
    { const int q = nwg / NXCD, r = nwg % NXCD, xcd = wgid % NXCD, off = wgid / NXCD; wgid = (xcd < r ? xcd * (q + 1) : r * (q + 1) + (xcd - r) * q) + off; }
    const int nig = WGM * nN, gid = wgid / nig, fm = gid * WGM, gsz = (nM - fm) < WGM ? (nM - fm) : WGM;
    pm = fm + ((wgid % nig) % gsz); pn = (wgid % nig) / gsz;
}
struct StaticOrder {
    int nM, nN, nwg, G, c; size_t a_tile, b_tile;
    __device__ __forceinline__ void init(int nM_, int nN_, int G_, int c_, int lda, int ldb) { nM = nM_; nN = nN_; nwg = nM * nN; G = G_; c = c_; a_tile = (size_t)BM * lda * 2; b_tile = (size_t)BM * ldb * 2; }
    __device__ __forceinline__ bool next(int i, Unit& u) const {
        const long L = (long)i * G + c; if (L >= nwg) return false;
        tile_of((int)L, nM, nN, u.pm, u.pn); u.z = 0; return true;
    }
    __device__ __forceinline__ size_t a_off(const Unit& u) const { return (size_t)u.pm * a_tile; }
    __device__ __forceinline__ size_t b_off(const Unit& u) const { return (size_t)u.pn * b_tile; }
};
struct InOrder {
    int G, c; size_t a_tile, b_tile;
    __device__ __forceinline__ bool next(int i, Unit& u) const {
        const long L = (long)i * G + c; if (L >= 1152 + 48) return false;
        if (L < 1152) { tile_of((int)L, 64, 18, u.pm, u.pn); } else { const int j = (int)L - 1152; u.pm = 64 + (j & 7); u.pn = 2 + (j >> 3); }
        u.z = 0; return true;
    }
    __device__ __forceinline__ size_t a_off(const Unit& u) const { return (size_t)u.pm * a_tile; }
    __device__ __forceinline__ size_t b_off(const Unit& u) const { return (size_t)u.pn * b_tile; }
};
struct DftOrder {
    int G, c; size_t a_tile, b_tile;
    __device__ __forceinline__ bool next(int i, Unit& u) const {
        const long L = (long)i * G + c; if (L >= 128) return false;
        u.z = (int)L >> 4; u.pm = ((int)L >> 1) & 7; u.pn = (int)L & 1; return true;
    }
    __device__ __forceinline__ size_t a_off(const Unit& u) const { return (size_t)u.pm * a_tile; }
    __device__ __forceinline__ size_t b_off(const Unit& u) const { return (size_t)u.pn * b_tile + (size_t)u.z * 4096 * 2; }
};

__device__ __forceinline__ unsigned cvt_pk_bf16(float lo, float hi) { unsigned r; asm volatile("v_cvt_pk_bf16_f32 %0, %1, %2" : "=v"(r) : "v"(lo), "v"(hi)); return r; }

template <class F> struct Epi8 {
    static constexpr bool PERM = true;
    F f;
    __device__ __forceinline__ void operator()(const f32x4 (&acc)[2][2][4][2], const Unit& u, int wr, int wc, int fr, int fq) const {
        const int row0 = u.pm * BM + wr * 64 + fr, col0 = u.pn * BM + wc * 32 + 8 * fq;
#pragma unroll
        for (int ai = 0; ai < 2; ++ai)
#pragma unroll
            for (int m = 0; m < 4; ++m) {
#pragma unroll
                for (int bj = 0; bj < 2; ++bj) f(u, row0 + ai * HALF + m * 16, col0 + bj * HALF, acc[ai][bj][m][0], acc[ai][bj][m][1]);
                asm volatile("" ::: "memory");
            }
    }
};

template <class Epi, class Sched, bool ALIGN_EPI = false, bool SP2 = false>
__device__ __forceinline__ void gemm_phase(PG8_LAS unsigned char* lds, const Gemm g, const Sched& S, const Epi& E) {
    int tid_ = threadIdx.x; asm volatile("" : "+v"(tid_));
    const int tid = tid_, wid = __builtin_amdgcn_readfirstlane(tid >> 6), lane = tid & 63, wr = wid >> 2, wc = wid & 3, fr = lane & 15, fq = lane >> 4;
    const int K = g.K, nt = K / BK;
    unsigned voffA[2], voffB[2];
#pragma unroll
    for (int i = 0; i < 2; ++i) { int R, C; stage_rc(tid * 16 + i * 8192, R, C); const int Rb = Epi::PERM ? ((R & ~31) + perm32(R & 31)) : R;
        voffA[i] = (unsigned)(R * g.lda + C) * 2u; voffB[i] = (unsigned)(Rb * g.ldb + C) * 2u; }
    const size_t kstep = (size_t)(BK * 2);
    const size_t hstepA = (size_t)HALF * g.lda * 2, hstepB = (size_t)HALF * g.ldb * 2;
    const unsigned ldsw = (unsigned)wid * 1024u;
    const int aoff = lds_byte(wr * 64 + fr, fq * 8), boff = lds_byte(wc * 32 + fr, fq * 8);
#define PG8_SA(b, h) (((b) * 2 + (h)) * HTB)
#define PG8_SB(b, h) ((4 + (b) * 2 + (h)) * HTB)
#define PG8_STAGE(bufoff, gbase, voff) do { _Pragma("unroll") for (int _i = 0; _i < 2; ++_i) \
        __builtin_amdgcn_global_load_lds((const unsigned*)((const char*)(gbase) + (voff)[_i]), (PG8_LAS unsigned*)(lds + (bufoff) + ldsw + _i * 8192), 16, 0, 0); } while (0)
#define PG8_LDA(dst, b, h) do { _Pragma("unroll") for (int m = 0; m < 4; ++m) _Pragma("unroll") for (int k = 0; k < 2; ++k) dst[m][k] = *(const PG8_LAS bf16x8*)(lds + PG8_SA(b, h) + aoff + m * 2048 + k * 1024); } while (0)
#define PG8_LDB(dst, b, h) do { _Pragma("unroll") for (int n = 0; n < 2; ++n) _Pragma("unroll") for (int k = 0; k < 2; ++k) dst[n][k] = *(const PG8_LAS bf16x8*)(lds + PG8_SB(b, h) + boff + n * 2048 + k * 1024); } while (0)
#define PG8_MMA(ai, bj, At, Bt) do { __builtin_amdgcn_s_setprio(1); _Pragma("unroll") for (int m = 0; m < 4; ++m) _Pragma("unroll") for (int n = 0; n < 2; ++n) _Pragma("unroll") for (int k = 0; k < 2; ++k) \
        acc[ai][bj][m][n] = __builtin_amdgcn_mfma_f32_16x16x32_bf16(Bt[n][k], At[m][k], acc[ai][bj][m][n], 0, 0, 0); __builtin_amdgcn_s_setprio(0); } while (0)
#define PG8_WAIT_V(n) asm volatile("s_waitcnt vmcnt(" #n ")" ::: "memory")
#define PG8_WAIT_L(n) asm volatile("s_waitcnt lgkmcnt(" #n ")" ::: "memory")
#define PG8_BAR __builtin_amdgcn_s_barrier()
#define PG8_SCHED __builtin_amdgcn_sched_barrier(0)
    Unit cur, nxt; int ui = 0;
    if (!S.next(0, cur)) return;
    f32x4 acc[2][2][4][2];
#pragma unroll
    for (int a = 0; a < 2; ++a)
#pragma unroll
        for (int b = 0; b < 2; ++b)
#pragma unroll
            for (int m = 0; m < 4; ++m)
#pragma unroll
                for (int n = 0; n < 2; ++n) acc[a][b][m][n] = (f32x4){0.f, 0.f, 0.f, 0.f};
    bf16x8 At[4][2], B0[2][2], B1[2][2];
    const char* cA = (const char*)g.A + S.a_off(cur); const char* cB = (const char*)g.Bt + S.b_off(cur);
    if constexpr (SP2) {
        PG8_STAGE(PG8_SB(0, 0), cB, voffB); PG8_STAGE(PG8_SB(0, 1), cB + hstepB, voffB); PG8_STAGE(PG8_SA(0, 0), cA, voffA); PG8_STAGE(PG8_SA(0, 1), cA + hstepA, voffA);
        if (wr == 1) PG8_BAR;
        PG8_WAIT_V(2); PG8_BAR;
        PG8_STAGE(PG8_SB(1, 0), cB + kstep, voffB); PG8_STAGE(PG8_SA(1, 0), cA + kstep, voffA); PG8_STAGE(PG8_SB(1, 1), cB + hstepB + kstep, voffB);
        PG8_WAIT_V(6); PG8_BAR;
    } else {
        PG8_STAGE(PG8_SB(0, 0), cB, voffB); PG8_STAGE(PG8_SA(0, 0), cA, voffA); PG8_STAGE(PG8_SB(0, 1), cB + hstepB, voffB); PG8_STAGE(PG8_SA(0, 1), cA + hstepA, voffA);
        if (wr == 1) PG8_BAR;
        PG8_WAIT_V(4); PG8_BAR;
        PG8_STAGE(PG8_SB(1, 0), cB + kstep, voffB); PG8_STAGE(PG8_SA(1, 0), cA + kstep, voffA); PG8_STAGE(PG8_SB(1, 1), cB + hstepB + kstep, voffB);
        PG8_WAIT_V(6); PG8_BAR;
    }
    for (;;) {
        const bool has_next = S.next(ui + 1, nxt);
        const char* nA = has_next ? (const char*)g.A + S.a_off(nxt) : cA; const char* nB = has_next ? (const char*)g.Bt + S.b_off(nxt) : cB;
        for (int t = 0; t < nt; t += 2) {
            const bool last = (t == nt - 2);
            const char* a1 = cA + (size_t)(t + 1) * kstep;
            const char* a2 = last ? nA : cA + (size_t)(t + 2) * kstep; const char* b2 = last ? nB : cB + (size_t)(t + 2) * kstep;
            const char* a3 = a2 + kstep; const char* b3 = b2 + kstep;
            if constexpr (SP2) {
            PG8_LDB(B0, 0, 0); PG8_LDB(B1, 0, 1); PG8_SCHED; PG8_LDA(At, 0, 0); PG8_STAGE(PG8_SA(1, 1), a1 + hstepA, voffA);
            PG8_WAIT_V(8); PG8_WAIT_L(0); PG8_BAR; PG8_MMA(0, 0, At, B0); PG8_MMA(0, 1, At, B1); PG8_BAR; PG8_SCHED;
            PG8_LDA(At, 0, 1); PG8_STAGE(PG8_SB(0, 0), b2, voffB); PG8_STAGE(PG8_SB(0, 1), b2 + hstepB, voffB); PG8_STAGE(PG8_SA(0, 0), a2, voffA);
            PG8_WAIT_V(8); PG8_WAIT_L(0); PG8_BAR; PG8_MMA(1, 0, At, B0); PG8_MMA(1, 1, At, B1); PG8_BAR; PG8_SCHED;
            PG8_LDB(B0, 1, 0); PG8_LDB(B1, 1, 1); PG8_SCHED; PG8_LDA(At, 1, 0); PG8_STAGE(PG8_SA(0, 1), a2 + hstepA, voffA);
            PG8_WAIT_V(8); PG8_WAIT_L(0); PG8_BAR; PG8_MMA(0, 0, At, B0); PG8_MMA(0, 1, At, B1); PG8_BAR; PG8_SCHED;
            PG8_LDA(At, 1, 1); PG8_STAGE(PG8_SB(1, 0), b3, voffB); PG8_STAGE(PG8_SB(1, 1), b3 + hstepB, voffB); PG8_STAGE(PG8_SA(1, 0), a3, voffA);
            PG8_WAIT_V(8); PG8_WAIT_L(0); PG8_BAR; PG8_MMA(1, 0, At, B0); PG8_MMA(1, 1, At, B1); PG8_BAR; PG8_SCHED;
            } else {
            PG8_LDB(B0, 0, 0); PG8_SCHED; PG8_LDA(At, 0, 0); PG8_STAGE(PG8_SA(1, 1), a1 + hstepA, voffA);
            PG8_WAIT_L(8); PG8_BAR; PG8_WAIT_L(0); PG8_MMA(0, 0, At, B0); PG8_BAR; PG8_SCHED;
            PG8_LDB(B1, 0, 1); PG8_STAGE(PG8_SB(0, 0), b2, voffB);
            PG8_BAR; PG8_WAIT_L(0); PG8_MMA(0, 1, At, B1); PG8_BAR;
            PG8_LDA(At, 0, 1); PG8_STAGE(PG8_SA(0, 0), a2, voffA);
            PG8_BAR; PG8_WAIT_L(0); PG8_MMA(1, 0, At, B0); PG8_BAR; PG8_SCHED;
            PG8_STAGE(PG8_SB(0, 1), b2 + hstepB, voffB);
            PG8_WAIT_V(6); PG8_BAR; PG8_MMA(1, 1, At, B1); PG8_BAR;
            PG8_LDB(B0, 1, 0); PG8_SCHED; PG8_LDA(At, 1, 0); PG8_STAGE(PG8_SA(0, 1), a2 + hstepA, voffA);
            PG8_WAIT_L(8); PG8_BAR; PG8_WAIT_L(0); PG8_MMA(0, 0, At, B0); PG8_BAR; PG8_SCHED;
            PG8_LDB(B1, 1, 1); PG8_STAGE(PG8_SB(1, 0), b3, voffB);
            PG8_BAR; PG8_WAIT_L(0); PG8_MMA(0, 1, At, B1); PG8_BAR;
            PG8_LDA(At, 1, 1); PG8_STAGE(PG8_SA(1, 0), a3, voffA);
            PG8_BAR; PG8_WAIT_L(0); PG8_MMA(1, 0, At, B0); PG8_BAR; PG8_SCHED;
            PG8_STAGE(PG8_SB(1, 1), b3 + hstepB, voffB);
            PG8_WAIT_V(6); PG8_BAR; PG8_MMA(1, 1, At, B1); PG8_BAR;
            }
        }
        if constexpr (ALIGN_EPI) { if (wr == 0) PG8_BAR; }
        E(acc, cur, wr, wc, fr, fq);
        if (!has_next) break;
#pragma unroll
        for (int a = 0; a < 2; ++a)
#pragma unroll
            for (int b = 0; b < 2; ++b)
#pragma unroll
                for (int m = 0; m < 4; ++m)
#pragma unroll
                    for (int n = 0; n < 2; ++n) acc[a][b][m][n] = (f32x4){0.f, 0.f, 0.f, 0.f};
        cur = nxt; cA = nA; cB = nB; ++ui;
        if constexpr (ALIGN_EPI) { if (wr == 1) PG8_BAR; }
    }
    PG8_WAIT_V(0);
    if constexpr (!ALIGN_EPI) { if (wr == 0) PG8_BAR; }
    PG8_BAR;
#undef PG8_SA
#undef PG8_SB
#undef PG8_STAGE
#undef PG8_LDA
#undef PG8_LDB
#undef PG8_MMA
#undef PG8_WAIT_V
#undef PG8_WAIT_L
#undef PG8_BAR
#undef PG8_SCHED
}
}

constexpr int DM = 1024, NB = 8, SEQ = 2048, MTOK = NB * SEQ, CTXL = 256, MCTX = NB * CTXL;
constexpr int HGD = 512, DFF = 2816, DFF2 = 5632, INDIM = 5120, NMOD = 6;
constexpr float EPSN = 1e-6f;
constexpr int NWAVES = 8, NTHR = 512;
constexpr int LDS_BYTES = 147456;
#ifndef DUP_MASK
#define DUP_MASK 0
#endif
#define REPS(k) ((((DUP_MASK) >> (k)) & 1) ? 2 : 1)
#ifndef PROBE_K
#define PROBE_K -1
#endif
#ifndef EXTRA_SYNCS
#define EXTRA_SYNCS 0
#endif

constexpr size_t MiB = 1u << 20;
constexpr size_t WS_MX = 0;
constexpr size_t WS_LB = 256 * 1024;
constexpr size_t WS_WFS = 2 * MiB, WS_TCH = 3 * MiB;
constexpr size_t WS_BAR = 512 * 1024, BAR_BYTES = 16384;
constexpr int MISC_OFF = 147456 - 128;
constexpr size_t WS_WIN = 6 * MiB;
constexpr size_t WS_WPQ = 16 * MiB;
constexpr size_t WS_WA = 18 * MiB, WS_WB = 19 * MiB, WS_WOUT = 20 * MiB;
constexpr size_t WS_CS = 22 * MiB;
constexpr size_t WS_WUP = 6 * MiB;
constexpr size_t WS_WDN = 250 * MiB;
constexpr size_t WS_HX = 38 * MiB;
constexpr size_t WS_OF = 38 * MiB, WS_OB = 54 * MiB;
constexpr size_t WS_TMP = 38 * MiB;
constexpr size_t WS_H2 = 38 * MiB;
constexpr size_t WS_Q = 74 * MiB, WS_V = 90 * MiB, WS_OG = 106 * MiB, WS_GA = 122 * MiB, WS_GBG = 154 * MiB, WS_PQT = 186 * MiB;
constexpr size_t WS_GFC = 218 * MiB, WS_GBC = 222 * MiB, WS_VC = 226 * MiB;
constexpr size_t WS_YF = 228 * MiB;
constexpr size_t WS_YH = 74 * MiB;
constexpr size_t WS_MRG = 186 * MiB;
constexpr size_t WS_Z = 74 * MiB;
constexpr size_t WS_A2 = 162 * MiB;
constexpr size_t WS_XO = 38 * MiB;
constexpr size_t WS_END = 256 * MiB;

typedef unsigned short bf16;
typedef float f32x4 __attribute__((ext_vector_type(4)));
typedef unsigned u32x4 __attribute__((ext_vector_type(4)));
typedef unsigned u32x2 __attribute__((ext_vector_type(2)));
typedef float f32x2 __attribute__((ext_vector_type(2)));
#define LAS __attribute__((address_space(3)))

struct Params {
    const float* in[19];
    float* out;
    unsigned char* ws;
};

__device__ __forceinline__ float bf2f(unsigned short b) { return __uint_as_float(((unsigned)b) << 16); }
__device__ __forceinline__ float bflo(unsigned w) { return __uint_as_float(w << 16); }
__device__ __forceinline__ float bfhi(unsigned w) { return __uint_as_float(w & 0xffff0000u); }
__device__ __forceinline__ unsigned f2bf(float f) { unsigned u = __float_as_uint(f); return (u + 0x7fffu + ((u >> 16) & 1u)) >> 16; }
__device__ __forceinline__ unsigned pk2(float lo, float hi);
typedef __bf16 bf16x2_t __attribute__((ext_vector_type(2)));
__device__ __forceinline__ unsigned hwpk2(float lo, float hi) { const f32x2 v = {lo, hi}; const bf16x2_t r = __builtin_convertvector(v, bf16x2_t); return __builtin_bit_cast(unsigned, r); }
__device__ __forceinline__ unsigned pk2(float lo, float hi) { return hwpk2(lo, hi); }
__device__ __forceinline__ float sigmoidf_(float x) { return 1.f / (1.f + __expf(-x)); }
__device__ __forceinline__ float siluf_(float x) { return x / (1.f + __expf(-x)); }
__device__ __forceinline__ float wave_sum(float v) {
#pragma unroll
    for (int o = 1; o < 64; o <<= 1) v += __shfl_xor(v, o);
    return v;
}
__device__ __forceinline__ u32x4 pack8(const f32x4 a, const f32x4 b) { u32x4 w; w.x = pk2(a[0], a[1]); w.y = pk2(a[2], a[3]); w.z = pk2(b[0], b[1]); w.w = pk2(b[2], b[3]); return w; }

typedef __attribute__((address_space(1))) unsigned gu32;
#define XB_TMO      128
#define XB_XCNT(j)  (256  + 64 * (j))
#define XB_XSUB(j)  (1280 + 64 * (j))
#define XB_XGEN(j)  (2304 + 64 * (j))
#define XB_TOP      3328
#define XB_TOPGEN   3392
#define XCD_BAR_WORDS 3456
#define XB_SPIN_CAP (1u << 18)

__device__ __forceinline__ unsigned xb_ld(unsigned* p)              { return __hip_atomic_load(p, __ATOMIC_RELAXED, __HIP_MEMORY_SCOPE_AGENT); }
__device__ __forceinline__ unsigned xb_add(unsigned* p, unsigned v) { return __hip_atomic_fetch_add(p, v, __ATOMIC_RELAXED, __HIP_MEMORY_SCOPE_AGENT); }
__device__ __forceinline__ unsigned xb_xcc_id() { return (unsigned)__builtin_amdgcn_s_getreg((3 << 11) | 20) & 0xFu; }
#define XB_SPIN(cond, bar) do { unsigned _sp = 0; while (cond) { __builtin_amdgcn_s_sleep(1); \
    if ((++_sp & 255u) == 0u) { if (xb_ld(&(bar)[XB_TMO])) break; if (_sp > XB_SPIN_CAP) { atomicAdd(&(bar)[XB_TMO], 1u); break; } } } } while (0)

struct XcdBarrier {
    unsigned* bar; unsigned x;
    volatile LAS unsigned* st;
};

__device__ __forceinline__ XcdBarrier xcd_barrier_post(unsigned* bar, volatile LAS unsigned* st) {
    XcdBarrier b; b.bar = bar; b.x = xb_xcc_id(); b.st = st;
    if (threadIdx.x == 0) (void)xb_add(&bar[XB_XCNT(b.x)], 1u);
    return b;
}
__device__ __forceinline__ void xcd_barrier_complete(unsigned* bar, unsigned x, unsigned& nloc, unsigned& nx) {
    const unsigned G = gridDim.x * gridDim.y * gridDim.z;
    unsigned sum, cnt, mine, sp = 0u;
    for (;;) {
        sum = 0u; cnt = 0u; mine = 0u;
#pragma unroll
        for (unsigned j = 0; j < 16; ++j) { const unsigned c = xb_ld(&bar[XB_XCNT(j)]); sum += c; cnt += (c > 0u) ? 1u : 0u; mine = (j == x) ? c : mine; }
        if (sum == G) break;
        __builtin_amdgcn_s_sleep(1);
        if ((++sp & 255u) == 0u) { if (xb_ld(&bar[XB_TMO])) break; if (sp > XB_SPIN_CAP) { atomicAdd(&bar[XB_TMO], 1u); break; } }
    }
    nloc = mine > 0u ? mine : 1u; nx = cnt > 0u ? cnt : 1u;
}

__device__ __forceinline__ void xcd_barrier(const XcdBarrier& b) {
    asm volatile("s_waitcnt vmcnt(0)" ::: "memory");
    __syncthreads();
    if (threadIdx.x == 0) {
        unsigned* bar = b.bar;
        __builtin_amdgcn_s_waitcnt(0);
        unsigned nloc = b.st[0], nx = b.st[1];
        if (nloc == 0u) { xcd_barrier_complete(bar, b.x, nloc, nx); b.st[0] = nloc; b.st[1] = nx; }
        const unsigned old = xb_add(&bar[XB_XSUB(b.x)], 1u);
        const unsigned gen = old / nloc;
        if (old + 1u == (gen + 1u) * nloc) {
            __builtin_amdgcn_fence(__ATOMIC_RELEASE, "agent");
            asm volatile("s_waitcnt vmcnt(0)" ::: "memory");
            const unsigned og = xb_add(&bar[XB_TOP], 1u);
            const unsigned tg = og / nx;
            if (og + 1u == (tg + 1u) * nx) xb_add(&bar[XB_TOPGEN], 1u);
            else XB_SPIN(xb_ld(&bar[XB_TOPGEN]) == tg, bar);
            __builtin_amdgcn_fence(__ATOMIC_ACQUIRE, "agent");
            xb_add(&bar[XB_XGEN(b.x)], 1u);
            asm volatile("s_waitcnt vmcnt(0)" ::: "memory");
        } else {
            XB_SPIN(xb_ld(&bar[XB_XGEN(b.x)]) == gen, bar);
            __builtin_amdgcn_fence(__ATOMIC_ACQUIRE, "agent");
            asm volatile("s_waitcnt vmcnt(0)" ::: "memory");
        }
    }
    __syncthreads();
}


struct FIn {
    unsigned char* ws; float* out;
    __device__ __forceinline__ void operator()(const pg8::Unit& u, int row, int col, f32x4 v0, f32x4 v1) const {
        const int seg = u.pn >> 1, c = col & 511;
        if (seg == 0 || seg == 4) { f32x4 a, b;
#pragma unroll
            for (int i = 0; i < 4; ++i) { a[i] = siluf_(v0[i]); b[i] = siluf_(v1[i]); }
            bf16* dst = (bf16*)(ws + (seg == 0 ? WS_Q : WS_OG));
            *(u32x4*)(dst + (size_t)row * 512 + c) = pack8(a, b);
        } else if (seg == 1 || seg == 2) {
            const float* lb = (const float*)(ws + WS_LB);
            const f32x4 l0 = *(const f32x4*)(lb + c), l1 = *(const f32x4*)(lb + c + 4); f32x4 a, b;
#pragma unroll
            for (int i = 0; i < 4; ++i) { a[i] = l0[i] + (1.f - l0[i]) * sigmoidf_(v0[i]); b[i] = l1[i] + (1.f - l1[i]) * sigmoidf_(v1[i]); }
            float* dst;
            if (u.pm < 64) dst = out + (seg == 1 ? (size_t)0 : (size_t)MTOK * 512) + (size_t)row * 512 + c;
            else dst = (float*)(ws + (seg == 1 ? WS_GFC : WS_GBC)) + (size_t)(row - MTOK) * 512 + c;
            *(f32x4*)dst = a; *(f32x4*)(dst + 4) = b;
        } else if (seg == 3) {
            bf16* dst;
            if (u.pm < 64) dst = (bf16*)(ws + WS_V) + (size_t)row * 512 + c; else dst = (bf16*)(ws + WS_VC) + (size_t)(row - MTOK) * 512 + c;
            *(u32x4*)dst = pack8(v0, v1);
        } else { f32x4 a, b;
#pragma unroll
            for (int i = 0; i < 4; ++i) { a[i] = sigmoidf_(v0[i]); b[i] = sigmoidf_(v1[i]); }
            bf16* dst = (seg < 7) ? ((bf16*)(ws + WS_GA) + (size_t)row * 1024 + (col - 5 * 512)) : ((bf16*)(ws + WS_GBG) + (size_t)row * 1024 + (col - 7 * 512));
            *(u32x4*)dst = pack8(a, b);
        }
    }
};
struct FPQ {
    bf16* pqt;
    __device__ __forceinline__ void operator()(const pg8::Unit&, int row, int col, f32x4 v0, f32x4 v1) const {
        *(u32x4*)(pqt + (size_t)(row & 511) * 32768 + (size_t)(col >> 11) * 4096 + (size_t)(row >> 9) * 2048 + (col & 2047)) = pack8(v0, v1);
    }
};
struct FDft {
    bf16* yf;
    __device__ __forceinline__ void operator()(const pg8::Unit& u, int row, int col, f32x4 v0, f32x4 v1) const {
        *(u32x4*)(yf + ((size_t)u.z * SEQ + row) * 512 + col) = pack8(v0 * (1.f / 512.f), v1 * (1.f / 512.f));
    }
};
struct FYa {
    const bf16* ga; bf16* tmp;
    __device__ __forceinline__ void operator()(const pg8::Unit&, int row, int col, f32x4 v0, f32x4 v1) const {
        const size_t o = (size_t)row * 1024 + col; const u32x4 g = *(const u32x4*)(ga + o);
        f32x4 a, b; a[0] = v0[0] * bflo(g.x); a[1] = v0[1] * bfhi(g.x); a[2] = v0[2] * bflo(g.y); a[3] = v0[3] * bfhi(g.y);
        b[0] = v1[0] * bflo(g.z); b[1] = v1[1] * bfhi(g.z); b[2] = v1[2] * bflo(g.w); b[3] = v1[3] * bfhi(g.w);
        *(u32x4*)(tmp + o) = pack8(a, b);
    }
};
struct FYb {
    const bf16* gbg; const bf16* tmp; bf16* mrg;
    __device__ __forceinline__ void operator()(const pg8::Unit&, int row, int col, f32x4 v0, f32x4 v1) const {
        const size_t o = (size_t)row * 1024 + col; const u32x4 g = *(const u32x4*)(gbg + o); const u32x4 t = *(const u32x4*)(tmp + o);
        f32x4 a, b; a[0] = bflo(t.x) + v0[0] * bflo(g.x); a[1] = bfhi(t.x) + v0[1] * bfhi(g.x); a[2] = bflo(t.y) + v0[2] * bflo(g.y); a[3] = bfhi(t.y) + v0[3] * bfhi(g.y);
        b[0] = bflo(t.z) + v1[0] * bflo(g.z); b[1] = bfhi(t.z) + v1[1] * bfhi(g.z); b[2] = bflo(t.w) + v1[2] * bflo(g.w); b[3] = bfhi(t.w) + v1[3] * bfhi(g.w);
        *(u32x4*)(mrg + o) = pack8(a, b);
    }
};
struct FRes {
    const float* src; float* dst; const float* mx; int mod;
    __device__ __forceinline__ void operator()(const pg8::Unit&, int row, int col, f32x4 v0, f32x4 v1) const {
        const size_t o = (size_t)row * 1024 + col; const float* m = mx + (size_t)(row >> 11) * (NMOD * DM) + mod * DM + col;
        const f32x4 m0 = *(const f32x4*)m, m1 = *(const f32x4*)(m + 4), s0 = *(const f32x4*)(src + o), s1 = *(const f32x4*)(src + o + 4);
        *(f32x4*)(dst + o) = s0 + m0 * v0; *(f32x4*)(dst + o + 4) = s1 + m1 * v1;
    }
};
struct FUp {
    bf16* z; int ld;
    __device__ __forceinline__ void operator()(const pg8::Unit&, int row, int col, f32x4 v0, f32x4 v1) const {
        *(u32x4*)(z + (size_t)row * ld + col) = pack8(v0, v1);
    }
};

__device__ __forceinline__ void transpose_item(const float* W, int K, int N, bf16* WT, LAS float* scr, int item, int lane) {
    const int nblk = N / 32, kb = item / nblk, nb = item % nblk, k0 = 64 * kb, n0 = 32 * nb;
#pragma unroll 8
    for (int i = 0; i < 32; ++i) { const int kk = 2 * i + (lane >> 5); scr[kk * 33 + (lane & 31)] = W[(size_t)(k0 + kk) * N + n0 + (lane & 31)]; }
    asm volatile("s_waitcnt lgkmcnt(0)" ::: "memory");
    const int c = lane & 7;
#pragma unroll
    for (int j = 0; j < 4; ++j) { const int n = (lane >> 3) + 8 * j; const LAS float* s = scr + (8 * c) * 33 + n;
        u32x4 o; o.x = pk2(s[0 * 33], s[1 * 33]); o.y = pk2(s[2 * 33], s[3 * 33]); o.z = pk2(s[4 * 33], s[5 * 33]); o.w = pk2(s[6 * 33], s[7 * 33]);
        *(u32x4*)(WT + (size_t)(n0 + n) * K + k0 + 8 * c) = o; }
    asm volatile("s_waitcnt lgkmcnt(0)" ::: "memory");
}

template <bool MOD>
__device__ __forceinline__ void norm_rows(const float* srcA, const float* srcB, int nA, const float* g, const float* mx, int shift_mod, int scale_mod,
                                          bf16* outb, float* outf, int r0, int nr, int lane) {
    f32x4 G[4], SH[4], cur[4], nxt[4];
    int curmod = -1;
    { const float* s0 = (r0 < nA) ? srcA + (size_t)r0 * DM : srcB + (size_t)(r0 - nA) * DM;
#pragma unroll
      for (int j = 0; j < 4; ++j) cur[j] = *(const f32x4*)(s0 + (lane + 64 * j) * 4); }
#pragma unroll 1
    for (int i = 0; i < nr; ++i) {
        const int m = r0 + i;
        if (i + 1 < nr) { const int m1 = m + 1; const float* s1 = (m1 < nA) ? srcA + (size_t)m1 * DM : srcB + (size_t)(m1 - nA) * DM;
#pragma unroll
            for (int j = 0; j < 4; ++j) nxt[j] = *(const f32x4*)(s1 + (lane + 64 * j) * 4); }
        const int mr = MOD ? ((m < nA) ? (m >> 11) : 8) : 0;
        if (mr != curmod) { curmod = mr;
#pragma unroll
            for (int j = 0; j < 4; ++j) { const int e = (lane + 64 * j) * 4; const f32x4 gg = *(const f32x4*)(g + e);
                if (MOD) { const f32x4 sc = *(const f32x4*)(mx + (size_t)mr * (NMOD * DM) + scale_mod * DM + e); SH[j] = *(const f32x4*)(mx + (size_t)mr * (NMOD * DM) + shift_mod * DM + e); G[j] = gg * (sc + 1.f); }
                else { G[j] = gg; SH[j] = (f32x4){0.f, 0.f, 0.f, 0.f}; } } }
        float s = 0.f;
#pragma unroll
        for (int j = 0; j < 4; ++j) s += (cur[j][0] * cur[j][0] + cur[j][1] * cur[j][1]) + (cur[j][2] * cur[j][2] + cur[j][3] * cur[j][3]);
        const float rinv = rsqrtf(wave_sum(s) * (1.f / DM) + EPSN);
#pragma unroll
        for (int j = 0; j < 4; ++j) { const int e = (lane + 64 * j) * 4; const f32x4 h = cur[j] * rinv * G[j] + SH[j];
            if (MOD) { u32x2 w; w.x = pk2(h[0], h[1]); w.y = pk2(h[2], h[3]); *(u32x2*)(outb + (size_t)m * DM + e) = w; }
            else *(f32x4*)(outf + (size_t)m * DM + e) = h; }
#pragma unroll
        for (int j = 0; j < 4; ++j) cur[j] = nxt[j];
    }
}

__device__ __forceinline__ void phase0(const Params& p, unsigned char* lds, int tid, int lane, int wave, int G, const int part) {
    float* ldsf = (float*)lds;
    float* mxo = (float*)(p.ws + WS_MX);
    if (part == 0) {
    for (int it = blockIdx.x; it < 192; it += G) {
        __syncthreads();
        {
            const float* c = p.in[1]; const float* cc = p.in[3]; const float* aw = p.in[4]; const float* ab = p.in[5];
            float* sc = ldsf;
            float* red = ldsf + 9 * 1024;
            for (int i = tid; i < 9 * 1024; i += NTHR) { const int r = i >> 10, k = i & 1023; const float cv = (r < 8) ? c[r * 1024 + k] : cc[k]; sc[i] = cv / (1.f + __expf(-cv)); }
            __syncthreads();
            const int n0 = it * 32, col = tid & 31, ks = tid >> 5;
            float a[9];
#pragma unroll
            for (int r = 0; r < 9; ++r) a[r] = 0.f;
            for (int k = ks * 64; k < ks * 64 + 64; ++k) { const float w = aw[(size_t)k * (NMOD * DM) + n0 + col];
#pragma unroll
                for (int r = 0; r < 9; ++r) a[r] += sc[r * 1024 + k] * w; }
#pragma unroll
            for (int r = 0; r < 9; ++r) red[(ks * 9 + r) * 32 + col] = a[r];
            __syncthreads();
            if (tid < 288) { const int r = tid >> 5, cl = tid & 31; float s = ab[n0 + cl];
                for (int k2 = 0; k2 < 16; ++k2) s += red[(k2 * 9 + r) * 32 + cl];
                mxo[r * (NMOD * DM) + n0 + cl] = s; }
        }
    }
    __syncthreads();
    { bf16* tch = (bf16*)(p.ws + WS_TCH); bf16* wfs = (bf16*)(p.ws + WS_WFS); const float* win = p.in[7];
      for (int i = blockIdx.x * NTHR + tid; i < 1024 * 64; i += G * NTHR) { const int n = i >> 6, c8 = (i & 63) * 8, gn = (n & 511) >> 7, j = n & 127; float vv[8];
#pragma unroll
          for (int e = 0; e < 8; ++e) { const int cp = c8 + e, idx = ((cp & 127) * j) & 127; const float ang = (float)idx * (1.f / 64.f);
              vv[e] = ((cp >> 7) == gn) ? ((n < 512) ? cospif(ang) : sinpif(ang)) : 0.f; }
          u32x4 w; w.x = pk2(vv[0], vv[1]); w.y = pk2(vv[2], vv[3]); w.z = pk2(vv[4], vv[5]); w.w = pk2(vv[6], vv[7]);
          *(u32x4*)(tch + (size_t)n * 512 + c8) = w;
          const f32x4 a = *(const f32x4*)(win + (size_t)n * INDIM + c8), b2 = *(const f32x4*)(win + (size_t)n * INDIM + c8 + 4);
          *(u32x4*)(wfs + (size_t)n * 512 + c8) = pack8(a, b2); } }
    }
    if (part == 0 && blockIdx.x == G - 1) { const float* hl = p.in[8]; float* lbo = (float*)(p.ws + WS_LB);
        if (tid < 512) { const float a = hl[tid], b = hl[512 + tid]; lbo[tid] = 1.f / (1.f + expf(b - a)); } }
    if (part == 0) return;
    { bf16* cs = (bf16*)(p.ws + WS_CS);
      for (int i = blockIdx.x * NTHR + tid; i < 2048 * 512; i += G * NTHR) { const int l = i >> 9, kc = (i & 511) * 8; float vv[8];
#pragma unroll
          for (int e = 0; e < 8; ++e) { const int k = kc + e, s = k >> 11, kk = k & 2047, ph = (l * kk) & 2047; const float ang = (float)ph * (1.f / 1024.f); vv[e] = s ? -sinpif(ang) : cospif(ang); }
          u32x4 w; w.x = pk2(vv[0], vv[1]); w.y = pk2(vv[2], vv[3]); w.z = pk2(vv[4], vv[5]); w.w = pk2(vv[6], vv[7]);
          *(u32x4*)(cs + (size_t)l * 4096 + kc) = w; } }
    { LAS float* scr = (LAS float*)((LAS unsigned char*)lds + wave * 16384);
      const int gw = blockIdx.x * NWAVES + wave, NGW = G * NWAVES;
      constexpr int I_IN = 16 * 160, I_A = 8 * 32, I_B = 8 * 32, I_O = 16 * 32;
      for (int it = gw; it < I_IN + I_A + I_B + I_O; it += NGW) { int r = it;
          if (r < I_IN) { transpose_item(p.in[7], 1024, INDIM, (bf16*)(p.ws + WS_WIN), scr, r, lane); continue; } r -= I_IN;
          if (r < I_A) { transpose_item(p.in[10], 512, 1024, (bf16*)(p.ws + WS_WA), scr, r, lane); continue; } r -= I_A;
          if (r < I_B) { transpose_item(p.in[11], 512, 1024, (bf16*)(p.ws + WS_WB), scr, r, lane); continue; } r -= I_B;
          transpose_item(p.in[12], 1024, 1024, (bf16*)(p.ws + WS_WOUT), scr, r, lane); } }
}

__device__ __forceinline__ void hgrn_mfma_item(const Params& p, unsigned char* lds, int item) {
    int tid_ = threadIdx.x; asm volatile("" : "+v"(tid_));
    const int tid = tid_, lane = tid & 63, w = __builtin_amdgcn_readfirstlane(tid >> 6), fr = lane & 15, fq = lane >> 4;
    const int vh = item & 1, dir = (item >> 1) & 1, h = (item >> 2) & 3, b = item >> 4;
    bf16* Qs = (bf16*)lds;
    bf16* Ks = Qs + 64 * 136;
    bf16* St = Ks + 64 * 136;
    bf16* Kh = St + 2 * 64 * 136;
    bf16* Vt = Kh + 128 * 72;
    bf16* Ps = Vt + 64 * 72;
    float* Et = (float*)(Ps + 64 * 72);
    float* Fr = Et + 128;
    const int d = 16 * w + fr;
    const float* fL = p.out + (dir ? (size_t)MTOK * 512 : 0) + (size_t)b * SEQ * 512 + h * 128;
    const float* fC = (const float*)(p.ws + (dir ? WS_GBC : WS_GFC)) + (size_t)b * CTXL * 512 + h * 128;
    const bf16* qL = (const bf16*)(p.ws + WS_Q) + (size_t)b * SEQ * 512 + h * 128;
    const bf16* vL = (const bf16*)(p.ws + WS_V) + (size_t)b * SEQ * 512 + h * 128 + vh * 64;
    const bf16* vC = (const bf16*)(p.ws + WS_VC) + (size_t)b * CTXL * 512 + h * 128 + vh * 64;
    bf16* oL = (bf16*)(p.ws + (dir ? WS_OB : WS_OF)) + (size_t)b * SEQ * 512 + h * 128 + vh * 64;
    f32x4 Sa[4];
#pragma unroll
    for (int i = 0; i < 4; ++i) Sa[i] = (f32x4){0.f, 0.f, 0.f, 0.f};
    f32x4 fR[4]; u32x4 qR[2], vR;
#define HG_LOAD(cc_) do { const int _cc = (cc_); const bool _lat = _cc >= 4; const int _c = _lat ? _cc - 4 : _cc, _n = _lat ? SEQ : CTXL; \
        const float* _f = _lat ? fL : fC; const bf16* _v = _lat ? vL : vC; \
        _Pragma("unroll") for (int i = 0; i < 4; ++i) { const int _j = tid + 512 * i, _s = _c * 64 + (_j >> 5), _pos = dir ? (_n - 1 - _s) : _s; fR[i] = *(const f32x4*)(_f + (size_t)_pos * 512 + (_j & 31) * 4); } \
        if (_lat) { _Pragma("unroll") for (int i = 0; i < 2; ++i) { const int _j = tid + 512 * i, _s = _c * 64 + (_j >> 4), _pos = dir ? (_n - 1 - _s) : _s; qR[i] = *(const u32x4*)(qL + (size_t)_pos * 512 + (_j & 15) * 8); } } \
        { const int _s = _c * 64 + (tid >> 3), _pos = dir ? (_n - 1 - _s) : _s; vR = *(const u32x4*)(_v + (size_t)_pos * 512 + (tid & 7) * 8); } } while (0)
#define HG_STAGE(lat_) do { \
        _Pragma("unroll") for (int i = 0; i < 4; ++i) { const int _j = tid + 512 * i; *(f32x4*)(Fr + (_j >> 5) * 132 + (_j & 31) * 4) = fR[i]; } \
        if (lat_) { _Pragma("unroll") for (int i = 0; i < 2; ++i) { const int _j = tid + 512 * i; *(u32x4*)(Qs + (_j >> 4) * 136 + (_j & 15) * 8) = qR[i]; } } } while (0)
    HG_LOAD(0);
    HG_STAGE(false);
    __syncthreads();
    for (int cc = 0; cc < 36; ++cc) {
        const bool lat = cc >= 4; const int c = lat ? cc - 4 : cc;
        bf16* Scur = St + (cc & 1) * (64 * 136); bf16* Snxt = St + ((cc & 1) ^ 1) * (64 * 136);
        {
            float fv[16], ce[16]; float e = 1.f;
#pragma unroll
            for (int i = 0; i < 16; ++i) { fv[i] = Fr[(fq * 16 + i) * 132 + d]; e *= fv[i]; ce[i] = e; }
            const float T0 = __shfl(e, fr), T1 = __shfl(e, fr + 16), T2 = __shfl(e, fr + 32), T3 = __shfl(e, fr + 48);
            const float pre = (fq == 0) ? 1.f : (fq == 1) ? T0 : (fq == 2) ? T0 * T1 : T0 * T1 * T2;
            const float tot = T0 * T1 * T2 * T3;
            if (fq == 0) Et[d] = tot;
            unsigned khw[8];
#pragma unroll
            for (int i = 0; i < 16; i += 2) { float qt2[2], kt2[2], kh2[2];
#pragma unroll
                for (int u = 0; u < 2; ++u) { const float cm = fmaxf(pre * ce[i + u], 1e-30f), ie = __builtin_amdgcn_rcpf(cm); kt2[u] = (1.f - fv[i + u]) * ie; kh2[u] = kt2[u] * tot;
                    qt2[u] = lat ? bf2f(Qs[(fq * 16 + i + u) * 136 + d]) * cm : 0.f; }
                if (lat) { const unsigned qw = hwpk2(qt2[0], qt2[1]), kw = hwpk2(kt2[0], kt2[1]); const int sl = fq * 16 + i;
                    Qs[sl * 136 + d] = (bf16)(qw & 0xffffu); Qs[(sl + 1) * 136 + d] = (bf16)(qw >> 16); Ks[sl * 136 + d] = (bf16)(kw & 0xffffu); Ks[(sl + 1) * 136 + d] = (bf16)(kw >> 16); }
                khw[i >> 1] = hwpk2(kh2[0], kh2[1]); }
            u32x4 k0; k0.x = khw[0]; k0.y = khw[1]; k0.z = khw[2]; k0.w = khw[3]; u32x4 k1; k1.x = khw[4]; k1.y = khw[5]; k1.z = khw[6]; k1.w = khw[7];
            *(u32x4*)(Kh + d * 72 + fq * 16) = k0; *(u32x4*)(Kh + d * 72 + fq * 16 + 8) = k1;
            { const int sv = tid >> 3, v8 = (tid & 7) * 8;
              Vt[(v8 + 0) * 72 + sv] = (bf16)(vR.x & 0xffffu); Vt[(v8 + 1) * 72 + sv] = (bf16)(vR.x >> 16); Vt[(v8 + 2) * 72 + sv] = (bf16)(vR.y & 0xffffu); Vt[(v8 + 3) * 72 + sv] = (bf16)(vR.y >> 16);
              Vt[(v8 + 4) * 72 + sv] = (bf16)(vR.z & 0xffffu); Vt[(v8 + 5) * 72 + sv] = (bf16)(vR.z >> 16); Vt[(v8 + 6) * 72 + sv] = (bf16)(vR.w & 0xffffu); Vt[(v8 + 7) * 72 + sv] = (bf16)(vR.w >> 16); }
        }
        if (cc + 1 < 36) HG_LOAD(cc + 1);
        __syncthreads();
        const int ti = w >> 1, x2 = 2 * (w & 1);
        if (lat) {
#pragma unroll
            for (int u2 = 0; u2 < 2; ++u2) { const int si = x2 + u2; f32x4 acc = (f32x4){0.f, 0.f, 0.f, 0.f};
                if (si <= ti) {
#pragma unroll
                    for (int kk = 0; kk < 4; ++kk) { const pg8::bf16x8 a = *(const pg8::bf16x8*)(Ks + (si * 16 + fr) * 136 + kk * 32 + fq * 8), bq = *(const pg8::bf16x8*)(Qs + (ti * 16 + fr) * 136 + kk * 32 + fq * 8);
                        acc = __builtin_amdgcn_mfma_f32_16x16x32_bf16(a, bq, acc, 0, 0, 0); }
                    if (si == ti) {
#pragma unroll
                        for (int r = 0; r < 4; ++r) if (4 * fq + r > fr) acc[r] = 0.f; } }
                u32x2 pw; pw.x = hwpk2(acc[0], acc[1]); pw.y = hwpk2(acc[2], acc[3]);
                *(u32x2*)(Ps + (ti * 16 + fr) * 72 + si * 16 + 4 * fq) = pw; }
        }
        {
            const f32x4 et = *(const f32x4*)(Et + w * 16 + 4 * fq);
            pg8::bf16x8 ka[2];
#pragma unroll
            for (int kk = 0; kk < 2; ++kk) ka[kk] = *(const pg8::bf16x8*)(Kh + (w * 16 + fr) * 72 + kk * 32 + fq * 8);
#pragma unroll
            for (int vi = 0; vi < 4; ++vi) { Sa[vi] = Sa[vi] * et;
#pragma unroll
                for (int kk = 0; kk < 2; ++kk) { const pg8::bf16x8 bv = *(const pg8::bf16x8*)(Vt + (vi * 16 + fr) * 72 + kk * 32 + fq * 8);
                    Sa[vi] = __builtin_amdgcn_mfma_f32_16x16x32_bf16(ka[kk], bv, Sa[vi], 0, 0, 0); }
                u32x2 sw; sw.x = hwpk2(Sa[vi][0], Sa[vi][1]); sw.y = hwpk2(Sa[vi][2], Sa[vi][3]);
                *(u32x2*)(Snxt + (vi * 16 + fr) * 136 + w * 16 + 4 * fq) = sw; }
        }
        f32x4 Oa[2];
        Oa[0] = (f32x4){0.f, 0.f, 0.f, 0.f}; Oa[1] = (f32x4){0.f, 0.f, 0.f, 0.f};
        if (lat) {
#pragma unroll
            for (int kk = 0; kk < 4; ++kk) { const pg8::bf16x8 bq = *(const pg8::bf16x8*)(Qs + (ti * 16 + fr) * 136 + kk * 32 + fq * 8);
#pragma unroll
                for (int u2 = 0; u2 < 2; ++u2) { const pg8::bf16x8 a = *(const pg8::bf16x8*)(Scur + ((x2 + u2) * 16 + fr) * 136 + kk * 32 + fq * 8);
                    Oa[u2] = __builtin_amdgcn_mfma_f32_16x16x32_bf16(a, bq, Oa[u2], 0, 0, 0); } }
        }
        __syncthreads();
        if (lat) {
#pragma unroll
            for (int kk = 0; kk < 2; ++kk) { const pg8::bf16x8 bp = *(const pg8::bf16x8*)(Ps + (ti * 16 + fr) * 72 + kk * 32 + fq * 8);
#pragma unroll
                for (int u2 = 0; u2 < 2; ++u2) { const pg8::bf16x8 a = *(const pg8::bf16x8*)(Vt + ((x2 + u2) * 16 + fr) * 72 + kk * 32 + fq * 8);
                    Oa[u2] = __builtin_amdgcn_mfma_f32_16x16x32_bf16(a, bp, Oa[u2], 0, 0, 0); } }
            const int sg = c * 64 + ti * 16 + fr, pos = dir ? (SEQ - 1 - sg) : sg;
#pragma unroll
            for (int u2 = 0; u2 < 2; ++u2) { u32x2 ow; ow.x = hwpk2(Oa[u2][0], Oa[u2][1]); ow.y = hwpk2(Oa[u2][2], Oa[u2][3]);
                *(u32x2*)(oL + (size_t)pos * 512 + (x2 + u2) * 16 + 4 * fq) = ow; }
        }
        if (cc + 1 < 36) HG_STAGE(cc + 1 >= 4);
        __syncthreads();
    }
#undef HG_LOAD
#undef HG_STAGE
}

__device__ __forceinline__ void phase_yh(const Params& p, int lane, int gw, int NGW) {
    const bf16* of = (const bf16*)(p.ws + WS_OF); const bf16* ob = (const bf16*)(p.ws + WS_OB); const bf16* og = (const bf16*)(p.ws + WS_OG);
    bf16* yh = (bf16*)(p.ws + WS_YH); const float* on = p.in[9];
    const f32x4 n0 = *(const f32x4*)(on + lane * 8), n1 = *(const f32x4*)(on + lane * 8 + 4);
    const int per = (MTOK + NGW - 1) / NGW, r0 = gw * per, nr = min(per, MTOK - r0);
    if (nr <= 0) return;
    u32x4 a = *(const u32x4*)(of + (size_t)r0 * 512 + lane * 8), b = *(const u32x4*)(ob + (size_t)r0 * 512 + lane * 8), gg = *(const u32x4*)(og + (size_t)r0 * 512 + lane * 8);
#pragma unroll 1
    for (int i = 0; i < nr; ++i) { const size_t o = (size_t)(r0 + i) * 512 + lane * 8;
        u32x4 a1 = a, b1 = b, g1 = gg;
        if (i + 1 < nr) { a1 = *(const u32x4*)(of + o + 512); b1 = *(const u32x4*)(ob + o + 512); g1 = *(const u32x4*)(og + o + 512); }
        float v[8]; v[0] = bflo(a.x) + bflo(b.x); v[1] = bfhi(a.x) + bfhi(b.x); v[2] = bflo(a.y) + bflo(b.y); v[3] = bfhi(a.y) + bfhi(b.y);
        v[4] = bflo(a.z) + bflo(b.z); v[5] = bfhi(a.z) + bfhi(b.z); v[6] = bflo(a.w) + bflo(b.w); v[7] = bfhi(a.w) + bfhi(b.w);
        float s = 0.f;
#pragma unroll
        for (int k = 0; k < 8; ++k) s += v[k] * v[k];
        s += __shfl_xor(s, 1); s += __shfl_xor(s, 2); s += __shfl_xor(s, 4); s += __shfl_xor(s, 8);
        const float rinv = rsqrtf(s * (1.f / 128.f) + EPSN);
        float gv[8]; gv[0] = bflo(gg.x); gv[1] = bfhi(gg.x); gv[2] = bflo(gg.y); gv[3] = bfhi(gg.y); gv[4] = bflo(gg.z); gv[5] = bfhi(gg.z); gv[6] = bflo(gg.w); gv[7] = bfhi(gg.w);
        f32x4 q0, q1;
#pragma unroll
        for (int k = 0; k < 4; ++k) { q0[k] = v[k] * rinv * n0[k] * gv[k]; q1[k] = v[4 + k] * rinv * n1[k] * gv[4 + k]; }
        *(u32x4*)(yh + o) = pack8(q0, q1);
        a = a1; b = b1; gg = g1; }
}

struct ConvRaw { u32x2 a[3], g[3]; };
__device__ __forceinline__ void conv_issue(const bf16* z, int tokbase, int r, int cc, int ch, ConvRaw& q) {
#pragma unroll
    for (int i = 0; i < 3; ++i) { const int rr = r + i - 1;
        if (rr >= 0 && rr < 32 && cc >= 0 && cc < 64) { const size_t zo = (size_t)(tokbase + rr * 64 + cc) * DFF2 + ch;
            q.a[i] = *(const u32x2*)(z + zo); q.g[i] = *(const u32x2*)(z + zo + DFF);
        } else { q.a[i] = (u32x2){0u, 0u}; q.g[i] = (u32x2){0u, 0u}; } }
}
__device__ __forceinline__ void phase_conv(const Params& p, int hf, int tid, int G) {
    const bf16* z = (const bf16*)(p.ws + WS_Z); bf16* a2 = (bf16*)(p.ws + WS_A2) + (size_t)hf * 8192 * DFF;
    const float* cw = p.in[15]; const float* cb = p.in[16];
    for (int it = blockIdx.x * NTHR + tid; it < 4 * 32 * 4 * 704; it += G * NTHR) {
        const int cg4 = it % 704, rest = it / 704, strip = rest & 3, r = (rest >> 2) & 31, img = rest >> 7, ch = cg4 * 4, c0 = strip * 16, tokbase = img * 2048;
        ConvRaw ring[3];
#pragma unroll
        for (int j = 0; j < 3; ++j) conv_issue(z, tokbase, r, c0 - 1 + j, ch, ring[j]);
        f32x2 w1[9][2], w2[9][2];
#pragma unroll
        for (int t = 0; t < 9; ++t) { const f32x4 a = *(const f32x4*)(cw + (size_t)t * DFF2 + ch), g = *(const f32x4*)(cw + (size_t)t * DFF2 + DFF + ch);
            w1[t][0] = (f32x2){a[0], a[1]}; w1[t][1] = (f32x2){a[2], a[3]}; w2[t][0] = (f32x2){g[0], g[1]}; w2[t][1] = (f32x2){g[2], g[3]}; }
        const f32x4 b1 = *(const f32x4*)(cb + ch), b2 = *(const f32x4*)(cb + DFF + ch);
        f32x2 W1[3][3][2], W2[3][3][2];
#pragma unroll
        for (int j = 0; j < 18; ++j) {
            const int sl = j % 3;
#pragma unroll
            for (int i = 0; i < 3; ++i) { const u32x2 a = ring[j % 3].a[i], g = ring[j % 3].g[i];
                W1[sl][i][0] = (f32x2){bflo(a.x), bfhi(a.x)}; W1[sl][i][1] = (f32x2){bflo(a.y), bfhi(a.y)};
                W2[sl][i][0] = (f32x2){bflo(g.x), bfhi(g.x)}; W2[sl][i][1] = (f32x2){bflo(g.y), bfhi(g.y)}; }
            if (j + 3 < 18) conv_issue(z, tokbase, r, c0 - 1 + j + 3, ch, ring[j % 3]);
            if (j >= 2) {
                const int sL = (j - 2) % 3, sC = (j - 1) % 3, sR = j % 3;
                f32x2 o1[2], o2[2];
                o1[0] = (f32x2){b1[0], b1[1]}; o1[1] = (f32x2){b1[2], b1[3]}; o2[0] = (f32x2){b2[0], b2[1]}; o2[1] = (f32x2){b2[2], b2[3]};
#pragma unroll
                for (int i = 0; i < 3; ++i)
#pragma unroll
                    for (int e = 0; e < 2; ++e) {
                        o1[e] = __builtin_elementwise_fma(W1[sL][i][e], w1[i * 3 + 0][e], o1[e]); o1[e] = __builtin_elementwise_fma(W1[sC][i][e], w1[i * 3 + 1][e], o1[e]); o1[e] = __builtin_elementwise_fma(W1[sR][i][e], w1[i * 3 + 2][e], o1[e]);
                        o2[e] = __builtin_elementwise_fma(W2[sL][i][e], w2[i * 3 + 0][e], o2[e]); o2[e] = __builtin_elementwise_fma(W2[sC][i][e], w2[i * 3 + 1][e], o2[e]); o2[e] = __builtin_elementwise_fma(W2[sR][i][e], w2[i * 3 + 2][e], o2[e]); }
                u32x2 ow; ow.x = pk2(siluf_(o1[0][0]) * o2[0][0], siluf_(o1[0][1]) * o2[0][1]); ow.y = pk2(siluf_(o1[1][0]) * o2[1][0], siluf_(o1[1][1]) * o2[1][1]);
                *(u32x2*)(a2 + (size_t)(tokbase + r * 64 + c0 + j - 2) * DFF + ch) = ow;
            }
        }
    }
}

__global__ void __launch_bounds__(NTHR, 2) fwd_mega(Params p) {
    extern __shared__ __attribute__((aligned(16))) unsigned char lds[];
    cg::grid_group grid = cg::this_grid();
    const int tid = threadIdx.x, lane = tid & 63, wave = __builtin_amdgcn_readfirstlane(tid >> 6);
    const int G = gridDim.x, gw = blockIdx.x * NWAVES + wave, NGW = G * NWAVES;
    PG8_LAS unsigned char* ldsl = (PG8_LAS unsigned char*)lds;
    unsigned char* ws = p.ws;
    const float* mx = (const float*)(ws + WS_MX);
    volatile LAS unsigned* misc = (volatile LAS unsigned*)((LAS unsigned char*)lds + MISC_OFF);
    if (tid < 16) misc[tid] = 0u;
    __syncthreads();
    const XcdBarrier xbar = xcd_barrier_post((unsigned*)(ws + WS_BAR), misc + 8);
    const unsigned long long t0_ = (PROBE_K >= 0) ? __builtin_amdgcn_s_memrealtime() : 0ull;
#define PROBE_POINT(k) do { if (PROBE_K == (k) && tid == 0) { const unsigned long long _n = __builtin_amdgcn_s_memrealtime(), _d = _n - t0_; while (__builtin_amdgcn_s_memrealtime() - _n < _d) __builtin_amdgcn_s_sleep(8); } } while (0)

    for (int rep_ = 0; rep_ < REPS(0); ++rep_) {
    phase0(p, lds, tid, lane, wave, G, 0);
    phase0(p, lds, tid, lane, wave, G, 1);
    xcd_barrier(xbar);
    if (G == 0x7fffffff) grid.sync();
    }
    for (int xs_ = 0; xs_ < EXTRA_SYNCS; ++xs_) xcd_barrier(xbar);
    PROBE_POINT(0);
    for (int rep_ = 0; rep_ < REPS(1); ++rep_) {
    if (blockIdx.x < 16 && G >= 16) {
        pg8::Gemm g{(const bf16*)(ws + WS_TCH), (const bf16*)(ws + WS_WFS), 512, 512, 512};
        pg8::StaticOrder S; S.init(4, 4, 16, blockIdx.x, 512, 512);
        pg8::Epi8<FUp> E{FUp{(bf16*)(ws + WS_WPQ), 1024}};
        pg8::gemm_phase<pg8::Epi8<FUp>, pg8::StaticOrder, true, true>(ldsl, g, S, E);
    }
    { const int per = (MTOK + MCTX + NGW - 1) / NGW, r0 = gw * per, nr = min(per, MTOK + MCTX - r0);
      if (nr > 0) norm_rows<true>(p.in[0], p.in[2], MTOK, p.in[6], mx, 0, 1, (bf16*)(ws + WS_HX), nullptr, r0, nr, lane); }
    xcd_barrier(xbar);
    }
    PROBE_POINT(1);
    for (int rep_ = 0; rep_ < REPS(2); ++rep_) {
    {
        pg8::Gemm g{(const bf16*)(ws + WS_HX), (const bf16*)(ws + WS_WIN) + (size_t)512 * 1024, 1024, 1024, 1024};
        pg8::InOrder S; S.G = G; S.c = blockIdx.x; S.a_tile = (size_t)256 * 1024 * 2; S.b_tile = (size_t)256 * 1024 * 2;
        pg8::Epi8<FIn> E{FIn{ws, p.out}};
        pg8::gemm_phase<pg8::Epi8<FIn>, pg8::InOrder, true, true>(ldsl, g, S, E);
    }
    {
        pg8::Gemm g{(const bf16*)(ws + WS_WPQ), (const bf16*)(ws + WS_HX), 1024, 1024, 1024};
        pg8::StaticOrder S; S.init(4, 64, G, blockIdx.x, 1024, 1024);
        pg8::Epi8<FPQ> E{FPQ{(bf16*)(ws + WS_PQT)}};
        pg8::gemm_phase<pg8::Epi8<FPQ>, pg8::StaticOrder, true, true>(ldsl, g, S, E);
    }
    xcd_barrier(xbar);
    }
    PROBE_POINT(2);
    for (int rep_ = 0; rep_ < REPS(3); ++rep_) {
    if (blockIdx.x < 128 && G >= 192) {
        pg8::Gemm g{(const bf16*)(ws + WS_CS), (const bf16*)(ws + WS_PQT), 4096, 4096, 32768};
        pg8::DftOrder S; S.G = 128; S.c = blockIdx.x; S.a_tile = (size_t)256 * 4096 * 2; S.b_tile = (size_t)256 * 32768 * 2;
        pg8::Epi8<FDft> E{FDft{(bf16*)(ws + WS_YF)}};
        pg8::gemm_phase<pg8::Epi8<FDft>, pg8::DftOrder, true, true>(ldsl, g, S, E);
    } else if (G >= 192) {
        for (int it = blockIdx.x - 128; it < 128; it += G - 128) hgrn_mfma_item(p, lds, it);
    } else {
        pg8::Gemm g{(const bf16*)(ws + WS_CS), (const bf16*)(ws + WS_PQT), 4096, 4096, 32768};
        pg8::DftOrder S; S.G = G; S.c = blockIdx.x; S.a_tile = (size_t)256 * 4096 * 2; S.b_tile = (size_t)256 * 32768 * 2;
        pg8::Epi8<FDft> E{FDft{(bf16*)(ws + WS_YF)}};
        pg8::gemm_phase<pg8::Epi8<FDft>, pg8::DftOrder, true, true>(ldsl, g, S, E);
        for (int it = blockIdx.x; it < 128; it += G) hgrn_mfma_item(p, lds, it);
    }
    xcd_barrier(xbar);
    }
    PROBE_POINT(3);
    for (int rep_ = 0; rep_ < REPS(4); ++rep_) {
    phase_yh(p, lane, gw, NGW);
    { LAS float* scr = (LAS float*)((LAS unsigned char*)lds + wave * 16384);
      constexpr int I_UP = 16 * 176, I_DN = 44 * 32;
      for (int it = gw; it < I_UP + I_DN; it += NGW) {
          if (it < I_UP) transpose_item(p.in[14], 1024, DFF2, (bf16*)(ws + WS_WUP), scr, it, lane);
          else transpose_item(p.in[17], DFF, 1024, (bf16*)(ws + WS_WDN), scr, it - I_UP, lane); } }
    xcd_barrier(xbar);
    }
    PROBE_POINT(4);
    for (int rep_ = 0; rep_ < REPS(5); ++rep_) {
    {
        pg8::Gemm g{(const bf16*)(ws + WS_YF), (const bf16*)(ws + WS_WA), 512, 512, 512};
        pg8::StaticOrder S; S.init(64, 4, G, blockIdx.x, 512, 512);
        pg8::Epi8<FYa> E{FYa{(const bf16*)(ws + WS_GA), (bf16*)(ws + WS_TMP)}};
        pg8::gemm_phase<pg8::Epi8<FYa>, pg8::StaticOrder, true, true>(ldsl, g, S, E);
    }
    {
        pg8::Gemm g{(const bf16*)(ws + WS_YH), (const bf16*)(ws + WS_WB), 512, 512, 512};
        pg8::StaticOrder S; S.init(64, 4, G, blockIdx.x, 512, 512);
        pg8::Epi8<FYb> E{FYb{(const bf16*)(ws + WS_GBG), (const bf16*)(ws + WS_TMP), (bf16*)(ws + WS_MRG)}};
        pg8::gemm_phase<pg8::Epi8<FYb>, pg8::StaticOrder, true, true>(ldsl, g, S, E);
    }
    xcd_barrier(xbar);
    }
    PROBE_POINT(5);
    for (int rep_ = 0; rep_ < REPS(6); ++rep_) {
    {
        pg8::Gemm g{(const bf16*)(ws + WS_MRG), (const bf16*)(ws + WS_WOUT), 1024, 1024, 1024};
        pg8::StaticOrder S; S.init(64, 4, G, blockIdx.x, 1024, 1024);
        pg8::Epi8<FRes> E{FRes{p.in[0], p.out, mx, 2}};
        pg8::gemm_phase<pg8::Epi8<FRes>, pg8::StaticOrder, true, true>(ldsl, g, S, E);
    }
    xcd_barrier(xbar);
    }
    PROBE_POINT(6);
    for (int rep_ = 0; rep_ < REPS(7); ++rep_) {
    { const int per = (MTOK + NGW - 1) / NGW, r0 = gw * per, nr = min(per, MTOK - r0);
      if (nr > 0) norm_rows<true>(p.out, p.out, MTOK, p.in[13], mx, 3, 4, (bf16*)(ws + WS_H2), nullptr, r0, nr, lane); }
    xcd_barrier(xbar);
    }
    PROBE_POINT(7);
    {
    for (int hf = 0; hf < 2; ++hf) {
        for (int rep_ = 0; rep_ < REPS(8); ++rep_) {
            pg8::Gemm g{(const bf16*)(ws + WS_H2) + (size_t)hf * 8192 * 1024, (const bf16*)(ws + WS_WUP), 1024, 1024, 1024};
            pg8::StaticOrder S; S.init(32, 22, G, blockIdx.x, 1024, 1024);
            pg8::Epi8<FUp> E{FUp{(bf16*)(ws + WS_Z), DFF2}};
            pg8::gemm_phase<pg8::Epi8<FUp>, pg8::StaticOrder, true, true>(ldsl, g, S, E);
        xcd_barrier(xbar);
        }
        for (int rep_ = 0; rep_ < REPS(9); ++rep_) {
        phase_conv(p, hf, tid, G);
        xcd_barrier(xbar);
        }
    }
    }
    PROBE_POINT(8);
    for (int rep_ = 0; rep_ < REPS(10); ++rep_) {
    {
        pg8::Gemm g{(const bf16*)(ws + WS_A2), (const bf16*)(ws + WS_WDN), DFF, DFF, DFF};
        pg8::StaticOrder S; S.init(64, 4, G, blockIdx.x, DFF, DFF);
        pg8::Epi8<FRes> E{FRes{p.out, (float*)(ws + WS_XO), mx, 5}};
        pg8::gemm_phase<pg8::Epi8<FRes>, pg8::StaticOrder, true, true>(ldsl, g, S, E);
    }
    xcd_barrier(xbar);
    }
    PROBE_POINT(10);
    for (int rep_ = 0; rep_ < REPS(11); ++rep_) {
    { const int per = (MTOK + NGW - 1) / NGW, r0 = gw * per, nr = min(per, MTOK - r0);
      if (nr > 0) norm_rows<false>((const float*)(ws + WS_XO), (const float*)(ws + WS_XO), MTOK, p.in[18], nullptr, 0, 0, nullptr, p.out, r0, nr, lane); }
    }
}

extern "C" void kernel_launch(void* const* d_in, const int* in_sizes, int n_in, void* d_out, int out_size, void* d_ws, size_t ws_size, hipStream_t stream) {
    static int grid = 0;
    if (grid == 0) {
        if (n_in != 19 || out_size != MTOK * DM || ws_size < WS_END) { fprintf(stderr, "kernel_launch: unexpected problem: n_in %d out %d ws %zu\n", n_in, out_size, ws_size); grid = -1; return; }
        int dev = 0, cus = 0, per_cu = 0;
        hipGetDevice(&dev);
        hipDeviceGetAttribute(&cus, hipDeviceAttributeMultiprocessorCount, dev);
        if (hipFuncSetAttribute((const void*)fwd_mega, hipFuncAttributeMaxDynamicSharedMemorySize, LDS_BYTES) != hipSuccess) { fprintf(stderr, "kernel_launch: hipFuncSetAttribute failed\n"); grid = -1; return; }
        if (hipOccupancyMaxActiveBlocksPerMultiprocessor(&per_cu, (const void*)fwd_mega, NTHR, LDS_BYTES) != hipSuccess || per_cu < 1) { fprintf(stderr, "kernel_launch: occupancy query says %d\n", per_cu); per_cu = 1; }
        (void)hipGetLastError();
        grid = cus * (per_cu > 1 ? 1 : per_cu);
        fprintf(stderr, "kernel_launch: grid %d (cus %d, per_cu %d), ws %zu\n", grid, cus, per_cu, ws_size);
    }
    if (grid < 0) return;
    Params p{};
    for (int i = 0; i < 19; ++i) p.in[i] = (const float*)d_in[i];
    p.out = (float*)d_out; p.ws = (unsigned char*)d_ws;
    if (hipMemsetAsync((char*)d_ws + WS_BAR, 0, BAR_BYTES, stream) != hipSuccess) { fprintf(stderr, "kernel_launch: memset failed\n"); return; }
    void* args[] = {&p};
    hipError_t e = hipLaunchCooperativeKernel((const void*)fwd_mega, dim3(grid), dim3(NTHR), args, LDS_BYTES, stream);
    if (e != hipSuccess) fprintf(stderr, "kernel_launch: cooperative launch failed: %s (grid %d)\n", hipGetErrorString(e), grid);
}
```

```cpp
#include <hip/hip_runtime.h>
#include <hip/hip_cooperative_groups.h>
#include <cstdio>
#include <cstdint>
namespace cg = cooperative_groups;

namespace pg8 {
#define PG8_LAS __attribute__((address_space(3)))
typedef unsigned short bf16_t;
typedef short bf16x8 __attribute__((ext_vector_type(8)));
typedef float f32x4 __attribute__((ext_vector_type(4)));
typedef unsigned u32x4 __attribute__((ext_vector_type(4)));
typedef unsigned u32x2 __attribute__((ext_vector_type(2)));
constexpr int BM = 256, BK = 64, HALF = 128, HTB = HALF * BK * 2  , STAGE_BYTES = 8 * HTB, NXCD = 8, WGM = 8;

__host__ __device__ __forceinline__ int lds_byte(int r, int c) { const int st = (r >> 4) * 2 + (c >> 5), rr = r & 15, cc = c & 31, ob = rr * 64 + cc * 2; return st * 1024 + (ob ^ (((ob >> 9) & 1) << 5)); }
__host__ __device__ __forceinline__ void stage_rc(int b, int& R, int& C) { const int st = b / 1024, sb = b % 1024, swz = sb ^ (((sb >> 9) & 1) << 5); R = (st >> 1) * 16 + swz / 64; C = (st & 1) * 32 + (swz % 64) / 2; }
__host__ __device__ __forceinline__ int perm32(int rho) { const int n = rho >> 4, i = rho & 15; return 8 * (i >> 2) + 4 * n + (i & 3); }

struct Unit { int pm, pn, z; };
struct Gemm { const bf16_t* A; const bf16_t* Bt; int K, lda, ldb; };

__device__ __forceinline__ void tile_of(int wgid, int nM, int nN, int& pm, int& pn) {
    const int nwg = nM * nN;
    { const int q = nwg / NXCD, r = nwg % NXCD, xcd = wgid % NXCD, off = wgid / NXCD; wgid = (xcd < r ? xcd * (q + 1) : r * (q + 1) + (xcd - r) * q) + off; }
    const int nig = WGM * nN, gid = wgid / nig, fm = gid * WGM, gsz = (nM - fm) < WGM ? (nM - fm) : WGM;
    pm = fm + ((wgid % nig) % gsz); pn = (wgid % nig) / gsz;
}
struct StaticOrder {
    int nM, nN, nwg, G, c; size_t a_tile, b_tile;
    __device__ __forceinline__ void init(int nM_, int nN_, int G_, int c_, int lda, int ldb) { nM = nM_; nN = nN_; nwg = nM * nN; G = G_; c = c_; a_tile = (size_t)BM * lda * 2; b_tile = (size_t)BM * ldb * 2; }
    __device__ __forceinline__ bool next(int i, Unit& u) const {
        const long L = (long)i * G + c; if (L >= nwg) return false;
        tile_of((int)L, nM, nN, u.pm, u.pn); u.z = 0; return true;
    }
    __device__ __forceinline__ size_t a_off(const Unit& u) const { return (size_t)u.pm * a_tile; }
    __device__ __forceinline__ size_t b_off(const Unit& u) const { return (size_t)u.pn * b_tile; }
};
struct InOrder {
    int G, c; size_t a_tile, b_tile;
    __device__ __forceinline__ bool next(int i, Unit& u) const {
        const long L = (long)i * G + c; if (L >= 1152 + 48) return false;
        if (L < 1152) { tile_of((int)L, 64, 18, u.pm, u.pn); } else { const int j = (int)L - 1152; u.pm = 64 + (j & 7); u.pn = 2 + (j >> 3); }
        u.z = 0; return true;
    }
    __device__ __forceinline__ size_t a_off(const Unit& u) const { return (size_t)u.pm * a_tile; }
    __device__ __forceinline__ size_t b_off(const Unit& u) const { return (size_t)u.pn * b_tile; }
};
struct DftOrder {
    int G, c; size_t a_tile, b_tile;
    __device__ __forceinline__ bool next(int i, Unit& u) const {
        const long L = (long)i * G + c; if (L >= 128) return false;
        const int eo = (L < 64) ? 1 : 0, q = (int)L & 63;
        u.pn = q & 1; u.pm = (q >> 1) & 3; u.z = (q >> 3) | (eo << 8); return true;
    }
    __device__ __forceinline__ size_t a_off(const Unit& u) const { return (size_t)((u.z >> 8) * 4 + u.pm) * a_tile; }
    __device__ __forceinline__ size_t b_off(const Unit& u) const { return (size_t)u.pn * b_tile + ((size_t)(u.z & 255) * 4096 + (size_t)(u.z >> 8) * 2048) * 2; }
};

__device__ __forceinline__ unsigned cvt_pk_bf16(float lo, float hi) { unsigned r; asm volatile("v_cvt_pk_bf16_f32 %0, %1, %2" : "=v"(r) : "v"(lo), "v"(hi)); return r; }

template <class F> struct Epi8 {
    static constexpr bool PERM = true;
    F f;
    __device__ __forceinline__ void operator()(const f32x4 (&acc)[2][2][4][2], const Unit& u, int wr, int wc, int fr, int fq) const {
        const int row0 = u.pm * BM + wr * 64 + fr, col0 = u.pn * BM + wc * 32 + 8 * fq;
#pragma unroll
        for (int ai = 0; ai < 2; ++ai)
#pragma unroll
            for (int m = 0; m < 4; ++m) {
#pragma unroll
                for (int bj = 0; bj < 2; ++bj) f(u, row0 + ai * HALF + m * 16, col0 + bj * HALF, acc[ai][bj][m][0], acc[ai][bj][m][1]);
                asm volatile("" ::: "memory");
            }
    }
};

template <class Epi, class Sched, bool ALIGN_EPI = false, bool SP2 = false>
__device__ __forceinline__ void gemm_phase(PG8_LAS unsigned char* lds, const Gemm g, const Sched& S, const Epi& E) {
    int tid_ = threadIdx.x; asm volatile("" : "+v"(tid_));
    const int tid = tid_, wid = __builtin_amdgcn_readfirstlane(tid >> 6), lane = tid & 63, wr = wid >> 2, wc = wid & 3, fr = lane & 15, fq = lane >> 4;
    const int K = g.K, nt = K / BK;
    unsigned voffA[2], voffB[2];
#pragma unroll
    for (int i = 0; i < 2; ++i) { int R, C; stage_rc(tid * 16 + i * 8192, R, C); const int Rb = Epi::PERM ? ((R & ~31) + perm32(R & 31)) : R;
        voffA[i] = (unsigned)(R * g.lda + C) * 2u; voffB[i] = (unsigned)(Rb * g.ldb + C) * 2u; }
    const size_t kstep = (size_t)(BK * 2);
    const size_t hstepA = (size_t)HALF * g.lda * 2, hstepB = (size_t)HALF * g.ldb * 2;
    const unsigned ldsw = (unsigned)wid * 1024u;
    const int aoff = lds_byte(wr * 64 + fr, fq * 8), boff = lds_byte(wc * 32 + fr, fq * 8);
#define PG8_SA(b, h) (((b) * 2 + (h)) * HTB)
#define PG8_SB(b, h) ((4 + (b) * 2 + (h)) * HTB)
#define PG8_STAGE(bufoff, gbase, voff) do { _Pragma("unroll") for (int _i = 0; _i < 2; ++_i) \
        __builtin_amdgcn_global_load_lds((const unsigned*)((const char*)(gbase) + (voff)[_i]), (PG8_LAS unsigned*)(lds + (bufoff) + ldsw + _i * 8192), 16, 0, 0); } while (0)
#define PG8_LDA(dst, b, h) do { _Pragma("unroll") for (int m = 0; m < 4; ++m) _Pragma("unroll") for (int k = 0; k < 2; ++k) dst[m][k] = *(const PG8_LAS bf16x8*)(lds + PG8_SA(b, h) + aoff + m * 2048 + k * 1024); } while (0)
#define PG8_LDB(dst, b, h) do { _Pragma("unroll") for (int n = 0; n < 2; ++n) _Pragma("unroll") for (int k = 0; k < 2; ++k) dst[n][k] = *(const PG8_LAS bf16x8*)(lds + PG8_SB(b, h) + boff + n * 2048 + k * 1024); } while (0)
#define PG8_MMA(ai, bj, At, Bt) do { __builtin_amdgcn_s_setprio(1); _Pragma("unroll") for (int m = 0; m < 4; ++m) _Pragma("unroll") for (int n = 0; n < 2; ++n) _Pragma("unroll") for (int k = 0; k < 2; ++k) \
        acc[ai][bj][m][n] = __builtin_amdgcn_mfma_f32_16x16x32_bf16(Bt[n][k], At[m][k], acc[ai][bj][m][n], 0, 0, 0); __builtin_amdgcn_s_setprio(0); } while (0)
#define PG8_WAIT_V(n) asm volatile("s_waitcnt vmcnt(" #n ")" ::: "memory")
#define PG8_WAIT_L(n) asm volatile("s_waitcnt lgkmcnt(" #n ")" ::: "memory")
#define PG8_BAR __builtin_amdgcn_s_barrier()
#define PG8_SCHED __builtin_amdgcn_sched_barrier(0)
    Unit cur, nxt; int ui = 0;
    if (!S.next(0, cur)) return;
    f32x4 acc[2][2][4][2];
#pragma unroll
    for (int a = 0; a < 2; ++a)
#pragma unroll
        for (int b = 0; b < 2; ++b)
#pragma unroll
            for (int m = 0; m < 4; ++m)
#pragma unroll
                for (int n = 0; n < 2; ++n) acc[a][b][m][n] = (f32x4){0.f, 0.f, 0.f, 0.f};
    bf16x8 At[4][2], B0[2][2], B1[2][2];
    const char* cA = (const char*)g.A + S.a_off(cur); const char* cB = (const char*)g.Bt + S.b_off(cur);
    if constexpr (SP2) {
        PG8_STAGE(PG8_SB(0, 0), cB, voffB); PG8_STAGE(PG8_SB(0, 1), cB + hstepB, voffB); PG8_STAGE(PG8_SA(0, 0), cA, voffA); PG8_STAGE(PG8_SA(0, 1), cA + hstepA, voffA);
        if (wr == 1) PG8_BAR;
        PG8_WAIT_V(2); PG8_BAR;
        PG8_STAGE(PG8_SB(1, 0), cB + kstep, voffB); PG8_STAGE(PG8_SA(1, 0), cA + kstep, voffA); PG8_STAGE(PG8_SB(1, 1), cB + hstepB + kstep, voffB);
        PG8_WAIT_V(6); PG8_BAR;
    } else {
        PG8_STAGE(PG8_SB(0, 0), cB, voffB); PG8_STAGE(PG8_SA(0, 0), cA, voffA); PG8_STAGE(PG8_SB(0, 1), cB + hstepB, voffB); PG8_STAGE(PG8_SA(0, 1), cA + hstepA, voffA);
        if (wr == 1) PG8_BAR;
        PG8_WAIT_V(4); PG8_BAR;
        PG8_STAGE(PG8_SB(1, 0), cB + kstep, voffB); PG8_STAGE(PG8_SA(1, 0), cA + kstep, voffA); PG8_STAGE(PG8_SB(1, 1), cB + hstepB + kstep, voffB);
        PG8_WAIT_V(6); PG8_BAR;
    }
    for (;;) {
        const bool has_next = S.next(ui + 1, nxt);
        const char* nA = has_next ? (const char*)g.A + S.a_off(nxt) : cA; const char* nB = has_next ? (const char*)g.Bt + S.b_off(nxt) : cB;
        for (int t = 0; t < nt; t += 2) {
            const bool last = (t == nt - 2);
            const char* a1 = cA + (size_t)(t + 1) * kstep;
            const char* a2 = last ? nA : cA + (size_t)(t + 2) * kstep; const char* b2 = last ? nB : cB + (size_t)(t + 2) * kstep;
            const char* a3 = a2 + kstep; const char* b3 = b2 + kstep;
            if constexpr (SP2) {
            PG8_LDB(B0, 0, 0); PG8_LDB(B1, 0, 1); PG8_SCHED; PG8_LDA(At, 0, 0); PG8_STAGE(PG8_SA(1, 1), a1 + hstepA, voffA);
            PG8_WAIT_V(8); PG8_WAIT_L(0); PG8_BAR; PG8_MMA(0, 0, At, B0); PG8_MMA(0, 1, At, B1); PG8_BAR; PG8_SCHED;
            PG8_LDA(At, 0, 1); PG8_STAGE(PG8_SB(0, 0), b2, voffB); PG8_STAGE(PG8_SB(0, 1), b2 + hstepB, voffB); PG8_STAGE(PG8_SA(0, 0), a2, voffA);
            PG8_WAIT_V(8); PG8_WAIT_L(0); PG8_BAR; PG8_MMA(1, 0, At, B0); PG8_MMA(1, 1, At, B1); PG8_BAR; PG8_SCHED;
            PG8_LDB(B0, 1, 0); PG8_LDB(B1, 1, 1); PG8_SCHED; PG8_LDA(At, 1, 0); PG8_STAGE(PG8_SA(0, 1), a2 + hstepA, voffA);
            PG8_WAIT_V(8); PG8_WAIT_L(0); PG8_BAR; PG8_MMA(0, 0, At, B0); PG8_MMA(0, 1, At, B1); PG8_BAR; PG8_SCHED;
            PG8_LDA(At, 1, 1); PG8_STAGE(PG8_SB(1, 0), b3, voffB); PG8_STAGE(PG8_SB(1, 1), b3 + hstepB, voffB); PG8_STAGE(PG8_SA(1, 0), a3, voffA);
            PG8_WAIT_V(8); PG8_WAIT_L(0); PG8_BAR; PG8_MMA(1, 0, At, B0); PG8_MMA(1, 1, At, B1); PG8_BAR; PG8_SCHED;
            } else {
            PG8_LDB(B0, 0, 0); PG8_SCHED; PG8_LDA(At, 0, 0); PG8_STAGE(PG8_SA(1, 1), a1 + hstepA, voffA);
            PG8_WAIT_L(8); PG8_BAR; PG8_WAIT_L(0); PG8_MMA(0, 0, At, B0); PG8_BAR; PG8_SCHED;
            PG8_LDB(B1, 0, 1); PG8_STAGE(PG8_SB(0, 0), b2, voffB);
            PG8_BAR; PG8_WAIT_L(0); PG8_MMA(0, 1, At, B1); PG8_BAR;
            PG8_LDA(At, 0, 1); PG8_STAGE(PG8_SA(0, 0), a2, voffA);
            PG8_BAR; PG8_WAIT_L(0); PG8_MMA(1, 0, At, B0); PG8_BAR; PG8_SCHED;
            PG8_STAGE(PG8_SB(0, 1), b2 + hstepB, voffB);
            PG8_WAIT_V(6); PG8_BAR; PG8_MMA(1, 1, At, B1); PG8_BAR;
            PG8_LDB(B0, 1, 0); PG8_SCHED; PG8_LDA(At, 1, 0); PG8_STAGE(PG8_SA(0, 1), a2 + hstepA, voffA);
            PG8_WAIT_L(8); PG8_BAR; PG8_WAIT_L(0); PG8_MMA(0, 0, At, B0); PG8_BAR; PG8_SCHED;
            PG8_LDB(B1, 1, 1); PG8_STAGE(PG8_SB(1, 0), b3, voffB);
            PG8_BAR; PG8_WAIT_L(0); PG8_MMA(0, 1, At, B1); PG8_BAR;
            PG8_LDA(At, 1, 1); PG8_STAGE(PG8_SA(1, 0), a3, voffA);
            PG8_BAR; PG8_WAIT_L(0); PG8_MMA(1, 0, At, B0); PG8_BAR; PG8_SCHED;
            PG8_STAGE(PG8_SB(1, 1), b3 + hstepB, voffB);
            PG8_WAIT_V(6); PG8_BAR; PG8_MMA(1, 1, At, B1); PG8_BAR;
            }
        }
        if constexpr (ALIGN_EPI) { if (wr == 0) PG8_BAR; }
        E(acc, cur, wr, wc, fr, fq);
        if (!has_next) break;
#pragma unroll
        for (int a = 0; a < 2; ++a)
#pragma unroll
            for (int b = 0; b < 2; ++b)
#pragma unroll
                for (int m = 0; m < 4; ++m)
#pragma unroll
                    for (int n = 0; n < 2; ++n) acc[a][b][m][n] = (f32x4){0.f, 0.f, 0.f, 0.f};
        cur = nxt; cA = nA; cB = nB; ++ui;
        if constexpr (ALIGN_EPI) { if (wr == 1) PG8_BAR; }
    }
    PG8_WAIT_V(0);
    if constexpr (!ALIGN_EPI) { if (wr == 0) PG8_BAR; }
    PG8_BAR;
#undef PG8_SA
#undef PG8_SB
#undef PG8_STAGE
#undef PG8_LDA
#undef PG8_LDB
#undef PG8_MMA
#undef PG8_WAIT_V
#undef PG8_WAIT_L
#undef PG8_BAR
#undef PG8_SCHED
}
}

constexpr int DM = 1024, NB = 8, SEQ = 2048, MTOK = NB * SEQ, CTXL = 256, MCTX = NB * CTXL;
constexpr int HGD = 512, DFF = 2816, DFF2 = 5632, INDIM = 5120, NMOD = 6;
constexpr float EPSN = 1e-6f;
constexpr int NWAVES = 8, NTHR = 512;
constexpr int LDS_BYTES = 147456;
#ifndef DUP_MASK
#define DUP_MASK 0
#endif
#define REPS(k) ((((DUP_MASK) >> (k)) & 1) ? 2 : 1)
#ifndef PROBE_K
#define PROBE_K -1
#endif
#ifndef EXTRA_SYNCS
#define EXTRA_SYNCS 0
#endif

constexpr size_t MiB = 1u << 20;
constexpr size_t WS_MX = 0;
constexpr size_t WS_LB = 256 * 1024;
constexpr size_t WS_WFS = 2 * MiB, WS_TCH = 3 * MiB;
constexpr size_t WS_BAR = 512 * 1024, BAR_BYTES = 32768;
constexpr int MISC_OFF = 147456 - 128;
constexpr size_t WS_WIN = 6 * MiB;
constexpr size_t WS_WPQ = 16 * MiB;
constexpr size_t WS_WA = 18 * MiB, WS_WB = 19 * MiB, WS_WOUT = 20 * MiB;
constexpr size_t WS_CS = 22 * MiB;
constexpr size_t WS_WUP = 6 * MiB;
constexpr size_t WS_WDN = 250 * MiB;
constexpr size_t WS_HX = 38 * MiB;
constexpr size_t WS_OF = 38 * MiB, WS_OB = 54 * MiB;
constexpr size_t WS_TMP = 38 * MiB;
constexpr size_t WS_H2 = 38 * MiB;
constexpr size_t WS_Q = 74 * MiB, WS_V = 90 * MiB, WS_OG = 106 * MiB, WS_GA = 122 * MiB, WS_GBG = 154 * MiB, WS_PQT = 186 * MiB;
constexpr size_t WS_GFC = 218 * MiB, WS_GBC = 222 * MiB, WS_VC = 226 * MiB;
constexpr size_t WS_YF = 228 * MiB;
constexpr size_t WS_YH = 74 * MiB;
constexpr size_t WS_MRG = 186 * MiB;
constexpr size_t WS_Z = 74 * MiB;
constexpr size_t WS_A2 = 162 * MiB;
constexpr size_t WS_XO = 38 * MiB;
constexpr size_t WS_END = 256 * MiB;

typedef unsigned short bf16;
typedef float f32x4 __attribute__((ext_vector_type(4)));
typedef unsigned u32x4 __attribute__((ext_vector_type(4)));
typedef unsigned u32x2 __attribute__((ext_vector_type(2)));
typedef float f32x2 __attribute__((ext_vector_type(2)));
#define LAS __attribute__((address_space(3)))

struct Params {
    const float* in[19];
    float* out;
    unsigned char* ws;
};

__device__ __forceinline__ float bf2f(unsigned short b) { return __uint_as_float(((unsigned)b) << 16); }
__device__ __forceinline__ float bflo(unsigned w) { return __uint_as_float(w << 16); }
__device__ __forceinline__ float bfhi(unsigned w) { return __uint_as_float(w & 0xffff0000u); }
__device__ __forceinline__ unsigned f2bf(float f) { unsigned u = __float_as_uint(f); return (u + 0x7fffu + ((u >> 16) & 1u)) >> 16; }
__device__ __forceinline__ unsigned pk2(float lo, float hi);
typedef __bf16 bf16x2_t __attribute__((ext_vector_type(2)));
__device__ __forceinline__ unsigned hwpk2(float lo, float hi) { const f32x2 v = {lo, hi}; const bf16x2_t r = __builtin_convertvector(v, bf16x2_t); return __builtin_bit_cast(unsigned, r); }
__device__ __forceinline__ unsigned pk2(float lo, float hi) { return hwpk2(lo, hi); }
__device__ __forceinline__ float sigmoidf_(float x) { return 1.f / (1.f + __expf(-x)); }
__device__ __forceinline__ float siluf_(float x) { return x / (1.f + __expf(-x)); }
__device__ __forceinline__ float wave_sum(float v) {
#pragma unroll
    for (int o = 1; o < 64; o <<= 1) v += __shfl_xor(v, o);
    return v;
}
__device__ __forceinline__ u32x4 pack8(const f32x4 a, const f32x4 b) { u32x4 w; w.x = pk2(a[0], a[1]); w.y = pk2(a[2], a[3]); w.z = pk2(b[0], b[1]); w.w = pk2(b[2], b[3]); return w; }

typedef __attribute__((address_space(1))) unsigned gu32;
#define XB_TMO      128
#define XB_XCNT(j)  (256  + 64 * (j))
#define XB_XSUB(j)  (1280 + 64 * (j))
#define XB_XGEN(j)  (2304 + 64 * (j))
#define XB_TOP      3328
#define XB_TOPGEN   3392
#define XCD_BAR_WORDS 3456
#define XB_SPIN_CAP (1u << 18)

__device__ __forceinline__ unsigned xb_ld(unsigned* p)              { return __hip_atomic_load(p, __ATOMIC_RELAXED, __HIP_MEMORY_SCOPE_AGENT); }
__device__ __forceinline__ unsigned xb_add(unsigned* p, unsigned v) { return __hip_atomic_fetch_add(p, v, __ATOMIC_RELAXED, __HIP_MEMORY_SCOPE_AGENT); }
__device__ __forceinline__ unsigned xb_xcc_id() { return (unsigned)__builtin_amdgcn_s_getreg((3 << 11) | 20) & 0xFu; }
#define XB_SPIN(cond, bar) do { unsigned _sp = 0; while (cond) { __builtin_amdgcn_s_sleep(1); \
    if ((++_sp & 255u) == 0u) { if (xb_ld(&(bar)[XB_TMO])) break; if (_sp > XB_SPIN_CAP) { atomicAdd(&(bar)[XB_TMO], 1u); break; } } } } while (0)

struct XcdBarrier {
    unsigned* bar; unsigned x;
    volatile LAS unsigned* st;
};

__device__ __forceinline__ XcdBarrier xcd_barrier_post(unsigned* bar, volatile LAS unsigned* st) {
    XcdBarrier b; b.bar = bar; b.x = xb_xcc_id(); b.st = st;
    if (threadIdx.x == 0) (void)xb_add(&bar[XB_XCNT(b.x)], 1u);
    return b;
}
__device__ __forceinline__ void xcd_barrier_complete(unsigned* bar, unsigned x, unsigned& nloc, unsigned& nx) {
    const unsigned G = gridDim.x * gridDim.y * gridDim.z;
    unsigned sum, cnt, mine, sp = 0u;
    for (;;) {
        sum = 0u; cnt = 0u; mine = 0u;
#pragma unroll
        for (unsigned j = 0; j < 16; ++j) { const unsigned c = xb_ld(&bar[XB_XCNT(j)]); sum += c; cnt += (c > 0u) ? 1u : 0u; mine = (j == x) ? c : mine; }
        if (sum == G) break;
        __builtin_amdgcn_s_sleep(1);
        if ((++sp & 255u) == 0u) { if (xb_ld(&bar[XB_TMO])) break; if (sp > XB_SPIN_CAP) { atomicAdd(&bar[XB_TMO], 1u); break; } }
    }
    nloc = mine > 0u ? mine : 1u; nx = cnt > 0u ? cnt : 1u;
}

__device__ __forceinline__ void xcd_barrier(const XcdBarrier& b) {
    asm volatile("s_waitcnt vmcnt(0)" ::: "memory");
    __syncthreads();
    if (threadIdx.x == 0) {
        unsigned* bar = b.bar;
        __builtin_amdgcn_s_waitcnt(0);
        unsigned nloc = b.st[0], nx = b.st[1];
        if (nloc == 0u) { xcd_barrier_complete(bar, b.x, nloc, nx); b.st[0] = nloc; b.st[1] = nx; }
        const unsigned old = xb_add(&bar[XB_XSUB(b.x)], 1u);
        const unsigned gen = old / nloc;
        if (old + 1u == (gen + 1u) * nloc) {
            __builtin_amdgcn_fence(__ATOMIC_RELEASE, "agent");
            asm volatile("s_waitcnt vmcnt(0)" ::: "memory");
            const unsigned og = xb_add(&bar[XB_TOP], 1u);
            const unsigned tg = og / nx;
            if (og + 1u == (tg + 1u) * nx) xb_add(&bar[XB_TOPGEN], 1u);
            else XB_SPIN(xb_ld(&bar[XB_TOPGEN]) == tg, bar);
            __builtin_amdgcn_fence(__ATOMIC_ACQUIRE, "agent");
            xb_add(&bar[XB_XGEN(b.x)], 1u);
            asm volatile("s_waitcnt vmcnt(0)" ::: "memory");
        } else {
            XB_SPIN(xb_ld(&bar[XB_XGEN(b.x)]) == gen, bar);
            __builtin_amdgcn_fence(__ATOMIC_ACQUIRE, "agent");
            asm volatile("s_waitcnt vmcnt(0)" ::: "memory");
        }
    }
    __syncthreads();
}


struct FIn {
    unsigned char* ws; float* out;
    __device__ __forceinline__ void operator()(const pg8::Unit& u, int row, int col, f32x4 v0, f32x4 v1) const {
        const int seg = u.pn >> 1, c = col & 511;
        if (seg == 0 || seg == 4) { f32x4 a, b;
#pragma unroll
            for (int i = 0; i < 4; ++i) { a[i] = siluf_(v0[i]); b[i] = siluf_(v1[i]); }
            bf16* dst = (bf16*)(ws + (seg == 0 ? WS_Q : WS_OG));
            *(u32x4*)(dst + (size_t)row * 512 + c) = pack8(a, b);
        } else if (seg == 1 || seg == 2) {
            const float* lb = (const float*)(ws + WS_LB);
            const f32x4 l0 = *(const f32x4*)(lb + c), l1 = *(const f32x4*)(lb + c + 4); f32x4 a, b;
#pragma unroll
            for (int i = 0; i < 4; ++i) { a[i] = l0[i] + (1.f - l0[i]) * sigmoidf_(v0[i]); b[i] = l1[i] + (1.f - l1[i]) * sigmoidf_(v1[i]); }
            float* dst;
            if (u.pm < 64) dst = out + (seg == 1 ? (size_t)0 : (size_t)MTOK * 512) + (size_t)row * 512 + c;
            else dst = (float*)(ws + (seg == 1 ? WS_GFC : WS_GBC)) + (size_t)(row - MTOK) * 512 + c;
            *(f32x4*)dst = a; *(f32x4*)(dst + 4) = b;
        } else if (seg == 3) {
            bf16* dst;
            if (u.pm < 64) dst = (bf16*)(ws + WS_V) + (size_t)row * 512 + c; else dst = (bf16*)(ws + WS_VC) + (size_t)(row - MTOK) * 512 + c;
            *(u32x4*)dst = pack8(v0, v1);
        } else { f32x4 a, b;
#pragma unroll
            for (int i = 0; i < 4; ++i) { a[i] = sigmoidf_(v0[i]); b[i] = sigmoidf_(v1[i]); }
            bf16* dst = (seg < 7) ? ((bf16*)(ws + WS_GA) + (size_t)row * 1024 + (col - 5 * 512)) : ((bf16*)(ws + WS_GBG) + (size_t)row * 1024 + (col - 7 * 512));
            *(u32x4*)dst = pack8(a, b);
        }
    }
};
struct FPQ {
    bf16* pqt;
    __device__ __forceinline__ void operator()(const pg8::Unit&, int row, int col, f32x4 v0, f32x4 v1) const {
        bf16* dst = pqt + (size_t)(row & 511) * 32768 + (size_t)(col >> 11) * 4096 + (size_t)(row >> 9) * 1024 + ((col & 2047) >> 1);
        u32x2 ev, od; ev.x = pk2(v0[0], v0[2]); ev.y = pk2(v1[0], v1[2]); od.x = pk2(v0[1], v0[3]); od.y = pk2(v1[1], v1[3]);
        *(u32x2*)dst = ev; *(u32x2*)(dst + 2048) = od;
    }
};
struct EpiDft {
    static constexpr bool PERM = true;
    bf16* yf; unsigned* flags;
    __device__ __forceinline__ void operator()(const f32x4 (&acc)[2][2][4][2], const pg8::Unit& u, int wr, int wc, int fr, int fq) const {
        const int z = u.z & 255, eo = u.z >> 8, pair = (z * 4 + u.pm) * 2 + u.pn;
        const int row0 = u.pm * 256 + wr * 64 + fr, col0 = u.pn * 256 + wc * 32 + 8 * fq;
        unsigned* flag = flags + pair * 16;
        if (eo) {
#pragma unroll
            for (int ai = 0; ai < 2; ++ai)
#pragma unroll
                for (int m = 0; m < 4; ++m)
#pragma unroll
                    for (int bj = 0; bj < 2; ++bj) { const int row = row0 + ai * 128 + m * 16, col = col0 + bj * 128;
                        *(u32x4*)(yf + ((size_t)z * SEQ + 1024 + row) * 512 + col) = pack8(acc[ai][bj][m][0] * (1.f / 512.f), acc[ai][bj][m][1] * (1.f / 512.f)); }
            asm volatile("s_waitcnt vmcnt(0)" ::: "memory");
            __syncthreads();
            if (threadIdx.x == 0) { __builtin_amdgcn_fence(__ATOMIC_RELEASE, "agent"); asm volatile("s_waitcnt vmcnt(0)" ::: "memory");
                __hip_atomic_store(flag, 1u, __ATOMIC_RELAXED, __HIP_MEMORY_SCOPE_AGENT); }
        } else {
            if (threadIdx.x == 0) { unsigned spins = 0;
                while (__hip_atomic_load(flag, __ATOMIC_RELAXED, __HIP_MEMORY_SCOPE_AGENT) == 0u && ++spins < (1u << 22)) __builtin_amdgcn_s_sleep(2);
                __builtin_amdgcn_fence(__ATOMIC_ACQUIRE, "agent"); asm volatile("s_waitcnt vmcnt(0)" ::: "memory"); }
            __syncthreads();
#pragma unroll
            for (int ai = 0; ai < 2; ++ai)
#pragma unroll
                for (int m = 0; m < 4; ++m) {
#pragma unroll
                    for (int bj = 0; bj < 2; ++bj) { const int row = row0 + ai * 128 + m * 16, col = col0 + bj * 128;
                        bf16* plo = yf + ((size_t)z * SEQ + row) * 512 + col; bf16* phi = plo + (size_t)1024 * 512;
                        const u32x4 o = *(const u32x4*)phi;
                        const f32x4 e0 = acc[ai][bj][m][0] * (1.f / 512.f), e1 = acc[ai][bj][m][1] * (1.f / 512.f);
                        f32x4 o0, o1; o0[0] = bflo(o.x); o0[1] = bfhi(o.x); o0[2] = bflo(o.y); o0[3] = bfhi(o.y); o1[0] = bflo(o.z); o1[1] = bfhi(o.z); o1[2] = bflo(o.w); o1[3] = bfhi(o.w);
                        *(u32x4*)plo = pack8(e0 + o0, e1 + o1); *(u32x4*)phi = pack8(e0 - o0, e1 - o1); }
                    asm volatile("" ::: "memory"); }
        }
    }
};
struct FYa {
    const bf16* ga; bf16* tmp;
    __device__ __forceinline__ void operator()(const pg8::Unit&, int row, int col, f32x4 v0, f32x4 v1) const {
        const size_t o = (size_t)row * 1024 + col; const u32x4 g = *(const u32x4*)(ga + o);
        f32x4 a, b; a[0] = v0[0] * bflo(g.x); a[1] = v0[1] * bfhi(g.x); a[2] = v0[2] * bflo(g.y); a[3] = v0[3] * bfhi(g.y);
        b[0] = v1[0] * bflo(g.z); b[1] = v1[1] * bfhi(g.z); b[2] = v1[2] * bflo(g.w); b[3] = v1[3] * bfhi(g.w);
        *(u32x4*)(tmp + o) = pack8(a, b);
    }
};
struct FYb {
    const bf16* gbg; const bf16* tmp; bf16* mrg;
    __device__ __forceinline__ void operator()(const pg8::Unit&, int row, int col, f32x4 v0, f32x4 v1) const {
        const size_t o = (size_t)row * 1024 + col; const u32x4 g = *(const u32x4*)(gbg + o); const u32x4 t = *(const u32x4*)(tmp + o);
        f32x4 a, b; a[0] = bflo(t.x) + v0[0] * bflo(g.x); a[1] = bfhi(t.x) + v0[1] * bfhi(g.x); a[2] = bflo(t.y) + v0[2] * bflo(g.y); a[3] = bfhi(t.y) + v0[3] * bfhi(g.y);
        b[0] = bflo(t.z) + v1[0] * bflo(g.z); b[1] = bfhi(t.z) + v1[1] * bfhi(g.z); b[2] = bflo(t.w) + v1[2] * bflo(g.w); b[3] = bfhi(t.w) + v1[3] * bfhi(g.w);
        *(u32x4*)(mrg + o) = pack8(a, b);
    }
};
struct FRes {
    const float* src; float* dst; const float* mx; int mod;
    __device__ __forceinline__ void operator()(const pg8::Unit&, int row, int col, f32x4 v0, f32x4 v1) const {
        const size_t o = (size_t)row * 1024 + col; const float* m = mx + (size_t)(row >> 11) * (NMOD * DM) + mod * DM + col;
        const f32x4 m0 = *(const f32x4*)m, m1 = *(const f32x4*)(m + 4), s0 = *(const f32x4*)(src + o), s1 = *(const f32x4*)(src + o + 4);
        *(f32x4*)(dst + o) = s0 + m0 * v0; *(f32x4*)(dst + o + 4) = s1 + m1 * v1;
    }
};
struct FUp {
    bf16* z; int ld;
    __device__ __forceinline__ void operator()(const pg8::Unit&, int row, int col, f32x4 v0, f32x4 v1) const {
        *(u32x4*)(z + (size_t)row * ld + col) = pack8(v0, v1);
    }
};

__device__ __forceinline__ void transpose_item(const float* W, int K, int N, bf16* WT, LAS float* scr, int item, int lane) {
    const int nblk = N / 32, kb = item / nblk, nb = item % nblk, k0 = 64 * kb, n0 = 32 * nb;
#pragma unroll 8
    for (int i = 0; i < 32; ++i) { const int kk = 2 * i + (lane >> 5); scr[kk * 33 + (lane & 31)] = W[(size_t)(k0 + kk) * N + n0 + (lane & 31)]; }
    asm volatile("s_waitcnt lgkmcnt(0)" ::: "memory");
    const int c = lane & 7;
#pragma unroll
    for (int j = 0; j < 4; ++j) { const int n = (lane >> 3) + 8 * j; const LAS float* s = scr + (8 * c) * 33 + n;
        u32x4 o; o.x = pk2(s[0 * 33], s[1 * 33]); o.y = pk2(s[2 * 33], s[3 * 33]); o.z = pk2(s[4 * 33], s[5 * 33]); o.w = pk2(s[6 * 33], s[7 * 33]);
        *(u32x4*)(WT + (size_t)(n0 + n) * K + k0 + 8 * c) = o; }
    asm volatile("s_waitcnt lgkmcnt(0)" ::: "memory");
}

template <bool MOD>
__device__ __forceinline__ void norm_rows(const float* srcA, const float* srcB, int nA, const float* g, const float* mx, int shift_mod, int scale_mod,
                                          bf16* outb, float* outf, int r0, int nr, int lane) {
    f32x4 G[4], SH[4], cur[4], nxt[4];
    int curmod = -1;
    { const float* s0 = (r0 < nA) ? srcA + (size_t)r0 * DM : srcB + (size_t)(r0 - nA) * DM;
#pragma unroll
      for (int j = 0; j < 4; ++j) cur[j] = *(const f32x4*)(s0 + (lane + 64 * j) * 4); }
#pragma unroll 1
    for (int i = 0; i < nr; ++i) {
        const int m = r0 + i;
        if (i + 1 < nr) { const int m1 = m + 1; const float* s1 = (m1 < nA) ? srcA + (size_t)m1 * DM : srcB + (size_t)(m1 - nA) * DM;
#pragma unroll
            for (int j = 0; j < 4; ++j) nxt[j] = *(const f32x4*)(s1 + (lane + 64 * j) * 4); }
        const int mr = MOD ? ((m < nA) ? (m >> 11) : 8) : 0;
        if (mr != curmod) { curmod = mr;
#pragma unroll
            for (int j = 0; j < 4; ++j) { const int e = (lane + 64 * j) * 4; const f32x4 gg = *(const f32x4*)(g + e);
                if (MOD) { const f32x4 sc = *(const f32x4*)(mx + (size_t)mr * (NMOD * DM) + scale_mod * DM + e); SH[j] = *(const f32x4*)(mx + (size_t)mr * (NMOD * DM) + shift_mod * DM + e); G[j] = gg * (sc + 1.f); }
                else { G[j] = gg; SH[j] = (f32x4){0.f, 0.f, 0.f, 0.f}; } } }
        float s = 0.f;
#pragma unroll
        for (int j = 0; j < 4; ++j) s += (cur[j][0] * cur[j][0] + cur[j][1] * cur[j][1]) + (cur[j][2] * cur[j][2] + cur[j][3] * cur[j][3]);
        const float rinv = rsqrtf(wave_sum(s) * (1.f / DM) + EPSN);
#pragma unroll
        for (int j = 0; j < 4; ++j) { const int e = (lane + 64 * j) * 4; const f32x4 h = cur[j] * rinv * G[j] + SH[j];
            if (MOD) { u32x2 w; w.x = pk2(h[0], h[1]); w.y = pk2(h[2], h[3]); *(u32x2*)(outb + (size_t)m * DM + e) = w; }
            else *(f32x4*)(outf + (size_t)m * DM + e) = h; }
#pragma unroll
        for (int j = 0; j < 4; ++j) cur[j] = nxt[j];
    }
}

__device__ __forceinline__ void phase0(const Params& p, unsigned char* lds, int tid, int lane, int wave, int G, const int part) {
    float* ldsf = (float*)lds;
    float* mxo = (float*)(p.ws + WS_MX);
    if (part == 0) {
    for (int it = blockIdx.x; it < 192; it += G) {
        __syncthreads();
        {
            const float* c = p.in[1]; const float* cc = p.in[3]; const float* aw = p.in[4]; const float* ab = p.in[5];
            float* sc = ldsf;
            float* red = ldsf + 9 * 1024;
            for (int i = tid; i < 9 * 1024; i += NTHR) { const int r = i >> 10, k = i & 1023; const float cv = (r < 8) ? c[r * 1024 + k] : cc[k]; sc[i] = cv / (1.f + __expf(-cv)); }
            __syncthreads();
            const int n0 = it * 32, col = tid & 31, ks = tid >> 5;
            float a[9];
#pragma unroll
            for (int r = 0; r < 9; ++r) a[r] = 0.f;
            for (int k = ks * 64; k < ks * 64 + 64; ++k) { const float w = aw[(size_t)k * (NMOD * DM) + n0 + col];
#pragma unroll
                for (int r = 0; r < 9; ++r) a[r] += sc[r * 1024 + k] * w; }
#pragma unroll
            for (int r = 0; r < 9; ++r) red[(ks * 9 + r) * 32 + col] = a[r];
            __syncthreads();
            if (tid < 288) { const int r = tid >> 5, cl = tid & 31; float s = ab[n0 + cl];
                for (int k2 = 0; k2 < 16; ++k2) s += red[(k2 * 9 + r) * 32 + cl];
                mxo[r * (NMOD * DM) + n0 + cl] = s; }
        }
    }
    __syncthreads();
    { bf16* tch = (bf16*)(p.ws + WS_TCH); bf16* wfs = (bf16*)(p.ws + WS_WFS); const float* win = p.in[7];
      for (int i = blockIdx.x * NTHR + tid; i < 1024 * 64; i += G * NTHR) { const int n = i >> 6, c8 = (i & 63) * 8, gn = (n & 511) >> 7, j = n & 127; float vv[8];
#pragma unroll
          for (int e = 0; e < 8; ++e) { const int cp = c8 + e, idx = ((cp & 127) * j) & 127; const float ang = (float)idx * (1.f / 64.f);
              vv[e] = ((cp >> 7) == gn) ? ((n < 512) ? cospif(ang) : sinpif(ang)) : 0.f; }
          u32x4 w; w.x = pk2(vv[0], vv[1]); w.y = pk2(vv[2], vv[3]); w.z = pk2(vv[4], vv[5]); w.w = pk2(vv[6], vv[7]);
          *(u32x4*)(tch + (size_t)n * 512 + c8) = w;
          const f32x4 a = *(const f32x4*)(win + (size_t)n * INDIM + c8), b2 = *(const f32x4*)(win + (size_t)n * INDIM + c8 + 4);
          *(u32x4*)(wfs + (size_t)n * 512 + c8) = pack8(a, b2); } }
    }
    if (part == 0 && blockIdx.x == G - 1) { const float* hl = p.in[8]; float* lbo = (float*)(p.ws + WS_LB);
        if (tid < 512) { const float a = hl[tid], b = hl[512 + tid]; lbo[tid] = 1.f / (1.f + expf(b - a)); } }
    if (part == 0) return;
    { bf16* cs = (bf16*)(p.ws + WS_CS);
      for (int i = blockIdx.x * NTHR + tid; i < 2 * 1024 * 256; i += G * NTHR) { const int eo = i >> 18, l = (i >> 8) & 1023, kc = (i & 255) * 8; float vv[8];
#pragma unroll
          for (int e = 0; e < 8; ++e) { const int k = kc + e, sn = k >> 10, m = k & 1023;
              const float ang = eo ? (float)((l * (2 * m + 1)) & 2047) * (1.f / 1024.f) : (float)((l * m) & 1023) * (1.f / 512.f);
              vv[e] = sn ? -sinpif(ang) : cospif(ang); }
          u32x4 w; w.x = pk2(vv[0], vv[1]); w.y = pk2(vv[2], vv[3]); w.z = pk2(vv[4], vv[5]); w.w = pk2(vv[6], vv[7]);
          *(u32x4*)(cs + ((size_t)eo * 1024 + l) * 2048 + kc) = w; } }
    { LAS float* scr = (LAS float*)((LAS unsigned char*)lds + wave * 16384);
      const int gw = blockIdx.x * NWAVES + wave, NGW = G * NWAVES;
      constexpr int I_IN = 16 * 160, I_A = 8 * 32, I_B = 8 * 32, I_O = 16 * 32;
      for (int it = gw; it < I_IN + I_A + I_B + I_O; it += NGW) { int r = it;
          if (r < I_IN) { transpose_item(p.in[7], 1024, INDIM, (bf16*)(p.ws + WS_WIN), scr, r, lane); continue; } r -= I_IN;
          if (r < I_A) { transpose_item(p.in[10], 512, 1024, (bf16*)(p.ws + WS_WA), scr, r, lane); continue; } r -= I_A;
          if (r < I_B) { transpose_item(p.in[11], 512, 1024, (bf16*)(p.ws + WS_WB), scr, r, lane); continue; } r -= I_B;
          transpose_item(p.in[12], 1024, 1024, (bf16*)(p.ws + WS_WOUT), scr, r, lane); } }
}

__device__ __forceinline__ void hgrn_mfma_item(const Params& p, unsigned char* lds, int item) {
    int tid_ = threadIdx.x; asm volatile("" : "+v"(tid_));
    const int tid = tid_, lane = tid & 63, w = __builtin_amdgcn_readfirstlane(tid >> 6), fr = lane & 15, fq = lane >> 4;
    const int vh = item & 1, dir = (item >> 1) & 1, h = (item >> 2) & 3, b = item >> 4;
    bf16* Qs = (bf16*)lds;
    bf16* Ks = Qs + 64 * 136;
    bf16* St = Ks + 64 * 136;
    bf16* Kh = St + 2 * 64 * 136;
    bf16* Vt = Kh + 128 * 72;
    bf16* Ps = Vt + 64 * 72;
    float* Et = (float*)(Ps + 64 * 72);
    float* Fr = Et + 128;
    const int d = 16 * w + fr;
    const float* fL = p.out + (dir ? (size_t)MTOK * 512 : 0) + (size_t)b * SEQ * 512 + h * 128;
    const float* fC = (const float*)(p.ws + (dir ? WS_GBC : WS_GFC)) + (size_t)b * CTXL * 512 + h * 128;
    const bf16* qL = (const bf16*)(p.ws + WS_Q) + (size_t)b * SEQ * 512 + h * 128;
    const bf16* vL = (const bf16*)(p.ws + WS_V) + (size_t)b * SEQ * 512 + h * 128 + vh * 64;
    const bf16* vC = (const bf16*)(p.ws + WS_VC) + (size_t)b * CTXL * 512 + h * 128 + vh * 64;
    bf16* oL = (bf16*)(p.ws + (dir ? WS_OB : WS_OF)) + (size_t)b * SEQ * 512 + h * 128 + vh * 64;
    f32x4 Sa[4];
#pragma unroll
    for (int i = 0; i < 4; ++i) Sa[i] = (f32x4){0.f, 0.f, 0.f, 0.f};
    f32x4 fR[4]; u32x4 qR[2], vR;
#define HG_LOAD(cc_) do { const int _cc = (cc_); const bool _lat = _cc >= 4; const int _c = _lat ? _cc - 4 : _cc, _n = _lat ? SEQ : CTXL; \
        const float* _f = _lat ? fL : fC; const bf16* _v = _lat ? vL : vC; \
        _Pragma("unroll") for (int i = 0; i < 4; ++i) { const int _j = tid + 512 * i, _s = _c * 64 + (_j >> 5), _pos = dir ? (_n - 1 - _s) : _s; fR[i] = *(const f32x4*)(_f + (size_t)_pos * 512 + (_j & 31) * 4); } \
        if (_lat) { _Pragma("unroll") for (int i = 0; i < 2; ++i) { const int _j = tid + 512 * i, _s = _c * 64 + (_j >> 4), _pos = dir ? (_n - 1 - _s) : _s; qR[i] = *(const u32x4*)(qL + (size_t)_pos * 512 + (_j & 15) * 8); } } \
        { const int _s = _c * 64 + lane, _pos = dir ? (_n - 1 - _s) : _s; vR = *(const u32x4*)(_v + (size_t)_pos * 512 + w * 8); } } while (0)
#define HG_STAGE(lat_) do { \
        _Pragma("unroll") for (int i = 0; i < 4; ++i) { const int _j = tid + 512 * i; *(f32x4*)(Fr + (_j >> 5) * 132 + (_j & 31) * 4) = fR[i]; } \
        if (lat_) { _Pragma("unroll") for (int i = 0; i < 2; ++i) { const int _j = tid + 512 * i; *(u32x4*)(Qs + (_j >> 4) * 136 + (_j & 15) * 8) = qR[i]; } } } while (0)
    HG_LOAD(0);
    HG_STAGE(false);
    __syncthreads();
    for (int cc = 0; cc < 36; ++cc) {
        const bool lat = cc >= 4; const int c = lat ? cc - 4 : cc;
        bf16* Scur = St + (cc & 1) * (64 * 136); bf16* Snxt = St + ((cc & 1) ^ 1) * (64 * 136);
        {
            f32x2 cum = (f32x2){1.f, 1.f};
            for (int blk = 0; blk < w; ++blk) { f32x2 t[8];
#pragma unroll
                for (int i = 0; i < 8; ++i) t[i] = *(const f32x2*)(Fr + (8 * blk + i) * 132 + 2 * lane);
                cum = cum * (((t[0] * t[1]) * (t[2] * t[3])) * ((t[4] * t[5]) * (t[6] * t[7]))); }
            f32x2 fown[8];
#pragma unroll
            for (int i = 0; i < 8; ++i) fown[i] = *(const f32x2*)(Fr + (8 * w + i) * 132 + 2 * lane);
            unsigned kp0[4], kp1[4];
#pragma unroll
            for (int i = 0; i < 8; i += 2) { float k0v[2], k1v[2];
#pragma unroll
                for (int u = 0; u < 2; ++u) { const int r = 8 * w + i + u; const f32x2 f = fown[i + u]; cum = cum * f;
                    const float cm0 = fmaxf(cum[0], 1e-30f), cm1 = fmaxf(cum[1], 1e-30f);
                    const float kt0 = (1.f - f[0]) * __builtin_amdgcn_rcpf(cm0), kt1 = (1.f - f[1]) * __builtin_amdgcn_rcpf(cm1);
                    if (lat) { const unsigned qr = *(const unsigned*)(Qs + r * 136 + 2 * lane);
                        *(unsigned*)(Qs + r * 136 + 2 * lane) = hwpk2(bflo(qr) * cm0, bfhi(qr) * cm1); *(unsigned*)(Ks + r * 136 + 2 * lane) = hwpk2(kt0, kt1); }
                    k0v[u] = kt0; k1v[u] = kt1; }
                kp0[i >> 1] = hwpk2(k0v[0], k0v[1]); kp1[i >> 1] = hwpk2(k1v[0], k1v[1]); }
            u32x4 q0; q0.x = kp0[0]; q0.y = kp0[1]; q0.z = kp0[2]; q0.w = kp0[3]; u32x4 q1; q1.x = kp1[0]; q1.y = kp1[1]; q1.z = kp1[2]; q1.w = kp1[3];
            *(u32x4*)(Kh + (2 * lane) * 72 + 8 * w) = q0; *(u32x4*)(Kh + (2 * lane + 1) * 72 + 8 * w) = q1;
            if (w == 7) *(f32x2*)(Et + 2 * lane) = cum;
            Vt[(8 * w + 0) * 72 + lane] = (bf16)(vR.x & 0xffffu); Vt[(8 * w + 1) * 72 + lane] = (bf16)(vR.x >> 16); Vt[(8 * w + 2) * 72 + lane] = (bf16)(vR.y & 0xffffu); Vt[(8 * w + 3) * 72 + lane] = (bf16)(vR.y >> 16);
            Vt[(8 * w + 4) * 72 + lane] = (bf16)(vR.z & 0xffffu); Vt[(8 * w + 5) * 72 + lane] = (bf16)(vR.z >> 16); Vt[(8 * w + 6) * 72 + lane] = (bf16)(vR.w & 0xffffu); Vt[(8 * w + 7) * 72 + lane] = (bf16)(vR.w >> 16);
        }
        if (cc + 1 < 36) HG_LOAD(cc + 1);
        __syncthreads();
        const int ti = w >> 1, x2 = 2 * (w & 1);
        if (lat) {
#pragma unroll
            for (int u2 = 0; u2 < 2; ++u2) { const int si = x2 + u2; f32x4 acc = (f32x4){0.f, 0.f, 0.f, 0.f};
                if (si <= ti) {
#pragma unroll
                    for (int kk = 0; kk < 4; ++kk) { const pg8::bf16x8 a = *(const pg8::bf16x8*)(Ks + (si * 16 + fr) * 136 + kk * 32 + fq * 8), bq = *(const pg8::bf16x8*)(Qs + (ti * 16 + fr) * 136 + kk * 32 + fq * 8);
                        acc = __builtin_amdgcn_mfma_f32_16x16x32_bf16(a, bq, acc, 0, 0, 0); }
                    if (si == ti) {
#pragma unroll
                        for (int r = 0; r < 4; ++r) if (4 * fq + r > fr) acc[r] = 0.f; } }
                u32x2 pw; pw.x = hwpk2(acc[0], acc[1]); pw.y = hwpk2(acc[2], acc[3]);
                *(u32x2*)(Ps + (ti * 16 + fr) * 72 + si * 16 + 4 * fq) = pw; }
        }
        {
            const f32x4 et = *(const f32x4*)(Et + w * 16 + 4 * fq);
            pg8::bf16x8 ka[2];
#pragma unroll
            for (int kk = 0; kk < 2; ++kk) ka[kk] = *(const pg8::bf16x8*)(Kh + (w * 16 + fr) * 72 + kk * 32 + fq * 8);
#pragma unroll
            for (int vi = 0; vi < 4; ++vi) {
#pragma unroll
                for (int kk = 0; kk < 2; ++kk) { const pg8::bf16x8 bv = *(const pg8::bf16x8*)(Vt + (vi * 16 + fr) * 72 + kk * 32 + fq * 8);
                    Sa[vi] = __builtin_amdgcn_mfma_f32_16x16x32_bf16(ka[kk], bv, Sa[vi], 0, 0, 0); }
                Sa[vi] = Sa[vi] * et;
                u32x2 sw; sw.x = hwpk2(Sa[vi][0], Sa[vi][1]); sw.y = hwpk2(Sa[vi][2], Sa[vi][3]);
                *(u32x2*)(Snxt + (vi * 16 + fr) * 136 + w * 16 + 4 * fq) = sw; }
        }
        f32x4 Oa[2];
        Oa[0] = (f32x4){0.f, 0.f, 0.f, 0.f}; Oa[1] = (f32x4){0.f, 0.f, 0.f, 0.f};
        if (lat) {
#pragma unroll
            for (int kk = 0; kk < 4; ++kk) { const pg8::bf16x8 bq = *(const pg8::bf16x8*)(Qs + (ti * 16 + fr) * 136 + kk * 32 + fq * 8);
#pragma unroll
                for (int u2 = 0; u2 < 2; ++u2) { const pg8::bf16x8 a = *(const pg8::bf16x8*)(Scur + ((x2 + u2) * 16 + fr) * 136 + kk * 32 + fq * 8);
                    Oa[u2] = __builtin_amdgcn_mfma_f32_16x16x32_bf16(a, bq, Oa[u2], 0, 0, 0); } }
        }
        __syncthreads();
        if (lat) {
#pragma unroll
            for (int kk = 0; kk < 2; ++kk) { const pg8::bf16x8 bp = *(const pg8::bf16x8*)(Ps + (ti * 16 + fr) * 72 + kk * 32 + fq * 8);
#pragma unroll
                for (int u2 = 0; u2 < 2; ++u2) { const pg8::bf16x8 a = *(const pg8::bf16x8*)(Vt + ((x2 + u2) * 16 + fr) * 72 + kk * 32 + fq * 8);
                    Oa[u2] = __builtin_amdgcn_mfma_f32_16x16x32_bf16(a, bp, Oa[u2], 0, 0, 0); } }
            const int sg = c * 64 + ti * 16 + fr, pos = dir ? (SEQ - 1 - sg) : sg;
#pragma unroll
            for (int u2 = 0; u2 < 2; ++u2) { u32x2 ow; ow.x = hwpk2(Oa[u2][0], Oa[u2][1]); ow.y = hwpk2(Oa[u2][2], Oa[u2][3]);
                *(u32x2*)(oL + (size_t)pos * 512 + (x2 + u2) * 16 + 4 * fq) = ow; }
        }
        if (cc + 1 < 36) HG_STAGE(cc + 1 >= 4);
        __syncthreads();
    }
#undef HG_LOAD
#undef HG_STAGE
}

__device__ __forceinline__ void phase_yh(const Params& p, int lane, int gw, int NGW) {
    const bf16* of = (const bf16*)(p.ws + WS_OF); const bf16* ob = (const bf16*)(p.ws + WS_OB); const bf16* og = (const bf16*)(p.ws + WS_OG);
    bf16* yh = (bf16*)(p.ws + WS_YH); const float* on = p.in[9];
    const f32x4 n0 = *(const f32x4*)(on + lane * 8), n1 = *(const f32x4*)(on + lane * 8 + 4);
    const int per = (MTOK + NGW - 1) / NGW, r0 = gw * per, nr = min(per, MTOK - r0);
    if (nr <= 0) return;
    u32x4 a = *(const u32x4*)(of + (size_t)r0 * 512 + lane * 8), b = *(const u32x4*)(ob + (size_t)r0 * 512 + lane * 8), gg = *(const u32x4*)(og + (size_t)r0 * 512 + lane * 8);
#pragma unroll 1
    for (int i = 0; i < nr; ++i) { const size_t o = (size_t)(r0 + i) * 512 + lane * 8;
        u32x4 a1 = a, b1 = b, g1 = gg;
        if (i + 1 < nr) { a1 = *(const u32x4*)(of + o + 512); b1 = *(const u32x4*)(ob + o + 512); g1 = *(const u32x4*)(og + o + 512); }
        float v[8]; v[0] = bflo(a.x) + bflo(b.x); v[1] = bfhi(a.x) + bfhi(b.x); v[2] = bflo(a.y) + bflo(b.y); v[3] = bfhi(a.y) + bfhi(b.y);
        v[4] = bflo(a.z) + bflo(b.z); v[5] = bfhi(a.z) + bfhi(b.z); v[6] = bflo(a.w) + bflo(b.w); v[7] = bfhi(a.w) + bfhi(b.w);
        float s = 0.f;
#pragma unroll
        for (int k = 0; k < 8; ++k) s += v[k] * v[k];
        s += __shfl_xor(s, 1); s += __shfl_xor(s, 2); s += __shfl_xor(s, 4); s += __shfl_xor(s, 8);
        const float rinv = rsqrtf(s * (1.f / 128.f) + EPSN);
        float gv[8]; gv[0] = bflo(gg.x); gv[1] = bfhi(gg.x); gv[2] = bflo(gg.y); gv[3] = bfhi(gg.y); gv[4] = bflo(gg.z); gv[5] = bfhi(gg.z); gv[6] = bflo(gg.w); gv[7] = bfhi(gg.w);
        f32x4 q0, q1;
#pragma unroll
        for (int k = 0; k < 4; ++k) { q0[k] = v[k] * rinv * n0[k] * gv[k]; q1[k] = v[4 + k] * rinv * n1[k] * gv[4 + k]; }
        *(u32x4*)(yh + o) = pack8(q0, q1);
        a = a1; b = b1; gg = g1; }
}

struct ConvRaw { u32x2 a[3], g[3]; };
__device__ __forceinline__ void conv_issue(const bf16* z, int tokbase, int r, int cc, int ch, ConvRaw& q) {
#pragma unroll
    for (int i = 0; i < 3; ++i) { const int rr = r + i - 1;
        if (rr >= 0 && rr < 32 && cc >= 0 && cc < 64) { const size_t zo = (size_t)(tokbase + rr * 64 + cc) * DFF2 + ch;
            q.a[i] = *(const u32x2*)(z + zo); q.g[i] = *(const u32x2*)(z + zo + DFF);
        } else { q.a[i] = (u32x2){0u, 0u}; q.g[i] = (u32x2){0u, 0u}; } }
}
__device__ __forceinline__ void phase_conv(const Params& p, int hf, int tid, int G) {
    const bf16* z = (const bf16*)(p.ws + WS_Z); bf16* a2 = (bf16*)(p.ws + WS_A2) + (size_t)hf * 8192 * DFF;
    const float* cw = p.in[15]; const float* cb = p.in[16];
    for (int it = blockIdx.x * NTHR + tid; it < 4 * 32 * 4 * 704; it += G * NTHR) {
        const int cg4 = it % 704, rest = it / 704, strip = rest & 3, r = (rest >> 2) & 31, img = rest >> 7, ch = cg4 * 4, c0 = strip * 16, tokbase = img * 2048;
        ConvRaw ring[3];
#pragma unroll
        for (int j = 0; j < 3; ++j) conv_issue(z, tokbase, r, c0 - 1 + j, ch, ring[j]);
        f32x2 w1[9][2], w2[9][2];
#pragma unroll
        for (int t = 0; t < 9; ++t) { const f32x4 a = *(const f32x4*)(cw + (size_t)t * DFF2 + ch), g = *(const f32x4*)(cw + (size_t)t * DFF2 + DFF + ch);
            w1[t][0] = (f32x2){a[0], a[1]}; w1[t][1] = (f32x2){a[2], a[3]}; w2[t][0] = (f32x2){g[0], g[1]}; w2[t][1] = (f32x2){g[2], g[3]}; }
        const f32x4 b1 = *(const f32x4*)(cb + ch), b2 = *(const f32x4*)(cb + DFF + ch);
        f32x2 W1[3][3][2], W2[3][3][2];
#pragma unroll
        for (int j = 0; j < 18; ++j) {
            const int sl = j % 3;
#pragma unroll
            for (int i = 0; i < 3; ++i) { const u32x2 a = ring[j % 3].a[i], g = ring[j % 3].g[i];
                W1[sl][i][0] = (f32x2){bflo(a.x), bfhi(a.x)}; W1[sl][i][1] = (f32x2){bflo(a.y), bfhi(a.y)};
                W2[sl][i][0] = (f32x2){bflo(g.x), bfhi(g.x)}; W2[sl][i][1] = (f32x2){bflo(g.y), bfhi(g.y)}; }
            if (j + 3 < 18) conv_issue(z, tokbase, r, c0 - 1 + j + 3, ch, ring[j % 3]);
            if (j >= 2) {
                const int sL = (j - 2) % 3, sC = (j - 1) % 3, sR = j % 3;
                f32x2 o1[2], o2[2];
                o1[0] = (f32x2){b1[0], b1[1]}; o1[1] = (f32x2){b1[2], b1[3]}; o2[0] = (f32x2){b2[0], b2[1]}; o2[1] = (f32x2){b2[2], b2[3]};
#pragma unroll
                for (int i = 0; i < 3; ++i)
#pragma unroll
                    for (int e = 0; e < 2; ++e) {
                        o1[e] = __builtin_elementwise_fma(W1[sL][i][e], w1[i * 3 + 0][e], o1[e]); o1[e] = __builtin_elementwise_fma(W1[sC][i][e], w1[i * 3 + 1][e], o1[e]); o1[e] = __builtin_elementwise_fma(W1[sR][i][e], w1[i * 3 + 2][e], o1[e]);
                        o2[e] = __builtin_elementwise_fma(W2[sL][i][e], w2[i * 3 + 0][e], o2[e]); o2[e] = __builtin_elementwise_fma(W2[sC][i][e], w2[i * 3 + 1][e], o2[e]); o2[e] = __builtin_elementwise_fma(W2[sR][i][e], w2[i * 3 + 2][e], o2[e]); }
                u32x2 ow; ow.x = pk2(siluf_(o1[0][0]) * o2[0][0], siluf_(o1[0][1]) * o2[0][1]); ow.y = pk2(siluf_(o1[1][0]) * o2[1][0], siluf_(o1[1][1]) * o2[1][1]);
                *(u32x2*)(a2 + (size_t)(tokbase + r * 64 + c0 + j - 2) * DFF + ch) = ow;
            }
        }
    }
}

__global__ void __launch_bounds__(NTHR, 2) fwd_mega(Params p) {
    extern __shared__ __attribute__((aligned(16))) unsigned char lds[];
    cg::grid_group grid = cg::this_grid();
    const int tid = threadIdx.x, lane = tid & 63, wave = __builtin_amdgcn_readfirstlane(tid >> 6);
    const int G = gridDim.x, gw = blockIdx.x * NWAVES + wave, NGW = G * NWAVES;
    PG8_LAS unsigned char* ldsl = (PG8_LAS unsigned char*)lds;
    unsigned char* ws = p.ws;
    const float* mx = (const float*)(ws + WS_MX);
    volatile LAS unsigned* misc = (volatile LAS unsigned*)((LAS unsigned char*)lds + MISC_OFF);
    if (tid < 16) misc[tid] = 0u;
    __syncthreads();
    const XcdBarrier xbar = xcd_barrier_post((unsigned*)(ws + WS_BAR), misc + 8);
    const unsigned long long t0_ = (PROBE_K >= 0) ? __builtin_amdgcn_s_memrealtime() : 0ull;
#define PROBE_POINT(k) do { if (PROBE_K == (k) && tid == 0) { const unsigned long long _n = __builtin_amdgcn_s_memrealtime(), _d = _n - t0_; while (__builtin_amdgcn_s_memrealtime() - _n < _d) __builtin_amdgcn_s_sleep(8); } } while (0)

    for (int rep_ = 0; rep_ < REPS(0); ++rep_) {
    phase0(p, lds, tid, lane, wave, G, 0);
    phase0(p, lds, tid, lane, wave, G, 1);
    xcd_barrier(xbar);
    if (G == 0x7fffffff) grid.sync();
    }
    for (int xs_ = 0; xs_ < EXTRA_SYNCS; ++xs_) xcd_barrier(xbar);
    PROBE_POINT(0);
    for (int rep_ = 0; rep_ < REPS(1); ++rep_) {
    if (blockIdx.x < 16 && G >= 16) {
        pg8::Gemm g{(const bf16*)(ws + WS_TCH), (const bf16*)(ws + WS_WFS), 512, 512, 512};
        pg8::StaticOrder S; S.init(4, 4, 16, blockIdx.x, 512, 512);
        pg8::Epi8<FUp> E{FUp{(bf16*)(ws + WS_WPQ), 1024}};
        pg8::gemm_phase<pg8::Epi8<FUp>, pg8::StaticOrder, true, true>(ldsl, g, S, E);
    }
    { const int per = (MTOK + MCTX + NGW - 1) / NGW, r0 = gw * per, nr = min(per, MTOK + MCTX - r0);
      if (nr > 0) norm_rows<true>(p.in[0], p.in[2], MTOK, p.in[6], mx, 0, 1, (bf16*)(ws + WS_HX), nullptr, r0, nr, lane); }
    xcd_barrier(xbar);
    }
    PROBE_POINT(1);
    for (int rep_ = 0; rep_ < REPS(2); ++rep_) {
    {
        pg8::Gemm g{(const bf16*)(ws + WS_HX), (const bf16*)(ws + WS_WIN) + (size_t)512 * 1024, 1024, 1024, 1024};
        pg8::InOrder S; S.G = G; S.c = blockIdx.x; S.a_tile = (size_t)256 * 1024 * 2; S.b_tile = (size_t)256 * 1024 * 2;
        pg8::Epi8<FIn> E{FIn{ws, p.out}};
        pg8::gemm_phase<pg8::Epi8<FIn>, pg8::InOrder, true, true>(ldsl, g, S, E);
    }
    {
        pg8::Gemm g{(const bf16*)(ws + WS_WPQ), (const bf16*)(ws + WS_HX), 1024, 1024, 1024};
        pg8::StaticOrder S; S.init(4, 64, G, blockIdx.x, 1024, 1024);
        pg8::Epi8<FPQ> E{FPQ{(bf16*)(ws + WS_PQT)}};
        pg8::gemm_phase<pg8::Epi8<FPQ>, pg8::StaticOrder, true, true>(ldsl, g, S, E);
    }
    xcd_barrier(xbar);
    }
    PROBE_POINT(2);
    for (int rep_ = 0; rep_ < REPS(3); ++rep_) {
    if (blockIdx.x < 128 && G >= 192) {
        pg8::Gemm g{(const bf16*)(ws + WS_CS), (const bf16*)(ws + WS_PQT), 2048, 2048, 32768};
        pg8::DftOrder S; S.G = 128; S.c = blockIdx.x; S.a_tile = (size_t)256 * 2048 * 2; S.b_tile = (size_t)256 * 32768 * 2;
        EpiDft E{(bf16*)(ws + WS_YF), (unsigned*)(ws + WS_BAR + 16384)};
        pg8::gemm_phase<EpiDft, pg8::DftOrder, true, true>(ldsl, g, S, E);
    } else if (G >= 192) {
        for (int it = blockIdx.x - 128; it < 128; it += G - 128) hgrn_mfma_item(p, lds, it);
    } else {
        pg8::Gemm g{(const bf16*)(ws + WS_CS), (const bf16*)(ws + WS_PQT), 2048, 2048, 32768};
        pg8::DftOrder S; S.G = G; S.c = blockIdx.x; S.a_tile = (size_t)256 * 2048 * 2; S.b_tile = (size_t)256 * 32768 * 2;
        EpiDft E{(bf16*)(ws + WS_YF), (unsigned*)(ws + WS_BAR + 16384)};
        pg8::gemm_phase<EpiDft, pg8::DftOrder, true, true>(ldsl, g, S, E);
        for (int it = blockIdx.x; it < 128; it += G) hgrn_mfma_item(p, lds, it);
    }
    xcd_barrier(xbar);
    }
    PROBE_POINT(3);
    for (int rep_ = 0; rep_ < REPS(4); ++rep_) {
    phase_yh(p, lane, gw, NGW);
    { LAS float* scr = (LAS float*)((LAS unsigned char*)lds + wave * 16384);
      constexpr int I_UP = 16 * 176, I_DN = 44 * 32;
      for (int it = gw; it < I_UP + I_DN; it += NGW) {
          if (it < I_UP) transpose_item(p.in[14], 1024, DFF2, (bf16*)(ws + WS_WUP), scr, it, lane);
          else transpose_item(p.in[17], DFF, 1024, (bf16*)(ws + WS_WDN), scr, it - I_UP, lane); } }
    xcd_barrier(xbar);
    }
    PROBE_POINT(4);
    for (int rep_ = 0; rep_ < REPS(5); ++rep_) {
    {
        pg8::Gemm g{(const bf16*)(ws + WS_YF), (const bf16*)(ws + WS_WA), 512, 512, 512};
        pg8::StaticOrder S; S.init(64, 4, G, blockIdx.x, 512, 512);
        pg8::Epi8<FYa> E{FYa{(const bf16*)(ws + WS_GA), (bf16*)(ws + WS_TMP)}};
        pg8::gemm_phase<pg8::Epi8<FYa>, pg8::StaticOrder, true, true>(ldsl, g, S, E);
    }
    {
        pg8::Gemm g{(const bf16*)(ws + WS_YH), (const bf16*)(ws + WS_WB), 512, 512, 512};
        pg8::StaticOrder S; S.init(64, 4, G, blockIdx.x, 512, 512);
        pg8::Epi8<FYb> E{FYb{(const bf16*)(ws + WS_GBG), (const bf16*)(ws + WS_TMP), (bf16*)(ws + WS_MRG)}};
        pg8::gemm_phase<pg8::Epi8<FYb>, pg8::StaticOrder, true, true>(ldsl, g, S, E);
    }
    xcd_barrier(xbar);
    }
    PROBE_POINT(5);
    for (int rep_ = 0; rep_ < REPS(6); ++rep_) {
    {
        pg8::Gemm g{(const bf16*)(ws + WS_MRG), (const bf16*)(ws + WS_WOUT), 1024, 1024, 1024};
        pg8::StaticOrder S; S.init(64, 4, G, blockIdx.x, 1024, 1024);
        pg8::Epi8<FRes> E{FRes{p.in[0], p.out, mx, 2}};
        pg8::gemm_phase<pg8::Epi8<FRes>, pg8::StaticOrder, true, true>(ldsl, g, S, E);
    }
    xcd_barrier(xbar);
    }
    PROBE_POINT(6);
    for (int rep_ = 0; rep_ < REPS(7); ++rep_) {
    { const int per = (MTOK + NGW - 1) / NGW, r0 = gw * per, nr = min(per, MTOK - r0);
      if (nr > 0) norm_rows<true>(p.out, p.out, MTOK, p.in[13], mx, 3, 4, (bf16*)(ws + WS_H2), nullptr, r0, nr, lane); }
    xcd_barrier(xbar);
    }
    PROBE_POINT(7);
    {
    for (int hf = 0; hf < 2; ++hf) {
        for (int rep_ = 0; rep_ < REPS(8); ++rep_) {
            pg8::Gemm g{(const bf16*)(ws + WS_H2) + (size_t)hf * 8192 * 1024, (const bf16*)(ws + WS_WUP), 1024, 1024, 1024};
            pg8::StaticOrder S; S.init(32, 22, G, blockIdx.x, 1024, 1024);
            pg8::Epi8<FUp> E{FUp{(bf16*)(ws + WS_Z), DFF2}};
            pg8::gemm_phase<pg8::Epi8<FUp>, pg8::StaticOrder, true, true>(ldsl, g, S, E);
        xcd_barrier(xbar);
        }
        for (int rep_ = 0; rep_ < REPS(9); ++rep_) {
        phase_conv(p, hf, tid, G);
        xcd_barrier(xbar);
        }
    }
    }
    PROBE_POINT(8);
    for (int rep_ = 0; rep_ < REPS(10); ++rep_) {
    {
        pg8::Gemm g{(const bf16*)(ws + WS_A2), (const bf16*)(ws + WS_WDN), DFF, DFF, DFF};
        pg8::StaticOrder S; S.init(64, 4, G, blockIdx.x, DFF, DFF);
        pg8::Epi8<FRes> E{FRes{p.out, (float*)(ws + WS_XO), mx, 5}};
        pg8::gemm_phase<pg8::Epi8<FRes>, pg8::StaticOrder, true, true>(ldsl, g, S, E);
    }
    xcd_barrier(xbar);
    }
    PROBE_POINT(10);
    for (int rep_ = 0; rep_ < REPS(11); ++rep_) {
    { const int per = (MTOK + NGW - 1) / NGW, r0 = gw * per, nr = min(per, MTOK - r0);
      if (nr > 0) norm_rows<false>((const float*)(ws + WS_XO), (const float*)(ws + WS_XO), MTOK, p.in[18], nullptr, 0, 0, nullptr, p.out, r0, nr, lane); }
    }
}

extern "C" void kernel_launch(void* const* d_in, const int* in_sizes, int n_in, void* d_out, int out_size, void* d_ws, size_t ws_size, hipStream_t stream) {
    static int grid = 0;
    if (grid == 0) {
        if (n_in != 19 || out_size != MTOK * DM || ws_size < WS_END) { fprintf(stderr, "kernel_launch: unexpected problem: n_in %d out %d ws %zu\n", n_in, out_size, ws_size); grid = -1; return; }
        int dev = 0, cus = 0, per_cu = 0;
        hipGetDevice(&dev);
        hipDeviceGetAttribute(&cus, hipDeviceAttributeMultiprocessorCount, dev);
        if (hipFuncSetAttribute((const void*)fwd_mega, hipFuncAttributeMaxDynamicSharedMemorySize, LDS_BYTES) != hipSuccess) { fprintf(stderr, "kernel_launch: hipFuncSetAttribute failed\n"); grid = -1; return; }
        if (hipOccupancyMaxActiveBlocksPerMultiprocessor(&per_cu, (const void*)fwd_mega, NTHR, LDS_BYTES) != hipSuccess || per_cu < 1) { fprintf(stderr, "kernel_launch: occupancy query says %d\n", per_cu); per_cu = 1; }
        (void)hipGetLastError();
        grid = cus * (per_cu > 1 ? 1 : per_cu);
        fprintf(stderr, "kernel_launch: grid %d (cus %d, per_cu %d), ws %zu\n", grid, cus, per_cu, ws_size);
    }
    if (grid < 0) return;
    Params p{};
    for (int i = 0; i < 19; ++i) p.in[i] = (const float*)d_in[i];
    p.out = (float*)d_out; p.ws = (unsigned char*)d_ws;
    if (hipMemsetAsync((char*)d_ws + WS_BAR, 0, BAR_BYTES, stream) != hipSuccess) { fprintf(stderr, "kernel_launch: memset failed\n"); return; }
    void* args[] = {&p};
    hipError_t e = hipLaunchCooperativeKernel((const void*)fwd_mega, dim3(grid), dim3(NTHR), args, LDS_BYTES, stream);
    if (e != hipSuccess) fprintf(stderr, "kernel_launch: cooperative launch failed: %s (grid %d)\n", hipGetErrorString(e), grid);
}
```

```cpp
#include <hip/hip_runtime.h>
#include <hip/hip_cooperative_groups.h>
#include <cstdio>
#include <cstdint>
namespace cg = cooperative_groups;

namespace pg8 {
#define PG8_LAS __attribute__((address_space(3)))
typedef unsigned short bf16_t;
typedef short bf16x8 __attribute__((ext_vector_type(8)));
typedef float f32x4 __attribute__((ext_vector_type(4)));
typedef unsigned u32x4 __attribute__((ext_vector_type(4)));
typedef unsigned u32x2 __attribute__((ext_vector_type(2)));
constexpr int BM = 256, BK = 64, HALF = 128, HTB = HALF * BK * 2  , STAGE_BYTES = 8 * HTB, NXCD = 8, WGM = 8;

__host__ __device__ __forceinline__ int lds_byte(int r, int c) { const int st = (r >> 4) * 2 + (c >> 5), rr = r & 15, cc = c & 31, ob = rr * 64 + cc * 2; return st * 1024 + (ob ^ (((ob >> 9) & 1) << 5)); }
__host__ __device__ __forceinline__ void stage_rc(int b, int& R, int& C) { const int st = b / 1024, sb = b % 1024, swz = sb ^ (((sb >> 9) & 1) << 5); R = (st >> 1) * 16 + swz / 64; C = (st & 1) * 32 + (swz % 64) / 2; }
__host__ __device__ __forceinline__ int perm32(int rho) { const int n = rho >> 4, i = rho & 15; return 8 * (i >> 2) + 4 * n + (i & 3); }

struct Unit { int pm, pn, z; };
struct Gemm { const bf16_t* A; const bf16_t* Bt; int K, lda, ldb; };

__device__ __forceinline__ void tile_of(int wgid, int nM, int nN, int& pm, int& pn) {
    const int nwg = nM * nN;
    { const int q = nwg / NXCD, r = nwg % NXCD, xcd = wgid % NXCD, off = wgid / NXCD; wgid = (xcd < r ? xcd * (q + 1) : r * (q + 1) + (xcd - r) * q) + off; }
    const int nig = WGM * nN, gid = wgid / nig, fm = gid * WGM, gsz = (nM - fm) < WGM ? (nM - fm) : WGM;
    pm = fm + ((wgid % nig) % gsz); pn = (wgid % nig) / gsz;
}
struct StaticOrder {
    int nM, nN, nwg, G, c; size_t a_tile, b_tile;
    __device__ __forceinline__ void init(int nM_, int nN_, int G_, int c_, int lda, int ldb) { nM = nM_; nN = nN_; nwg = nM * nN; G = G_; c = c_; a_tile = (size_t)BM * lda * 2; b_tile = (size_t)BM * ldb * 2; }
    __device__ __forceinline__ bool next(int i, Unit& u) const {
        const long L = (long)i * G + c; if (L >= nwg) return false;
        tile_of((int)L, nM, nN, u.pm, u.pn); u.z = 0; return true;
    }
    __device__ __forceinline__ size_t a_off(const Unit& u) const { return (size_t)u.pm * a_tile; }
    __device__ __forceinline__ size_t b_off(const Unit& u) const { return (size_t)u.pn * b_tile; }
};
struct InOrder {
    int G, c; size_t a_tile, b_tile;
    __device__ __forceinline__ bool next(int i, Unit& u) const {
        const long L = (long)i * G + c; if (L >= 1152 + 48) return false;
        if (L < 1152) { tile_of((int)L, 64, 18, u.pm, u.pn); } else { const int j = (int)L - 1152; u.pm = 64 + (j & 7); u.pn = 2 + (j >> 3); }
        u.z = 0; return true;
    }
    __device__ __forceinline__ size_t a_off(const Unit& u) const { return (size_t)u.pm * a_tile; }
    __device__ __forceinline__ size_t b_off(const Unit& u) const { return (size_t)u.pn * b_tile; }
};
struct DftOrder {
    int G, c; size_t a_tile, b_tile;
    __device__ __forceinline__ bool next(int i, Unit& u) const {
        const long L = (long)i * G + c; if (L >= 128) return false;
        const int eo = (L < 64) ? 1 : 0, q = (int)L & 63;
        u.pn = q & 1; u.pm = (q >> 1) & 3; u.z = (q >> 3) | (eo << 8); return true;
    }
    __device__ __forceinline__ size_t a_off(const Unit& u) const { return (size_t)((u.z >> 8) * 4 + u.pm) * a_tile; }
    __device__ __forceinline__ size_t b_off(const Unit& u) const { return (size_t)u.pn * b_tile + ((size_t)(u.z & 255) * 4096 + (size_t)(u.z >> 8) * 2048) * 2; }
};

__device__ __forceinline__ unsigned cvt_pk_bf16(float lo, float hi) { unsigned r; asm volatile("v_cvt_pk_bf16_f32 %0, %1, %2" : "=v"(r) : "v"(lo), "v"(hi)); return r; }

template <class F> struct Epi8 {
    static constexpr bool PERM = true;
    F f;
    __device__ __forceinline__ void operator()(const f32x4 (&acc)[2][2][4][2], const Unit& u, int wr, int wc, int fr, int fq) const {
        const int row0 = u.pm * BM + wr * 64 + fr, col0 = u.pn * BM + wc * 32 + 8 * fq;
#pragma unroll
        for (int ai = 0; ai < 2; ++ai)
#pragma unroll
            for (int m = 0; m < 4; ++m) {
#pragma unroll
                for (int bj = 0; bj < 2; ++bj) f(u, row0 + ai * HALF + m * 16, col0 + bj * HALF, acc[ai][bj][m][0], acc[ai][bj][m][1]);
                asm volatile("" ::: "memory");
            }
    }
};

template <class Epi, class Sched, bool ALIGN_EPI = false, bool SP2 = false>
__device__ __forceinline__ void gemm_phase(PG8_LAS unsigned char* lds, const Gemm g, const Sched& S, const Epi& E) {
    int tid_ = threadIdx.x; asm volatile("" : "+v"(tid_));
    const int tid = tid_, wid = __builtin_amdgcn_readfirstlane(tid >> 6), lane = tid & 63, wr = wid >> 2, wc = wid & 3, fr = lane & 15, fq = lane >> 4;
    const int K = g.K, nt = K / BK;
    unsigned voffA[2], voffB[2];
#pragma unroll
    for (int i = 0; i < 2; ++i) { int R, C; stage_rc(tid * 16 + i * 8192, R, C); const int Rb = Epi::PERM ? ((R & ~31) + perm32(R & 31)) : R;
        voffA[i] = (unsigned)(R * g.lda + C) * 2u; voffB[i] = (unsigned)(Rb * g.ldb + C) * 2u; }
    const size_t kstep = (size_t)(BK * 2);
    const size_t hstepA = (size_t)HALF * g.lda * 2, hstepB = (size_t)HALF * g.ldb * 2;
    const unsigned ldsw = (unsigned)wid * 1024u;
    const int aoff = lds_byte(wr * 64 + fr, fq * 8), boff = lds_byte(wc * 32 + fr, fq * 8);
#define PG8_SA(b, h) (((b) * 2 + (h)) * HTB)
#define PG8_SB(b, h) ((4 + (b) * 2 + (h)) * HTB)
#define PG8_STAGE(bufoff, gbase, voff) do { _Pragma("unroll") for (int _i = 0; _i < 2; ++_i) \
        __builtin_amdgcn_global_load_lds((const unsigned*)((const char*)(gbase) + (voff)[_i]), (PG8_LAS unsigned*)(lds + (bufoff) + ldsw + _i * 8192), 16, 0, 0); } while (0)
#define PG8_LDA(dst, b, h) do { _Pragma("unroll") for (int m = 0; m < 4; ++m) _Pragma("unroll") for (int k = 0; k < 2; ++k) dst[m][k] = *(const PG8_LAS bf16x8*)(lds + PG8_SA(b, h) + aoff + m * 2048 + k * 1024); } while (0)
#define PG8_LDB(dst, b, h) do { _Pragma("unroll") for (int n = 0; n < 2; ++n) _Pragma("unroll") for (int k = 0; k < 2; ++k) dst[n][k] = *(const PG8_LAS bf16x8*)(lds + PG8_SB(b, h) + boff + n * 2048 + k * 1024); } while (0)
#define PG8_MMA(ai, bj, At, Bt) do { __builtin_amdgcn_s_setprio(1); _Pragma("unroll") for (int m = 0; m < 4; ++m) _Pragma("unroll") for (int n = 0; n < 2; ++n) _Pragma("unroll") for (int k = 0; k < 2; ++k) \
        acc[ai][bj][m][n] = __builtin_amdgcn_mfma_f32_16x16x32_bf16(Bt[n][k], At[m][k], acc[ai][bj][m][n], 0, 0, 0); __builtin_amdgcn_s_setprio(0); } while (0)
#define PG8_WAIT_V(n) asm volatile("s_waitcnt vmcnt(" #n ")" ::: "memory")
#define PG8_WAIT_L(n) asm volatile("s_waitcnt lgkmcnt(" #n ")" ::: "memory")
#define PG8_BAR __builtin_amdgcn_s_barrier()
#define PG8_SCHED __builtin_amdgcn_sched_barrier(0)
    Unit cur, nxt; int ui = 0;
    if (!S.next(0, cur)) return;
    f32x4 acc[2][2][4][2];
#pragma unroll
    for (int a = 0; a < 2; ++a)
#pragma unroll
        for (int b = 0; b < 2; ++b)
#pragma unroll
            for (int m = 0; m < 4; ++m)
#pragma unroll
                for (int n = 0; n < 2; ++n) acc[a][b][m][n] = (f32x4){0.f, 0.f, 0.f, 0.f};
    bf16x8 At[4][2], B0[2][2], B1[2][2];
    const char* cA = (const char*)g.A + S.a_off(cur); const char* cB = (const char*)g.Bt + S.b_off(cur);
    if constexpr (SP2) {
        PG8_STAGE(PG8_SB(0, 0), cB, voffB); PG8_STAGE(PG8_SB(0, 1), cB + hstepB, voffB); PG8_STAGE(PG8_SA(0, 0), cA, voffA); PG8_STAGE(PG8_SA(0, 1), cA + hstepA, voffA);
        if (wr == 1) PG8_BAR;
        PG8_WAIT_V(2); PG8_BAR;
        PG8_STAGE(PG8_SB(1, 0), cB + kstep, voffB); PG8_STAGE(PG8_SA(1, 0), cA + kstep, voffA); PG8_STAGE(PG8_SB(1, 1), cB + hstepB + kstep, voffB);
        PG8_WAIT_V(6); PG8_BAR;
    } else {
        PG8_STAGE(PG8_SB(0, 0), cB, voffB); PG8_STAGE(PG8_SA(0, 0), cA, voffA); PG8_STAGE(PG8_SB(0, 1), cB + hstepB, voffB); PG8_STAGE(PG8_SA(0, 1), cA + hstepA, voffA);
        if (wr == 1) PG8_BAR;
        PG8_WAIT_V(4); PG8_BAR;
        PG8_STAGE(PG8_SB(1, 0), cB + kstep, voffB); PG8_STAGE(PG8_SA(1, 0), cA + kstep, voffA); PG8_STAGE(PG8_SB(1, 1), cB + hstepB + kstep, voffB);
        PG8_WAIT_V(6); PG8_BAR;
    }
    for (;;) {
        const bool has_next = S.next(ui + 1, nxt);
        const char* nA = has_next ? (const char*)g.A + S.a_off(nxt) : cA; const char* nB = has_next ? (const char*)g.Bt + S.b_off(nxt) : cB;
        for (int t = 0; t < nt; t += 2) {
            const bool last = (t == nt - 2);
            const char* a1 = cA + (size_t)(t + 1) * kstep;
            const char* a2 = last ? nA : cA + (size_t)(t + 2) * kstep; const char* b2 = last ? nB : cB + (size_t)(t + 2) * kstep;
            const char* a3 = a2 + kstep; const char* b3 = b2 + kstep;
            if constexpr (SP2) {
            PG8_LDB(B0, 0, 0); PG8_LDB(B1, 0, 1); PG8_SCHED; PG8_LDA(At, 0, 0); PG8_STAGE(PG8_SA(1, 1), a1 + hstepA, voffA);
            PG8_WAIT_V(8); PG8_WAIT_L(0); PG8_BAR; PG8_MMA(0, 0, At, B0); PG8_MMA(0, 1, At, B1); PG8_BAR; PG8_SCHED;
            PG8_LDA(At, 0, 1); PG8_STAGE(PG8_SB(0, 0), b2, voffB); PG8_STAGE(PG8_SB(0, 1), b2 + hstepB, voffB); PG8_STAGE(PG8_SA(0, 0), a2, voffA);
            PG8_WAIT_V(8); PG8_WAIT_L(0); PG8_BAR; PG8_MMA(1, 0, At, B0); PG8_MMA(1, 1, At, B1); PG8_BAR; PG8_SCHED;
            PG8_LDB(B0, 1, 0); PG8_LDB(B1, 1, 1); PG8_SCHED; PG8_LDA(At, 1, 0); PG8_STAGE(PG8_SA(0, 1), a2 + hstepA, voffA);
            PG8_WAIT_V(8); PG8_WAIT_L(0); PG8_BAR; PG8_MMA(0, 0, At, B0); PG8_MMA(0, 1, At, B1); PG8_BAR; PG8_SCHED;
            PG8_LDA(At, 1, 1); PG8_STAGE(PG8_SB(1, 0), b3, voffB); PG8_STAGE(PG8_SB(1, 1), b3 + hstepB, voffB); PG8_STAGE(PG8_SA(1, 0), a3, voffA);
            PG8_WAIT_V(8); PG8_WAIT_L(0); PG8_BAR; PG8_MMA(1, 0, At, B0); PG8_MMA(1, 1, At, B1); PG8_BAR; PG8_SCHED;
            } else {
            PG8_LDB(B0, 0, 0); PG8_SCHED; PG8_LDA(At, 0, 0); PG8_STAGE(PG8_SA(1, 1), a1 + hstepA, voffA);
            PG8_WAIT_L(8); PG8_BAR; PG8_WAIT_L(0); PG8_MMA(0, 0, At, B0); PG8_BAR; PG8_SCHED;
            PG8_LDB(B1, 0, 1); PG8_STAGE(PG8_SB(0, 0), b2, voffB);
            PG8_BAR; PG8_WAIT_L(0); PG8_MMA(0, 1, At, B1); PG8_BAR;
            PG8_LDA(At, 0, 1); PG8_STAGE(PG8_SA(0, 0), a2, voffA);
            PG8_BAR; PG8_WAIT_L(0); PG8_MMA(1, 0, At, B0); PG8_BAR; PG8_SCHED;
            PG8_STAGE(PG8_SB(0, 1), b2 + hstepB, voffB);
            PG8_WAIT_V(6); PG8_BAR; PG8_MMA(1, 1, At, B1); PG8_BAR;
            PG8_LDB(B0, 1, 0); PG8_SCHED; PG8_LDA(At, 1, 0); PG8_STAGE(PG8_SA(0, 1), a2 + hstepA, voffA);
            PG8_WAIT_L(8); PG8_BAR; PG8_WAIT_L(0); PG8_MMA(0, 0, At, B0); PG8_BAR; PG8_SCHED;
            PG8_LDB(B1, 1, 1); PG8_STAGE(PG8_SB(1, 0), b3, voffB);
            PG8_BAR; PG8_WAIT_L(0); PG8_MMA(0, 1, At, B1); PG8_BAR;
            PG8_LDA(At, 1, 1); PG8_STAGE(PG8_SA(1, 0), a3, voffA);
            PG8_BAR; PG8_WAIT_L(0); PG8_MMA(1, 0, At, B0); PG8_BAR; PG8_SCHED;
            PG8_STAGE(PG8_SB(1, 1), b3 + hstepB, voffB);
            PG8_WAIT_V(6); PG8_BAR; PG8_MMA(1, 1, At, B1); PG8_BAR;
            }
        }
        if constexpr (ALIGN_EPI) { if (wr == 0) PG8_BAR; }
        E(acc, cur, wr, wc, fr, fq);
        if (!has_next) break;
#pragma unroll
        for (int a = 0; a < 2; ++a)
#pragma unroll
            for (int b = 0; b < 2; ++b)
#pragma unroll
                for (int m = 0; m < 4; ++m)
#pragma unroll
                    for (int n = 0; n < 2; ++n) acc[a][b][m][n] = (f32x4){0.f, 0.f, 0.f, 0.f};
        cur = nxt; cA = nA; cB = nB; ++ui;
        if constexpr (ALIGN_EPI) { if (wr == 1) PG8_BAR; }
    }
    PG8_WAIT_V(0);
    if constexpr (!ALIGN_EPI) { if (wr == 0) PG8_BAR; }
    PG8_BAR;
#undef PG8_SA
#undef PG8_SB
#undef PG8_STAGE
#undef PG8_LDA
#undef PG8_LDB
#undef PG8_MMA
#undef PG8_WAIT_V
#undef PG8_WAIT_L
#undef PG8_BAR
#undef PG8_SCHED
}
}

constexpr int DM = 1024, NB = 8, SEQ = 2048, MTOK = NB * SEQ, CTXL = 256, MCTX = NB * CTXL;
constexpr int HGD = 512, DFF = 2816, DFF2 = 5632, INDIM = 5120, NMOD = 6;
constexpr float EPSN = 1e-6f;
constexpr int NWAVES = 8, NTHR = 512;
constexpr int LDS_BYTES = 147456;
#ifndef DUP_MASK
#define DUP_MASK 0
#endif
#define REPS(k) ((((DUP_MASK) >> (k)) & 1) ? 2 : 1)
#ifndef PROBE_K
#define PROBE_K -1
#endif
#ifndef EXTRA_SYNCS
#define EXTRA_SYNCS 0
#endif

constexpr size_t MiB = 1u << 20;
constexpr size_t WS_MX = 0;
constexpr size_t WS_LB = 256 * 1024;
constexpr size_t WS_WFS = 2 * MiB, WS_TCH = 3 * MiB;
constexpr size_t WS_BAR = 512 * 1024, BAR_BYTES = 32768;
constexpr int MISC_OFF = 147456 - 128;
constexpr size_t WS_WIN = 6 * MiB;
constexpr size_t WS_WPQ = 16 * MiB;
constexpr size_t WS_WA = 18 * MiB, WS_WB = 19 * MiB, WS_WOUT = 20 * MiB;
constexpr size_t WS_CS = 22 * MiB;
constexpr size_t WS_WUP = 6 * MiB;
constexpr size_t WS_WDN = 250 * MiB;
constexpr size_t WS_HX = 38 * MiB;
constexpr size_t WS_OF = 38 * MiB, WS_OB = 54 * MiB;
constexpr size_t WS_TMP = 38 * MiB;
constexpr size_t WS_H2 = 38 * MiB;
constexpr size_t WS_Q = 74 * MiB, WS_V = 90 * MiB, WS_OG = 106 * MiB, WS_GA = 122 * MiB, WS_GBG = 154 * MiB, WS_PQT = 186 * MiB;
constexpr size_t WS_GFC = 218 * MiB, WS_GBC = 222 * MiB, WS_VC = 226 * MiB;
constexpr size_t WS_YF = 228 * MiB;
constexpr size_t WS_YH = 74 * MiB;
constexpr size_t WS_MRG = 186 * MiB;
constexpr size_t WS_Z = 74 * MiB;
constexpr size_t WS_A2 = 162 * MiB;
constexpr size_t WS_XO = 38 * MiB;
constexpr size_t WS_END = 256 * MiB;

typedef unsigned short bf16;
typedef float f32x4 __attribute__((ext_vector_type(4)));
typedef unsigned u32x4 __attribute__((ext_vector_type(4)));
typedef unsigned u32x2 __attribute__((ext_vector_type(2)));
typedef float f32x2 __attribute__((ext_vector_type(2)));
#define LAS __attribute__((address_space(3)))

struct Params {
    const float* in[19];
    float* out;
    unsigned char* ws;
};

__device__ __forceinline__ float bf2f(unsigned short b) { return __uint_as_float(((unsigned)b) << 16); }
__device__ __forceinline__ float bflo(unsigned w) { return __uint_as_float(w << 16); }
__device__ __forceinline__ float bfhi(unsigned w) { return __uint_as_float(w & 0xffff0000u); }
__device__ __forceinline__ unsigned f2bf(float f) { unsigned u = __float_as_uint(f); return (u + 0x7fffu + ((u >> 16) & 1u)) >> 16; }
__device__ __forceinline__ unsigned pk2(float lo, float hi);
typedef __bf16 bf16x2_t __attribute__((ext_vector_type(2)));
__device__ __forceinline__ unsigned hwpk2(float lo, float hi) { const f32x2 v = {lo, hi}; const bf16x2_t r = __builtin_convertvector(v, bf16x2_t); return __builtin_bit_cast(unsigned, r); }
__device__ __forceinline__ unsigned pk2(float lo, float hi) { return hwpk2(lo, hi); }
__device__ __forceinline__ float sigmoidf_(float x) { return __builtin_amdgcn_rcpf(1.f + __expf(-x)); }
__device__ __forceinline__ float siluf_(float x) { return x * __builtin_amdgcn_rcpf(1.f + __expf(-x)); }
__device__ __forceinline__ float wave_sum(float v) {
#pragma unroll
    for (int o = 1; o < 64; o <<= 1) v += __shfl_xor(v, o);
    return v;
}
__device__ __forceinline__ u32x4 pack8(const f32x4 a, const f32x4 b) { u32x4 w; w.x = pk2(a[0], a[1]); w.y = pk2(a[2], a[3]); w.z = pk2(b[0], b[1]); w.w = pk2(b[2], b[3]); return w; }

typedef __attribute__((address_space(1))) unsigned gu32;
#define XB_TMO      128
#define XB_XCNT(j)  (256  + 64 * (j))
#define XB_XSUB(j)  (1280 + 64 * (j))
#define XB_XGEN(j)  (2304 + 64 * (j))
#define XB_TOP      3328
#define XB_TOPGEN   3392
#define XCD_BAR_WORDS 3456
#define XB_SPIN_CAP (1u << 18)

__device__ __forceinline__ unsigned xb_ld(unsigned* p)              { return __hip_atomic_load(p, __ATOMIC_RELAXED, __HIP_MEMORY_SCOPE_AGENT); }
__device__ __forceinline__ unsigned xb_add(unsigned* p, unsigned v) { return __hip_atomic_fetch_add(p, v, __ATOMIC_RELAXED, __HIP_MEMORY_SCOPE_AGENT); }
__device__ __forceinline__ unsigned xb_xcc_id() { return (unsigned)__builtin_amdgcn_s_getreg((3 << 11) | 20) & 0xFu; }
#define XB_SPIN(cond, bar) do { unsigned _sp = 0; while (cond) { __builtin_amdgcn_s_sleep(1); \
    if ((++_sp & 255u) == 0u) { if (xb_ld(&(bar)[XB_TMO])) break; if (_sp > XB_SPIN_CAP) { atomicAdd(&(bar)[XB_TMO], 1u); break; } } } } while (0)

struct XcdBarrier {
    unsigned* bar; unsigned x;
    volatile LAS unsigned* st;
};

__device__ __forceinline__ XcdBarrier xcd_barrier_post(unsigned* bar, volatile LAS unsigned* st) {
    XcdBarrier b; b.bar = bar; b.x = xb_xcc_id(); b.st = st;
    if (threadIdx.x == 0) (void)xb_add(&bar[XB_XCNT(b.x)], 1u);
    return b;
}
__device__ __forceinline__ void xcd_barrier_complete(unsigned* bar, unsigned x, unsigned& nloc, unsigned& nx) {
    const unsigned G = gridDim.x * gridDim.y * gridDim.z;
    unsigned sum, cnt, mine, sp = 0u;
    for (;;) {
        sum = 0u; cnt = 0u; mine = 0u;
#pragma unroll
        for (unsigned j = 0; j < 16; ++j) { const unsigned c = xb_ld(&bar[XB_XCNT(j)]); sum += c; cnt += (c > 0u) ? 1u : 0u; mine = (j == x) ? c : mine; }
        if (sum == G) break;
        __builtin_amdgcn_s_sleep(1);
        if ((++sp & 255u) == 0u) { if (xb_ld(&bar[XB_TMO])) break; if (sp > XB_SPIN_CAP) { atomicAdd(&bar[XB_TMO], 1u); break; } }
    }
    nloc = mine > 0u ? mine : 1u; nx = cnt > 0u ? cnt : 1u;
}

__device__ __forceinline__ void xcd_barrier(const XcdBarrier& b) {
    asm volatile("s_waitcnt vmcnt(0)" ::: "memory");
    __syncthreads();
    if (threadIdx.x == 0) {
        unsigned* bar = b.bar;
        __builtin_amdgcn_s_waitcnt(0);
        unsigned nloc = b.st[0], nx = b.st[1];
        if (nloc == 0u) { xcd_barrier_complete(bar, b.x, nloc, nx); b.st[0] = nloc; b.st[1] = nx; }
        const unsigned old = xb_add(&bar[XB_XSUB(b.x)], 1u);
        const unsigned gen = old / nloc;
        if (old + 1u == (gen + 1u) * nloc) {
            __builtin_amdgcn_fence(__ATOMIC_RELEASE, "agent");
            asm volatile("s_waitcnt vmcnt(0)" ::: "memory");
            const unsigned og = xb_add(&bar[XB_TOP], 1u);
            const unsigned tg = og / nx;
            if (og + 1u == (tg + 1u) * nx) xb_add(&bar[XB_TOPGEN], 1u);
            else XB_SPIN(xb_ld(&bar[XB_TOPGEN]) == tg, bar);
            __builtin_amdgcn_fence(__ATOMIC_ACQUIRE, "agent");
            xb_add(&bar[XB_XGEN(b.x)], 1u);
            asm volatile("s_waitcnt vmcnt(0)" ::: "memory");
        } else {
            XB_SPIN(xb_ld(&bar[XB_XGEN(b.x)]) == gen, bar);
            __builtin_amdgcn_fence(__ATOMIC_ACQUIRE, "agent");
            asm volatile("s_waitcnt vmcnt(0)" ::: "memory");
        }
    }
    __syncthreads();
}


struct FIn {
    unsigned char* ws; float* out;
    __device__ __forceinline__ void operator()(const pg8::Unit& u, int row, int col, f32x4 v0, f32x4 v1) const {
        const int seg = u.pn >> 1, c = col & 511;
        if (seg == 0 || seg == 4) { f32x4 a, b;
#pragma unroll
            for (int i = 0; i < 4; ++i) { a[i] = siluf_(v0[i]); b[i] = siluf_(v1[i]); }
            bf16* dst = (bf16*)(ws + (seg == 0 ? WS_Q : WS_OG));
            *(u32x4*)(dst + (size_t)row * 512 + c) = pack8(a, b);
        } else if (seg == 1 || seg == 2) {
            const float* lb = (const float*)(ws + WS_LB);
            const f32x4 l0 = *(const f32x4*)(lb + c), l1 = *(const f32x4*)(lb + c + 4); f32x4 a, b;
#pragma unroll
            for (int i = 0; i < 4; ++i) { a[i] = l0[i] + (1.f - l0[i]) * sigmoidf_(v0[i]); b[i] = l1[i] + (1.f - l1[i]) * sigmoidf_(v1[i]); }
            float* dst;
            if (u.pm < 64) dst = out + (seg == 1 ? (size_t)0 : (size_t)MTOK * 512) + (size_t)row * 512 + c;
            else dst = (float*)(ws + (seg == 1 ? WS_GFC : WS_GBC)) + (size_t)(row - MTOK) * 512 + c;
            *(f32x4*)dst = a; *(f32x4*)(dst + 4) = b;
        } else if (seg == 3) {
            bf16* dst;
            if (u.pm < 64) dst = (bf16*)(ws + WS_V) + (size_t)row * 512 + c; else dst = (bf16*)(ws + WS_VC) + (size_t)(row - MTOK) * 512 + c;
            *(u32x4*)dst = pack8(v0, v1);
        } else { f32x4 a, b;
#pragma unroll
            for (int i = 0; i < 4; ++i) { a[i] = sigmoidf_(v0[i]); b[i] = sigmoidf_(v1[i]); }
            bf16* dst = (seg < 7) ? ((bf16*)(ws + WS_GA) + (size_t)row * 1024 + (col - 5 * 512)) : ((bf16*)(ws + WS_GBG) + (size_t)row * 1024 + (col - 7 * 512));
            *(u32x4*)dst = pack8(a, b);
        }
    }
};
struct FPQ {
    bf16* pqt;
    __device__ __forceinline__ void operator()(const pg8::Unit&, int row, int col, f32x4 v0, f32x4 v1) const {
        bf16* dst = pqt + (size_t)(row & 511) * 32768 + (size_t)(col >> 11) * 4096 + (size_t)(row >> 9) * 1024 + ((col & 2047) >> 1);
        u32x2 ev, od; ev.x = pk2(v0[0], v0[2]); ev.y = pk2(v1[0], v1[2]); od.x = pk2(v0[1], v0[3]); od.y = pk2(v1[1], v1[3]);
        *(u32x2*)dst = ev; *(u32x2*)(dst + 2048) = od;
    }
};
struct EpiDft {
    static constexpr bool PERM = true;
    bf16* yf; unsigned* flags;
    __device__ __forceinline__ void operator()(const f32x4 (&acc)[2][2][4][2], const pg8::Unit& u, int wr, int wc, int fr, int fq) const {
        const int z = u.z & 255, eo = u.z >> 8, pair = (z * 4 + u.pm) * 2 + u.pn;
        const int row0 = u.pm * 256 + wr * 64 + fr, col0 = u.pn * 256 + wc * 32 + 8 * fq;
        unsigned* flag = flags + pair * 16;
        if (eo) {
#pragma unroll
            for (int ai = 0; ai < 2; ++ai)
#pragma unroll
                for (int m = 0; m < 4; ++m)
#pragma unroll
                    for (int bj = 0; bj < 2; ++bj) { const int row = row0 + ai * 128 + m * 16, col = col0 + bj * 128;
                        *(u32x4*)(yf + ((size_t)z * SEQ + 1024 + row) * 512 + col) = pack8(acc[ai][bj][m][0] * (1.f / 512.f), acc[ai][bj][m][1] * (1.f / 512.f)); }
            asm volatile("s_waitcnt vmcnt(0)" ::: "memory");
            __syncthreads();
            if (threadIdx.x == 0) { __builtin_amdgcn_fence(__ATOMIC_RELEASE, "agent"); asm volatile("s_waitcnt vmcnt(0)" ::: "memory");
                __hip_atomic_store(flag, 1u, __ATOMIC_RELAXED, __HIP_MEMORY_SCOPE_AGENT); }
        } else {
            if (threadIdx.x == 0) { unsigned spins = 0;
                while (__hip_atomic_load(flag, __ATOMIC_RELAXED, __HIP_MEMORY_SCOPE_AGENT) == 0u && ++spins < (1u << 22)) __builtin_amdgcn_s_sleep(2);
                __builtin_amdgcn_fence(__ATOMIC_ACQUIRE, "agent"); asm volatile("s_waitcnt vmcnt(0)" ::: "memory"); }
            __syncthreads();
#pragma unroll
            for (int ai = 0; ai < 2; ++ai)
#pragma unroll
                for (int m = 0; m < 4; ++m) {
#pragma unroll
                    for (int bj = 0; bj < 2; ++bj) { const int row = row0 + ai * 128 + m * 16, col = col0 + bj * 128;
                        bf16* plo = yf + ((size_t)z * SEQ + row) * 512 + col; bf16* phi = plo + (size_t)1024 * 512;
                        const u32x4 o = *(const u32x4*)phi;
                        const f32x4 e0 = acc[ai][bj][m][0] * (1.f / 512.f), e1 = acc[ai][bj][m][1] * (1.f / 512.f);
                        f32x4 o0, o1; o0[0] = bflo(o.x); o0[1] = bfhi(o.x); o0[2] = bflo(o.y); o0[3] = bfhi(o.y); o1[0] = bflo(o.z); o1[1] = bfhi(o.z); o1[2] = bflo(o.w); o1[3] = bfhi(o.w);
                        *(u32x4*)plo = pack8(e0 + o0, e1 + o1); *(u32x4*)phi = pack8(e0 - o0, e1 - o1); }
                    asm volatile("" ::: "memory"); }
        }
    }
};
struct FYa {
    const bf16* ga; bf16* tmp;
    __device__ __forceinline__ void operator()(const pg8::Unit&, int row, int col, f32x4 v0, f32x4 v1) const {
        const size_t o = (size_t)row * 1024 + col; const u32x4 g = *(const u32x4*)(ga + o);
        f32x4 a, b; a[0] = v0[0] * bflo(g.x); a[1] = v0[1] * bfhi(g.x); a[2] = v0[2] * bflo(g.y); a[3] = v0[3] * bfhi(g.y);
        b[0] = v1[0] * bflo(g.z); b[1] = v1[1] * bfhi(g.z); b[2] = v1[2] * bflo(g.w); b[3] = v1[3] * bfhi(g.w);
        *(u32x4*)(tmp + o) = pack8(a, b);
    }
};
struct FYb {
    const bf16* gbg; const bf16* tmp; bf16* mrg;
    __device__ __forceinline__ void operator()(const pg8::Unit&, int row, int col, f32x4 v0, f32x4 v1) const {
        const size_t o = (size_t)row * 1024 + col; const u32x4 g = *(const u32x4*)(gbg + o); const u32x4 t = *(const u32x4*)(tmp + o);
        f32x4 a, b; a[0] = bflo(t.x) + v0[0] * bflo(g.x); a[1] = bfhi(t.x) + v0[1] * bfhi(g.x); a[2] = bflo(t.y) + v0[2] * bflo(g.y); a[3] = bfhi(t.y) + v0[3] * bfhi(g.y);
        b[0] = bflo(t.z) + v1[0] * bflo(g.z); b[1] = bfhi(t.z) + v1[1] * bfhi(g.z); b[2] = bflo(t.w) + v1[2] * bflo(g.w); b[3] = bfhi(t.w) + v1[3] * bfhi(g.w);
        *(u32x4*)(mrg + o) = pack8(a, b);
    }
};
struct FRes {
    const float* src; float* dst; const float* mx; int mod;
    __device__ __forceinline__ void operator()(const pg8::Unit&, int row, int col, f32x4 v0, f32x4 v1) const {
        const size_t o = (size_t)row * 1024 + col; const float* m = mx + (size_t)(row >> 11) * (NMOD * DM) + mod * DM + col;
        const f32x4 m0 = *(const f32x4*)m, m1 = *(const f32x4*)(m + 4), s0 = *(const f32x4*)(src + o), s1 = *(const f32x4*)(src + o + 4);
        *(f32x4*)(dst + o) = s0 + m0 * v0; *(f32x4*)(dst + o + 4) = s1 + m1 * v1;
    }
};
struct FUp {
    bf16* z; int ld;
    __device__ __forceinline__ void operator()(const pg8::Unit&, int row, int col, f32x4 v0, f32x4 v1) const {
        *(u32x4*)(z + (size_t)row * ld + col) = pack8(v0, v1);
    }
};

__device__ __forceinline__ void transpose_item(const float* W, int K, int N, bf16* WT, LAS float* scr, int item, int lane) {
    const int nblk = N / 32, kb = item / nblk, nb = item % nblk, k0 = 64 * kb, n0 = 32 * nb;
#pragma unroll 8
    for (int i = 0; i < 32; ++i) { const int kk = 2 * i + (lane >> 5); scr[kk * 33 + (lane & 31)] = W[(size_t)(k0 + kk) * N + n0 + (lane & 31)]; }
    asm volatile("s_waitcnt lgkmcnt(0)" ::: "memory");
    const int c = lane & 7;
#pragma unroll
    for (int j = 0; j < 4; ++j) { const int n = (lane >> 3) + 8 * j; const LAS float* s = scr + (8 * c) * 33 + n;
        u32x4 o; o.x = pk2(s[0 * 33], s[1 * 33]); o.y = pk2(s[2 * 33], s[3 * 33]); o.z = pk2(s[4 * 33], s[5 * 33]); o.w = pk2(s[6 * 33], s[7 * 33]);
        *(u32x4*)(WT + (size_t)(n0 + n) * K + k0 + 8 * c) = o; }
    asm volatile("s_waitcnt lgkmcnt(0)" ::: "memory");
}

template <bool MOD>
__device__ __forceinline__ void norm_rows(const float* srcA, const float* srcB, int nA, const float* g, const float* mx, int shift_mod, int scale_mod,
                                          bf16* outb, float* outf, int r0, int nr, int lane) {
    f32x4 G[4], SH[4], cur[4], nxt[4];
    int curmod = -1;
    { const float* s0 = (r0 < nA) ? srcA + (size_t)r0 * DM : srcB + (size_t)(r0 - nA) * DM;
#pragma unroll
      for (int j = 0; j < 4; ++j) cur[j] = *(const f32x4*)(s0 + (lane + 64 * j) * 4); }
#pragma unroll 1
    for (int i = 0; i < nr; ++i) {
        const int m = r0 + i;
        if (i + 1 < nr) { const int m1 = m + 1; const float* s1 = (m1 < nA) ? srcA + (size_t)m1 * DM : srcB + (size_t)(m1 - nA) * DM;
#pragma unroll
            for (int j = 0; j < 4; ++j) nxt[j] = *(const f32x4*)(s1 + (lane + 64 * j) * 4); }
        const int mr = MOD ? ((m < nA) ? (m >> 11) : 8) : 0;
        if (mr != curmod) { curmod = mr;
#pragma unroll
            for (int j = 0; j < 4; ++j) { const int e = (lane + 64 * j) * 4; const f32x4 gg = *(const f32x4*)(g + e);
                if (MOD) { const f32x4 sc = *(const f32x4*)(mx + (size_t)mr * (NMOD * DM) + scale_mod * DM + e); SH[j] = *(const f32x4*)(mx + (size_t)mr * (NMOD * DM) + shift_mod * DM + e); G[j] = gg * (sc + 1.f); }
                else { G[j] = gg; SH[j] = (f32x4){0.f, 0.f, 0.f, 0.f}; } } }
        float s = 0.f;
#pragma unroll
        for (int j = 0; j < 4; ++j) s += (cur[j][0] * cur[j][0] + cur[j][1] * cur[j][1]) + (cur[j][2] * cur[j][2] + cur[j][3] * cur[j][3]);
        const float rinv = rsqrtf(wave_sum(s) * (1.f / DM) + EPSN);
#pragma unroll
        for (int j = 0; j < 4; ++j) { const int e = (lane + 64 * j) * 4; const f32x4 h = cur[j] * rinv * G[j] + SH[j];
            if (MOD) { u32x2 w; w.x = pk2(h[0], h[1]); w.y = pk2(h[2], h[3]); *(u32x2*)(outb + (size_t)m * DM + e) = w; }
            else *(f32x4*)(outf + (size_t)m * DM + e) = h; }
#pragma unroll
        for (int j = 0; j < 4; ++j) cur[j] = nxt[j];
    }
}

__device__ __forceinline__ void phase0(const Params& p, unsigned char* lds, int tid, int lane, int wave, int G, const int part) {
    float* ldsf = (float*)lds;
    float* mxo = (float*)(p.ws + WS_MX);
    if (part == 0) {
    for (int it = blockIdx.x; it < 192; it += G) {
        __syncthreads();
        {
            const float* c = p.in[1]; const float* cc = p.in[3]; const float* aw = p.in[4]; const float* ab = p.in[5];
            float* sc = ldsf;
            float* red = ldsf + 9 * 1024;
            for (int i = tid; i < 9 * 1024; i += NTHR) { const int r = i >> 10, k = i & 1023; const float cv = (r < 8) ? c[r * 1024 + k] : cc[k]; sc[i] = cv / (1.f + __expf(-cv)); }
            __syncthreads();
            const int n0 = it * 32, col = tid & 31, ks = tid >> 5;
            float a[9];
#pragma unroll
            for (int r = 0; r < 9; ++r) a[r] = 0.f;
            for (int k = ks * 64; k < ks * 64 + 64; ++k) { const float w = aw[(size_t)k * (NMOD * DM) + n0 + col];
#pragma unroll
                for (int r = 0; r < 9; ++r) a[r] += sc[r * 1024 + k] * w; }
#pragma unroll
            for (int r = 0; r < 9; ++r) red[(ks * 9 + r) * 32 + col] = a[r];
            __syncthreads();
            if (tid < 288) { const int r = tid >> 5, cl = tid & 31; float s = ab[n0 + cl];
                for (int k2 = 0; k2 < 16; ++k2) s += red[(k2 * 9 + r) * 32 + cl];
                mxo[r * (NMOD * DM) + n0 + cl] = s; }
        }
    }
    __syncthreads();
    { bf16* tch = (bf16*)(p.ws + WS_TCH); bf16* wfs = (bf16*)(p.ws + WS_WFS); const float* win = p.in[7];
      for (int i = blockIdx.x * NTHR + tid; i < 1024 * 64; i += G * NTHR) { const int n = i >> 6, c8 = (i & 63) * 8, gn = (n & 511) >> 7, j = n & 127; float vv[8];
#pragma unroll
          for (int e = 0; e < 8; ++e) { const int cp = c8 + e, idx = ((cp & 127) * j) & 127; const float ang = (float)idx * (1.f / 64.f);
              vv[e] = ((cp >> 7) == gn) ? ((n < 512) ? cospif(ang) : sinpif(ang)) : 0.f; }
          u32x4 w; w.x = pk2(vv[0], vv[1]); w.y = pk2(vv[2], vv[3]); w.z = pk2(vv[4], vv[5]); w.w = pk2(vv[6], vv[7]);
          *(u32x4*)(tch + (size_t)n * 512 + c8) = w;
          const f32x4 a = *(const f32x4*)(win + (size_t)n * INDIM + c8), b2 = *(const f32x4*)(win + (size_t)n * INDIM + c8 + 4);
          *(u32x4*)(wfs + (size_t)n * 512 + c8) = pack8(a, b2); } }
    }
    if (part == 0 && blockIdx.x == G - 1) { const float* hl = p.in[8]; float* lbo = (float*)(p.ws + WS_LB);
        if (tid < 512) { const float a = hl[tid], b = hl[512 + tid]; lbo[tid] = 1.f / (1.f + expf(b - a)); } }
    if (part == 0) return;
    { bf16* cs = (bf16*)(p.ws + WS_CS);
      for (int i = blockIdx.x * NTHR + tid; i < 2 * 1024 * 256; i += G * NTHR) { const int eo = i >> 18, l = (i >> 8) & 1023, kc = (i & 255) * 8; float vv[8];
#pragma unroll
          for (int e = 0; e < 8; ++e) { const int k = kc + e, sn = k >> 10, m = k & 1023;
              const float ang = eo ? (float)((l * (2 * m + 1)) & 2047) * (1.f / 1024.f) : (float)((l * m) & 1023) * (1.f / 512.f);
              vv[e] = sn ? -sinpif(ang) : cospif(ang); }
          u32x4 w; w.x = pk2(vv[0], vv[1]); w.y = pk2(vv[2], vv[3]); w.z = pk2(vv[4], vv[5]); w.w = pk2(vv[6], vv[7]);
          *(u32x4*)(cs + ((size_t)eo * 1024 + l) * 2048 + kc) = w; } }
    { LAS float* scr = (LAS float*)((LAS unsigned char*)lds + wave * 16384);
      const int gw = blockIdx.x * NWAVES + wave, NGW = G * NWAVES;
      constexpr int I_IN = 16 * 160, I_A = 8 * 32, I_B = 8 * 32, I_O = 16 * 32;
      for (int it = gw; it < ((G >= 192) ? I_IN : I_IN + I_A + I_B + I_O); it += NGW) { int r = it;
          if (r < I_IN) { transpose_item(p.in[7], 1024, INDIM, (bf16*)(p.ws + WS_WIN), scr, r, lane); continue; } r -= I_IN;
          if (r < I_A) { transpose_item(p.in[10], 512, 1024, (bf16*)(p.ws + WS_WA), scr, r, lane); continue; } r -= I_A;
          if (r < I_B) { transpose_item(p.in[11], 512, 1024, (bf16*)(p.ws + WS_WB), scr, r, lane); continue; } r -= I_B;
          transpose_item(p.in[12], 1024, 1024, (bf16*)(p.ws + WS_WOUT), scr, r, lane); } }
}

__device__ __forceinline__ void hgrn_mfma_item(const Params& p, unsigned char* lds, int item) {
    int tid_ = threadIdx.x; asm volatile("" : "+v"(tid_));
    const int tid = tid_, lane = tid & 63, w = __builtin_amdgcn_readfirstlane(tid >> 6), fr = lane & 15, fq = lane >> 4;
    const int vh = item & 1, dir = (item >> 1) & 1, h = (item >> 2) & 3, b = item >> 4;
    bf16* Qs = (bf16*)lds;
    bf16* Ks = Qs + 64 * 136;
    bf16* St = Ks + 64 * 136;
    bf16* Kh = St + 2 * 64 * 136;
    bf16* Vt = Kh + 128 * 72;
    bf16* Ps = Vt + 64 * 72;
    float* Et = (float*)(Ps + 64 * 72);
    float* Fr = Et + 128;
    const int d = 16 * w + fr;
    const float* fL = p.out + (dir ? (size_t)MTOK * 512 : 0) + (size_t)b * SEQ * 512 + h * 128;
    const float* fC = (const float*)(p.ws + (dir ? WS_GBC : WS_GFC)) + (size_t)b * CTXL * 512 + h * 128;
    const bf16* qL = (const bf16*)(p.ws + WS_Q) + (size_t)b * SEQ * 512 + h * 128;
    const bf16* vL = (const bf16*)(p.ws + WS_V) + (size_t)b * SEQ * 512 + h * 128 + vh * 64;
    const bf16* vC = (const bf16*)(p.ws + WS_VC) + (size_t)b * CTXL * 512 + h * 128 + vh * 64;
    bf16* oL = (bf16*)(p.ws + (dir ? WS_OB : WS_OF)) + (size_t)b * SEQ * 512 + h * 128 + vh * 64;
    f32x4 Sa[4];
#pragma unroll
    for (int i = 0; i < 4; ++i) Sa[i] = (f32x4){0.f, 0.f, 0.f, 0.f};
    f32x4 fR[4]; u32x4 qR[2], vR;
#define HG_LOAD(cc_) do { const int _cc = (cc_); const bool _lat = _cc >= 4; const int _c = _lat ? _cc - 4 : _cc, _n = _lat ? SEQ : CTXL; \
        const float* _f = _lat ? fL : fC; const bf16* _v = _lat ? vL : vC; \
        _Pragma("unroll") for (int i = 0; i < 4; ++i) { const int _j = tid + 512 * i, _s = _c * 64 + (_j >> 5), _pos = dir ? (_n - 1 - _s) : _s; fR[i] = *(const f32x4*)(_f + (size_t)_pos * 512 + (_j & 31) * 4); } \
        if (_lat) { _Pragma("unroll") for (int i = 0; i < 2; ++i) { const int _j = tid + 512 * i, _s = _c * 64 + (_j >> 4), _pos = dir ? (_n - 1 - _s) : _s; qR[i] = *(const u32x4*)(qL + (size_t)_pos * 512 + (_j & 15) * 8); } } \
        { const int _s = _c * 64 + lane, _pos = dir ? (_n - 1 - _s) : _s; vR = *(const u32x4*)(_v + (size_t)_pos * 512 + w * 8); } } while (0)
#define HG_STAGE(lat_) do { \
        _Pragma("unroll") for (int i = 0; i < 4; ++i) { const int _j = tid + 512 * i; *(f32x4*)(Fr + (_j >> 5) * 132 + (_j & 31) * 4) = fR[i]; } \
        if (lat_) { _Pragma("unroll") for (int i = 0; i < 2; ++i) { const int _j = tid + 512 * i; *(u32x4*)(Qs + (_j >> 4) * 136 + (_j & 15) * 8) = qR[i]; } } } while (0)
    HG_LOAD(0);
    HG_STAGE(false);
    __syncthreads();
    for (int cc = 0; cc < 36; ++cc) {
        const bool lat = cc >= 4; const int c = lat ? cc - 4 : cc;
        bf16* Scur = St + (cc & 1) * (64 * 136); bf16* Snxt = St + ((cc & 1) ^ 1) * (64 * 136);
        {
            f32x2 cum = (f32x2){1.f, 1.f};
            for (int blk = 0; blk < w; ++blk) { f32x2 t[8];
#pragma unroll
                for (int i = 0; i < 8; ++i) t[i] = *(const f32x2*)(Fr + (8 * blk + i) * 132 + 2 * lane);
                cum = cum * (((t[0] * t[1]) * (t[2] * t[3])) * ((t[4] * t[5]) * (t[6] * t[7]))); }
            f32x2 fown[8];
#pragma unroll
            for (int i = 0; i < 8; ++i) fown[i] = *(const f32x2*)(Fr + (8 * w + i) * 132 + 2 * lane);
            unsigned kp0[4], kp1[4];
#pragma unroll
            for (int i = 0; i < 8; i += 2) { float k0v[2], k1v[2];
#pragma unroll
                for (int u = 0; u < 2; ++u) { const int r = 8 * w + i + u; const f32x2 f = fown[i + u]; cum = cum * f;
                    const float cm0 = fmaxf(cum[0], 1e-30f), cm1 = fmaxf(cum[1], 1e-30f);
                    const float kt0 = (1.f - f[0]) * __builtin_amdgcn_rcpf(cm0), kt1 = (1.f - f[1]) * __builtin_amdgcn_rcpf(cm1);
                    if (lat) { const unsigned qr = *(const unsigned*)(Qs + r * 136 + 2 * lane);
                        *(unsigned*)(Qs + r * 136 + 2 * lane) = hwpk2(bflo(qr) * cm0, bfhi(qr) * cm1); *(unsigned*)(Ks + r * 136 + 2 * lane) = hwpk2(kt0, kt1); }
                    k0v[u] = kt0; k1v[u] = kt1; }
                kp0[i >> 1] = hwpk2(k0v[0], k0v[1]); kp1[i >> 1] = hwpk2(k1v[0], k1v[1]); }
            u32x4 q0; q0.x = kp0[0]; q0.y = kp0[1]; q0.z = kp0[2]; q0.w = kp0[3]; u32x4 q1; q1.x = kp1[0]; q1.y = kp1[1]; q1.z = kp1[2]; q1.w = kp1[3];
            *(u32x4*)(Kh + (2 * lane) * 72 + 8 * w) = q0; *(u32x4*)(Kh + (2 * lane + 1) * 72 + 8 * w) = q1;
            if (w == 7) *(f32x2*)(Et + 2 * lane) = cum;
            Vt[(8 * w + 0) * 72 + lane] = (bf16)(vR.x & 0xffffu); Vt[(8 * w + 1) * 72 + lane] = (bf16)(vR.x >> 16); Vt[(8 * w + 2) * 72 + lane] = (bf16)(vR.y & 0xffffu); Vt[(8 * w + 3) * 72 + lane] = (bf16)(vR.y >> 16);
            Vt[(8 * w + 4) * 72 + lane] = (bf16)(vR.z & 0xffffu); Vt[(8 * w + 5) * 72 + lane] = (bf16)(vR.z >> 16); Vt[(8 * w + 6) * 72 + lane] = (bf16)(vR.w & 0xffffu); Vt[(8 * w + 7) * 72 + lane] = (bf16)(vR.w >> 16);
        }
        if (cc + 1 < 36) HG_LOAD(cc + 1);
        __syncthreads();
        const int ti = w >> 1, x2 = 2 * (w & 1);
        if (lat) {
#pragma unroll
            for (int u2 = 0; u2 < 2; ++u2) { const int si = x2 + u2; f32x4 acc = (f32x4){0.f, 0.f, 0.f, 0.f};
                if (si <= ti) {
#pragma unroll
                    for (int kk = 0; kk < 4; ++kk) { const pg8::bf16x8 a = *(const pg8::bf16x8*)(Ks + (si * 16 + fr) * 136 + kk * 32 + fq * 8), bq = *(const pg8::bf16x8*)(Qs + (ti * 16 + fr) * 136 + kk * 32 + fq * 8);
                        acc = __builtin_amdgcn_mfma_f32_16x16x32_bf16(a, bq, acc, 0, 0, 0); }
                    if (si == ti) {
#pragma unroll
                        for (int r = 0; r < 4; ++r) if (4 * fq + r > fr) acc[r] = 0.f; } }
                u32x2 pw; pw.x = hwpk2(acc[0], acc[1]); pw.y = hwpk2(acc[2], acc[3]);
                *(u32x2*)(Ps + (ti * 16 + fr) * 72 + si * 16 + 4 * fq) = pw; }
        }
        {
            const f32x4 et = *(const f32x4*)(Et + w * 16 + 4 * fq);
            pg8::bf16x8 ka[2];
#pragma unroll
            for (int kk = 0; kk < 2; ++kk) ka[kk] = *(const pg8::bf16x8*)(Kh + (w * 16 + fr) * 72 + kk * 32 + fq * 8);
#pragma unroll
            for (int vi = 0; vi < 4; ++vi) {
#pragma unroll
                for (int kk = 0; kk < 2; ++kk) { const pg8::bf16x8 bv = *(const pg8::bf16x8*)(Vt + (vi * 16 + fr) * 72 + kk * 32 + fq * 8);
                    Sa[vi] = __builtin_amdgcn_mfma_f32_16x16x32_bf16(ka[kk], bv, Sa[vi], 0, 0, 0); }
                Sa[vi] = Sa[vi] * et;
                u32x2 sw; sw.x = hwpk2(Sa[vi][0], Sa[vi][1]); sw.y = hwpk2(Sa[vi][2], Sa[vi][3]);
                *(u32x2*)(Snxt + (vi * 16 + fr) * 136 + w * 16 + 4 * fq) = sw; }
        }
        f32x4 Oa[2];
        Oa[0] = (f32x4){0.f, 0.f, 0.f, 0.f}; Oa[1] = (f32x4){0.f, 0.f, 0.f, 0.f};
        if (lat) {
#pragma unroll
            for (int kk = 0; kk < 4; ++kk) { const pg8::bf16x8 bq = *(const pg8::bf16x8*)(Qs + (ti * 16 + fr) * 136 + kk * 32 + fq * 8);
#pragma unroll
                for (int u2 = 0; u2 < 2; ++u2) { const pg8::bf16x8 a = *(const pg8::bf16x8*)(Scur + ((x2 + u2) * 16 + fr) * 136 + kk * 32 + fq * 8);
                    Oa[u2] = __builtin_amdgcn_mfma_f32_16x16x32_bf16(a, bq, Oa[u2], 0, 0, 0); } }
        }
        __syncthreads();
        if (lat) {
#pragma unroll
            for (int kk = 0; kk < 2; ++kk) { const pg8::bf16x8 bp = *(const pg8::bf16x8*)(Ps + (ti * 16 + fr) * 72 + kk * 32 + fq * 8);
#pragma unroll
                for (int u2 = 0; u2 < 2; ++u2) { const pg8::bf16x8 a = *(const pg8::bf16x8*)(Vt + ((x2 + u2) * 16 + fr) * 72 + kk * 32 + fq * 8);
                    Oa[u2] = __builtin_amdgcn_mfma_f32_16x16x32_bf16(a, bp, Oa[u2], 0, 0, 0); } }
            const int sg = c * 64 + ti * 16 + fr, pos = dir ? (SEQ - 1 - sg) : sg;
#pragma unroll
            for (int u2 = 0; u2 < 2; ++u2) { u32x2 ow; ow.x = hwpk2(Oa[u2][0], Oa[u2][1]); ow.y = hwpk2(Oa[u2][2], Oa[u2][3]);
                *(u32x2*)(oL + (size_t)pos * 512 + (x2 + u2) * 16 + 4 * fq) = ow; }
        }
        if (cc + 1 < 36) HG_STAGE(cc + 1 >= 4);
        __syncthreads();
    }
#undef HG_LOAD
#undef HG_STAGE
}

__device__ __forceinline__ void phase_yh(const Params& p, int lane, int gw, int NGW) {
    const bf16* of = (const bf16*)(p.ws + WS_OF); const bf16* ob = (const bf16*)(p.ws + WS_OB); const bf16* og = (const bf16*)(p.ws + WS_OG);
    bf16* yh = (bf16*)(p.ws + WS_YH); const float* on = p.in[9];
    const f32x4 n0 = *(const f32x4*)(on + lane * 8), n1 = *(const f32x4*)(on + lane * 8 + 4);
    const int per = (MTOK + NGW - 1) / NGW, r0 = gw * per, nr = min(per, MTOK - r0);
    if (nr <= 0) return;
    u32x4 a = *(const u32x4*)(of + (size_t)r0 * 512 + lane * 8), b = *(const u32x4*)(ob + (size_t)r0 * 512 + lane * 8), gg = *(const u32x4*)(og + (size_t)r0 * 512 + lane * 8);
#pragma unroll 1
    for (int i = 0; i < nr; ++i) { const size_t o = (size_t)(r0 + i) * 512 + lane * 8;
        u32x4 a1 = a, b1 = b, g1 = gg;
        if (i + 1 < nr) { a1 = *(const u32x4*)(of + o + 512); b1 = *(const u32x4*)(ob + o + 512); g1 = *(const u32x4*)(og + o + 512); }
        float v[8]; v[0] = bflo(a.x) + bflo(b.x); v[1] = bfhi(a.x) + bfhi(b.x); v[2] = bflo(a.y) + bflo(b.y); v[3] = bfhi(a.y) + bfhi(b.y);
        v[4] = bflo(a.z) + bflo(b.z); v[5] = bfhi(a.z) + bfhi(b.z); v[6] = bflo(a.w) + bflo(b.w); v[7] = bfhi(a.w) + bfhi(b.w);
        float s = 0.f;
#pragma unroll
        for (int k = 0; k < 8; ++k) s += v[k] * v[k];
        s += __shfl_xor(s, 1); s += __shfl_xor(s, 2); s += __shfl_xor(s, 4); s += __shfl_xor(s, 8);
        const float rinv = rsqrtf(s * (1.f / 128.f) + EPSN);
        float gv[8]; gv[0] = bflo(gg.x); gv[1] = bfhi(gg.x); gv[2] = bflo(gg.y); gv[3] = bfhi(gg.y); gv[4] = bflo(gg.z); gv[5] = bfhi(gg.z); gv[6] = bflo(gg.w); gv[7] = bfhi(gg.w);
        f32x4 q0, q1;
#pragma unroll
        for (int k = 0; k < 4; ++k) { q0[k] = v[k] * rinv * n0[k] * gv[k]; q1[k] = v[4 + k] * rinv * n1[k] * gv[4 + k]; }
        *(u32x4*)(yh + o) = pack8(q0, q1);
        a = a1; b = b1; gg = g1; }
}

struct ConvRaw { u32x2 a[3], g[3]; };
__device__ __forceinline__ void conv_issue(const bf16* z, int tokbase, int r, int cc, int ch, ConvRaw& q) {
#pragma unroll
    for (int i = 0; i < 3; ++i) { const int rr = r + i - 1;
        if (rr >= 0 && rr < 32 && cc >= 0 && cc < 64) { const size_t zo = (size_t)(tokbase + rr * 64 + cc) * DFF2 + ch;
            q.a[i] = *(const u32x2*)(z + zo); q.g[i] = *(const u32x2*)(z + zo + DFF);
        } else { q.a[i] = (u32x2){0u, 0u}; q.g[i] = (u32x2){0u, 0u}; } }
}
__device__ __forceinline__ void phase_conv(const Params& p, int hf, int tid, int G) {
    const bf16* z = (const bf16*)(p.ws + WS_Z); bf16* a2 = (bf16*)(p.ws + WS_A2) + (size_t)hf * 8192 * DFF;
    const float* cw = p.in[15]; const float* cb = p.in[16];
    for (int it = blockIdx.x * NTHR + tid; it < 4 * 32 * 4 * 704; it += G * NTHR) {
        const int cg4 = it % 704, rest = it / 704, strip = rest & 3, r = (rest >> 2) & 31, img = rest >> 7, ch = cg4 * 4, c0 = strip * 16, tokbase = img * 2048;
        ConvRaw ring[3];
#pragma unroll
        for (int j = 0; j < 3; ++j) conv_issue(z, tokbase, r, c0 - 1 + j, ch, ring[j]);
        f32x2 w1[9][2], w2[9][2];
#pragma unroll
        for (int t = 0; t < 9; ++t) { const f32x4 a = *(const f32x4*)(cw + (size_t)t * DFF2 + ch), g = *(const f32x4*)(cw + (size_t)t * DFF2 + DFF + ch);
            w1[t][0] = (f32x2){a[0], a[1]}; w1[t][1] = (f32x2){a[2], a[3]}; w2[t][0] = (f32x2){g[0], g[1]}; w2[t][1] = (f32x2){g[2], g[3]}; }
        const f32x4 b1 = *(const f32x4*)(cb + ch), b2 = *(const f32x4*)(cb + DFF + ch);
        f32x2 W1[3][3][2], W2[3][3][2];
#pragma unroll
        for (int j = 0; j < 18; ++j) {
            const int sl = j % 3;
#pragma unroll
            for (int i = 0; i < 3; ++i) { const u32x2 a = ring[j % 3].a[i], g = ring[j % 3].g[i];
                W1[sl][i][0] = (f32x2){bflo(a.x), bfhi(a.x)}; W1[sl][i][1] = (f32x2){bflo(a.y), bfhi(a.y)};
                W2[sl][i][0] = (f32x2){bflo(g.x), bfhi(g.x)}; W2[sl][i][1] = (f32x2){bflo(g.y), bfhi(g.y)}; }
            if (j + 3 < 18) conv_issue(z, tokbase, r, c0 - 1 + j + 3, ch, ring[j % 3]);
            if (j >= 2) {
                const int sL = (j - 2) % 3, sC = (j - 1) % 3, sR = j % 3;
                f32x2 o1[2], o2[2];
                o1[0] = (f32x2){b1[0], b1[1]}; o1[1] = (f32x2){b1[2], b1[3]}; o2[0] = (f32x2){b2[0], b2[1]}; o2[1] = (f32x2){b2[2], b2[3]};
#pragma unroll
                for (int i = 0; i < 3; ++i)
#pragma unroll
                    for (int e = 0; e < 2; ++e) {
                        o1[e] = __builtin_elementwise_fma(W1[sL][i][e], w1[i * 3 + 0][e], o1[e]); o1[e] = __builtin_elementwise_fma(W1[sC][i][e], w1[i * 3 + 1][e], o1[e]); o1[e] = __builtin_elementwise_fma(W1[sR][i][e], w1[i * 3 + 2][e], o1[e]);
                        o2[e] = __builtin_elementwise_fma(W2[sL][i][e], w2[i * 3 + 0][e], o2[e]); o2[e] = __builtin_elementwise_fma(W2[sC][i][e], w2[i * 3 + 1][e], o2[e]); o2[e] = __builtin_elementwise_fma(W2[sR][i][e], w2[i * 3 + 2][e], o2[e]); }
                u32x2 ow; ow.x = pk2(siluf_(o1[0][0]) * o2[0][0], siluf_(o1[0][1]) * o2[0][1]); ow.y = pk2(siluf_(o1[1][0]) * o2[1][0], siluf_(o1[1][1]) * o2[1][1]);
                *(u32x2*)(a2 + (size_t)(tokbase + r * 64 + c0 + j - 2) * DFF + ch) = ow;
            }
        }
    }
}

__global__ void __launch_bounds__(NTHR, 2) fwd_mega(Params p) {
    extern __shared__ __attribute__((aligned(16))) unsigned char lds[];
    cg::grid_group grid = cg::this_grid();
    const int tid = threadIdx.x, lane = tid & 63, wave = __builtin_amdgcn_readfirstlane(tid >> 6);
    const int G = gridDim.x, gw = blockIdx.x * NWAVES + wave, NGW = G * NWAVES;
    PG8_LAS unsigned char* ldsl = (PG8_LAS unsigned char*)lds;
    unsigned char* ws = p.ws;
    const float* mx = (const float*)(ws + WS_MX);
    volatile LAS unsigned* misc = (volatile LAS unsigned*)((LAS unsigned char*)lds + MISC_OFF);
    if (tid < 16) misc[tid] = 0u;
    __syncthreads();
    const XcdBarrier xbar = xcd_barrier_post((unsigned*)(ws + WS_BAR), misc + 8);
    const unsigned long long t0_ = (PROBE_K >= 0) ? __builtin_amdgcn_s_memrealtime() : 0ull;
#define PROBE_POINT(k) do { if (PROBE_K == (k) && tid == 0) { const unsigned long long _n = __builtin_amdgcn_s_memrealtime(), _d = _n - t0_; while (__builtin_amdgcn_s_memrealtime() - _n < _d) __builtin_amdgcn_s_sleep(8); } } while (0)

    for (int rep_ = 0; rep_ < REPS(0); ++rep_) {
    phase0(p, lds, tid, lane, wave, G, 0);
    phase0(p, lds, tid, lane, wave, G, 1);
    xcd_barrier(xbar);
    if (G == 0x7fffffff) grid.sync();
    }
    for (int xs_ = 0; xs_ < EXTRA_SYNCS; ++xs_) xcd_barrier(xbar);
    PROBE_POINT(0);
    for (int rep_ = 0; rep_ < REPS(1); ++rep_) {
    if (blockIdx.x < 16 && G >= 16) {
        pg8::Gemm g{(const bf16*)(ws + WS_TCH), (const bf16*)(ws + WS_WFS), 512, 512, 512};
        pg8::StaticOrder S; S.init(4, 4, 16, blockIdx.x, 512, 512);
        pg8::Epi8<FUp> E{FUp{(bf16*)(ws + WS_WPQ), 1024}};
        pg8::gemm_phase<pg8::Epi8<FUp>, pg8::StaticOrder, true, true>(ldsl, g, S, E);
    }
    { const int skip = (G >= 32) ? 16 * NWAVES : 0, nw = NGW - skip, per = (MTOK + MCTX + nw - 1) / nw, r0 = (gw - skip) * per, nr = (gw < skip) ? 0 : min(per, MTOK + MCTX - r0);
      if (nr > 0) norm_rows<true>(p.in[0], p.in[2], MTOK, p.in[6], mx, 0, 1, (bf16*)(ws + WS_HX), nullptr, r0, nr, lane); }
    xcd_barrier(xbar);
    }
    PROBE_POINT(1);
    for (int rep_ = 0; rep_ < REPS(2); ++rep_) {
    {
        pg8::Gemm g{(const bf16*)(ws + WS_HX), (const bf16*)(ws + WS_WIN) + (size_t)512 * 1024, 1024, 1024, 1024};
        pg8::InOrder S; S.G = G; S.c = blockIdx.x; S.a_tile = (size_t)256 * 1024 * 2; S.b_tile = (size_t)256 * 1024 * 2;
        pg8::Epi8<FIn> E{FIn{ws, p.out}};
        pg8::gemm_phase<pg8::Epi8<FIn>, pg8::InOrder, true, true>(ldsl, g, S, E);
    }
    {
        pg8::Gemm g{(const bf16*)(ws + WS_WPQ), (const bf16*)(ws + WS_HX), 1024, 1024, 1024};
        pg8::StaticOrder S; S.init(4, 64, G, blockIdx.x, 1024, 1024);
        pg8::Epi8<FPQ> E{FPQ{(bf16*)(ws + WS_PQT)}};
        pg8::gemm_phase<pg8::Epi8<FPQ>, pg8::StaticOrder, true, true>(ldsl, g, S, E);
    }
    xcd_barrier(xbar);
    }
    PROBE_POINT(2);
    for (int rep_ = 0; rep_ < REPS(3); ++rep_) {
    if (blockIdx.x < 128 && G >= 192) {
        pg8::Gemm g{(const bf16*)(ws + WS_CS), (const bf16*)(ws + WS_PQT), 2048, 2048, 32768};
        pg8::DftOrder S; S.G = 128; S.c = blockIdx.x; S.a_tile = (size_t)256 * 2048 * 2; S.b_tile = (size_t)256 * 32768 * 2;
        EpiDft E{(bf16*)(ws + WS_YF), (unsigned*)(ws + WS_BAR + 16384)};
        pg8::gemm_phase<EpiDft, pg8::DftOrder, true, true>(ldsl, g, S, E);
        { int t2 = threadIdx.x; asm volatile("" : "+v"(t2));
          const int lane = t2 & 63, wave = __builtin_amdgcn_readfirstlane(t2 >> 6), gw = blockIdx.x * NWAVES + wave;
          LAS float* scr = (LAS float*)((LAS unsigned char*)lds + wave * 16384);
          constexpr int I_UP = 16 * 176, I_DN = 44 * 32;
          for (int it = gw; it < I_UP + I_DN; it += 128 * NWAVES) {
              if (it < I_UP) transpose_item(p.in[14], 1024, DFF2, (bf16*)(ws + WS_WUP), scr, it, lane);
              else transpose_item(p.in[17], DFF, 1024, (bf16*)(ws + WS_WDN), scr, it - I_UP, lane); }
          constexpr int I_A = 8 * 32, I_B = 8 * 32, I_O = 16 * 32;
          for (int it = gw; it < I_A + I_B + I_O; it += 128 * NWAVES) {
              if (it < I_A) transpose_item(p.in[10], 512, 1024, (bf16*)(ws + WS_WA), scr, it, lane);
              else if (it < I_A + I_B) transpose_item(p.in[11], 512, 1024, (bf16*)(ws + WS_WB), scr, it - I_A, lane);
              else transpose_item(p.in[12], 1024, 1024, (bf16*)(ws + WS_WOUT), scr, it - I_A - I_B, lane); } }
    } else if (G >= 192) {
        for (int it = blockIdx.x - 128; it < 128; it += G - 128) hgrn_mfma_item(p, lds, it);
    } else {
        pg8::Gemm g{(const bf16*)(ws + WS_CS), (const bf16*)(ws + WS_PQT), 2048, 2048, 32768};
        pg8::DftOrder S; S.G = G; S.c = blockIdx.x; S.a_tile = (size_t)256 * 2048 * 2; S.b_tile = (size_t)256 * 32768 * 2;
        EpiDft E{(bf16*)(ws + WS_YF), (unsigned*)(ws + WS_BAR + 16384)};
        pg8::gemm_phase<EpiDft, pg8::DftOrder, true, true>(ldsl, g, S, E);
        for (int it = blockIdx.x; it < 128; it += G) hgrn_mfma_item(p, lds, it);
    }
    xcd_barrier(xbar);
    }
    PROBE_POINT(3);
    for (int rep_ = 0; rep_ < REPS(4); ++rep_) {
    phase_yh(p, lane, gw, NGW);
    { LAS float* scr = (LAS float*)((LAS unsigned char*)lds + wave * 16384);
      constexpr int I_UP = 16 * 176, I_DN = 44 * 32;
      for (int it = (G >= 192) ? I_UP + I_DN : gw; it < I_UP + I_DN; it += NGW) {
          if (it < I_UP) transpose_item(p.in[14], 1024, DFF2, (bf16*)(ws + WS_WUP), scr, it, lane);
          else transpose_item(p.in[17], DFF, 1024, (bf16*)(ws + WS_WDN), scr, it - I_UP, lane); } }
    xcd_barrier(xbar);
    }
    PROBE_POINT(4);
    for (int rep_ = 0; rep_ < REPS(5); ++rep_) {
    {
        pg8::Gemm g{(const bf16*)(ws + WS_YF), (const bf16*)(ws + WS_WA), 512, 512, 512};
        pg8::StaticOrder S; S.init(64, 4, G, blockIdx.x, 512, 512);
        pg8::Epi8<FYa> E{FYa{(const bf16*)(ws + WS_GA), (bf16*)(ws + WS_TMP)}};
        pg8::gemm_phase<pg8::Epi8<FYa>, pg8::StaticOrder, true, true>(ldsl, g, S, E);
    }
    {
        pg8::Gemm g{(const bf16*)(ws + WS_YH), (const bf16*)(ws + WS_WB), 512, 512, 512};
        pg8::StaticOrder S; S.init(64, 4, G, blockIdx.x, 512, 512);
        pg8::Epi8<FYb> E{FYb{(const bf16*)(ws + WS_GBG), (const bf16*)(ws + WS_TMP), (bf16*)(ws + WS_MRG)}};
        pg8::gemm_phase<pg8::Epi8<FYb>, pg8::StaticOrder, true, true>(ldsl, g, S, E);
    }
    xcd_barrier(xbar);
    }
    PROBE_POINT(5);
    for (int rep_ = 0; rep_ < REPS(6); ++rep_) {
    {
        pg8::Gemm g{(const bf16*)(ws + WS_MRG), (const bf16*)(ws + WS_WOUT), 1024, 1024, 1024};
        pg8::StaticOrder S; S.init(64, 4, G, blockIdx.x, 1024, 1024);
        pg8::Epi8<FRes> E{FRes{p.in[0], p.out, mx, 2}};
        pg8::gemm_phase<pg8::Epi8<FRes>, pg8::StaticOrder, true, true>(ldsl, g, S, E);
    }
    xcd_barrier(xbar);
    }
    PROBE_POINT(6);
    for (int rep_ = 0; rep_ < REPS(7); ++rep_) {
    { const int per = (MTOK + NGW - 1) / NGW, r0 = gw * per, nr = min(per, MTOK - r0);
      if (nr > 0) norm_rows<true>(p.out, p.out, MTOK, p.in[13], mx, 3, 4, (bf16*)(ws + WS_H2), nullptr, r0, nr, lane); }
    xcd_barrier(xbar);
    }
    PROBE_POINT(7);
    {
    for (int hf = 0; hf < 2; ++hf) {
        for (int rep_ = 0; rep_ < REPS(8); ++rep_) {
            pg8::Gemm g{(const bf16*)(ws + WS_H2) + (size_t)hf * 8192 * 1024, (const bf16*)(ws + WS_WUP), 1024, 1024, 1024};
            pg8::StaticOrder S; S.init(32, 22, G, blockIdx.x, 1024, 1024);
            pg8::Epi8<FUp> E{FUp{(bf16*)(ws + WS_Z), DFF2}};
            pg8::gemm_phase<pg8::Epi8<FUp>, pg8::StaticOrder, true, true>(ldsl, g, S, E);
        xcd_barrier(xbar);
        }
        for (int rep_ = 0; rep_ < REPS(9); ++rep_) {
        phase_conv(p, hf, tid, G);
        xcd_barrier(xbar);
        }
    }
    }
    PROBE_POINT(8);
    for (int rep_ = 0; rep_ < REPS(10); ++rep_) {
    {
        pg8::Gemm g{(const bf16*)(ws + WS_A2), (const bf16*)(ws + WS_WDN), DFF, DFF, DFF};
        pg8::StaticOrder S; S.init(64, 4, G, blockIdx.x, DFF, DFF);
        pg8::Epi8<FRes> E{FRes{p.out, (float*)(ws + WS_XO), mx, 5}};
        pg8::gemm_phase<pg8::Epi8<FRes>, pg8::StaticOrder, true, true>(ldsl, g, S, E);
    }
    xcd_barrier(xbar);
    }
    PROBE_POINT(10);
    for (int rep_ = 0; rep_ < REPS(11); ++rep_) {
    { const int per = (MTOK + NGW - 1) / NGW, r0 = gw * per, nr = min(per, MTOK - r0);
      if (nr > 0) norm_rows<false>((const float*)(ws + WS_XO), (const float*)(ws + WS_XO), MTOK, p.in[18], nullptr, 0, 0, nullptr, p.out, r0, nr, lane); }
    }
}

extern "C" void kernel_launch(void* const* d_in, const int* in_sizes, int n_in, void* d_out, int out_size, void* d_ws, size_t ws_size, hipStream_t stream) {
    static int grid = 0;
    if (grid == 0) {
        if (n_in != 19 || out_size != MTOK * DM || ws_size < WS_END) { fprintf(stderr, "kernel_launch: unexpected problem: n_in %d out %d ws %zu\n", n_in, out_size, ws_size); grid = -1; return; }
        int dev = 0, cus = 0, per_cu = 0;
        hipGetDevice(&dev);
        hipDeviceGetAttribute(&cus, hipDeviceAttributeMultiprocessorCount, dev);
        if (hipFuncSetAttribute((const void*)fwd_mega, hipFuncAttributeMaxDynamicSharedMemorySize, LDS_BYTES) != hipSuccess) { fprintf(stderr, "kernel_launch: hipFuncSetAttribute failed\n"); grid = -1; return; }
        if (hipOccupancyMaxActiveBlocksPerMultiprocessor(&per_cu, (const void*)fwd_mega, NTHR, LDS_BYTES) != hipSuccess || per_cu < 1) { fprintf(stderr, "kernel_launch: occupancy query says %d\n", per_cu); per_cu = 1; }
        (void)hipGetLastError();
        grid = cus * (per_cu > 1 ? 1 : per_cu);
        fprintf(stderr, "kernel_launch: grid %d (cus %d, per_cu %d), ws %zu\n", grid, cus, per_cu, ws_size);
    }
    if (grid < 0) return;
    Params p{};
    for (int i = 0; i < 19; ++i) p.in[i] = (const float*)d_in[i];
    p.out = (float*)d_out; p.ws = (unsigned char*)d_ws;
    if (hipMemsetAsync((char*)d_ws + WS_BAR, 0, BAR_BYTES, stream) != hipSuccess) { fprintf(stderr, "kernel_launch: memset failed\n"); return; }
    void* args[] = {&p};
    hipError_t e = hipLaunchCooperativeKernel((const void*)fwd_mega, dim3(grid), dim3(NTHR), args, LDS_BYTES, stream);
    if (e != hipSuccess) fprintf(stderr, "kernel_launch: cooperative launch failed: %s (grid %d)\n", hipGetErrorString(e), grid);
}
```

```cpp
#include <hip/hip_runtime.h>
#include <hip/hip_cooperative_groups.h>
#include <cstdio>
#include <cstdint>
namespace cg = cooperative_groups;

namespace pg8 {
#define PG8_LAS __attribute__((address_space(3)))
typedef unsigned short bf16_t;
typedef short bf16x8 __attribute__((ext_vector_type(8)));
typedef float f32x4 __attribute__((ext_vector_type(4)));
typedef unsigned u32x4 __attribute__((ext_vector_type(4)));
typedef unsigned u32x2 __attribute__((ext_vector_type(2)));
constexpr int BM = 256, BK = 64, HALF = 128, HTB = HALF * BK * 2  , STAGE_BYTES = 8 * HTB, NXCD = 8, WGM = 8;

__host__ __device__ __forceinline__ int lds_byte(int r, int c) { const int st = (r >> 4) * 2 + (c >> 5), rr = r & 15, cc = c & 31, ob = rr * 64 + cc * 2; return st * 1024 + (ob ^ (((ob >> 9) & 1) << 5)); }
__host__ __device__ __forceinline__ void stage_rc(int b, int& R, int& C) { const int st = b / 1024, sb = b % 1024, swz = sb ^ (((sb >> 9) & 1) << 5); R = (st >> 1) * 16 + swz / 64; C = (st & 1) * 32 + (swz % 64) / 2; }
__host__ __device__ __forceinline__ int perm32(int rho) { const int n = rho >> 4, i = rho & 15; return 8 * (i >> 2) + 4 * n + (i & 3); }

struct Unit { int pm, pn, z; };
struct Gemm { const bf16_t* A; const bf16_t* Bt; int K, lda, ldb; };

__device__ __forceinline__ void tile_of(int wgid, int nM, int nN, int& pm, int& pn) {
    const int nwg = nM * nN;
    { const int q = nwg / NXCD, r = nwg % NXCD, xcd = wgid % NXCD, off = wgid / NXCD; wgid = (xcd < r ? xcd * (q + 1) : r * (q + 1) + (xcd - r) * q) + off; }
    const int nig = WGM * nN, gid = wgid / nig, fm = gid * WGM, gsz = (nM - fm) < WGM ? (nM - fm) : WGM;
    pm = fm + ((wgid % nig) % gsz); pn = (wgid % nig) / gsz;
}
struct StaticOrder {
    int nM, nN, nwg, G, c; size_t a_tile, b_tile;
    __device__ __forceinline__ void init(int nM_, int nN_, int G_, int c_, int lda, int ldb) { nM = nM_; nN = nN_; nwg = nM * nN; G = G_; c = c_; a_tile = (size_t)BM * lda * 2; b_tile = (size_t)BM * ldb * 2; }
    __device__ __forceinline__ bool next(int i, Unit& u) const {
        const long L = (long)i * G + c; if (L >= nwg) return false;
        tile_of((int)L, nM, nN, u.pm, u.pn); u.z = 0; return true;
    }
    __device__ __forceinline__ size_t a_off(const Unit& u) const { return (size_t)u.pm * a_tile; }
    __device__ __forceinline__ size_t b_off(const Unit& u) const { return (size_t)u.pn * b_tile; }
};
struct OneOrder {
    int L, nM, nN; size_t a_tile, b_tile;
    __device__ __forceinline__ bool next(int i, Unit& u) const { if (i > 0) return false; tile_of(L, nM, nN, u.pm, u.pn); u.z = 0; return true; }
    __device__ __forceinline__ size_t a_off(const Unit& u) const { return (size_t)u.pm * a_tile; }
    __device__ __forceinline__ size_t b_off(const Unit& u) const { return (size_t)u.pn * b_tile; }
};
struct InOrder {
    int G, c; size_t a_tile, b_tile;
    __device__ __forceinline__ bool next(int i, Unit& u) const {
        const long L = (long)i * G + c; if (L >= 1152 + 48) return false;
        if (L < 1152) { tile_of((int)L, 64, 18, u.pm, u.pn); } else { const int j = (int)L - 1152; u.pm = 64 + (j & 7); u.pn = 2 + (j >> 3); }
        u.z = 0; return true;
    }
    __device__ __forceinline__ size_t a_off(const Unit& u) const { return (size_t)u.pm * a_tile; }
    __device__ __forceinline__ size_t b_off(const Unit& u) const { return (size_t)u.pn * b_tile; }
};
struct DftOrder {
    int G, c; size_t a_tile, b_tile;
    __device__ __forceinline__ bool next(int i, Unit& u) const {
        const long L = (long)i * G + c; if (L >= 128) return false;
        const int eo = (L < 64) ? 1 : 0, q = (int)L & 63;
        u.pn = q & 1; u.pm = (q >> 1) & 3; u.z = (q >> 3) | (eo << 8); return true;
    }
    __device__ __forceinline__ size_t a_off(const Unit& u) const { return (size_t)((u.z >> 8) * 4 + u.pm) * a_tile; }
    __device__ __forceinline__ size_t b_off(const Unit& u) const { return (size_t)u.pn * b_tile + ((size_t)(u.z & 255) * 4096 + (size_t)(u.z >> 8) * 2048) * 2; }
};

__device__ __forceinline__ unsigned cvt_pk_bf16(float lo, float hi) { unsigned r; asm volatile("v_cvt_pk_bf16_f32 %0, %1, %2" : "=v"(r) : "v"(lo), "v"(hi)); return r; }

template <class F> struct Epi8 {
    static constexpr bool PERM = true;
    F f;
    __device__ __forceinline__ void inplace(f32x4 (&acc)[2][2][4][2], const Unit& u, int wr, int wc, int fr, int fq) const {
        const int row0 = u.pm * BM + wr * 64 + fr, col0 = u.pn * BM + wc * 32 + 8 * fq;
#pragma unroll
        for (int ai = 0; ai < 2; ++ai)
#pragma unroll
            for (int m = 0; m < 4; ++m) {
#pragma unroll
                for (int bj = 0; bj < 2; ++bj) f.scale(u, row0 + ai * HALF + m * 16, col0 + bj * HALF, acc[ai][bj][m][0], acc[ai][bj][m][1]);
                asm volatile("" ::: "memory");
            }
    }
    __device__ __forceinline__ void operator()(const f32x4 (&acc)[2][2][4][2], const Unit& u, int wr, int wc, int fr, int fq) const {
        const int row0 = u.pm * BM + wr * 64 + fr, col0 = u.pn * BM + wc * 32 + 8 * fq;
#pragma unroll
        for (int ai = 0; ai < 2; ++ai)
#pragma unroll
            for (int m = 0; m < 4; ++m) {
#pragma unroll
                for (int bj = 0; bj < 2; ++bj) f(u, row0 + ai * HALF + m * 16, col0 + bj * HALF, acc[ai][bj][m][0], acc[ai][bj][m][1]);
                asm volatile("" ::: "memory");
            }
    }
};

template <class Epi, class Sched, bool ALIGN_EPI = false, bool SP2 = false, int EXTACC = 0>
__device__ __forceinline__ void gemm_phase(PG8_LAS unsigned char* lds, const Gemm g, const Sched& S, const Epi& E, f32x4 (*accx)[2][4][2] = nullptr) {
    int tid_ = threadIdx.x; asm volatile("" : "+v"(tid_));
    const int tid = tid_, wid = __builtin_amdgcn_readfirstlane(tid >> 6), lane = tid & 63, wr = wid >> 2, wc = wid & 3, fr = lane & 15, fq = lane >> 4;
    const int K = g.K, nt = K / BK;
    unsigned voffA[2], voffB[2];
#pragma unroll
    for (int i = 0; i < 2; ++i) { int R, C; stage_rc(tid * 16 + i * 8192, R, C); const int Rb = Epi::PERM ? ((R & ~31) + perm32(R & 31)) : R;
        voffA[i] = (unsigned)(R * g.lda + C) * 2u; voffB[i] = (unsigned)(Rb * g.ldb + C) * 2u; }
    const size_t kstep = (size_t)(BK * 2);
    const size_t hstepA = (size_t)HALF * g.lda * 2, hstepB = (size_t)HALF * g.ldb * 2;
    const unsigned ldsw = (unsigned)wid * 1024u;
    const int aoff = lds_byte(wr * 64 + fr, fq * 8), boff = lds_byte(wc * 32 + fr, fq * 8);
#define PG8_SA(b, h) (((b) * 2 + (h)) * HTB)
#define PG8_SB(b, h) ((4 + (b) * 2 + (h)) * HTB)
#define PG8_STAGE(bufoff, gbase, voff) do { _Pragma("unroll") for (int _i = 0; _i < 2; ++_i) \
        __builtin_amdgcn_global_load_lds((const unsigned*)((const char*)(gbase) + (voff)[_i]), (PG8_LAS unsigned*)(lds + (bufoff) + ldsw + _i * 8192), 16, 0, 0); } while (0)
#define PG8_LDA(dst, b, h) do { _Pragma("unroll") for (int m = 0; m < 4; ++m) _Pragma("unroll") for (int k = 0; k < 2; ++k) dst[m][k] = *(const PG8_LAS bf16x8*)(lds + PG8_SA(b, h) + aoff + m * 2048 + k * 1024); } while (0)
#define PG8_LDB(dst, b, h) do { _Pragma("unroll") for (int n = 0; n < 2; ++n) _Pragma("unroll") for (int k = 0; k < 2; ++k) dst[n][k] = *(const PG8_LAS bf16x8*)(lds + PG8_SB(b, h) + boff + n * 2048 + k * 1024); } while (0)
#define PG8_MMA(ai, bj, At, Bt) do { __builtin_amdgcn_s_setprio(1); _Pragma("unroll") for (int m = 0; m < 4; ++m) _Pragma("unroll") for (int n = 0; n < 2; ++n) _Pragma("unroll") for (int k = 0; k < 2; ++k) \
        acc[ai][bj][m][n] = __builtin_amdgcn_mfma_f32_16x16x32_bf16(Bt[n][k], At[m][k], acc[ai][bj][m][n], 0, 0, 0); __builtin_amdgcn_s_setprio(0); } while (0)
#define PG8_WAIT_V(n) asm volatile("s_waitcnt vmcnt(" #n ")" ::: "memory")
#define PG8_WAIT_L(n) asm volatile("s_waitcnt lgkmcnt(" #n ")" ::: "memory")
#define PG8_BAR __builtin_amdgcn_s_barrier()
#define PG8_SCHED __builtin_amdgcn_sched_barrier(0)
    Unit cur, nxt; int ui = 0;
    if (!S.next(0, cur)) return;
    f32x4 accl[2][2][4][2];
    f32x4 (&acc)[2][2][4][2] = *(EXTACC ? (f32x4 (*)[2][2][4][2])accx : &accl);
    if constexpr (EXTACC != 2) {
#pragma unroll
    for (int a = 0; a < 2; ++a)
#pragma unroll
        for (int b = 0; b < 2; ++b)
#pragma unroll
            for (int m = 0; m < 4; ++m)
#pragma unroll
                for (int n = 0; n < 2; ++n) acc[a][b][m][n] = (f32x4){0.f, 0.f, 0.f, 0.f};
    }
    bf16x8 At[4][2], B0[2][2], B1[2][2];
    const char* cA = (const char*)g.A + S.a_off(cur); const char* cB = (const char*)g.Bt + S.b_off(cur);
    if constexpr (SP2) {
        PG8_STAGE(PG8_SB(0, 0), cB, voffB); PG8_STAGE(PG8_SB(0, 1), cB + hstepB, voffB); PG8_STAGE(PG8_SA(0, 0), cA, voffA); PG8_STAGE(PG8_SA(0, 1), cA + hstepA, voffA);
        if (wr == 1) PG8_BAR;
        PG8_WAIT_V(2); PG8_BAR;
        PG8_STAGE(PG8_SB(1, 0), cB + kstep, voffB); PG8_STAGE(PG8_SA(1, 0), cA + kstep, voffA); PG8_STAGE(PG8_SB(1, 1), cB + hstepB + kstep, voffB);
        PG8_WAIT_V(6); PG8_BAR;
    } else {
        PG8_STAGE(PG8_SB(0, 0), cB, voffB); PG8_STAGE(PG8_SA(0, 0), cA, voffA); PG8_STAGE(PG8_SB(0, 1), cB + hstepB, voffB); PG8_STAGE(PG8_SA(0, 1), cA + hstepA, voffA);
        if (wr == 1) PG8_BAR;
        PG8_WAIT_V(4); PG8_BAR;
        PG8_STAGE(PG8_SB(1, 0), cB + kstep, voffB); PG8_STAGE(PG8_SA(1, 0), cA + kstep, voffA); PG8_STAGE(PG8_SB(1, 1), cB + hstepB + kstep, voffB);
        PG8_WAIT_V(6); PG8_BAR;
    }
    for (;;) {
        const bool has_next = S.next(ui + 1, nxt);
        const char* nA = has_next ? (const char*)g.A + S.a_off(nxt) : cA; const char* nB = has_next ? (const char*)g.Bt + S.b_off(nxt) : cB;
        for (int t = 0; t < nt; t += 2) {
            const bool last = (t == nt - 2);
            const char* a1 = cA + (size_t)(t + 1) * kstep;
            const char* a2 = last ? nA : cA + (size_t)(t + 2) * kstep; const char* b2 = last ? nB : cB + (size_t)(t + 2) * kstep;
            const char* a3 = a2 + kstep; const char* b3 = b2 + kstep;
            if constexpr (SP2) {
            PG8_LDB(B0, 0, 0); PG8_LDB(B1, 0, 1); PG8_SCHED; PG8_LDA(At, 0, 0); PG8_STAGE(PG8_SA(1, 1), a1 + hstepA, voffA);
            PG8_WAIT_V(8); PG8_WAIT_L(0); PG8_BAR; PG8_MMA(0, 0, At, B0); PG8_MMA(0, 1, At, B1); PG8_BAR; PG8_SCHED;
            PG8_LDA(At, 0, 1); PG8_STAGE(PG8_SB(0, 0), b2, voffB); PG8_STAGE(PG8_SB(0, 1), b2 + hstepB, voffB); PG8_STAGE(PG8_SA(0, 0), a2, voffA);
            PG8_WAIT_V(8); PG8_WAIT_L(0); PG8_BAR; PG8_MMA(1, 0, At, B0); PG8_MMA(1, 1, At, B1); PG8_BAR; PG8_SCHED;
            PG8_LDB(B0, 1, 0); PG8_LDB(B1, 1, 1); PG8_SCHED; PG8_LDA(At, 1, 0); PG8_STAGE(PG8_SA(0, 1), a2 + hstepA, voffA);
            PG8_WAIT_V(8); PG8_WAIT_L(0); PG8_BAR; PG8_MMA(0, 0, At, B0); PG8_MMA(0, 1, At, B1); PG8_BAR; PG8_SCHED;
            PG8_LDA(At, 1, 1); PG8_STAGE(PG8_SB(1, 0), b3, voffB); PG8_STAGE(PG8_SB(1, 1), b3 + hstepB, voffB); PG8_STAGE(PG8_SA(1, 0), a3, voffA);
            PG8_WAIT_V(8); PG8_WAIT_L(0); PG8_BAR; PG8_MMA(1, 0, At, B0); PG8_MMA(1, 1, At, B1); PG8_BAR; PG8_SCHED;
            } else {
            PG8_LDB(B0, 0, 0); PG8_SCHED; PG8_LDA(At, 0, 0); PG8_STAGE(PG8_SA(1, 1), a1 + hstepA, voffA);
            PG8_WAIT_L(8); PG8_BAR; PG8_WAIT_L(0); PG8_MMA(0, 0, At, B0); PG8_BAR; PG8_SCHED;
            PG8_LDB(B1, 0, 1); PG8_STAGE(PG8_SB(0, 0), b2, voffB);
            PG8_BAR; PG8_WAIT_L(0); PG8_MMA(0, 1, At, B1); PG8_BAR;
            PG8_LDA(At, 0, 1); PG8_STAGE(PG8_SA(0, 0), a2, voffA);
            PG8_BAR; PG8_WAIT_L(0); PG8_MMA(1, 0, At, B0); PG8_BAR; PG8_SCHED;
            PG8_STAGE(PG8_SB(0, 1), b2 + hstepB, voffB);
            PG8_WAIT_V(6); PG8_BAR; PG8_MMA(1, 1, At, B1); PG8_BAR;
            PG8_LDB(B0, 1, 0); PG8_SCHED; PG8_LDA(At, 1, 0); PG8_STAGE(PG8_SA(0, 1), a2 + hstepA, voffA);
            PG8_WAIT_L(8); PG8_BAR; PG8_WAIT_L(0); PG8_MMA(0, 0, At, B0); PG8_BAR; PG8_SCHED;
            PG8_LDB(B1, 1, 1); PG8_STAGE(PG8_SB(1, 0), b3, voffB);
            PG8_BAR; PG8_WAIT_L(0); PG8_MMA(0, 1, At, B1); PG8_BAR;
            PG8_LDA(At, 1, 1); PG8_STAGE(PG8_SA(1, 0), a3, voffA);
            PG8_BAR; PG8_WAIT_L(0); PG8_MMA(1, 0, At, B0); PG8_BAR; PG8_SCHED;
            PG8_STAGE(PG8_SB(1, 1), b3 + hstepB, voffB);
            PG8_WAIT_V(6); PG8_BAR; PG8_MMA(1, 1, At, B1); PG8_BAR;
            }
        }
        if constexpr (ALIGN_EPI) { if (wr == 0) PG8_BAR; }
        if constexpr (EXTACC == 1) E.inplace(acc, cur, wr, wc, fr, fq); else E(acc, cur, wr, wc, fr, fq);
        if (!has_next || EXTACC != 0) break;
#pragma unroll
        for (int a = 0; a < 2; ++a)
#pragma unroll
            for (int b = 0; b < 2; ++b)
#pragma unroll
                for (int m = 0; m < 4; ++m)
#pragma unroll
                    for (int n = 0; n < 2; ++n) acc[a][b][m][n] = (f32x4){0.f, 0.f, 0.f, 0.f};
        cur = nxt; cA = nA; cB = nB; ++ui;
        if constexpr (ALIGN_EPI) { if (wr == 1) PG8_BAR; }
    }
    PG8_WAIT_V(0);
    if constexpr (!ALIGN_EPI) { if (wr == 0) PG8_BAR; }
    PG8_BAR;
#undef PG8_SA
#undef PG8_SB
#undef PG8_STAGE
#undef PG8_LDA
#undef PG8_LDB
#undef PG8_MMA
#undef PG8_WAIT_V
#undef PG8_WAIT_L
#undef PG8_BAR
#undef PG8_SCHED
}
}

constexpr int DM = 1024, NB = 8, SEQ = 2048, MTOK = NB * SEQ, CTXL = 256, MCTX = NB * CTXL;
constexpr int HGD = 512, DFF = 2816, DFF2 = 5632, INDIM = 5120, NMOD = 6;
constexpr float EPSN = 1e-6f;
constexpr int NWAVES = 8, NTHR = 512;
constexpr int LDS_BYTES = 147456;
#ifndef DUP_MASK
#define DUP_MASK 0
#endif
#define REPS(k) ((((DUP_MASK) >> (k)) & 1) ? 2 : 1)
#ifndef PROBE_K
#define PROBE_K -1
#endif
#ifndef EXTRA_SYNCS
#define EXTRA_SYNCS 0
#endif

constexpr size_t MiB = 1u << 20;
constexpr size_t WS_MX = 0;
constexpr size_t WS_LB = 256 * 1024;
constexpr size_t WS_WFS = 2 * MiB, WS_TCH = 3 * MiB;
constexpr size_t WS_BAR = 512 * 1024, BAR_BYTES = 32768;
constexpr int MISC_OFF = 147456 - 128;
constexpr size_t WS_WIN = 6 * MiB;
constexpr size_t WS_WPQ = 16 * MiB;
constexpr size_t WS_WA = 18 * MiB, WS_WB = 19 * MiB, WS_WOUT = 20 * MiB;
constexpr size_t WS_CS = 22 * MiB;
constexpr size_t WS_WUP = 6 * MiB;
constexpr size_t WS_WDN = 250 * MiB;
constexpr size_t WS_HX = 38 * MiB;
constexpr size_t WS_OF = 38 * MiB, WS_OB = 54 * MiB;
constexpr size_t WS_TMP = 38 * MiB;
constexpr size_t WS_H2 = 38 * MiB;
constexpr size_t WS_Q = 74 * MiB, WS_V = 90 * MiB, WS_OG = 106 * MiB, WS_GA = 122 * MiB, WS_GBG = 154 * MiB, WS_PQT = 186 * MiB;
constexpr size_t WS_GFC = 218 * MiB, WS_GBC = 222 * MiB, WS_VC = 226 * MiB;
constexpr size_t WS_YF = 228 * MiB;
constexpr size_t WS_YH = 74 * MiB;
constexpr size_t WS_MRG = 186 * MiB;
constexpr size_t WS_Z = 74 * MiB;
constexpr size_t WS_A2 = 162 * MiB;
constexpr size_t WS_XO = 38 * MiB;
constexpr size_t WS_END = 256 * MiB;

typedef unsigned short bf16;
typedef float f32x4 __attribute__((ext_vector_type(4)));
typedef unsigned u32x4 __attribute__((ext_vector_type(4)));
typedef unsigned u32x2 __attribute__((ext_vector_type(2)));
typedef float f32x2 __attribute__((ext_vector_type(2)));
#define LAS __attribute__((address_space(3)))

struct Params {
    const float* in[19];
    float* out;
    unsigned char* ws;
};

__device__ __forceinline__ float bf2f(unsigned short b) { return __uint_as_float(((unsigned)b) << 16); }
__device__ __forceinline__ float bflo(unsigned w) { return __uint_as_float(w << 16); }
__device__ __forceinline__ float bfhi(unsigned w) { return __uint_as_float(w & 0xffff0000u); }
__device__ __forceinline__ unsigned f2bf(float f) { unsigned u = __float_as_uint(f); return (u + 0x7fffu + ((u >> 16) & 1u)) >> 16; }
__device__ __forceinline__ unsigned pk2(float lo, float hi);
typedef __bf16 bf16x2_t __attribute__((ext_vector_type(2)));
__device__ __forceinline__ unsigned hwpk2(float lo, float hi) { const f32x2 v = {lo, hi}; const bf16x2_t r = __builtin_convertvector(v, bf16x2_t); return __builtin_bit_cast(unsigned, r); }
__device__ __forceinline__ unsigned pk2(float lo, float hi) { return hwpk2(lo, hi); }
__device__ __forceinline__ float sigmoidf_(float x) { return __builtin_amdgcn_rcpf(1.f + __expf(-x)); }
__device__ __forceinline__ float siluf_(float x) { return x * __builtin_amdgcn_rcpf(1.f + __expf(-x)); }
__device__ __forceinline__ float wave_sum(float v) {
#pragma unroll
    for (int o = 1; o < 64; o <<= 1) v += __shfl_xor(v, o);
    return v;
}
__device__ __forceinline__ u32x4 pack8(const f32x4 a, const f32x4 b) { u32x4 w; w.x = pk2(a[0], a[1]); w.y = pk2(a[2], a[3]); w.z = pk2(b[0], b[1]); w.w = pk2(b[2], b[3]); return w; }

typedef __attribute__((address_space(1))) unsigned gu32;
#define XB_TMO      128
#define XB_XCNT(j)  (256  + 64 * (j))
#define XB_XSUB(j)  (1280 + 64 * (j))
#define XB_XGEN(j)  (2304 + 64 * (j))
#define XB_TOP      3328
#define XB_TOPGEN   3392
#define XCD_BAR_WORDS 3456
#define XB_SPIN_CAP (1u << 18)

__device__ __forceinline__ unsigned xb_ld(unsigned* p)              { return __hip_atomic_load(p, __ATOMIC_RELAXED, __HIP_MEMORY_SCOPE_AGENT); }
__device__ __forceinline__ unsigned xb_add(unsigned* p, unsigned v) { return __hip_atomic_fetch_add(p, v, __ATOMIC_RELAXED, __HIP_MEMORY_SCOPE_AGENT); }
__device__ __forceinline__ unsigned xb_xcc_id() { return (unsigned)__builtin_amdgcn_s_getreg((3 << 11) | 20) & 0xFu; }
#define XB_SPIN(cond, bar) do { unsigned _sp = 0; while (cond) { __builtin_amdgcn_s_sleep(1); \
    if ((++_sp & 255u) == 0u) { if (xb_ld(&(bar)[XB_TMO])) break; if (_sp > XB_SPIN_CAP) { atomicAdd(&(bar)[XB_TMO], 1u); break; } } } } while (0)

struct XcdBarrier {
    unsigned* bar; unsigned x;
    volatile LAS unsigned* st;
};

__device__ __forceinline__ XcdBarrier xcd_barrier_post(unsigned* bar, volatile LAS unsigned* st) {
    XcdBarrier b; b.bar = bar; b.x = xb_xcc_id(); b.st = st;
    if (threadIdx.x == 0) (void)xb_add(&bar[XB_XCNT(b.x)], 1u);
    return b;
}
__device__ __forceinline__ void xcd_barrier_complete(unsigned* bar, unsigned x, unsigned& nloc, unsigned& nx) {
    const unsigned G = gridDim.x * gridDim.y * gridDim.z;
    unsigned sum, cnt, mine, sp = 0u;
    for (;;) {
        sum = 0u; cnt = 0u; mine = 0u;
#pragma unroll
        for (unsigned j = 0; j < 16; ++j) { const unsigned c = xb_ld(&bar[XB_XCNT(j)]); sum += c; cnt += (c > 0u) ? 1u : 0u; mine = (j == x) ? c : mine; }
        if (sum == G) break;
        __builtin_amdgcn_s_sleep(1);
        if ((++sp & 255u) == 0u) { if (xb_ld(&bar[XB_TMO])) break; if (sp > XB_SPIN_CAP) { atomicAdd(&bar[XB_TMO], 1u); break; } }
    }
    nloc = mine > 0u ? mine : 1u; nx = cnt > 0u ? cnt : 1u;
}

__device__ __forceinline__ void xcd_barrier(const XcdBarrier& b) {
    asm volatile("s_waitcnt vmcnt(0)" ::: "memory");
    __syncthreads();
    if (threadIdx.x == 0) {
        unsigned* bar = b.bar;
        __builtin_amdgcn_s_waitcnt(0);
        unsigned nloc = b.st[0], nx = b.st[1];
        if (nloc == 0u) { xcd_barrier_complete(bar, b.x, nloc, nx); b.st[0] = nloc; b.st[1] = nx; }
        const unsigned old = xb_add(&bar[XB_XSUB(b.x)], 1u);
        const unsigned gen = old / nloc;
        if (old + 1u == (gen + 1u) * nloc) {
            __builtin_amdgcn_fence(__ATOMIC_RELEASE, "agent");
            asm volatile("s_waitcnt vmcnt(0)" ::: "memory");
            const unsigned og = xb_add(&bar[XB_TOP], 1u);
            const unsigned tg = og / nx;
            if (og + 1u == (tg + 1u) * nx) xb_add(&bar[XB_TOPGEN], 1u);
            else XB_SPIN(xb_ld(&bar[XB_TOPGEN]) == tg, bar);
            __builtin_amdgcn_fence(__ATOMIC_ACQUIRE, "agent");
            xb_add(&bar[XB_XGEN(b.x)], 1u);
            asm volatile("s_waitcnt vmcnt(0)" ::: "memory");
        } else {
            XB_SPIN(xb_ld(&bar[XB_XGEN(b.x)]) == gen, bar);
            __builtin_amdgcn_fence(__ATOMIC_ACQUIRE, "agent");
            asm volatile("s_waitcnt vmcnt(0)" ::: "memory");
        }
    }
    __syncthreads();
}


struct FIn {
    unsigned char* ws; float* out;
    __device__ __forceinline__ void operator()(const pg8::Unit& u, int row, int col, f32x4 v0, f32x4 v1) const {
        const int seg = u.pn >> 1, c = col & 511;
        if (seg == 0 || seg == 4) { f32x4 a, b;
#pragma unroll
            for (int i = 0; i < 4; ++i) { a[i] = siluf_(v0[i]); b[i] = siluf_(v1[i]); }
            bf16* dst = (bf16*)(ws + (seg == 0 ? WS_Q : WS_OG));
            *(u32x4*)(dst + (size_t)row * 512 + c) = pack8(a, b);
        } else if (seg == 1 || seg == 2) {
            const float* lb = (const float*)(ws + WS_LB);
            const f32x4 l0 = *(const f32x4*)(lb + c), l1 = *(const f32x4*)(lb + c + 4); f32x4 a, b;
#pragma unroll
            for (int i = 0; i < 4; ++i) { a[i] = l0[i] + (1.f - l0[i]) * sigmoidf_(v0[i]); b[i] = l1[i] + (1.f - l1[i]) * sigmoidf_(v1[i]); }
            float* dst;
            if (u.pm < 64) dst = out + (seg == 1 ? (size_t)0 : (size_t)MTOK * 512) + (size_t)row * 512 + c;
            else dst = (float*)(ws + (seg == 1 ? WS_GFC : WS_GBC)) + (size_t)(row - MTOK) * 512 + c;
            *(f32x4*)dst = a; *(f32x4*)(dst + 4) = b;
        } else if (seg == 3) {
            bf16* dst;
            if (u.pm < 64) dst = (bf16*)(ws + WS_V) + (size_t)row * 512 + c; else dst = (bf16*)(ws + WS_VC) + (size_t)(row - MTOK) * 512 + c;
            *(u32x4*)dst = pack8(v0, v1);
        } else { f32x4 a, b;
#pragma unroll
            for (int i = 0; i < 4; ++i) { a[i] = sigmoidf_(v0[i]); b[i] = sigmoidf_(v1[i]); }
            bf16* dst = (seg < 7) ? ((bf16*)(ws + WS_GA) + (size_t)row * 1024 + (col - 5 * 512)) : ((bf16*)(ws + WS_GBG) + (size_t)row * 1024 + (col - 7 * 512));
            *(u32x4*)dst = pack8(a, b);
        }
    }
};
struct FPQ {
    bf16* pqt;
    __device__ __forceinline__ void operator()(const pg8::Unit&, int row, int col, f32x4 v0, f32x4 v1) const {
        bf16* dst = pqt + (size_t)(row & 511) * 32768 + (size_t)(col >> 11) * 4096 + (size_t)(row >> 9) * 1024 + ((col & 2047) >> 1);
        u32x2 ev, od; ev.x = pk2(v0[0], v0[2]); ev.y = pk2(v1[0], v1[2]); od.x = pk2(v0[1], v0[3]); od.y = pk2(v1[1], v1[3]);
        *(u32x2*)dst = ev; *(u32x2*)(dst + 2048) = od;
    }
};
struct EpiDft {
    static constexpr bool PERM = true;
    bf16* yf; unsigned* flags;
    __device__ __forceinline__ void operator()(const f32x4 (&acc)[2][2][4][2], const pg8::Unit& u, int wr, int wc, int fr, int fq) const {
        const int z = u.z & 255, eo = u.z >> 8, pair = (z * 4 + u.pm) * 2 + u.pn;
        const int row0 = u.pm * 256 + wr * 64 + fr, col0 = u.pn * 256 + wc * 32 + 8 * fq;
        unsigned* flag = flags + pair * 16;
        if (eo) {
#pragma unroll
            for (int ai = 0; ai < 2; ++ai)
#pragma unroll
                for (int m = 0; m < 4; ++m)
#pragma unroll
                    for (int bj = 0; bj < 2; ++bj) { const int row = row0 + ai * 128 + m * 16, col = col0 + bj * 128;
                        *(u32x4*)(yf + ((size_t)z * SEQ + 1024 + row) * 512 + col) = pack8(acc[ai][bj][m][0] * (1.f / 512.f), acc[ai][bj][m][1] * (1.f / 512.f)); }
            asm volatile("s_waitcnt vmcnt(0)" ::: "memory");
            __syncthreads();
            if (threadIdx.x == 0) { __builtin_amdgcn_fence(__ATOMIC_RELEASE, "agent"); asm volatile("s_waitcnt vmcnt(0)" ::: "memory");
                __hip_atomic_store(flag, 1u, __ATOMIC_RELAXED, __HIP_MEMORY_SCOPE_AGENT); }
        } else {
            if (threadIdx.x == 0) { unsigned spins = 0;
                while (__hip_atomic_load(flag, __ATOMIC_RELAXED, __HIP_MEMORY_SCOPE_AGENT) == 0u && ++spins < (1u << 22)) __builtin_amdgcn_s_sleep(2);
                __builtin_amdgcn_fence(__ATOMIC_ACQUIRE, "agent"); asm volatile("s_waitcnt vmcnt(0)" ::: "memory"); }
            __syncthreads();
#pragma unroll
            for (int ai = 0; ai < 2; ++ai)
#pragma unroll
                for (int m = 0; m < 4; ++m) {
#pragma unroll
                    for (int bj = 0; bj < 2; ++bj) { const int row = row0 + ai * 128 + m * 16, col = col0 + bj * 128;
                        bf16* plo = yf + ((size_t)z * SEQ + row) * 512 + col; bf16* phi = plo + (size_t)1024 * 512;
                        const u32x4 o = *(const u32x4*)phi;
                        const f32x4 e0 = acc[ai][bj][m][0] * (1.f / 512.f), e1 = acc[ai][bj][m][1] * (1.f / 512.f);
                        f32x4 o0, o1; o0[0] = bflo(o.x); o0[1] = bfhi(o.x); o0[2] = bflo(o.y); o0[3] = bfhi(o.y); o1[0] = bflo(o.z); o1[1] = bfhi(o.z); o1[2] = bflo(o.w); o1[3] = bfhi(o.w);
                        *(u32x4*)plo = pack8(e0 + o0, e1 + o1); *(u32x4*)phi = pack8(e0 - o0, e1 - o1); }
                    asm volatile("" ::: "memory"); }
        }
    }
};
struct FYa {
    const bf16* ga;
    __device__ __forceinline__ void scale(const pg8::Unit&, int row, int col, f32x4& v0, f32x4& v1) const {
        const size_t o = (size_t)row * 1024 + col; const u32x4 g = *(const u32x4*)(ga + o);
        v0[0] *= bflo(g.x); v0[1] *= bfhi(g.x); v0[2] *= bflo(g.y); v0[3] *= bfhi(g.y); v1[0] *= bflo(g.z); v1[1] *= bfhi(g.z); v1[2] *= bflo(g.w); v1[3] *= bfhi(g.w);
    }
    __device__ __forceinline__ void operator()(const pg8::Unit&, int, int, f32x4, f32x4) const {}
};
struct FYb {
    const bf16* gbg; bf16* mrg;
    __device__ __forceinline__ void scale(const pg8::Unit&, int row, int col, f32x4& v0, f32x4& v1) const {
        const size_t o = (size_t)row * 1024 + col; const u32x4 h = *(const u32x4*)(gbg + o);
        v0[0] *= __builtin_amdgcn_rcpf(bflo(h.x)); v0[1] *= __builtin_amdgcn_rcpf(bfhi(h.x)); v0[2] *= __builtin_amdgcn_rcpf(bflo(h.y)); v0[3] *= __builtin_amdgcn_rcpf(bfhi(h.y));
        v1[0] *= __builtin_amdgcn_rcpf(bflo(h.z)); v1[1] *= __builtin_amdgcn_rcpf(bfhi(h.z)); v1[2] *= __builtin_amdgcn_rcpf(bflo(h.w)); v1[3] *= __builtin_amdgcn_rcpf(bfhi(h.w));
    }
    __device__ __forceinline__ void operator()(const pg8::Unit&, int row, int col, f32x4 v0, f32x4 v1) const {
        const size_t o = (size_t)row * 1024 + col; const u32x4 h = *(const u32x4*)(gbg + o);
        f32x4 a, b; a[0] = v0[0] * bflo(h.x); a[1] = v0[1] * bfhi(h.x); a[2] = v0[2] * bflo(h.y); a[3] = v0[3] * bfhi(h.y);
        b[0] = v1[0] * bflo(h.z); b[1] = v1[1] * bfhi(h.z); b[2] = v1[2] * bflo(h.w); b[3] = v1[3] * bfhi(h.w);
        *(u32x4*)(mrg + o) = pack8(a, b);
    }
};
struct FYab {
    const bf16* ga; const bf16* gbg;
    __device__ __forceinline__ void scale(const pg8::Unit&, int row, int col, f32x4& v0, f32x4& v1) const {
        const size_t o = (size_t)row * 1024 + col; const u32x4 g = *(const u32x4*)(ga + o), h = *(const u32x4*)(gbg + o);
        v0[0] *= bflo(g.x) * __builtin_amdgcn_rcpf(bflo(h.x)); v0[1] *= bfhi(g.x) * __builtin_amdgcn_rcpf(bfhi(h.x)); v0[2] *= bflo(g.y) * __builtin_amdgcn_rcpf(bflo(h.y)); v0[3] *= bfhi(g.y) * __builtin_amdgcn_rcpf(bfhi(h.y));
        v1[0] *= bflo(g.z) * __builtin_amdgcn_rcpf(bflo(h.z)); v1[1] *= bfhi(g.z) * __builtin_amdgcn_rcpf(bfhi(h.z)); v1[2] *= bflo(g.w) * __builtin_amdgcn_rcpf(bflo(h.w)); v1[3] *= bfhi(g.w) * __builtin_amdgcn_rcpf(bfhi(h.w));
    }
    __device__ __forceinline__ void operator()(const pg8::Unit&, int, int, f32x4, f32x4) const {}
};
struct FYaT {
    const bf16* ga; bf16* tmp;
    __device__ __forceinline__ void operator()(const pg8::Unit&, int row, int col, f32x4 v0, f32x4 v1) const {
        const size_t o = (size_t)row * 1024 + col; const u32x4 g = *(const u32x4*)(ga + o);
        f32x4 a, b; a[0] = v0[0] * bflo(g.x); a[1] = v0[1] * bfhi(g.x); a[2] = v0[2] * bflo(g.y); a[3] = v0[3] * bfhi(g.y);
        b[0] = v1[0] * bflo(g.z); b[1] = v1[1] * bfhi(g.z); b[2] = v1[2] * bflo(g.w); b[3] = v1[3] * bfhi(g.w);
        *(u32x4*)(tmp + o) = pack8(a, b);
    }
};
struct FYbT {
    const bf16* gbg; const bf16* tmp; bf16* mrg;
    __device__ __forceinline__ void operator()(const pg8::Unit&, int row, int col, f32x4 v0, f32x4 v1) const {
        const size_t o = (size_t)row * 1024 + col; const u32x4 g = *(const u32x4*)(gbg + o); const u32x4 t = *(const u32x4*)(tmp + o);
        f32x4 a, b; a[0] = bflo(t.x) + v0[0] * bflo(g.x); a[1] = bfhi(t.x) + v0[1] * bfhi(g.x); a[2] = bflo(t.y) + v0[2] * bflo(g.y); a[3] = bfhi(t.y) + v0[3] * bfhi(g.y);
        b[0] = bflo(t.z) + v1[0] * bflo(g.z); b[1] = bfhi(t.z) + v1[1] * bfhi(g.z); b[2] = bflo(t.w) + v1[2] * bflo(g.w); b[3] = bfhi(t.w) + v1[3] * bfhi(g.w);
        *(u32x4*)(mrg + o) = pack8(a, b);
    }
};
struct FRes {
    const float* src; float* dst; const float* mx; int mod;
    __device__ __forceinline__ void operator()(const pg8::Unit&, int row, int col, f32x4 v0, f32x4 v1) const {
        const size_t o = (size_t)row * 1024 + col; const float* m = mx + (size_t)(row >> 11) * (NMOD * DM) + mod * DM + col;
        const f32x4 m0 = *(const f32x4*)m, m1 = *(const f32x4*)(m + 4), s0 = *(const f32x4*)(src + o), s1 = *(const f32x4*)(src + o + 4);
        *(f32x4*)(dst + o) = s0 + m0 * v0; *(f32x4*)(dst + o + 4) = s1 + m1 * v1;
    }
};
struct FUp {
    bf16* z; int ld;
    __device__ __forceinline__ void operator()(const pg8::Unit&, int row, int col, f32x4 v0, f32x4 v1) const {
        *(u32x4*)(z + (size_t)row * ld + col) = pack8(v0, v1);
    }
};

__device__ __forceinline__ void transpose_item(const float* W, int K, int N, bf16* WT, LAS float* scr, int item, int lane) {
    const int nblk = N / 32, kb = item / nblk, nb = item % nblk, k0 = 64 * kb, n0 = 32 * nb;
#pragma unroll 8
    for (int i = 0; i < 32; ++i) { const int kk = 2 * i + (lane >> 5); scr[kk * 33 + (lane & 31)] = W[(size_t)(k0 + kk) * N + n0 + (lane & 31)]; }
    asm volatile("s_waitcnt lgkmcnt(0)" ::: "memory");
    const int c = lane & 7;
#pragma unroll
    for (int j = 0; j < 4; ++j) { const int n = (lane >> 3) + 8 * j; const LAS float* s = scr + (8 * c) * 33 + n;
        u32x4 o; o.x = pk2(s[0 * 33], s[1 * 33]); o.y = pk2(s[2 * 33], s[3 * 33]); o.z = pk2(s[4 * 33], s[5 * 33]); o.w = pk2(s[6 * 33], s[7 * 33]);
        *(u32x4*)(WT + (size_t)(n0 + n) * K + k0 + 8 * c) = o; }
    asm volatile("s_waitcnt lgkmcnt(0)" ::: "memory");
}

template <bool MOD>
__device__ __forceinline__ void norm_rows(const float* srcA, const float* srcB, int nA, const float* g, const float* mx, int shift_mod, int scale_mod,
                                          bf16* outb, float* outf, int r0, int nr, int lane) {
    f32x4 G[4], SH[4], cur[4], nxt[4];
    int curmod = -1;
    { const float* s0 = (r0 < nA) ? srcA + (size_t)r0 * DM : srcB + (size_t)(r0 - nA) * DM;
#pragma unroll
      for (int j = 0; j < 4; ++j) cur[j] = *(const f32x4*)(s0 + (lane + 64 * j) * 4); }
#pragma unroll 1
    for (int i = 0; i < nr; ++i) {
        const int m = r0 + i;
        if (i + 1 < nr) { const int m1 = m + 1; const float* s1 = (m1 < nA) ? srcA + (size_t)m1 * DM : srcB + (size_t)(m1 - nA) * DM;
#pragma unroll
            for (int j = 0; j < 4; ++j) nxt[j] = *(const f32x4*)(s1 + (lane + 64 * j) * 4); }
        const int mr = MOD ? ((m < nA) ? (m >> 11) : 8) : 0;
        if (mr != curmod) { curmod = mr;
#pragma unroll
            for (int j = 0; j < 4; ++j) { const int e = (lane + 64 * j) * 4; const f32x4 gg = *(const f32x4*)(g + e);
                if (MOD) { const f32x4 sc = *(const f32x4*)(mx + (size_t)mr * (NMOD * DM) + scale_mod * DM + e); SH[j] = *(const f32x4*)(mx + (size_t)mr * (NMOD * DM) + shift_mod * DM + e); G[j] = gg * (sc + 1.f); }
                else { G[j] = gg; SH[j] = (f32x4){0.f, 0.f, 0.f, 0.f}; } } }
        float s = 0.f;
#pragma unroll
        for (int j = 0; j < 4; ++j) s += (cur[j][0] * cur[j][0] + cur[j][1] * cur[j][1]) + (cur[j][2] * cur[j][2] + cur[j][3] * cur[j][3]);
        const float rinv = rsqrtf(wave_sum(s) * (1.f / DM) + EPSN);
#pragma unroll
        for (int j = 0; j < 4; ++j) { const int e = (lane + 64 * j) * 4; const f32x4 h = cur[j] * rinv * G[j] + SH[j];
            if (MOD) { u32x2 w; w.x = pk2(h[0], h[1]); w.y = pk2(h[2], h[3]); *(u32x2*)(outb + (size_t)m * DM + e) = w; }
            else *(f32x4*)(outf + (size_t)m * DM + e) = h; }
#pragma unroll
        for (int j = 0; j < 4; ++j) cur[j] = nxt[j];
    }
}

__device__ __forceinline__ void phase0(const Params& p, unsigned char* lds, int tid, int lane, int wave, int G, const int part) {
    float* ldsf = (float*)lds;
    float* mxo = (float*)(p.ws + WS_MX);
    if (part == 0) {
    for (int it = blockIdx.x; it < 192; it += G) {
        __syncthreads();
        {
            const float* c = p.in[1]; const float* cc = p.in[3]; const float* aw = p.in[4]; const float* ab = p.in[5];
            float* sc = ldsf;
            float* red = ldsf + 9 * 1024;
            for (int i = tid; i < 9 * 1024; i += NTHR) { const int r = i >> 10, k = i & 1023; const float cv = (r < 8) ? c[r * 1024 + k] : cc[k]; sc[i] = cv / (1.f + __expf(-cv)); }
            __syncthreads();
            const int n0 = it * 32, col = tid & 31, ks = tid >> 5;
            float a[9];
#pragma unroll
            for (int r = 0; r < 9; ++r) a[r] = 0.f;
            for (int k = ks * 64; k < ks * 64 + 64; ++k) { const float w = aw[(size_t)k * (NMOD * DM) + n0 + col];
#pragma unroll
                for (int r = 0; r < 9; ++r) a[r] += sc[r * 1024 + k] * w; }
#pragma unroll
            for (int r = 0; r < 9; ++r) red[(ks * 9 + r) * 32 + col] = a[r];
            __syncthreads();
            if (tid < 288) { const int r = tid >> 5, cl = tid & 31; float s = ab[n0 + cl];
                for (int k2 = 0; k2 < 16; ++k2) s += red[(k2 * 9 + r) * 32 + cl];
                mxo[r * (NMOD * DM) + n0 + cl] = s; }
        }
    }
    __syncthreads();
    { bf16* tch = (bf16*)(p.ws + WS_TCH); bf16* wfs = (bf16*)(p.ws + WS_WFS); const float* win = p.in[7];
      for (int i = blockIdx.x * NTHR + tid; i < 1024 * 64; i += G * NTHR) { const int n = i >> 6, c8 = (i & 63) * 8, gn = (n & 511) >> 7, j = n & 127; float vv[8];
#pragma unroll
          for (int e = 0; e < 8; ++e) { const int cp = c8 + e, idx = ((cp & 127) * j) & 127; const float ang = (float)idx * (1.f / 64.f);
              vv[e] = ((cp >> 7) == gn) ? ((n < 512) ? cospif(ang) : sinpif(ang)) : 0.f; }
          u32x4 w; w.x = pk2(vv[0], vv[1]); w.y = pk2(vv[2], vv[3]); w.z = pk2(vv[4], vv[5]); w.w = pk2(vv[6], vv[7]);
          *(u32x4*)(tch + (size_t)n * 512 + c8) = w;
          const f32x4 a = *(const f32x4*)(win + (size_t)n * INDIM + c8), b2 = *(const f32x4*)(win + (size_t)n * INDIM + c8 + 4);
          *(u32x4*)(wfs + (size_t)n * 512 + c8) = pack8(a, b2); } }
    }
    if (part == 0 && blockIdx.x == G - 1) { const float* hl = p.in[8]; float* lbo = (float*)(p.ws + WS_LB);
        if (tid < 512) { const float a = hl[tid], b = hl[512 + tid]; lbo[tid] = 1.f / (1.f + expf(b - a)); } }
    if (part == 0) return;
    { bf16* cs = (bf16*)(p.ws + WS_CS);
      for (int i = blockIdx.x * NTHR + tid; i < 2 * 1024 * 256; i += G * NTHR) { const int eo = i >> 18, l = (i >> 8) & 1023, kc = (i & 255) * 8; float vv[8];
#pragma unroll
          for (int e = 0; e < 8; ++e) { const int k = kc + e, sn = k >> 10, m = k & 1023;
              const float ang = eo ? (float)((l * (2 * m + 1)) & 2047) * (1.f / 1024.f) : (float)((l * m) & 1023) * (1.f / 512.f);
              vv[e] = sn ? -sinpif(ang) : cospif(ang); }
          u32x4 w; w.x = pk2(vv[0], vv[1]); w.y = pk2(vv[2], vv[3]); w.z = pk2(vv[4], vv[5]); w.w = pk2(vv[6], vv[7]);
          *(u32x4*)(cs + ((size_t)eo * 1024 + l) * 2048 + kc) = w; } }
    { LAS float* scr = (LAS float*)((LAS unsigned char*)lds + wave * 16384);
      const int gw = blockIdx.x * NWAVES + wave, NGW = G * NWAVES;
      constexpr int I_IN = 16 * 160, I_A = 8 * 32, I_B = 8 * 32, I_O = 16 * 32;
      for (int it = gw; it < ((G >= 192) ? I_IN : I_IN + I_A + I_B + I_O); it += NGW) { int r = it;
          if (r < I_IN) { transpose_item(p.in[7], 1024, INDIM, (bf16*)(p.ws + WS_WIN), scr, r, lane); continue; } r -= I_IN;
          if (r < I_A) { transpose_item(p.in[10], 512, 1024, (bf16*)(p.ws + WS_WA), scr, r, lane); continue; } r -= I_A;
          if (r < I_B) { transpose_item(p.in[11], 512, 1024, (bf16*)(p.ws + WS_WB), scr, r, lane); continue; } r -= I_B;
          transpose_item(p.in[12], 1024, 1024, (bf16*)(p.ws + WS_WOUT), scr, r, lane); } }
}

__device__ __forceinline__ void hgrn_mfma_item(const Params& p, unsigned char* lds, int item) {
    int tid_ = threadIdx.x; asm volatile("" : "+v"(tid_));
    const int tid = tid_, lane = tid & 63, w = __builtin_amdgcn_readfirstlane(tid >> 6), fr = lane & 15, fq = lane >> 4;
    const int vh = item & 1, dir = (item >> 1) & 1, h = (item >> 2) & 3, b = item >> 4;
    bf16* Qs = (bf16*)lds;
    bf16* Ks = Qs + 64 * 136;
    bf16* St = Ks + 64 * 136;
    bf16* Kh = St + 2 * 64 * 136;
    bf16* Vt = Kh + 128 * 72;
    bf16* Ps = Vt + 64 * 72;
    float* Et = (float*)(Ps + 64 * 72);
    float* Fr = Et + 128;
    const int d = 16 * w + fr;
    const float* fL = p.out + (dir ? (size_t)MTOK * 512 : 0) + (size_t)b * SEQ * 512 + h * 128;
    const float* fC = (const float*)(p.ws + (dir ? WS_GBC : WS_GFC)) + (size_t)b * CTXL * 512 + h * 128;
    const bf16* qL = (const bf16*)(p.ws + WS_Q) + (size_t)b * SEQ * 512 + h * 128;
    const bf16* vL = (const bf16*)(p.ws + WS_V) + (size_t)b * SEQ * 512 + h * 128 + vh * 64;
    const bf16* vC = (const bf16*)(p.ws + WS_VC) + (size_t)b * CTXL * 512 + h * 128 + vh * 64;
    bf16* oL = (bf16*)(p.ws + (dir ? WS_OB : WS_OF)) + (size_t)b * SEQ * 512 + h * 128 + vh * 64;
    f32x4 Sa[4];
#pragma unroll
    for (int i = 0; i < 4; ++i) Sa[i] = (f32x4){0.f, 0.f, 0.f, 0.f};
    f32x4 fR[4]; u32x4 qR[2], vR;
#define HG_LOAD(cc_) do { const int _cc = (cc_); const bool _lat = _cc >= 4; const int _c = _lat ? _cc - 4 : _cc, _n = _lat ? SEQ : CTXL; \
        const float* _f = _lat ? fL : fC; const bf16* _v = _lat ? vL : vC; \
        _Pragma("unroll") for (int i = 0; i < 4; ++i) { const int _j = tid + 512 * i, _s = _c * 64 + (_j >> 5), _pos = dir ? (_n - 1 - _s) : _s; fR[i] = *(const f32x4*)(_f + (size_t)_pos * 512 + (_j & 31) * 4); } \
        if (_lat) { _Pragma("unroll") for (int i = 0; i < 2; ++i) { const int _j = tid + 512 * i, _s = _c * 64 + (_j >> 4), _pos = dir ? (_n - 1 - _s) : _s; qR[i] = *(const u32x4*)(qL + (size_t)_pos * 512 + (_j & 15) * 8); } } \
        { const int _s = _c * 64 + lane, _pos = dir ? (_n - 1 - _s) : _s; vR = *(const u32x4*)(_v + (size_t)_pos * 512 + w * 8); } } while (0)
#define HG_STAGE(lat_) do { \
        _Pragma("unroll") for (int i = 0; i < 4; ++i) { const int _j = tid + 512 * i; *(f32x4*)(Fr + (_j >> 5) * 132 + (_j & 31) * 4) = fR[i]; } \
        if (lat_) { _Pragma("unroll") for (int i = 0; i < 2; ++i) { const int _j = tid + 512 * i; *(u32x4*)(Qs + (_j >> 4) * 136 + (_j & 15) * 8) = qR[i]; } } } while (0)
    HG_LOAD(0);
    HG_STAGE(false);
    __syncthreads();
    for (int cc = 0; cc < 36; ++cc) {
        const bool lat = cc >= 4; const int c = lat ? cc - 4 : cc;
        bf16* Scur = St + (cc & 1) * (64 * 136); bf16* Snxt = St + ((cc & 1) ^ 1) * (64 * 136);
        {
            f32x2 cum = (f32x2){1.f, 1.f};
            for (int blk = 0; blk < w; ++blk) { f32x2 t[8];
#pragma unroll
                for (int i = 0; i < 8; ++i) t[i] = *(const f32x2*)(Fr + (8 * blk + i) * 132 + 2 * lane);
                cum = cum * (((t[0] * t[1]) * (t[2] * t[3])) * ((t[4] * t[5]) * (t[6] * t[7]))); }
            f32x2 fown[8];
#pragma unroll
            for (int i = 0; i < 8; ++i) fown[i] = *(const f32x2*)(Fr + (8 * w + i) * 132 + 2 * lane);
            unsigned kp0[4], kp1[4];
#pragma unroll
            for (int i = 0; i < 8; i += 2) { float k0v[2], k1v[2];
#pragma unroll
                for (int u = 0; u < 2; ++u) { const int r = 8 * w + i + u; const f32x2 f = fown[i + u]; cum = cum * f;
                    const float cm0 = fmaxf(cum[0], 1e-30f), cm1 = fmaxf(cum[1], 1e-30f);
                    const float kt0 = (1.f - f[0]) * __builtin_amdgcn_rcpf(cm0), kt1 = (1.f - f[1]) * __builtin_amdgcn_rcpf(cm1);
                    if (lat) { const unsigned qr = *(const unsigned*)(Qs + r * 136 + 2 * lane);
                        *(unsigned*)(Qs + r * 136 + 2 * lane) = hwpk2(bflo(qr) * cm0, bfhi(qr) * cm1); *(unsigned*)(Ks + r * 136 + 2 * lane) = hwpk2(kt0, kt1); }
                    k0v[u] = kt0; k1v[u] = kt1; }
                kp0[i >> 1] = hwpk2(k0v[0], k0v[1]); kp1[i >> 1] = hwpk2(k1v[0], k1v[1]); }
            u32x4 q0; q0.x = kp0[0]; q0.y = kp0[1]; q0.z = kp0[2]; q0.w = kp0[3]; u32x4 q1; q1.x = kp1[0]; q1.y = kp1[1]; q1.z = kp1[2]; q1.w = kp1[3];
            *(u32x4*)(Kh + (2 * lane) * 72 + 8 * w) = q0; *(u32x4*)(Kh + (2 * lane + 1) * 72 + 8 * w) = q1;
            if (w == 7) *(f32x2*)(Et + 2 * lane) = cum;
            Vt[(8 * w + 0) * 72 + lane] = (bf16)(vR.x & 0xffffu); Vt[(8 * w + 1) * 72 + lane] = (bf16)(vR.x >> 16); Vt[(8 * w + 2) * 72 + lane] = (bf16)(vR.y & 0xffffu); Vt[(8 * w + 3) * 72 + lane] = (bf16)(vR.y >> 16);
            Vt[(8 * w + 4) * 72 + lane] = (bf16)(vR.z & 0xffffu); Vt[(8 * w + 5) * 72 + lane] = (bf16)(vR.z >> 16); Vt[(8 * w + 6) * 72 + lane] = (bf16)(vR.w & 0xffffu); Vt[(8 * w + 7) * 72 + lane] = (bf16)(vR.w >> 16);
        }
        if (cc + 1 < 36) HG_LOAD(cc + 1);
        __syncthreads();
        const int ti = w >> 1, x2 = 2 * (w & 1);
        if (lat) {
#pragma unroll
            for (int u2 = 0; u2 < 2; ++u2) { const int si = x2 + u2; f32x4 acc = (f32x4){0.f, 0.f, 0.f, 0.f};
                if (si <= ti) {
#pragma unroll
                    for (int kk = 0; kk < 4; ++kk) { const pg8::bf16x8 a = *(const pg8::bf16x8*)(Ks + (si * 16 + fr) * 136 + kk * 32 + fq * 8), bq = *(const pg8::bf16x8*)(Qs + (ti * 16 + fr) * 136 + kk * 32 + fq * 8);
                        acc = __builtin_amdgcn_mfma_f32_16x16x32_bf16(a, bq, acc, 0, 0, 0); }
                    if (si == ti) {
#pragma unroll
                        for (int r = 0; r < 4; ++r) if (4 * fq + r > fr) acc[r] = 0.f; } }
                u32x2 pw; pw.x = hwpk2(acc[0], acc[1]); pw.y = hwpk2(acc[2], acc[3]);
                *(u32x2*)(Ps + (ti * 16 + fr) * 72 + si * 16 + 4 * fq) = pw; }
        }
        {
            const f32x4 et = *(const f32x4*)(Et + w * 16 + 4 * fq);
            pg8::bf16x8 ka[2];
#pragma unroll
            for (int kk = 0; kk < 2; ++kk) ka[kk] = *(const pg8::bf16x8*)(Kh + (w * 16 + fr) * 72 + kk * 32 + fq * 8);
#pragma unroll
            for (int vi = 0; vi < 4; ++vi) {
#pragma unroll
                for (int kk = 0; kk < 2; ++kk) { const pg8::bf16x8 bv = *(const pg8::bf16x8*)(Vt + (vi * 16 + fr) * 72 + kk * 32 + fq * 8);
                    Sa[vi] = __builtin_amdgcn_mfma_f32_16x16x32_bf16(ka[kk], bv, Sa[vi], 0, 0, 0); }
                Sa[vi] = Sa[vi] * et;
                u32x2 sw; sw.x = hwpk2(Sa[vi][0], Sa[vi][1]); sw.y = hwpk2(Sa[vi][2], Sa[vi][3]);
                *(u32x2*)(Snxt + (vi * 16 + fr) * 136 + w * 16 + 4 * fq) = sw; }
        }
        f32x4 Oa[2];
        Oa[0] = (f32x4){0.f, 0.f, 0.f, 0.f}; Oa[1] = (f32x4){0.f, 0.f, 0.f, 0.f};
        if (lat) {
#pragma unroll
            for (int kk = 0; kk < 4; ++kk) { const pg8::bf16x8 bq = *(const pg8::bf16x8*)(Qs + (ti * 16 + fr) * 136 + kk * 32 + fq * 8);
#pragma unroll
                for (int u2 = 0; u2 < 2; ++u2) { const pg8::bf16x8 a = *(const pg8::bf16x8*)(Scur + ((x2 + u2) * 16 + fr) * 136 + kk * 32 + fq * 8);
                    Oa[u2] = __builtin_amdgcn_mfma_f32_16x16x32_bf16(a, bq, Oa[u2], 0, 0, 0); } }
        }
        __syncthreads();
        if (lat) {
#pragma unroll
            for (int kk = 0; kk < 2; ++kk) { const pg8::bf16x8 bp = *(const pg8::bf16x8*)(Ps + (ti * 16 + fr) * 72 + kk * 32 + fq * 8);
#pragma unroll
                for (int u2 = 0; u2 < 2; ++u2) { const pg8::bf16x8 a = *(const pg8::bf16x8*)(Vt + ((x2 + u2) * 16 + fr) * 72 + kk * 32 + fq * 8);
                    Oa[u2] = __builtin_amdgcn_mfma_f32_16x16x32_bf16(a, bp, Oa[u2], 0, 0, 0); } }
            const int sg = c * 64 + ti * 16 + fr, pos = dir ? (SEQ - 1 - sg) : sg;
#pragma unroll
            for (int u2 = 0; u2 < 2; ++u2) { u32x2 ow; ow.x = hwpk2(Oa[u2][0], Oa[u2][1]); ow.y = hwpk2(Oa[u2][2], Oa[u2][3]);
                *(u32x2*)(oL + (size_t)pos * 512 + (x2 + u2) * 16 + 4 * fq) = ow; }
        }
        if (cc + 1 < 36) HG_STAGE(cc + 1 >= 4);
        __syncthreads();
    }
#undef HG_LOAD
#undef HG_STAGE
}

__device__ __forceinline__ void phase_yh(const Params& p, int lane, int gw, int NGW) {
    const bf16* of = (const bf16*)(p.ws + WS_OF); const bf16* ob = (const bf16*)(p.ws + WS_OB); const bf16* og = (const bf16*)(p.ws + WS_OG);
    bf16* yh = (bf16*)(p.ws + WS_YH); const float* on = p.in[9];
    const f32x4 n0 = *(const f32x4*)(on + lane * 8), n1 = *(const f32x4*)(on + lane * 8 + 4);
    const int per = (MTOK + NGW - 1) / NGW, r0 = gw * per, nr = min(per, MTOK - r0);
    if (nr <= 0) return;
    u32x4 a = *(const u32x4*)(of + (size_t)r0 * 512 + lane * 8), b = *(const u32x4*)(ob + (size_t)r0 * 512 + lane * 8), gg = *(const u32x4*)(og + (size_t)r0 * 512 + lane * 8);
#pragma unroll 1
    for (int i = 0; i < nr; ++i) { const size_t o = (size_t)(r0 + i) * 512 + lane * 8;
        u32x4 a1 = a, b1 = b, g1 = gg;
        if (i + 1 < nr) { a1 = *(const u32x4*)(of + o + 512); b1 = *(const u32x4*)(ob + o + 512); g1 = *(const u32x4*)(og + o + 512); }
        float v[8]; v[0] = bflo(a.x) + bflo(b.x); v[1] = bfhi(a.x) + bfhi(b.x); v[2] = bflo(a.y) + bflo(b.y); v[3] = bfhi(a.y) + bfhi(b.y);
        v[4] = bflo(a.z) + bflo(b.z); v[5] = bfhi(a.z) + bfhi(b.z); v[6] = bflo(a.w) + bflo(b.w); v[7] = bfhi(a.w) + bfhi(b.w);
        float s = 0.f;
#pragma unroll
        for (int k = 0; k < 8; ++k) s += v[k] * v[k];
        s += __shfl_xor(s, 1); s += __shfl_xor(s, 2); s += __shfl_xor(s, 4); s += __shfl_xor(s, 8);
        const float rinv = rsqrtf(s * (1.f / 128.f) + EPSN);
        float gv[8]; gv[0] = bflo(gg.x); gv[1] = bfhi(gg.x); gv[2] = bflo(gg.y); gv[3] = bfhi(gg.y); gv[4] = bflo(gg.z); gv[5] = bfhi(gg.z); gv[6] = bflo(gg.w); gv[7] = bfhi(gg.w);
        f32x4 q0, q1;
#pragma unroll
        for (int k = 0; k < 4; ++k) { q0[k] = v[k] * rinv * n0[k] * gv[k]; q1[k] = v[4 + k] * rinv * n1[k] * gv[4 + k]; }
        *(u32x4*)(yh + o) = pack8(q0, q1);
        a = a1; b = b1; gg = g1; }
}

struct ConvRaw { u32x2 a[3], g[3]; };
__device__ __forceinline__ void conv_issue(const bf16* z, int tokbase, int r, int cc, int ch, ConvRaw& q) {
#pragma unroll
    for (int i = 0; i < 3; ++i) { const int rr = r + i - 1;
        if (rr >= 0 && rr < 32 && cc >= 0 && cc < 64) { const size_t zo = (size_t)(tokbase + rr * 64 + cc) * DFF2 + ch;
            q.a[i] = *(const u32x2*)(z + zo); q.g[i] = *(const u32x2*)(z + zo + DFF);
        } else { q.a[i] = (u32x2){0u, 0u}; q.g[i] = (u32x2){0u, 0u}; } }
}
__device__ __forceinline__ void phase_conv(const Params& p, int hf, int tid, int G) {
    const bf16* z = (const bf16*)(p.ws + WS_Z); bf16* a2 = (bf16*)(p.ws + WS_A2) + (size_t)hf * 8192 * DFF;
    const float* cw = p.in[15]; const float* cb = p.in[16];
    for (int it = blockIdx.x * NTHR + tid; it < 4 * 32 * 4 * 704; it += G * NTHR) {
        const int cg4 = it % 704, rest = it / 704, strip = rest & 3, r = (rest >> 2) & 31, img = rest >> 7, ch = cg4 * 4, c0 = strip * 16, tokbase = img * 2048;
        ConvRaw ring[3];
#pragma unroll
        for (int j = 0; j < 3; ++j) conv_issue(z, tokbase, r, c0 - 1 + j, ch, ring[j]);
        f32x2 w1[9][2], w2[9][2];
#pragma unroll
        for (int t = 0; t < 9; ++t) { const f32x4 a = *(const f32x4*)(cw + (size_t)t * DFF2 + ch), g = *(const f32x4*)(cw + (size_t)t * DFF2 + DFF + ch);
            w1[t][0] = (f32x2){a[0], a[1]}; w1[t][1] = (f32x2){a[2], a[3]}; w2[t][0] = (f32x2){g[0], g[1]}; w2[t][1] = (f32x2){g[2], g[3]}; }
        const f32x4 b1 = *(const f32x4*)(cb + ch), b2 = *(const f32x4*)(cb + DFF + ch);
        f32x2 W1[3][3][2], W2[3][3][2];
#pragma unroll
        for (int j = 0; j < 18; ++j) {
            const int sl = j % 3;
#pragma unroll
            for (int i = 0; i < 3; ++i) { const u32x2 a = ring[j % 3].a[i], g = ring[j % 3].g[i];
                W1[sl][i][0] = (f32x2){bflo(a.x), bfhi(a.x)}; W1[sl][i][1] = (f32x2){bflo(a.y), bfhi(a.y)};
                W2[sl][i][0] = (f32x2){bflo(g.x), bfhi(g.x)}; W2[sl][i][1] = (f32x2){bflo(g.y), bfhi(g.y)}; }
            if (j + 3 < 18) conv_issue(z, tokbase, r, c0 - 1 + j + 3, ch, ring[j % 3]);
            if (j >= 2) {
                const int sL = (j - 2) % 3, sC = (j - 1) % 3, sR = j % 3;
                f32x2 o1[2], o2[2];
                o1[0] = (f32x2){b1[0], b1[1]}; o1[1] = (f32x2){b1[2], b1[3]}; o2[0] = (f32x2){b2[0], b2[1]}; o2[1] = (f32x2){b2[2], b2[3]};
#pragma unroll
                for (int i = 0; i < 3; ++i)
#pragma unroll
                    for (int e = 0; e < 2; ++e) {
                        o1[e] = __builtin_elementwise_fma(W1[sL][i][e], w1[i * 3 + 0][e], o1[e]); o1[e] = __builtin_elementwise_fma(W1[sC][i][e], w1[i * 3 + 1][e], o1[e]); o1[e] = __builtin_elementwise_fma(W1[sR][i][e], w1[i * 3 + 2][e], o1[e]);
                        o2[e] = __builtin_elementwise_fma(W2[sL][i][e], w2[i * 3 + 0][e], o2[e]); o2[e] = __builtin_elementwise_fma(W2[sC][i][e], w2[i * 3 + 1][e], o2[e]); o2[e] = __builtin_elementwise_fma(W2[sR][i][e], w2[i * 3 + 2][e], o2[e]); }
                u32x2 ow; ow.x = pk2(siluf_(o1[0][0]) * o2[0][0], siluf_(o1[0][1]) * o2[0][1]); ow.y = pk2(siluf_(o1[1][0]) * o2[1][0], siluf_(o1[1][1]) * o2[1][1]);
                *(u32x2*)(a2 + (size_t)(tokbase + r * 64 + c0 + j - 2) * DFF + ch) = ow;
            }
        }
    }
}

__global__ void __launch_bounds__(NTHR, 2) fwd_mega(Params p) {
    extern __shared__ __attribute__((aligned(16))) unsigned char lds[];
    cg::grid_group grid = cg::this_grid();
    const int tid = threadIdx.x, lane = tid & 63, wave = __builtin_amdgcn_readfirstlane(tid >> 6);
    const int G = gridDim.x, gw = blockIdx.x * NWAVES + wave, NGW = G * NWAVES;
    PG8_LAS unsigned char* ldsl = (PG8_LAS unsigned char*)lds;
    unsigned char* ws = p.ws;
    const float* mx = (const float*)(ws + WS_MX);
    volatile LAS unsigned* misc = (volatile LAS unsigned*)((LAS unsigned char*)lds + MISC_OFF);
    if (tid < 16) misc[tid] = 0u;
    __syncthreads();
    const XcdBarrier xbar = xcd_barrier_post((unsigned*)(ws + WS_BAR), misc + 8);
    const unsigned long long t0_ = (PROBE_K >= 0) ? __builtin_amdgcn_s_memrealtime() : 0ull;
#define PROBE_POINT(k) do { if (PROBE_K == (k) && tid == 0) { const unsigned long long _n = __builtin_amdgcn_s_memrealtime(), _d = _n - t0_; while (__builtin_amdgcn_s_memrealtime() - _n < _d) __builtin_amdgcn_s_sleep(8); } } while (0)

    for (int rep_ = 0; rep_ < REPS(0); ++rep_) {
    phase0(p, lds, tid, lane, wave, G, 0);
    phase0(p, lds, tid, lane, wave, G, 1);
    xcd_barrier(xbar);
    if (G == 0x7fffffff) grid.sync();
    }
    for (int xs_ = 0; xs_ < EXTRA_SYNCS; ++xs_) xcd_barrier(xbar);
    PROBE_POINT(0);
    for (int rep_ = 0; rep_ < REPS(1); ++rep_) {
    if (blockIdx.x < 16 && G >= 16) {
        pg8::Gemm g{(const bf16*)(ws + WS_TCH), (const bf16*)(ws + WS_WFS), 512, 512, 512};
        pg8::StaticOrder S; S.init(4, 4, 16, blockIdx.x, 512, 512);
        pg8::Epi8<FUp> E{FUp{(bf16*)(ws + WS_WPQ), 1024}};
        pg8::gemm_phase<pg8::Epi8<FUp>, pg8::StaticOrder, true, true>(ldsl, g, S, E);
    }
    { const int skip = (G >= 32) ? 16 * NWAVES : 0, nw = NGW - skip, per = (MTOK + MCTX + nw - 1) / nw, r0 = (gw - skip) * per, nr = (gw < skip) ? 0 : min(per, MTOK + MCTX - r0);
      if (nr > 0) norm_rows<true>(p.in[0], p.in[2], MTOK, p.in[6], mx, 0, 1, (bf16*)(ws + WS_HX), nullptr, r0, nr, lane); }
    xcd_barrier(xbar);
    }
    PROBE_POINT(1);
    for (int rep_ = 0; rep_ < REPS(2); ++rep_) {
    {
        pg8::Gemm g{(const bf16*)(ws + WS_HX), (const bf16*)(ws + WS_WIN) + (size_t)512 * 1024, 1024, 1024, 1024};
        pg8::InOrder S; S.G = G; S.c = blockIdx.x; S.a_tile = (size_t)256 * 1024 * 2; S.b_tile = (size_t)256 * 1024 * 2;
        pg8::Epi8<FIn> E{FIn{ws, p.out}};
        pg8::gemm_phase<pg8::Epi8<FIn>, pg8::InOrder, true, true>(ldsl, g, S, E);
    }
    {
        pg8::Gemm g{(const bf16*)(ws + WS_WPQ), (const bf16*)(ws + WS_HX), 1024, 1024, 1024};
        pg8::StaticOrder S; S.init(4, 64, G, blockIdx.x, 1024, 1024);
        pg8::Epi8<FPQ> E{FPQ{(bf16*)(ws + WS_PQT)}};
        pg8::gemm_phase<pg8::Epi8<FPQ>, pg8::StaticOrder, true, true>(ldsl, g, S, E);
    }
    xcd_barrier(xbar);
    }
    PROBE_POINT(2);
    for (int rep_ = 0; rep_ < REPS(3); ++rep_) {
    if (blockIdx.x < 128 && G >= 192) {
        pg8::Gemm g{(const bf16*)(ws + WS_CS), (const bf16*)(ws + WS_PQT), 2048, 2048, 32768};
        pg8::DftOrder S; S.G = 128; S.c = blockIdx.x; S.a_tile = (size_t)256 * 2048 * 2; S.b_tile = (size_t)256 * 32768 * 2;
        EpiDft E{(bf16*)(ws + WS_YF), (unsigned*)(ws + WS_BAR + 16384)};
        pg8::gemm_phase<EpiDft, pg8::DftOrder, true, true>(ldsl, g, S, E);
        { int t2 = threadIdx.x; asm volatile("" : "+v"(t2));
          const int lane = t2 & 63, wave = __builtin_amdgcn_readfirstlane(t2 >> 6), gw = blockIdx.x * NWAVES + wave;
          LAS float* scr = (LAS float*)((LAS unsigned char*)lds + wave * 16384);
          constexpr int I_UP = 16 * 176, I_DN = 44 * 32;
          for (int it = gw; it < I_UP + I_DN; it += 128 * NWAVES) {
              if (it < I_UP) transpose_item(p.in[14], 1024, DFF2, (bf16*)(ws + WS_WUP), scr, it, lane);
              else transpose_item(p.in[17], DFF, 1024, (bf16*)(ws + WS_WDN), scr, it - I_UP, lane); }
          constexpr int I_A = 8 * 32, I_B = 8 * 32, I_O = 16 * 32;
          for (int it = gw; it < I_A + I_B + I_O; it += 128 * NWAVES) {
              if (it < I_A) transpose_item(p.in[10], 512, 1024, (bf16*)(ws + WS_WA), scr, it, lane);
              else if (it < I_A + I_B) transpose_item(p.in[11], 512, 1024, (bf16*)(ws + WS_WB), scr, it - I_A, lane);
              else transpose_item(p.in[12], 1024, 1024, (bf16*)(ws + WS_WOUT), scr, it - I_A - I_B, lane); } }
    } else if (G >= 192) {
        for (int it = blockIdx.x - 128; it < 128; it += G - 128) hgrn_mfma_item(p, lds, it);
    } else {
        pg8::Gemm g{(const bf16*)(ws + WS_CS), (const bf16*)(ws + WS_PQT), 2048, 2048, 32768};
        pg8::DftOrder S; S.G = G; S.c = blockIdx.x; S.a_tile = (size_t)256 * 2048 * 2; S.b_tile = (size_t)256 * 32768 * 2;
        EpiDft E{(bf16*)(ws + WS_YF), (unsigned*)(ws + WS_BAR + 16384)};
        pg8::gemm_phase<EpiDft, pg8::DftOrder, true, true>(ldsl, g, S, E);
        for (int it = blockIdx.x; it < 128; it += G) hgrn_mfma_item(p, lds, it);
    }
    xcd_barrier(xbar);
    }
    PROBE_POINT(3);
    for (int rep_ = 0; rep_ < REPS(4); ++rep_) {
    phase_yh(p, lane, gw, NGW);
    { LAS float* scr = (LAS float*)((LAS unsigned char*)lds + wave * 16384);
      constexpr int I_UP = 16 * 176, I_DN = 44 * 32;
      for (int it = (G >= 192) ? I_UP + I_DN : gw; it < I_UP + I_DN; it += NGW) {
          if (it < I_UP) transpose_item(p.in[14], 1024, DFF2, (bf16*)(ws + WS_WUP), scr, it, lane);
          else transpose_item(p.in[17], DFF, 1024, (bf16*)(ws + WS_WDN), scr, it - I_UP, lane); } }
    xcd_barrier(xbar);
    }
    PROBE_POINT(4);
    for (int rep_ = 0; rep_ < REPS(5); ++rep_) {
    if (G == 256) {
        pg8::f32x4 accm[2][2][4][2];
        {
            pg8::Gemm g{(const bf16*)(ws + WS_YF), (const bf16*)(ws + WS_WA), 512, 512, 512};
            pg8::StaticOrder S; S.init(64, 4, G, blockIdx.x, 512, 512);
            pg8::Epi8<FYab> E{FYab{(const bf16*)(ws + WS_GA), (const bf16*)(ws + WS_GBG)}};
            pg8::gemm_phase<pg8::Epi8<FYab>, pg8::StaticOrder, true, true, 1>(ldsl, g, S, E, &accm[0]);
        }
        {
            pg8::Gemm g{(const bf16*)(ws + WS_YH), (const bf16*)(ws + WS_WB), 512, 512, 512};
            pg8::StaticOrder S; S.init(64, 4, G, blockIdx.x, 512, 512);
            pg8::Epi8<FYb> E{FYb{(const bf16*)(ws + WS_GBG), (bf16*)(ws + WS_MRG)}};
            pg8::gemm_phase<pg8::Epi8<FYb>, pg8::StaticOrder, true, true, 2>(ldsl, g, S, E, &accm[0]);
        }
    } else {
    {
        pg8::Gemm g{(const bf16*)(ws + WS_YF), (const bf16*)(ws + WS_WA), 512, 512, 512};
        pg8::StaticOrder S; S.init(64, 4, G, blockIdx.x, 512, 512);
        pg8::Epi8<FYaT> E{FYaT{(const bf16*)(ws + WS_GA), (bf16*)(ws + WS_TMP)}};
        pg8::gemm_phase<pg8::Epi8<FYaT>, pg8::StaticOrder, true, true>(ldsl, g, S, E);
    }
    {
        pg8::Gemm g{(const bf16*)(ws + WS_YH), (const bf16*)(ws + WS_WB), 512, 512, 512};
        pg8::StaticOrder S; S.init(64, 4, G, blockIdx.x, 512, 512);
        pg8::Epi8<FYbT> E{FYbT{(const bf16*)(ws + WS_GBG), (const bf16*)(ws + WS_TMP), (bf16*)(ws + WS_MRG)}};
        pg8::gemm_phase<pg8::Epi8<FYbT>, pg8::StaticOrder, true, true>(ldsl, g, S, E);
    }
    }
    xcd_barrier(xbar);
    }
    PROBE_POINT(5);
    for (int rep_ = 0; rep_ < REPS(6); ++rep_) {
    {
        pg8::Gemm g{(const bf16*)(ws + WS_MRG), (const bf16*)(ws + WS_WOUT), 1024, 1024, 1024};
        pg8::StaticOrder S; S.init(64, 4, G, blockIdx.x, 1024, 1024);
        pg8::Epi8<FRes> E{FRes{p.in[0], p.out, mx, 2}};
        pg8::gemm_phase<pg8::Epi8<FRes>, pg8::StaticOrder, true, true>(ldsl, g, S, E);
    }
    xcd_barrier(xbar);
    }
    PROBE_POINT(6);
    for (int rep_ = 0; rep_ < REPS(7); ++rep_) {
    { const int per = (MTOK + NGW - 1) / NGW, r0 = gw * per, nr = min(per, MTOK - r0);
      if (nr > 0) norm_rows<true>(p.out, p.out, MTOK, p.in[13], mx, 3, 4, (bf16*)(ws + WS_H2), nullptr, r0, nr, lane); }
    xcd_barrier(xbar);
    }
    PROBE_POINT(7);
    {
    for (int hf = 0; hf < 2; ++hf) {
        for (int rep_ = 0; rep_ < REPS(8); ++rep_) {
            pg8::Gemm g{(const bf16*)(ws + WS_H2) + (size_t)hf * 8192 * 1024, (const bf16*)(ws + WS_WUP), 1024, 1024, 1024};
            pg8::StaticOrder S; S.init(32, 22, G, blockIdx.x, 1024, 1024);
            pg8::Epi8<FUp> E{FUp{(bf16*)(ws + WS_Z), DFF2}};
            pg8::gemm_phase<pg8::Epi8<FUp>, pg8::StaticOrder, true, true>(ldsl, g, S, E);
        xcd_barrier(xbar);
        }
        for (int rep_ = 0; rep_ < REPS(9); ++rep_) {
        phase_conv(p, hf, tid, G);
        xcd_barrier(xbar);
        }
    }
    }
    PROBE_POINT(8);
    for (int rep_ = 0; rep_ < REPS(10); ++rep_) {
    {
        pg8::Gemm g{(const bf16*)(ws + WS_A2), (const bf16*)(ws + WS_WDN), DFF, DFF, DFF};
        pg8::StaticOrder S; S.init(64, 4, G, blockIdx.x, DFF, DFF);
        pg8::Epi8<FRes> E{FRes{p.out, (float*)(ws + WS_XO), mx, 5}};
        pg8::gemm_phase<pg8::Epi8<FRes>, pg8::StaticOrder, true, true>(ldsl, g, S, E);
    }
    xcd_barrier(xbar);
    }
    PROBE_POINT(10);
    for (int rep_ = 0; rep_ < REPS(11); ++rep_) {
    { const int per = (MTOK + NGW - 1) / NGW, r0 = gw * per, nr = min(per, MTOK - r0);
      if (nr > 0) norm_rows<false>((const float*)(ws + WS_XO), (const float*)(ws + WS_XO), MTOK, p.in[18], nullptr, 0, 0, nullptr, p.out, r0, nr, lane); }
    }
}

extern "C" void kernel_launch(void* const* d_in, const int* in_sizes, int n_in, void* d_out, int out_size, void* d_ws, size_t ws_size, hipStream_t stream) {
    static int grid = 0;
    if (grid == 0) {
        if (n_in != 19 || out_size != MTOK * DM || ws_size < WS_END) { fprintf(stderr, "kernel_launch: unexpected problem: n_in %d out %d ws %zu\n", n_in, out_size, ws_size); grid = -1; return; }
        int dev = 0, cus = 0, per_cu = 0;
        hipGetDevice(&dev);
        hipDeviceGetAttribute(&cus, hipDeviceAttributeMultiprocessorCount, dev);
        if (hipFuncSetAttribute((const void*)fwd_mega, hipFuncAttributeMaxDynamicSharedMemorySize, LDS_BYTES) != hipSuccess) { fprintf(stderr, "kernel_launch: hipFuncSetAttribute failed\n"); grid = -1; return; }
        if (hipOccupancyMaxActiveBlocksPerMultiprocessor(&per_cu, (const void*)fwd_mega, NTHR, LDS_BYTES) != hipSuccess || per_cu < 1) { fprintf(stderr, "kernel_launch: occupancy query says %d\n", per_cu); per_cu = 1; }
        (void)hipGetLastError();
        grid = cus * (per_cu > 1 ? 1 : per_cu);
        fprintf(stderr, "kernel_launch: grid %d (cus %d, per_cu %d), ws %zu\n", grid, cus, per_cu, ws_size);
    }
    if (grid < 0) return;
    Params p{};
    for (int i = 0; i < 19; ++i) p.in[i] = (const float*)d_in[i];
    p.out = (float*)d_out; p.ws = (unsigned char*)d_ws;
    if (hipMemsetAsync((char*)d_ws + WS_BAR, 0, BAR_BYTES, stream) != hipSuccess) { fprintf(stderr, "kernel_launch: memset failed\n"); return; }
    void* args[] = {&p};
    hipError_t e = hipLaunchCooperativeKernel((const void*)fwd_mega, dim3(grid), dim3(NTHR), args, LDS_BYTES, stream);
    if (e != hipSuccess) fprintf(stderr, "kernel_launch: cooperative launch failed: %s (grid %d)\n", hipGetErrorString(e), grid);
}
```

```cpp
#include <hip/hip_runtime.h>
#include <hip/hip_cooperative_groups.h>
#include <cstdio>
#include <cstdint>
namespace cg = cooperative_groups;

namespace pg8 {
#define PG8_LAS __attribute__((address_space(3)))
typedef unsigned short bf16_t;
typedef short bf16x8 __attribute__((ext_vector_type(8)));
typedef float f32x4 __attribute__((ext_vector_type(4)));
typedef unsigned u32x4 __attribute__((ext_vector_type(4)));
typedef unsigned u32x2 __attribute__((ext_vector_type(2)));
constexpr int BM = 256, BK = 64, HALF = 128, HTB = HALF * BK * 2  , STAGE_BYTES = 8 * HTB, NXCD = 8, WGM = 8;

__host__ __device__ __forceinline__ int lds_byte(int r, int c) { const int st = (r >> 4) * 2 + (c >> 5), rr = r & 15, cc = c & 31, ob = rr * 64 + cc * 2; return st * 1024 + (ob ^ (((ob >> 9) & 1) << 5)); }
__host__ __device__ __forceinline__ void stage_rc(int b, int& R, int& C) { const int st = b / 1024, sb = b % 1024, swz = sb ^ (((sb >> 9) & 1) << 5); R = (st >> 1) * 16 + swz / 64; C = (st & 1) * 32 + (swz % 64) / 2; }
__host__ __device__ __forceinline__ int perm32(int rho) { const int n = rho >> 4, i = rho & 15; return 8 * (i >> 2) + 4 * n + (i & 3); }

struct Unit { int pm, pn, z; };
struct Gemm { const bf16_t* A; const bf16_t* Bt; int K, lda, ldb; };

__device__ __forceinline__ void tile_of(int wgid, int nM, int nN, int& pm, int& pn) {
    const int nwg = nM * nN;
    { const int q = nwg / NXCD, r = nwg % NXCD, xcd = wgid % NXCD, off = wgid / NXCD; wgid = (xcd < r ? xcd * (q + 1) : r * (q + 1) + (xcd - r) * q) + off; }
    const int nig = WGM * nN, gid = wgid / nig, fm = gid * WGM, gsz = (nM - fm) < WGM ? (nM - fm) : WGM;
    pm = fm + ((wgid % nig) % gsz); pn = (wgid % nig) / gsz;
}
struct StaticOrder {
    int nM, nN, nwg, G, c; size_t a_tile, b_tile;
    __device__ __forceinline__ void init(int nM_, int nN_, int G_, int c_, int lda, int ldb) { nM = nM_; nN = nN_; nwg = nM * nN; G = G_; c = c_; a_tile = (size_t)BM * lda * 2; b_tile = (size_t)BM * ldb * 2; }
    __device__ __forceinline__ bool next(int i, Unit& u) const {
        const long L = (long)i * G + c; if (L >= nwg) return false;
        tile_of((int)L, nM, nN, u.pm, u.pn); u.z = 0; return true;
    }
    __device__ __forceinline__ size_t a_off(const Unit& u) const { return (size_t)u.pm * a_tile; }
    __device__ __forceinline__ size_t b_off(const Unit& u) const { return (size_t)u.pn * b_tile; }
};
struct OneOrder {
    int L, nM, nN; size_t a_tile, b_tile;
    __device__ __forceinline__ bool next(int i, Unit& u) const { if (i > 0) return false; tile_of(L, nM, nN, u.pm, u.pn); u.z = 0; return true; }
    __device__ __forceinline__ size_t a_off(const Unit& u) const { return (size_t)u.pm * a_tile; }
    __device__ __forceinline__ size_t b_off(const Unit& u) const { return (size_t)u.pn * b_tile; }
};
struct InOrder {
    int G, c; size_t a_tile, b_tile;
    __device__ __forceinline__ bool next(int i, Unit& u) const {
        const long L = (long)i * G + c; if (L >= 1152 + 48) return false;
        if (L < 1152) { tile_of((int)L, 64, 18, u.pm, u.pn); } else { const int j = (int)L - 1152; u.pm = 64 + (j & 7); u.pn = 2 + (j >> 3); }
        u.z = 0; return true;
    }
    __device__ __forceinline__ size_t a_off(const Unit& u) const { return (size_t)u.pm * a_tile; }
    __device__ __forceinline__ size_t b_off(const Unit& u) const { return (size_t)u.pn * b_tile; }
};
struct DftOrder {
    int G, c; size_t a_tile, b_tile;
    __device__ __forceinline__ bool next(int i, Unit& u) const {
        const long L = (long)i * G + c; if (L >= 128) return false;
        const int eo = (L < 64) ? 1 : 0, q = (int)L & 63;
        u.pn = q & 1; u.pm = (q >> 1) & 3; u.z = (q >> 3) | (eo << 8); return true;
    }
    __device__ __forceinline__ size_t a_off(const Unit& u) const { return (size_t)((u.z >> 8) * 4 + u.pm) * a_tile; }
    __device__ __forceinline__ size_t b_off(const Unit& u) const { return (size_t)u.pn * b_tile + ((size_t)(u.z & 255) * 4096 + (size_t)(u.z >> 8) * 2048) * 2; }
};

__device__ __forceinline__ unsigned cvt_pk_bf16(float lo, float hi) { unsigned r; asm volatile("v_cvt_pk_bf16_f32 %0, %1, %2" : "=v"(r) : "v"(lo), "v"(hi)); return r; }

template <class F> struct Epi8 {
    static constexpr bool PERM = true;
    F f;
    __device__ __forceinline__ void inplace(f32x4 (&acc)[2][2][4][2], const Unit& u, int wr, int wc, int fr, int fq) const {
        const int row0 = u.pm * BM + wr * 64 + fr, col0 = u.pn * BM + wc * 32 + 8 * fq;
#pragma unroll
        for (int ai = 0; ai < 2; ++ai)
#pragma unroll
            for (int m = 0; m < 4; ++m) {
#pragma unroll
                for (int bj = 0; bj < 2; ++bj) f.scale(u, row0 + ai * HALF + m * 16, col0 + bj * HALF, acc[ai][bj][m][0], acc[ai][bj][m][1]);
                asm volatile("" ::: "memory");
            }
    }
    __device__ __forceinline__ void operator()(const f32x4 (&acc)[2][2][4][2], const Unit& u, int wr, int wc, int fr, int fq) const {
        const int row0 = u.pm * BM + wr * 64 + fr, col0 = u.pn * BM + wc * 32 + 8 * fq;
#pragma unroll
        for (int ai = 0; ai < 2; ++ai)
#pragma unroll
            for (int m = 0; m < 4; ++m) {
#pragma unroll
                for (int bj = 0; bj < 2; ++bj) f(u, row0 + ai * HALF + m * 16, col0 + bj * HALF, acc[ai][bj][m][0], acc[ai][bj][m][1]);
                asm volatile("" ::: "memory");
            }
    }
};

template <class Epi, class Sched, bool ALIGN_EPI = false, bool SP2 = false, int EXTACC = 0>
__device__ __forceinline__ void gemm_phase(PG8_LAS unsigned char* lds, const Gemm g, const Sched& S, const Epi& E, f32x4 (*accx)[2][4][2] = nullptr) {
    int tid_ = threadIdx.x; asm volatile("" : "+v"(tid_));
    const int tid = tid_, wid = __builtin_amdgcn_readfirstlane(tid >> 6), lane = tid & 63, wr = wid >> 2, wc = wid & 3, fr = lane & 15, fq = lane >> 4;
    const int K = g.K, nt = K / BK;
    unsigned voffA[2], voffB[2];
#pragma unroll
    for (int i = 0; i < 2; ++i) { int R, C; stage_rc(tid * 16 + i * 8192, R, C); const int Rb = Epi::PERM ? ((R & ~31) + perm32(R & 31)) : R;
        voffA[i] = (unsigned)(R * g.lda + C) * 2u; voffB[i] = (unsigned)(Rb * g.ldb + C) * 2u; }
    const size_t kstep = (size_t)(BK * 2);
    const size_t hstepA = (size_t)HALF * g.lda * 2, hstepB = (size_t)HALF * g.ldb * 2;
    const unsigned ldsw = (unsigned)wid * 1024u;
    const int aoff = lds_byte(wr * 64 + fr, fq * 8), boff = lds_byte(wc * 32 + fr, fq * 8);
#define PG8_SA(b, h) (((b) * 2 + (h)) * HTB)
#define PG8_SB(b, h) ((4 + (b) * 2 + (h)) * HTB)
#define PG8_STAGE(bufoff, gbase, voff) do { _Pragma("unroll") for (int _i = 0; _i < 2; ++_i) \
        __builtin_amdgcn_global_load_lds((const unsigned*)((const char*)(gbase) + (voff)[_i]), (PG8_LAS unsigned*)(lds + (bufoff) + ldsw + _i * 8192), 16, 0, 0); } while (0)
#define PG8_LDA(dst, b, h) do { _Pragma("unroll") for (int m = 0; m < 4; ++m) _Pragma("unroll") for (int k = 0; k < 2; ++k) dst[m][k] = *(const PG8_LAS bf16x8*)(lds + PG8_SA(b, h) + aoff + m * 2048 + k * 1024); } while (0)
#define PG8_LDB(dst, b, h) do { _Pragma("unroll") for (int n = 0; n < 2; ++n) _Pragma("unroll") for (int k = 0; k < 2; ++k) dst[n][k] = *(const PG8_LAS bf16x8*)(lds + PG8_SB(b, h) + boff + n * 2048 + k * 1024); } while (0)
#define PG8_MMA(ai, bj, At, Bt) do { __builtin_amdgcn_s_setprio(1); _Pragma("unroll") for (int m = 0; m < 4; ++m) _Pragma("unroll") for (int n = 0; n < 2; ++n) _Pragma("unroll") for (int k = 0; k < 2; ++k) \
        acc[ai][bj][m][n] = __builtin_amdgcn_mfma_f32_16x16x32_bf16(Bt[n][k], At[m][k], acc[ai][bj][m][n], 0, 0, 0); __builtin_amdgcn_s_setprio(0); } while (0)
#define PG8_WAIT_V(n) asm volatile("s_waitcnt vmcnt(" #n ")" ::: "memory")
#define PG8_WAIT_L(n) asm volatile("s_waitcnt lgkmcnt(" #n ")" ::: "memory")
#define PG8_BAR __builtin_amdgcn_s_barrier()
#define PG8_SCHED __builtin_amdgcn_sched_barrier(0)
    Unit cur, nxt; int ui = 0;
    if (!S.next(0, cur)) return;
    f32x4 accl[2][2][4][2];
    f32x4 (&acc)[2][2][4][2] = *(EXTACC ? (f32x4 (*)[2][2][4][2])accx : &accl);
    if constexpr (EXTACC != 2) {
#pragma unroll
    for (int a = 0; a < 2; ++a)
#pragma unroll
        for (int b = 0; b < 2; ++b)
#pragma unroll
            for (int m = 0; m < 4; ++m)
#pragma unroll
                for (int n = 0; n < 2; ++n) acc[a][b][m][n] = (f32x4){0.f, 0.f, 0.f, 0.f};
    }
    bf16x8 At[4][2], B0[2][2], B1[2][2];
    const char* cA = (const char*)g.A + S.a_off(cur); const char* cB = (const char*)g.Bt + S.b_off(cur);
    if constexpr (SP2) {
        PG8_STAGE(PG8_SB(0, 0), cB, voffB); PG8_STAGE(PG8_SB(0, 1), cB + hstepB, voffB); PG8_STAGE(PG8_SA(0, 0), cA, voffA); PG8_STAGE(PG8_SA(0, 1), cA + hstepA, voffA);
        if (wr == 1) PG8_BAR;
        PG8_WAIT_V(2); PG8_BAR;
        PG8_STAGE(PG8_SB(1, 0), cB + kstep, voffB); PG8_STAGE(PG8_SA(1, 0), cA + kstep, voffA); PG8_STAGE(PG8_SB(1, 1), cB + hstepB + kstep, voffB);
        PG8_WAIT_V(6); PG8_BAR;
    } else {
        PG8_STAGE(PG8_SB(0, 0), cB, voffB); PG8_STAGE(PG8_SA(0, 0), cA, voffA); PG8_STAGE(PG8_SB(0, 1), cB + hstepB, voffB); PG8_STAGE(PG8_SA(0, 1), cA + hstepA, voffA);
        if (wr == 1) PG8_BAR;
        PG8_WAIT_V(4); PG8_BAR;
        PG8_STAGE(PG8_SB(1, 0), cB + kstep, voffB); PG8_STAGE(PG8_SA(1, 0), cA + kstep, voffA); PG8_STAGE(PG8_SB(1, 1), cB + hstepB + kstep, voffB);
        PG8_WAIT_V(6); PG8_BAR;
    }
    for (;;) {
        const bool has_next = S.next(ui + 1, nxt);
        const char* nA = has_next ? (const char*)g.A + S.a_off(nxt) : cA; const char* nB = has_next ? (const char*)g.Bt + S.b_off(nxt) : cB;
        for (int t = 0; t < nt; t += 2) {
            const bool last = (t == nt - 2);
            const char* a1 = cA + (size_t)(t + 1) * kstep;
            const char* a2 = last ? nA : cA + (size_t)(t + 2) * kstep; const char* b2 = last ? nB : cB + (size_t)(t + 2) * kstep;
            const char* a3 = a2 + kstep; const char* b3 = b2 + kstep;
            if constexpr (SP2) {
            PG8_LDB(B0, 0, 0); PG8_LDB(B1, 0, 1); PG8_SCHED; PG8_LDA(At, 0, 0); PG8_STAGE(PG8_SA(1, 1), a1 + hstepA, voffA);
            PG8_WAIT_V(8); PG8_WAIT_L(0); PG8_BAR; PG8_MMA(0, 0, At, B0); PG8_MMA(0, 1, At, B1); PG8_BAR; PG8_SCHED;
            PG8_LDA(At, 0, 1); PG8_STAGE(PG8_SB(0, 0), b2, voffB); PG8_STAGE(PG8_SB(0, 1), b2 + hstepB, voffB); PG8_STAGE(PG8_SA(0, 0), a2, voffA);
            PG8_WAIT_V(8); PG8_WAIT_L(0); PG8_BAR; PG8_MMA(1, 0, At, B0); PG8_MMA(1, 1, At, B1); PG8_BAR; PG8_SCHED;
            PG8_LDB(B0, 1, 0); PG8_LDB(B1, 1, 1); PG8_SCHED; PG8_LDA(At, 1, 0); PG8_STAGE(PG8_SA(0, 1), a2 + hstepA, voffA);
            PG8_WAIT_V(8); PG8_WAIT_L(0); PG8_BAR; PG8_MMA(0, 0, At, B0); PG8_MMA(0, 1, At, B1); PG8_BAR; PG8_SCHED;
            PG8_LDA(At, 1, 1); PG8_STAGE(PG8_SB(1, 0), b3, voffB); PG8_STAGE(PG8_SB(1, 1), b3 + hstepB, voffB); PG8_STAGE(PG8_SA(1, 0), a3, voffA);
            PG8_WAIT_V(8); PG8_WAIT_L(0); PG8_BAR; PG8_MMA(1, 0, At, B0); PG8_MMA(1, 1, At, B1); PG8_BAR; PG8_SCHED;
            } else {
            PG8_LDB(B0, 0, 0); PG8_SCHED; PG8_LDA(At, 0, 0); PG8_STAGE(PG8_SA(1, 1), a1 + hstepA, voffA);
            PG8_WAIT_L(8); PG8_BAR; PG8_WAIT_L(0); PG8_MMA(0, 0, At, B0); PG8_BAR; PG8_SCHED;
            PG8_LDB(B1, 0, 1); PG8_STAGE(PG8_SB(0, 0), b2, voffB);
            PG8_BAR; PG8_WAIT_L(0); PG8_MMA(0, 1, At, B1); PG8_BAR;
            PG8_LDA(At, 0, 1); PG8_STAGE(PG8_SA(0, 0), a2, voffA);
            PG8_BAR; PG8_WAIT_L(0); PG8_MMA(1, 0, At, B0); PG8_BAR; PG8_SCHED;
            PG8_STAGE(PG8_SB(0, 1), b2 + hstepB, voffB);
            PG8_WAIT_V(6); PG8_BAR; PG8_MMA(1, 1, At, B1); PG8_BAR;
            PG8_LDB(B0, 1, 0); PG8_SCHED; PG8_LDA(At, 1, 0); PG8_STAGE(PG8_SA(0, 1), a2 + hstepA, voffA);
            PG8_WAIT_L(8); PG8_BAR; PG8_WAIT_L(0); PG8_MMA(0, 0, At, B0); PG8_BAR; PG8_SCHED;
            PG8_LDB(B1, 1, 1); PG8_STAGE(PG8_SB(1, 0), b3, voffB);
            PG8_BAR; PG8_WAIT_L(0); PG8_MMA(0, 1, At, B1); PG8_BAR;
            PG8_LDA(At, 1, 1); PG8_STAGE(PG8_SA(1, 0), a3, voffA);
            PG8_BAR; PG8_WAIT_L(0); PG8_MMA(1, 0, At, B0); PG8_BAR; PG8_SCHED;
            PG8_STAGE(PG8_SB(1, 1), b3 + hstepB, voffB);
            PG8_WAIT_V(6); PG8_BAR; PG8_MMA(1, 1, At, B1); PG8_BAR;
            }
        }
        if constexpr (ALIGN_EPI) { if (wr == 0) PG8_BAR; }
        if constexpr (EXTACC == 1) E.inplace(acc, cur, wr, wc, fr, fq); else E(acc, cur, wr, wc, fr, fq);
        if (!has_next || EXTACC != 0) break;
#pragma unroll
        for (int a = 0; a < 2; ++a)
#pragma unroll
            for (int b = 0; b < 2; ++b)
#pragma unroll
                for (int m = 0; m < 4; ++m)
#pragma unroll
                    for (int n = 0; n < 2; ++n) acc[a][b][m][n] = (f32x4){0.f, 0.f, 0.f, 0.f};
        cur = nxt; cA = nA; cB = nB; ++ui;
        if constexpr (ALIGN_EPI) { if (wr == 1) PG8_BAR; }
    }
    PG8_WAIT_V(0);
    if constexpr (!ALIGN_EPI) { if (wr == 0) PG8_BAR; }
    PG8_BAR;
#undef PG8_SA
#undef PG8_SB
#undef PG8_STAGE
#undef PG8_LDA
#undef PG8_LDB
#undef PG8_MMA
#undef PG8_WAIT_V
#undef PG8_WAIT_L
#undef PG8_BAR
#undef PG8_SCHED
}
}

constexpr int DM = 1024, NB = 8, SEQ = 2048, MTOK = NB * SEQ, CTXL = 256, MCTX = NB * CTXL;
constexpr int HGD = 512, DFF = 2816, DFF2 = 5632, INDIM = 5120, NMOD = 6;
constexpr float EPSN = 1e-6f;
constexpr int NWAVES = 8, NTHR = 512;
constexpr int LDS_BYTES = 147456;
#ifndef DUP_MASK
#define DUP_MASK 0
#endif
#define REPS(k) ((((DUP_MASK) >> (k)) & 1) ? 2 : 1)
#ifndef PROBE_K
#define PROBE_K -1
#endif
#ifndef EXTRA_SYNCS
#define EXTRA_SYNCS 0
#endif

constexpr size_t MiB = 1u << 20;
constexpr size_t WS_MX = 0;
constexpr size_t WS_LB = 256 * 1024;
constexpr size_t WS_WFS = 2 * MiB, WS_TCH = 3 * MiB;
constexpr size_t WS_BAR = 512 * 1024, BAR_BYTES = 32768;
constexpr int MISC_OFF = 147456 - 128;
constexpr size_t WS_WIN = 6 * MiB;
constexpr size_t WS_WPQ = 16 * MiB;
constexpr size_t WS_WA = 18 * MiB, WS_WB = 19 * MiB, WS_WOUT = 20 * MiB;
constexpr size_t WS_CS = 22 * MiB;
constexpr size_t WS_WUP = 6 * MiB;
constexpr size_t WS_WDN = 250 * MiB;
constexpr size_t WS_HX = 38 * MiB;
constexpr size_t WS_OF = 38 * MiB, WS_OB = 54 * MiB;
constexpr size_t WS_TMP = 38 * MiB;
constexpr size_t WS_H2 = 38 * MiB;
constexpr size_t WS_Q = 74 * MiB, WS_V = 90 * MiB, WS_OG = 106 * MiB, WS_GA = 122 * MiB, WS_GBG = 154 * MiB, WS_PQT = 186 * MiB;
constexpr size_t WS_GFC = 218 * MiB, WS_GBC = 222 * MiB, WS_VC = 226 * MiB;
constexpr size_t WS_YF = 228 * MiB;
constexpr size_t WS_YH = 74 * MiB;
constexpr size_t WS_MRG = 186 * MiB;
constexpr size_t WS_Z = 74 * MiB;
constexpr size_t WS_A2 = 162 * MiB;
constexpr size_t WS_XO = 38 * MiB;
constexpr size_t WS_END = 256 * MiB;

typedef unsigned short bf16;
typedef float f32x4 __attribute__((ext_vector_type(4)));
typedef unsigned u32x4 __attribute__((ext_vector_type(4)));
typedef unsigned u32x2 __attribute__((ext_vector_type(2)));
typedef float f32x2 __attribute__((ext_vector_type(2)));
#define LAS __attribute__((address_space(3)))

struct Params {
    const float* in[19];
    float* out;
    unsigned char* ws;
};

__device__ __forceinline__ float bf2f(unsigned short b) { return __uint_as_float(((unsigned)b) << 16); }
__device__ __forceinline__ float bflo(unsigned w) { return __uint_as_float(w << 16); }
__device__ __forceinline__ float bfhi(unsigned w) { return __uint_as_float(w & 0xffff0000u); }
__device__ __forceinline__ unsigned f2bf(float f) { unsigned u = __float_as_uint(f); return (u + 0x7fffu + ((u >> 16) & 1u)) >> 16; }
__device__ __forceinline__ unsigned pk2(float lo, float hi);
typedef __bf16 bf16x2_t __attribute__((ext_vector_type(2)));
__device__ __forceinline__ unsigned hwpk2(float lo, float hi) { const f32x2 v = {lo, hi}; const bf16x2_t r = __builtin_convertvector(v, bf16x2_t); return __builtin_bit_cast(unsigned, r); }
__device__ __forceinline__ unsigned pk2(float lo, float hi) { return hwpk2(lo, hi); }
__device__ __forceinline__ float sigmoidf_(float x) { return __builtin_amdgcn_rcpf(1.f + __expf(-x)); }
__device__ __forceinline__ float siluf_(float x) { return x * __builtin_amdgcn_rcpf(1.f + __expf(-x)); }
__device__ __forceinline__ float wave_sum(float v) {
#pragma unroll
    for (int o = 1; o < 64; o <<= 1) v += __shfl_xor(v, o);
    return v;
}
__device__ __forceinline__ u32x4 pack8(const f32x4 a, const f32x4 b) { u32x4 w; w.x = pk2(a[0], a[1]); w.y = pk2(a[2], a[3]); w.z = pk2(b[0], b[1]); w.w = pk2(b[2], b[3]); return w; }

typedef __attribute__((address_space(1))) unsigned gu32;
#define XB_TMO      128
#define XB_XCNT(j)  (256  + 64 * (j))
#define XB_XSUB(j)  (1280 + 64 * (j))
#define XB_XGEN(j)  (2304 + 64 * (j))
#define XB_TOP      3328
#define XB_TOPGEN   3392
#define XCD_BAR_WORDS 3456
#define XB_SPIN_CAP (1u << 18)

__device__ __forceinline__ unsigned xb_ld(unsigned* p)              { return __hip_atomic_load(p, __ATOMIC_RELAXED, __HIP_MEMORY_SCOPE_AGENT); }
__device__ __forceinline__ unsigned xb_add(unsigned* p, unsigned v) { return __hip_atomic_fetch_add(p, v, __ATOMIC_RELAXED, __HIP_MEMORY_SCOPE_AGENT); }
__device__ __forceinline__ unsigned xb_xcc_id() { return (unsigned)__builtin_amdgcn_s_getreg((3 << 11) | 20) & 0xFu; }
#define XB_SPIN(cond, bar) do { unsigned _sp = 0; while (cond) { __builtin_amdgcn_s_sleep(1); \
    if ((++_sp & 255u) == 0u) { if (xb_ld(&(bar)[XB_TMO])) break; if (_sp > XB_SPIN_CAP) { atomicAdd(&(bar)[XB_TMO], 1u); break; } } } } while (0)

struct XcdBarrier {
    unsigned* bar; unsigned x;
    volatile LAS unsigned* st;
};

__device__ __forceinline__ XcdBarrier xcd_barrier_post(unsigned* bar, volatile LAS unsigned* st) {
    XcdBarrier b; b.bar = bar; b.x = xb_xcc_id(); b.st = st;
    if (threadIdx.x == 0) (void)xb_add(&bar[XB_XCNT(b.x)], 1u);
    return b;
}
__device__ __forceinline__ void xcd_barrier_complete(unsigned* bar, unsigned x, unsigned& nloc, unsigned& nx) {
    const unsigned G = gridDim.x * gridDim.y * gridDim.z;
    unsigned sum, cnt, mine, sp = 0u;
    for (;;) {
        sum = 0u; cnt = 0u; mine = 0u;
#pragma unroll
        for (unsigned j = 0; j < 16; ++j) { const unsigned c = xb_ld(&bar[XB_XCNT(j)]); sum += c; cnt += (c > 0u) ? 1u : 0u; mine = (j == x) ? c : mine; }
        if (sum == G) break;
        __builtin_amdgcn_s_sleep(1);
        if ((++sp & 255u) == 0u) { if (xb_ld(&bar[XB_TMO])) break; if (sp > XB_SPIN_CAP) { atomicAdd(&bar[XB_TMO], 1u); break; } }
    }
    nloc = mine > 0u ? mine : 1u; nx = cnt > 0u ? cnt : 1u;
}

__device__ __forceinline__ void xcd_barrier(const XcdBarrier& b) {
    asm volatile("s_waitcnt vmcnt(0)" ::: "memory");
    __syncthreads();
    if (threadIdx.x == 0) {
        unsigned* bar = b.bar;
        __builtin_amdgcn_s_waitcnt(0);
        unsigned nloc = b.st[0], nx = b.st[1];
        if (nloc == 0u) { xcd_barrier_complete(bar, b.x, nloc, nx); b.st[0] = nloc; b.st[1] = nx; }
        const unsigned old = xb_add(&bar[XB_XSUB(b.x)], 1u);
        const unsigned gen = old / nloc;
        if (old + 1u == (gen + 1u) * nloc) {
            __builtin_amdgcn_fence(__ATOMIC_RELEASE, "agent");
            asm volatile("s_waitcnt vmcnt(0)" ::: "memory");
            const unsigned og = xb_add(&bar[XB_TOP], 1u);
            const unsigned tg = og / nx;
            if (og + 1u == (tg + 1u) * nx) xb_add(&bar[XB_TOPGEN], 1u);
            else XB_SPIN(xb_ld(&bar[XB_TOPGEN]) == tg, bar);
            __builtin_amdgcn_fence(__ATOMIC_ACQUIRE, "agent");
            xb_add(&bar[XB_XGEN(b.x)], 1u);
            asm volatile("s_waitcnt vmcnt(0)" ::: "memory");
        } else {
            XB_SPIN(xb_ld(&bar[XB_XGEN(b.x)]) == gen, bar);
            __builtin_amdgcn_fence(__ATOMIC_ACQUIRE, "agent");
            asm volatile("s_waitcnt vmcnt(0)" ::: "memory");
        }
    }
    __syncthreads();
}


struct FIn {
    unsigned char* ws; float* out;
    __device__ __forceinline__ void operator()(const pg8::Unit& u, int row, int col, f32x4 v0, f32x4 v1) const {
        const int seg = u.pn >> 1, c = col & 511;
        if (seg == 0 || seg == 4) { f32x4 a, b;
#pragma unroll
            for (int i = 0; i < 4; ++i) { a[i] = siluf_(v0[i]); b[i] = siluf_(v1[i]); }
            bf16* dst = (bf16*)(ws + (seg == 0 ? WS_Q : WS_OG));
            *(u32x4*)(dst + (size_t)row * 512 + c) = pack8(a, b);
        } else if (seg == 1 || seg == 2) {
            const float* lb = (const float*)(ws + WS_LB);
            const f32x4 l0 = *(const f32x4*)(lb + c), l1 = *(const f32x4*)(lb + c + 4); f32x4 a, b;
#pragma unroll
            for (int i = 0; i < 4; ++i) { a[i] = l0[i] + (1.f - l0[i]) * sigmoidf_(v0[i]); b[i] = l1[i] + (1.f - l1[i]) * sigmoidf_(v1[i]); }
            float* dst;
            if (u.pm < 64) dst = out + (seg == 1 ? (size_t)0 : (size_t)MTOK * 512) + (size_t)row * 512 + c;
            else dst = (float*)(ws + (seg == 1 ? WS_GFC : WS_GBC)) + (size_t)(row - MTOK) * 512 + c;
            *(f32x4*)dst = a; *(f32x4*)(dst + 4) = b;
        } else if (seg == 3) {
            bf16* dst;
            if (u.pm < 64) dst = (bf16*)(ws + WS_V) + (size_t)row * 512 + c; else dst = (bf16*)(ws + WS_VC) + (size_t)(row - MTOK) * 512 + c;
            *(u32x4*)dst = pack8(v0, v1);
        } else { f32x4 a, b;
#pragma unroll
            for (int i = 0; i < 4; ++i) { a[i] = sigmoidf_(v0[i]); b[i] = sigmoidf_(v1[i]); }
            bf16* dst = (seg < 7) ? ((bf16*)(ws + WS_GA) + (size_t)row * 1024 + (col - 5 * 512)) : ((bf16*)(ws + WS_GBG) + (size_t)row * 1024 + (col - 7 * 512));
            *(u32x4*)dst = pack8(a, b);
        }
    }
};
struct FPQ {
    bf16* pqt;
    __device__ __forceinline__ void operator()(const pg8::Unit&, int row, int col, f32x4 v0, f32x4 v1) const {
        bf16* dst = pqt + (size_t)(row & 511) * 32768 + (size_t)(col >> 11) * 4096 + (size_t)(row >> 9) * 1024 + ((col & 2047) >> 1);
        u32x2 ev, od; ev.x = pk2(v0[0], v0[2]); ev.y = pk2(v1[0], v1[2]); od.x = pk2(v0[1], v0[3]); od.y = pk2(v1[1], v1[3]);
        *(u32x2*)dst = ev; *(u32x2*)(dst + 2048) = od;
    }
};
struct EpiDft {
    static constexpr bool PERM = true;
    bf16* yf; unsigned* flags;
    __device__ __forceinline__ void operator()(const f32x4 (&acc)[2][2][4][2], const pg8::Unit& u, int wr, int wc, int fr, int fq) const {
        const int z = u.z & 255, eo = u.z >> 8, pair = (z * 4 + u.pm) * 2 + u.pn;
        const int row0 = u.pm * 256 + wr * 64 + fr, col0 = u.pn * 256 + wc * 32 + 8 * fq;
        unsigned* flag = flags + pair * 16;
        if (eo) {
#pragma unroll
            for (int ai = 0; ai < 2; ++ai)
#pragma unroll
                for (int m = 0; m < 4; ++m)
#pragma unroll
                    for (int bj = 0; bj < 2; ++bj) { const int row = row0 + ai * 128 + m * 16, col = col0 + bj * 128;
                        *(u32x4*)(yf + ((size_t)z * SEQ + 1024 + row) * 512 + col) = pack8(acc[ai][bj][m][0] * (1.f / 512.f), acc[ai][bj][m][1] * (1.f / 512.f)); }
            asm volatile("s_waitcnt vmcnt(0)" ::: "memory");
            __syncthreads();
            if (threadIdx.x == 0) { __builtin_amdgcn_fence(__ATOMIC_RELEASE, "agent"); asm volatile("s_waitcnt vmcnt(0)" ::: "memory");
                __hip_atomic_store(flag, 1u, __ATOMIC_RELAXED, __HIP_MEMORY_SCOPE_AGENT); }
        } else {
            if (threadIdx.x == 0) { unsigned spins = 0;
                while (__hip_atomic_load(flag, __ATOMIC_RELAXED, __HIP_MEMORY_SCOPE_AGENT) == 0u && ++spins < (1u << 22)) __builtin_amdgcn_s_sleep(2);
                __builtin_amdgcn_fence(__ATOMIC_ACQUIRE, "agent"); asm volatile("s_waitcnt vmcnt(0)" ::: "memory"); }
            __syncthreads();
#pragma unroll
            for (int ai = 0; ai < 2; ++ai)
#pragma unroll
                for (int m = 0; m < 4; ++m) {
#pragma unroll
                    for (int bj = 0; bj < 2; ++bj) { const int row = row0 + ai * 128 + m * 16, col = col0 + bj * 128;
                        bf16* plo = yf + ((size_t)z * SEQ + row) * 512 + col; bf16* phi = plo + (size_t)1024 * 512;
                        const u32x4 o = *(const u32x4*)phi;
                        const f32x4 e0 = acc[ai][bj][m][0] * (1.f / 512.f), e1 = acc[ai][bj][m][1] * (1.f / 512.f);
                        f32x4 o0, o1; o0[0] = bflo(o.x); o0[1] = bfhi(o.x); o0[2] = bflo(o.y); o0[3] = bfhi(o.y); o1[0] = bflo(o.z); o1[1] = bfhi(o.z); o1[2] = bflo(o.w); o1[3] = bfhi(o.w);
                        *(u32x4*)plo = pack8(e0 + o0, e1 + o1); *(u32x4*)phi = pack8(e0 - o0, e1 - o1); }
                    asm volatile("" ::: "memory"); }
        }
    }
};
struct FYa {
    const bf16* ga;
    __device__ __forceinline__ void scale(const pg8::Unit&, int row, int col, f32x4& v0, f32x4& v1) const {
        const size_t o = (size_t)row * 1024 + col; const u32x4 g = *(const u32x4*)(ga + o);
        v0[0] *= bflo(g.x); v0[1] *= bfhi(g.x); v0[2] *= bflo(g.y); v0[3] *= bfhi(g.y); v1[0] *= bflo(g.z); v1[1] *= bfhi(g.z); v1[2] *= bflo(g.w); v1[3] *= bfhi(g.w);
    }
    __device__ __forceinline__ void operator()(const pg8::Unit&, int, int, f32x4, f32x4) const {}
};
struct FYb {
    const bf16* gbg; bf16* mrg;
    __device__ __forceinline__ void scale(const pg8::Unit&, int row, int col, f32x4& v0, f32x4& v1) const {
        const size_t o = (size_t)row * 1024 + col; const u32x4 h = *(const u32x4*)(gbg + o);
        v0[0] *= __builtin_amdgcn_rcpf(bflo(h.x)); v0[1] *= __builtin_amdgcn_rcpf(bfhi(h.x)); v0[2] *= __builtin_amdgcn_rcpf(bflo(h.y)); v0[3] *= __builtin_amdgcn_rcpf(bfhi(h.y));
        v1[0] *= __builtin_amdgcn_rcpf(bflo(h.z)); v1[1] *= __builtin_amdgcn_rcpf(bfhi(h.z)); v1[2] *= __builtin_amdgcn_rcpf(bflo(h.w)); v1[3] *= __builtin_amdgcn_rcpf(bfhi(h.w));
    }
    __device__ __forceinline__ void operator()(const pg8::Unit&, int row, int col, f32x4 v0, f32x4 v1) const {
        const size_t o = (size_t)row * 1024 + col; const u32x4 h = *(const u32x4*)(gbg + o);
        f32x4 a, b; a[0] = v0[0] * bflo(h.x); a[1] = v0[1] * bfhi(h.x); a[2] = v0[2] * bflo(h.y); a[3] = v0[3] * bfhi(h.y);
        b[0] = v1[0] * bflo(h.z); b[1] = v1[1] * bfhi(h.z); b[2] = v1[2] * bflo(h.w); b[3] = v1[3] * bfhi(h.w);
        *(u32x4*)(mrg + o) = pack8(a, b);
    }
};
struct FYab {
    const bf16* ga; const bf16* gbg;
    __device__ __forceinline__ void scale(const pg8::Unit&, int row, int col, f32x4& v0, f32x4& v1) const {
        const size_t o = (size_t)row * 1024 + col; const u32x4 g = *(const u32x4*)(ga + o), h = *(const u32x4*)(gbg + o);
        v0[0] *= bflo(g.x) * __builtin_amdgcn_rcpf(bflo(h.x)); v0[1] *= bfhi(g.x) * __builtin_amdgcn_rcpf(bfhi(h.x)); v0[2] *= bflo(g.y) * __builtin_amdgcn_rcpf(bflo(h.y)); v0[3] *= bfhi(g.y) * __builtin_amdgcn_rcpf(bfhi(h.y));
        v1[0] *= bflo(g.z) * __builtin_amdgcn_rcpf(bflo(h.z)); v1[1] *= bfhi(g.z) * __builtin_amdgcn_rcpf(bfhi(h.z)); v1[2] *= bflo(g.w) * __builtin_amdgcn_rcpf(bflo(h.w)); v1[3] *= bfhi(g.w) * __builtin_amdgcn_rcpf(bfhi(h.w));
    }
    __device__ __forceinline__ void operator()(const pg8::Unit&, int, int, f32x4, f32x4) const {}
};
struct FYaT {
    const bf16* ga; bf16* tmp;
    __device__ __forceinline__ void operator()(const pg8::Unit&, int row, int col, f32x4 v0, f32x4 v1) const {
        const size_t o = (size_t)row * 1024 + col; const u32x4 g = *(const u32x4*)(ga + o);
        f32x4 a, b; a[0] = v0[0] * bflo(g.x); a[1] = v0[1] * bfhi(g.x); a[2] = v0[2] * bflo(g.y); a[3] = v0[3] * bfhi(g.y);
        b[0] = v1[0] * bflo(g.z); b[1] = v1[1] * bfhi(g.z); b[2] = v1[2] * bflo(g.w); b[3] = v1[3] * bfhi(g.w);
        *(u32x4*)(tmp + o) = pack8(a, b);
    }
};
struct FYbT {
    const bf16* gbg; const bf16* tmp; bf16* mrg;
    __device__ __forceinline__ void operator()(const pg8::Unit&, int row, int col, f32x4 v0, f32x4 v1) const {
        const size_t o = (size_t)row * 1024 + col; const u32x4 g = *(const u32x4*)(gbg + o); const u32x4 t = *(const u32x4*)(tmp + o);
        f32x4 a, b; a[0] = bflo(t.x) + v0[0] * bflo(g.x); a[1] = bfhi(t.x) + v0[1] * bfhi(g.x); a[2] = bflo(t.y) + v0[2] * bflo(g.y); a[3] = bfhi(t.y) + v0[3] * bfhi(g.y);
        b[0] = bflo(t.z) + v1[0] * bflo(g.z); b[1] = bfhi(t.z) + v1[1] * bfhi(g.z); b[2] = bflo(t.w) + v1[2] * bflo(g.w); b[3] = bfhi(t.w) + v1[3] * bfhi(g.w);
        *(u32x4*)(mrg + o) = pack8(a, b);
    }
};
struct FRes {
    const float* src; float* dst; const float* mx; int mod;
    __device__ __forceinline__ void operator()(const pg8::Unit&, int row, int col, f32x4 v0, f32x4 v1) const {
        const size_t o = (size_t)row * 1024 + col; const float* m = mx + (size_t)(row >> 11) * (NMOD * DM) + mod * DM + col;
        const f32x4 m0 = *(const f32x4*)m, m1 = *(const f32x4*)(m + 4), s0 = *(const f32x4*)(src + o), s1 = *(const f32x4*)(src + o + 4);
        *(f32x4*)(dst + o) = s0 + m0 * v0; *(f32x4*)(dst + o + 4) = s1 + m1 * v1;
    }
};
struct FUp {
    bf16* z; int ld;
    __device__ __forceinline__ void operator()(const pg8::Unit&, int row, int col, f32x4 v0, f32x4 v1) const {
        *(u32x4*)(z + (size_t)row * ld + col) = pack8(v0, v1);
    }
};

__device__ __forceinline__ void transpose_item(const float* W, int K, int N, bf16* WT, LAS float* scr, int item, int lane) {
    const int nblk = N / 32, kb = item / nblk, nb = item % nblk, k0 = 64 * kb, n0 = 32 * nb;
#pragma unroll 8
    for (int i = 0; i < 32; ++i) { const int kk = 2 * i + (lane >> 5); scr[kk * 33 + (lane & 31)] = W[(size_t)(k0 + kk) * N + n0 + (lane & 31)]; }
    asm volatile("s_waitcnt lgkmcnt(0)" ::: "memory");
    const int c = lane & 7;
#pragma unroll
    for (int j = 0; j < 4; ++j) { const int n = (lane >> 3) + 8 * j; const LAS float* s = scr + (8 * c) * 33 + n;
        u32x4 o; o.x = pk2(s[0 * 33], s[1 * 33]); o.y = pk2(s[2 * 33], s[3 * 33]); o.z = pk2(s[4 * 33], s[5 * 33]); o.w = pk2(s[6 * 33], s[7 * 33]);
        *(u32x4*)(WT + (size_t)(n0 + n) * K + k0 + 8 * c) = o; }
    asm volatile("s_waitcnt lgkmcnt(0)" ::: "memory");
}

template <bool MOD>
__device__ __forceinline__ void norm_rows(const float* srcA, const float* srcB, int nA, const float* g, const float* mx, int shift_mod, int scale_mod,
                                          bf16* outb, float* outf, int r0, int nr, int lane) {
    f32x4 G[4], SH[4], cur[4], nxt[4];
    int curmod = -1;
    { const float* s0 = (r0 < nA) ? srcA + (size_t)r0 * DM : srcB + (size_t)(r0 - nA) * DM;
#pragma unroll
      for (int j = 0; j < 4; ++j) cur[j] = *(const f32x4*)(s0 + (lane + 64 * j) * 4); }
#pragma unroll 1
    for (int i = 0; i < nr; ++i) {
        const int m = r0 + i;
        if (i + 1 < nr) { const int m1 = m + 1; const float* s1 = (m1 < nA) ? srcA + (size_t)m1 * DM : srcB + (size_t)(m1 - nA) * DM;
#pragma unroll
            for (int j = 0; j < 4; ++j) nxt[j] = *(const f32x4*)(s1 + (lane + 64 * j) * 4); }
        const int mr = MOD ? ((m < nA) ? (m >> 11) : 8) : 0;
        if (mr != curmod) { curmod = mr;
#pragma unroll
            for (int j = 0; j < 4; ++j) { const int e = (lane + 64 * j) * 4; const f32x4 gg = *(const f32x4*)(g + e);
                if (MOD) { const f32x4 sc = *(const f32x4*)(mx + (size_t)mr * (NMOD * DM) + scale_mod * DM + e); SH[j] = *(const f32x4*)(mx + (size_t)mr * (NMOD * DM) + shift_mod * DM + e); G[j] = gg * (sc + 1.f); }
                else { G[j] = gg; SH[j] = (f32x4){0.f, 0.f, 0.f, 0.f}; } } }
        float s = 0.f;
#pragma unroll
        for (int j = 0; j < 4; ++j) s += (cur[j][0] * cur[j][0] + cur[j][1] * cur[j][1]) + (cur[j][2] * cur[j][2] + cur[j][3] * cur[j][3]);
        const float rinv = rsqrtf(wave_sum(s) * (1.f / DM) + EPSN);
#pragma unroll
        for (int j = 0; j < 4; ++j) { const int e = (lane + 64 * j) * 4; const f32x4 h = cur[j] * rinv * G[j] + SH[j];
            if (MOD) { u32x2 w; w.x = pk2(h[0], h[1]); w.y = pk2(h[2], h[3]); *(u32x2*)(outb + (size_t)m * DM + e) = w; }
            else *(f32x4*)(outf + (size_t)m * DM + e) = h; }
#pragma unroll
        for (int j = 0; j < 4; ++j) cur[j] = nxt[j];
    }
}

__device__ __forceinline__ void phase0(const Params& p, unsigned char* lds, int tid, int lane, int wave, int G, const int part) {
    float* ldsf = (float*)lds;
    float* mxo = (float*)(p.ws + WS_MX);
    if (part == 0) {
    for (int it = blockIdx.x; it < 192; it += G) {
        __syncthreads();
        {
            const float* c = p.in[1]; const float* cc = p.in[3]; const float* aw = p.in[4]; const float* ab = p.in[5];
            float* sc = ldsf;
            float* red = ldsf + 9 * 1024;
            for (int i = tid; i < 9 * 1024; i += NTHR) { const int r = i >> 10, k = i & 1023; const float cv = (r < 8) ? c[r * 1024 + k] : cc[k]; sc[i] = cv / (1.f + __expf(-cv)); }
            __syncthreads();
            const int n0 = it * 32, col = tid & 31, ks = tid >> 5;
            float a[9];
#pragma unroll
            for (int r = 0; r < 9; ++r) a[r] = 0.f;
            for (int k = ks * 64; k < ks * 64 + 64; ++k) { const float w = aw[(size_t)k * (NMOD * DM) + n0 + col];
#pragma unroll
                for (int r = 0; r < 9; ++r) a[r] += sc[r * 1024 + k] * w; }
#pragma unroll
            for (int r = 0; r < 9; ++r) red[(ks * 9 + r) * 32 + col] = a[r];
            __syncthreads();
            if (tid < 288) { const int r = tid >> 5, cl = tid & 31; float s = ab[n0 + cl];
                for (int k2 = 0; k2 < 16; ++k2) s += red[(k2 * 9 + r) * 32 + cl];
                mxo[r * (NMOD * DM) + n0 + cl] = s; }
        }
    }
    __syncthreads();
    { bf16* tch = (bf16*)(p.ws + WS_TCH); bf16* wfs = (bf16*)(p.ws + WS_WFS); const float* win = p.in[7];
      for (int i = blockIdx.x * NTHR + tid; i < 1024 * 64; i += G * NTHR) { const int n = i >> 6, c8 = (i & 63) * 8, gn = (n & 511) >> 7, j = n & 127; float vv[8];
#pragma unroll
          for (int e = 0; e < 8; ++e) { const int cp = c8 + e, idx = ((cp & 127) * j) & 127; const float ang = (float)idx * (1.f / 64.f);
              vv[e] = ((cp >> 7) == gn) ? ((n < 512) ? cospif(ang) : sinpif(ang)) : 0.f; }
          u32x4 w; w.x = pk2(vv[0], vv[1]); w.y = pk2(vv[2], vv[3]); w.z = pk2(vv[4], vv[5]); w.w = pk2(vv[6], vv[7]);
          *(u32x4*)(tch + (size_t)n * 512 + c8) = w;
          const f32x4 a = *(const f32x4*)(win + (size_t)n * INDIM + c8), b2 = *(const f32x4*)(win + (size_t)n * INDIM + c8 + 4);
          *(u32x4*)(wfs + (size_t)n * 512 + c8) = pack8(a, b2); } }
    }
    if (part == 0 && blockIdx.x == G - 1) { const float* hl = p.in[8]; float* lbo = (float*)(p.ws + WS_LB);
        if (tid < 512) { const float a = hl[tid], b = hl[512 + tid]; lbo[tid] = 1.f / (1.f + expf(b - a)); } }
    if (part == 0) return;
    { bf16* cs = (bf16*)(p.ws + WS_CS);
      for (int i = blockIdx.x * NTHR + tid; i < 2 * 1024 * 256; i += G * NTHR) { const int eo = i >> 18, l = (i >> 8) & 1023, kc = (i & 255) * 8; float vv[8];
#pragma unroll
          for (int e = 0; e < 8; ++e) { const int k = kc + e, sn = k >> 10, m = k & 1023;
              const float ang = eo ? (float)((l * (2 * m + 1)) & 2047) * (1.f / 1024.f) : (float)((l * m) & 1023) * (1.f / 512.f);
              vv[e] = sn ? -sinpif(ang) : cospif(ang); }
          u32x4 w; w.x = pk2(vv[0], vv[1]); w.y = pk2(vv[2], vv[3]); w.z = pk2(vv[4], vv[5]); w.w = pk2(vv[6], vv[7]);
          *(u32x4*)(cs + ((size_t)eo * 1024 + l) * 2048 + kc) = w; } }
    { LAS float* scr = (LAS float*)((LAS unsigned char*)lds + wave * 16384);
      const int gw = blockIdx.x * NWAVES + wave, NGW = G * NWAVES;
      constexpr int I_IN = 16 * 160, I_A = 8 * 32, I_B = 8 * 32, I_O = 16 * 32;
      for (int it = gw; it < ((G >= 192) ? I_IN : I_IN + I_A + I_B + I_O); it += NGW) { int r = it;
          if (r < I_IN) { transpose_item(p.in[7], 1024, INDIM, (bf16*)(p.ws + WS_WIN), scr, r, lane); continue; } r -= I_IN;
          if (r < I_A) { transpose_item(p.in[10], 512, 1024, (bf16*)(p.ws + WS_WA), scr, r, lane); continue; } r -= I_A;
          if (r < I_B) { transpose_item(p.in[11], 512, 1024, (bf16*)(p.ws + WS_WB), scr, r, lane); continue; } r -= I_B;
          transpose_item(p.in[12], 1024, 1024, (bf16*)(p.ws + WS_WOUT), scr, r, lane); } }
}

__device__ __forceinline__ void hgrn_mfma_item(const Params& p, unsigned char* lds, int item) {
    int tid_ = threadIdx.x; asm volatile("" : "+v"(tid_));
    const int tid = tid_, lane = tid & 63, w = __builtin_amdgcn_readfirstlane(tid >> 6), fr = lane & 15, fq = lane >> 4;
    const int vh = item & 1, dir = (item >> 1) & 1, h = (item >> 2) & 3, b = item >> 4;
    bf16* Qs = (bf16*)lds;
    bf16* Ks = Qs + 64 * 136;
    bf16* St = Ks + 64 * 136;
    bf16* Kh = St + 2 * 64 * 136;
    bf16* Vt = Kh + 128 * 72;
    bf16* Ps = Vt + 64 * 72;
    float* Et = (float*)(Ps + 64 * 72);
    float* Fr = Et + 128;
    float* Bt = Fr + 64 * 132;
    const int d = 16 * w + fr;
    const float* fL = p.out + (dir ? (size_t)MTOK * 512 : 0) + (size_t)b * SEQ * 512 + h * 128;
    const float* fC = (const float*)(p.ws + (dir ? WS_GBC : WS_GFC)) + (size_t)b * CTXL * 512 + h * 128;
    const bf16* qL = (const bf16*)(p.ws + WS_Q) + (size_t)b * SEQ * 512 + h * 128;
    const bf16* vL = (const bf16*)(p.ws + WS_V) + (size_t)b * SEQ * 512 + h * 128 + vh * 64;
    const bf16* vC = (const bf16*)(p.ws + WS_VC) + (size_t)b * CTXL * 512 + h * 128 + vh * 64;
    bf16* oL = (bf16*)(p.ws + (dir ? WS_OB : WS_OF)) + (size_t)b * SEQ * 512 + h * 128 + vh * 64;
    f32x4 Sa[4];
#pragma unroll
    for (int i = 0; i < 4; ++i) Sa[i] = (f32x4){0.f, 0.f, 0.f, 0.f};
    f32x4 fR[4]; u32x4 qR[2], vR;
#define HG_LOAD(cc_) do { const int _cc = (cc_); const bool _lat = _cc >= 4; const int _c = _lat ? _cc - 4 : _cc, _n = _lat ? SEQ : CTXL; \
        const float* _f = _lat ? fL : fC; const bf16* _v = _lat ? vL : vC; \
        _Pragma("unroll") for (int i = 0; i < 4; ++i) { const int _j = tid + 512 * i, _s = _c * 64 + (_j >> 5), _pos = dir ? (_n - 1 - _s) : _s; fR[i] = *(const f32x4*)(_f + (size_t)_pos * 512 + (_j & 31) * 4); } \
        if (_lat) { _Pragma("unroll") for (int i = 0; i < 2; ++i) { const int _j = tid + 512 * i, _s = _c * 64 + (_j >> 4), _pos = dir ? (_n - 1 - _s) : _s; qR[i] = *(const u32x4*)(qL + (size_t)_pos * 512 + (_j & 15) * 8); } } \
        { const int _s = _c * 64 + lane, _pos = dir ? (_n - 1 - _s) : _s; vR = *(const u32x4*)(_v + (size_t)_pos * 512 + w * 8); } } while (0)
#define HG_STAGE(lat_) do { \
        _Pragma("unroll") for (int i = 0; i < 4; ++i) { const int _j = tid + 512 * i; *(f32x4*)(Fr + (_j >> 5) * 132 + (_j & 31) * 4) = fR[i]; } \
        if (lat_) { _Pragma("unroll") for (int i = 0; i < 2; ++i) { const int _j = tid + 512 * i; *(u32x4*)(Qs + (_j >> 4) * 136 + (_j & 15) * 8) = qR[i]; } } } while (0)
    HG_LOAD(0);
    HG_STAGE(false);
    __syncthreads();
    for (int cc = 0; cc < 36; ++cc) {
        const bool lat = cc >= 4; const int c = lat ? cc - 4 : cc;
        bf16* Scur = St + (cc & 1) * (64 * 136); bf16* Snxt = St + ((cc & 1) ^ 1) * (64 * 136);
        {
            f32x2 fown[8];
#pragma unroll
            for (int i = 0; i < 8; ++i) fown[i] = *(const f32x2*)(Fr + (8 * w + i) * 132 + 2 * lane);
            *(f32x2*)(Bt + w * 128 + 2 * lane) = ((fown[0] * fown[1]) * (fown[2] * fown[3])) * ((fown[4] * fown[5]) * (fown[6] * fown[7]));
            __syncthreads();
            f32x2 cum = (f32x2){1.f, 1.f};
            { f32x2 t[7];
#pragma unroll
              for (int i = 0; i < 7; ++i) t[i] = *(const f32x2*)(Bt + i * 128 + 2 * lane);
#pragma unroll
              for (int i = 0; i < 7; ++i) if (i < w) cum = cum * t[i]; }
            unsigned kp0[4], kp1[4];
#pragma unroll
            for (int i = 0; i < 8; i += 2) { float k0v[2], k1v[2];
#pragma unroll
                for (int u = 0; u < 2; ++u) { const int r = 8 * w + i + u; const f32x2 f = fown[i + u]; cum = cum * f;
                    const float cm0 = fmaxf(cum[0], 1e-30f), cm1 = fmaxf(cum[1], 1e-30f);
                    const float kt0 = (1.f - f[0]) * __builtin_amdgcn_rcpf(cm0), kt1 = (1.f - f[1]) * __builtin_amdgcn_rcpf(cm1);
                    if (lat) { const unsigned qr = *(const unsigned*)(Qs + r * 136 + 2 * lane);
                        *(unsigned*)(Qs + r * 136 + 2 * lane) = hwpk2(bflo(qr) * cm0, bfhi(qr) * cm1); *(unsigned*)(Ks + r * 136 + 2 * lane) = hwpk2(kt0, kt1); }
                    k0v[u] = kt0; k1v[u] = kt1; }
                kp0[i >> 1] = hwpk2(k0v[0], k0v[1]); kp1[i >> 1] = hwpk2(k1v[0], k1v[1]); }
            u32x4 q0; q0.x = kp0[0]; q0.y = kp0[1]; q0.z = kp0[2]; q0.w = kp0[3]; u32x4 q1; q1.x = kp1[0]; q1.y = kp1[1]; q1.z = kp1[2]; q1.w = kp1[3];
            *(u32x4*)(Kh + (2 * lane) * 72 + 8 * w) = q0; *(u32x4*)(Kh + (2 * lane + 1) * 72 + 8 * w) = q1;
            if (w == 7) *(f32x2*)(Et + 2 * lane) = cum;
            Vt[(8 * w + 0) * 72 + lane] = (bf16)(vR.x & 0xffffu); Vt[(8 * w + 1) * 72 + lane] = (bf16)(vR.x >> 16); Vt[(8 * w + 2) * 72 + lane] = (bf16)(vR.y & 0xffffu); Vt[(8 * w + 3) * 72 + lane] = (bf16)(vR.y >> 16);
            Vt[(8 * w + 4) * 72 + lane] = (bf16)(vR.z & 0xffffu); Vt[(8 * w + 5) * 72 + lane] = (bf16)(vR.z >> 16); Vt[(8 * w + 6) * 72 + lane] = (bf16)(vR.w & 0xffffu); Vt[(8 * w + 7) * 72 + lane] = (bf16)(vR.w >> 16);
        }
        if (cc + 1 < 36) HG_LOAD(cc + 1);
        __syncthreads();
        const int ti = w >> 1, x2 = 2 * (w & 1);
        if (lat) {
#pragma unroll
            for (int u2 = 0; u2 < 2; ++u2) { const int si = x2 + u2; f32x4 acc = (f32x4){0.f, 0.f, 0.f, 0.f};
                if (si <= ti) {
#pragma unroll
                    for (int kk = 0; kk < 4; ++kk) { const pg8::bf16x8 a = *(const pg8::bf16x8*)(Ks + (si * 16 + fr) * 136 + kk * 32 + fq * 8), bq = *(const pg8::bf16x8*)(Qs + (ti * 16 + fr) * 136 + kk * 32 + fq * 8);
                        acc = __builtin_amdgcn_mfma_f32_16x16x32_bf16(a, bq, acc, 0, 0, 0); }
                    if (si == ti) {
#pragma unroll
                        for (int r = 0; r < 4; ++r) if (4 * fq + r > fr) acc[r] = 0.f; } }
                u32x2 pw; pw.x = hwpk2(acc[0], acc[1]); pw.y = hwpk2(acc[2], acc[3]);
                *(u32x2*)(Ps + (ti * 16 + fr) * 72 + si * 16 + 4 * fq) = pw; }
        }
        {
            const f32x4 et = *(const f32x4*)(Et + w * 16 + 4 * fq);
            pg8::bf16x8 ka[2];
#pragma unroll
            for (int kk = 0; kk < 2; ++kk) ka[kk] = *(const pg8::bf16x8*)(Kh + (w * 16 + fr) * 72 + kk * 32 + fq * 8);
#pragma unroll
            for (int vi = 0; vi < 4; ++vi) {
#pragma unroll
                for (int kk = 0; kk < 2; ++kk) { const pg8::bf16x8 bv = *(const pg8::bf16x8*)(Vt + (vi * 16 + fr) * 72 + kk * 32 + fq * 8);
                    Sa[vi] = __builtin_amdgcn_mfma_f32_16x16x32_bf16(ka[kk], bv, Sa[vi], 0, 0, 0); }
                Sa[vi] = Sa[vi] * et;
                u32x2 sw; sw.x = hwpk2(Sa[vi][0], Sa[vi][1]); sw.y = hwpk2(Sa[vi][2], Sa[vi][3]);
                *(u32x2*)(Snxt + (vi * 16 + fr) * 136 + w * 16 + 4 * fq) = sw; }
        }
        f32x4 Oa[2];
        Oa[0] = (f32x4){0.f, 0.f, 0.f, 0.f}; Oa[1] = (f32x4){0.f, 0.f, 0.f, 0.f};
        if (lat) {
#pragma unroll
            for (int kk = 0; kk < 4; ++kk) { const pg8::bf16x8 bq = *(const pg8::bf16x8*)(Qs + (ti * 16 + fr) * 136 + kk * 32 + fq * 8);
#pragma unroll
                for (int u2 = 0; u2 < 2; ++u2) { const pg8::bf16x8 a = *(const pg8::bf16x8*)(Scur + ((x2 + u2) * 16 + fr) * 136 + kk * 32 + fq * 8);
                    Oa[u2] = __builtin_amdgcn_mfma_f32_16x16x32_bf16(a, bq, Oa[u2], 0, 0, 0); } }
        }
        __syncthreads();
        if (lat) {
#pragma unroll
            for (int kk = 0; kk < 2; ++kk) { const pg8::bf16x8 bp = *(const pg8::bf16x8*)(Ps + (ti * 16 + fr) * 72 + kk * 32 + fq * 8);
#pragma unroll
                for (int u2 = 0; u2 < 2; ++u2) { const pg8::bf16x8 a = *(const pg8::bf16x8*)(Vt + ((x2 + u2) * 16 + fr) * 72 + kk * 32 + fq * 8);
                    Oa[u2] = __builtin_amdgcn_mfma_f32_16x16x32_bf16(a, bp, Oa[u2], 0, 0, 0); } }
            const int sg = c * 64 + ti * 16 + fr, pos = dir ? (SEQ - 1 - sg) : sg;
#pragma unroll
            for (int u2 = 0; u2 < 2; ++u2) { u32x2 ow; ow.x = hwpk2(Oa[u2][0], Oa[u2][1]); ow.y = hwpk2(Oa[u2][2], Oa[u2][3]);
                *(u32x2*)(oL + (size_t)pos * 512 + (x2 + u2) * 16 + 4 * fq) = ow; }
        }
        if (cc + 1 < 36) HG_STAGE(cc + 1 >= 4);
        __syncthreads();
    }
#undef HG_LOAD
#undef HG_STAGE
}

__device__ __forceinline__ void phase_yh(const Params& p, int lane, int gw, int NGW) {
    const bf16* of = (const bf16*)(p.ws + WS_OF); const bf16* ob = (const bf16*)(p.ws + WS_OB); const bf16* og = (const bf16*)(p.ws + WS_OG);
    bf16* yh = (bf16*)(p.ws + WS_YH); const float* on = p.in[9];
    const f32x4 n0 = *(const f32x4*)(on + lane * 8), n1 = *(const f32x4*)(on + lane * 8 + 4);
    const int per = (MTOK + NGW - 1) / NGW, r0 = gw * per, nr = min(per, MTOK - r0);
    if (nr <= 0) return;
    u32x4 a = *(const u32x4*)(of + (size_t)r0 * 512 + lane * 8), b = *(const u32x4*)(ob + (size_t)r0 * 512 + lane * 8), gg = *(const u32x4*)(og + (size_t)r0 * 512 + lane * 8);
#pragma unroll 1
    for (int i = 0; i < nr; ++i) { const size_t o = (size_t)(r0 + i) * 512 + lane * 8;
        u32x4 a1 = a, b1 = b, g1 = gg;
        if (i + 1 < nr) { a1 = *(const u32x4*)(of + o + 512); b1 = *(const u32x4*)(ob + o + 512); g1 = *(const u32x4*)(og + o + 512); }
        float v[8]; v[0] = bflo(a.x) + bflo(b.x); v[1] = bfhi(a.x) + bfhi(b.x); v[2] = bflo(a.y) + bflo(b.y); v[3] = bfhi(a.y) + bfhi(b.y);
        v[4] = bflo(a.z) + bflo(b.z); v[5] = bfhi(a.z) + bfhi(b.z); v[6] = bflo(a.w) + bflo(b.w); v[7] = bfhi(a.w) + bfhi(b.w);
        float s = 0.f;
#pragma unroll
        for (int k = 0; k < 8; ++k) s += v[k] * v[k];
        s += __shfl_xor(s, 1); s += __shfl_xor(s, 2); s += __shfl_xor(s, 4); s += __shfl_xor(s, 8);
        const float rinv = rsqrtf(s * (1.f / 128.f) + EPSN);
        float gv[8]; gv[0] = bflo(gg.x); gv[1] = bfhi(gg.x); gv[2] = bflo(gg.y); gv[3] = bfhi(gg.y); gv[4] = bflo(gg.z); gv[5] = bfhi(gg.z); gv[6] = bflo(gg.w); gv[7] = bfhi(gg.w);
        f32x4 q0, q1;
#pragma unroll
        for (int k = 0; k < 4; ++k) { q0[k] = v[k] * rinv * n0[k] * gv[k]; q1[k] = v[4 + k] * rinv * n1[k] * gv[4 + k]; }
        *(u32x4*)(yh + o) = pack8(q0, q1);
        a = a1; b = b1; gg = g1; }
}

struct ConvRaw { u32x2 a[3], g[3]; };
__device__ __forceinline__ void conv_issue(const bf16* z, int tokbase, int r, int cc, int ch, ConvRaw& q) {
#pragma unroll
    for (int i = 0; i < 3; ++i) { const int rr = r + i - 1;
        if (rr >= 0 && rr < 32 && cc >= 0 && cc < 64) { const size_t zo = (size_t)(tokbase + rr * 64 + cc) * DFF2 + ch;
            q.a[i] = *(const u32x2*)(z + zo); q.g[i] = *(const u32x2*)(z + zo + DFF);
        } else { q.a[i] = (u32x2){0u, 0u}; q.g[i] = (u32x2){0u, 0u}; } }
}
__device__ __forceinline__ void phase_conv(const Params& p, int hf, int tid, int G) {
    const bf16* z = (const bf16*)(p.ws + WS_Z); bf16* a2 = (bf16*)(p.ws + WS_A2) + (size_t)hf * 8192 * DFF;
    const float* cw = p.in[15]; const float* cb = p.in[16];
    for (int it = blockIdx.x * NTHR + tid; it < 4 * 32 * 4 * 704; it += G * NTHR) {
        const int cg4 = it % 704, rest = it / 704, strip = rest & 3, r = (rest >> 2) & 31, img = rest >> 7, ch = cg4 * 4, c0 = strip * 16, tokbase = img * 2048;
        ConvRaw ring[3];
#pragma unroll
        for (int j = 0; j < 3; ++j) conv_issue(z, tokbase, r, c0 - 1 + j, ch, ring[j]);
        f32x2 w1[9][2], w2[9][2];
#pragma unroll
        for (int t = 0; t < 9; ++t) { const f32x4 a = *(const f32x4*)(cw + (size_t)t * DFF2 + ch), g = *(const f32x4*)(cw + (size_t)t * DFF2 + DFF + ch);
            w1[t][0] = (f32x2){a[0], a[1]}; w1[t][1] = (f32x2){a[2], a[3]}; w2[t][0] = (f32x2){g[0], g[1]}; w2[t][1] = (f32x2){g[2], g[3]}; }
        const f32x4 b1 = *(const f32x4*)(cb + ch), b2 = *(const f32x4*)(cb + DFF + ch);
        f32x2 W1[3][3][2], W2[3][3][2];
#pragma unroll
        for (int j = 0; j < 18; ++j) {
            const int sl = j % 3;
#pragma unroll
            for (int i = 0; i < 3; ++i) { const u32x2 a = ring[j % 3].a[i], g = ring[j % 3].g[i];
                W1[sl][i][0] = (f32x2){bflo(a.x), bfhi(a.x)}; W1[sl][i][1] = (f32x2){bflo(a.y), bfhi(a.y)};
                W2[sl][i][0] = (f32x2){bflo(g.x), bfhi(g.x)}; W2[sl][i][1] = (f32x2){bflo(g.y), bfhi(g.y)}; }
            if (j + 3 < 18) conv_issue(z, tokbase, r, c0 - 1 + j + 3, ch, ring[j % 3]);
            if (j >= 2) {
                const int sL = (j - 2) % 3, sC = (j - 1) % 3, sR = j % 3;
                f32x2 o1[2], o2[2];
                o1[0] = (f32x2){b1[0], b1[1]}; o1[1] = (f32x2){b1[2], b1[3]}; o2[0] = (f32x2){b2[0], b2[1]}; o2[1] = (f32x2){b2[2], b2[3]};
#pragma unroll
                for (int i = 0; i < 3; ++i)
#pragma unroll
                    for (int e = 0; e < 2; ++e) {
                        o1[e] = __builtin_elementwise_fma(W1[sL][i][e], w1[i * 3 + 0][e], o1[e]); o1[e] = __builtin_elementwise_fma(W1[sC][i][e], w1[i * 3 + 1][e], o1[e]); o1[e] = __builtin_elementwise_fma(W1[sR][i][e], w1[i * 3 + 2][e], o1[e]);
                        o2[e] = __builtin_elementwise_fma(W2[sL][i][e], w2[i * 3 + 0][e], o2[e]); o2[e] = __builtin_elementwise_fma(W2[sC][i][e], w2[i * 3 + 1][e], o2[e]); o2[e] = __builtin_elementwise_fma(W2[sR][i][e], w2[i * 3 + 2][e], o2[e]); }
                u32x2 ow; ow.x = pk2(siluf_(o1[0][0]) * o2[0][0], siluf_(o1[0][1]) * o2[0][1]); ow.y = pk2(siluf_(o1[1][0]) * o2[1][0], siluf_(o1[1][1]) * o2[1][1]);
                *(u32x2*)(a2 + (size_t)(tokbase + r * 64 + c0 + j - 2) * DFF + ch) = ow;
            }
        }
    }
}

__global__ void __launch_bounds__(NTHR, 2) fwd_mega(Params p) {
    extern __shared__ __attribute__((aligned(16))) unsigned char lds[];
    cg::grid_group grid = cg::this_grid();
    const int tid = threadIdx.x, lane = tid & 63, wave = __builtin_amdgcn_readfirstlane(tid >> 6);
    const int G = gridDim.x, gw = blockIdx.x * NWAVES + wave, NGW = G * NWAVES;
    PG8_LAS unsigned char* ldsl = (PG8_LAS unsigned char*)lds;
    unsigned char* ws = p.ws;
    const float* mx = (const float*)(ws + WS_MX);
    volatile LAS unsigned* misc = (volatile LAS unsigned*)((LAS unsigned char*)lds + MISC_OFF);
    if (tid < 16) misc[tid] = 0u;
    __syncthreads();
    const XcdBarrier xbar = xcd_barrier_post((unsigned*)(ws + WS_BAR), misc + 8);
    const unsigned long long t0_ = (PROBE_K >= 0) ? __builtin_amdgcn_s_memrealtime() : 0ull;
#define PROBE_POINT(k) do { if (PROBE_K == (k) && tid == 0) { const unsigned long long _n = __builtin_amdgcn_s_memrealtime(), _d = _n - t0_; while (__builtin_amdgcn_s_memrealtime() - _n < _d) __builtin_amdgcn_s_sleep(8); } } while (0)

    for (int rep_ = 0; rep_ < REPS(0); ++rep_) {
    phase0(p, lds, tid, lane, wave, G, 0);
    phase0(p, lds, tid, lane, wave, G, 1);
    xcd_barrier(xbar);
    if (G == 0x7fffffff) grid.sync();
    }
    for (int xs_ = 0; xs_ < EXTRA_SYNCS; ++xs_) xcd_barrier(xbar);
    PROBE_POINT(0);
    for (int rep_ = 0; rep_ < REPS(1); ++rep_) {
    if (blockIdx.x < 16 && G >= 16) {
        pg8::Gemm g{(const bf16*)(ws + WS_TCH), (const bf16*)(ws + WS_WFS), 512, 512, 512};
        pg8::StaticOrder S; S.init(4, 4, 16, blockIdx.x, 512, 512);
        pg8::Epi8<FUp> E{FUp{(bf16*)(ws + WS_WPQ), 1024}};
        pg8::gemm_phase<pg8::Epi8<FUp>, pg8::StaticOrder, true, true>(ldsl, g, S, E);
    }
    { const int skip = (G >= 32) ? 16 * NWAVES : 0, nw = NGW - skip, per = (MTOK + MCTX + nw - 1) / nw, r0 = (gw - skip) * per, nr = (gw < skip) ? 0 : min(per, MTOK + MCTX - r0);
      if (nr > 0) norm_rows<true>(p.in[0], p.in[2], MTOK, p.in[6], mx, 0, 1, (bf16*)(ws + WS_HX), nullptr, r0, nr, lane); }
    xcd_barrier(xbar);
    }
    PROBE_POINT(1);
    for (int rep_ = 0; rep_ < REPS(2); ++rep_) {
    {
        pg8::Gemm g{(const bf16*)(ws + WS_HX), (const bf16*)(ws + WS_WIN) + (size_t)512 * 1024, 1024, 1024, 1024};
        pg8::InOrder S; S.G = G; S.c = blockIdx.x; S.a_tile = (size_t)256 * 1024 * 2; S.b_tile = (size_t)256 * 1024 * 2;
        pg8::Epi8<FIn> E{FIn{ws, p.out}};
        pg8::gemm_phase<pg8::Epi8<FIn>, pg8::InOrder, true, true>(ldsl, g, S, E);
    }
    {
        pg8::Gemm g{(const bf16*)(ws + WS_WPQ), (const bf16*)(ws + WS_HX), 1024, 1024, 1024};
        pg8::StaticOrder S; S.init(4, 64, G, blockIdx.x, 1024, 1024);
        pg8::Epi8<FPQ> E{FPQ{(bf16*)(ws + WS_PQT)}};
        pg8::gemm_phase<pg8::Epi8<FPQ>, pg8::StaticOrder, true, true>(ldsl, g, S, E);
    }
    xcd_barrier(xbar);
    }
    PROBE_POINT(2);
    for (int rep_ = 0; rep_ < REPS(3); ++rep_) {
    if (blockIdx.x < 128 && G >= 192) {
        pg8::Gemm g{(const bf16*)(ws + WS_CS), (const bf16*)(ws + WS_PQT), 2048, 2048, 32768};
        pg8::DftOrder S; S.G = 128; S.c = blockIdx.x; S.a_tile = (size_t)256 * 2048 * 2; S.b_tile = (size_t)256 * 32768 * 2;
        EpiDft E{(bf16*)(ws + WS_YF), (unsigned*)(ws + WS_BAR + 16384)};
        pg8::gemm_phase<EpiDft, pg8::DftOrder, true, true>(ldsl, g, S, E);
        { int t2 = threadIdx.x; asm volatile("" : "+v"(t2));
          const int lane = t2 & 63, wave = __builtin_amdgcn_readfirstlane(t2 >> 6), gw = blockIdx.x * NWAVES + wave;
          LAS float* scr = (LAS float*)((LAS unsigned char*)lds + wave * 16384);
          constexpr int I_UP = 16 * 176, I_DN = 44 * 32;
          for (int it = gw; it < I_UP + I_DN; it += 128 * NWAVES) {
              if (it < I_UP) transpose_item(p.in[14], 1024, DFF2, (bf16*)(ws + WS_WUP), scr, it, lane);
              else transpose_item(p.in[17], DFF, 1024, (bf16*)(ws + WS_WDN), scr, it - I_UP, lane); }
          constexpr int I_A = 8 * 32, I_B = 8 * 32, I_O = 16 * 32;
          for (int it = gw; it < I_A + I_B + I_O; it += 128 * NWAVES) {
              if (it < I_A) transpose_item(p.in[10], 512, 1024, (bf16*)(ws + WS_WA), scr, it, lane);
              else if (it < I_A + I_B) transpose_item(p.in[11], 512, 1024, (bf16*)(ws + WS_WB), scr, it - I_A, lane);
              else transpose_item(p.in[12], 1024, 1024, (bf16*)(ws + WS_WOUT), scr, it - I_A - I_B, lane); } }
    } else if (G >= 192) {
        for (int it = blockIdx.x - 128; it < 128; it += G - 128) hgrn_mfma_item(p, lds, it);
    } else {
        pg8::Gemm g{(const bf16*)(ws + WS_CS), (const bf16*)(ws + WS_PQT), 2048, 2048, 32768};
        pg8::DftOrder S; S.G = G; S.c = blockIdx.x; S.a_tile = (size_t)256 * 2048 * 2; S.b_tile = (size_t)256 * 32768 * 2;
        EpiDft E{(bf16*)(ws + WS_YF), (unsigned*)(ws + WS_BAR + 16384)};
        pg8::gemm_phase<EpiDft, pg8::DftOrder, true, true>(ldsl, g, S, E);
        for (int it = blockIdx.x; it < 128; it += G) hgrn_mfma_item(p, lds, it);
    }
    xcd_barrier(xbar);
    }
    PROBE_POINT(3);
    for (int rep_ = 0; rep_ < REPS(4); ++rep_) {
    phase_yh(p, lane, gw, NGW);
    { LAS float* scr = (LAS float*)((LAS unsigned char*)lds + wave * 16384);
      constexpr int I_UP = 16 * 176, I_DN = 44 * 32;
      for (int it = (G >= 192) ? I_UP + I_DN : gw; it < I_UP + I_DN; it += NGW) {
          if (it < I_UP) transpose_item(p.in[14], 1024, DFF2, (bf16*)(ws + WS_WUP), scr, it, lane);
          else transpose_item(p.in[17], DFF, 1024, (bf16*)(ws + WS_WDN), scr, it - I_UP, lane); } }
    xcd_barrier(xbar);
    }
    PROBE_POINT(4);
    for (int rep_ = 0; rep_ < REPS(5); ++rep_) {
    if (G == 256) {
        pg8::f32x4 accm[2][2][4][2];
        {
            pg8::Gemm g{(const bf16*)(ws + WS_YF), (const bf16*)(ws + WS_WA), 512, 512, 512};
            pg8::StaticOrder S; S.init(64, 4, G, blockIdx.x, 512, 512);
            pg8::Epi8<FYab> E{FYab{(const bf16*)(ws + WS_GA), (const bf16*)(ws + WS_GBG)}};
            pg8::gemm_phase<pg8::Epi8<FYab>, pg8::StaticOrder, true, true, 1>(ldsl, g, S, E, &accm[0]);
        }
        {
            pg8::Gemm g{(const bf16*)(ws + WS_YH), (const bf16*)(ws + WS_WB), 512, 512, 512};
            pg8::StaticOrder S; S.init(64, 4, G, blockIdx.x, 512, 512);
            pg8::Epi8<FYb> E{FYb{(const bf16*)(ws + WS_GBG), (bf16*)(ws + WS_MRG)}};
            pg8::gemm_phase<pg8::Epi8<FYb>, pg8::StaticOrder, true, true, 2>(ldsl, g, S, E, &accm[0]);
        }
    } else {
    {
        pg8::Gemm g{(const bf16*)(ws + WS_YF), (const bf16*)(ws + WS_WA), 512, 512, 512};
        pg8::StaticOrder S; S.init(64, 4, G, blockIdx.x, 512, 512);
        pg8::Epi8<FYaT> E{FYaT{(const bf16*)(ws + WS_GA), (bf16*)(ws + WS_TMP)}};
        pg8::gemm_phase<pg8::Epi8<FYaT>, pg8::StaticOrder, true, true>(ldsl, g, S, E);
    }
    {
        pg8::Gemm g{(const bf16*)(ws + WS_YH), (const bf16*)(ws + WS_WB), 512, 512, 512};
        pg8::StaticOrder S; S.init(64, 4, G, blockIdx.x, 512, 512);
        pg8::Epi8<FYbT> E{FYbT{(const bf16*)(ws + WS_GBG), (const bf16*)(ws + WS_TMP), (bf16*)(ws + WS_MRG)}};
        pg8::gemm_phase<pg8::Epi8<FYbT>, pg8::StaticOrder, true, true>(ldsl, g, S, E);
    }
    }
    xcd_barrier(xbar);
    }
    PROBE_POINT(5);
    for (int rep_ = 0; rep_ < REPS(6); ++rep_) {
    {
        pg8::Gemm g{(const bf16*)(ws + WS_MRG), (const bf16*)(ws + WS_WOUT), 1024, 1024, 1024};
        pg8::StaticOrder S; S.init(64, 4, G, blockIdx.x, 1024, 1024);
        pg8::Epi8<FRes> E{FRes{p.in[0], p.out, mx, 2}};
        pg8::gemm_phase<pg8::Epi8<FRes>, pg8::StaticOrder, true, true>(ldsl, g, S, E);
    }
    xcd_barrier(xbar);
    }
    PROBE_POINT(6);
    for (int rep_ = 0; rep_ < REPS(7); ++rep_) {
    { const int per = (MTOK + NGW - 1) / NGW, r0 = gw * per, nr = min(per, MTOK - r0);
      if (nr > 0) norm_rows<true>(p.out, p.out, MTOK, p.in[13], mx, 3, 4, (bf16*)(ws + WS_H2), nullptr, r0, nr, lane); }
    xcd_barrier(xbar);
    }
    PROBE_POINT(7);
    {
    for (int hf = 0; hf < 2; ++hf) {
        for (int rep_ = 0; rep_ < REPS(8); ++rep_) {
            pg8::Gemm g{(const bf16*)(ws + WS_H2) + (size_t)hf * 8192 * 1024, (const bf16*)(ws + WS_WUP), 1024, 1024, 1024};
            pg8::StaticOrder S; S.init(32, 22, G, blockIdx.x, 1024, 1024);
            pg8::Epi8<FUp> E{FUp{(bf16*)(ws + WS_Z), DFF2}};
            pg8::gemm_phase<pg8::Epi8<FUp>, pg8::StaticOrder, true, true>(ldsl, g, S, E);
        xcd_barrier(xbar);
        }
        for (int rep_ = 0; rep_ < REPS(9); ++rep_) {
        phase_conv(p, hf, tid, G);
        xcd_barrier(xbar);
        }
    }
    }
    PROBE_POINT(8);
    for (int rep_ = 0; rep_ < REPS(10); ++rep_) {
    {
        pg8::Gemm g{(const bf16*)(ws + WS_A2), (const bf16*)(ws + WS_WDN), DFF, DFF, DFF};
        pg8::StaticOrder S; S.init(64, 4, G, blockIdx.x, DFF, DFF);
        pg8::Epi8<FRes> E{FRes{p.out, (float*)(ws + WS_XO), mx, 5}};
        pg8::gemm_phase<pg8::Epi8<FRes>, pg8::StaticOrder, true, true>(ldsl, g, S, E);
    }
    xcd_barrier(xbar);
    }
    PROBE_POINT(10);
    for (int rep_ = 0; rep_ < REPS(11); ++rep_) {
    { const int per = (MTOK + NGW - 1) / NGW, r0 = gw * per, nr = min(per, MTOK - r0);
      if (nr > 0) norm_rows<false>((const float*)(ws + WS_XO), (const float*)(ws + WS_XO), MTOK, p.in[18], nullptr, 0, 0, nullptr, p.out, r0, nr, lane); }
    }
}

extern "C" void kernel_launch(void* const* d_in, const int* in_sizes, int n_in, void* d_out, int out_size, void* d_ws, size_t ws_size, hipStream_t stream) {
    static int grid = 0;
    if (grid == 0) {
        if (n_in != 19 || out_size != MTOK * DM || ws_size < WS_END) { fprintf(stderr, "kernel_launch: unexpected problem: n_in %d out %d ws %zu\n", n_in, out_size, ws_size); grid = -1; return; }
        int dev = 0, cus = 0, per_cu = 0;
        hipGetDevice(&dev);
        hipDeviceGetAttribute(&cus, hipDeviceAttributeMultiprocessorCount, dev);
        if (hipFuncSetAttribute((const void*)fwd_mega, hipFuncAttributeMaxDynamicSharedMemorySize, LDS_BYTES) != hipSuccess) { fprintf(stderr, "kernel_launch: hipFuncSetAttribute failed\n"); grid = -1; return; }
        if (hipOccupancyMaxActiveBlocksPerMultiprocessor(&per_cu, (const void*)fwd_mega, NTHR, LDS_BYTES) != hipSuccess || per_cu < 1) { fprintf(stderr, "kernel_launch: occupancy query says %d\n", per_cu); per_cu = 1; }
        (void)hipGetLastError();
        grid = cus * (per_cu > 1 ? 1 : per_cu);
        fprintf(stderr, "kernel_launch: grid %d (cus %d, per_cu %d), ws %zu\n", grid, cus, per_cu, ws_size);
    }
    if (grid < 0) return;
    Params p{};
    for (int i = 0; i < 19; ++i) p.in[i] = (const float*)d_in[i];
    p.out = (float*)d_out; p.ws = (unsigned char*)d_ws;
    if (hipMemsetAsync((char*)d_ws + WS_BAR, 0, BAR_BYTES, stream) != hipSuccess) { fprintf(stderr, "kernel_launch: memset failed\n"); return; }
    void* args[] = {&p};
    hipError_t e = hipLaunchCooperativeKernel((const void*)fwd_mega, dim3(grid), dim3(NTHR), args, LDS_BYTES, stream);
    if (e != hipSuccess) fprintf(stderr, "kernel_launch: cooperative launch failed: %s (grid %d)\n", hipGetErrorString(e), grid);
}
```

```cpp
#include <hip/hip_runtime.h>
#include <hip/hip_cooperative_groups.h>
#include <cstdio>
#include <cstdint>
namespace cg = cooperative_groups;

namespace pg8 {
#define PG8_LAS __attribute__((address_space(3)))
typedef unsigned short bf16_t;
typedef short bf16x8 __attribute__((ext_vector_type(8)));
typedef float f32x4 __attribute__((ext_vector_type(4)));
typedef unsigned u32x4 __attribute__((ext_vector_type(4)));
typedef unsigned u32x2 __attribute__((ext_vector_type(2)));
constexpr int BM = 256, BK = 64, HALF = 128, HTB = HALF * BK * 2  , STAGE_BYTES = 8 * HTB, NXCD = 8, WGM = 8;

__host__ __device__ __forceinline__ int lds_byte(int r, int c) { const int st = (r >> 4) * 2 + (c >> 5), rr = r & 15, cc = c & 31, ob = rr * 64 + cc * 2; return st * 1024 + (ob ^ (((ob >> 9) & 1) << 5)); }
__host__ __device__ __forceinline__ void stage_rc(int b, int& R, int& C) { const int st = b / 1024, sb = b % 1024, swz = sb ^ (((sb >> 9) & 1) << 5); R = (st >> 1) * 16 + swz / 64; C = (st & 1) * 32 + (swz % 64) / 2; }
__host__ __device__ __forceinline__ int perm32(int rho) { const int n = rho >> 4, i = rho & 15; return 8 * (i >> 2) + 4 * n + (i & 3); }

struct Unit { int pm, pn, z; };
struct Gemm { const bf16_t* A; const bf16_t* Bt; int K, lda, ldb; };

__device__ __forceinline__ void tile_of(int wgid, int nM, int nN, int& pm, int& pn) {
    const int nwg = nM * nN;
    { const int q = nwg / NXCD, r = nwg % NXCD, xcd = wgid % NXCD, off = wgid / NXCD; wgid = (xcd < r ? xcd * (q + 1) : r * (q + 1) + (xcd - r) * q) + off; }
    const int nig = WGM * nN, gid = wgid / nig, fm = gid * WGM, gsz = (nM - fm) < WGM ? (nM - fm) : WGM;
    pm = fm + ((wgid % nig) % gsz); pn = (wgid % nig) / gsz;
}
struct StaticOrder {
    int nM, nN, nwg, G, c; size_t a_tile, b_tile;
    __device__ __forceinline__ void init(int nM_, int nN_, int G_, int c_, int lda, int ldb) { nM = nM_; nN = nN_; nwg = nM * nN; G = G_; c = c_; a_tile = (size_t)BM * lda * 2; b_tile = (size_t)BM * ldb * 2; }
    __device__ __forceinline__ bool next(int i, Unit& u) const {
        const long L = (long)i * G + c; if (L >= nwg) return false;
        tile_of((int)L, nM, nN, u.pm, u.pn); u.z = 0; return true;
    }
    __device__ __forceinline__ size_t a_off(const Unit& u) const { return (size_t)u.pm * a_tile; }
    __device__ __forceinline__ size_t b_off(const Unit& u) const { return (size_t)u.pn * b_tile; }
};
struct OneOrder {
    int L, nM, nN; size_t a_tile, b_tile;
    __device__ __forceinline__ bool next(int i, Unit& u) const { if (i > 0) return false; tile_of(L, nM, nN, u.pm, u.pn); u.z = 0; return true; }
    __device__ __forceinline__ size_t a_off(const Unit& u) const { return (size_t)u.pm * a_tile; }
    __device__ __forceinline__ size_t b_off(const Unit& u) const { return (size_t)u.pn * b_tile; }
};
struct InOrder {
    int G, c; size_t a_tile, b_tile;
    __device__ __forceinline__ bool next(int i, Unit& u) const {
        const long L = (long)i * G + c; if (L >= 1152 + 48) return false;
        if (L < 1152) { tile_of((int)L, 64, 18, u.pm, u.pn); } else { const int j = (int)L - 1152; u.pm = 64 + (j & 7); u.pn = 2 + (j >> 3); }
        u.z = 0; return true;
    }
    __device__ __forceinline__ size_t a_off(const Unit& u) const { return (size_t)u.pm * a_tile; }
    __device__ __forceinline__ size_t b_off(const Unit& u) const { return (size_t)u.pn * b_tile; }
};
struct DftOrder {
    int G, c; size_t a_tile, b_tile;
    __device__ __forceinline__ bool next(int i, Unit& u) const {
        const long L = (long)i * G + c; if (L >= 128) return false;
        const int eo = (L < 64) ? 1 : 0, q = (int)L & 63;
        u.pn = q & 1; u.pm = (q >> 1) & 3; u.z = (q >> 3) | (eo << 8); return true;
    }
    __device__ __forceinline__ size_t a_off(const Unit& u) const { return (size_t)((u.z >> 8) * 4 + u.pm) * a_tile; }
    __device__ __forceinline__ size_t b_off(const Unit& u) const { return (size_t)u.pn * b_tile + ((size_t)(u.z & 255) * 4096 + (size_t)(u.z >> 8) * 2048) * 2; }
};

__device__ __forceinline__ unsigned cvt_pk_bf16(float lo, float hi) { unsigned r; asm volatile("v_cvt_pk_bf16_f32 %0, %1, %2" : "=v"(r) : "v"(lo), "v"(hi)); return r; }

template <class F> struct Epi8 {
    static constexpr bool PERM = true;
    F f;
    __device__ __forceinline__ void inplace(f32x4 (&acc)[2][2][4][2], const Unit& u, int wr, int wc, int fr, int fq) const {
        const int row0 = u.pm * BM + wr * 64 + fr, col0 = u.pn * BM + wc * 32 + 8 * fq;
#pragma unroll
        for (int ai = 0; ai < 2; ++ai)
#pragma unroll
            for (int m = 0; m < 4; ++m) {
#pragma unroll
                for (int bj = 0; bj < 2; ++bj) f.scale(u, row0 + ai * HALF + m * 16, col0 + bj * HALF, acc[ai][bj][m][0], acc[ai][bj][m][1]);
                asm volatile("" ::: "memory");
            }
    }
    __device__ __forceinline__ void operator()(const f32x4 (&acc)[2][2][4][2], const Unit& u, int wr, int wc, int fr, int fq) const {
        const int row0 = u.pm * BM + wr * 64 + fr, col0 = u.pn * BM + wc * 32 + 8 * fq;
#pragma unroll
        for (int ai = 0; ai < 2; ++ai)
#pragma unroll
            for (int m = 0; m < 4; ++m) {
#pragma unroll
                for (int bj = 0; bj < 2; ++bj) f(u, row0 + ai * HALF + m * 16, col0 + bj * HALF, acc[ai][bj][m][0], acc[ai][bj][m][1]);
                asm volatile("" ::: "memory");
            }
    }
};

template <class Epi, class Sched, bool ALIGN_EPI = false, bool SP2 = false, int EXTACC = 0>
__device__ __forceinline__ void gemm_phase(PG8_LAS unsigned char* lds, const Gemm g, const Sched& S, const Epi& E, f32x4 (*accx)[2][4][2] = nullptr) {
    int tid_ = threadIdx.x; asm volatile("" : "+v"(tid_));
    const int tid = tid_, wid = __builtin_amdgcn_readfirstlane(tid >> 6), lane = tid & 63, wr = wid >> 2, wc = wid & 3, fr = lane & 15, fq = lane >> 4;
    const int K = g.K, nt = K / BK;
    unsigned voffA[2], voffB[2];
#pragma unroll
    for (int i = 0; i < 2; ++i) { int R, C; stage_rc(tid * 16 + i * 8192, R, C); const int Rb = Epi::PERM ? ((R & ~31) + perm32(R & 31)) : R;
        voffA[i] = (unsigned)(R * g.lda + C) * 2u; voffB[i] = (unsigned)(Rb * g.ldb + C) * 2u; }
    const size_t kstep = (size_t)(BK * 2);
    const size_t hstepA = (size_t)HALF * g.lda * 2, hstepB = (size_t)HALF * g.ldb * 2;
    const unsigned ldsw = (unsigned)wid * 1024u;
    const int aoff = lds_byte(wr * 64 + fr, fq * 8), boff = lds_byte(wc * 32 + fr, fq * 8);
#define PG8_SA(b, h) (((b) * 2 + (h)) * HTB)
#define PG8_SB(b, h) ((4 + (b) * 2 + (h)) * HTB)
#define PG8_STAGE(bufoff, gbase, voff) do { _Pragma("unroll") for (int _i = 0; _i < 2; ++_i) \
        __builtin_amdgcn_global_load_lds((const unsigned*)((const char*)(gbase) + (voff)[_i]), (PG8_LAS unsigned*)(lds + (bufoff) + ldsw + _i * 8192), 16, 0, 0); } while (0)
#define PG8_LDA(dst, b, h) do { _Pragma("unroll") for (int m = 0; m < 4; ++m) _Pragma("unroll") for (int k = 0; k < 2; ++k) dst[m][k] = *(const PG8_LAS bf16x8*)(lds + PG8_SA(b, h) + aoff + m * 2048 + k * 1024); } while (0)
#define PG8_LDB(dst, b, h) do { _Pragma("unroll") for (int n = 0; n < 2; ++n) _Pragma("unroll") for (int k = 0; k < 2; ++k) dst[n][k] = *(const PG8_LAS bf16x8*)(lds + PG8_SB(b, h) + boff + n * 2048 + k * 1024); } while (0)
#define PG8_MMA(ai, bj, At, Bt) do { __builtin_amdgcn_s_setprio(1); _Pragma("unroll") for (int m = 0; m < 4; ++m) _Pragma("unroll") for (int n = 0; n < 2; ++n) _Pragma("unroll") for (int k = 0; k < 2; ++k) \
        acc[ai][bj][m][n] = __builtin_amdgcn_mfma_f32_16x16x32_bf16(Bt[n][k], At[m][k], acc[ai][bj][m][n], 0, 0, 0); __builtin_amdgcn_s_setprio(0); } while (0)
#define PG8_WAIT_V(n) asm volatile("s_waitcnt vmcnt(" #n ")" ::: "memory")
#define PG8_WAIT_L(n) asm volatile("s_waitcnt lgkmcnt(" #n ")" ::: "memory")
#define PG8_BAR __builtin_amdgcn_s_barrier()
#define PG8_SCHED __builtin_amdgcn_sched_barrier(0)
    Unit cur, nxt; int ui = 0;
    if (!S.next(0, cur)) return;
    f32x4 accl[2][2][4][2];
    f32x4 (&acc)[2][2][4][2] = *(EXTACC ? (f32x4 (*)[2][2][4][2])accx : &accl);
    if constexpr (EXTACC != 2) {
#pragma unroll
    for (int a = 0; a < 2; ++a)
#pragma unroll
        for (int b = 0; b < 2; ++b)
#pragma unroll
            for (int m = 0; m < 4; ++m)
#pragma unroll
                for (int n = 0; n < 2; ++n) acc[a][b][m][n] = (f32x4){0.f, 0.f, 0.f, 0.f};
    }
    bf16x8 At[4][2], B0[2][2], B1[2][2];
    const char* cA = (const char*)g.A + S.a_off(cur); const char* cB = (const char*)g.Bt + S.b_off(cur);
    if constexpr (SP2) {
        PG8_STAGE(PG8_SB(0, 0), cB, voffB); PG8_STAGE(PG8_SB(0, 1), cB + hstepB, voffB); PG8_STAGE(PG8_SA(0, 0), cA, voffA); PG8_STAGE(PG8_SA(0, 1), cA + hstepA, voffA);
        if (wr == 1) PG8_BAR;
        PG8_WAIT_V(2); PG8_BAR;
        PG8_STAGE(PG8_SB(1, 0), cB + kstep, voffB); PG8_STAGE(PG8_SA(1, 0), cA + kstep, voffA); PG8_STAGE(PG8_SB(1, 1), cB + hstepB + kstep, voffB);
        PG8_WAIT_V(6); PG8_BAR;
    } else {
        PG8_STAGE(PG8_SB(0, 0), cB, voffB); PG8_STAGE(PG8_SA(0, 0), cA, voffA); PG8_STAGE(PG8_SB(0, 1), cB + hstepB, voffB); PG8_STAGE(PG8_SA(0, 1), cA + hstepA, voffA);
        if (wr == 1) PG8_BAR;
        PG8_WAIT_V(4); PG8_BAR;
        PG8_STAGE(PG8_SB(1, 0), cB + kstep, voffB); PG8_STAGE(PG8_SA(1, 0), cA + kstep, voffA); PG8_STAGE(PG8_SB(1, 1), cB + hstepB + kstep, voffB);
        PG8_WAIT_V(6); PG8_BAR;
    }
    for (;;) {
        const bool has_next = S.next(ui + 1, nxt);
        const char* nA = has_next ? (const char*)g.A + S.a_off(nxt) : cA; const char* nB = has_next ? (const char*)g.Bt + S.b_off(nxt) : cB;
        for (int t = 0; t < nt; t += 2) {
            const bool last = (t == nt - 2);
            const char* a1 = cA + (size_t)(t + 1) * kstep;
            const char* a2 = last ? nA : cA + (size_t)(t + 2) * kstep; const char* b2 = last ? nB : cB + (size_t)(t + 2) * kstep;
            const char* a3 = a2 + kstep; const char* b3 = b2 + kstep;
            if constexpr (SP2) {
            PG8_LDB(B0, 0, 0); PG8_LDB(B1, 0, 1); PG8_SCHED; PG8_LDA(At, 0, 0); PG8_STAGE(PG8_SA(1, 1), a1 + hstepA, voffA);
            PG8_WAIT_V(8); PG8_WAIT_L(0); PG8_BAR; PG8_MMA(0, 0, At, B0); PG8_MMA(0, 1, At, B1); PG8_BAR; PG8_SCHED;
            PG8_LDA(At, 0, 1); PG8_STAGE(PG8_SB(0, 0), b2, voffB); PG8_STAGE(PG8_SB(0, 1), b2 + hstepB, voffB); PG8_STAGE(PG8_SA(0, 0), a2, voffA);
            PG8_WAIT_V(8); PG8_WAIT_L(0); PG8_BAR; PG8_MMA(1, 0, At, B0); PG8_MMA(1, 1, At, B1); PG8_BAR; PG8_SCHED;
            PG8_LDB(B0, 1, 0); PG8_LDB(B1, 1, 1); PG8_SCHED; PG8_LDA(At, 1, 0); PG8_STAGE(PG8_SA(0, 1), a2 + hstepA, voffA);
            PG8_WAIT_V(8); PG8_WAIT_L(0); PG8_BAR; PG8_MMA(0, 0, At, B0); PG8_MMA(0, 1, At, B1); PG8_BAR; PG8_SCHED;
            PG8_LDA(At, 1, 1); PG8_STAGE(PG8_SB(1, 0), b3, voffB); PG8_STAGE(PG8_SB(1, 1), b3 + hstepB, voffB); PG8_STAGE(PG8_SA(1, 0), a3, voffA);
            PG8_WAIT_V(8); PG8_WAIT_L(0); PG8_BAR; PG8_MMA(1, 0, At, B0); PG8_MMA(1, 1, At, B1); PG8_BAR; PG8_SCHED;
            } else {
            PG8_LDB(B0, 0, 0); PG8_SCHED; PG8_LDA(At, 0, 0); PG8_STAGE(PG8_SA(1, 1), a1 + hstepA, voffA);
            PG8_WAIT_L(8); PG8_BAR; PG8_WAIT_L(0); PG8_MMA(0, 0, At, B0); PG8_BAR; PG8_SCHED;
            PG8_LDB(B1, 0, 1); PG8_STAGE(PG8_SB(0, 0), b2, voffB);
            PG8_BAR; PG8_WAIT_L(0); PG8_MMA(0, 1, At, B1); PG8_BAR;
            PG8_LDA(At, 0, 1); PG8_STAGE(PG8_SA(0, 0), a2, voffA);
            PG8_BAR; PG8_WAIT_L(0); PG8_MMA(1, 0, At, B0); PG8_BAR; PG8_SCHED;
            PG8_STAGE(PG8_SB(0, 1), b2 + hstepB, voffB);
            PG8_WAIT_V(6); PG8_BAR; PG8_MMA(1, 1, At, B1); PG8_BAR;
            PG8_LDB(B0, 1, 0); PG8_SCHED; PG8_LDA(At, 1, 0); PG8_STAGE(PG8_SA(0, 1), a2 + hstepA, voffA);
            PG8_WAIT_L(8); PG8_BAR; PG8_WAIT_L(0); PG8_MMA(0, 0, At, B0); PG8_BAR; PG8_SCHED;
            PG8_LDB(B1, 1, 1); PG8_STAGE(PG8_SB(1, 0), b3, voffB);
            PG8_BAR; PG8_WAIT_L(0); PG8_MMA(0, 1, At, B1); PG8_BAR;
            PG8_LDA(At, 1, 1); PG8_STAGE(PG8_SA(1, 0), a3, voffA);
            PG8_BAR; PG8_WAIT_L(0); PG8_MMA(1, 0, At, B0); PG8_BAR; PG8_SCHED;
            PG8_STAGE(PG8_SB(1, 1), b3 + hstepB, voffB);
            PG8_WAIT_V(6); PG8_BAR; PG8_MMA(1, 1, At, B1); PG8_BAR;
            }
        }
        if constexpr (ALIGN_EPI) { if (wr == 0) PG8_BAR; }
        if constexpr (EXTACC == 1) E.inplace(acc, cur, wr, wc, fr, fq); else E(acc, cur, wr, wc, fr, fq);
        if (!has_next || EXTACC != 0) break;
#pragma unroll
        for (int a = 0; a < 2; ++a)
#pragma unroll
            for (int b = 0; b < 2; ++b)
#pragma unroll
                for (int m = 0; m < 4; ++m)
#pragma unroll
                    for (int n = 0; n < 2; ++n) acc[a][b][m][n] = (f32x4){0.f, 0.f, 0.f, 0.f};
        cur = nxt; cA = nA; cB = nB; ++ui;
        if constexpr (ALIGN_EPI) { if (wr == 1) PG8_BAR; }
    }
    PG8_WAIT_V(0);
    if constexpr (!ALIGN_EPI) { if (wr == 0) PG8_BAR; }
    PG8_BAR;
#undef PG8_SA
#undef PG8_SB
#undef PG8_STAGE
#undef PG8_LDA
#undef PG8_LDB
#undef PG8_MMA
#undef PG8_WAIT_V
#undef PG8_WAIT_L
#undef PG8_BAR
#undef PG8_SCHED
}
}

constexpr int DM = 1024, NB = 8, SEQ = 2048, MTOK = NB * SEQ, CTXL = 256, MCTX = NB * CTXL;
constexpr int HGD = 512, DFF = 2816, DFF2 = 5632, INDIM = 5120, NMOD = 6;
constexpr float EPSN = 1e-6f;
constexpr int NWAVES = 8, NTHR = 512;
constexpr int LDS_BYTES = 147456;
#ifndef DUP_MASK
#define DUP_MASK 0
#endif
#define REPS(k) ((((DUP_MASK) >> (k)) & 1) ? 2 : 1)
#ifndef PROBE_K
#define PROBE_K -1
#endif
#ifndef EXTRA_SYNCS
#define EXTRA_SYNCS 0
#endif

constexpr size_t MiB = 1u << 20;
constexpr size_t WS_MX = 0;
constexpr size_t WS_LB = 256 * 1024;
constexpr size_t WS_WFS = 2 * MiB, WS_TCH = 3 * MiB;
constexpr size_t WS_BAR = 512 * 1024, BAR_BYTES = 32768;
constexpr int MISC_OFF = 147456 - 128;
constexpr size_t WS_WIN = 6 * MiB;
constexpr size_t WS_WPQ = 16 * MiB;
constexpr size_t WS_WA = 18 * MiB, WS_WB = 19 * MiB, WS_WOUT = 20 * MiB;
constexpr size_t WS_CS = 22 * MiB;
constexpr size_t WS_WUP = 6 * MiB;
constexpr size_t WS_WDN = 250 * MiB;
constexpr size_t WS_HX = 38 * MiB;
constexpr size_t WS_OF = 38 * MiB, WS_OB = 54 * MiB;
constexpr size_t WS_TMP = 38 * MiB;
constexpr size_t WS_H2 = 38 * MiB;
constexpr size_t WS_Q = 74 * MiB, WS_V = 90 * MiB, WS_OG = 106 * MiB, WS_GA = 122 * MiB, WS_GBG = 154 * MiB, WS_PQT = 186 * MiB;
constexpr size_t WS_GFC = 218 * MiB, WS_GBC = 222 * MiB, WS_VC = 226 * MiB;
constexpr size_t WS_YF = 228 * MiB;
constexpr size_t WS_YH = 74 * MiB;
constexpr size_t WS_MRG = 186 * MiB;
constexpr size_t WS_Z = 74 * MiB;
constexpr size_t WS_A2 = 162 * MiB;
constexpr size_t WS_XO = 38 * MiB;
constexpr size_t WS_END = 256 * MiB;

typedef unsigned short bf16;
typedef float f32x4 __attribute__((ext_vector_type(4)));
typedef unsigned u32x4 __attribute__((ext_vector_type(4)));
typedef unsigned u32x2 __attribute__((ext_vector_type(2)));
typedef float f32x2 __attribute__((ext_vector_type(2)));
#define LAS __attribute__((address_space(3)))

struct Params {
    const float* in[19];
    float* out;
    unsigned char* ws;
};

__device__ __forceinline__ float bf2f(unsigned short b) { return __uint_as_float(((unsigned)b) << 16); }
__device__ __forceinline__ float bflo(unsigned w) { return __uint_as_float(w << 16); }
__device__ __forceinline__ float bfhi(unsigned w) { return __uint_as_float(w & 0xffff0000u); }
__device__ __forceinline__ unsigned f2bf(float f) { unsigned u = __float_as_uint(f); return (u + 0x7fffu + ((u >> 16) & 1u)) >> 16; }
__device__ __forceinline__ unsigned pk2(float lo, float hi);
typedef __bf16 bf16x2_t __attribute__((ext_vector_type(2)));
__device__ __forceinline__ unsigned hwpk2(float lo, float hi) { const f32x2 v = {lo, hi}; const bf16x2_t r = __builtin_convertvector(v, bf16x2_t); return __builtin_bit_cast(unsigned, r); }
__device__ __forceinline__ unsigned pk2(float lo, float hi) { return hwpk2(lo, hi); }
__device__ __forceinline__ float sigmoidf_(float x) { return __builtin_amdgcn_rcpf(1.f + __expf(-x)); }
__device__ __forceinline__ float siluf_(float x) { return x * __builtin_amdgcn_rcpf(1.f + __expf(-x)); }
__device__ __forceinline__ float wave_sum(float v) {
#pragma unroll
    for (int o = 1; o < 64; o <<= 1) v += __shfl_xor(v, o);
    return v;
}
__device__ __forceinline__ u32x4 pack8(const f32x4 a, const f32x4 b) { u32x4 w; w.x = pk2(a[0], a[1]); w.y = pk2(a[2], a[3]); w.z = pk2(b[0], b[1]); w.w = pk2(b[2], b[3]); return w; }

typedef __attribute__((address_space(1))) unsigned gu32;
#define XB_TMO      128
#define XB_XCNT(j)  (256  + 64 * (j))
#define XB_XSUB(j)  (1280 + 64 * (j))
#define XB_XGEN(j)  (2304 + 64 * (j))
#define XB_TOP      3328
#define XB_TOPGEN   3392
#define XCD_BAR_WORDS 3456
#define XB_SPIN_CAP (1u << 18)

__device__ __forceinline__ unsigned xb_ld(unsigned* p)              { return __hip_atomic_load(p, __ATOMIC_RELAXED, __HIP_MEMORY_SCOPE_AGENT); }
__device__ __forceinline__ unsigned xb_add(unsigned* p, unsigned v) { return __hip_atomic_fetch_add(p, v, __ATOMIC_RELAXED, __HIP_MEMORY_SCOPE_AGENT); }
__device__ __forceinline__ unsigned xb_xcc_id() { return (unsigned)__builtin_amdgcn_s_getreg((3 << 11) | 20) & 0xFu; }
#define XB_SPIN(cond, bar) do { unsigned _sp = 0; while (cond) { __builtin_amdgcn_s_sleep(1); \
    if ((++_sp & 255u) == 0u) { if (xb_ld(&(bar)[XB_TMO])) break; if (_sp > XB_SPIN_CAP) { atomicAdd(&(bar)[XB_TMO], 1u); break; } } } } while (0)

struct XcdBarrier {
    unsigned* bar; unsigned x;
    volatile LAS unsigned* st;
};

__device__ __forceinline__ XcdBarrier xcd_barrier_post(unsigned* bar, volatile LAS unsigned* st) {
    XcdBarrier b; b.bar = bar; b.x = xb_xcc_id(); b.st = st;
    if (threadIdx.x == 0) (void)xb_add(&bar[XB_XCNT(b.x)], 1u);
    return b;
}
__device__ __forceinline__ void xcd_barrier_complete(unsigned* bar, unsigned x, unsigned& nloc, unsigned& nx) {
    const unsigned G = gridDim.x * gridDim.y * gridDim.z;
    unsigned sum, cnt, mine, sp = 0u;
    for (;;) {
        sum = 0u; cnt = 0u; mine = 0u;
#pragma unroll
        for (unsigned j = 0; j < 16; ++j) { const unsigned c = xb_ld(&bar[XB_XCNT(j)]); sum += c; cnt += (c > 0u) ? 1u : 0u; mine = (j == x) ? c : mine; }
        if (sum == G) break;
        __builtin_amdgcn_s_sleep(1);
        if ((++sp & 255u) == 0u) { if (xb_ld(&bar[XB_TMO])) break; if (sp > XB_SPIN_CAP) { atomicAdd(&bar[XB_TMO], 1u); break; } }
    }
    nloc = mine > 0u ? mine : 1u; nx = cnt > 0u ? cnt : 1u;
}

__device__ __forceinline__ void xcd_barrier(const XcdBarrier& b) {
    asm volatile("s_waitcnt vmcnt(0)" ::: "memory");
    __syncthreads();
    if (threadIdx.x == 0) {
        unsigned* bar = b.bar;
        __builtin_amdgcn_s_waitcnt(0);
        unsigned nloc = b.st[0], nx = b.st[1];
        if (nloc == 0u) { xcd_barrier_complete(bar, b.x, nloc, nx); b.st[0] = nloc; b.st[1] = nx; }
        const unsigned old = xb_add(&bar[XB_XSUB(b.x)], 1u);
        const unsigned gen = old / nloc;
        if (old + 1u == (gen + 1u) * nloc) {
            __builtin_amdgcn_fence(__ATOMIC_RELEASE, "agent");
            asm volatile("s_waitcnt vmcnt(0)" ::: "memory");
            const unsigned og = xb_add(&bar[XB_TOP], 1u);
            const unsigned tg = og / nx;
            if (og + 1u == (tg + 1u) * nx) xb_add(&bar[XB_TOPGEN], 1u);
            else XB_SPIN(xb_ld(&bar[XB_TOPGEN]) == tg, bar);
            __builtin_amdgcn_fence(__ATOMIC_ACQUIRE, "agent");
            xb_add(&bar[XB_XGEN(b.x)], 1u);
            asm volatile("s_waitcnt vmcnt(0)" ::: "memory");
        } else {
            XB_SPIN(xb_ld(&bar[XB_XGEN(b.x)]) == gen, bar);
            __builtin_amdgcn_fence(__ATOMIC_ACQUIRE, "agent");
            asm volatile("s_waitcnt vmcnt(0)" ::: "memory");
        }
    }
    __syncthreads();
}


struct FIn {
    unsigned char* ws; float* out;
    __device__ __forceinline__ void operator()(const pg8::Unit& u, int row, int col, f32x4 v0, f32x4 v1) const {
        const int seg = u.pn >> 1, c = col & 511;
        if (seg == 0 || seg == 4) { f32x4 a, b;
#pragma unroll
            for (int i = 0; i < 4; ++i) { a[i] = siluf_(v0[i]); b[i] = siluf_(v1[i]); }
            bf16* dst = (bf16*)(ws + (seg == 0 ? WS_Q : WS_OG));
            *(u32x4*)(dst + (size_t)row * 512 + c) = pack8(a, b);
        } else if (seg == 1 || seg == 2) {
            const float* lb = (const float*)(ws + WS_LB);
            const f32x4 l0 = *(const f32x4*)(lb + c), l1 = *(const f32x4*)(lb + c + 4); f32x4 a, b;
#pragma unroll
            for (int i = 0; i < 4; ++i) { a[i] = l0[i] + (1.f - l0[i]) * sigmoidf_(v0[i]); b[i] = l1[i] + (1.f - l1[i]) * sigmoidf_(v1[i]); }
            float* dst;
            if (u.pm < 64) dst = out + (seg == 1 ? (size_t)0 : (size_t)MTOK * 512) + (size_t)row * 512 + c;
            else dst = (float*)(ws + (seg == 1 ? WS_GFC : WS_GBC)) + (size_t)(row - MTOK) * 512 + c;
            *(f32x4*)dst = a; *(f32x4*)(dst + 4) = b;
        } else if (seg == 3) {
            bf16* dst;
            if (u.pm < 64) dst = (bf16*)(ws + WS_V) + (size_t)row * 512 + c; else dst = (bf16*)(ws + WS_VC) + (size_t)(row - MTOK) * 512 + c;
            *(u32x4*)dst = pack8(v0, v1);
        } else { f32x4 a, b;
#pragma unroll
            for (int i = 0; i < 4; ++i) { a[i] = sigmoidf_(v0[i]); b[i] = sigmoidf_(v1[i]); }
            bf16* dst = (seg < 7) ? ((bf16*)(ws + WS_GA) + (size_t)row * 1024 + (col - 5 * 512)) : ((bf16*)(ws + WS_GBG) + (size_t)row * 1024 + (col - 7 * 512));
            *(u32x4*)dst = pack8(a, b);
        }
    }
};
struct FPQ {
    bf16* pqt;
    __device__ __forceinline__ void operator()(const pg8::Unit&, int row, int col, f32x4 v0, f32x4 v1) const {
        bf16* dst = pqt + (size_t)(row & 511) * 32768 + (size_t)(col >> 11) * 4096 + (size_t)(row >> 9) * 1024 + ((col & 2047) >> 1);
        u32x2 ev, od; ev.x = pk2(v0[0], v0[2]); ev.y = pk2(v1[0], v1[2]); od.x = pk2(v0[1], v0[3]); od.y = pk2(v1[1], v1[3]);
        *(u32x2*)dst = ev; *(u32x2*)(dst + 2048) = od;
    }
};
struct EpiDft {
    static constexpr bool PERM = true;
    bf16* yf; unsigned* flags;
    __device__ __forceinline__ void operator()(const f32x4 (&acc)[2][2][4][2], const pg8::Unit& u, int wr, int wc, int fr, int fq) const {
        const int z = u.z & 255, eo = u.z >> 8, pair = (z * 4 + u.pm) * 2 + u.pn;
        const int row0 = u.pm * 256 + wr * 64 + fr, col0 = u.pn * 256 + wc * 32 + 8 * fq;
        unsigned* flag = flags + pair * 16;
        if (eo) {
#pragma unroll
            for (int ai = 0; ai < 2; ++ai)
#pragma unroll
                for (int m = 0; m < 4; ++m)
#pragma unroll
                    for (int bj = 0; bj < 2; ++bj) { const int row = row0 + ai * 128 + m * 16, col = col0 + bj * 128;
                        *(u32x4*)(yf + ((size_t)z * SEQ + 1024 + row) * 512 + col) = pack8(acc[ai][bj][m][0] * (1.f / 512.f), acc[ai][bj][m][1] * (1.f / 512.f)); }
            asm volatile("s_waitcnt vmcnt(0)" ::: "memory");
            __syncthreads();
            if (threadIdx.x == 0) { __builtin_amdgcn_fence(__ATOMIC_RELEASE, "agent"); asm volatile("s_waitcnt vmcnt(0)" ::: "memory");
                __hip_atomic_store(flag, 1u, __ATOMIC_RELAXED, __HIP_MEMORY_SCOPE_AGENT); }
        } else {
            if (threadIdx.x == 0) { unsigned spins = 0;
                while (__hip_atomic_load(flag, __ATOMIC_RELAXED, __HIP_MEMORY_SCOPE_AGENT) == 0u && ++spins < (1u << 22)) __builtin_amdgcn_s_sleep(2);
                __builtin_amdgcn_fence(__ATOMIC_ACQUIRE, "agent"); asm volatile("s_waitcnt vmcnt(0)" ::: "memory"); }
            __syncthreads();
#pragma unroll
            for (int ai = 0; ai < 2; ++ai)
#pragma unroll
                for (int m = 0; m < 4; ++m) {
#pragma unroll
                    for (int bj = 0; bj < 2; ++bj) { const int row = row0 + ai * 128 + m * 16, col = col0 + bj * 128;
                        bf16* plo = yf + ((size_t)z * SEQ + row) * 512 + col; bf16* phi = plo + (size_t)1024 * 512;
                        const u32x4 o = *(const u32x4*)phi;
                        const f32x4 e0 = acc[ai][bj][m][0] * (1.f / 512.f), e1 = acc[ai][bj][m][1] * (1.f / 512.f);
                        f32x4 o0, o1; o0[0] = bflo(o.x); o0[1] = bfhi(o.x); o0[2] = bflo(o.y); o0[3] = bfhi(o.y); o1[0] = bflo(o.z); o1[1] = bfhi(o.z); o1[2] = bflo(o.w); o1[3] = bfhi(o.w);
                        *(u32x4*)plo = pack8(e0 + o0, e1 + o1); *(u32x4*)phi = pack8(e0 - o0, e1 - o1); }
                    asm volatile("" ::: "memory"); }
        }
    }
};
struct FYa {
    const bf16* ga;
    __device__ __forceinline__ void scale(const pg8::Unit&, int row, int col, f32x4& v0, f32x4& v1) const {
        const size_t o = (size_t)row * 1024 + col; const u32x4 g = *(const u32x4*)(ga + o);
        v0[0] *= bflo(g.x); v0[1] *= bfhi(g.x); v0[2] *= bflo(g.y); v0[3] *= bfhi(g.y); v1[0] *= bflo(g.z); v1[1] *= bfhi(g.z); v1[2] *= bflo(g.w); v1[3] *= bfhi(g.w);
    }
    __device__ __forceinline__ void operator()(const pg8::Unit&, int, int, f32x4, f32x4) const {}
};
struct FYb {
    const bf16* gbg; bf16* mrg;
    __device__ __forceinline__ void scale(const pg8::Unit&, int row, int col, f32x4& v0, f32x4& v1) const {
        const size_t o = (size_t)row * 1024 + col; const u32x4 h = *(const u32x4*)(gbg + o);
        v0[0] *= __builtin_amdgcn_rcpf(bflo(h.x)); v0[1] *= __builtin_amdgcn_rcpf(bfhi(h.x)); v0[2] *= __builtin_amdgcn_rcpf(bflo(h.y)); v0[3] *= __builtin_amdgcn_rcpf(bfhi(h.y));
        v1[0] *= __builtin_amdgcn_rcpf(bflo(h.z)); v1[1] *= __builtin_amdgcn_rcpf(bfhi(h.z)); v1[2] *= __builtin_amdgcn_rcpf(bflo(h.w)); v1[3] *= __builtin_amdgcn_rcpf(bfhi(h.w));
    }
    __device__ __forceinline__ void operator()(const pg8::Unit&, int row, int col, f32x4 v0, f32x4 v1) const {
        const size_t o = (size_t)row * 1024 + col; const u32x4 h = *(const u32x4*)(gbg + o);
        f32x4 a, b; a[0] = v0[0] * bflo(h.x); a[1] = v0[1] * bfhi(h.x); a[2] = v0[2] * bflo(h.y); a[3] = v0[3] * bfhi(h.y);
        b[0] = v1[0] * bflo(h.z); b[1] = v1[1] * bfhi(h.z); b[2] = v1[2] * bflo(h.w); b[3] = v1[3] * bfhi(h.w);
        *(u32x4*)(mrg + o) = pack8(a, b);
    }
};
struct FYab {
    const bf16* ga; const bf16* gbg;
    __device__ __forceinline__ void scale(const pg8::Unit&, int row, int col, f32x4& v0, f32x4& v1) const {
        const size_t o = (size_t)row * 1024 + col; const u32x4 g = *(const u32x4*)(ga + o), h = *(const u32x4*)(gbg + o);
        v0[0] *= bflo(g.x) * __builtin_amdgcn_rcpf(bflo(h.x)); v0[1] *= bfhi(g.x) * __builtin_amdgcn_rcpf(bfhi(h.x)); v0[2] *= bflo(g.y) * __builtin_amdgcn_rcpf(bflo(h.y)); v0[3] *= bfhi(g.y) * __builtin_amdgcn_rcpf(bfhi(h.y));
        v1[0] *= bflo(g.z) * __builtin_amdgcn_rcpf(bflo(h.z)); v1[1] *= bfhi(g.z) * __builtin_amdgcn_rcpf(bfhi(h.z)); v1[2] *= bflo(g.w) * __builtin_amdgcn_rcpf(bflo(h.w)); v1[3] *= bfhi(g.w) * __builtin_amdgcn_rcpf(bfhi(h.w));
    }
    __device__ __forceinline__ void operator()(const pg8::Unit&, int, int, f32x4, f32x4) const {}
};
struct FYaT {
    const bf16* ga; bf16* tmp;
    __device__ __forceinline__ void operator()(const pg8::Unit&, int row, int col, f32x4 v0, f32x4 v1) const {
        const size_t o = (size_t)row * 1024 + col; const u32x4 g = *(const u32x4*)(ga + o);
        f32x4 a, b; a[0] = v0[0] * bflo(g.x); a[1] = v0[1] * bfhi(g.x); a[2] = v0[2] * bflo(g.y); a[3] = v0[3] * bfhi(g.y);
        b[0] = v1[0] * bflo(g.z); b[1] = v1[1] * bfhi(g.z); b[2] = v1[2] * bflo(g.w); b[3] = v1[3] * bfhi(g.w);
        *(u32x4*)(tmp + o) = pack8(a, b);
    }
};
struct FYbT {
    const bf16* gbg; const bf16* tmp; bf16* mrg;
    __device__ __forceinline__ void operator()(const pg8::Unit&, int row, int col, f32x4 v0, f32x4 v1) const {
        const size_t o = (size_t)row * 1024 + col; const u32x4 g = *(const u32x4*)(gbg + o); const u32x4 t = *(const u32x4*)(tmp + o);
        f32x4 a, b; a[0] = bflo(t.x) + v0[0] * bflo(g.x); a[1] = bfhi(t.x) + v0[1] * bfhi(g.x); a[2] = bflo(t.y) + v0[2] * bflo(g.y); a[3] = bfhi(t.y) + v0[3] * bfhi(g.y);
        b[0] = bflo(t.z) + v1[0] * bflo(g.z); b[1] = bfhi(t.z) + v1[1] * bfhi(g.z); b[2] = bflo(t.w) + v1[2] * bflo(g.w); b[3] = bfhi(t.w) + v1[3] * bfhi(g.w);
        *(u32x4*)(mrg + o) = pack8(a, b);
    }
};
struct FRes {
    const float* src; float* dst; const float* mx; int mod;
    __device__ __forceinline__ void operator()(const pg8::Unit&, int row, int col, f32x4 v0, f32x4 v1) const {
        const size_t o = (size_t)row * 1024 + col; const float* m = mx + (size_t)(row >> 11) * (NMOD * DM) + mod * DM + col;
        const f32x4 m0 = *(const f32x4*)m, m1 = *(const f32x4*)(m + 4), s0 = *(const f32x4*)(src + o), s1 = *(const f32x4*)(src + o + 4);
        *(f32x4*)(dst + o) = s0 + m0 * v0; *(f32x4*)(dst + o + 4) = s1 + m1 * v1;
    }
};
struct FUp {
    bf16* z; int ld;
    __device__ __forceinline__ void operator()(const pg8::Unit&, int row, int col, f32x4 v0, f32x4 v1) const {
        *(u32x4*)(z + (size_t)row * ld + col) = pack8(v0, v1);
    }
};

__device__ __forceinline__ void transpose_item(const float* W, int K, int N, bf16* WT, LAS float* scr, int item, int lane) {
    const int nblk = N / 32, kb = item / nblk, nb = item % nblk, k0 = 64 * kb, n0 = 32 * nb;
#pragma unroll 8
    for (int i = 0; i < 32; ++i) { const int kk = 2 * i + (lane >> 5); scr[kk * 33 + (lane & 31)] = W[(size_t)(k0 + kk) * N + n0 + (lane & 31)]; }
    asm volatile("s_waitcnt lgkmcnt(0)" ::: "memory");
    const int c = lane & 7;
#pragma unroll
    for (int j = 0; j < 4; ++j) { const int n = (lane >> 3) + 8 * j; const LAS float* s = scr + (8 * c) * 33 + n;
        u32x4 o; o.x = pk2(s[0 * 33], s[1 * 33]); o.y = pk2(s[2 * 33], s[3 * 33]); o.z = pk2(s[4 * 33], s[5 * 33]); o.w = pk2(s[6 * 33], s[7 * 33]);
        *(u32x4*)(WT + (size_t)(n0 + n) * K + k0 + 8 * c) = o; }
    asm volatile("s_waitcnt lgkmcnt(0)" ::: "memory");
}

template <bool MOD>
__device__ __forceinline__ void norm_rows(const float* srcA, const float* srcB, int nA, const float* g, const float* mx, int shift_mod, int scale_mod,
                                          bf16* outb, float* outf, int r0, int nr, int lane) {
    f32x4 G[4], SH[4], cur[4], nxt[4];
    int curmod = -1;
    { const float* s0 = (r0 < nA) ? srcA + (size_t)r0 * DM : srcB + (size_t)(r0 - nA) * DM;
#pragma unroll
      for (int j = 0; j < 4; ++j) cur[j] = *(const f32x4*)(s0 + (lane + 64 * j) * 4); }
#pragma unroll 1
    for (int i = 0; i < nr; ++i) {
        const int m = r0 + i;
        if (i + 1 < nr) { const int m1 = m + 1; const float* s1 = (m1 < nA) ? srcA + (size_t)m1 * DM : srcB + (size_t)(m1 - nA) * DM;
#pragma unroll
            for (int j = 0; j < 4; ++j) nxt[j] = *(const f32x4*)(s1 + (lane + 64 * j) * 4); }
        const int mr = MOD ? ((m < nA) ? (m >> 11) : 8) : 0;
        if (mr != curmod) { curmod = mr;
#pragma unroll
            for (int j = 0; j < 4; ++j) { const int e = (lane + 64 * j) * 4; const f32x4 gg = *(const f32x4*)(g + e);
                if (MOD) { const f32x4 sc = *(const f32x4*)(mx + (size_t)mr * (NMOD * DM) + scale_mod * DM + e); SH[j] = *(const f32x4*)(mx + (size_t)mr * (NMOD * DM) + shift_mod * DM + e); G[j] = gg * (sc + 1.f); }
                else { G[j] = gg; SH[j] = (f32x4){0.f, 0.f, 0.f, 0.f}; } } }
        float s = 0.f;
#pragma unroll
        for (int j = 0; j < 4; ++j) s += (cur[j][0] * cur[j][0] + cur[j][1] * cur[j][1]) + (cur[j][2] * cur[j][2] + cur[j][3] * cur[j][3]);
        const float rinv = rsqrtf(wave_sum(s) * (1.f / DM) + EPSN);
#pragma unroll
        for (int j = 0; j < 4; ++j) { const int e = (lane + 64 * j) * 4; const f32x4 h = cur[j] * rinv * G[j] + SH[j];
            if (MOD) { u32x2 w; w.x = pk2(h[0], h[1]); w.y = pk2(h[2], h[3]); *(u32x2*)(outb + (size_t)m * DM + e) = w; }
            else *(f32x4*)(outf + (size_t)m * DM + e) = h; }
#pragma unroll
        for (int j = 0; j < 4; ++j) cur[j] = nxt[j];
    }
}

__device__ __forceinline__ void phase0(const Params& p, unsigned char* lds, int tid, int lane, int wave, int G, const int part) {
    float* ldsf = (float*)lds;
    float* mxo = (float*)(p.ws + WS_MX);
    if (part == 0) {
    for (int it = blockIdx.x; it < 192; it += G) {
        __syncthreads();
        {
            const float* c = p.in[1]; const float* cc = p.in[3]; const float* aw = p.in[4]; const float* ab = p.in[5];
            float* sc = ldsf;
            float* red = ldsf + 9 * 1024;
            for (int i = tid; i < 9 * 1024; i += NTHR) { const int r = i >> 10, k = i & 1023; const float cv = (r < 8) ? c[r * 1024 + k] : cc[k]; sc[i] = cv / (1.f + __expf(-cv)); }
            __syncthreads();
            const int n0 = it * 32, col = tid & 31, ks = tid >> 5;
            float a[9];
#pragma unroll
            for (int r = 0; r < 9; ++r) a[r] = 0.f;
            for (int k = ks * 64; k < ks * 64 + 64; ++k) { const float w = aw[(size_t)k * (NMOD * DM) + n0 + col];
#pragma unroll
                for (int r = 0; r < 9; ++r) a[r] += sc[r * 1024 + k] * w; }
#pragma unroll
            for (int r = 0; r < 9; ++r) red[(ks * 9 + r) * 32 + col] = a[r];
            __syncthreads();
            if (tid < 288) { const int r = tid >> 5, cl = tid & 31; float s = ab[n0 + cl];
                for (int k2 = 0; k2 < 16; ++k2) s += red[(k2 * 9 + r) * 32 + cl];
                mxo[r * (NMOD * DM) + n0 + cl] = s; }
        }
    }
    __syncthreads();
    { bf16* tch = (bf16*)(p.ws + WS_TCH); bf16* wfs = (bf16*)(p.ws + WS_WFS); const float* win = p.in[7];
      for (int i = blockIdx.x * NTHR + tid; i < 1024 * 64; i += G * NTHR) { const int n = i >> 6, c8 = (i & 63) * 8, gn = (n & 511) >> 7, j = n & 127; float vv[8];
#pragma unroll
          for (int e = 0; e < 8; ++e) { const int cp = c8 + e, idx = ((cp & 127) * j) & 127; const float ang = (float)idx * (1.f / 64.f);
              vv[e] = ((cp >> 7) == gn) ? ((n < 512) ? cospif(ang) : sinpif(ang)) : 0.f; }
          u32x4 w; w.x = pk2(vv[0], vv[1]); w.y = pk2(vv[2], vv[3]); w.z = pk2(vv[4], vv[5]); w.w = pk2(vv[6], vv[7]);
          *(u32x4*)(tch + (size_t)n * 512 + c8) = w;
          const f32x4 a = *(const f32x4*)(win + (size_t)n * INDIM + c8), b2 = *(const f32x4*)(win + (size_t)n * INDIM + c8 + 4);
          *(u32x4*)(wfs + (size_t)n * 512 + c8) = pack8(a, b2); } }
    }
    if (part == 0 && blockIdx.x == G - 1) { const float* hl = p.in[8]; float* lbo = (float*)(p.ws + WS_LB);
        if (tid < 512) { const float a = hl[tid], b = hl[512 + tid]; lbo[tid] = 1.f / (1.f + expf(b - a)); } }
    if (part == 0) return;
    { bf16* cs = (bf16*)(p.ws + WS_CS);
      for (int i = blockIdx.x * NTHR + tid; i < 2 * 1024 * 256; i += G * NTHR) { const int eo = i >> 18, l = (i >> 8) & 1023, kc = (i & 255) * 8; float vv[8];
#pragma unroll
          for (int e = 0; e < 8; ++e) { const int k = kc + e, sn = k >> 10, m = k & 1023;
              const float ang = eo ? (float)((l * (2 * m + 1)) & 2047) * (1.f / 1024.f) : (float)((l * m) & 1023) * (1.f / 512.f);
              vv[e] = sn ? -sinpif(ang) : cospif(ang); }
          u32x4 w; w.x = pk2(vv[0], vv[1]); w.y = pk2(vv[2], vv[3]); w.z = pk2(vv[4], vv[5]); w.w = pk2(vv[6], vv[7]);
          *(u32x4*)(cs + ((size_t)eo * 1024 + l) * 2048 + kc) = w; } }
    { LAS float* scr = (LAS float*)((LAS unsigned char*)lds + wave * 16384);
      const int gw = blockIdx.x * NWAVES + wave, NGW = G * NWAVES;
      constexpr int I_IN = 16 * 160, I_A = 8 * 32, I_B = 8 * 32, I_O = 16 * 32;
      for (int it = gw; it < ((G >= 192) ? I_IN : I_IN + I_A + I_B + I_O); it += NGW) { int r = it;
          if (r < I_IN) { transpose_item(p.in[7], 1024, INDIM, (bf16*)(p.ws + WS_WIN), scr, r, lane); continue; } r -= I_IN;
          if (r < I_A) { transpose_item(p.in[10], 512, 1024, (bf16*)(p.ws + WS_WA), scr, r, lane); continue; } r -= I_A;
          if (r < I_B) { transpose_item(p.in[11], 512, 1024, (bf16*)(p.ws + WS_WB), scr, r, lane); continue; } r -= I_B;
          transpose_item(p.in[12], 1024, 1024, (bf16*)(p.ws + WS_WOUT), scr, r, lane); } }
}

__device__ __forceinline__ void hgrn_mfma_item(const Params& p, unsigned char* lds, int item) {
    int tid_ = threadIdx.x; asm volatile("" : "+v"(tid_));
    const int tid = tid_, lane = tid & 63, w = __builtin_amdgcn_readfirstlane(tid >> 6), fr = lane & 15, fq = lane >> 4;
    const int vh = item & 1, dir = (item >> 1) & 1, h = (item >> 2) & 3, b = item >> 4;
    bf16* Qs = (bf16*)lds;
    bf16* Ks = Qs + 64 * 136;
    bf16* St = Ks + 64 * 136;
    bf16* Kh = St + 2 * 64 * 136;
    bf16* Vt = Kh + 128 * 72;
    bf16* Ps = Vt + 64 * 72;
    float* Et = (float*)(Ps + 64 * 72);
    float* Fr = Et + 128;
    float* Bt = Fr + 64 * 132;
    const int d = 16 * w + fr;
    const float* fL = p.out + (dir ? (size_t)MTOK * 512 : 0) + (size_t)b * SEQ * 512 + h * 128;
    const float* fC = (const float*)(p.ws + (dir ? WS_GBC : WS_GFC)) + (size_t)b * CTXL * 512 + h * 128;
    const bf16* qL = (const bf16*)(p.ws + WS_Q) + (size_t)b * SEQ * 512 + h * 128;
    const bf16* vL = (const bf16*)(p.ws + WS_V) + (size_t)b * SEQ * 512 + h * 128 + vh * 64;
    const bf16* vC = (const bf16*)(p.ws + WS_VC) + (size_t)b * CTXL * 512 + h * 128 + vh * 64;
    bf16* oL = (bf16*)(p.ws + (dir ? WS_OB : WS_OF)) + (size_t)b * SEQ * 512 + h * 128 + vh * 64;
    f32x4 Sa[4];
#pragma unroll
    for (int i = 0; i < 4; ++i) Sa[i] = (f32x4){0.f, 0.f, 0.f, 0.f};
    f32x4 fR[4]; u32x4 qR[2], vR;
#define HG_LOAD(cc_) do { const int _cc = (cc_); const bool _lat = _cc >= 4; const int _c = _lat ? _cc - 4 : _cc, _n = _lat ? SEQ : CTXL; \
        const float* _f = _lat ? fL : fC; const bf16* _v = _lat ? vL : vC; \
        _Pragma("unroll") for (int i = 0; i < 4; ++i) { const int _j = tid + 512 * i, _s = _c * 64 + (_j >> 5), _pos = dir ? (_n - 1 - _s) : _s; fR[i] = *(const f32x4*)(_f + (size_t)_pos * 512 + (_j & 31) * 4); } \
        if (_lat) { _Pragma("unroll") for (int i = 0; i < 2; ++i) { const int _j = tid + 512 * i, _s = _c * 64 + (_j >> 4), _pos = dir ? (_n - 1 - _s) : _s; qR[i] = *(const u32x4*)(qL + (size_t)_pos * 512 + (_j & 15) * 8); } } \
        { const int _s = _c * 64 + lane, _pos = dir ? (_n - 1 - _s) : _s; vR = *(const u32x4*)(_v + (size_t)_pos * 512 + w * 8); } } while (0)
#define HG_STAGE(lat_) do { \
        _Pragma("unroll") for (int i = 0; i < 4; ++i) { const int _j = tid + 512 * i; *(f32x4*)(Fr + (_j >> 5) * 132 + (_j & 31) * 4) = fR[i]; } \
        if (lat_) { _Pragma("unroll") for (int i = 0; i < 2; ++i) { const int _j = tid + 512 * i; *(u32x4*)(Qs + (_j >> 4) * 136 + (_j & 15) * 8) = qR[i]; } } } while (0)
    HG_LOAD(0);
    HG_STAGE(false);
    __syncthreads();
    for (int cc = 0; cc < 36; ++cc) {
        const bool lat = cc >= 4; const int c = lat ? cc - 4 : cc;
        bf16* Scur = St + (cc & 1) * (64 * 136); bf16* Snxt = St + ((cc & 1) ^ 1) * (64 * 136);
        {
            f32x2 fown[8];
#pragma unroll
            for (int i = 0; i < 8; ++i) fown[i] = *(const f32x2*)(Fr + (8 * w + i) * 132 + 2 * lane);
            *(f32x2*)(Bt + w * 128 + 2 * lane) = ((fown[0] * fown[1]) * (fown[2] * fown[3])) * ((fown[4] * fown[5]) * (fown[6] * fown[7]));
            __syncthreads();
            f32x2 cum = (f32x2){1.f, 1.f};
            { f32x2 t[7];
#pragma unroll
              for (int i = 0; i < 7; ++i) t[i] = *(const f32x2*)(Bt + i * 128 + 2 * lane);
#pragma unroll
              for (int i = 0; i < 7; ++i) if (i < w) cum = cum * t[i]; }
            unsigned kp0[4], kp1[4];
#pragma unroll
            for (int i = 0; i < 8; i += 2) { float k0v[2], k1v[2];
#pragma unroll
                for (int u = 0; u < 2; ++u) { const int r = 8 * w + i + u; const f32x2 f = fown[i + u]; cum = cum * f;
                    const float cm0 = fmaxf(cum[0], 1e-30f), cm1 = fmaxf(cum[1], 1e-30f);
                    const float kt0 = (1.f - f[0]) * __builtin_amdgcn_rcpf(cm0), kt1 = (1.f - f[1]) * __builtin_amdgcn_rcpf(cm1);
                    if (lat) { const unsigned qr = *(const unsigned*)(Qs + r * 136 + 2 * lane);
                        *(unsigned*)(Qs + r * 136 + 2 * lane) = hwpk2(bflo(qr) * cm0, bfhi(qr) * cm1); *(unsigned*)(Ks + r * 136 + 2 * lane) = hwpk2(kt0, kt1); }
                    k0v[u] = kt0; k1v[u] = kt1; }
                kp0[i >> 1] = hwpk2(k0v[0], k0v[1]); kp1[i >> 1] = hwpk2(k1v[0], k1v[1]); }
            u32x4 q0; q0.x = kp0[0]; q0.y = kp0[1]; q0.z = kp0[2]; q0.w = kp0[3]; u32x4 q1; q1.x = kp1[0]; q1.y = kp1[1]; q1.z = kp1[2]; q1.w = kp1[3];
            *(u32x4*)(Kh + (2 * lane) * 72 + 8 * w) = q0; *(u32x4*)(Kh + (2 * lane + 1) * 72 + 8 * w) = q1;
            if (w == 7) *(f32x2*)(Et + 2 * lane) = cum;
            Vt[(8 * w + 0) * 72 + lane] = (bf16)(vR.x & 0xffffu); Vt[(8 * w + 1) * 72 + lane] = (bf16)(vR.x >> 16); Vt[(8 * w + 2) * 72 + lane] = (bf16)(vR.y & 0xffffu); Vt[(8 * w + 3) * 72 + lane] = (bf16)(vR.y >> 16);
            Vt[(8 * w + 4) * 72 + lane] = (bf16)(vR.z & 0xffffu); Vt[(8 * w + 5) * 72 + lane] = (bf16)(vR.z >> 16); Vt[(8 * w + 6) * 72 + lane] = (bf16)(vR.w & 0xffffu); Vt[(8 * w + 7) * 72 + lane] = (bf16)(vR.w >> 16);
        }
        if (cc + 1 < 36) HG_LOAD(cc + 1);
        __syncthreads();
        const int ti = w >> 1, x2 = 2 * (w & 1);
        if (lat) {
#pragma unroll
            for (int u2 = 0; u2 < 2; ++u2) { const int si = x2 + u2; f32x4 acc = (f32x4){0.f, 0.f, 0.f, 0.f};
                if (si <= ti) {
#pragma unroll
                    for (int kk = 0; kk < 4; ++kk) { const pg8::bf16x8 a = *(const pg8::bf16x8*)(Ks + (si * 16 + fr) * 136 + kk * 32 + fq * 8), bq = *(const pg8::bf16x8*)(Qs + (ti * 16 + fr) * 136 + kk * 32 + fq * 8);
                        acc = __builtin_amdgcn_mfma_f32_16x16x32_bf16(a, bq, acc, 0, 0, 0); }
                    if (si == ti) {
#pragma unroll
                        for (int r = 0; r < 4; ++r) if (4 * fq + r > fr) acc[r] = 0.f; } }
                u32x2 pw; pw.x = hwpk2(acc[0], acc[1]); pw.y = hwpk2(acc[2], acc[3]);
                *(u32x2*)(Ps + (ti * 16 + fr) * 72 + si * 16 + 4 * fq) = pw; }
        }
        {
            const f32x4 et = *(const f32x4*)(Et + w * 16 + 4 * fq);
            pg8::bf16x8 ka[2];
#pragma unroll
            for (int kk = 0; kk < 2; ++kk) ka[kk] = *(const pg8::bf16x8*)(Kh + (w * 16 + fr) * 72 + kk * 32 + fq * 8);
#pragma unroll
            for (int vi = 0; vi < 4; ++vi) {
#pragma unroll
                for (int kk = 0; kk < 2; ++kk) { const pg8::bf16x8 bv = *(const pg8::bf16x8*)(Vt + (vi * 16 + fr) * 72 + kk * 32 + fq * 8);
                    Sa[vi] = __builtin_amdgcn_mfma_f32_16x16x32_bf16(ka[kk], bv, Sa[vi], 0, 0, 0); }
                Sa[vi] = Sa[vi] * et;
                u32x2 sw; sw.x = hwpk2(Sa[vi][0], Sa[vi][1]); sw.y = hwpk2(Sa[vi][2], Sa[vi][3]);
                *(u32x2*)(Snxt + (vi * 16 + fr) * 136 + w * 16 + 4 * fq) = sw; }
        }
        f32x4 Oa[2];
        Oa[0] = (f32x4){0.f, 0.f, 0.f, 0.f}; Oa[1] = (f32x4){0.f, 0.f, 0.f, 0.f};
        if (lat) {
#pragma unroll
            for (int kk = 0; kk < 4; ++kk) { const pg8::bf16x8 bq = *(const pg8::bf16x8*)(Qs + (ti * 16 + fr) * 136 + kk * 32 + fq * 8);
#pragma unroll
                for (int u2 = 0; u2 < 2; ++u2) { const pg8::bf16x8 a = *(const pg8::bf16x8*)(Scur + ((x2 + u2) * 16 + fr) * 136 + kk * 32 + fq * 8);
                    Oa[u2] = __builtin_amdgcn_mfma_f32_16x16x32_bf16(a, bq, Oa[u2], 0, 0, 0); } }
        }
        __syncthreads();
        if (lat) {
#pragma unroll
            for (int kk = 0; kk < 2; ++kk) { const pg8::bf16x8 bp = *(const pg8::bf16x8*)(Ps + (ti * 16 + fr) * 72 + kk * 32 + fq * 8);
#pragma unroll
                for (int u2 = 0; u2 < 2; ++u2) { const pg8::bf16x8 a = *(const pg8::bf16x8*)(Vt + ((x2 + u2) * 16 + fr) * 72 + kk * 32 + fq * 8);
                    Oa[u2] = __builtin_amdgcn_mfma_f32_16x16x32_bf16(a, bp, Oa[u2], 0, 0, 0); } }
            const int sg = c * 64 + ti * 16 + fr, pos = dir ? (SEQ - 1 - sg) : sg;
#pragma unroll
            for (int u2 = 0; u2 < 2; ++u2) { u32x2 ow; ow.x = hwpk2(Oa[u2][0], Oa[u2][1]); ow.y = hwpk2(Oa[u2][2], Oa[u2][3]);
                *(u32x2*)(oL + (size_t)pos * 512 + (x2 + u2) * 16 + 4 * fq) = ow; }
        }
        if (cc + 1 < 36) HG_STAGE(cc + 1 >= 4);
        __syncthreads();
    }
#undef HG_LOAD
#undef HG_STAGE
}

__device__ __forceinline__ void phase_yh(const Params& p, int lane, int gw, int NGW) {
    const bf16* of = (const bf16*)(p.ws + WS_OF); const bf16* ob = (const bf16*)(p.ws + WS_OB); const bf16* og = (const bf16*)(p.ws + WS_OG);
    bf16* yh = (bf16*)(p.ws + WS_YH); const float* on = p.in[9];
    const f32x4 n0 = *(const f32x4*)(on + lane * 8), n1 = *(const f32x4*)(on + lane * 8 + 4);
    const int per = (MTOK + NGW - 1) / NGW, r0 = gw * per, nr = min(per, MTOK - r0);
    if (nr <= 0) return;
    u32x4 a = *(const u32x4*)(of + (size_t)r0 * 512 + lane * 8), b = *(const u32x4*)(ob + (size_t)r0 * 512 + lane * 8), gg = *(const u32x4*)(og + (size_t)r0 * 512 + lane * 8);
#pragma unroll 1
    for (int i = 0; i < nr; ++i) { const size_t o = (size_t)(r0 + i) * 512 + lane * 8;
        u32x4 a1 = a, b1 = b, g1 = gg;
        if (i + 1 < nr) { a1 = *(const u32x4*)(of + o + 512); b1 = *(const u32x4*)(ob + o + 512); g1 = *(const u32x4*)(og + o + 512); }
        float v[8]; v[0] = bflo(a.x) + bflo(b.x); v[1] = bfhi(a.x) + bfhi(b.x); v[2] = bflo(a.y) + bflo(b.y); v[3] = bfhi(a.y) + bfhi(b.y);
        v[4] = bflo(a.z) + bflo(b.z); v[5] = bfhi(a.z) + bfhi(b.z); v[6] = bflo(a.w) + bflo(b.w); v[7] = bfhi(a.w) + bfhi(b.w);
        float s = 0.f;
#pragma unroll
        for (int k = 0; k < 8; ++k) s += v[k] * v[k];
        s += __shfl_xor(s, 1); s += __shfl_xor(s, 2); s += __shfl_xor(s, 4); s += __shfl_xor(s, 8);
        const float rinv = rsqrtf(s * (1.f / 128.f) + EPSN);
        float gv[8]; gv[0] = bflo(gg.x); gv[1] = bfhi(gg.x); gv[2] = bflo(gg.y); gv[3] = bfhi(gg.y); gv[4] = bflo(gg.z); gv[5] = bfhi(gg.z); gv[6] = bflo(gg.w); gv[7] = bfhi(gg.w);
        f32x4 q0, q1;
#pragma unroll
        for (int k = 0; k < 4; ++k) { q0[k] = v[k] * rinv * n0[k] * gv[k]; q1[k] = v[4 + k] * rinv * n1[k] * gv[4 + k]; }
        *(u32x4*)(yh + o) = pack8(q0, q1);
        a = a1; b = b1; gg = g1; }
}

struct ConvRaw { u32x2 a[3], g[3]; };
__device__ __forceinline__ void conv_issue(const bf16* z, int tokbase, int r, int cc, int ch, ConvRaw& q) {
#pragma unroll
    for (int i = 0; i < 3; ++i) { const int rr = r + i - 1;
        if (rr >= 0 && rr < 32 && cc >= 0 && cc < 64) { const size_t zo = (size_t)(tokbase + rr * 64 + cc) * DFF2 + ch;
            q.a[i] = *(const u32x2*)(z + zo); q.g[i] = *(const u32x2*)(z + zo + DFF);
        } else { q.a[i] = (u32x2){0u, 0u}; q.g[i] = (u32x2){0u, 0u}; } }
}
__device__ __forceinline__ void phase_conv(const Params& p, int hf, int tid, int G) {
    const bf16* z = (const bf16*)(p.ws + WS_Z); bf16* a2 = (bf16*)(p.ws + WS_A2) + (size_t)hf * 8192 * DFF;
    const float* cw = p.in[15]; const float* cb = p.in[16];
    for (int it = blockIdx.x * NTHR + tid; it < 4 * 32 * 4 * 704; it += G * NTHR) {
        const int cg4 = it % 704, rest = it / 704, strip = rest & 3, r = (rest >> 2) & 31, img = rest >> 7, ch = cg4 * 4, c0 = strip * 16, tokbase = img * 2048;
        ConvRaw ring[3];
#pragma unroll
        for (int j = 0; j < 3; ++j) conv_issue(z, tokbase, r, c0 - 1 + j, ch, ring[j]);
        f32x2 w1[9][2], w2[9][2];
#pragma unroll
        for (int t = 0; t < 9; ++t) { const f32x4 a = *(const f32x4*)(cw + (size_t)t * DFF2 + ch), g = *(const f32x4*)(cw + (size_t)t * DFF2 + DFF + ch);
            w1[t][0] = (f32x2){a[0], a[1]}; w1[t][1] = (f32x2){a[2], a[3]}; w2[t][0] = (f32x2){g[0], g[1]}; w2[t][1] = (f32x2){g[2], g[3]}; }
        const f32x4 b1 = *(const f32x4*)(cb + ch), b2 = *(const f32x4*)(cb + DFF + ch);
        f32x2 W1[3][3][2], W2[3][3][2];
#pragma unroll
        for (int j = 0; j < 18; ++j) {
            const int sl = j % 3;
#pragma unroll
            for (int i = 0; i < 3; ++i) { const u32x2 a = ring[j % 3].a[i], g = ring[j % 3].g[i];
                W1[sl][i][0] = (f32x2){bflo(a.x), bfhi(a.x)}; W1[sl][i][1] = (f32x2){bflo(a.y), bfhi(a.y)};
                W2[sl][i][0] = (f32x2){bflo(g.x), bfhi(g.x)}; W2[sl][i][1] = (f32x2){bflo(g.y), bfhi(g.y)}; }
            if (j + 3 < 18) conv_issue(z, tokbase, r, c0 - 1 + j + 3, ch, ring[j % 3]);
            if (j >= 2) {
                const int sL = (j - 2) % 3, sC = (j - 1) % 3, sR = j % 3;
                f32x2 o1[2], o2[2];
                o1[0] = (f32x2){b1[0], b1[1]}; o1[1] = (f32x2){b1[2], b1[3]}; o2[0] = (f32x2){b2[0], b2[1]}; o2[1] = (f32x2){b2[2], b2[3]};
#pragma unroll
                for (int i = 0; i < 3; ++i)
#pragma unroll
                    for (int e = 0; e < 2; ++e) {
                        o1[e] = __builtin_elementwise_fma(W1[sL][i][e], w1[i * 3 + 0][e], o1[e]); o1[e] = __builtin_elementwise_fma(W1[sC][i][e], w1[i * 3 + 1][e], o1[e]); o1[e] = __builtin_elementwise_fma(W1[sR][i][e], w1[i * 3 + 2][e], o1[e]);
                        o2[e] = __builtin_elementwise_fma(W2[sL][i][e], w2[i * 3 + 0][e], o2[e]); o2[e] = __builtin_elementwise_fma(W2[sC][i][e], w2[i * 3 + 1][e], o2[e]); o2[e] = __builtin_elementwise_fma(W2[sR][i][e], w2[i * 3 + 2][e], o2[e]); }
                u32x2 ow; ow.x = pk2(siluf_(o1[0][0]) * o2[0][0], siluf_(o1[0][1]) * o2[0][1]); ow.y = pk2(siluf_(o1[1][0]) * o2[1][0], siluf_(o1[1][1]) * o2[1][1]);
                *(u32x2*)(a2 + (size_t)(tokbase + r * 64 + c0 + j - 2) * DFF + ch) = ow;
            }
        }
    }
}

__device__ __forceinline__ void phase_conv_lds(const Params& p, int hf, unsigned char* lds, int G) {
    int t_ = threadIdx.x; asm volatile("" : "+v"(t_));
    const int tid = t_;
    bf16* ring = (bf16*)lds;
    const bf16* z = (const bf16*)(p.ws + WS_Z); bf16* a2 = (bf16*)(p.ws + WS_A2) + (size_t)hf * 8192 * DFF;
    const float* cw = p.in[15]; const float* cb = p.in[16];
    const int ch4 = (tid & 15) * 4, c0 = (tid >> 4) * 2;
    __syncthreads();
    for (int i = tid; i < 4 * 2 * 80; i += NTHR) { const int slot = i / 160, rem = i % 160, side = rem / 80, wd = rem % 80;
        ((unsigned*)(ring + ((size_t)(slot * 66 + side * 65)) * 160))[wd] = 0u; }
    for (int seq = blockIdx.x; seq < 704; seq += G) {
        const int cbk = seq % 44, rest = seq / 44, rseg = rest & 3, img = rest >> 2, r0 = rseg * 8, tokbase = img * 2048, chb = cbk * 64;
        f32x2 w1[9][2], w2[9][2];
#pragma unroll
        for (int t = 0; t < 9; ++t) { const f32x4 a = *(const f32x4*)(cw + (size_t)t * DFF2 + chb + ch4), g = *(const f32x4*)(cw + (size_t)t * DFF2 + DFF + chb + ch4);
            w1[t][0] = (f32x2){a[0], a[1]}; w1[t][1] = (f32x2){a[2], a[3]}; w2[t][0] = (f32x2){g[0], g[1]}; w2[t][1] = (f32x2){g[2], g[3]}; }
        const f32x4 b1 = *(const f32x4*)(cb + chb + ch4), b2 = *(const f32x4*)(cb + DFF + chb + ch4);
        u32x4 stA[2], stB[2];
#define CV_LOAD(ST, row_) do { const int _r = (row_); _Pragma("unroll") for (int k_ = 0; k_ < 2; ++k_) { const int _q = tid + 512 * k_, _col = _q >> 4, _path = (_q >> 3) & 1, _c8 = (_q & 7) * 8; \
            ST[k_] = (_r >= 0 && _r < 32) ? *(const u32x4*)(z + (size_t)(tokbase + _r * 64 + _col) * DFF2 + _path * DFF + chb + _c8) : (u32x4){0u, 0u, 0u, 0u}; } } while (0)
#define CV_STORE(ST, slot_) do { const int _sl = (slot_); _Pragma("unroll") for (int k_ = 0; k_ < 2; ++k_) { const int _q = tid + 512 * k_, _col = _q >> 4, _path = (_q >> 3) & 1, _c8 = (_q & 7) * 8; \
            *(u32x4*)(ring + ((size_t)(_sl * 66 + _col + 1)) * 160 + _path * 64 + _c8) = ST[k_]; } } while (0)
#define CV_COMPUTE(i_) do { const int _i = (i_); \
            f32x2 o1[2][2], o2[2][2]; \
            _Pragma("unroll") for (int oc = 0; oc < 2; ++oc) { o1[oc][0] = (f32x2){b1[0], b1[1]}; o1[oc][1] = (f32x2){b1[2], b1[3]}; o2[oc][0] = (f32x2){b2[0], b2[1]}; o2[oc][1] = (f32x2){b2[2], b2[3]}; } \
            _Pragma("unroll") for (int rr = 0; rr < 3; ++rr) { const int slot = (_i + rr) & 3; \
                const bf16* base = ring + ((size_t)(slot * 66 + c0)) * 160 + ch4; \
                _Pragma("unroll") for (int cc = 0; cc < 4; ++cc) { const u32x2 a = *(const u32x2*)(base + cc * 160), g = *(const u32x2*)(base + cc * 160 + 64); \
                    const f32x2 a0 = (f32x2){bflo(a.x), bfhi(a.x)}, a1 = (f32x2){bflo(a.y), bfhi(a.y)}, g0 = (f32x2){bflo(g.x), bfhi(g.x)}, g1 = (f32x2){bflo(g.y), bfhi(g.y)}; \
                    _Pragma("unroll") for (int oc = 0; oc < 2; ++oc) { const int dj = cc - oc; \
                        if (dj >= 0 && dj < 3) { const int t = rr * 3 + dj; \
                            o1[oc][0] = __builtin_elementwise_fma(a0, w1[t][0], o1[oc][0]); o1[oc][1] = __builtin_elementwise_fma(a1, w1[t][1], o1[oc][1]); \
                            o2[oc][0] = __builtin_elementwise_fma(g0, w2[t][0], o2[oc][0]); o2[oc][1] = __builtin_elementwise_fma(g1, w2[t][1], o2[oc][1]); } } } } \
            _Pragma("unroll") for (int oc = 0; oc < 2; ++oc) { u32x2 ow; ow.x = pk2(siluf_(o1[oc][0][0]) * o2[oc][0][0], siluf_(o1[oc][0][1]) * o2[oc][0][1]); ow.y = pk2(siluf_(o1[oc][1][0]) * o2[oc][1][0], siluf_(o1[oc][1][1]) * o2[oc][1][1]); \
                *(u32x2*)(a2 + (size_t)(tokbase + (r0 + _i) * 64 + c0 + oc) * DFF + chb + ch4) = ow; } } while (0)
        __syncthreads();
        CV_LOAD(stA, r0 - 1); CV_STORE(stA, 0); CV_LOAD(stA, r0); CV_STORE(stA, 1); CV_LOAD(stA, r0 + 1); CV_STORE(stA, 2);
        CV_LOAD(stA, r0 + 2);
        __syncthreads();
#pragma unroll 1
        for (int i = 0; i < 8; i += 2) {
            CV_LOAD(stB, r0 + i + 3);
            CV_COMPUTE(i);
            CV_STORE(stA, (i + 3) & 3);
            __syncthreads();
            if (i + 2 < 8) CV_LOAD(stA, r0 + i + 4);
            CV_COMPUTE(i + 1);
            if (i + 1 < 7) CV_STORE(stB, (i + 4) & 3);
            __syncthreads();
        }
#undef CV_COMPUTE
#undef CV_LOAD
#undef CV_STORE
    }
}

__global__ void __launch_bounds__(NTHR, 2) fwd_mega(Params p) {
    extern __shared__ __attribute__((aligned(16))) unsigned char lds[];
    cg::grid_group grid = cg::this_grid();
    const int tid = threadIdx.x, lane = tid & 63, wave = __builtin_amdgcn_readfirstlane(tid >> 6);
    const int G = gridDim.x, gw = blockIdx.x * NWAVES + wave, NGW = G * NWAVES;
    PG8_LAS unsigned char* ldsl = (PG8_LAS unsigned char*)lds;
    unsigned char* ws = p.ws;
    const float* mx = (const float*)(ws + WS_MX);
    volatile LAS unsigned* misc = (volatile LAS unsigned*)((LAS unsigned char*)lds + MISC_OFF);
    if (tid < 16) misc[tid] = 0u;
    __syncthreads();
    const XcdBarrier xbar = xcd_barrier_post((unsigned*)(ws + WS_BAR), misc + 8);
    const unsigned long long t0_ = (PROBE_K >= 0) ? __builtin_amdgcn_s_memrealtime() : 0ull;
#define PROBE_POINT(k) do { if (PROBE_K == (k) && tid == 0) { const unsigned long long _n = __builtin_amdgcn_s_memrealtime(), _d = _n - t0_; while (__builtin_amdgcn_s_memrealtime() - _n < _d) __builtin_amdgcn_s_sleep(8); } } while (0)

    for (int rep_ = 0; rep_ < REPS(0); ++rep_) {
    phase0(p, lds, tid, lane, wave, G, 0);
    phase0(p, lds, tid, lane, wave, G, 1);
    xcd_barrier(xbar);
    if (G == 0x7fffffff) grid.sync();
    }
    for (int xs_ = 0; xs_ < EXTRA_SYNCS; ++xs_) xcd_barrier(xbar);
    PROBE_POINT(0);
    for (int rep_ = 0; rep_ < REPS(1); ++rep_) {
    if (blockIdx.x < 16 && G >= 16) {
        pg8::Gemm g{(const bf16*)(ws + WS_TCH), (const bf16*)(ws + WS_WFS), 512, 512, 512};
        pg8::StaticOrder S; S.init(4, 4, 16, blockIdx.x, 512, 512);
        pg8::Epi8<FUp> E{FUp{(bf16*)(ws + WS_WPQ), 1024}};
        pg8::gemm_phase<pg8::Epi8<FUp>, pg8::StaticOrder, true, true>(ldsl, g, S, E);
    }
    { const int skip = (G >= 32) ? 16 * NWAVES : 0, nw = NGW - skip, per = (MTOK + MCTX + nw - 1) / nw, r0 = (gw - skip) * per, nr = (gw < skip) ? 0 : min(per, MTOK + MCTX - r0);
      if (nr > 0) norm_rows<true>(p.in[0], p.in[2], MTOK, p.in[6], mx, 0, 1, (bf16*)(ws + WS_HX), nullptr, r0, nr, lane); }
    xcd_barrier(xbar);
    }
    PROBE_POINT(1);
    for (int rep_ = 0; rep_ < REPS(2); ++rep_) {
    {
        pg8::Gemm g{(const bf16*)(ws + WS_HX), (const bf16*)(ws + WS_WIN) + (size_t)512 * 1024, 1024, 1024, 1024};
        pg8::InOrder S; S.G = G; S.c = blockIdx.x; S.a_tile = (size_t)256 * 1024 * 2; S.b_tile = (size_t)256 * 1024 * 2;
        pg8::Epi8<FIn> E{FIn{ws, p.out}};
        pg8::gemm_phase<pg8::Epi8<FIn>, pg8::InOrder, true, true>(ldsl, g, S, E);
    }
    {
        pg8::Gemm g{(const bf16*)(ws + WS_WPQ), (const bf16*)(ws + WS_HX), 1024, 1024, 1024};
        pg8::StaticOrder S; S.init(4, 64, G, blockIdx.x, 1024, 1024);
        pg8::Epi8<FPQ> E{FPQ{(bf16*)(ws + WS_PQT)}};
        pg8::gemm_phase<pg8::Epi8<FPQ>, pg8::StaticOrder, true, true>(ldsl, g, S, E);
    }
    xcd_barrier(xbar);
    }
    PROBE_POINT(2);
    for (int rep_ = 0; rep_ < REPS(3); ++rep_) {
    if (blockIdx.x < 128 && G >= 192) {
        pg8::Gemm g{(const bf16*)(ws + WS_CS), (const bf16*)(ws + WS_PQT), 2048, 2048, 32768};
        pg8::DftOrder S; S.G = 128; S.c = blockIdx.x; S.a_tile = (size_t)256 * 2048 * 2; S.b_tile = (size_t)256 * 32768 * 2;
        EpiDft E{(bf16*)(ws + WS_YF), (unsigned*)(ws + WS_BAR + 16384)};
        pg8::gemm_phase<EpiDft, pg8::DftOrder, true, true>(ldsl, g, S, E);
        { int t2 = threadIdx.x; asm volatile("" : "+v"(t2));
          const int lane = t2 & 63, wave = __builtin_amdgcn_readfirstlane(t2 >> 6), gw = blockIdx.x * NWAVES + wave;
          LAS float* scr = (LAS float*)((LAS unsigned char*)lds + wave * 16384);
          constexpr int I_UP = 16 * 176, I_DN = 44 * 32;
          for (int it = gw; it < I_UP + I_DN; it += 128 * NWAVES) {
              if (it < I_UP) transpose_item(p.in[14], 1024, DFF2, (bf16*)(ws + WS_WUP), scr, it, lane);
              else transpose_item(p.in[17], DFF, 1024, (bf16*)(ws + WS_WDN), scr, it - I_UP, lane); }
          constexpr int I_A = 8 * 32, I_B = 8 * 32, I_O = 16 * 32;
          for (int it = gw; it < I_A + I_B + I_O; it += 128 * NWAVES) {
              if (it < I_A) transpose_item(p.in[10], 512, 1024, (bf16*)(ws + WS_WA), scr, it, lane);
              else if (it < I_A + I_B) transpose_item(p.in[11], 512, 1024, (bf16*)(ws + WS_WB), scr, it - I_A, lane);
              else transpose_item(p.in[12], 1024, 1024, (bf16*)(ws + WS_WOUT), scr, it - I_A - I_B, lane); } }
    } else if (G >= 192) {
        for (int it = blockIdx.x - 128; it < 128; it += G - 128) hgrn_mfma_item(p, lds, it);
    } else {
        pg8::Gemm g{(const bf16*)(ws + WS_CS), (const bf16*)(ws + WS_PQT), 2048, 2048, 32768};
        pg8::DftOrder S; S.G = G; S.c = blockIdx.x; S.a_tile = (size_t)256 * 2048 * 2; S.b_tile = (size_t)256 * 32768 * 2;
        EpiDft E{(bf16*)(ws + WS_YF), (unsigned*)(ws + WS_BAR + 16384)};
        pg8::gemm_phase<EpiDft, pg8::DftOrder, true, true>(ldsl, g, S, E);
        for (int it = blockIdx.x; it < 128; it += G) hgrn_mfma_item(p, lds, it);
    }
    xcd_barrier(xbar);
    }
    PROBE_POINT(3);
    for (int rep_ = 0; rep_ < REPS(4); ++rep_) {
    phase_yh(p, lane, gw, NGW);
    { LAS float* scr = (LAS float*)((LAS unsigned char*)lds + wave * 16384);
      constexpr int I_UP = 16 * 176, I_DN = 44 * 32;
      for (int it = (G >= 192) ? I_UP + I_DN : gw; it < I_UP + I_DN; it += NGW) {
          if (it < I_UP) transpose_item(p.in[14], 1024, DFF2, (bf16*)(ws + WS_WUP), scr, it, lane);
          else transpose_item(p.in[17], DFF, 1024, (bf16*)(ws + WS_WDN), scr, it - I_UP, lane); } }
    xcd_barrier(xbar);
    }
    PROBE_POINT(4);
    for (int rep_ = 0; rep_ < REPS(5); ++rep_) {
    if (G == 256) {
        pg8::f32x4 accm[2][2][4][2];
        {
            pg8::Gemm g{(const bf16*)(ws + WS_YF), (const bf16*)(ws + WS_WA), 512, 512, 512};
            pg8::StaticOrder S; S.init(64, 4, G, blockIdx.x, 512, 512);
            pg8::Epi8<FYab> E{FYab{(const bf16*)(ws + WS_GA), (const bf16*)(ws + WS_GBG)}};
            pg8::gemm_phase<pg8::Epi8<FYab>, pg8::StaticOrder, true, true, 1>(ldsl, g, S, E, &accm[0]);
        }
        {
            pg8::Gemm g{(const bf16*)(ws + WS_YH), (const bf16*)(ws + WS_WB), 512, 512, 512};
            pg8::StaticOrder S; S.init(64, 4, G, blockIdx.x, 512, 512);
            pg8::Epi8<FYb> E{FYb{(const bf16*)(ws + WS_GBG), (bf16*)(ws + WS_MRG)}};
            pg8::gemm_phase<pg8::Epi8<FYb>, pg8::StaticOrder, true, true, 2>(ldsl, g, S, E, &accm[0]);
        }
    } else {
    {
        pg8::Gemm g{(const bf16*)(ws + WS_YF), (const bf16*)(ws + WS_WA), 512, 512, 512};
        pg8::StaticOrder S; S.init(64, 4, G, blockIdx.x, 512, 512);
        pg8::Epi8<FYaT> E{FYaT{(const bf16*)(ws + WS_GA), (bf16*)(ws + WS_TMP)}};
        pg8::gemm_phase<pg8::Epi8<FYaT>, pg8::StaticOrder, true, true>(ldsl, g, S, E);
    }
    {
        pg8::Gemm g{(const bf16*)(ws + WS_YH), (const bf16*)(ws + WS_WB), 512, 512, 512};
        pg8::StaticOrder S; S.init(64, 4, G, blockIdx.x, 512, 512);
        pg8::Epi8<FYbT> E{FYbT{(const bf16*)(ws + WS_GBG), (const bf16*)(ws + WS_TMP), (bf16*)(ws + WS_MRG)}};
        pg8::gemm_phase<pg8::Epi8<FYbT>, pg8::StaticOrder, true, true>(ldsl, g, S, E);
    }
    }
    xcd_barrier(xbar);
    }
    PROBE_POINT(5);
    for (int rep_ = 0; rep_ < REPS(6); ++rep_) {
    {
        pg8::Gemm g{(const bf16*)(ws + WS_MRG), (const bf16*)(ws + WS_WOUT), 1024, 1024, 1024};
        pg8::StaticOrder S; S.init(64, 4, G, blockIdx.x, 1024, 1024);
        pg8::Epi8<FRes> E{FRes{p.in[0], p.out, mx, 2}};
        pg8::gemm_phase<pg8::Epi8<FRes>, pg8::StaticOrder, true, true>(ldsl, g, S, E);
    }
    xcd_barrier(xbar);
    }
    PROBE_POINT(6);
    for (int rep_ = 0; rep_ < REPS(7); ++rep_) {
    { const int per = (MTOK + NGW - 1) / NGW, r0 = gw * per, nr = min(per, MTOK - r0);
      if (nr > 0) norm_rows<true>(p.out, p.out, MTOK, p.in[13], mx, 3, 4, (bf16*)(ws + WS_H2), nullptr, r0, nr, lane); }
    xcd_barrier(xbar);
    }
    PROBE_POINT(7);
    {
    for (int hf = 0; hf < 2; ++hf) {
        for (int rep_ = 0; rep_ < REPS(8); ++rep_) {
            pg8::Gemm g{(const bf16*)(ws + WS_H2) + (size_t)hf * 8192 * 1024, (const bf16*)(ws + WS_WUP), 1024, 1024, 1024};
            pg8::StaticOrder S; S.init(32, 22, G, blockIdx.x, 1024, 1024);
            pg8::Epi8<FUp> E{FUp{(bf16*)(ws + WS_Z), DFF2}};
            pg8::gemm_phase<pg8::Epi8<FUp>, pg8::StaticOrder, true, true>(ldsl, g, S, E);
        xcd_barrier(xbar);
        }
        for (int rep_ = 0; rep_ < REPS(9); ++rep_) {
        phase_conv_lds(p, hf, lds, G);
        xcd_barrier(xbar);
        }
    }
    }
    PROBE_POINT(8);
    for (int rep_ = 0; rep_ < REPS(10); ++rep_) {
    {
        pg8::Gemm g{(const bf16*)(ws + WS_A2), (const bf16*)(ws + WS_WDN), DFF, DFF, DFF};
        pg8::StaticOrder S; S.init(64, 4, G, blockIdx.x, DFF, DFF);
        pg8::Epi8<FRes> E{FRes{p.out, (float*)(ws + WS_XO), mx, 5}};
        pg8::gemm_phase<pg8::Epi8<FRes>, pg8::StaticOrder, true, true>(ldsl, g, S, E);
    }
    xcd_barrier(xbar);
    }
    PROBE_POINT(10);
    for (int rep_ = 0; rep_ < REPS(11); ++rep_) {
    { const int per = (MTOK + NGW - 1) / NGW, r0 = gw * per, nr = min(per, MTOK - r0);
      if (nr > 0) norm_rows<false>((const float*)(ws + WS_XO), (const float*)(ws + WS_XO), MTOK, p.in[18], nullptr, 0, 0, nullptr, p.out, r0, nr, lane); }
    }
}

extern "C" void kernel_launch(void* const* d_in, const int* in_sizes, int n_in, void* d_out, int out_size, void* d_ws, size_t ws_size, hipStream_t stream) {
    static int grid = 0;
    if (grid == 0) {
        if (n_in != 19 || out_size != MTOK * DM || ws_size < WS_END) { fprintf(stderr, "kernel_launch: unexpected problem: n_in %d out %d ws %zu\n", n_in, out_size, ws_size); grid = -1; return; }
        int dev = 0, cus = 0, per_cu = 0;
        hipGetDevice(&dev);
        hipDeviceGetAttribute(&cus, hipDeviceAttributeMultiprocessorCount, dev);
        if (hipFuncSetAttribute((const void*)fwd_mega, hipFuncAttributeMaxDynamicSharedMemorySize, LDS_BYTES) != hipSuccess) { fprintf(stderr, "kernel_launch: hipFuncSetAttribute failed\n"); grid = -1; return; }
        if (hipOccupancyMaxActiveBlocksPerMultiprocessor(&per_cu, (const void*)fwd_mega, NTHR, LDS_BYTES) != hipSuccess || per_cu < 1) { fprintf(stderr, "kernel_launch: occupancy query says %d\n", per_cu); per_cu = 1; }
        (void)hipGetLastError();
        grid = cus * (per_cu > 1 ? 1 : per_cu);
        fprintf(stderr, "kernel_launch: grid %d (cus %d, per_cu %d), ws %zu\n", grid, cus, per_cu, ws_size);
    }
    if (grid < 0) return;
    Params p{};
    for (int i = 0; i < 19; ++i) p.in[i] = (const float*)d_in[i];
    p.out = (float*)d_out; p.ws = (unsigned char*)d_ws;
    if (hipMemsetAsync((char*)d_ws + WS_BAR, 0, BAR_BYTES, stream) != hipSuccess) { fprintf(stderr, "kernel_launch: memset failed\n"); return; }
    void* args[] = {&p};
    hipError_t e = hipLaunchCooperativeKernel((const void*)fwd_mega, dim3(grid), dim3(NTHR), args, LDS_BYTES, stream);
    if (e != hipSuccess) fprintf(stderr, "kernel_launch: cooperative launch failed: %s (grid %d)\n", hipGetErrorString(e), grid);
}
```

```cpp
#include <hip/hip_runtime.h>
#include <hip/hip_cooperative_groups.h>
#include <cstdio>
#include <cstdint>
namespace cg = cooperative_groups;

namespace pg8 {
#define PG8_LAS __attribute__((address_space(3)))
typedef unsigned short bf16_t;
typedef short bf16x8 __attribute__((ext_vector_type(8)));
typedef float f32x4 __attribute__((ext_vector_type(4)));
typedef unsigned u32x4 __attribute__((ext_vector_type(4)));
typedef unsigned u32x2 __attribute__((ext_vector_type(2)));
constexpr int BM = 256, BK = 64, HALF = 128, HTB = HALF * BK * 2  , STAGE_BYTES = 8 * HTB, NXCD = 8, WGM = 8;

__host__ __device__ __forceinline__ int lds_byte(int r, int c) { const int st = (r >> 4) * 2 + (c >> 5), rr = r & 15, cc = c & 31, ob = rr * 64 + cc * 2; return st * 1024 + (ob ^ (((ob >> 9) & 1) << 5)); }
__host__ __device__ __forceinline__ void stage_rc(int b, int& R, int& C) { const int st = b / 1024, sb = b % 1024, swz = sb ^ (((sb >> 9) & 1) << 5); R = (st >> 1) * 16 + swz / 64; C = (st & 1) * 32 + (swz % 64) / 2; }
__host__ __device__ __forceinline__ int perm32(int rho) { const int n = rho >> 4, i = rho & 15; return 8 * (i >> 2) + 4 * n + (i & 3); }

struct Unit { int pm, pn, z; };
struct Gemm { const bf16_t* A; const bf16_t* Bt; int K, lda, ldb; };

__device__ __forceinline__ void tile_of(int wgid, int nM, int nN, int& pm, int& pn) {
    const int nwg = nM * nN;
    { const int q = nwg / NXCD, r = nwg % NXCD, xcd = wgid % NXCD, off = wgid / NXCD; wgid = (xcd < r ? xcd * (q + 1) : r * (q + 1) + (xcd - r) * q) + off; }
    const int nig = WGM * nN, gid = wgid / nig, fm = gid * WGM, gsz = (nM - fm) < WGM ? (nM - fm) : WGM;
    pm = fm + ((wgid % nig) % gsz); pn = (wgid % nig) / gsz;
}
struct StaticOrder {
    int nM, nN, nwg, G, c; size_t a_tile, b_tile;
    __device__ __forceinline__ void init(int nM_, int nN_, int G_, int c_, int lda, int ldb) { nM = nM_; nN = nN_; nwg = nM * nN; G = G_; c = c_; a_tile = (size_t)BM * lda * 2; b_tile = (size_t)BM * ldb * 2; }
    __device__ __forceinline__ bool next(int i, Unit& u) const {
        const long L = (long)i * G + c; if (L >= nwg) return false;
        tile_of((int)L, nM, nN, u.pm, u.pn); u.z = 0; return true;
    }
    __device__ __forceinline__ size_t a_off(const Unit& u) const { return (size_t)u.pm * a_tile; }
    __device__ __forceinline__ size_t b_off(const Unit& u) const { return (size_t)u.pn * b_tile; }
};
struct OneOrder {
    int L, nM, nN; size_t a_tile, b_tile;
    __device__ __forceinline__ bool next(int i, Unit& u) const { if (i > 0) return false; tile_of(L, nM, nN, u.pm, u.pn); u.z = 0; return true; }
    __device__ __forceinline__ size_t a_off(const Unit& u) const { return (size_t)u.pm * a_tile; }
    __device__ __forceinline__ size_t b_off(const Unit& u) const { return (size_t)u.pn * b_tile; }
};
struct InOrder {
    int G, c; size_t a_tile, b_tile;
    __device__ __forceinline__ bool next(int i, Unit& u) const {
        const long L = (long)i * G + c; if (L >= 1152 + 48) return false;
        if (L < 1152) { tile_of((int)L, 64, 18, u.pm, u.pn); } else { const int j = (int)L - 1152; u.pm = 64 + (j & 7); u.pn = 2 + (j >> 3); }
        u.z = 0; return true;
    }
    __device__ __forceinline__ size_t a_off(const Unit& u) const { return (size_t)u.pm * a_tile; }
    __device__ __forceinline__ size_t b_off(const Unit& u) const { return (size_t)u.pn * b_tile; }
};
struct DftOrder {
    int G, c; size_t a_tile, b_tile;
    __device__ __forceinline__ bool next(int i, Unit& u) const {
        const long L = (long)i * G + c; if (L >= 128) return false;
        const int eo = (L < 64) ? 1 : 0, q = (int)L & 63;
        u.pn = q & 1; u.pm = (q >> 1) & 3; u.z = (q >> 3) | (eo << 8); return true;
    }
    __device__ __forceinline__ size_t a_off(const Unit& u) const { return (size_t)((u.z >> 8) * 4 + u.pm) * a_tile; }
    __device__ __forceinline__ size_t b_off(const Unit& u) const { return (size_t)u.pn * b_tile + ((size_t)(u.z & 255) * 4096 + (size_t)(u.z >> 8) * 2048) * 2; }
};

__device__ __forceinline__ unsigned cvt_pk_bf16(float lo, float hi) { unsigned r; asm volatile("v_cvt_pk_bf16_f32 %0, %1, %2" : "=v"(r) : "v"(lo), "v"(hi)); return r; }

template <class F> struct Epi8 {
    static constexpr bool PERM = true;
    F f;
    __device__ __forceinline__ void inplace(f32x4 (&acc)[2][2][4][2], const Unit& u, int wr, int wc, int fr, int fq) const {
        const int row0 = u.pm * BM + wr * 64 + fr, col0 = u.pn * BM + wc * 32 + 8 * fq;
#pragma unroll
        for (int ai = 0; ai < 2; ++ai)
#pragma unroll
            for (int m = 0; m < 4; ++m) {
#pragma unroll
                for (int bj = 0; bj < 2; ++bj) f.scale(u, row0 + ai * HALF + m * 16, col0 + bj * HALF, acc[ai][bj][m][0], acc[ai][bj][m][1]);
                asm volatile("" ::: "memory");
            }
    }
    __device__ __forceinline__ void operator()(const f32x4 (&acc)[2][2][4][2], const Unit& u, int wr, int wc, int fr, int fq) const {
        const int row0 = u.pm * BM + wr * 64 + fr, col0 = u.pn * BM + wc * 32 + 8 * fq;
#pragma unroll
        for (int ai = 0; ai < 2; ++ai)
#pragma unroll
            for (int m = 0; m < 4; ++m) {
#pragma unroll
                for (int bj = 0; bj < 2; ++bj) f(u, row0 + ai * HALF + m * 16, col0 + bj * HALF, acc[ai][bj][m][0], acc[ai][bj][m][1]);
                asm volatile("" ::: "memory");
            }
    }
};

template <class E, class = void> struct after_drain { static constexpr bool value = false; };
template <class E> struct after_drain<E, decltype((void)E::AFTER_DRAIN)> { static constexpr bool value = E::AFTER_DRAIN; };
template <class Epi, class Sched, bool ALIGN_EPI = false, bool SP2 = false, int EXTACC = 0>
__device__ __forceinline__ void gemm_phase(PG8_LAS unsigned char* lds, const Gemm g, const Sched& S, const Epi& E, f32x4 (*accx)[2][4][2] = nullptr) {
    int tid_ = threadIdx.x; asm volatile("" : "+v"(tid_));
    const int tid = tid_, wid = __builtin_amdgcn_readfirstlane(tid >> 6), lane = tid & 63, wr = wid >> 2, wc = wid & 3, fr = lane & 15, fq = lane >> 4;
    const int K = g.K, nt = K / BK;
    unsigned voffA[2], voffB[2];
#pragma unroll
    for (int i = 0; i < 2; ++i) { int R, C; stage_rc(tid * 16 + i * 8192, R, C); const int Rb = Epi::PERM ? ((R & ~31) + perm32(R & 31)) : R;
        voffA[i] = (unsigned)(R * g.lda + C) * 2u; voffB[i] = (unsigned)(Rb * g.ldb + C) * 2u; }
    const size_t kstep = (size_t)(BK * 2);
    const size_t hstepA = (size_t)HALF * g.lda * 2, hstepB = (size_t)HALF * g.ldb * 2;
    const unsigned ldsw = (unsigned)wid * 1024u;
    const int aoff = lds_byte(wr * 64 + fr, fq * 8), boff = lds_byte(wc * 32 + fr, fq * 8);
#define PG8_SA(b, h) (((b) * 2 + (h)) * HTB)
#define PG8_SB(b, h) ((4 + (b) * 2 + (h)) * HTB)
#define PG8_STAGE(bufoff, gbase, voff) do { _Pragma("unroll") for (int _i = 0; _i < 2; ++_i) \
        __builtin_amdgcn_global_load_lds((const unsigned*)((const char*)(gbase) + (voff)[_i]), (PG8_LAS unsigned*)(lds + (bufoff) + ldsw + _i * 8192), 16, 0, 0); } while (0)
#define PG8_LDA(dst, b, h) do { _Pragma("unroll") for (int m = 0; m < 4; ++m) _Pragma("unroll") for (int k = 0; k < 2; ++k) dst[m][k] = *(const PG8_LAS bf16x8*)(lds + PG8_SA(b, h) + aoff + m * 2048 + k * 1024); } while (0)
#define PG8_LDB(dst, b, h) do { _Pragma("unroll") for (int n = 0; n < 2; ++n) _Pragma("unroll") for (int k = 0; k < 2; ++k) dst[n][k] = *(const PG8_LAS bf16x8*)(lds + PG8_SB(b, h) + boff + n * 2048 + k * 1024); } while (0)
#define PG8_MMA(ai, bj, At, Bt) do { __builtin_amdgcn_s_setprio(1); _Pragma("unroll") for (int m = 0; m < 4; ++m) _Pragma("unroll") for (int n = 0; n < 2; ++n) _Pragma("unroll") for (int k = 0; k < 2; ++k) \
        acc[ai][bj][m][n] = __builtin_amdgcn_mfma_f32_16x16x32_bf16(Bt[n][k], At[m][k], acc[ai][bj][m][n], 0, 0, 0); __builtin_amdgcn_s_setprio(0); } while (0)
#define PG8_WAIT_V(n) asm volatile("s_waitcnt vmcnt(" #n ")" ::: "memory")
#define PG8_WAIT_L(n) asm volatile("s_waitcnt lgkmcnt(" #n ")" ::: "memory")
#define PG8_BAR __builtin_amdgcn_s_barrier()
#define PG8_SCHED __builtin_amdgcn_sched_barrier(0)
    Unit cur, nxt; int ui = 0;
    if (!S.next(0, cur)) return;
    f32x4 accl[2][2][4][2];
    f32x4 (&acc)[2][2][4][2] = *(EXTACC ? (f32x4 (*)[2][2][4][2])accx : &accl);
    if constexpr (EXTACC != 2) {
#pragma unroll
    for (int a = 0; a < 2; ++a)
#pragma unroll
        for (int b = 0; b < 2; ++b)
#pragma unroll
            for (int m = 0; m < 4; ++m)
#pragma unroll
                for (int n = 0; n < 2; ++n) acc[a][b][m][n] = (f32x4){0.f, 0.f, 0.f, 0.f};
    }
    bf16x8 At[4][2], B0[2][2], B1[2][2];
    const char* cA = (const char*)g.A + S.a_off(cur); const char* cB = (const char*)g.Bt + S.b_off(cur);
    if constexpr (SP2) {
        PG8_STAGE(PG8_SB(0, 0), cB, voffB); PG8_STAGE(PG8_SB(0, 1), cB + hstepB, voffB); PG8_STAGE(PG8_SA(0, 0), cA, voffA); PG8_STAGE(PG8_SA(0, 1), cA + hstepA, voffA);
        if (wr == 1) PG8_BAR;
        PG8_WAIT_V(2); PG8_BAR;
        PG8_STAGE(PG8_SB(1, 0), cB + kstep, voffB); PG8_STAGE(PG8_SA(1, 0), cA + kstep, voffA); PG8_STAGE(PG8_SB(1, 1), cB + hstepB + kstep, voffB);
        PG8_WAIT_V(6); PG8_BAR;
    } else {
        PG8_STAGE(PG8_SB(0, 0), cB, voffB); PG8_STAGE(PG8_SA(0, 0), cA, voffA); PG8_STAGE(PG8_SB(0, 1), cB + hstepB, voffB); PG8_STAGE(PG8_SA(0, 1), cA + hstepA, voffA);
        if (wr == 1) PG8_BAR;
        PG8_WAIT_V(4); PG8_BAR;
        PG8_STAGE(PG8_SB(1, 0), cB + kstep, voffB); PG8_STAGE(PG8_SA(1, 0), cA + kstep, voffA); PG8_STAGE(PG8_SB(1, 1), cB + hstepB + kstep, voffB);
        PG8_WAIT_V(6); PG8_BAR;
    }
    for (;;) {
        const bool has_next = S.next(ui + 1, nxt);
        const char* nA = has_next ? (const char*)g.A + S.a_off(nxt) : cA; const char* nB = has_next ? (const char*)g.Bt + S.b_off(nxt) : cB;
        for (int t = 0; t < nt; t += 2) {
            const bool last = (t == nt - 2);
            const char* a1 = cA + (size_t)(t + 1) * kstep;
            const char* a2 = last ? nA : cA + (size_t)(t + 2) * kstep; const char* b2 = last ? nB : cB + (size_t)(t + 2) * kstep;
            const char* a3 = a2 + kstep; const char* b3 = b2 + kstep;
            if constexpr (SP2) {
            PG8_LDB(B0, 0, 0); PG8_LDB(B1, 0, 1); PG8_SCHED; PG8_LDA(At, 0, 0); PG8_STAGE(PG8_SA(1, 1), a1 + hstepA, voffA);
            PG8_WAIT_V(8); PG8_WAIT_L(0); PG8_BAR; PG8_MMA(0, 0, At, B0); PG8_MMA(0, 1, At, B1); PG8_BAR; PG8_SCHED;
            PG8_LDA(At, 0, 1); PG8_STAGE(PG8_SB(0, 0), b2, voffB); PG8_STAGE(PG8_SB(0, 1), b2 + hstepB, voffB); PG8_STAGE(PG8_SA(0, 0), a2, voffA);
            PG8_WAIT_V(8); PG8_WAIT_L(0); PG8_BAR; PG8_MMA(1, 0, At, B0); PG8_MMA(1, 1, At, B1); PG8_BAR; PG8_SCHED;
            PG8_LDB(B0, 1, 0); PG8_LDB(B1, 1, 1); PG8_SCHED; PG8_LDA(At, 1, 0); PG8_STAGE(PG8_SA(0, 1), a2 + hstepA, voffA);
            PG8_WAIT_V(8); PG8_WAIT_L(0); PG8_BAR; PG8_MMA(0, 0, At, B0); PG8_MMA(0, 1, At, B1); PG8_BAR; PG8_SCHED;
            PG8_LDA(At, 1, 1); PG8_STAGE(PG8_SB(1, 0), b3, voffB); PG8_STAGE(PG8_SB(1, 1), b3 + hstepB, voffB); PG8_STAGE(PG8_SA(1, 0), a3, voffA);
            PG8_WAIT_V(8); PG8_WAIT_L(0); PG8_BAR; PG8_MMA(1, 0, At, B0); PG8_MMA(1, 1, At, B1); PG8_BAR; PG8_SCHED;
            } else {
            PG8_LDB(B0, 0, 0); PG8_SCHED; PG8_LDA(At, 0, 0); PG8_STAGE(PG8_SA(1, 1), a1 + hstepA, voffA);
            PG8_WAIT_L(8); PG8_BAR; PG8_WAIT_L(0); PG8_MMA(0, 0, At, B0); PG8_BAR; PG8_SCHED;
            PG8_LDB(B1, 0, 1); PG8_STAGE(PG8_SB(0, 0), b2, voffB);
            PG8_BAR; PG8_WAIT_L(0); PG8_MMA(0, 1, At, B1); PG8_BAR;
            PG8_LDA(At, 0, 1); PG8_STAGE(PG8_SA(0, 0), a2, voffA);
            PG8_BAR; PG8_WAIT_L(0); PG8_MMA(1, 0, At, B0); PG8_BAR; PG8_SCHED;
            PG8_STAGE(PG8_SB(0, 1), b2 + hstepB, voffB);
            PG8_WAIT_V(6); PG8_BAR; PG8_MMA(1, 1, At, B1); PG8_BAR;
            PG8_LDB(B0, 1, 0); PG8_SCHED; PG8_LDA(At, 1, 0); PG8_STAGE(PG8_SA(0, 1), a2 + hstepA, voffA);
            PG8_WAIT_L(8); PG8_BAR; PG8_WAIT_L(0); PG8_MMA(0, 0, At, B0); PG8_BAR; PG8_SCHED;
            PG8_LDB(B1, 1, 1); PG8_STAGE(PG8_SB(1, 0), b3, voffB);
            PG8_BAR; PG8_WAIT_L(0); PG8_MMA(0, 1, At, B1); PG8_BAR;
            PG8_LDA(At, 1, 1); PG8_STAGE(PG8_SA(1, 0), a3, voffA);
            PG8_BAR; PG8_WAIT_L(0); PG8_MMA(1, 0, At, B0); PG8_BAR; PG8_SCHED;
            PG8_STAGE(PG8_SB(1, 1), b3 + hstepB, voffB);
            PG8_WAIT_V(6); PG8_BAR; PG8_MMA(1, 1, At, B1); PG8_BAR;
            }
        }
        if constexpr (ALIGN_EPI) { if (wr == 0) PG8_BAR; }
        if constexpr (after_drain<Epi>::value) {   }
        else if constexpr (EXTACC == 1) E.inplace(acc, cur, wr, wc, fr, fq); else E(acc, cur, wr, wc, fr, fq);
        if (!has_next || EXTACC != 0 || after_drain<Epi>::value) break;
#pragma unroll
        for (int a = 0; a < 2; ++a)
#pragma unroll
            for (int b = 0; b < 2; ++b)
#pragma unroll
                for (int m = 0; m < 4; ++m)
#pragma unroll
                    for (int n = 0; n < 2; ++n) acc[a][b][m][n] = (f32x4){0.f, 0.f, 0.f, 0.f};
        cur = nxt; cA = nA; cB = nB; ++ui;
        if constexpr (ALIGN_EPI) { if (wr == 1) PG8_BAR; }
    }
    PG8_WAIT_V(0);
    if constexpr (!ALIGN_EPI) { if (wr == 0) PG8_BAR; }
    PG8_BAR;
    if constexpr (after_drain<Epi>::value) E.fused(acc, cur, lds);
#undef PG8_SA
#undef PG8_SB
#undef PG8_STAGE
#undef PG8_LDA
#undef PG8_LDB
#undef PG8_MMA
#undef PG8_WAIT_V
#undef PG8_WAIT_L
#undef PG8_BAR
#undef PG8_SCHED
}
}

constexpr int DM = 1024, NB = 8, SEQ = 2048, MTOK = NB * SEQ, CTXL = 256, MCTX = NB * CTXL;
constexpr int HGD = 512, DFF = 2816, DFF2 = 5632, INDIM = 5120, NMOD = 6;
constexpr float EPSN = 1e-6f;
constexpr int NWAVES = 8, NTHR = 512;
constexpr int LDS_BYTES = 147456;
#ifndef DUP_MASK
#define DUP_MASK 0
#endif
#define REPS(k) ((((DUP_MASK) >> (k)) & 1) ? 2 : 1)
#ifndef PROBE_K
#define PROBE_K -1
#endif
#ifndef EXTRA_SYNCS
#define EXTRA_SYNCS 0
#endif

constexpr size_t MiB = 1u << 20;
constexpr size_t WS_MX = 0;
constexpr size_t WS_LB = 256 * 1024;
constexpr size_t WS_SLOT = 1 * MiB;
constexpr size_t WS_WFS = 2 * MiB, WS_TCH = 3 * MiB;
constexpr size_t WS_BAR = 512 * 1024, BAR_BYTES = 32768;
constexpr int MISC_OFF = 147456 - 128;
constexpr size_t WS_WIN = 6 * MiB;
constexpr size_t WS_WPQ = 16 * MiB;
constexpr size_t WS_WA = 18 * MiB, WS_WB = 19 * MiB, WS_WOUT = 20 * MiB;
constexpr size_t WS_CS = 22 * MiB;
constexpr size_t WS_WUP = 6 * MiB;
constexpr size_t WS_WDN = 250 * MiB;
constexpr size_t WS_HX = 38 * MiB;
constexpr size_t WS_OF = 38 * MiB, WS_OB = 54 * MiB;
constexpr size_t WS_TMP = 38 * MiB;
constexpr size_t WS_H2 = 38 * MiB;
constexpr size_t WS_Q = 74 * MiB, WS_V = 90 * MiB, WS_OG = 106 * MiB, WS_GA = 122 * MiB, WS_GBG = 154 * MiB, WS_PQT = 186 * MiB;
constexpr size_t WS_GFC = 218 * MiB, WS_GBC = 222 * MiB, WS_VC = 226 * MiB;
constexpr size_t WS_YF = 228 * MiB;
constexpr size_t WS_YH = 74 * MiB;
constexpr size_t WS_MRG = 186 * MiB;
constexpr size_t WS_Z = 74 * MiB;
constexpr size_t WS_A2 = 162 * MiB;
constexpr size_t WS_XO = 38 * MiB;
constexpr size_t WS_END = 256 * MiB;

typedef unsigned short bf16;
typedef float f32x4 __attribute__((ext_vector_type(4)));
typedef unsigned u32x4 __attribute__((ext_vector_type(4)));
typedef unsigned u32x2 __attribute__((ext_vector_type(2)));
typedef float f32x2 __attribute__((ext_vector_type(2)));
#define LAS __attribute__((address_space(3)))

struct Params {
    const float* in[19];
    float* out;
    unsigned char* ws;
};

__device__ __forceinline__ float bf2f(unsigned short b) { return __uint_as_float(((unsigned)b) << 16); }
__device__ __forceinline__ float bflo(unsigned w) { return __uint_as_float(w << 16); }
__device__ __forceinline__ float bfhi(unsigned w) { return __uint_as_float(w & 0xffff0000u); }
__device__ __forceinline__ unsigned f2bf(float f) { unsigned u = __float_as_uint(f); return (u + 0x7fffu + ((u >> 16) & 1u)) >> 16; }
__device__ __forceinline__ unsigned pk2(float lo, float hi);
typedef __bf16 bf16x2_t __attribute__((ext_vector_type(2)));
__device__ __forceinline__ unsigned hwpk2(float lo, float hi) { const f32x2 v = {lo, hi}; const bf16x2_t r = __builtin_convertvector(v, bf16x2_t); return __builtin_bit_cast(unsigned, r); }
__device__ __forceinline__ unsigned pk2(float lo, float hi) { return hwpk2(lo, hi); }
__device__ __forceinline__ float sigmoidf_(float x) { return __builtin_amdgcn_rcpf(1.f + __expf(-x)); }
__device__ __forceinline__ float siluf_(float x) { return x * __builtin_amdgcn_rcpf(1.f + __expf(-x)); }
__device__ __forceinline__ float wave_sum(float v) {
#pragma unroll
    for (int o = 1; o < 64; o <<= 1) v += __shfl_xor(v, o);
    return v;
}
__device__ __forceinline__ u32x4 pack8(const f32x4 a, const f32x4 b) { u32x4 w; w.x = pk2(a[0], a[1]); w.y = pk2(a[2], a[3]); w.z = pk2(b[0], b[1]); w.w = pk2(b[2], b[3]); return w; }

typedef __attribute__((address_space(1))) unsigned gu32;
#define XB_TMO      128
#define XB_XCNT(j)  (256  + 64 * (j))
#define XB_XSUB(j)  (1280 + 64 * (j))
#define XB_XGEN(j)  (2304 + 64 * (j))
#define XB_TOP      3328
#define XB_TOPGEN   3392
#define XCD_BAR_WORDS 3456
#define XB_SPIN_CAP (1u << 18)

__device__ __forceinline__ unsigned xb_ld(unsigned* p)              { return __hip_atomic_load(p, __ATOMIC_RELAXED, __HIP_MEMORY_SCOPE_AGENT); }
__device__ __forceinline__ unsigned xb_add(unsigned* p, unsigned v) { return __hip_atomic_fetch_add(p, v, __ATOMIC_RELAXED, __HIP_MEMORY_SCOPE_AGENT); }
__device__ __forceinline__ unsigned xb_xcc_id() { return (unsigned)__builtin_amdgcn_s_getreg((3 << 11) | 20) & 0xFu; }
#define XB_SPIN(cond, bar) do { unsigned _sp = 0; while (cond) { __builtin_amdgcn_s_sleep(1); \
    if ((++_sp & 255u) == 0u) { if (xb_ld(&(bar)[XB_TMO])) break; if (_sp > XB_SPIN_CAP) { atomicAdd(&(bar)[XB_TMO], 1u); break; } } } } while (0)

struct XcdBarrier {
    unsigned* bar; unsigned x;
    volatile LAS unsigned* st;
};

__device__ __forceinline__ XcdBarrier xcd_barrier_post(unsigned* bar, volatile LAS unsigned* st) {
    XcdBarrier b; b.bar = bar; b.x = xb_xcc_id(); b.st = st;
    if (threadIdx.x == 0) (void)xb_add(&bar[XB_XCNT(b.x)], 1u);
    return b;
}
__device__ __forceinline__ void xcd_barrier_complete(unsigned* bar, unsigned x, unsigned& nloc, unsigned& nx) {
    const unsigned G = gridDim.x * gridDim.y * gridDim.z;
    unsigned sum, cnt, mine, sp = 0u;
    for (;;) {
        sum = 0u; cnt = 0u; mine = 0u;
#pragma unroll
        for (unsigned j = 0; j < 16; ++j) { const unsigned c = xb_ld(&bar[XB_XCNT(j)]); sum += c; cnt += (c > 0u) ? 1u : 0u; mine = (j == x) ? c : mine; }
        if (sum == G) break;
        __builtin_amdgcn_s_sleep(1);
        if ((++sp & 255u) == 0u) { if (xb_ld(&bar[XB_TMO])) break; if (sp > XB_SPIN_CAP) { atomicAdd(&bar[XB_TMO], 1u); break; } }
    }
    nloc = mine > 0u ? mine : 1u; nx = cnt > 0u ? cnt : 1u;
}

__device__ __forceinline__ void xcd_barrier(const XcdBarrier& b) {
    asm volatile("s_waitcnt vmcnt(0)" ::: "memory");
    __syncthreads();
    if (threadIdx.x == 0) {
        unsigned* bar = b.bar;
        __builtin_amdgcn_s_waitcnt(0);
        unsigned nloc = b.st[0], nx = b.st[1];
        if (nloc == 0u) { xcd_barrier_complete(bar, b.x, nloc, nx); b.st[0] = nloc; b.st[1] = nx; }
        const unsigned old = xb_add(&bar[XB_XSUB(b.x)], 1u);
        const unsigned gen = old / nloc;
        if (old + 1u == (gen + 1u) * nloc) {
            __builtin_amdgcn_fence(__ATOMIC_RELEASE, "agent");
            asm volatile("s_waitcnt vmcnt(0)" ::: "memory");
            const unsigned og = xb_add(&bar[XB_TOP], 1u);
            const unsigned tg = og / nx;
            if (og + 1u == (tg + 1u) * nx) xb_add(&bar[XB_TOPGEN], 1u);
            else XB_SPIN(xb_ld(&bar[XB_TOPGEN]) == tg, bar);
            __builtin_amdgcn_fence(__ATOMIC_ACQUIRE, "agent");
            xb_add(&bar[XB_XGEN(b.x)], 1u);
            asm volatile("s_waitcnt vmcnt(0)" ::: "memory");
        } else {
            XB_SPIN(xb_ld(&bar[XB_XGEN(b.x)]) == gen, bar);
            __builtin_amdgcn_fence(__ATOMIC_ACQUIRE, "agent");
            asm volatile("s_waitcnt vmcnt(0)" ::: "memory");
        }
    }
    __syncthreads();
}


struct FIn {
    unsigned char* ws; float* out;
    __device__ __forceinline__ void operator()(const pg8::Unit& u, int row, int col, f32x4 v0, f32x4 v1) const {
        const int seg = u.pn >> 1, c = col & 511;
        if (seg == 0 || seg == 4) { f32x4 a, b;
#pragma unroll
            for (int i = 0; i < 4; ++i) { a[i] = siluf_(v0[i]); b[i] = siluf_(v1[i]); }
            bf16* dst = (bf16*)(ws + (seg == 0 ? WS_Q : WS_OG));
            *(u32x4*)(dst + (size_t)row * 512 + c) = pack8(a, b);
        } else if (seg == 1 || seg == 2) {
            const float* lb = (const float*)(ws + WS_LB);
            const f32x4 l0 = *(const f32x4*)(lb + c), l1 = *(const f32x4*)(lb + c + 4); f32x4 a, b;
#pragma unroll
            for (int i = 0; i < 4; ++i) { a[i] = l0[i] + (1.f - l0[i]) * sigmoidf_(v0[i]); b[i] = l1[i] + (1.f - l1[i]) * sigmoidf_(v1[i]); }
            float* dst;
            if (u.pm < 64) dst = out + (seg == 1 ? (size_t)0 : (size_t)MTOK * 512) + (size_t)row * 512 + c;
            else dst = (float*)(ws + (seg == 1 ? WS_GFC : WS_GBC)) + (size_t)(row - MTOK) * 512 + c;
            *(f32x4*)dst = a; *(f32x4*)(dst + 4) = b;
        } else if (seg == 3) {
            bf16* dst;
            if (u.pm < 64) dst = (bf16*)(ws + WS_V) + (size_t)row * 512 + c; else dst = (bf16*)(ws + WS_VC) + (size_t)(row - MTOK) * 512 + c;
            *(u32x4*)dst = pack8(v0, v1);
        } else { f32x4 a, b;
#pragma unroll
            for (int i = 0; i < 4; ++i) { a[i] = sigmoidf_(v0[i]); b[i] = sigmoidf_(v1[i]); }
            bf16* dst = (seg < 7) ? ((bf16*)(ws + WS_GA) + (size_t)row * 1024 + (col - 5 * 512)) : ((bf16*)(ws + WS_GBG) + (size_t)row * 1024 + (col - 7 * 512));
            *(u32x4*)dst = pack8(a, b);
        }
    }
};
struct FPQ {
    bf16* pqt;
    __device__ __forceinline__ void operator()(const pg8::Unit&, int row, int col, f32x4 v0, f32x4 v1) const {
        bf16* dst = pqt + (size_t)(row & 511) * 32768 + (size_t)(col >> 11) * 4096 + (size_t)(row >> 9) * 1024 + ((col & 2047) >> 1);
        u32x2 ev, od; ev.x = pk2(v0[0], v0[2]); ev.y = pk2(v1[0], v1[2]); od.x = pk2(v0[1], v0[3]); od.y = pk2(v1[1], v1[3]);
        *(u32x2*)dst = ev; *(u32x2*)(dst + 2048) = od;
    }
};
struct EpiDft {
    static constexpr bool PERM = true;
    bf16* yf; unsigned* flags;
    __device__ __forceinline__ void operator()(const f32x4 (&acc)[2][2][4][2], const pg8::Unit& u, int wr, int wc, int fr, int fq) const {
        const int z = u.z & 255, eo = u.z >> 8, pair = (z * 4 + u.pm) * 2 + u.pn;
        const int row0 = u.pm * 256 + wr * 64 + fr, col0 = u.pn * 256 + wc * 32 + 8 * fq;
        unsigned* flag = flags + pair * 16;
        if (eo) {
#pragma unroll
            for (int ai = 0; ai < 2; ++ai)
#pragma unroll
                for (int m = 0; m < 4; ++m)
#pragma unroll
                    for (int bj = 0; bj < 2; ++bj) { const int row = row0 + ai * 128 + m * 16, col = col0 + bj * 128;
                        *(u32x4*)(yf + ((size_t)z * SEQ + 1024 + row) * 512 + col) = pack8(acc[ai][bj][m][0] * (1.f / 512.f), acc[ai][bj][m][1] * (1.f / 512.f)); }
            asm volatile("s_waitcnt vmcnt(0)" ::: "memory");
            __syncthreads();
            if (threadIdx.x == 0) { __builtin_amdgcn_fence(__ATOMIC_RELEASE, "agent"); asm volatile("s_waitcnt vmcnt(0)" ::: "memory");
                __hip_atomic_store(flag, 1u, __ATOMIC_RELAXED, __HIP_MEMORY_SCOPE_AGENT); }
        } else {
            if (threadIdx.x == 0) { unsigned spins = 0;
                while (__hip_atomic_load(flag, __ATOMIC_RELAXED, __HIP_MEMORY_SCOPE_AGENT) == 0u && ++spins < (1u << 22)) __builtin_amdgcn_s_sleep(2);
                __builtin_amdgcn_fence(__ATOMIC_ACQUIRE, "agent"); asm volatile("s_waitcnt vmcnt(0)" ::: "memory"); }
            __syncthreads();
#pragma unroll
            for (int ai = 0; ai < 2; ++ai)
#pragma unroll
                for (int m = 0; m < 4; ++m) {
#pragma unroll
                    for (int bj = 0; bj < 2; ++bj) { const int row = row0 + ai * 128 + m * 16, col = col0 + bj * 128;
                        bf16* plo = yf + ((size_t)z * SEQ + row) * 512 + col; bf16* phi = plo + (size_t)1024 * 512;
                        const u32x4 o = *(const u32x4*)phi;
                        const f32x4 e0 = acc[ai][bj][m][0] * (1.f / 512.f), e1 = acc[ai][bj][m][1] * (1.f / 512.f);
                        f32x4 o0, o1; o0[0] = bflo(o.x); o0[1] = bfhi(o.x); o0[2] = bflo(o.y); o0[3] = bfhi(o.y); o1[0] = bflo(o.z); o1[1] = bfhi(o.z); o1[2] = bflo(o.w); o1[3] = bfhi(o.w);
                        *(u32x4*)plo = pack8(e0 + o0, e1 + o1); *(u32x4*)phi = pack8(e0 - o0, e1 - o1); }
                    asm volatile("" ::: "memory"); }
        }
    }
};
struct FYa {
    const bf16* ga;
    __device__ __forceinline__ void scale(const pg8::Unit&, int row, int col, f32x4& v0, f32x4& v1) const {
        const size_t o = (size_t)row * 1024 + col; const u32x4 g = *(const u32x4*)(ga + o);
        v0[0] *= bflo(g.x); v0[1] *= bfhi(g.x); v0[2] *= bflo(g.y); v0[3] *= bfhi(g.y); v1[0] *= bflo(g.z); v1[1] *= bfhi(g.z); v1[2] *= bflo(g.w); v1[3] *= bfhi(g.w);
    }
    __device__ __forceinline__ void operator()(const pg8::Unit&, int, int, f32x4, f32x4) const {}
};
struct FYb {
    const bf16* gbg; bf16* mrg;
    __device__ __forceinline__ void scale(const pg8::Unit&, int row, int col, f32x4& v0, f32x4& v1) const {
        const size_t o = (size_t)row * 1024 + col; const u32x4 h = *(const u32x4*)(gbg + o);
        v0[0] *= __builtin_amdgcn_rcpf(bflo(h.x)); v0[1] *= __builtin_amdgcn_rcpf(bfhi(h.x)); v0[2] *= __builtin_amdgcn_rcpf(bflo(h.y)); v0[3] *= __builtin_amdgcn_rcpf(bfhi(h.y));
        v1[0] *= __builtin_amdgcn_rcpf(bflo(h.z)); v1[1] *= __builtin_amdgcn_rcpf(bfhi(h.z)); v1[2] *= __builtin_amdgcn_rcpf(bflo(h.w)); v1[3] *= __builtin_amdgcn_rcpf(bfhi(h.w));
    }
    __device__ __forceinline__ void operator()(const pg8::Unit&, int row, int col, f32x4 v0, f32x4 v1) const {
        const size_t o = (size_t)row * 1024 + col; const u32x4 h = *(const u32x4*)(gbg + o);
        f32x4 a, b; a[0] = v0[0] * bflo(h.x); a[1] = v0[1] * bfhi(h.x); a[2] = v0[2] * bflo(h.y); a[3] = v0[3] * bfhi(h.y);
        b[0] = v1[0] * bflo(h.z); b[1] = v1[1] * bfhi(h.z); b[2] = v1[2] * bflo(h.w); b[3] = v1[3] * bfhi(h.w);
        *(u32x4*)(mrg + o) = pack8(a, b);
    }
};
struct FYab {
    const bf16* ga; const bf16* gbg;
    __device__ __forceinline__ void scale(const pg8::Unit&, int row, int col, f32x4& v0, f32x4& v1) const {
        const size_t o = (size_t)row * 1024 + col; const u32x4 g = *(const u32x4*)(ga + o), h = *(const u32x4*)(gbg + o);
        v0[0] *= bflo(g.x) * __builtin_amdgcn_rcpf(bflo(h.x)); v0[1] *= bfhi(g.x) * __builtin_amdgcn_rcpf(bfhi(h.x)); v0[2] *= bflo(g.y) * __builtin_amdgcn_rcpf(bflo(h.y)); v0[3] *= bfhi(g.y) * __builtin_amdgcn_rcpf(bfhi(h.y));
        v1[0] *= bflo(g.z) * __builtin_amdgcn_rcpf(bflo(h.z)); v1[1] *= bfhi(g.z) * __builtin_amdgcn_rcpf(bfhi(h.z)); v1[2] *= bflo(g.w) * __builtin_amdgcn_rcpf(bflo(h.w)); v1[3] *= bfhi(g.w) * __builtin_amdgcn_rcpf(bfhi(h.w));
    }
    __device__ __forceinline__ void operator()(const pg8::Unit&, int, int, f32x4, f32x4) const {}
};
struct FYaT {
    const bf16* ga; bf16* tmp;
    __device__ __forceinline__ void operator()(const pg8::Unit&, int row, int col, f32x4 v0, f32x4 v1) const {
        const size_t o = (size_t)row * 1024 + col; const u32x4 g = *(const u32x4*)(ga + o);
        f32x4 a, b; a[0] = v0[0] * bflo(g.x); a[1] = v0[1] * bfhi(g.x); a[2] = v0[2] * bflo(g.y); a[3] = v0[3] * bfhi(g.y);
        b[0] = v1[0] * bflo(g.z); b[1] = v1[1] * bfhi(g.z); b[2] = v1[2] * bflo(g.w); b[3] = v1[3] * bfhi(g.w);
        *(u32x4*)(tmp + o) = pack8(a, b);
    }
};
struct FYbT {
    const bf16* gbg; const bf16* tmp; bf16* mrg;
    __device__ __forceinline__ void operator()(const pg8::Unit&, int row, int col, f32x4 v0, f32x4 v1) const {
        const size_t o = (size_t)row * 1024 + col; const u32x4 g = *(const u32x4*)(gbg + o); const u32x4 t = *(const u32x4*)(tmp + o);
        f32x4 a, b; a[0] = bflo(t.x) + v0[0] * bflo(g.x); a[1] = bfhi(t.x) + v0[1] * bfhi(g.x); a[2] = bflo(t.y) + v0[2] * bflo(g.y); a[3] = bfhi(t.y) + v0[3] * bfhi(g.y);
        b[0] = bflo(t.z) + v1[0] * bflo(g.z); b[1] = bfhi(t.z) + v1[1] * bfhi(g.z); b[2] = bflo(t.w) + v1[2] * bflo(g.w); b[3] = bfhi(t.w) + v1[3] * bfhi(g.w);
        *(u32x4*)(mrg + o) = pack8(a, b);
    }
};
struct FRes {
    const float* src; float* dst; const float* mx; int mod;
    __device__ __forceinline__ void operator()(const pg8::Unit&, int row, int col, f32x4 v0, f32x4 v1) const {
        const size_t o = (size_t)row * 1024 + col; const float* m = mx + (size_t)(row >> 11) * (NMOD * DM) + mod * DM + col;
        const f32x4 m0 = *(const f32x4*)m, m1 = *(const f32x4*)(m + 4), s0 = *(const f32x4*)(src + o), s1 = *(const f32x4*)(src + o + 4);
        *(f32x4*)(dst + o) = s0 + m0 * v0; *(f32x4*)(dst + o + 4) = s1 + m1 * v1;
    }
};
struct FUp {
    bf16* z; int ld;
    __device__ __forceinline__ void operator()(const pg8::Unit&, int row, int col, f32x4 v0, f32x4 v1) const {
        *(u32x4*)(z + (size_t)row * ld + col) = pack8(v0, v1);
    }
};

struct EpiFinal {
    static constexpr bool PERM = true, AFTER_DRAIN = true;
    float* xio; const float* mx; const float* fg; float* slots; unsigned* flags;
    __device__ __forceinline__ void operator()(const f32x4 (&)[2][2][4][2], const pg8::Unit&, int, int, int, int) const {}
    __device__ __forceinline__ void fused(f32x4 (&acc)[2][2][4][2], const pg8::Unit& u, PG8_LAS unsigned char* ldsl) const {
        int t2_ = threadIdx.x; asm volatile("" : "+v"(t2_));
        const int tid = t2_, wid = __builtin_amdgcn_readfirstlane(tid >> 6), lane = tid & 63, wr = wid >> 2, wc = wid & 3, fr = lane & 15, fq = lane >> 4;
        PG8_LAS float* red = (PG8_LAS float*)ldsl;
        PG8_LAS float* rin = red + 1024;
        const int row0 = u.pm * 256 + wr * 64 + fr, col0 = u.pn * 256 + wc * 32 + 8 * fq;
        float ss[2][4];
#pragma unroll
        for (int ai = 0; ai < 2; ++ai)
#pragma unroll
            for (int m = 0; m < 4; ++m) ss[ai][m] = 0.f;
#pragma unroll
        for (int bj = 0; bj < 2; ++bj) { const int col = col0 + bj * 128;
            const float* mm = mx + (size_t)(u.pm >> 3) * (NMOD * DM) + 5 * DM + col;
            const f32x4 m0 = *(const f32x4*)mm, m1 = *(const f32x4*)(mm + 4);
#pragma unroll
            for (int ai = 0; ai < 2; ++ai)
#pragma unroll
                for (int m = 0; m < 4; ++m) { const size_t o = (size_t)(row0 + ai * 128 + m * 16) * 1024 + col;
                    const f32x4 x0 = *(const f32x4*)(xio + o), x1 = *(const f32x4*)(xio + o + 4);
                    const f32x4 v0 = x0 + m0 * acc[ai][bj][m][0], v1 = x1 + m1 * acc[ai][bj][m][1];
                    acc[ai][bj][m][0] = v0; acc[ai][bj][m][1] = v1;
                    ss[ai][m] += (v0[0] * v0[0] + v0[1] * v0[1]) + (v0[2] * v0[2] + v0[3] * v0[3]) + (v1[0] * v1[0] + v1[1] * v1[1]) + (v1[2] * v1[2] + v1[3] * v1[3]);
                    asm volatile("" ::: "memory"); } }
#pragma unroll
        for (int ai = 0; ai < 2; ++ai)
#pragma unroll
            for (int m = 0; m < 4; ++m) { float s = ss[ai][m]; s += __shfl_xor(s, 16); s += __shfl_xor(s, 32); ss[ai][m] = s; }
        if (fq == 0) {
#pragma unroll
            for (int ai = 0; ai < 2; ++ai)
#pragma unroll
                for (int m = 0; m < 4; ++m) red[(ai * 128 + wr * 64 + m * 16 + fr) * 4 + wc] = ss[ai][m]; }
        __syncthreads();
        float* myslot = slots + (size_t)(u.pm * 4 + u.pn) * 256;
        if (tid < 256) myslot[tid] = (red[tid * 4 + 0] + red[tid * 4 + 1]) + (red[tid * 4 + 2] + red[tid * 4 + 3]);
        asm volatile("s_waitcnt vmcnt(0)" ::: "memory");
        __syncthreads();
        unsigned* flag = flags + u.pm * 16;
        if (tid == 0) { __builtin_amdgcn_fence(__ATOMIC_RELEASE, "agent"); asm volatile("s_waitcnt vmcnt(0)" ::: "memory");
            __hip_atomic_fetch_add(flag, 1u, __ATOMIC_RELAXED, __HIP_MEMORY_SCOPE_AGENT);
            unsigned spins = 0;
            while (__hip_atomic_load(flag, __ATOMIC_RELAXED, __HIP_MEMORY_SCOPE_AGENT) < 4u && ++spins < (1u << 22)) __builtin_amdgcn_s_sleep(2);
            __builtin_amdgcn_fence(__ATOMIC_ACQUIRE, "agent"); asm volatile("s_waitcnt vmcnt(0)" ::: "memory"); }
        __syncthreads();
        if (tid < 256) { const float* sl = slots + (size_t)(u.pm * 4) * 256 + tid;
            const float tot = (sl[0] + sl[256]) + (sl[512] + sl[768]);
            rin[tid] = rsqrtf(tot * (1.f / DM) + EPSN); }
        __syncthreads();
#pragma unroll
        for (int bj = 0; bj < 2; ++bj) { const int col = col0 + bj * 128;
            const f32x4 g0 = *(const f32x4*)(fg + col), g1 = *(const f32x4*)(fg + col + 4);
#pragma unroll
            for (int ai = 0; ai < 2; ++ai)
#pragma unroll
                for (int m = 0; m < 4; ++m) { const float r = rin[ai * 128 + wr * 64 + m * 16 + fr]; const size_t o = (size_t)(row0 + ai * 128 + m * 16) * 1024 + col;
                    *(f32x4*)(xio + o) = acc[ai][bj][m][0] * r * g0; *(f32x4*)(xio + o + 4) = acc[ai][bj][m][1] * r * g1;
                    asm volatile("" ::: "memory"); } }
    }
};

__device__ __forceinline__ void transpose_item(const float* W, int K, int N, bf16* WT, LAS float* scr, int item, int lane) {
    const int nblk = N / 32, kb = item / nblk, nb = item % nblk, k0 = 64 * kb, n0 = 32 * nb;
#pragma unroll 8
    for (int i = 0; i < 32; ++i) { const int kk = 2 * i + (lane >> 5); scr[kk * 33 + (lane & 31)] = W[(size_t)(k0 + kk) * N + n0 + (lane & 31)]; }
    asm volatile("s_waitcnt lgkmcnt(0)" ::: "memory");
    const int c = lane & 7;
#pragma unroll
    for (int j = 0; j < 4; ++j) { const int n = (lane >> 3) + 8 * j; const LAS float* s = scr + (8 * c) * 33 + n;
        u32x4 o; o.x = pk2(s[0 * 33], s[1 * 33]); o.y = pk2(s[2 * 33], s[3 * 33]); o.z = pk2(s[4 * 33], s[5 * 33]); o.w = pk2(s[6 * 33], s[7 * 33]);
        *(u32x4*)(WT + (size_t)(n0 + n) * K + k0 + 8 * c) = o; }
    asm volatile("s_waitcnt lgkmcnt(0)" ::: "memory");
}

template <bool MOD>
__device__ __forceinline__ void norm_rows(const float* srcA, const float* srcB, int nA, const float* g, const float* mx, int shift_mod, int scale_mod,
                                          bf16* outb, float* outf, int r0, int nr, int lane) {
    f32x4 G[4], SH[4], cur[4], nxt[4];
    int curmod = -1;
    { const float* s0 = (r0 < nA) ? srcA + (size_t)r0 * DM : srcB + (size_t)(r0 - nA) * DM;
#pragma unroll
      for (int j = 0; j < 4; ++j) cur[j] = *(const f32x4*)(s0 + (lane + 64 * j) * 4); }
#pragma unroll 1
    for (int i = 0; i < nr; ++i) {
        const int m = r0 + i;
        if (i + 1 < nr) { const int m1 = m + 1; const float* s1 = (m1 < nA) ? srcA + (size_t)m1 * DM : srcB + (size_t)(m1 - nA) * DM;
#pragma unroll
            for (int j = 0; j < 4; ++j) nxt[j] = *(const f32x4*)(s1 + (lane + 64 * j) * 4); }
        const int mr = MOD ? ((m < nA) ? (m >> 11) : 8) : 0;
        if (mr != curmod) { curmod = mr;
#pragma unroll
            for (int j = 0; j < 4; ++j) { const int e = (lane + 64 * j) * 4; const f32x4 gg = *(const f32x4*)(g + e);
                if (MOD) { const f32x4 sc = *(const f32x4*)(mx + (size_t)mr * (NMOD * DM) + scale_mod * DM + e); SH[j] = *(const f32x4*)(mx + (size_t)mr * (NMOD * DM) + shift_mod * DM + e); G[j] = gg * (sc + 1.f); }
                else { G[j] = gg; SH[j] = (f32x4){0.f, 0.f, 0.f, 0.f}; } } }
        float s = 0.f;
#pragma unroll
        for (int j = 0; j < 4; ++j) s += (cur[j][0] * cur[j][0] + cur[j][1] * cur[j][1]) + (cur[j][2] * cur[j][2] + cur[j][3] * cur[j][3]);
        const float rinv = rsqrtf(wave_sum(s) * (1.f / DM) + EPSN);
#pragma unroll
        for (int j = 0; j < 4; ++j) { const int e = (lane + 64 * j) * 4; const f32x4 h = cur[j] * rinv * G[j] + SH[j];
            if (MOD) { u32x2 w; w.x = pk2(h[0], h[1]); w.y = pk2(h[2], h[3]); *(u32x2*)(outb + (size_t)m * DM + e) = w; }
            else *(f32x4*)(outf + (size_t)m * DM + e) = h; }
#pragma unroll
        for (int j = 0; j < 4; ++j) cur[j] = nxt[j];
    }
}

__device__ __forceinline__ void phase0(const Params& p, unsigned char* lds, int tid, int lane, int wave, int G, const int part) {
    float* ldsf = (float*)lds;
    float* mxo = (float*)(p.ws + WS_MX);
    if (part == 0) {
    for (int it = blockIdx.x; it < 192; it += G) {
        __syncthreads();
        {
            const float* c = p.in[1]; const float* cc = p.in[3]; const float* aw = p.in[4]; const float* ab = p.in[5];
            float* sc = ldsf;
            float* red = ldsf + 9 * 1024;
            for (int i = tid; i < 9 * 1024; i += NTHR) { const int r = i >> 10, k = i & 1023; const float cv = (r < 8) ? c[r * 1024 + k] : cc[k]; sc[i] = cv / (1.f + __expf(-cv)); }
            __syncthreads();
            const int n0 = it * 32, col = tid & 31, ks = tid >> 5;
            float a[9];
#pragma unroll
            for (int r = 0; r < 9; ++r) a[r] = 0.f;
            for (int k = ks * 64; k < ks * 64 + 64; ++k) { const float w = aw[(size_t)k * (NMOD * DM) + n0 + col];
#pragma unroll
                for (int r = 0; r < 9; ++r) a[r] += sc[r * 1024 + k] * w; }
#pragma unroll
            for (int r = 0; r < 9; ++r) red[(ks * 9 + r) * 32 + col] = a[r];
            __syncthreads();
            if (tid < 288) { const int r = tid >> 5, cl = tid & 31; float s = ab[n0 + cl];
                for (int k2 = 0; k2 < 16; ++k2) s += red[(k2 * 9 + r) * 32 + cl];
                mxo[r * (NMOD * DM) + n0 + cl] = s; }
        }
    }
    __syncthreads();
    { bf16* tch = (bf16*)(p.ws + WS_TCH); bf16* wfs = (bf16*)(p.ws + WS_WFS); const float* win = p.in[7];
      for (int i = blockIdx.x * NTHR + tid; i < 1024 * 64; i += G * NTHR) { const int n = i >> 6, c8 = (i & 63) * 8, gn = (n & 511) >> 7, j = n & 127; float vv[8];
#pragma unroll
          for (int e = 0; e < 8; ++e) { const int cp = c8 + e, idx = ((cp & 127) * j) & 127; const float ang = (float)idx * (1.f / 64.f);
              vv[e] = ((cp >> 7) == gn) ? ((n < 512) ? cospif(ang) : sinpif(ang)) : 0.f; }
          u32x4 w; w.x = pk2(vv[0], vv[1]); w.y = pk2(vv[2], vv[3]); w.z = pk2(vv[4], vv[5]); w.w = pk2(vv[6], vv[7]);
          *(u32x4*)(tch + (size_t)n * 512 + c8) = w;
          const f32x4 a = *(const f32x4*)(win + (size_t)n * INDIM + c8), b2 = *(const f32x4*)(win + (size_t)n * INDIM + c8 + 4);
          *(u32x4*)(wfs + (size_t)n * 512 + c8) = pack8(a, b2); } }
    }
    if (part == 0 && blockIdx.x == G - 1) { const float* hl = p.in[8]; float* lbo = (float*)(p.ws + WS_LB);
        if (tid < 512) { const float a = hl[tid], b = hl[512 + tid]; lbo[tid] = 1.f / (1.f + expf(b - a)); } }
    if (part == 0) return;
    { bf16* cs = (bf16*)(p.ws + WS_CS);
      for (int i = blockIdx.x * NTHR + tid; i < 2 * 1024 * 256; i += G * NTHR) { const int eo = i >> 18, l = (i >> 8) & 1023, kc = (i & 255) * 8; float vv[8];
#pragma unroll
          for (int e = 0; e < 8; ++e) { const int k = kc + e, sn = k >> 10, m = k & 1023;
              const float ang = eo ? (float)((l * (2 * m + 1)) & 2047) * (1.f / 1024.f) : (float)((l * m) & 1023) * (1.f / 512.f);
              vv[e] = sn ? -sinpif(ang) : cospif(ang); }
          u32x4 w; w.x = pk2(vv[0], vv[1]); w.y = pk2(vv[2], vv[3]); w.z = pk2(vv[4], vv[5]); w.w = pk2(vv[6], vv[7]);
          *(u32x4*)(cs + ((size_t)eo * 1024 + l) * 2048 + kc) = w; } }
    { LAS float* scr = (LAS float*)((LAS unsigned char*)lds + wave * 16384);
      const int gw = blockIdx.x * NWAVES + wave, NGW = G * NWAVES;
      constexpr int I_IN = 16 * 160, I_A = 8 * 32, I_B = 8 * 32, I_O = 16 * 32;
      for (int it = gw; it < ((G >= 192) ? I_IN : I_IN + I_A + I_B + I_O); it += NGW) { int r = it;
          if (r < I_IN) { transpose_item(p.in[7], 1024, INDIM, (bf16*)(p.ws + WS_WIN), scr, r, lane); continue; } r -= I_IN;
          if (r < I_A) { transpose_item(p.in[10], 512, 1024, (bf16*)(p.ws + WS_WA), scr, r, lane); continue; } r -= I_A;
          if (r < I_B) { transpose_item(p.in[11], 512, 1024, (bf16*)(p.ws + WS_WB), scr, r, lane); continue; } r -= I_B;
          transpose_item(p.in[12], 1024, 1024, (bf16*)(p.ws + WS_WOUT), scr, r, lane); } }
}

__device__ __forceinline__ void hgrn_mfma_item(const Params& p, unsigned char* lds, int item) {
    int tid_ = threadIdx.x; asm volatile("" : "+v"(tid_));
    const int tid = tid_, lane = tid & 63, w = __builtin_amdgcn_readfirstlane(tid >> 6), fr = lane & 15, fq = lane >> 4;
    const int vh = item & 1, dir = (item >> 1) & 1, h = (item >> 2) & 3, b = item >> 4;
    bf16* Qs = (bf16*)lds;
    bf16* Ks = Qs + 64 * 136;
    bf16* St = Ks + 64 * 136;
    bf16* Kh = St + 2 * 64 * 136;
    bf16* Vt = Kh + 128 * 72;
    bf16* Ps = Vt + 64 * 72;
    float* Et = (float*)(Ps + 64 * 72);
    float* Fr = Et + 128;
    float* Bt = Fr + 64 * 132;
    const int d = 16 * w + fr;
    const float* fL = p.out + (dir ? (size_t)MTOK * 512 : 0) + (size_t)b * SEQ * 512 + h * 128;
    const float* fC = (const float*)(p.ws + (dir ? WS_GBC : WS_GFC)) + (size_t)b * CTXL * 512 + h * 128;
    const bf16* qL = (const bf16*)(p.ws + WS_Q) + (size_t)b * SEQ * 512 + h * 128;
    const bf16* vL = (const bf16*)(p.ws + WS_V) + (size_t)b * SEQ * 512 + h * 128 + vh * 64;
    const bf16* vC = (const bf16*)(p.ws + WS_VC) + (size_t)b * CTXL * 512 + h * 128 + vh * 64;
    bf16* oL = (bf16*)(p.ws + (dir ? WS_OB : WS_OF)) + (size_t)b * SEQ * 512 + h * 128 + vh * 64;
    f32x4 Sa[4];
#pragma unroll
    for (int i = 0; i < 4; ++i) Sa[i] = (f32x4){0.f, 0.f, 0.f, 0.f};
    f32x4 fR[4]; u32x4 qR[2], vR;
#define HG_LOAD(cc_) do { const int _cc = (cc_); const bool _lat = _cc >= 4; const int _c = _lat ? _cc - 4 : _cc, _n = _lat ? SEQ : CTXL; \
        const float* _f = _lat ? fL : fC; const bf16* _v = _lat ? vL : vC; \
        _Pragma("unroll") for (int i = 0; i < 4; ++i) { const int _j = tid + 512 * i, _s = _c * 64 + (_j >> 5), _pos = dir ? (_n - 1 - _s) : _s; fR[i] = *(const f32x4*)(_f + (size_t)_pos * 512 + (_j & 31) * 4); } \
        if (_lat) { _Pragma("unroll") for (int i = 0; i < 2; ++i) { const int _j = tid + 512 * i, _s = _c * 64 + (_j >> 4), _pos = dir ? (_n - 1 - _s) : _s; qR[i] = *(const u32x4*)(qL + (size_t)_pos * 512 + (_j & 15) * 8); } } \
        { const int _s = _c * 64 + lane, _pos = dir ? (_n - 1 - _s) : _s; vR = *(const u32x4*)(_v + (size_t)_pos * 512 + w * 8); } } while (0)
#define HG_STAGE(lat_) do { \
        _Pragma("unroll") for (int i = 0; i < 4; ++i) { const int _j = tid + 512 * i; *(f32x4*)(Fr + (_j >> 5) * 132 + (_j & 31) * 4) = fR[i]; } \
        if (lat_) { _Pragma("unroll") for (int i = 0; i < 2; ++i) { const int _j = tid + 512 * i; *(u32x4*)(Qs + (_j >> 4) * 136 + (_j & 15) * 8) = qR[i]; } } } while (0)
    HG_LOAD(0);
    HG_STAGE(false);
    __syncthreads();
    for (int cc = 0; cc < 36; ++cc) {
        const bool lat = cc >= 4; const int c = lat ? cc - 4 : cc;
        bf16* Scur = St + (cc & 1) * (64 * 136); bf16* Snxt = St + ((cc & 1) ^ 1) * (64 * 136);
        {
            f32x2 fown[8];
#pragma unroll
            for (int i = 0; i < 8; ++i) fown[i] = *(const f32x2*)(Fr + (8 * w + i) * 132 + 2 * lane);
            *(f32x2*)(Bt + w * 128 + 2 * lane) = ((fown[0] * fown[1]) * (fown[2] * fown[3])) * ((fown[4] * fown[5]) * (fown[6] * fown[7]));
            __syncthreads();
            f32x2 cum = (f32x2){1.f, 1.f};
            { f32x2 t[7];
#pragma unroll
              for (int i = 0; i < 7; ++i) t[i] = *(const f32x2*)(Bt + i * 128 + 2 * lane);
#pragma unroll
              for (int i = 0; i < 7; ++i) if (i < w) cum = cum * t[i]; }
            unsigned kp0[4], kp1[4];
#pragma unroll
            for (int i = 0; i < 8; i += 2) { float k0v[2], k1v[2];
#pragma unroll
                for (int u = 0; u < 2; ++u) { const int r = 8 * w + i + u; const f32x2 f = fown[i + u]; cum = cum * f;
                    const float cm0 = fmaxf(cum[0], 1e-30f), cm1 = fmaxf(cum[1], 1e-30f);
                    const float kt0 = (1.f - f[0]) * __builtin_amdgcn_rcpf(cm0), kt1 = (1.f - f[1]) * __builtin_amdgcn_rcpf(cm1);
                    if (lat) { const unsigned qr = *(const unsigned*)(Qs + r * 136 + 2 * lane);
                        *(unsigned*)(Qs + r * 136 + 2 * lane) = hwpk2(bflo(qr) * cm0, bfhi(qr) * cm1); *(unsigned*)(Ks + r * 136 + 2 * lane) = hwpk2(kt0, kt1); }
                    k0v[u] = kt0; k1v[u] = kt1; }
                kp0[i >> 1] = hwpk2(k0v[0], k0v[1]); kp1[i >> 1] = hwpk2(k1v[0], k1v[1]); }
            u32x4 q0; q0.x = kp0[0]; q0.y = kp0[1]; q0.z = kp0[2]; q0.w = kp0[3]; u32x4 q1; q1.x = kp1[0]; q1.y = kp1[1]; q1.z = kp1[2]; q1.w = kp1[3];
            *(u32x4*)(Kh + (2 * lane) * 72 + 8 * w) = q0; *(u32x4*)(Kh + (2 * lane + 1) * 72 + 8 * w) = q1;
            if (w == 7) *(f32x2*)(Et + 2 * lane) = cum;
            Vt[(8 * w + 0) * 72 + lane] = (bf16)(vR.x & 0xffffu); Vt[(8 * w + 1) * 72 + lane] = (bf16)(vR.x >> 16); Vt[(8 * w + 2) * 72 + lane] = (bf16)(vR.y & 0xffffu); Vt[(8 * w + 3) * 72 + lane] = (bf16)(vR.y >> 16);
            Vt[(8 * w + 4) * 72 + lane] = (bf16)(vR.z & 0xffffu); Vt[(8 * w + 5) * 72 + lane] = (bf16)(vR.z >> 16); Vt[(8 * w + 6) * 72 + lane] = (bf16)(vR.w & 0xffffu); Vt[(8 * w + 7) * 72 + lane] = (bf16)(vR.w >> 16);
        }
        if (cc + 1 < 36) HG_LOAD(cc + 1);
        __syncthreads();
        const int ti = w >> 1, x2 = 2 * (w & 1);
        if (lat) {
#pragma unroll
            for (int u2 = 0; u2 < 2; ++u2) { const int si = x2 + u2; f32x4 acc = (f32x4){0.f, 0.f, 0.f, 0.f};
                if (si <= ti) {
#pragma unroll
                    for (int kk = 0; kk < 4; ++kk) { const pg8::bf16x8 a = *(const pg8::bf16x8*)(Ks + (si * 16 + fr) * 136 + kk * 32 + fq * 8), bq = *(const pg8::bf16x8*)(Qs + (ti * 16 + fr) * 136 + kk * 32 + fq * 8);
                        acc = __builtin_amdgcn_mfma_f32_16x16x32_bf16(a, bq, acc, 0, 0, 0); }
                    if (si == ti) {
#pragma unroll
                        for (int r = 0; r < 4; ++r) if (4 * fq + r > fr) acc[r] = 0.f; } }
                u32x2 pw; pw.x = hwpk2(acc[0], acc[1]); pw.y = hwpk2(acc[2], acc[3]);
                *(u32x2*)(Ps + (ti * 16 + fr) * 72 + si * 16 + 4 * fq) = pw; }
        }
        {
            const f32x4 et = *(const f32x4*)(Et + w * 16 + 4 * fq);
            pg8::bf16x8 ka[2];
#pragma unroll
            for (int kk = 0; kk < 2; ++kk) ka[kk] = *(const pg8::bf16x8*)(Kh + (w * 16 + fr) * 72 + kk * 32 + fq * 8);
#pragma unroll
            for (int vi = 0; vi < 4; ++vi) {
#pragma unroll
                for (int kk = 0; kk < 2; ++kk) { const pg8::bf16x8 bv = *(const pg8::bf16x8*)(Vt + (vi * 16 + fr) * 72 + kk * 32 + fq * 8);
                    Sa[vi] = __builtin_amdgcn_mfma_f32_16x16x32_bf16(ka[kk], bv, Sa[vi], 0, 0, 0); }
                Sa[vi] = Sa[vi] * et;
                u32x2 sw; sw.x = hwpk2(Sa[vi][0], Sa[vi][1]); sw.y = hwpk2(Sa[vi][2], Sa[vi][3]);
                *(u32x2*)(Snxt + (vi * 16 + fr) * 136 + w * 16 + 4 * fq) = sw; }
        }
        f32x4 Oa[2];
        Oa[0] = (f32x4){0.f, 0.f, 0.f, 0.f}; Oa[1] = (f32x4){0.f, 0.f, 0.f, 0.f};
        if (lat) {
#pragma unroll
            for (int kk = 0; kk < 4; ++kk) { const pg8::bf16x8 bq = *(const pg8::bf16x8*)(Qs + (ti * 16 + fr) * 136 + kk * 32 + fq * 8);
#pragma unroll
                for (int u2 = 0; u2 < 2; ++u2) { const pg8::bf16x8 a = *(const pg8::bf16x8*)(Scur + ((x2 + u2) * 16 + fr) * 136 + kk * 32 + fq * 8);
                    Oa[u2] = __builtin_amdgcn_mfma_f32_16x16x32_bf16(a, bq, Oa[u2], 0, 0, 0); } }
        }
        __syncthreads();
        if (lat) {
#pragma unroll
            for (int kk = 0; kk < 2; ++kk) { const pg8::bf16x8 bp = *(const pg8::bf16x8*)(Ps + (ti * 16 + fr) * 72 + kk * 32 + fq * 8);
#pragma unroll
                for (int u2 = 0; u2 < 2; ++u2) { const pg8::bf16x8 a = *(const pg8::bf16x8*)(Vt + ((x2 + u2) * 16 + fr) * 72 + kk * 32 + fq * 8);
                    Oa[u2] = __builtin_amdgcn_mfma_f32_16x16x32_bf16(a, bp, Oa[u2], 0, 0, 0); } }
            const int sg = c * 64 + ti * 16 + fr, pos = dir ? (SEQ - 1 - sg) : sg;
#pragma unroll
            for (int u2 = 0; u2 < 2; ++u2) { u32x2 ow; ow.x = hwpk2(Oa[u2][0], Oa[u2][1]); ow.y = hwpk2(Oa[u2][2], Oa[u2][3]);
                *(u32x2*)(oL + (size_t)pos * 512 + (x2 + u2) * 16 + 4 * fq) = ow; }
        }
        if (cc + 1 < 36) HG_STAGE(cc + 1 >= 4);
        __syncthreads();
    }
#undef HG_LOAD
#undef HG_STAGE
}

__device__ __forceinline__ void phase_yh(const Params& p, int lane, int gw, int NGW) {
    const bf16* of = (const bf16*)(p.ws + WS_OF); const bf16* ob = (const bf16*)(p.ws + WS_OB); const bf16* og = (const bf16*)(p.ws + WS_OG);
    bf16* yh = (bf16*)(p.ws + WS_YH); const float* on = p.in[9];
    const f32x4 n0 = *(const f32x4*)(on + lane * 8), n1 = *(const f32x4*)(on + lane * 8 + 4);
    const int per = (MTOK + NGW - 1) / NGW, r0 = gw * per, nr = min(per, MTOK - r0);
    if (nr <= 0) return;
    u32x4 a = *(const u32x4*)(of + (size_t)r0 * 512 + lane * 8), b = *(const u32x4*)(ob + (size_t)r0 * 512 + lane * 8), gg = *(const u32x4*)(og + (size_t)r0 * 512 + lane * 8);
#pragma unroll 1
    for (int i = 0; i < nr; ++i) { const size_t o = (size_t)(r0 + i) * 512 + lane * 8;
        u32x4 a1 = a, b1 = b, g1 = gg;
        if (i + 1 < nr) { a1 = *(const u32x4*)(of + o + 512); b1 = *(const u32x4*)(ob + o + 512); g1 = *(const u32x4*)(og + o + 512); }
        float v[8]; v[0] = bflo(a.x) + bflo(b.x); v[1] = bfhi(a.x) + bfhi(b.x); v[2] = bflo(a.y) + bflo(b.y); v[3] = bfhi(a.y) + bfhi(b.y);
        v[4] = bflo(a.z) + bflo(b.z); v[5] = bfhi(a.z) + bfhi(b.z); v[6] = bflo(a.w) + bflo(b.w); v[7] = bfhi(a.w) + bfhi(b.w);
        float s = 0.f;
#pragma unroll
        for (int k = 0; k < 8; ++k) s += v[k] * v[k];
        s += __shfl_xor(s, 1); s += __shfl_xor(s, 2); s += __shfl_xor(s, 4); s += __shfl_xor(s, 8);
        const float rinv = rsqrtf(s * (1.f / 128.f) + EPSN);
        float gv[8]; gv[0] = bflo(gg.x); gv[1] = bfhi(gg.x); gv[2] = bflo(gg.y); gv[3] = bfhi(gg.y); gv[4] = bflo(gg.z); gv[5] = bfhi(gg.z); gv[6] = bflo(gg.w); gv[7] = bfhi(gg.w);
        f32x4 q0, q1;
#pragma unroll
        for (int k = 0; k < 4; ++k) { q0[k] = v[k] * rinv * n0[k] * gv[k]; q1[k] = v[4 + k] * rinv * n1[k] * gv[4 + k]; }
        *(u32x4*)(yh + o) = pack8(q0, q1);
        a = a1; b = b1; gg = g1; }
}

struct ConvRaw { u32x2 a[3], g[3]; };
__device__ __forceinline__ void conv_issue(const bf16* z, int tokbase, int r, int cc, int ch, ConvRaw& q) {
#pragma unroll
    for (int i = 0; i < 3; ++i) { const int rr = r + i - 1;
        if (rr >= 0 && rr < 32 && cc >= 0 && cc < 64) { const size_t zo = (size_t)(tokbase + rr * 64 + cc) * DFF2 + ch;
            q.a[i] = *(const u32x2*)(z + zo); q.g[i] = *(const u32x2*)(z + zo + DFF);
        } else { q.a[i] = (u32x2){0u, 0u}; q.g[i] = (u32x2){0u, 0u}; } }
}
__device__ __forceinline__ void phase_conv(const Params& p, int hf, int tid, int G) {
    const bf16* z = (const bf16*)(p.ws + WS_Z); bf16* a2 = (bf16*)(p.ws + WS_A2) + (size_t)hf * 8192 * DFF;
    const float* cw = p.in[15]; const float* cb = p.in[16];
    for (int it = blockIdx.x * NTHR + tid; it < 4 * 32 * 4 * 704; it += G * NTHR) {
        const int cg4 = it % 704, rest = it / 704, strip = rest & 3, r = (rest >> 2) & 31, img = rest >> 7, ch = cg4 * 4, c0 = strip * 16, tokbase = img * 2048;
        ConvRaw ring[3];
#pragma unroll
        for (int j = 0; j < 3; ++j) conv_issue(z, tokbase, r, c0 - 1 + j, ch, ring[j]);
        f32x2 w1[9][2], w2[9][2];
#pragma unroll
        for (int t = 0; t < 9; ++t) { const f32x4 a = *(const f32x4*)(cw + (size_t)t * DFF2 + ch), g = *(const f32x4*)(cw + (size_t)t * DFF2 + DFF + ch);
            w1[t][0] = (f32x2){a[0], a[1]}; w1[t][1] = (f32x2){a[2], a[3]}; w2[t][0] = (f32x2){g[0], g[1]}; w2[t][1] = (f32x2){g[2], g[3]}; }
        const f32x4 b1 = *(const f32x4*)(cb + ch), b2 = *(const f32x4*)(cb + DFF + ch);
        f32x2 W1[3][3][2], W2[3][3][2];
#pragma unroll
        for (int j = 0; j < 18; ++j) {
            const int sl = j % 3;
#pragma unroll
            for (int i = 0; i < 3; ++i) { const u32x2 a = ring[j % 3].a[i], g = ring[j % 3].g[i];
                W1[sl][i][0] = (f32x2){bflo(a.x), bfhi(a.x)}; W1[sl][i][1] = (f32x2){bflo(a.y), bfhi(a.y)};
                W2[sl][i][0] = (f32x2){bflo(g.x), bfhi(g.x)}; W2[sl][i][1] = (f32x2){bflo(g.y), bfhi(g.y)}; }
            if (j + 3 < 18) conv_issue(z, tokbase, r, c0 - 1 + j + 3, ch, ring[j % 3]);
            if (j >= 2) {
                const int sL = (j - 2) % 3, sC = (j - 1) % 3, sR = j % 3;
                f32x2 o1[2], o2[2];
                o1[0] = (f32x2){b1[0], b1[1]}; o1[1] = (f32x2){b1[2], b1[3]}; o2[0] = (f32x2){b2[0], b2[1]}; o2[1] = (f32x2){b2[2], b2[3]};
#pragma unroll
                for (int i = 0; i < 3; ++i)
#pragma unroll
                    for (int e = 0; e < 2; ++e) {
                        o1[e] = __builtin_elementwise_fma(W1[sL][i][e], w1[i * 3 + 0][e], o1[e]); o1[e] = __builtin_elementwise_fma(W1[sC][i][e], w1[i * 3 + 1][e], o1[e]); o1[e] = __builtin_elementwise_fma(W1[sR][i][e], w1[i * 3 + 2][e], o1[e]);
                        o2[e] = __builtin_elementwise_fma(W2[sL][i][e], w2[i * 3 + 0][e], o2[e]); o2[e] = __builtin_elementwise_fma(W2[sC][i][e], w2[i * 3 + 1][e], o2[e]); o2[e] = __builtin_elementwise_fma(W2[sR][i][e], w2[i * 3 + 2][e], o2[e]); }
                u32x2 ow; ow.x = pk2(siluf_(o1[0][0]) * o2[0][0], siluf_(o1[0][1]) * o2[0][1]); ow.y = pk2(siluf_(o1[1][0]) * o2[1][0], siluf_(o1[1][1]) * o2[1][1]);
                *(u32x2*)(a2 + (size_t)(tokbase + r * 64 + c0 + j - 2) * DFF + ch) = ow;
            }
        }
    }
}

__device__ __forceinline__ void phase_conv_lds(const Params& p, int hf, unsigned char* lds, int G) {
    int t_ = threadIdx.x; asm volatile("" : "+v"(t_));
    const int tid = t_;
    bf16* ring = (bf16*)lds;
    const bf16* z = (const bf16*)(p.ws + WS_Z); bf16* a2 = (bf16*)(p.ws + WS_A2) + (size_t)hf * 8192 * DFF;
    const float* cw = p.in[15]; const float* cb = p.in[16];
    const int ch4 = (tid & 15) * 4, c0 = (tid >> 4) * 2;
    __syncthreads();
    for (int i = tid; i < 4 * 2 * 80; i += NTHR) { const int slot = i / 160, rem = i % 160, side = rem / 80, wd = rem % 80;
        ((unsigned*)(ring + ((size_t)(slot * 66 + side * 65)) * 160))[wd] = 0u; }
    for (int seq = blockIdx.x; seq < 704; seq += G) {
        const int cbk = seq % 44, rest = seq / 44, rseg = rest & 3, img = rest >> 2, r0 = rseg * 8, tokbase = img * 2048, chb = cbk * 64;
        f32x2 w1[9][2], w2[9][2];
#pragma unroll
        for (int t = 0; t < 9; ++t) { const f32x4 a = *(const f32x4*)(cw + (size_t)t * DFF2 + chb + ch4), g = *(const f32x4*)(cw + (size_t)t * DFF2 + DFF + chb + ch4);
            w1[t][0] = (f32x2){a[0], a[1]}; w1[t][1] = (f32x2){a[2], a[3]}; w2[t][0] = (f32x2){g[0], g[1]}; w2[t][1] = (f32x2){g[2], g[3]}; }
        const f32x4 b1 = *(const f32x4*)(cb + chb + ch4), b2 = *(const f32x4*)(cb + DFF + chb + ch4);
        u32x4 stA[2], stB[2];
#define CV_LOAD(ST, row_) do { const int _r = (row_); _Pragma("unroll") for (int k_ = 0; k_ < 2; ++k_) { const int _q = tid + 512 * k_, _col = _q >> 4, _path = (_q >> 3) & 1, _c8 = (_q & 7) * 8; \
            ST[k_] = (_r >= 0 && _r < 32) ? *(const u32x4*)(z + (size_t)(tokbase + _r * 64 + _col) * DFF2 + _path * DFF + chb + _c8) : (u32x4){0u, 0u, 0u, 0u}; } } while (0)
#define CV_STORE(ST, slot_) do { const int _sl = (slot_); _Pragma("unroll") for (int k_ = 0; k_ < 2; ++k_) { const int _q = tid + 512 * k_, _col = _q >> 4, _path = (_q >> 3) & 1, _c8 = (_q & 7) * 8; \
            *(u32x4*)(ring + ((size_t)(_sl * 66 + _col + 1)) * 160 + _path * 64 + _c8) = ST[k_]; } } while (0)
#define CV_COMPUTE(i_) do { const int _i = (i_); \
            f32x2 o1[2][2], o2[2][2]; \
            _Pragma("unroll") for (int oc = 0; oc < 2; ++oc) { o1[oc][0] = (f32x2){b1[0], b1[1]}; o1[oc][1] = (f32x2){b1[2], b1[3]}; o2[oc][0] = (f32x2){b2[0], b2[1]}; o2[oc][1] = (f32x2){b2[2], b2[3]}; } \
            _Pragma("unroll") for (int rr = 0; rr < 3; ++rr) { const int slot = (_i + rr) & 3; \
                const bf16* base = ring + ((size_t)(slot * 66 + c0)) * 160 + ch4; \
                _Pragma("unroll") for (int cc = 0; cc < 4; ++cc) { const u32x2 a = *(const u32x2*)(base + cc * 160), g = *(const u32x2*)(base + cc * 160 + 64); \
                    const f32x2 a0 = (f32x2){bflo(a.x), bfhi(a.x)}, a1 = (f32x2){bflo(a.y), bfhi(a.y)}, g0 = (f32x2){bflo(g.x), bfhi(g.x)}, g1 = (f32x2){bflo(g.y), bfhi(g.y)}; \
                    _Pragma("unroll") for (int oc = 0; oc < 2; ++oc) { const int dj = cc - oc; \
                        if (dj >= 0 && dj < 3) { const int t = rr * 3 + dj; \
                            o1[oc][0] = __builtin_elementwise_fma(a0, w1[t][0], o1[oc][0]); o1[oc][1] = __builtin_elementwise_fma(a1, w1[t][1], o1[oc][1]); \
                            o2[oc][0] = __builtin_elementwise_fma(g0, w2[t][0], o2[oc][0]); o2[oc][1] = __builtin_elementwise_fma(g1, w2[t][1], o2[oc][1]); } } } } \
            _Pragma("unroll") for (int oc = 0; oc < 2; ++oc) { u32x2 ow; ow.x = pk2(siluf_(o1[oc][0][0]) * o2[oc][0][0], siluf_(o1[oc][0][1]) * o2[oc][0][1]); ow.y = pk2(siluf_(o1[oc][1][0]) * o2[oc][1][0], siluf_(o1[oc][1][1]) * o2[oc][1][1]); \
                *(u32x2*)(a2 + (size_t)(tokbase + (r0 + _i) * 64 + c0 + oc) * DFF + chb + ch4) = ow; } } while (0)
        __syncthreads();
        CV_LOAD(stA, r0 - 1); CV_STORE(stA, 0); CV_LOAD(stA, r0); CV_STORE(stA, 1); CV_LOAD(stA, r0 + 1); CV_STORE(stA, 2);
        CV_LOAD(stA, r0 + 2);
        __syncthreads();
#pragma unroll 1
        for (int i = 0; i < 8; i += 2) {
            CV_LOAD(stB, r0 + i + 3);
            CV_COMPUTE(i);
            CV_STORE(stA, (i + 3) & 3);
            __syncthreads();
            if (i + 2 < 8) CV_LOAD(stA, r0 + i + 4);
            CV_COMPUTE(i + 1);
            if (i + 1 < 7) CV_STORE(stB, (i + 4) & 3);
            __syncthreads();
        }
#undef CV_COMPUTE
#undef CV_LOAD
#undef CV_STORE
    }
}

__global__ void __launch_bounds__(NTHR, 2) fwd_mega(Params p) {
    extern __shared__ __attribute__((aligned(16))) unsigned char lds[];
    cg::grid_group grid = cg::this_grid();
    const int tid = threadIdx.x, lane = tid & 63, wave = __builtin_amdgcn_readfirstlane(tid >> 6);
    const int G = gridDim.x, gw = blockIdx.x * NWAVES + wave, NGW = G * NWAVES;
    PG8_LAS unsigned char* ldsl = (PG8_LAS unsigned char*)lds;
    unsigned char* ws = p.ws;
    const float* mx = (const float*)(ws + WS_MX);
    volatile LAS unsigned* misc = (volatile LAS unsigned*)((LAS unsigned char*)lds + MISC_OFF);
    if (tid < 16) misc[tid] = 0u;
    __syncthreads();
    const XcdBarrier xbar = xcd_barrier_post((unsigned*)(ws + WS_BAR), misc + 8);
    const unsigned long long t0_ = (PROBE_K >= 0) ? __builtin_amdgcn_s_memrealtime() : 0ull;
#define PROBE_POINT(k) do { if (PROBE_K == (k) && tid == 0) { const unsigned long long _n = __builtin_amdgcn_s_memrealtime(), _d = _n - t0_; while (__builtin_amdgcn_s_memrealtime() - _n < _d) __builtin_amdgcn_s_sleep(8); } } while (0)

    for (int rep_ = 0; rep_ < REPS(0); ++rep_) {
    phase0(p, lds, tid, lane, wave, G, 0);
    phase0(p, lds, tid, lane, wave, G, 1);
    xcd_barrier(xbar);
    if (G == 0x7fffffff) grid.sync();
    }
    for (int xs_ = 0; xs_ < EXTRA_SYNCS; ++xs_) xcd_barrier(xbar);
    PROBE_POINT(0);
    for (int rep_ = 0; rep_ < REPS(1); ++rep_) {
    if (blockIdx.x < 16 && G >= 16) {
        pg8::Gemm g{(const bf16*)(ws + WS_TCH), (const bf16*)(ws + WS_WFS), 512, 512, 512};
        pg8::StaticOrder S; S.init(4, 4, 16, blockIdx.x, 512, 512);
        pg8::Epi8<FUp> E{FUp{(bf16*)(ws + WS_WPQ), 1024}};
        pg8::gemm_phase<pg8::Epi8<FUp>, pg8::StaticOrder, true, true>(ldsl, g, S, E);
    }
    { const int skip = (G >= 32) ? 16 * NWAVES : 0, nw = NGW - skip, per = (MTOK + MCTX + nw - 1) / nw, r0 = (gw - skip) * per, nr = (gw < skip) ? 0 : min(per, MTOK + MCTX - r0);
      if (nr > 0) norm_rows<true>(p.in[0], p.in[2], MTOK, p.in[6], mx, 0, 1, (bf16*)(ws + WS_HX), nullptr, r0, nr, lane); }
    xcd_barrier(xbar);
    }
    PROBE_POINT(1);
    for (int rep_ = 0; rep_ < REPS(2); ++rep_) {
    {
        pg8::Gemm g{(const bf16*)(ws + WS_HX), (const bf16*)(ws + WS_WIN) + (size_t)512 * 1024, 1024, 1024, 1024};
        pg8::InOrder S; S.G = G; S.c = blockIdx.x; S.a_tile = (size_t)256 * 1024 * 2; S.b_tile = (size_t)256 * 1024 * 2;
        pg8::Epi8<FIn> E{FIn{ws, p.out}};
        pg8::gemm_phase<pg8::Epi8<FIn>, pg8::InOrder, true, true>(ldsl, g, S, E);
    }
    {
        pg8::Gemm g{(const bf16*)(ws + WS_WPQ), (const bf16*)(ws + WS_HX), 1024, 1024, 1024};
        pg8::StaticOrder S; S.init(4, 64, G, blockIdx.x, 1024, 1024);
        pg8::Epi8<FPQ> E{FPQ{(bf16*)(ws + WS_PQT)}};
        pg8::gemm_phase<pg8::Epi8<FPQ>, pg8::StaticOrder, true, true>(ldsl, g, S, E);
    }
    xcd_barrier(xbar);
    }
    PROBE_POINT(2);
    for (int rep_ = 0; rep_ < REPS(3); ++rep_) {
    if (blockIdx.x < 128 && G >= 192) {
        pg8::Gemm g{(const bf16*)(ws + WS_CS), (const bf16*)(ws + WS_PQT), 2048, 2048, 32768};
        pg8::DftOrder S; S.G = 128; S.c = blockIdx.x; S.a_tile = (size_t)256 * 2048 * 2; S.b_tile = (size_t)256 * 32768 * 2;
        EpiDft E{(bf16*)(ws + WS_YF), (unsigned*)(ws + WS_BAR + 16384)};
        pg8::gemm_phase<EpiDft, pg8::DftOrder, true, true>(ldsl, g, S, E);
        { int t2 = threadIdx.x; asm volatile("" : "+v"(t2));
          const int lane = t2 & 63, wave = __builtin_amdgcn_readfirstlane(t2 >> 6), gw = blockIdx.x * NWAVES + wave;
          LAS float* scr = (LAS float*)((LAS unsigned char*)lds + wave * 16384);
          constexpr int I_UP = 16 * 176, I_DN = 44 * 32;
          for (int it = gw; it < I_UP + I_DN; it += 128 * NWAVES) {
              if (it < I_UP) transpose_item(p.in[14], 1024, DFF2, (bf16*)(ws + WS_WUP), scr, it, lane);
              else transpose_item(p.in[17], DFF, 1024, (bf16*)(ws + WS_WDN), scr, it - I_UP, lane); }
          constexpr int I_A = 8 * 32, I_B = 8 * 32, I_O = 16 * 32;
          for (int it = gw; it < I_A + I_B + I_O; it += 128 * NWAVES) {
              if (it < I_A) transpose_item(p.in[10], 512, 1024, (bf16*)(ws + WS_WA), scr, it, lane);
              else if (it < I_A + I_B) transpose_item(p.in[11], 512, 1024, (bf16*)(ws + WS_WB), scr, it - I_A, lane);
              else transpose_item(p.in[12], 1024, 1024, (bf16*)(ws + WS_WOUT), scr, it - I_A - I_B, lane); } }
    } else if (G >= 192) {
        for (int it = blockIdx.x - 128; it < 128; it += G - 128) hgrn_mfma_item(p, lds, it);
    } else {
        pg8::Gemm g{(const bf16*)(ws + WS_CS), (const bf16*)(ws + WS_PQT), 2048, 2048, 32768};
        pg8::DftOrder S; S.G = G; S.c = blockIdx.x; S.a_tile = (size_t)256 * 2048 * 2; S.b_tile = (size_t)256 * 32768 * 2;
        EpiDft E{(bf16*)(ws + WS_YF), (unsigned*)(ws + WS_BAR + 16384)};
        pg8::gemm_phase<EpiDft, pg8::DftOrder, true, true>(ldsl, g, S, E);
        for (int it = blockIdx.x; it < 128; it += G) hgrn_mfma_item(p, lds, it);
    }
    xcd_barrier(xbar);
    }
    PROBE_POINT(3);
    for (int rep_ = 0; rep_ < REPS(4); ++rep_) {
    phase_yh(p, lane, gw, NGW);
    { LAS float* scr = (LAS float*)((LAS unsigned char*)lds + wave * 16384);
      constexpr int I_UP = 16 * 176, I_DN = 44 * 32;
      for (int it = (G >= 192) ? I_UP + I_DN : gw; it < I_UP + I_DN; it += NGW) {
          if (it < I_UP) transpose_item(p.in[14], 1024, DFF2, (bf16*)(ws + WS_WUP), scr, it, lane);
          else transpose_item(p.in[17], DFF, 1024, (bf16*)(ws + WS_WDN), scr, it - I_UP, lane); } }
    xcd_barrier(xbar);
    }
    PROBE_POINT(4);
    for (int rep_ = 0; rep_ < REPS(5); ++rep_) {
    if (G == 256) {
        pg8::f32x4 accm[2][2][4][2];
        {
            pg8::Gemm g{(const bf16*)(ws + WS_YF), (const bf16*)(ws + WS_WA), 512, 512, 512};
            pg8::StaticOrder S; S.init(64, 4, G, blockIdx.x, 512, 512);
            pg8::Epi8<FYab> E{FYab{(const bf16*)(ws + WS_GA), (const bf16*)(ws + WS_GBG)}};
            pg8::gemm_phase<pg8::Epi8<FYab>, pg8::StaticOrder, true, true, 1>(ldsl, g, S, E, &accm[0]);
        }
        {
            pg8::Gemm g{(const bf16*)(ws + WS_YH), (const bf16*)(ws + WS_WB), 512, 512, 512};
            pg8::StaticOrder S; S.init(64, 4, G, blockIdx.x, 512, 512);
            pg8::Epi8<FYb> E{FYb{(const bf16*)(ws + WS_GBG), (bf16*)(ws + WS_MRG)}};
            pg8::gemm_phase<pg8::Epi8<FYb>, pg8::StaticOrder, true, true, 2>(ldsl, g, S, E, &accm[0]);
        }
    } else {
    {
        pg8::Gemm g{(const bf16*)(ws + WS_YF), (const bf16*)(ws + WS_WA), 512, 512, 512};
        pg8::StaticOrder S; S.init(64, 4, G, blockIdx.x, 512, 512);
        pg8::Epi8<FYaT> E{FYaT{(const bf16*)(ws + WS_GA), (bf16*)(ws + WS_TMP)}};
        pg8::gemm_phase<pg8::Epi8<FYaT>, pg8::StaticOrder, true, true>(ldsl, g, S, E);
    }
    {
        pg8::Gemm g{(const bf16*)(ws + WS_YH), (const bf16*)(ws + WS_WB), 512, 512, 512};
        pg8::StaticOrder S; S.init(64, 4, G, blockIdx.x, 512, 512);
        pg8::Epi8<FYbT> E{FYbT{(const bf16*)(ws + WS_GBG), (const bf16*)(ws + WS_TMP), (bf16*)(ws + WS_MRG)}};
        pg8::gemm_phase<pg8::Epi8<FYbT>, pg8::StaticOrder, true, true>(ldsl, g, S, E);
    }
    }
    xcd_barrier(xbar);
    }
    PROBE_POINT(5);
    for (int rep_ = 0; rep_ < REPS(6); ++rep_) {
    {
        pg8::Gemm g{(const bf16*)(ws + WS_MRG), (const bf16*)(ws + WS_WOUT), 1024, 1024, 1024};
        pg8::StaticOrder S; S.init(64, 4, G, blockIdx.x, 1024, 1024);
        pg8::Epi8<FRes> E{FRes{p.in[0], p.out, mx, 2}};
        pg8::gemm_phase<pg8::Epi8<FRes>, pg8::StaticOrder, true, true>(ldsl, g, S, E);
    }
    xcd_barrier(xbar);
    }
    PROBE_POINT(6);
    for (int rep_ = 0; rep_ < REPS(7); ++rep_) {
    { const int per = (MTOK + NGW - 1) / NGW, r0 = gw * per, nr = min(per, MTOK - r0);
      if (nr > 0) norm_rows<true>(p.out, p.out, MTOK, p.in[13], mx, 3, 4, (bf16*)(ws + WS_H2), nullptr, r0, nr, lane); }
    xcd_barrier(xbar);
    }
    PROBE_POINT(7);
    {
    for (int hf = 0; hf < 2; ++hf) {
        for (int rep_ = 0; rep_ < REPS(8); ++rep_) {
            pg8::Gemm g{(const bf16*)(ws + WS_H2) + (size_t)hf * 8192 * 1024, (const bf16*)(ws + WS_WUP), 1024, 1024, 1024};
            pg8::StaticOrder S; S.init(32, 22, G, blockIdx.x, 1024, 1024);
            pg8::Epi8<FUp> E{FUp{(bf16*)(ws + WS_Z), DFF2}};
            pg8::gemm_phase<pg8::Epi8<FUp>, pg8::StaticOrder, true, true>(ldsl, g, S, E);
        xcd_barrier(xbar);
        }
        for (int rep_ = 0; rep_ < REPS(9); ++rep_) {
        phase_conv_lds(p, hf, lds, G);
        xcd_barrier(xbar);
        }
    }
    }
    PROBE_POINT(8);
    if (G == 256) {
        pg8::Gemm g{(const bf16*)(ws + WS_A2), (const bf16*)(ws + WS_WDN), DFF, DFF, DFF};
        pg8::StaticOrder S; S.init(64, 4, G, blockIdx.x, DFF, DFF);
        EpiFinal E{p.out, mx, p.in[18], (float*)(ws + WS_SLOT), (unsigned*)(ws + WS_BAR + 20480)};
        pg8::gemm_phase<EpiFinal, pg8::StaticOrder, true, true>(ldsl, g, S, E);
    } else {
    {
        pg8::Gemm g{(const bf16*)(ws + WS_A2), (const bf16*)(ws + WS_WDN), DFF, DFF, DFF};
        pg8::StaticOrder S; S.init(64, 4, G, blockIdx.x, DFF, DFF);
        pg8::Epi8<FRes> E{FRes{p.out, (float*)(ws + WS_XO), mx, 5}};
        pg8::gemm_phase<pg8::Epi8<FRes>, pg8::StaticOrder, true, true>(ldsl, g, S, E);
    }
    xcd_barrier(xbar);
    { const int per = (MTOK + NGW - 1) / NGW, r0 = gw * per, nr = min(per, MTOK - r0);
      if (nr > 0) norm_rows<false>((const float*)(ws + WS_XO), (const float*)(ws + WS_XO), MTOK, p.in[18], nullptr, 0, 0, nullptr, p.out, r0, nr, lane); }
    }
}

extern "C" void kernel_launch(void* const* d_in, const int* in_sizes, int n_in, void* d_out, int out_size, void* d_ws, size_t ws_size, hipStream_t stream) {
    static int grid = 0;
    if (grid == 0) {
        if (n_in != 19 || out_size != MTOK * DM || ws_size < WS_END) { fprintf(stderr, "kernel_launch: unexpected problem: n_in %d out %d ws %zu\n", n_in, out_size, ws_size); grid = -1; return; }
        int dev = 0, cus = 0, per_cu = 0;
        hipGetDevice(&dev);
        hipDeviceGetAttribute(&cus, hipDeviceAttributeMultiprocessorCount, dev);
        if (hipFuncSetAttribute((const void*)fwd_mega, hipFuncAttributeMaxDynamicSharedMemorySize, LDS_BYTES) != hipSuccess) { fprintf(stderr, "kernel_launch: hipFuncSetAttribute failed\n"); grid = -1; return; }
        if (hipOccupancyMaxActiveBlocksPerMultiprocessor(&per_cu, (const void*)fwd_mega, NTHR, LDS_BYTES) != hipSuccess || per_cu < 1) { fprintf(stderr, "kernel_launch: occupancy query says %d\n", per_cu); per_cu = 1; }
        (void)hipGetLastError();
        grid = cus * (per_cu > 1 ? 1 : per_cu);
        fprintf(stderr, "kernel_launch: grid %d (cus %d, per_cu %d), ws %zu\n", grid, cus, per_cu, ws_size);
    }
    if (grid < 0) return;
    Params p{};
    for (int i = 0; i < 19; ++i) p.in[i] = (const float*)d_in[i];
    p.out = (float*)d_out; p.ws = (unsigned char*)d_ws;
    if (hipMemsetAsync((char*)d_ws + WS_BAR, 0, BAR_BYTES, stream) != hipSuccess) { fprintf(stderr, "kernel_launch: memset failed\n"); return; }
    void* args[] = {&p};
    hipError_t e = hipLaunchCooperativeKernel((const void*)fwd_mega, dim3(grid), dim3(NTHR), args, LDS_BYTES, stream);
    if (e != hipSuccess) fprintf(stderr, "kernel_launch: cooperative launch failed: %s (grid %d)\n", hipGetErrorString(e), grid);
}
```

```cpp
#include <hip/hip_runtime.h>
#include <hip/hip_cooperative_groups.h>
#include <cstdio>
#include <cstdint>
namespace cg = cooperative_groups;

namespace pg8 {
#define PG8_LAS __attribute__((address_space(3)))
typedef unsigned short bf16_t;
typedef short bf16x8 __attribute__((ext_vector_type(8)));
typedef float f32x4 __attribute__((ext_vector_type(4)));
typedef unsigned u32x4 __attribute__((ext_vector_type(4)));
typedef unsigned u32x2 __attribute__((ext_vector_type(2)));
constexpr int BM = 256, BK = 64, HALF = 128, HTB = HALF * BK * 2  , STAGE_BYTES = 8 * HTB, NXCD = 8, WGM = 8;

__host__ __device__ __forceinline__ int lds_byte(int r, int c) { const int st = (r >> 4) * 2 + (c >> 5), rr = r & 15, cc = c & 31, ob = rr * 64 + cc * 2; return st * 1024 + (ob ^ (((ob >> 9) & 1) << 5)); }
__host__ __device__ __forceinline__ void stage_rc(int b, int& R, int& C) { const int st = b / 1024, sb = b % 1024, swz = sb ^ (((sb >> 9) & 1) << 5); R = (st >> 1) * 16 + swz / 64; C = (st & 1) * 32 + (swz % 64) / 2; }
__host__ __device__ __forceinline__ int perm32(int rho) { const int n = rho >> 4, i = rho & 15; return 8 * (i >> 2) + 4 * n + (i & 3); }

struct Unit { int pm, pn, z; };
struct Gemm { const bf16_t* A; const bf16_t* Bt; int K, lda, ldb; };

__device__ __forceinline__ void tile_of(int wgid, int nM, int nN, int& pm, int& pn) {
    const int nwg = nM * nN;
    { const int q = nwg / NXCD, r = nwg % NXCD, xcd = wgid % NXCD, off = wgid / NXCD; wgid = (xcd < r ? xcd * (q + 1) : r * (q + 1) + (xcd - r) * q) + off; }
    const int nig = WGM * nN, gid = wgid / nig, fm = gid * WGM, gsz = (nM - fm) < WGM ? (nM - fm) : WGM;
    pm = fm + ((wgid % nig) % gsz); pn = (wgid % nig) / gsz;
}
struct StaticOrder {
    int nM, nN, nwg, G, c; size_t a_tile, b_tile;
    __device__ __forceinline__ void init(int nM_, int nN_, int G_, int c_, int lda, int ldb) { nM = nM_; nN = nN_; nwg = nM * nN; G = G_; c = c_; a_tile = (size_t)BM * lda * 2; b_tile = (size_t)BM * ldb * 2; }
    __device__ __forceinline__ bool next(int i, Unit& u) const {
        const long L = (long)i * G + c; if (L >= nwg) return false;
        tile_of((int)L, nM, nN, u.pm, u.pn); u.z = 0; return true;
    }
    __device__ __forceinline__ size_t a_off(const Unit& u) const { return (size_t)u.pm * a_tile; }
    __device__ __forceinline__ size_t b_off(const Unit& u) const { return (size_t)u.pn * b_tile; }
};
struct OneOrder {
    int L, nM, nN; size_t a_tile, b_tile;
    __device__ __forceinline__ bool next(int i, Unit& u) const { if (i > 0) return false; tile_of(L, nM, nN, u.pm, u.pn); u.z = 0; return true; }
    __device__ __forceinline__ size_t a_off(const Unit& u) const { return (size_t)u.pm * a_tile; }
    __device__ __forceinline__ size_t b_off(const Unit& u) const { return (size_t)u.pn * b_tile; }
};
struct InOrder {
    int G, c; size_t a_tile, b_tile;
    __device__ __forceinline__ bool next(int i, Unit& u) const {
        const long L = (long)i * G + c; if (L >= 1152 + 48) return false;
        if (L < 1152) { tile_of((int)L, 64, 18, u.pm, u.pn); } else { const int j = (int)L - 1152; u.pm = 64 + (j & 7); u.pn = 2 + (j >> 3); }
        u.z = 0; return true;
    }
    __device__ __forceinline__ size_t a_off(const Unit& u) const { return (size_t)u.pm * a_tile; }
    __device__ __forceinline__ size_t b_off(const Unit& u) const { return (size_t)u.pn * b_tile; }
};
struct DftOrder {
    int G, c; size_t a_tile, b_tile;
    __device__ __forceinline__ bool next(int i, Unit& u) const {
        const long L = (long)i * G + c; if (L >= 128) return false;
        const int eo = (L < 64) ? 1 : 0, q = (int)L & 63;
        u.pn = q & 1; u.pm = (q >> 1) & 3; u.z = (q >> 3) | (eo << 8); return true;
    }
    __device__ __forceinline__ size_t a_off(const Unit& u) const { return (size_t)((u.z >> 8) * 4 + u.pm) * a_tile; }
    __device__ __forceinline__ size_t b_off(const Unit& u) const { return (size_t)u.pn * b_tile + ((size_t)(u.z & 255) * 4096 + (size_t)(u.z >> 8) * 2048) * 2; }
};

__device__ __forceinline__ unsigned cvt_pk_bf16(float lo, float hi) { unsigned r; asm volatile("v_cvt_pk_bf16_f32 %0, %1, %2" : "=v"(r) : "v"(lo), "v"(hi)); return r; }

template <class F> struct Epi8 {
    static constexpr bool PERM = true;
    F f;
    __device__ __forceinline__ void inplace(f32x4 (&acc)[2][2][4][2], const Unit& u, int wr, int wc, int fr, int fq) const {
        const int row0 = u.pm * BM + wr * 64 + fr, col0 = u.pn * BM + wc * 32 + 8 * fq;
#pragma unroll
        for (int ai = 0; ai < 2; ++ai)
#pragma unroll
            for (int m = 0; m < 4; ++m) {
#pragma unroll
                for (int bj = 0; bj < 2; ++bj) f.scale(u, row0 + ai * HALF + m * 16, col0 + bj * HALF, acc[ai][bj][m][0], acc[ai][bj][m][1]);
                asm volatile("" ::: "memory");
            }
    }
    __device__ __forceinline__ void operator()(const f32x4 (&acc)[2][2][4][2], const Unit& u, int wr, int wc, int fr, int fq) const {
        const int row0 = u.pm * BM + wr * 64 + fr, col0 = u.pn * BM + wc * 32 + 8 * fq;
#pragma unroll
        for (int ai = 0; ai < 2; ++ai)
#pragma unroll
            for (int m = 0; m < 4; ++m) {
#pragma unroll
                for (int bj = 0; bj < 2; ++bj) f(u, row0 + ai * HALF + m * 16, col0 + bj * HALF, acc[ai][bj][m][0], acc[ai][bj][m][1]);
                asm volatile("" ::: "memory");
            }
    }
};

template <class E, class = void> struct after_drain { static constexpr bool value = false; };
template <class E> struct after_drain<E, decltype((void)E::AFTER_DRAIN)> { static constexpr bool value = E::AFTER_DRAIN; };
template <class Epi, class Sched, bool ALIGN_EPI = false, bool SP2 = false, int EXTACC = 0>
__device__ __forceinline__ void gemm_phase(PG8_LAS unsigned char* lds, const Gemm g, const Sched& S, const Epi& E, f32x4 (*accx)[2][4][2] = nullptr) {
    int tid_ = threadIdx.x; asm volatile("" : "+v"(tid_));
    const int tid = tid_, wid = __builtin_amdgcn_readfirstlane(tid >> 6), lane = tid & 63, wr = wid >> 2, wc = wid & 3, fr = lane & 15, fq = lane >> 4;
    const int K = g.K, nt = K / BK;
    unsigned voffA[2], voffB[2];
#pragma unroll
    for (int i = 0; i < 2; ++i) { int R, C; stage_rc(tid * 16 + i * 8192, R, C); const int Rb = Epi::PERM ? ((R & ~31) + perm32(R & 31)) : R;
        voffA[i] = (unsigned)(R * g.lda + C) * 2u; voffB[i] = (unsigned)(Rb * g.ldb + C) * 2u; }
    const size_t kstep = (size_t)(BK * 2);
    const size_t hstepA = (size_t)HALF * g.lda * 2, hstepB = (size_t)HALF * g.ldb * 2;
    const unsigned ldsw = (unsigned)wid * 1024u;
    const int aoff = lds_byte(wr * 64 + fr, fq * 8), boff = lds_byte(wc * 32 + fr, fq * 8);
#define PG8_SA(b, h) (((b) * 2 + (h)) * HTB)
#define PG8_SB(b, h) ((4 + (b) * 2 + (h)) * HTB)
#define PG8_STAGE(bufoff, gbase, voff) do { _Pragma("unroll") for (int _i = 0; _i < 2; ++_i) \
        __builtin_amdgcn_global_load_lds((const unsigned*)((const char*)(gbase) + (voff)[_i]), (PG8_LAS unsigned*)(lds + (bufoff) + ldsw + _i * 8192), 16, 0, 0); } while (0)
#define PG8_LDA(dst, b, h) do { _Pragma("unroll") for (int m = 0; m < 4; ++m) _Pragma("unroll") for (int k = 0; k < 2; ++k) dst[m][k] = *(const PG8_LAS bf16x8*)(lds + PG8_SA(b, h) + aoff + m * 2048 + k * 1024); } while (0)
#define PG8_LDB(dst, b, h) do { _Pragma("unroll") for (int n = 0; n < 2; ++n) _Pragma("unroll") for (int k = 0; k < 2; ++k) dst[n][k] = *(const PG8_LAS bf16x8*)(lds + PG8_SB(b, h) + boff + n * 2048 + k * 1024); } while (0)
#define PG8_MMA(ai, bj, At, Bt) do { __builtin_amdgcn_s_setprio(1); _Pragma("unroll") for (int m = 0; m < 4; ++m) _Pragma("unroll") for (int n = 0; n < 2; ++n) _Pragma("unroll") for (int k = 0; k < 2; ++k) \
        acc[ai][bj][m][n] = __builtin_amdgcn_mfma_f32_16x16x32_bf16(Bt[n][k], At[m][k], acc[ai][bj][m][n], 0, 0, 0); __builtin_amdgcn_s_setprio(0); } while (0)
#define PG8_WAIT_V(n) asm volatile("s_waitcnt vmcnt(" #n ")" ::: "memory")
#define PG8_WAIT_L(n) asm volatile("s_waitcnt lgkmcnt(" #n ")" ::: "memory")
#define PG8_BAR __builtin_amdgcn_s_barrier()
#define PG8_SCHED __builtin_amdgcn_sched_barrier(0)
    Unit cur, nxt; int ui = 0;
    if (!S.next(0, cur)) return;
    f32x4 accl[2][2][4][2];
    f32x4 (&acc)[2][2][4][2] = *(EXTACC ? (f32x4 (*)[2][2][4][2])accx : &accl);
    if constexpr (EXTACC != 2) {
#pragma unroll
    for (int a = 0; a < 2; ++a)
#pragma unroll
        for (int b = 0; b < 2; ++b)
#pragma unroll
            for (int m = 0; m < 4; ++m)
#pragma unroll
                for (int n = 0; n < 2; ++n) acc[a][b][m][n] = (f32x4){0.f, 0.f, 0.f, 0.f};
    }
    bf16x8 At[4][2], B0[2][2], B1[2][2];
    const char* cA = (const char*)g.A + S.a_off(cur); const char* cB = (const char*)g.Bt + S.b_off(cur);
    if constexpr (SP2) {
        PG8_STAGE(PG8_SB(0, 0), cB, voffB); PG8_STAGE(PG8_SB(0, 1), cB + hstepB, voffB); PG8_STAGE(PG8_SA(0, 0), cA, voffA); PG8_STAGE(PG8_SA(0, 1), cA + hstepA, voffA);
        if (wr == 1) PG8_BAR;
        PG8_WAIT_V(2); PG8_BAR;
        PG8_STAGE(PG8_SB(1, 0), cB + kstep, voffB); PG8_STAGE(PG8_SA(1, 0), cA + kstep, voffA); PG8_STAGE(PG8_SB(1, 1), cB + hstepB + kstep, voffB);
        PG8_WAIT_V(6); PG8_BAR;
    } else {
        PG8_STAGE(PG8_SB(0, 0), cB, voffB); PG8_STAGE(PG8_SA(0, 0), cA, voffA); PG8_STAGE(PG8_SB(0, 1), cB + hstepB, voffB); PG8_STAGE(PG8_SA(0, 1), cA + hstepA, voffA);
        if (wr == 1) PG8_BAR;
        PG8_WAIT_V(4); PG8_BAR;
        PG8_STAGE(PG8_SB(1, 0), cB + kstep, voffB); PG8_STAGE(PG8_SA(1, 0), cA + kstep, voffA); PG8_STAGE(PG8_SB(1, 1), cB + hstepB + kstep, voffB);
        PG8_WAIT_V(6); PG8_BAR;
    }
    for (;;) {
        const bool has_next = S.next(ui + 1, nxt);
        const char* nA = has_next ? (const char*)g.A + S.a_off(nxt) : cA; const char* nB = has_next ? (const char*)g.Bt + S.b_off(nxt) : cB;
        for (int t = 0; t < nt; t += 2) {
            const bool last = (t == nt - 2);
            const char* a1 = cA + (size_t)(t + 1) * kstep;
            const char* a2 = last ? nA : cA + (size_t)(t + 2) * kstep; const char* b2 = last ? nB : cB + (size_t)(t + 2) * kstep;
            const char* a3 = a2 + kstep; const char* b3 = b2 + kstep;
            if constexpr (SP2) {
            PG8_LDB(B0, 0, 0); PG8_LDB(B1, 0, 1); PG8_SCHED; PG8_LDA(At, 0, 0); PG8_STAGE(PG8_SA(1, 1), a1 + hstepA, voffA);
            PG8_WAIT_V(8); PG8_WAIT_L(0); PG8_BAR; PG8_MMA(0, 0, At, B0); PG8_MMA(0, 1, At, B1); PG8_BAR; PG8_SCHED;
            PG8_LDA(At, 0, 1); PG8_STAGE(PG8_SB(0, 0), b2, voffB); PG8_STAGE(PG8_SB(0, 1), b2 + hstepB, voffB); PG8_STAGE(PG8_SA(0, 0), a2, voffA);
            PG8_WAIT_V(8); PG8_WAIT_L(0); PG8_BAR; PG8_MMA(1, 0, At, B0); PG8_MMA(1, 1, At, B1); PG8_BAR; PG8_SCHED;
            PG8_LDB(B0, 1, 0); PG8_LDB(B1, 1, 1); PG8_SCHED; PG8_LDA(At, 1, 0); PG8_STAGE(PG8_SA(0, 1), a2 + hstepA, voffA);
            PG8_WAIT_V(8); PG8_WAIT_L(0); PG8_BAR; PG8_MMA(0, 0, At, B0); PG8_MMA(0, 1, At, B1); PG8_BAR; PG8_SCHED;
            PG8_LDA(At, 1, 1); PG8_STAGE(PG8_SB(1, 0), b3, voffB); PG8_STAGE(PG8_SB(1, 1), b3 + hstepB, voffB); PG8_STAGE(PG8_SA(1, 0), a3, voffA);
            PG8_WAIT_V(8); PG8_WAIT_L(0); PG8_BAR; PG8_MMA(1, 0, At, B0); PG8_MMA(1, 1, At, B1); PG8_BAR; PG8_SCHED;
            } else {
            PG8_LDB(B0, 0, 0); PG8_SCHED; PG8_LDA(At, 0, 0); PG8_STAGE(PG8_SA(1, 1), a1 + hstepA, voffA);
            PG8_WAIT_L(8); PG8_BAR; PG8_WAIT_L(0); PG8_MMA(0, 0, At, B0); PG8_BAR; PG8_SCHED;
            PG8_LDB(B1, 0, 1); PG8_STAGE(PG8_SB(0, 0), b2, voffB);
            PG8_BAR; PG8_WAIT_L(0); PG8_MMA(0, 1, At, B1); PG8_BAR;
            PG8_LDA(At, 0, 1); PG8_STAGE(PG8_SA(0, 0), a2, voffA);
            PG8_BAR; PG8_WAIT_L(0); PG8_MMA(1, 0, At, B0); PG8_BAR; PG8_SCHED;
            PG8_STAGE(PG8_SB(0, 1), b2 + hstepB, voffB);
            PG8_WAIT_V(6); PG8_BAR; PG8_MMA(1, 1, At, B1); PG8_BAR;
            PG8_LDB(B0, 1, 0); PG8_SCHED; PG8_LDA(At, 1, 0); PG8_STAGE(PG8_SA(0, 1), a2 + hstepA, voffA);
            PG8_WAIT_L(8); PG8_BAR; PG8_WAIT_L(0); PG8_MMA(0, 0, At, B0); PG8_BAR; PG8_SCHED;
            PG8_LDB(B1, 1, 1); PG8_STAGE(PG8_SB(1, 0), b3, voffB);
            PG8_BAR; PG8_WAIT_L(0); PG8_MMA(0, 1, At, B1); PG8_BAR;
            PG8_LDA(At, 1, 1); PG8_STAGE(PG8_SA(1, 0), a3, voffA);
            PG8_BAR; PG8_WAIT_L(0); PG8_MMA(1, 0, At, B0); PG8_BAR; PG8_SCHED;
            PG8_STAGE(PG8_SB(1, 1), b3 + hstepB, voffB);
            PG8_WAIT_V(6); PG8_BAR; PG8_MMA(1, 1, At, B1); PG8_BAR;
            }
        }
        if constexpr (ALIGN_EPI) { if (wr == 0) PG8_BAR; }
        if constexpr (after_drain<Epi>::value) {   }
        else if constexpr (EXTACC == 1) E.inplace(acc, cur, wr, wc, fr, fq); else E(acc, cur, wr, wc, fr, fq);
        if (!has_next || EXTACC != 0 || after_drain<Epi>::value) break;
#pragma unroll
        for (int a = 0; a < 2; ++a)
#pragma unroll
            for (int b = 0; b < 2; ++b)
#pragma unroll
                for (int m = 0; m < 4; ++m)
#pragma unroll
                    for (int n = 0; n < 2; ++n) acc[a][b][m][n] = (f32x4){0.f, 0.f, 0.f, 0.f};
        cur = nxt; cA = nA; cB = nB; ++ui;
        if constexpr (ALIGN_EPI) { if (wr == 1) PG8_BAR; }
    }
    PG8_WAIT_V(0);
    if constexpr (!ALIGN_EPI) { if (wr == 0) PG8_BAR; }
    PG8_BAR;
    if constexpr (after_drain<Epi>::value) E.fused(acc, cur, lds);
#undef PG8_SA
#undef PG8_SB
#undef PG8_STAGE
#undef PG8_LDA
#undef PG8_LDB
#undef PG8_MMA
#undef PG8_WAIT_V
#undef PG8_WAIT_L
#undef PG8_BAR
#undef PG8_SCHED
}
}

constexpr int DM = 1024, NB = 8, SEQ = 2048, MTOK = NB * SEQ, CTXL = 256, MCTX = NB * CTXL;
constexpr int HGD = 512, DFF = 2816, DFF2 = 5632, INDIM = 5120, NMOD = 6;
constexpr float EPSN = 1e-6f;
constexpr int NWAVES = 8, NTHR = 512;
constexpr int LDS_BYTES = 147456;
#ifndef DUP_MASK
#define DUP_MASK 0
#endif
#define REPS(k) ((((DUP_MASK) >> (k)) & 1) ? 2 : 1)
#ifndef PROBE_K
#define PROBE_K -1
#endif
#ifndef EXTRA_SYNCS
#define EXTRA_SYNCS 0
#endif

constexpr size_t MiB = 1u << 20;
constexpr size_t WS_MX = 0;
constexpr size_t WS_LB = 256 * 1024;
constexpr size_t WS_SLOT = 1 * MiB;
constexpr size_t WS_WFS = 2 * MiB, WS_TCH = 3 * MiB;
constexpr size_t WS_BAR = 512 * 1024, BAR_BYTES = 32768;
constexpr int MISC_OFF = 147456 - 128;
constexpr size_t WS_WIN = 6 * MiB;
constexpr size_t WS_WPQ = 16 * MiB;
constexpr size_t WS_WA = 18 * MiB, WS_WB = 19 * MiB, WS_WOUT = 20 * MiB;
constexpr size_t WS_CS = 22 * MiB;
constexpr size_t WS_WUP = 6 * MiB;
constexpr size_t WS_WDN = 250 * MiB;
constexpr size_t WS_HX = 38 * MiB;
constexpr size_t WS_OF = 38 * MiB, WS_OB = 54 * MiB;
constexpr size_t WS_TMP = 38 * MiB;
constexpr size_t WS_H2 = 38 * MiB;
constexpr size_t WS_Q = 74 * MiB, WS_V = 90 * MiB, WS_OG = 106 * MiB, WS_GA = 122 * MiB, WS_GBG = 154 * MiB, WS_PQT = 186 * MiB;
constexpr size_t WS_GFC = 218 * MiB, WS_GBC = 222 * MiB, WS_VC = 226 * MiB;
constexpr size_t WS_YF = 228 * MiB;
constexpr size_t WS_YH = 74 * MiB;
constexpr size_t WS_MRG = 186 * MiB;
constexpr size_t WS_Z = 74 * MiB;
constexpr size_t WS_A2 = 162 * MiB;
constexpr size_t WS_XO = 38 * MiB;
constexpr size_t WS_END = 256 * MiB;

typedef unsigned short bf16;
typedef float f32x4 __attribute__((ext_vector_type(4)));
typedef unsigned u32x4 __attribute__((ext_vector_type(4)));
typedef unsigned u32x2 __attribute__((ext_vector_type(2)));
typedef float f32x2 __attribute__((ext_vector_type(2)));
#define LAS __attribute__((address_space(3)))

struct Params {
    const float* in[19];
    float* out;
    unsigned char* ws;
};

__device__ __forceinline__ float bf2f(unsigned short b) { return __uint_as_float(((unsigned)b) << 16); }
__device__ __forceinline__ float bflo(unsigned w) { return __uint_as_float(w << 16); }
__device__ __forceinline__ float bfhi(unsigned w) { return __uint_as_float(w & 0xffff0000u); }
__device__ __forceinline__ unsigned f2bf(float f) { unsigned u = __float_as_uint(f); return (u + 0x7fffu + ((u >> 16) & 1u)) >> 16; }
__device__ __forceinline__ unsigned pk2(float lo, float hi);
typedef __bf16 bf16x2_t __attribute__((ext_vector_type(2)));
__device__ __forceinline__ unsigned hwpk2(float lo, float hi) { const f32x2 v = {lo, hi}; const bf16x2_t r = __builtin_convertvector(v, bf16x2_t); return __builtin_bit_cast(unsigned, r); }
__device__ __forceinline__ unsigned pk2(float lo, float hi) { return hwpk2(lo, hi); }
__device__ __forceinline__ float sigmoidf_(float x) { return __builtin_amdgcn_rcpf(1.f + __expf(-x)); }
__device__ __forceinline__ float siluf_(float x) { return x * __builtin_amdgcn_rcpf(1.f + __expf(-x)); }
__device__ __forceinline__ float wave_sum(float v) {
#pragma unroll
    for (int o = 1; o < 64; o <<= 1) v += __shfl_xor(v, o);
    return v;
}
__device__ __forceinline__ u32x4 pack8(const f32x4 a, const f32x4 b) { u32x4 w; w.x = pk2(a[0], a[1]); w.y = pk2(a[2], a[3]); w.z = pk2(b[0], b[1]); w.w = pk2(b[2], b[3]); return w; }

typedef __attribute__((address_space(1))) unsigned gu32;
#define XB_TMO      128
#define XB_XCNT(j)  (256  + 64 * (j))
#define XB_XSUB(j)  (1280 + 64 * (j))
#define XB_XGEN(j)  (2304 + 64 * (j))
#define XB_TOP      3328
#define XB_TOPGEN   3392
#define XCD_BAR_WORDS 3456
#define XB_SPIN_CAP (1u << 18)

__device__ __forceinline__ unsigned xb_ld(unsigned* p)              { return __hip_atomic_load(p, __ATOMIC_RELAXED, __HIP_MEMORY_SCOPE_AGENT); }
__device__ __forceinline__ unsigned xb_add(unsigned* p, unsigned v) { return __hip_atomic_fetch_add(p, v, __ATOMIC_RELAXED, __HIP_MEMORY_SCOPE_AGENT); }
__device__ __forceinline__ unsigned xb_xcc_id() { return (unsigned)__builtin_amdgcn_s_getreg((3 << 11) | 20) & 0xFu; }
#define XB_SPIN(cond, bar) do { unsigned _sp = 0; while (cond) { __builtin_amdgcn_s_sleep(1); \
    if ((++_sp & 255u) == 0u) { if (xb_ld(&(bar)[XB_TMO])) break; if (_sp > XB_SPIN_CAP) { atomicAdd(&(bar)[XB_TMO], 1u); break; } } } } while (0)

struct XcdBarrier {
    unsigned* bar; unsigned x;
    volatile LAS unsigned* st;
};

__device__ __forceinline__ XcdBarrier xcd_barrier_post(unsigned* bar, volatile LAS unsigned* st) {
    XcdBarrier b; b.bar = bar; b.x = xb_xcc_id(); b.st = st;
    if (threadIdx.x == 0) (void)xb_add(&bar[XB_XCNT(b.x)], 1u);
    return b;
}
__device__ __forceinline__ void xcd_barrier_complete(unsigned* bar, unsigned x, unsigned& nloc, unsigned& nx) {
    const unsigned G = gridDim.x * gridDim.y * gridDim.z;
    unsigned sum, cnt, mine, sp = 0u;
    for (;;) {
        sum = 0u; cnt = 0u; mine = 0u;
#pragma unroll
        for (unsigned j = 0; j < 16; ++j) { const unsigned c = xb_ld(&bar[XB_XCNT(j)]); sum += c; cnt += (c > 0u) ? 1u : 0u; mine = (j == x) ? c : mine; }
        if (sum == G) break;
        __builtin_amdgcn_s_sleep(1);
        if ((++sp & 255u) == 0u) { if (xb_ld(&bar[XB_TMO])) break; if (sp > XB_SPIN_CAP) { atomicAdd(&bar[XB_TMO], 1u); break; } }
    }
    nloc = mine > 0u ? mine : 1u; nx = cnt > 0u ? cnt : 1u;
}

__device__ __forceinline__ void xcd_barrier(const XcdBarrier& b) {
    asm volatile("s_waitcnt vmcnt(0)" ::: "memory");
    __syncthreads();
    if (threadIdx.x == 0) {
        unsigned* bar = b.bar;
        __builtin_amdgcn_s_waitcnt(0);
        unsigned nloc = b.st[0], nx = b.st[1];
        if (nloc == 0u) { xcd_barrier_complete(bar, b.x, nloc, nx); b.st[0] = nloc; b.st[1] = nx; }
        const unsigned old = xb_add(&bar[XB_XSUB(b.x)], 1u);
        const unsigned gen = old / nloc;
        if (old + 1u == (gen + 1u) * nloc) {
            __builtin_amdgcn_fence(__ATOMIC_RELEASE, "agent");
            asm volatile("s_waitcnt vmcnt(0)" ::: "memory");
            const unsigned og = xb_add(&bar[XB_TOP], 1u);
            const unsigned tg = og / nx;
            if (og + 1u == (tg + 1u) * nx) xb_add(&bar[XB_TOPGEN], 1u);
            else XB_SPIN(xb_ld(&bar[XB_TOPGEN]) == tg, bar);
            __builtin_amdgcn_fence(__ATOMIC_ACQUIRE, "agent");
            xb_add(&bar[XB_XGEN(b.x)], 1u);
            asm volatile("s_waitcnt vmcnt(0)" ::: "memory");
        } else {
            XB_SPIN(xb_ld(&bar[XB_XGEN(b.x)]) == gen, bar);
            __builtin_amdgcn_fence(__ATOMIC_ACQUIRE, "agent");
            asm volatile("s_waitcnt vmcnt(0)" ::: "memory");
        }
    }
    __syncthreads();
}


struct FIn {
    unsigned char* ws; float* out;
    __device__ __forceinline__ void operator()(const pg8::Unit& u, int row, int col, f32x4 v0, f32x4 v1) const {
        const int seg = u.pn >> 1, c = col & 511;
        if (seg == 0 || seg == 4) { f32x4 a, b;
#pragma unroll
            for (int i = 0; i < 4; ++i) { a[i] = siluf_(v0[i]); b[i] = siluf_(v1[i]); }
            bf16* dst = (bf16*)(ws + (seg == 0 ? WS_Q : WS_OG));
            *(u32x4*)(dst + (size_t)row * 512 + c) = pack8(a, b);
        } else if (seg == 1 || seg == 2) {
            const float* lb = (const float*)(ws + WS_LB);
            const f32x4 l0 = *(const f32x4*)(lb + c), l1 = *(const f32x4*)(lb + c + 4); f32x4 a, b;
#pragma unroll
            for (int i = 0; i < 4; ++i) { a[i] = l0[i] + (1.f - l0[i]) * sigmoidf_(v0[i]); b[i] = l1[i] + (1.f - l1[i]) * sigmoidf_(v1[i]); }
            float* dst;
            if (u.pm < 64) dst = out + (seg == 1 ? (size_t)0 : (size_t)MTOK * 512) + (size_t)row * 512 + c;
            else dst = (float*)(ws + (seg == 1 ? WS_GFC : WS_GBC)) + (size_t)(row - MTOK) * 512 + c;
            *(f32x4*)dst = a; *(f32x4*)(dst + 4) = b;
        } else if (seg == 3) {
            bf16* dst;
            if (u.pm < 64) dst = (bf16*)(ws + WS_V) + (size_t)row * 512 + c; else dst = (bf16*)(ws + WS_VC) + (size_t)(row - MTOK) * 512 + c;
            *(u32x4*)dst = pack8(v0, v1);
        } else { f32x4 a, b;
#pragma unroll
            for (int i = 0; i < 4; ++i) { a[i] = sigmoidf_(v0[i]); b[i] = sigmoidf_(v1[i]); }
            bf16* dst = (seg < 7) ? ((bf16*)(ws + WS_GA) + (size_t)row * 1024 + (col - 5 * 512)) : ((bf16*)(ws + WS_GBG) + (size_t)row * 1024 + (col - 7 * 512));
            *(u32x4*)dst = pack8(a, b);
        }
    }
};
struct FPQ {
    bf16* pqt;
    __device__ __forceinline__ void operator()(const pg8::Unit&, int row, int col, f32x4 v0, f32x4 v1) const {
        bf16* dst = pqt + (size_t)(row & 511) * 32768 + (size_t)(col >> 11) * 4096 + (size_t)(row >> 9) * 1024 + ((col & 2047) >> 1);
        u32x2 ev, od; ev.x = pk2(v0[0], v0[2]); ev.y = pk2(v1[0], v1[2]); od.x = pk2(v0[1], v0[3]); od.y = pk2(v1[1], v1[3]);
        *(u32x2*)dst = ev; *(u32x2*)(dst + 2048) = od;
    }
};
struct EpiDft {
    static constexpr bool PERM = true;
    bf16* yf; unsigned* flags;
    __device__ __forceinline__ void operator()(const f32x4 (&acc)[2][2][4][2], const pg8::Unit& u, int wr, int wc, int fr, int fq) const {
        const int z = u.z & 255, eo = u.z >> 8, pair = (z * 4 + u.pm) * 2 + u.pn;
        const int row0 = u.pm * 256 + wr * 64 + fr, col0 = u.pn * 256 + wc * 32 + 8 * fq;
        unsigned* flag = flags + pair * 16;
        if (eo) {
#pragma unroll
            for (int ai = 0; ai < 2; ++ai)
#pragma unroll
                for (int m = 0; m < 4; ++m)
#pragma unroll
                    for (int bj = 0; bj < 2; ++bj) { const int row = row0 + ai * 128 + m * 16, col = col0 + bj * 128;
                        *(u32x4*)(yf + ((size_t)z * SEQ + 1024 + row) * 512 + col) = pack8(acc[ai][bj][m][0] * (1.f / 512.f), acc[ai][bj][m][1] * (1.f / 512.f)); }
            asm volatile("s_waitcnt vmcnt(0)" ::: "memory");
            __syncthreads();
            if (threadIdx.x == 0) { __builtin_amdgcn_fence(__ATOMIC_RELEASE, "agent"); asm volatile("s_waitcnt vmcnt(0)" ::: "memory");
                __hip_atomic_store(flag, 1u, __ATOMIC_RELAXED, __HIP_MEMORY_SCOPE_AGENT); }
        } else {
            if (threadIdx.x == 0) { unsigned spins = 0;
                while (__hip_atomic_load(flag, __ATOMIC_RELAXED, __HIP_MEMORY_SCOPE_AGENT) == 0u && ++spins < (1u << 22)) __builtin_amdgcn_s_sleep(2);
                __builtin_amdgcn_fence(__ATOMIC_ACQUIRE, "agent"); asm volatile("s_waitcnt vmcnt(0)" ::: "memory"); }
            __syncthreads();
#pragma unroll
            for (int ai = 0; ai < 2; ++ai)
#pragma unroll
                for (int m = 0; m < 4; ++m) {
#pragma unroll
                    for (int bj = 0; bj < 2; ++bj) { const int row = row0 + ai * 128 + m * 16, col = col0 + bj * 128;
                        bf16* plo = yf + ((size_t)z * SEQ + row) * 512 + col; bf16* phi = plo + (size_t)1024 * 512;
                        const u32x4 o = *(const u32x4*)phi;
                        const f32x4 e0 = acc[ai][bj][m][0] * (1.f / 512.f), e1 = acc[ai][bj][m][1] * (1.f / 512.f);
                        f32x4 o0, o1; o0[0] = bflo(o.x); o0[1] = bfhi(o.x); o0[2] = bflo(o.y); o0[3] = bfhi(o.y); o1[0] = bflo(o.z); o1[1] = bfhi(o.z); o1[2] = bflo(o.w); o1[3] = bfhi(o.w);
                        *(u32x4*)plo = pack8(e0 + o0, e1 + o1); *(u32x4*)phi = pack8(e0 - o0, e1 - o1); }
                    asm volatile("" ::: "memory"); }
        }
    }
};
struct FYa {
    const bf16* ga;
    __device__ __forceinline__ void scale(const pg8::Unit&, int row, int col, f32x4& v0, f32x4& v1) const {
        const size_t o = (size_t)row * 1024 + col; const u32x4 g = *(const u32x4*)(ga + o);
        v0[0] *= bflo(g.x); v0[1] *= bfhi(g.x); v0[2] *= bflo(g.y); v0[3] *= bfhi(g.y); v1[0] *= bflo(g.z); v1[1] *= bfhi(g.z); v1[2] *= bflo(g.w); v1[3] *= bfhi(g.w);
    }
    __device__ __forceinline__ void operator()(const pg8::Unit&, int, int, f32x4, f32x4) const {}
};
struct FYb {
    const bf16* gbg; bf16* mrg;
    __device__ __forceinline__ void scale(const pg8::Unit&, int row, int col, f32x4& v0, f32x4& v1) const {
        const size_t o = (size_t)row * 1024 + col; const u32x4 h = *(const u32x4*)(gbg + o);
        v0[0] *= __builtin_amdgcn_rcpf(bflo(h.x)); v0[1] *= __builtin_amdgcn_rcpf(bfhi(h.x)); v0[2] *= __builtin_amdgcn_rcpf(bflo(h.y)); v0[3] *= __builtin_amdgcn_rcpf(bfhi(h.y));
        v1[0] *= __builtin_amdgcn_rcpf(bflo(h.z)); v1[1] *= __builtin_amdgcn_rcpf(bfhi(h.z)); v1[2] *= __builtin_amdgcn_rcpf(bflo(h.w)); v1[3] *= __builtin_amdgcn_rcpf(bfhi(h.w));
    }
    __device__ __forceinline__ void operator()(const pg8::Unit&, int row, int col, f32x4 v0, f32x4 v1) const {
        const size_t o = (size_t)row * 1024 + col; const u32x4 h = *(const u32x4*)(gbg + o);
        f32x4 a, b; a[0] = v0[0] * bflo(h.x); a[1] = v0[1] * bfhi(h.x); a[2] = v0[2] * bflo(h.y); a[3] = v0[3] * bfhi(h.y);
        b[0] = v1[0] * bflo(h.z); b[1] = v1[1] * bfhi(h.z); b[2] = v1[2] * bflo(h.w); b[3] = v1[3] * bfhi(h.w);
        *(u32x4*)(mrg + o) = pack8(a, b);
    }
};
struct FYab {
    const bf16* ga; const bf16* gbg;
    __device__ __forceinline__ void scale(const pg8::Unit&, int row, int col, f32x4& v0, f32x4& v1) const {
        const size_t o = (size_t)row * 1024 + col; const u32x4 g = *(const u32x4*)(ga + o), h = *(const u32x4*)(gbg + o);
        v0[0] *= bflo(g.x) * __builtin_amdgcn_rcpf(bflo(h.x)); v0[1] *= bfhi(g.x) * __builtin_amdgcn_rcpf(bfhi(h.x)); v0[2] *= bflo(g.y) * __builtin_amdgcn_rcpf(bflo(h.y)); v0[3] *= bfhi(g.y) * __builtin_amdgcn_rcpf(bfhi(h.y));
        v1[0] *= bflo(g.z) * __builtin_amdgcn_rcpf(bflo(h.z)); v1[1] *= bfhi(g.z) * __builtin_amdgcn_rcpf(bfhi(h.z)); v1[2] *= bflo(g.w) * __builtin_amdgcn_rcpf(bflo(h.w)); v1[3] *= bfhi(g.w) * __builtin_amdgcn_rcpf(bfhi(h.w));
    }
    __device__ __forceinline__ void operator()(const pg8::Unit&, int, int, f32x4, f32x4) const {}
};
struct FYaT {
    const bf16* ga; bf16* tmp;
    __device__ __forceinline__ void operator()(const pg8::Unit&, int row, int col, f32x4 v0, f32x4 v1) const {
        const size_t o = (size_t)row * 1024 + col; const u32x4 g = *(const u32x4*)(ga + o);
        f32x4 a, b; a[0] = v0[0] * bflo(g.x); a[1] = v0[1] * bfhi(g.x); a[2] = v0[2] * bflo(g.y); a[3] = v0[3] * bfhi(g.y);
        b[0] = v1[0] * bflo(g.z); b[1] = v1[1] * bfhi(g.z); b[2] = v1[2] * bflo(g.w); b[3] = v1[3] * bfhi(g.w);
        *(u32x4*)(tmp + o) = pack8(a, b);
    }
};
struct FYbT {
    const bf16* gbg; const bf16* tmp; bf16* mrg;
    __device__ __forceinline__ void operator()(const pg8::Unit&, int row, int col, f32x4 v0, f32x4 v1) const {
        const size_t o = (size_t)row * 1024 + col; const u32x4 g = *(const u32x4*)(gbg + o); const u32x4 t = *(const u32x4*)(tmp + o);
        f32x4 a, b; a[0] = bflo(t.x) + v0[0] * bflo(g.x); a[1] = bfhi(t.x) + v0[1] * bfhi(g.x); a[2] = bflo(t.y) + v0[2] * bflo(g.y); a[3] = bfhi(t.y) + v0[3] * bfhi(g.y);
        b[0] = bflo(t.z) + v1[0] * bflo(g.z); b[1] = bfhi(t.z) + v1[1] * bfhi(g.z); b[2] = bflo(t.w) + v1[2] * bflo(g.w); b[3] = bfhi(t.w) + v1[3] * bfhi(g.w);
        *(u32x4*)(mrg + o) = pack8(a, b);
    }
};
struct FRes {
    const float* src; float* dst; const float* mx; int mod;
    __device__ __forceinline__ void operator()(const pg8::Unit&, int row, int col, f32x4 v0, f32x4 v1) const {
        const size_t o = (size_t)row * 1024 + col; const float* m = mx + (size_t)(row >> 11) * (NMOD * DM) + mod * DM + col;
        const f32x4 m0 = *(const f32x4*)m, m1 = *(const f32x4*)(m + 4), s0 = *(const f32x4*)(src + o), s1 = *(const f32x4*)(src + o + 4);
        *(f32x4*)(dst + o) = s0 + m0 * v0; *(f32x4*)(dst + o + 4) = s1 + m1 * v1;
    }
};
struct FUp {
    bf16* z; int ld;
    __device__ __forceinline__ void operator()(const pg8::Unit&, int row, int col, f32x4 v0, f32x4 v1) const {
        *(u32x4*)(z + (size_t)row * ld + col) = pack8(v0, v1);
    }
};

struct EpiFinal {
    static constexpr bool PERM = true, AFTER_DRAIN = true;
    float* xio; const float* mx; const float* fg; float* slots; unsigned* flags;
    __device__ __forceinline__ void operator()(const f32x4 (&)[2][2][4][2], const pg8::Unit&, int, int, int, int) const {}
    __device__ __forceinline__ void fused(f32x4 (&acc)[2][2][4][2], const pg8::Unit& u, PG8_LAS unsigned char* ldsl) const {
        int t2_ = threadIdx.x; asm volatile("" : "+v"(t2_));
        const int tid = t2_, wid = __builtin_amdgcn_readfirstlane(tid >> 6), lane = tid & 63, wr = wid >> 2, wc = wid & 3, fr = lane & 15, fq = lane >> 4;
        PG8_LAS float* red = (PG8_LAS float*)ldsl;
        PG8_LAS float* rin = red + 1024;
        const int row0 = u.pm * 256 + wr * 64 + fr, col0 = u.pn * 256 + wc * 32 + 8 * fq;
        float ss[2][4];
#pragma unroll
        for (int ai = 0; ai < 2; ++ai)
#pragma unroll
            for (int m = 0; m < 4; ++m) ss[ai][m] = 0.f;
#pragma unroll
        for (int bj = 0; bj < 2; ++bj) { const int col = col0 + bj * 128;
            const float* mm = mx + (size_t)(u.pm >> 3) * (NMOD * DM) + 5 * DM + col;
            const f32x4 m0 = *(const f32x4*)mm, m1 = *(const f32x4*)(mm + 4);
#pragma unroll
            for (int ai = 0; ai < 2; ++ai)
#pragma unroll
                for (int m = 0; m < 4; ++m) { const size_t o = (size_t)(row0 + ai * 128 + m * 16) * 1024 + col;
                    const f32x4 x0 = *(const f32x4*)(xio + o), x1 = *(const f32x4*)(xio + o + 4);
                    const f32x4 v0 = x0 + m0 * acc[ai][bj][m][0], v1 = x1 + m1 * acc[ai][bj][m][1];
                    acc[ai][bj][m][0] = v0; acc[ai][bj][m][1] = v1;
                    ss[ai][m] += (v0[0] * v0[0] + v0[1] * v0[1]) + (v0[2] * v0[2] + v0[3] * v0[3]) + (v1[0] * v1[0] + v1[1] * v1[1]) + (v1[2] * v1[2] + v1[3] * v1[3]);
                    asm volatile("" ::: "memory"); } }
#pragma unroll
        for (int ai = 0; ai < 2; ++ai)
#pragma unroll
            for (int m = 0; m < 4; ++m) { float s = ss[ai][m]; s += __shfl_xor(s, 16); s += __shfl_xor(s, 32); ss[ai][m] = s; }
        if (fq == 0) {
#pragma unroll
            for (int ai = 0; ai < 2; ++ai)
#pragma unroll
                for (int m = 0; m < 4; ++m) red[(ai * 128 + wr * 64 + m * 16 + fr) * 4 + wc] = ss[ai][m]; }
        __syncthreads();
        float* myslot = slots + (size_t)(u.pm * 4 + u.pn) * 256;
        if (tid < 256) myslot[tid] = (red[tid * 4 + 0] + red[tid * 4 + 1]) + (red[tid * 4 + 2] + red[tid * 4 + 3]);
        asm volatile("s_waitcnt vmcnt(0)" ::: "memory");
        __syncthreads();
        unsigned* flag = flags + u.pm * 16;
        if (tid == 0) { __builtin_amdgcn_fence(__ATOMIC_RELEASE, "agent"); asm volatile("s_waitcnt vmcnt(0)" ::: "memory");
            __hip_atomic_fetch_add(flag, 1u, __ATOMIC_RELAXED, __HIP_MEMORY_SCOPE_AGENT);
            unsigned spins = 0;
            while (__hip_atomic_load(flag, __ATOMIC_RELAXED, __HIP_MEMORY_SCOPE_AGENT) < 4u && ++spins < (1u << 22)) __builtin_amdgcn_s_sleep(2);
            __builtin_amdgcn_fence(__ATOMIC_ACQUIRE, "agent"); asm volatile("s_waitcnt vmcnt(0)" ::: "memory"); }
        __syncthreads();
        if (tid < 256) { const float* sl = slots + (size_t)(u.pm * 4) * 256 + tid;
            const float tot = (sl[0] + sl[256]) + (sl[512] + sl[768]);
            rin[tid] = rsqrtf(tot * (1.f / DM) + EPSN); }
        __syncthreads();
#pragma unroll
        for (int bj = 0; bj < 2; ++bj) { const int col = col0 + bj * 128;
            const f32x4 g0 = *(const f32x4*)(fg + col), g1 = *(const f32x4*)(fg + col + 4);
#pragma unroll
            for (int ai = 0; ai < 2; ++ai)
#pragma unroll
                for (int m = 0; m < 4; ++m) { const float r = rin[ai * 128 + wr * 64 + m * 16 + fr]; const size_t o = (size_t)(row0 + ai * 128 + m * 16) * 1024 + col;
                    *(f32x4*)(xio + o) = acc[ai][bj][m][0] * r * g0; *(f32x4*)(xio + o + 4) = acc[ai][bj][m][1] * r * g1;
                    asm volatile("" ::: "memory"); } }
    }
};

__device__ __forceinline__ void transpose_item(const float* W, int K, int N, bf16* WT, LAS float* scr, int item, int lane) {
    const int nblk = N / 32, kb = item / nblk, nb = item % nblk, k0 = 64 * kb, n0 = 32 * nb;
#pragma unroll 8
    for (int i = 0; i < 32; ++i) { const int kk = 2 * i + (lane >> 5); scr[kk * 33 + (lane & 31)] = W[(size_t)(k0 + kk) * N + n0 + (lane & 31)]; }
    asm volatile("s_waitcnt lgkmcnt(0)" ::: "memory");
    const int c = lane & 7;
#pragma unroll
    for (int j = 0; j < 4; ++j) { const int n = (lane >> 3) + 8 * j; const LAS float* s = scr + (8 * c) * 33 + n;
        u32x4 o; o.x = pk2(s[0 * 33], s[1 * 33]); o.y = pk2(s[2 * 33], s[3 * 33]); o.z = pk2(s[4 * 33], s[5 * 33]); o.w = pk2(s[6 * 33], s[7 * 33]);
        *(u32x4*)(WT + (size_t)(n0 + n) * K + k0 + 8 * c) = o; }
    asm volatile("s_waitcnt lgkmcnt(0)" ::: "memory");
}

template <bool MOD>
__device__ __forceinline__ void norm_rows(const float* srcA, const float* srcB, int nA, const float* g, const float* mx, int shift_mod, int scale_mod,
                                          bf16* outb, float* outf, int r0, int nr, int lane) {
    f32x4 G[4], SH[4], cur[4], nxt[4];
    int curmod = -1;
    { const float* s0 = (r0 < nA) ? srcA + (size_t)r0 * DM : srcB + (size_t)(r0 - nA) * DM;
#pragma unroll
      for (int j = 0; j < 4; ++j) cur[j] = *(const f32x4*)(s0 + (lane + 64 * j) * 4); }
#pragma unroll 1
    for (int i = 0; i < nr; ++i) {
        const int m = r0 + i;
        if (i + 1 < nr) { const int m1 = m + 1; const float* s1 = (m1 < nA) ? srcA + (size_t)m1 * DM : srcB + (size_t)(m1 - nA) * DM;
#pragma unroll
            for (int j = 0; j < 4; ++j) nxt[j] = *(const f32x4*)(s1 + (lane + 64 * j) * 4); }
        const int mr = MOD ? ((m < nA) ? (m >> 11) : 8) : 0;
        if (mr != curmod) { curmod = mr;
#pragma unroll
            for (int j = 0; j < 4; ++j) { const int e = (lane + 64 * j) * 4; const f32x4 gg = *(const f32x4*)(g + e);
                if (MOD) { const f32x4 sc = *(const f32x4*)(mx + (size_t)mr * (NMOD * DM) + scale_mod * DM + e); SH[j] = *(const f32x4*)(mx + (size_t)mr * (NMOD * DM) + shift_mod * DM + e); G[j] = gg * (sc + 1.f); }
                else { G[j] = gg; SH[j] = (f32x4){0.f, 0.f, 0.f, 0.f}; } } }
        float s = 0.f;
#pragma unroll
        for (int j = 0; j < 4; ++j) s += (cur[j][0] * cur[j][0] + cur[j][1] * cur[j][1]) + (cur[j][2] * cur[j][2] + cur[j][3] * cur[j][3]);
        const float rinv = rsqrtf(wave_sum(s) * (1.f / DM) + EPSN);
#pragma unroll
        for (int j = 0; j < 4; ++j) { const int e = (lane + 64 * j) * 4; const f32x4 h = cur[j] * rinv * G[j] + SH[j];
            if (MOD) { u32x2 w; w.x = pk2(h[0], h[1]); w.y = pk2(h[2], h[3]); *(u32x2*)(outb + (size_t)m * DM + e) = w; }
            else *(f32x4*)(outf + (size_t)m * DM + e) = h; }
#pragma unroll
        for (int j = 0; j < 4; ++j) cur[j] = nxt[j];
    }
}

__device__ __forceinline__ void phase0(const Params& p, unsigned char* lds, int tid, int lane, int wave, int G, const int part) {
    float* ldsf = (float*)lds;
    float* mxo = (float*)(p.ws + WS_MX);
    if (part == 0) {
    for (int it = blockIdx.x; it < 192; it += G) {
        __syncthreads();
        {
            const float* c = p.in[1]; const float* cc = p.in[3]; const float* aw = p.in[4]; const float* ab = p.in[5];
            float* sc = ldsf;
            float* red = ldsf + 9 * 1024;
            for (int i = tid; i < 9 * 1024; i += NTHR) { const int r = i >> 10, k = i & 1023; const float cv = (r < 8) ? c[r * 1024 + k] : cc[k]; sc[i] = cv / (1.f + __expf(-cv)); }
            __syncthreads();
            const int n0 = it * 32, col = tid & 31, ks = tid >> 5;
            float a[9];
#pragma unroll
            for (int r = 0; r < 9; ++r) a[r] = 0.f;
            for (int k = ks * 64; k < ks * 64 + 64; ++k) { const float w = aw[(size_t)k * (NMOD * DM) + n0 + col];
#pragma unroll
                for (int r = 0; r < 9; ++r) a[r] += sc[r * 1024 + k] * w; }
#pragma unroll
            for (int r = 0; r < 9; ++r) red[(ks * 9 + r) * 32 + col] = a[r];
            __syncthreads();
            if (tid < 288) { const int r = tid >> 5, cl = tid & 31; float s = ab[n0 + cl];
                for (int k2 = 0; k2 < 16; ++k2) s += red[(k2 * 9 + r) * 32 + cl];
                mxo[r * (NMOD * DM) + n0 + cl] = s; }
        }
    }
    __syncthreads();
    { bf16* tch = (bf16*)(p.ws + WS_TCH); bf16* wfs = (bf16*)(p.ws + WS_WFS); const float* win = p.in[7];
      for (int i = blockIdx.x * NTHR + tid; i < 1024 * 64; i += G * NTHR) { const int n = i >> 6, c8 = (i & 63) * 8, gn = (n & 511) >> 7, j = n & 127; float vv[8];
#pragma unroll
          for (int e = 0; e < 8; ++e) { const int cp = c8 + e, idx = ((cp & 127) * j) & 127; const float ang = (float)idx * (1.f / 64.f);
              vv[e] = ((cp >> 7) == gn) ? ((n < 512) ? cospif(ang) : sinpif(ang)) : 0.f; }
          u32x4 w; w.x = pk2(vv[0], vv[1]); w.y = pk2(vv[2], vv[3]); w.z = pk2(vv[4], vv[5]); w.w = pk2(vv[6], vv[7]);
          *(u32x4*)(tch + (size_t)n * 512 + c8) = w;
          const f32x4 a = *(const f32x4*)(win + (size_t)n * INDIM + c8), b2 = *(const f32x4*)(win + (size_t)n * INDIM + c8 + 4);
          *(u32x4*)(wfs + (size_t)n * 512 + c8) = pack8(a, b2); } }
    }
    if (part == 0 && blockIdx.x == G - 1) { const float* hl = p.in[8]; float* lbo = (float*)(p.ws + WS_LB);
        if (tid < 512) { const float a = hl[tid], b = hl[512 + tid]; lbo[tid] = 1.f / (1.f + expf(b - a)); } }
    if (part == 0) return;
    { bf16* cs = (bf16*)(p.ws + WS_CS);
      for (int i = blockIdx.x * NTHR + tid; i < 2 * 1024 * 256; i += G * NTHR) { const int eo = i >> 18, l = (i >> 8) & 1023, kc = (i & 255) * 8; float vv[8];
#pragma unroll
          for (int e = 0; e < 8; ++e) { const int k = kc + e, sn = k >> 10, m = k & 1023;
              const float ang = eo ? (float)((l * (2 * m + 1)) & 2047) * (1.f / 1024.f) : (float)((l * m) & 1023) * (1.f / 512.f);
              vv[e] = sn ? -sinpif(ang) : cospif(ang); }
          u32x4 w; w.x = pk2(vv[0], vv[1]); w.y = pk2(vv[2], vv[3]); w.z = pk2(vv[4], vv[5]); w.w = pk2(vv[6], vv[7]);
          *(u32x4*)(cs + ((size_t)eo * 1024 + l) * 2048 + kc) = w; } }
    { LAS float* scr = (LAS float*)((LAS unsigned char*)lds + wave * 16384);
      const int gw = blockIdx.x * NWAVES + wave, NGW = G * NWAVES;
      constexpr int I_IN = 16 * 160, I_A = 8 * 32, I_B = 8 * 32, I_O = 16 * 32;
      for (int it = gw; it < ((G >= 192) ? I_IN : I_IN + I_A + I_B + I_O); it += NGW) { int r = it;
          if (r < I_IN) { transpose_item(p.in[7], 1024, INDIM, (bf16*)(p.ws + WS_WIN), scr, r, lane); continue; } r -= I_IN;
          if (r < I_A) { transpose_item(p.in[10], 512, 1024, (bf16*)(p.ws + WS_WA), scr, r, lane); continue; } r -= I_A;
          if (r < I_B) { transpose_item(p.in[11], 512, 1024, (bf16*)(p.ws + WS_WB), scr, r, lane); continue; } r -= I_B;
          transpose_item(p.in[12], 1024, 1024, (bf16*)(p.ws + WS_WOUT), scr, r, lane); } }
}

__device__ __forceinline__ void hgrn_mfma_item(const Params& p, unsigned char* lds, int item) {
    int tid_ = threadIdx.x; asm volatile("" : "+v"(tid_));
    const int tid = tid_, lane = tid & 63, w = __builtin_amdgcn_readfirstlane(tid >> 6), fr = lane & 15, fq = lane >> 4;
    const int vh = item & 1, dir = (item >> 1) & 1, h = (item >> 2) & 3, b = item >> 4;
    bf16* Qs = (bf16*)lds;
    bf16* Ks = Qs + 64 * 136;
    bf16* St = Ks + 64 * 136;
    bf16* Kh = St + 2 * 64 * 136;
    bf16* Vt = Kh + 128 * 72;
    bf16* Ps = Vt + 64 * 72;
    float* Et = (float*)(Ps + 64 * 72);
    float* Fr = Et + 128;
    float* Bt = Fr + 64 * 132;
    const int d = 16 * w + fr;
    const float* fL = p.out + (dir ? (size_t)MTOK * 512 : 0) + (size_t)b * SEQ * 512 + h * 128;
    const float* fC = (const float*)(p.ws + (dir ? WS_GBC : WS_GFC)) + (size_t)b * CTXL * 512 + h * 128;
    const bf16* qL = (const bf16*)(p.ws + WS_Q) + (size_t)b * SEQ * 512 + h * 128;
    const bf16* vL = (const bf16*)(p.ws + WS_V) + (size_t)b * SEQ * 512 + h * 128 + vh * 64;
    const bf16* vC = (const bf16*)(p.ws + WS_VC) + (size_t)b * CTXL * 512 + h * 128 + vh * 64;
    bf16* oL = (bf16*)(p.ws + (dir ? WS_OB : WS_OF)) + (size_t)b * SEQ * 512 + h * 128 + vh * 64;
    f32x4 Sa[4];
#pragma unroll
    for (int i = 0; i < 4; ++i) Sa[i] = (f32x4){0.f, 0.f, 0.f, 0.f};
    f32x4 fR[4]; u32x4 qR[2], vR;
#define HG_LOAD(cc_) do { const int _cc = (cc_); const bool _lat = _cc >= 4; const int _c = _lat ? _cc - 4 : _cc, _n = _lat ? SEQ : CTXL; \
        const float* _f = _lat ? fL : fC; const bf16* _v = _lat ? vL : vC; \
        _Pragma("unroll") for (int i = 0; i < 4; ++i) { const int _j = tid + 512 * i, _s = _c * 64 + (_j >> 5), _pos = dir ? (_n - 1 - _s) : _s; fR[i] = *(const f32x4*)(_f + (size_t)_pos * 512 + (_j & 31) * 4); } \
        if (_lat) { _Pragma("unroll") for (int i = 0; i < 2; ++i) { const int _j = tid + 512 * i, _s = _c * 64 + (_j >> 4), _pos = dir ? (_n - 1 - _s) : _s; qR[i] = *(const u32x4*)(qL + (size_t)_pos * 512 + (_j & 15) * 8); } } \
        { const int _s = _c * 64 + lane, _pos = dir ? (_n - 1 - _s) : _s; vR = *(const u32x4*)(_v + (size_t)_pos * 512 + w * 8); } } while (0)
#define HG_STAGE(lat_) do { \
        _Pragma("unroll") for (int i = 0; i < 4; ++i) { const int _j = tid + 512 * i; *(f32x4*)(Fr + (_j >> 5) * 132 + (_j & 31) * 4) = fR[i]; } \
        if (lat_) { _Pragma("unroll") for (int i = 0; i < 2; ++i) { const int _j = tid + 512 * i; *(u32x4*)(Qs + (_j >> 4) * 136 + (_j & 15) * 8) = qR[i]; } } } while (0)
    HG_LOAD(0);
    HG_STAGE(false);
    __syncthreads();
    for (int cc = 0; cc < 36; ++cc) {
        const bool lat = cc >= 4; const int c = lat ? cc - 4 : cc;
        bf16* Scur = St + (cc & 1) * (64 * 136); bf16* Snxt = St + ((cc & 1) ^ 1) * (64 * 136);
        {
            f32x2 fown[8];
#pragma unroll
            for (int i = 0; i < 8; ++i) fown[i] = *(const f32x2*)(Fr + (8 * w + i) * 132 + 2 * lane);
            *(f32x2*)(Bt + w * 128 + 2 * lane) = ((fown[0] * fown[1]) * (fown[2] * fown[3])) * ((fown[4] * fown[5]) * (fown[6] * fown[7]));
            __syncthreads();
            f32x2 cum = (f32x2){1.f, 1.f};
            { f32x2 t[7];
#pragma unroll
              for (int i = 0; i < 7; ++i) t[i] = *(const f32x2*)(Bt + i * 128 + 2 * lane);
#pragma unroll
              for (int i = 0; i < 7; ++i) if (i < w) cum = cum * t[i]; }
            unsigned kp0[4], kp1[4];
#pragma unroll
            for (int i = 0; i < 8; i += 2) { float k0v[2], k1v[2];
#pragma unroll
                for (int u = 0; u < 2; ++u) { const int r = 8 * w + i + u; const f32x2 f = fown[i + u]; cum = cum * f;
                    const float cm0 = fmaxf(cum[0], 1e-30f), cm1 = fmaxf(cum[1], 1e-30f);
                    const float kt0 = (1.f - f[0]) * __builtin_amdgcn_rcpf(cm0), kt1 = (1.f - f[1]) * __builtin_amdgcn_rcpf(cm1);
                    if (lat) { const unsigned qr = *(const unsigned*)(Qs + r * 136 + 2 * lane);
                        *(unsigned*)(Qs + r * 136 + 2 * lane) = hwpk2(bflo(qr) * cm0, bfhi(qr) * cm1); *(unsigned*)(Ks + r * 136 + 2 * lane) = hwpk2(kt0, kt1); }
                    k0v[u] = kt0; k1v[u] = kt1; }
                kp0[i >> 1] = hwpk2(k0v[0], k0v[1]); kp1[i >> 1] = hwpk2(k1v[0], k1v[1]); }
            u32x4 q0; q0.x = kp0[0]; q0.y = kp0[1]; q0.z = kp0[2]; q0.w = kp0[3]; u32x4 q1; q1.x = kp1[0]; q1.y = kp1[1]; q1.z = kp1[2]; q1.w = kp1[3];
            *(u32x4*)(Kh + (2 * lane) * 72 + 8 * w) = q0; *(u32x4*)(Kh + (2 * lane + 1) * 72 + 8 * w) = q1;
            if (w == 7) *(f32x2*)(Et + 2 * lane) = cum;
            Vt[(8 * w + 0) * 72 + lane] = (bf16)(vR.x & 0xffffu); Vt[(8 * w + 1) * 72 + lane] = (bf16)(vR.x >> 16); Vt[(8 * w + 2) * 72 + lane] = (bf16)(vR.y & 0xffffu); Vt[(8 * w + 3) * 72 + lane] = (bf16)(vR.y >> 16);
            Vt[(8 * w + 4) * 72 + lane] = (bf16)(vR.z & 0xffffu); Vt[(8 * w + 5) * 72 + lane] = (bf16)(vR.z >> 16); Vt[(8 * w + 6) * 72 + lane] = (bf16)(vR.w & 0xffffu); Vt[(8 * w + 7) * 72 + lane] = (bf16)(vR.w >> 16);
        }
        if (cc + 1 < 36) HG_LOAD(cc + 1);
        __syncthreads();
        const int ti = w >> 1, x2 = 2 * (w & 1);
        pg8::bf16x8 bqf[4];
        if (lat) {
#pragma unroll
            for (int kk = 0; kk < 4; ++kk) bqf[kk] = *(const pg8::bf16x8*)(Qs + (ti * 16 + fr) * 136 + kk * 32 + fq * 8);
#pragma unroll
            for (int u2 = 0; u2 < 2; ++u2) { const int si = x2 + u2; f32x4 acc = (f32x4){0.f, 0.f, 0.f, 0.f};
                if (si <= ti) {
#pragma unroll
                    for (int kk = 0; kk < 4; ++kk) { const pg8::bf16x8 a = *(const pg8::bf16x8*)(Ks + (si * 16 + fr) * 136 + kk * 32 + fq * 8);
                        acc = __builtin_amdgcn_mfma_f32_16x16x32_bf16(a, bqf[kk], acc, 0, 0, 0); }
                    const bool diag = (si == ti);
#pragma unroll
                    for (int r = 0; r < 4; ++r) acc[r] = (diag && (4 * fq + r > fr)) ? 0.f : acc[r]; }
                u32x2 pw; pw.x = hwpk2(acc[0], acc[1]); pw.y = hwpk2(acc[2], acc[3]);
                *(u32x2*)(Ps + (ti * 16 + fr) * 72 + si * 16 + 4 * fq) = pw; }
        }
        pg8::bf16x8 kv0[2], kv1[2];
#pragma unroll
        for (int kk = 0; kk < 2; ++kk) { kv0[kk] = (pg8::bf16x8){0, 0, 0, 0, 0, 0, 0, 0}; kv1[kk] = kv0[kk]; }
        {
            const f32x4 et = *(const f32x4*)(Et + w * 16 + 4 * fq);
            pg8::bf16x8 ka[2];
#pragma unroll
            for (int kk = 0; kk < 2; ++kk) ka[kk] = *(const pg8::bf16x8*)(Kh + (w * 16 + fr) * 72 + kk * 32 + fq * 8);
#pragma unroll
            for (int vi = 0; vi < 4; ++vi) {
#pragma unroll
                for (int kk = 0; kk < 2; ++kk) { const pg8::bf16x8 bv = *(const pg8::bf16x8*)(Vt + (vi * 16 + fr) * 72 + kk * 32 + fq * 8);
                    if (vi == x2) kv0[kk] = bv;
                    if (vi == x2 + 1) kv1[kk] = bv;
                    Sa[vi] = __builtin_amdgcn_mfma_f32_16x16x32_bf16(ka[kk], bv, Sa[vi], 0, 0, 0); }
                Sa[vi] = Sa[vi] * et;
                u32x2 sw; sw.x = hwpk2(Sa[vi][0], Sa[vi][1]); sw.y = hwpk2(Sa[vi][2], Sa[vi][3]);
                *(u32x2*)(Snxt + (vi * 16 + fr) * 136 + w * 16 + 4 * fq) = sw; }
        }
        f32x4 Oa[2];
        Oa[0] = (f32x4){0.f, 0.f, 0.f, 0.f}; Oa[1] = (f32x4){0.f, 0.f, 0.f, 0.f};
        if (lat) {
#pragma unroll
            for (int kk = 0; kk < 4; ++kk) {
#pragma unroll
                for (int u2 = 0; u2 < 2; ++u2) { const pg8::bf16x8 a = *(const pg8::bf16x8*)(Scur + ((x2 + u2) * 16 + fr) * 136 + kk * 32 + fq * 8);
                    Oa[u2] = __builtin_amdgcn_mfma_f32_16x16x32_bf16(a, bqf[kk], Oa[u2], 0, 0, 0); } }
        }
        __syncthreads();
        if (lat) {
#pragma unroll
            for (int kk = 0; kk < 2; ++kk) { const pg8::bf16x8 bp = *(const pg8::bf16x8*)(Ps + (ti * 16 + fr) * 72 + kk * 32 + fq * 8);
#pragma unroll
                for (int u2 = 0; u2 < 2; ++u2) { const pg8::bf16x8 a = u2 ? kv1[kk] : kv0[kk];
                    Oa[u2] = __builtin_amdgcn_mfma_f32_16x16x32_bf16(a, bp, Oa[u2], 0, 0, 0); } }
            const int sg = c * 64 + ti * 16 + fr, pos = dir ? (SEQ - 1 - sg) : sg;
#pragma unroll
            for (int u2 = 0; u2 < 2; ++u2) { u32x2 ow; ow.x = hwpk2(Oa[u2][0], Oa[u2][1]); ow.y = hwpk2(Oa[u2][2], Oa[u2][3]);
                *(u32x2*)(oL + (size_t)pos * 512 + (x2 + u2) * 16 + 4 * fq) = ow; }
        }
        if (cc + 1 < 36) HG_STAGE(cc + 1 >= 4);
        __syncthreads();
    }
#undef HG_LOAD
#undef HG_STAGE
}

__device__ __forceinline__ void phase_yh(const Params& p, int lane, int gw, int NGW) {
    const bf16* of = (const bf16*)(p.ws + WS_OF); const bf16* ob = (const bf16*)(p.ws + WS_OB); const bf16* og = (const bf16*)(p.ws + WS_OG);
    bf16* yh = (bf16*)(p.ws + WS_YH); const float* on = p.in[9];
    const f32x4 n0 = *(const f32x4*)(on + lane * 8), n1 = *(const f32x4*)(on + lane * 8 + 4);
    const int per = (MTOK + NGW - 1) / NGW, r0 = gw * per, nr = min(per, MTOK - r0);
    if (nr <= 0) return;
    u32x4 a = *(const u32x4*)(of + (size_t)r0 * 512 + lane * 8), b = *(const u32x4*)(ob + (size_t)r0 * 512 + lane * 8), gg = *(const u32x4*)(og + (size_t)r0 * 512 + lane * 8);
#pragma unroll 1
    for (int i = 0; i < nr; ++i) { const size_t o = (size_t)(r0 + i) * 512 + lane * 8;
        u32x4 a1 = a, b1 = b, g1 = gg;
        if (i + 1 < nr) { a1 = *(const u32x4*)(of + o + 512); b1 = *(const u32x4*)(ob + o + 512); g1 = *(const u32x4*)(og + o + 512); }
        float v[8]; v[0] = bflo(a.x) + bflo(b.x); v[1] = bfhi(a.x) + bfhi(b.x); v[2] = bflo(a.y) + bflo(b.y); v[3] = bfhi(a.y) + bfhi(b.y);
        v[4] = bflo(a.z) + bflo(b.z); v[5] = bfhi(a.z) + bfhi(b.z); v[6] = bflo(a.w) + bflo(b.w); v[7] = bfhi(a.w) + bfhi(b.w);
        float s = 0.f;
#pragma unroll
        for (int k = 0; k < 8; ++k) s += v[k] * v[k];
        s += __shfl_xor(s, 1); s += __shfl_xor(s, 2); s += __shfl_xor(s, 4); s += __shfl_xor(s, 8);
        const float rinv = rsqrtf(s * (1.f / 128.f) + EPSN);
        float gv[8]; gv[0] = bflo(gg.x); gv[1] = bfhi(gg.x); gv[2] = bflo(gg.y); gv[3] = bfhi(gg.y); gv[4] = bflo(gg.z); gv[5] = bfhi(gg.z); gv[6] = bflo(gg.w); gv[7] = bfhi(gg.w);
        f32x4 q0, q1;
#pragma unroll
        for (int k = 0; k < 4; ++k) { q0[k] = v[k] * rinv * n0[k] * gv[k]; q1[k] = v[4 + k] * rinv * n1[k] * gv[4 + k]; }
        *(u32x4*)(yh + o) = pack8(q0, q1);
        a = a1; b = b1; gg = g1; }
}

struct ConvRaw { u32x2 a[3], g[3]; };
__device__ __forceinline__ void conv_issue(const bf16* z, int tokbase, int r, int cc, int ch, ConvRaw& q) {
#pragma unroll
    for (int i = 0; i < 3; ++i) { const int rr = r + i - 1;
        if (rr >= 0 && rr < 32 && cc >= 0 && cc < 64) { const size_t zo = (size_t)(tokbase + rr * 64 + cc) * DFF2 + ch;
            q.a[i] = *(const u32x2*)(z + zo); q.g[i] = *(const u32x2*)(z + zo + DFF);
        } else { q.a[i] = (u32x2){0u, 0u}; q.g[i] = (u32x2){0u, 0u}; } }
}
__device__ __forceinline__ void phase_conv(const Params& p, int hf, int tid, int G) {
    const bf16* z = (const bf16*)(p.ws + WS_Z); bf16* a2 = (bf16*)(p.ws + WS_A2) + (size_t)hf * 8192 * DFF;
    const float* cw = p.in[15]; const float* cb = p.in[16];
    for (int it = blockIdx.x * NTHR + tid; it < 4 * 32 * 4 * 704; it += G * NTHR) {
        const int cg4 = it % 704, rest = it / 704, strip = rest & 3, r = (rest >> 2) & 31, img = rest >> 7, ch = cg4 * 4, c0 = strip * 16, tokbase = img * 2048;
        ConvRaw ring[3];
#pragma unroll
        for (int j = 0; j < 3; ++j) conv_issue(z, tokbase, r, c0 - 1 + j, ch, ring[j]);
        f32x2 w1[9][2], w2[9][2];
#pragma unroll
        for (int t = 0; t < 9; ++t) { const f32x4 a = *(const f32x4*)(cw + (size_t)t * DFF2 + ch), g = *(const f32x4*)(cw + (size_t)t * DFF2 + DFF + ch);
            w1[t][0] = (f32x2){a[0], a[1]}; w1[t][1] = (f32x2){a[2], a[3]}; w2[t][0] = (f32x2){g[0], g[1]}; w2[t][1] = (f32x2){g[2], g[3]}; }
        const f32x4 b1 = *(const f32x4*)(cb + ch), b2 = *(const f32x4*)(cb + DFF + ch);
        f32x2 W1[3][3][2], W2[3][3][2];
#pragma unroll
        for (int j = 0; j < 18; ++j) {
            const int sl = j % 3;
#pragma unroll
            for (int i = 0; i < 3; ++i) { const u32x2 a = ring[j % 3].a[i], g = ring[j % 3].g[i];
                W1[sl][i][0] = (f32x2){bflo(a.x), bfhi(a.x)}; W1[sl][i][1] = (f32x2){bflo(a.y), bfhi(a.y)};
                W2[sl][i][0] = (f32x2){bflo(g.x), bfhi(g.x)}; W2[sl][i][1] = (f32x2){bflo(g.y), bfhi(g.y)}; }
            if (j + 3 < 18) conv_issue(z, tokbase, r, c0 - 1 + j + 3, ch, ring[j % 3]);
            if (j >= 2) {
                const int sL = (j - 2) % 3, sC = (j - 1) % 3, sR = j % 3;
                f32x2 o1[2], o2[2];
                o1[0] = (f32x2){b1[0], b1[1]}; o1[1] = (f32x2){b1[2], b1[3]}; o2[0] = (f32x2){b2[0], b2[1]}; o2[1] = (f32x2){b2[2], b2[3]};
#pragma unroll
                for (int i = 0; i < 3; ++i)
#pragma unroll
                    for (int e = 0; e < 2; ++e) {
                        o1[e] = __builtin_elementwise_fma(W1[sL][i][e], w1[i * 3 + 0][e], o1[e]); o1[e] = __builtin_elementwise_fma(W1[sC][i][e], w1[i * 3 + 1][e], o1[e]); o1[e] = __builtin_elementwise_fma(W1[sR][i][e], w1[i * 3 + 2][e], o1[e]);
                        o2[e] = __builtin_elementwise_fma(W2[sL][i][e], w2[i * 3 + 0][e], o2[e]); o2[e] = __builtin_elementwise_fma(W2[sC][i][e], w2[i * 3 + 1][e], o2[e]); o2[e] = __builtin_elementwise_fma(W2[sR][i][e], w2[i * 3 + 2][e], o2[e]); }
                u32x2 ow; ow.x = pk2(siluf_(o1[0][0]) * o2[0][0], siluf_(o1[0][1]) * o2[0][1]); ow.y = pk2(siluf_(o1[1][0]) * o2[1][0], siluf_(o1[1][1]) * o2[1][1]);
                *(u32x2*)(a2 + (size_t)(tokbase + r * 64 + c0 + j - 2) * DFF + ch) = ow;
            }
        }
    }
}

__device__ __forceinline__ void phase_conv_lds(const Params& p, int hf, unsigned char* lds, int G) {
    int t_ = threadIdx.x; asm volatile("" : "+v"(t_));
    const int tid = t_;
    bf16* ring = (bf16*)lds;
    const bf16* z = (const bf16*)(p.ws + WS_Z); bf16* a2 = (bf16*)(p.ws + WS_A2) + (size_t)hf * 8192 * DFF;
    const float* cw = p.in[15]; const float* cb = p.in[16];
    const int ch4 = (tid & 15) * 4, c0 = (tid >> 4) * 2;
    __syncthreads();
    for (int i = tid; i < 4 * 2 * 80; i += NTHR) { const int slot = i / 160, rem = i % 160, side = rem / 80, wd = rem % 80;
        ((unsigned*)(ring + ((size_t)(slot * 66 + side * 65)) * 160))[wd] = 0u; }
    for (int seq = blockIdx.x; seq < 704; seq += G) {
        const int cbk = seq % 44, rest = seq / 44, rseg = rest & 3, img = rest >> 2, r0 = rseg * 8, tokbase = img * 2048, chb = cbk * 64;
        f32x2 w1[9][2], w2[9][2];
#pragma unroll
        for (int t = 0; t < 9; ++t) { const f32x4 a = *(const f32x4*)(cw + (size_t)t * DFF2 + chb + ch4), g = *(const f32x4*)(cw + (size_t)t * DFF2 + DFF + chb + ch4);
            w1[t][0] = (f32x2){a[0], a[1]}; w1[t][1] = (f32x2){a[2], a[3]}; w2[t][0] = (f32x2){g[0], g[1]}; w2[t][1] = (f32x2){g[2], g[3]}; }
        const f32x4 b1 = *(const f32x4*)(cb + chb + ch4), b2 = *(const f32x4*)(cb + DFF + chb + ch4);
        u32x4 stA[2], stB[2];
#define CV_LOAD(ST, row_) do { const int _r = (row_); _Pragma("unroll") for (int k_ = 0; k_ < 2; ++k_) { const int _q = tid + 512 * k_, _col = _q >> 4, _path = (_q >> 3) & 1, _c8 = (_q & 7) * 8; \
            ST[k_] = (_r >= 0 && _r < 32) ? *(const u32x4*)(z + (size_t)(tokbase + _r * 64 + _col) * DFF2 + _path * DFF + chb + _c8) : (u32x4){0u, 0u, 0u, 0u}; } } while (0)
#define CV_STORE(ST, slot_) do { const int _sl = (slot_); _Pragma("unroll") for (int k_ = 0; k_ < 2; ++k_) { const int _q = tid + 512 * k_, _col = _q >> 4, _path = (_q >> 3) & 1, _c8 = (_q & 7) * 8; \
            *(u32x4*)(ring + ((size_t)(_sl * 66 + _col + 1)) * 160 + _path * 64 + _c8) = ST[k_]; } } while (0)
#define CV_COMPUTE(i_) do { const int _i = (i_); \
            f32x2 o1[2][2], o2[2][2]; \
            _Pragma("unroll") for (int oc = 0; oc < 2; ++oc) { o1[oc][0] = (f32x2){b1[0], b1[1]}; o1[oc][1] = (f32x2){b1[2], b1[3]}; o2[oc][0] = (f32x2){b2[0], b2[1]}; o2[oc][1] = (f32x2){b2[2], b2[3]}; } \
            _Pragma("unroll") for (int rr = 0; rr < 3; ++rr) { const int slot = (_i + rr) & 3; \
                const bf16* base = ring + ((size_t)(slot * 66 + c0)) * 160 + ch4; \
                _Pragma("unroll") for (int cc = 0; cc < 4; ++cc) { const u32x2 a = *(const u32x2*)(base + cc * 160), g = *(const u32x2*)(base + cc * 160 + 64); \
                    const f32x2 a0 = (f32x2){bflo(a.x), bfhi(a.x)}, a1 = (f32x2){bflo(a.y), bfhi(a.y)}, g0 = (f32x2){bflo(g.x), bfhi(g.x)}, g1 = (f32x2){bflo(g.y), bfhi(g.y)}; \
                    _Pragma("unroll") for (int oc = 0; oc < 2; ++oc) { const int dj = cc - oc; \
                        if (dj >= 0 && dj < 3) { const int t = rr * 3 + dj; \
                            o1[oc][0] = __builtin_elementwise_fma(a0, w1[t][0], o1[oc][0]); o1[oc][1] = __builtin_elementwise_fma(a1, w1[t][1], o1[oc][1]); \
                            o2[oc][0] = __builtin_elementwise_fma(g0, w2[t][0], o2[oc][0]); o2[oc][1] = __builtin_elementwise_fma(g1, w2[t][1], o2[oc][1]); } } } } \
            _Pragma("unroll") for (int oc = 0; oc < 2; ++oc) { u32x2 ow; ow.x = pk2(siluf_(o1[oc][0][0]) * o2[oc][0][0], siluf_(o1[oc][0][1]) * o2[oc][0][1]); ow.y = pk2(siluf_(o1[oc][1][0]) * o2[oc][1][0], siluf_(o1[oc][1][1]) * o2[oc][1][1]); \
                *(u32x2*)(a2 + (size_t)(tokbase + (r0 + _i) * 64 + c0 + oc) * DFF + chb + ch4) = ow; } } while (0)
        __syncthreads();
        CV_LOAD(stA, r0 - 1); CV_STORE(stA, 0); CV_LOAD(stA, r0); CV_STORE(stA, 1); CV_LOAD(stA, r0 + 1); CV_STORE(stA, 2);
        CV_LOAD(stA, r0 + 2);
        __syncthreads();
#pragma unroll 1
        for (int i = 0; i < 8; i += 2) {
            CV_LOAD(stB, r0 + i + 3);
            CV_COMPUTE(i);
            CV_STORE(stA, (i + 3) & 3);
            __syncthreads();
            if (i + 2 < 8) CV_LOAD(stA, r0 + i + 4);
            CV_COMPUTE(i + 1);
            if (i + 1 < 7) CV_STORE(stB, (i + 4) & 3);
            __syncthreads();
        }
#undef CV_COMPUTE
#undef CV_LOAD
#undef CV_STORE
    }
}

__global__ void __launch_bounds__(NTHR, 2) fwd_mega(Params p) {
    extern __shared__ __attribute__((aligned(16))) unsigned char lds[];
    cg::grid_group grid = cg::this_grid();
    const int tid = threadIdx.x, lane = tid & 63, wave = __builtin_amdgcn_readfirstlane(tid >> 6);
    const int G = gridDim.x, gw = blockIdx.x * NWAVES + wave, NGW = G * NWAVES;
    PG8_LAS unsigned char* ldsl = (PG8_LAS unsigned char*)lds;
    unsigned char* ws = p.ws;
    const float* mx = (const float*)(ws + WS_MX);
    volatile LAS unsigned* misc = (volatile LAS unsigned*)((LAS unsigned char*)lds + MISC_OFF);
    if (tid < 16) misc[tid] = 0u;
    __syncthreads();
    const XcdBarrier xbar = xcd_barrier_post((unsigned*)(ws + WS_BAR), misc + 8);
    const unsigned long long t0_ = (PROBE_K >= 0) ? __builtin_amdgcn_s_memrealtime() : 0ull;
#define PROBE_POINT(k) do { if (PROBE_K == (k) && tid == 0) { const unsigned long long _n = __builtin_amdgcn_s_memrealtime(), _d = _n - t0_; while (__builtin_amdgcn_s_memrealtime() - _n < _d) __builtin_amdgcn_s_sleep(8); } } while (0)

    for (int rep_ = 0; rep_ < REPS(0); ++rep_) {
    phase0(p, lds, tid, lane, wave, G, 0);
    phase0(p, lds, tid, lane, wave, G, 1);
    xcd_barrier(xbar);
    if (G == 0x7fffffff) grid.sync();
    }
    for (int xs_ = 0; xs_ < EXTRA_SYNCS; ++xs_) xcd_barrier(xbar);
    PROBE_POINT(0);
    for (int rep_ = 0; rep_ < REPS(1); ++rep_) {
    if (blockIdx.x < 16 && G >= 16) {
        pg8::Gemm g{(const bf16*)(ws + WS_TCH), (const bf16*)(ws + WS_WFS), 512, 512, 512};
        pg8::StaticOrder S; S.init(4, 4, 16, blockIdx.x, 512, 512);
        pg8::Epi8<FUp> E{FUp{(bf16*)(ws + WS_WPQ), 1024}};
        pg8::gemm_phase<pg8::Epi8<FUp>, pg8::StaticOrder, true, true>(ldsl, g, S, E);
    }
    { const int skip = (G >= 32) ? 16 * NWAVES : 0, nw = NGW - skip, per = (MTOK + MCTX + nw - 1) / nw, r0 = (gw - skip) * per, nr = (gw < skip) ? 0 : min(per, MTOK + MCTX - r0);
      if (nr > 0) norm_rows<true>(p.in[0], p.in[2], MTOK, p.in[6], mx, 0, 1, (bf16*)(ws + WS_HX), nullptr, r0, nr, lane); }
    xcd_barrier(xbar);
    }
    PROBE_POINT(1);
    for (int rep_ = 0; rep_ < REPS(2); ++rep_) {
    {
        pg8::Gemm g{(const bf16*)(ws + WS_HX), (const bf16*)(ws + WS_WIN) + (size_t)512 * 1024, 1024, 1024, 1024};
        pg8::InOrder S; S.G = G; S.c = blockIdx.x; S.a_tile = (size_t)256 * 1024 * 2; S.b_tile = (size_t)256 * 1024 * 2;
        pg8::Epi8<FIn> E{FIn{ws, p.out}};
        pg8::gemm_phase<pg8::Epi8<FIn>, pg8::InOrder, true, true>(ldsl, g, S, E);
    }
    {
        pg8::Gemm g{(const bf16*)(ws + WS_WPQ), (const bf16*)(ws + WS_HX), 1024, 1024, 1024};
        pg8::StaticOrder S; S.init(4, 64, G, blockIdx.x, 1024, 1024);
        pg8::Epi8<FPQ> E{FPQ{(bf16*)(ws + WS_PQT)}};
        pg8::gemm_phase<pg8::Epi8<FPQ>, pg8::StaticOrder, true, true>(ldsl, g, S, E);
    }
    xcd_barrier(xbar);
    }
    PROBE_POINT(2);
    for (int rep_ = 0; rep_ < REPS(3); ++rep_) {
    if (blockIdx.x < 128 && G >= 192) {
        pg8::Gemm g{(const bf16*)(ws + WS_CS), (const bf16*)(ws + WS_PQT), 2048, 2048, 32768};
        pg8::DftOrder S; S.G = 128; S.c = blockIdx.x; S.a_tile = (size_t)256 * 2048 * 2; S.b_tile = (size_t)256 * 32768 * 2;
        EpiDft E{(bf16*)(ws + WS_YF), (unsigned*)(ws + WS_BAR + 16384)};
        pg8::gemm_phase<EpiDft, pg8::DftOrder, true, true>(ldsl, g, S, E);
        { int t2 = threadIdx.x; asm volatile("" : "+v"(t2));
          const int lane = t2 & 63, wave = __builtin_amdgcn_readfirstlane(t2 >> 6), gw = blockIdx.x * NWAVES + wave;
          LAS float* scr = (LAS float*)((LAS unsigned char*)lds + wave * 16384);
          constexpr int I_UP = 16 * 176, I_DN = 44 * 32;
          for (int it = gw; it < I_UP + I_DN; it += 128 * NWAVES) {
              if (it < I_UP) transpose_item(p.in[14], 1024, DFF2, (bf16*)(ws + WS_WUP), scr, it, lane);
              else transpose_item(p.in[17], DFF, 1024, (bf16*)(ws + WS_WDN), scr, it - I_UP, lane); }
          constexpr int I_A = 8 * 32, I_B = 8 * 32, I_O = 16 * 32;
          for (int it = gw; it < I_A + I_B + I_O; it += 128 * NWAVES) {
              if (it < I_A) transpose_item(p.in[10], 512, 1024, (bf16*)(ws + WS_WA), scr, it, lane);
              else if (it < I_A + I_B) transpose_item(p.in[11], 512, 1024, (bf16*)(ws + WS_WB), scr, it - I_A, lane);
              else transpose_item(p.in[12], 1024, 1024, (bf16*)(ws + WS_WOUT), scr, it - I_A - I_B, lane); } }
    } else if (G >= 192) {
        for (int it = blockIdx.x - 128; it < 128; it += G - 128) hgrn_mfma_item(p, lds, it);
    } else {
        pg8::Gemm g{(const bf16*)(ws + WS_CS), (const bf16*)(ws + WS_PQT), 2048, 2048, 32768};
        pg8::DftOrder S; S.G = G; S.c = blockIdx.x; S.a_tile = (size_t)256 * 2048 * 2; S.b_tile = (size_t)256 * 32768 * 2;
        EpiDft E{(bf16*)(ws + WS_YF), (unsigned*)(ws + WS_BAR + 16384)};
        pg8::gemm_phase<EpiDft, pg8::DftOrder, true, true>(ldsl, g, S, E);
        for (int it = blockIdx.x; it < 128; it += G) hgrn_mfma_item(p, lds, it);
    }
    xcd_barrier(xbar);
    }
    PROBE_POINT(3);
    for (int rep_ = 0; rep_ < REPS(4); ++rep_) {
    phase_yh(p, lane, gw, NGW);
    { LAS float* scr = (LAS float*)((LAS unsigned char*)lds + wave * 16384);
      constexpr int I_UP = 16 * 176, I_DN = 44 * 32;
      for (int it = (G >= 192) ? I_UP + I_DN : gw; it < I_UP + I_DN; it += NGW) {
          if (it < I_UP) transpose_item(p.in[14], 1024, DFF2, (bf16*)(ws + WS_WUP), scr, it, lane);
          else transpose_item(p.in[17], DFF, 1024, (bf16*)(ws + WS_WDN), scr, it - I_UP, lane); } }
    xcd_barrier(xbar);
    }
    PROBE_POINT(4);
    for (int rep_ = 0; rep_ < REPS(5); ++rep_) {
    if (G == 256) {
        pg8::f32x4 accm[2][2][4][2];
        {
            pg8::Gemm g{(const bf16*)(ws + WS_YF), (const bf16*)(ws + WS_WA), 512, 512, 512};
            pg8::StaticOrder S; S.init(64, 4, G, blockIdx.x, 512, 512);
            pg8::Epi8<FYab> E{FYab{(const bf16*)(ws + WS_GA), (const bf16*)(ws + WS_GBG)}};
            pg8::gemm_phase<pg8::Epi8<FYab>, pg8::StaticOrder, true, true, 1>(ldsl, g, S, E, &accm[0]);
        }
        {
            pg8::Gemm g{(const bf16*)(ws + WS_YH), (const bf16*)(ws + WS_WB), 512, 512, 512};
            pg8::StaticOrder S; S.init(64, 4, G, blockIdx.x, 512, 512);
            pg8::Epi8<FYb> E{FYb{(const bf16*)(ws + WS_GBG), (bf16*)(ws + WS_MRG)}};
            pg8::gemm_phase<pg8::Epi8<FYb>, pg8::StaticOrder, true, true, 2>(ldsl, g, S, E, &accm[0]);
        }
    } else {
    {
        pg8::Gemm g{(const bf16*)(ws + WS_YF), (const bf16*)(ws + WS_WA), 512, 512, 512};
        pg8::StaticOrder S; S.init(64, 4, G, blockIdx.x, 512, 512);
        pg8::Epi8<FYaT> E{FYaT{(const bf16*)(ws + WS_GA), (bf16*)(ws + WS_TMP)}};
        pg8::gemm_phase<pg8::Epi8<FYaT>, pg8::StaticOrder, true, true>(ldsl, g, S, E);
    }
    {
        pg8::Gemm g{(const bf16*)(ws + WS_YH), (const bf16*)(ws + WS_WB), 512, 512, 512};
        pg8::StaticOrder S; S.init(64, 4, G, blockIdx.x, 512, 512);
        pg8::Epi8<FYbT> E{FYbT{(const bf16*)(ws + WS_GBG), (const bf16*)(ws + WS_TMP), (bf16*)(ws + WS_MRG)}};
        pg8::gemm_phase<pg8::Epi8<FYbT>, pg8::StaticOrder, true, true>(ldsl, g, S, E);
    }
    }
    xcd_barrier(xbar);
    }
    PROBE_POINT(5);
    for (int rep_ = 0; rep_ < REPS(6); ++rep_) {
    {
        pg8::Gemm g{(const bf16*)(ws + WS_MRG), (const bf16*)(ws + WS_WOUT), 1024, 1024, 1024};
        pg8::StaticOrder S; S.init(64, 4, G, blockIdx.x, 1024, 1024);
        pg8::Epi8<FRes> E{FRes{p.in[0], p.out, mx, 2}};
        pg8::gemm_phase<pg8::Epi8<FRes>, pg8::StaticOrder, true, true>(ldsl, g, S, E);
    }
    xcd_barrier(xbar);
    }
    PROBE_POINT(6);
    for (int rep_ = 0; rep_ < REPS(7); ++rep_) {
    { const int per = (MTOK + NGW - 1) / NGW, r0 = gw * per, nr = min(per, MTOK - r0);
      if (nr > 0) norm_rows<true>(p.out, p.out, MTOK, p.in[13], mx, 3, 4, (bf16*)(ws + WS_H2), nullptr, r0, nr, lane); }
    xcd_barrier(xbar);
    }
    PROBE_POINT(7);
    {
    for (int hf = 0; hf < 2; ++hf) {
        for (int rep_ = 0; rep_ < REPS(8); ++rep_) {
            pg8::Gemm g{(const bf16*)(ws + WS_H2) + (size_t)hf * 8192 * 1024, (const bf16*)(ws + WS_WUP), 1024, 1024, 1024};
            pg8::StaticOrder S; S.init(32, 22, G, blockIdx.x, 1024, 1024);
            pg8::Epi8<FUp> E{FUp{(bf16*)(ws + WS_Z), DFF2}};
            pg8::gemm_phase<pg8::Epi8<FUp>, pg8::StaticOrder, true, true>(ldsl, g, S, E);
        xcd_barrier(xbar);
        }
        for (int rep_ = 0; rep_ < REPS(9); ++rep_) {
        phase_conv_lds(p, hf, lds, G);
        xcd_barrier(xbar);
        }
    }
    }
    PROBE_POINT(8);
    if (G == 256) {
        pg8::Gemm g{(const bf16*)(ws + WS_A2), (const bf16*)(ws + WS_WDN), DFF, DFF, DFF};
        pg8::StaticOrder S; S.init(64, 4, G, blockIdx.x, DFF, DFF);
        EpiFinal E{p.out, mx, p.in[18], (float*)(ws + WS_SLOT), (unsigned*)(ws + WS_BAR + 20480)};
        pg8::gemm_phase<EpiFinal, pg8::StaticOrder, true, true>(ldsl, g, S, E);
    } else {
    {
        pg8::Gemm g{(const bf16*)(ws + WS_A2), (const bf16*)(ws + WS_WDN), DFF, DFF, DFF};
        pg8::StaticOrder S; S.init(64, 4, G, blockIdx.x, DFF, DFF);
        pg8::Epi8<FRes> E{FRes{p.out, (float*)(ws + WS_XO), mx, 5}};
        pg8::gemm_phase<pg8::Epi8<FRes>, pg8::StaticOrder, true, true>(ldsl, g, S, E);
    }
    xcd_barrier(xbar);
    { const int per = (MTOK + NGW - 1) / NGW, r0 = gw * per, nr = min(per, MTOK - r0);
      if (nr > 0) norm_rows<false>((const float*)(ws + WS_XO), (const float*)(ws + WS_XO), MTOK, p.in[18], nullptr, 0, 0, nullptr, p.out, r0, nr, lane); }
    }
}

extern "C" void kernel_launch(void* const* d_in, const int* in_sizes, int n_in, void* d_out, int out_size, void* d_ws, size_t ws_size, hipStream_t stream) {
    static int grid = 0;
    if (grid == 0) {
        if (n_in != 19 || out_size != MTOK * DM || ws_size < WS_END) { fprintf(stderr, "kernel_launch: unexpected problem: n_in %d out %d ws %zu\n", n_in, out_size, ws_size); grid = -1; return; }
        int dev = 0, cus = 0, per_cu = 0;
        hipGetDevice(&dev);
        hipDeviceGetAttribute(&cus, hipDeviceAttributeMultiprocessorCount, dev);
        if (hipFuncSetAttribute((const void*)fwd_mega, hipFuncAttributeMaxDynamicSharedMemorySize, LDS_BYTES) != hipSuccess) { fprintf(stderr, "kernel_launch: hipFuncSetAttribute failed\n"); grid = -1; return; }
        if (hipOccupancyMaxActiveBlocksPerMultiprocessor(&per_cu, (const void*)fwd_mega, NTHR, LDS_BYTES) != hipSuccess || per_cu < 1) { fprintf(stderr, "kernel_launch: occupancy query says %d\n", per_cu); per_cu = 1; }
        (void)hipGetLastError();
        grid = cus * (per_cu > 1 ? 1 : per_cu);
        fprintf(stderr, "kernel_launch: grid %d (cus %d, per_cu %d), ws %zu\n", grid, cus, per_cu, ws_size);
    }
    if (grid < 0) return;
    Params p{};
    for (int i = 0; i < 19; ++i) p.in[i] = (const float*)d_in[i];
    p.out = (float*)d_out; p.ws = (unsigned char*)d_ws;
    if (hipMemsetAsync((char*)d_ws + WS_BAR, 0, BAR_BYTES, stream) != hipSuccess) { fprintf(stderr, "kernel_launch: memset failed\n"); return; }
    void* args[] = {&p};
    hipError_t e = hipLaunchCooperativeKernel((const void*)fwd_mega, dim3(grid), dim3(NTHR), args, LDS_BYTES, stream);
    if (e != hipSuccess) fprintf(stderr, "kernel_launch: cooperative launch failed: %s (grid %d)\n", hipGetErrorString(e), grid);
}
```

```cpp
#include <hip/hip_runtime.h>
#include <hip/hip_cooperative_groups.h>
#include <cstdio>
#include <cstdint>
namespace cg = cooperative_groups;

namespace pg8 {
#define PG8_LAS __attribute__((address_space(3)))
typedef unsigned short bf16_t;
typedef short bf16x8 __attribute__((ext_vector_type(8)));
typedef float f32x4 __attribute__((ext_vector_type(4)));
typedef unsigned u32x4 __attribute__((ext_vector_type(4)));
typedef unsigned u32x2 __attribute__((ext_vector_type(2)));
constexpr int BM = 256, BK = 64, HALF = 128, HTB = HALF * BK * 2  , STAGE_BYTES = 8 * HTB, NXCD = 8, WGM = 8;

__host__ __device__ __forceinline__ int lds_byte(int r, int c) { const int st = (r >> 4) * 2 + (c >> 5), rr = r & 15, cc = c & 31, ob = rr * 64 + cc * 2; return st * 1024 + (ob ^ (((ob >> 9) & 1) << 5)); }
__host__ __device__ __forceinline__ void stage_rc(int b, int& R, int& C) { const int st = b / 1024, sb = b % 1024, swz = sb ^ (((sb >> 9) & 1) << 5); R = (st >> 1) * 16 + swz / 64; C = (st & 1) * 32 + (swz % 64) / 2; }
__host__ __device__ __forceinline__ int perm32(int rho) { const int n = rho >> 4, i = rho & 15; return 8 * (i >> 2) + 4 * n + (i & 3); }

struct Unit { int pm, pn, z; };
struct Gemm { const bf16_t* A; const bf16_t* Bt; int K, lda, ldb; };

__device__ __forceinline__ void tile_of(int wgid, int nM, int nN, int& pm, int& pn) {
    const int nwg = nM * nN;
    { const int q = nwg / NXCD, r = nwg % NXCD, xcd = wgid % NXCD, off = wgid / NXCD; wgid = (xcd < r ? xcd * (q + 1) : r * (q + 1) + (xcd - r) * q) + off; }
    const int nig = WGM * nN, gid = wgid / nig, fm = gid * WGM, gsz = (nM - fm) < WGM ? (nM - fm) : WGM;
    pm = fm + ((wgid % nig) % gsz); pn = (wgid % nig) / gsz;
}
struct StaticOrder {
    int nM, nN, nwg, G, c; size_t a_tile, b_tile;
    __device__ __forceinline__ void init(int nM_, int nN_, int G_, int c_, int lda, int ldb) { nM = nM_; nN = nN_; nwg = nM * nN; G = G_; c = c_; a_tile = (size_t)BM * lda * 2; b_tile = (size_t)BM * ldb * 2; }
    __device__ __forceinline__ bool next(int i, Unit& u) const {
        const long L = (long)i * G + c; if (L >= nwg) return false;
        tile_of((int)L, nM, nN, u.pm, u.pn); u.z = 0; return true;
    }
    __device__ __forceinline__ size_t a_off(const Unit& u) const { return (size_t)u.pm * a_tile; }
    __device__ __forceinline__ size_t b_off(const Unit& u) const { return (size_t)u.pn * b_tile; }
};
struct OneOrder {
    int L, nM, nN; size_t a_tile, b_tile;
    __device__ __forceinline__ bool next(int i, Unit& u) const { if (i > 0) return false; tile_of(L, nM, nN, u.pm, u.pn); u.z = 0; return true; }
    __device__ __forceinline__ size_t a_off(const Unit& u) const { return (size_t)u.pm * a_tile; }
    __device__ __forceinline__ size_t b_off(const Unit& u) const { return (size_t)u.pn * b_tile; }
};
struct InOrder {
    int G, c; size_t a_tile, b_tile;
    __device__ __forceinline__ bool next(int i, Unit& u) const {
        const long L = (long)i * G + c; if (L >= 1152 + 48) return false;
        if (L < 1152) { tile_of((int)L, 64, 18, u.pm, u.pn); } else { const int j = (int)L - 1152; u.pm = 64 + (j & 7); u.pn = 2 + (j >> 3); }
        u.z = 0; return true;
    }
    __device__ __forceinline__ size_t a_off(const Unit& u) const { return (size_t)u.pm * a_tile; }
    __device__ __forceinline__ size_t b_off(const Unit& u) const { return (size_t)u.pn * b_tile; }
};
struct DftOrder {
    int G, c; size_t a_tile, b_tile;
    __device__ __forceinline__ bool next(int i, Unit& u) const {
        const long L = (long)i * G + c; if (L >= 128) return false;
        const int eo = (L < 64) ? 1 : 0, q = (int)L & 63;
        u.pn = q & 1; u.pm = (q >> 1) & 3; u.z = (q >> 3) | (eo << 8); return true;
    }
    __device__ __forceinline__ size_t a_off(const Unit& u) const { return (size_t)((u.z >> 8) * 4 + u.pm) * a_tile; }
    __device__ __forceinline__ size_t b_off(const Unit& u) const { return (size_t)u.pn * b_tile + ((size_t)(u.z & 255) * 4096 + (size_t)(u.z >> 8) * 2048) * 2; }
};

__device__ __forceinline__ unsigned cvt_pk_bf16(float lo, float hi) { unsigned r; asm volatile("v_cvt_pk_bf16_f32 %0, %1, %2" : "=v"(r) : "v"(lo), "v"(hi)); return r; }

template <class F> struct Epi8 {
    static constexpr bool PERM = true;
    F f;
    __device__ __forceinline__ void inplace(f32x4 (&acc)[2][2][4][2], const Unit& u, int wr, int wc, int fr, int fq) const {
        const int row0 = u.pm * BM + wr * 64 + fr, col0 = u.pn * BM + wc * 32 + 8 * fq;
#pragma unroll
        for (int ai = 0; ai < 2; ++ai)
#pragma unroll
            for (int m = 0; m < 4; ++m) {
#pragma unroll
                for (int bj = 0; bj < 2; ++bj) f.scale(u, row0 + ai * HALF + m * 16, col0 + bj * HALF, acc[ai][bj][m][0], acc[ai][bj][m][1]);
                asm volatile("" ::: "memory");
            }
    }
    __device__ __forceinline__ void operator()(const f32x4 (&acc)[2][2][4][2], const Unit& u, int wr, int wc, int fr, int fq) const {
        const int row0 = u.pm * BM + wr * 64 + fr, col0 = u.pn * BM + wc * 32 + 8 * fq;
#pragma unroll
        for (int ai = 0; ai < 2; ++ai)
#pragma unroll
            for (int m = 0; m < 4; ++m) {
#pragma unroll
                for (int bj = 0; bj < 2; ++bj) f(u, row0 + ai * HALF + m * 16, col0 + bj * HALF, acc[ai][bj][m][0], acc[ai][bj][m][1]);
                asm volatile("" ::: "memory");
            }
    }
};

template <class E, class = void> struct after_drain { static constexpr bool value = false; };
template <class E> struct after_drain<E, decltype((void)E::AFTER_DRAIN)> { static constexpr bool value = E::AFTER_DRAIN; };
template <class Epi, class Sched, bool ALIGN_EPI = false, bool SP2 = false, int EXTACC = 0>
__device__ __forceinline__ void gemm_phase(PG8_LAS unsigned char* lds, const Gemm g, const Sched& S, const Epi& E, f32x4 (*accx)[2][4][2] = nullptr) {
    int tid_ = threadIdx.x; asm volatile("" : "+v"(tid_));
    const int tid = tid_, wid = __builtin_amdgcn_readfirstlane(tid >> 6), lane = tid & 63, wr = wid >> 2, wc = wid & 3, fr = lane & 15, fq = lane >> 4;
    const int K = g.K, nt = K / BK;
    unsigned voffA[2], voffB[2];
#pragma unroll
    for (int i = 0; i < 2; ++i) { int R, C; stage_rc(tid * 16 + i * 8192, R, C); const int Rb = Epi::PERM ? ((R & ~31) + perm32(R & 31)) : R;
        voffA[i] = (unsigned)(R * g.lda + C) * 2u; voffB[i] = (unsigned)(Rb * g.ldb + C) * 2u; }
    const size_t kstep = (size_t)(BK * 2);
    const size_t hstepA = (size_t)HALF * g.lda * 2, hstepB = (size_t)HALF * g.ldb * 2;
    const unsigned ldsw = (unsigned)wid * 1024u;
    const int aoff = lds_byte(wr * 64 + fr, fq * 8), boff = lds_byte(wc * 32 + fr, fq * 8);
#define PG8_SA(b, h) (((b) * 2 + (h)) * HTB)
#define PG8_SB(b, h) ((4 + (b) * 2 + (h)) * HTB)
#define PG8_STAGE(bufoff, gbase, voff) do { _Pragma("unroll") for (int _i = 0; _i < 2; ++_i) \
        __builtin_amdgcn_global_load_lds((const unsigned*)((const char*)(gbase) + (voff)[_i]), (PG8_LAS unsigned*)(lds + (bufoff) + ldsw + _i * 8192), 16, 0, 0); } while (0)
#define PG8_LDA(dst, b, h) do { _Pragma("unroll") for (int m = 0; m < 4; ++m) _Pragma("unroll") for (int k = 0; k < 2; ++k) dst[m][k] = *(const PG8_LAS bf16x8*)(lds + PG8_SA(b, h) + aoff + m * 2048 + k * 1024); } while (0)
#define PG8_LDB(dst, b, h) do { _Pragma("unroll") for (int n = 0; n < 2; ++n) _Pragma("unroll") for (int k = 0; k < 2; ++k) dst[n][k] = *(const PG8_LAS bf16x8*)(lds + PG8_SB(b, h) + boff + n * 2048 + k * 1024); } while (0)
#define PG8_MMA(ai, bj, At, Bt) do { __builtin_amdgcn_s_setprio(1); _Pragma("unroll") for (int m = 0; m < 4; ++m) _Pragma("unroll") for (int n = 0; n < 2; ++n) _Pragma("unroll") for (int k = 0; k < 2; ++k) \
        acc[ai][bj][m][n] = __builtin_amdgcn_mfma_f32_16x16x32_bf16(Bt[n][k], At[m][k], acc[ai][bj][m][n], 0, 0, 0); __builtin_amdgcn_s_setprio(0); } while (0)
#define PG8_WAIT_V(n) asm volatile("s_waitcnt vmcnt(" #n ")" ::: "memory")
#define PG8_WAIT_L(n) asm volatile("s_waitcnt lgkmcnt(" #n ")" ::: "memory")
#define PG8_BAR __builtin_amdgcn_s_barrier()
#define PG8_SCHED __builtin_amdgcn_sched_barrier(0)
    Unit cur, nxt; int ui = 0;
    if (!S.next(0, cur)) return;
    f32x4 accl[2][2][4][2];
    f32x4 (&acc)[2][2][4][2] = *(EXTACC ? (f32x4 (*)[2][2][4][2])accx : &accl);
    if constexpr (EXTACC != 2) {
#pragma unroll
    for (int a = 0; a < 2; ++a)
#pragma unroll
        for (int b = 0; b < 2; ++b)
#pragma unroll
            for (int m = 0; m < 4; ++m)
#pragma unroll
                for (int n = 0; n < 2; ++n) acc[a][b][m][n] = (f32x4){0.f, 0.f, 0.f, 0.f};
    }
    bf16x8 At[4][2], B0[2][2], B1[2][2];
    const char* cA = (const char*)g.A + S.a_off(cur); const char* cB = (const char*)g.Bt + S.b_off(cur);
    if constexpr (SP2) {
        PG8_STAGE(PG8_SB(0, 0), cB, voffB); PG8_STAGE(PG8_SB(0, 1), cB + hstepB, voffB); PG8_STAGE(PG8_SA(0, 0), cA, voffA); PG8_STAGE(PG8_SA(0, 1), cA + hstepA, voffA);
        if (wr == 1) PG8_BAR;
        PG8_WAIT_V(2); PG8_BAR;
        PG8_STAGE(PG8_SB(1, 0), cB + kstep, voffB); PG8_STAGE(PG8_SA(1, 0), cA + kstep, voffA); PG8_STAGE(PG8_SB(1, 1), cB + hstepB + kstep, voffB);
        PG8_WAIT_V(6); PG8_BAR;
    } else {
        PG8_STAGE(PG8_SB(0, 0), cB, voffB); PG8_STAGE(PG8_SA(0, 0), cA, voffA); PG8_STAGE(PG8_SB(0, 1), cB + hstepB, voffB); PG8_STAGE(PG8_SA(0, 1), cA + hstepA, voffA);
        if (wr == 1) PG8_BAR;
        PG8_WAIT_V(4); PG8_BAR;
        PG8_STAGE(PG8_SB(1, 0), cB + kstep, voffB); PG8_STAGE(PG8_SA(1, 0), cA + kstep, voffA); PG8_STAGE(PG8_SB(1, 1), cB + hstepB + kstep, voffB);
        PG8_WAIT_V(6); PG8_BAR;
    }
    for (;;) {
        const bool has_next = S.next(ui + 1, nxt);
        const char* nA = has_next ? (const char*)g.A + S.a_off(nxt) : cA; const char* nB = has_next ? (const char*)g.Bt + S.b_off(nxt) : cB;
        for (int t = 0; t < nt; t += 2) {
            const bool last = (t == nt - 2);
            const char* a1 = cA + (size_t)(t + 1) * kstep;
            const char* a2 = last ? nA : cA + (size_t)(t + 2) * kstep; const char* b2 = last ? nB : cB + (size_t)(t + 2) * kstep;
            const char* a3 = a2 + kstep; const char* b3 = b2 + kstep;
            if constexpr (SP2) {
            PG8_LDB(B0, 0, 0); PG8_LDB(B1, 0, 1); PG8_SCHED; PG8_LDA(At, 0, 0); PG8_STAGE(PG8_SA(1, 1), a1 + hstepA, voffA);
            PG8_WAIT_V(8); PG8_WAIT_L(0); PG8_BAR; PG8_MMA(0, 0, At, B0); PG8_MMA(0, 1, At, B1); PG8_BAR; PG8_SCHED;
            PG8_LDA(At, 0, 1); PG8_STAGE(PG8_SB(0, 0), b2, voffB); PG8_STAGE(PG8_SB(0, 1), b2 + hstepB, voffB); PG8_STAGE(PG8_SA(0, 0), a2, voffA);
            PG8_WAIT_V(8); PG8_WAIT_L(0); PG8_BAR; PG8_MMA(1, 0, At, B0); PG8_MMA(1, 1, At, B1); PG8_BAR; PG8_SCHED;
            PG8_LDB(B0, 1, 0); PG8_LDB(B1, 1, 1); PG8_SCHED; PG8_LDA(At, 1, 0); PG8_STAGE(PG8_SA(0, 1), a2 + hstepA, voffA);
            PG8_WAIT_V(8); PG8_WAIT_L(0); PG8_BAR; PG8_MMA(0, 0, At, B0); PG8_MMA(0, 1, At, B1); PG8_BAR; PG8_SCHED;
            PG8_LDA(At, 1, 1); PG8_STAGE(PG8_SB(1, 0), b3, voffB); PG8_STAGE(PG8_SB(1, 1), b3 + hstepB, voffB); PG8_STAGE(PG8_SA(1, 0), a3, voffA);
            PG8_WAIT_V(8); PG8_WAIT_L(0); PG8_BAR; PG8_MMA(1, 0, At, B0); PG8_MMA(1, 1, At, B1); PG8_BAR; PG8_SCHED;
            } else {
            PG8_LDB(B0, 0, 0); PG8_SCHED; PG8_LDA(At, 0, 0); PG8_STAGE(PG8_SA(1, 1), a1 + hstepA, voffA);
            PG8_WAIT_L(8); PG8_BAR; PG8_WAIT_L(0); PG8_MMA(0, 0, At, B0); PG8_BAR; PG8_SCHED;
            PG8_LDB(B1, 0, 1); PG8_STAGE(PG8_SB(0, 0), b2, voffB);
            PG8_BAR; PG8_WAIT_L(0); PG8_MMA(0, 1, At, B1); PG8_BAR;
            PG8_LDA(At, 0, 1); PG8_STAGE(PG8_SA(0, 0), a2, voffA);
            PG8_BAR; PG8_WAIT_L(0); PG8_MMA(1, 0, At, B0); PG8_BAR; PG8_SCHED;
            PG8_STAGE(PG8_SB(0, 1), b2 + hstepB, voffB);
            PG8_WAIT_V(6); PG8_BAR; PG8_MMA(1, 1, At, B1); PG8_BAR;
            PG8_LDB(B0, 1, 0); PG8_SCHED; PG8_LDA(At, 1, 0); PG8_STAGE(PG8_SA(0, 1), a2 + hstepA, voffA);
            PG8_WAIT_L(8); PG8_BAR; PG8_WAIT_L(0); PG8_MMA(0, 0, At, B0); PG8_BAR; PG8_SCHED;
            PG8_LDB(B1, 1, 1); PG8_STAGE(PG8_SB(1, 0), b3, voffB);
            PG8_BAR; PG8_WAIT_L(0); PG8_MMA(0, 1, At, B1); PG8_BAR;
            PG8_LDA(At, 1, 1); PG8_STAGE(PG8_SA(1, 0), a3, voffA);
            PG8_BAR; PG8_WAIT_L(0); PG8_MMA(1, 0, At, B0); PG8_BAR; PG8_SCHED;
            PG8_STAGE(PG8_SB(1, 1), b3 + hstepB, voffB);
            PG8_WAIT_V(6); PG8_BAR; PG8_MMA(1, 1, At, B1); PG8_BAR;
            }
        }
        if constexpr (ALIGN_EPI) { if (wr == 0) PG8_BAR; }
        if constexpr (after_drain<Epi>::value) {   }
        else if constexpr (EXTACC == 1) E.inplace(acc, cur, wr, wc, fr, fq); else E(acc, cur, wr, wc, fr, fq);
        if (!has_next || EXTACC != 0 || after_drain<Epi>::value) break;
#pragma unroll
        for (int a = 0; a < 2; ++a)
#pragma unroll
            for (int b = 0; b < 2; ++b)
#pragma unroll
                for (int m = 0; m < 4; ++m)
#pragma unroll
                    for (int n = 0; n < 2; ++n) acc[a][b][m][n] = (f32x4){0.f, 0.f, 0.f, 0.f};
        cur = nxt; cA = nA; cB = nB; ++ui;
        if constexpr (ALIGN_EPI) { if (wr == 1) PG8_BAR; }
    }
    PG8_WAIT_V(0);
    if constexpr (!ALIGN_EPI) { if (wr == 0) PG8_BAR; }
    PG8_BAR;
    if constexpr (after_drain<Epi>::value) E.fused(acc, cur, lds);
#undef PG8_SA
#undef PG8_SB
#undef PG8_STAGE
#undef PG8_LDA
#undef PG8_LDB
#undef PG8_MMA
#undef PG8_WAIT_V
#undef PG8_WAIT_L
#undef PG8_BAR
#undef PG8_SCHED
}
}

constexpr int DM = 1024, NB = 8, SEQ = 2048, MTOK = NB * SEQ, CTXL = 256, MCTX = NB * CTXL;
constexpr int HGD = 512, DFF = 2816, DFF2 = 5632, INDIM = 5120, NMOD = 6;
constexpr float EPSN = 1e-6f;
constexpr int NWAVES = 8, NTHR = 512;
constexpr int LDS_BYTES = 147456;
#ifndef DUP_MASK
#define DUP_MASK 0
#endif
#define REPS(k) ((((DUP_MASK) >> (k)) & 1) ? 2 : 1)
#ifndef PROBE_K
#define PROBE_K -1
#endif
#ifndef EXTRA_SYNCS
#define EXTRA_SYNCS 0
#endif

constexpr size_t MiB = 1u << 20;
constexpr size_t WS_MX = 0;
constexpr size_t WS_LB = 256 * 1024;
constexpr size_t WS_SLOT = 1 * MiB;
constexpr size_t WS_WFS = 2 * MiB, WS_TCH = 3 * MiB;
constexpr size_t WS_BAR = 512 * 1024, BAR_BYTES = 32768;
constexpr int MISC_OFF = 147456 - 128;
constexpr size_t WS_WIN = 6 * MiB;
constexpr size_t WS_WPQ = 16 * MiB;
constexpr size_t WS_WA = 18 * MiB, WS_WB = 19 * MiB, WS_WOUT = 20 * MiB;
constexpr size_t WS_CS = 22 * MiB;
constexpr size_t WS_WUP = 6 * MiB;
constexpr size_t WS_WDN = 250 * MiB;
constexpr size_t WS_HX = 38 * MiB;
constexpr size_t WS_OF = 38 * MiB, WS_OB = 54 * MiB;
constexpr size_t WS_TMP = 38 * MiB;
constexpr size_t WS_H2 = 38 * MiB;
constexpr size_t WS_Q = 74 * MiB, WS_V = 90 * MiB, WS_OG = 106 * MiB, WS_GA = 122 * MiB, WS_GBG = 154 * MiB, WS_PQT = 186 * MiB;
constexpr size_t WS_GFC = 218 * MiB, WS_GBC = 222 * MiB, WS_VC = 226 * MiB;
constexpr size_t WS_YF = 228 * MiB;
constexpr size_t WS_YH = 74 * MiB;
constexpr size_t WS_MRG = 186 * MiB;
constexpr size_t WS_Z = 74 * MiB;
constexpr size_t WS_A2 = 162 * MiB;
constexpr size_t WS_XO = 38 * MiB;
constexpr size_t WS_END = 256 * MiB;

typedef unsigned short bf16;
typedef float f32x4 __attribute__((ext_vector_type(4)));
typedef unsigned u32x4 __attribute__((ext_vector_type(4)));
typedef unsigned u32x2 __attribute__((ext_vector_type(2)));
typedef float f32x2 __attribute__((ext_vector_type(2)));
#define LAS __attribute__((address_space(3)))

struct Params {
    const float* in[19];
    float* out;
    unsigned char* ws;
};

__device__ __forceinline__ float bf2f(unsigned short b) { return __uint_as_float(((unsigned)b) << 16); }
__device__ __forceinline__ float bflo(unsigned w) { return __uint_as_float(w << 16); }
__device__ __forceinline__ float bfhi(unsigned w) { return __uint_as_float(w & 0xffff0000u); }
__device__ __forceinline__ unsigned f2bf(float f) { unsigned u = __float_as_uint(f); return (u + 0x7fffu + ((u >> 16) & 1u)) >> 16; }
__device__ __forceinline__ unsigned pk2(float lo, float hi);
typedef __bf16 bf16x2_t __attribute__((ext_vector_type(2)));
__device__ __forceinline__ unsigned hwpk2(float lo, float hi) { const f32x2 v = {lo, hi}; const bf16x2_t r = __builtin_convertvector(v, bf16x2_t); return __builtin_bit_cast(unsigned, r); }
__device__ __forceinline__ unsigned pk2(float lo, float hi) { return hwpk2(lo, hi); }
__device__ __forceinline__ float sigmoidf_(float x) { return __builtin_amdgcn_rcpf(1.f + __expf(-x)); }
__device__ __forceinline__ float siluf_(float x) { return x * __builtin_amdgcn_rcpf(1.f + __expf(-x)); }
__device__ __forceinline__ float wave_sum(float v) {
#pragma unroll
    for (int o = 1; o < 64; o <<= 1) v += __shfl_xor(v, o);
    return v;
}
__device__ __forceinline__ u32x4 pack8(const f32x4 a, const f32x4 b) { u32x4 w; w.x = pk2(a[0], a[1]); w.y = pk2(a[2], a[3]); w.z = pk2(b[0], b[1]); w.w = pk2(b[2], b[3]); return w; }

typedef __attribute__((address_space(1))) unsigned gu32;
#define XB_TMO      128
#define XB_XCNT(j)  (256  + 64 * (j))
#define XB_XSUB(j)  (1280 + 64 * (j))
#define XB_XGEN(j)  (2304 + 64 * (j))
#define XB_TOP      3328
#define XB_TOPGEN   3392
#define XCD_BAR_WORDS 3456
#define XB_SPIN_CAP (1u << 18)

__device__ __forceinline__ unsigned xb_ld(unsigned* p)              { return __hip_atomic_load(p, __ATOMIC_RELAXED, __HIP_MEMORY_SCOPE_AGENT); }
__device__ __forceinline__ unsigned xb_add(unsigned* p, unsigned v) { return __hip_atomic_fetch_add(p, v, __ATOMIC_RELAXED, __HIP_MEMORY_SCOPE_AGENT); }
__device__ __forceinline__ unsigned xb_xcc_id() { return (unsigned)__builtin_amdgcn_s_getreg((3 << 11) | 20) & 0xFu; }
#define XB_SPIN(cond, bar) do { unsigned _sp = 0; while (cond) { __builtin_amdgcn_s_sleep(1); \
    if ((++_sp & 255u) == 0u) { if (xb_ld(&(bar)[XB_TMO])) break; if (_sp > XB_SPIN_CAP) { atomicAdd(&(bar)[XB_TMO], 1u); break; } } } } while (0)

struct XcdBarrier {
    unsigned* bar; unsigned x;
    volatile LAS unsigned* st;
};

__device__ __forceinline__ XcdBarrier xcd_barrier_post(unsigned* bar, volatile LAS unsigned* st) {
    XcdBarrier b; b.bar = bar; b.x = xb_xcc_id(); b.st = st;
    if (threadIdx.x == 0) (void)xb_add(&bar[XB_XCNT(b.x)], 1u);
    return b;
}
__device__ __forceinline__ void xcd_barrier_complete(unsigned* bar, unsigned x, unsigned& nloc, unsigned& nx) {
    const unsigned G = gridDim.x * gridDim.y * gridDim.z;
    unsigned sum, cnt, mine, sp = 0u;
    for (;;) {
        sum = 0u; cnt = 0u; mine = 0u;
#pragma unroll
        for (unsigned j = 0; j < 16; ++j) { const unsigned c = xb_ld(&bar[XB_XCNT(j)]); sum += c; cnt += (c > 0u) ? 1u : 0u; mine = (j == x) ? c : mine; }
        if (sum == G) break;
        __builtin_amdgcn_s_sleep(1);
        if ((++sp & 255u) == 0u) { if (xb_ld(&bar[XB_TMO])) break; if (sp > XB_SPIN_CAP) { atomicAdd(&bar[XB_TMO], 1u); break; } }
    }
    nloc = mine > 0u ? mine : 1u; nx = cnt > 0u ? cnt : 1u;
}

__device__ __forceinline__ void xcd_barrier(const XcdBarrier& b) {
    asm volatile("s_waitcnt vmcnt(0)" ::: "memory");
    __syncthreads();
    if (threadIdx.x == 0) {
        unsigned* bar = b.bar;
        __builtin_amdgcn_s_waitcnt(0);
        unsigned nloc = b.st[0], nx = b.st[1];
        if (nloc == 0u) { xcd_barrier_complete(bar, b.x, nloc, nx); b.st[0] = nloc; b.st[1] = nx; }
        const unsigned old = xb_add(&bar[XB_XSUB(b.x)], 1u);
        const unsigned gen = old / nloc;
        if (old + 1u == (gen + 1u) * nloc) {
            __builtin_amdgcn_fence(__ATOMIC_RELEASE, "agent");
            asm volatile("s_waitcnt vmcnt(0)" ::: "memory");
            const unsigned og = xb_add(&bar[XB_TOP], 1u);
            const unsigned tg = og / nx;
            if (og + 1u == (tg + 1u) * nx) xb_add(&bar[XB_TOPGEN], 1u);
            else XB_SPIN(xb_ld(&bar[XB_TOPGEN]) == tg, bar);
            __builtin_amdgcn_fence(__ATOMIC_ACQUIRE, "agent");
            xb_add(&bar[XB_XGEN(b.x)], 1u);
            asm volatile("s_waitcnt vmcnt(0)" ::: "memory");
        } else {
            XB_SPIN(xb_ld(&bar[XB_XGEN(b.x)]) == gen, bar);
            __builtin_amdgcn_fence(__ATOMIC_ACQUIRE, "agent");
            asm volatile("s_waitcnt vmcnt(0)" ::: "memory");
        }
    }
    __syncthreads();
}


struct FIn {
    unsigned char* ws; float* out;
    __device__ __forceinline__ void operator()(const pg8::Unit& u, int row, int col, f32x4 v0, f32x4 v1) const {
        const int seg = u.pn >> 1, c = col & 511;
        if (seg == 0 || seg == 4) { f32x4 a, b;
#pragma unroll
            for (int i = 0; i < 4; ++i) { a[i] = siluf_(v0[i]); b[i] = siluf_(v1[i]); }
            bf16* dst = (bf16*)(ws + (seg == 0 ? WS_Q : WS_OG));
            *(u32x4*)(dst + (size_t)row * 512 + c) = pack8(a, b);
        } else if (seg == 1 || seg == 2) {
            const float* lb = (const float*)(ws + WS_LB);
            const f32x4 l0 = *(const f32x4*)(lb + c), l1 = *(const f32x4*)(lb + c + 4); f32x4 a, b;
#pragma unroll
            for (int i = 0; i < 4; ++i) { a[i] = l0[i] + (1.f - l0[i]) * sigmoidf_(v0[i]); b[i] = l1[i] + (1.f - l1[i]) * sigmoidf_(v1[i]); }
            float* dst;
            if (u.pm < 64) dst = out + (seg == 1 ? (size_t)0 : (size_t)MTOK * 512) + (size_t)row * 512 + c;
            else dst = (float*)(ws + (seg == 1 ? WS_GFC : WS_GBC)) + (size_t)(row - MTOK) * 512 + c;
            *(f32x4*)dst = a; *(f32x4*)(dst + 4) = b;
        } else if (seg == 3) {
            bf16* dst;
            if (u.pm < 64) dst = (bf16*)(ws + WS_V) + (size_t)row * 512 + c; else dst = (bf16*)(ws + WS_VC) + (size_t)(row - MTOK) * 512 + c;
            *(u32x4*)dst = pack8(v0, v1);
        } else { f32x4 a, b;
#pragma unroll
            for (int i = 0; i < 4; ++i) { a[i] = sigmoidf_(v0[i]); b[i] = sigmoidf_(v1[i]); }
            bf16* dst = (seg < 7) ? ((bf16*)(ws + WS_GA) + (size_t)row * 1024 + (col - 5 * 512)) : ((bf16*)(ws + WS_GBG) + (size_t)row * 1024 + (col - 7 * 512));
            *(u32x4*)dst = pack8(a, b);
        }
    }
};
struct FPQ {
    bf16* pqt;
    __device__ __forceinline__ void operator()(const pg8::Unit&, int row, int col, f32x4 v0, f32x4 v1) const {
        bf16* dst = pqt + (size_t)(row & 511) * 32768 + (size_t)(col >> 11) * 4096 + (size_t)(row >> 9) * 1024 + ((col & 2047) >> 1);
        u32x2 ev, od; ev.x = pk2(v0[0], v0[2]); ev.y = pk2(v1[0], v1[2]); od.x = pk2(v0[1], v0[3]); od.y = pk2(v1[1], v1[3]);
        *(u32x2*)dst = ev; *(u32x2*)(dst + 2048) = od;
    }
};
struct EpiDft {
    static constexpr bool PERM = true;
    bf16* yf; unsigned* flags;
    __device__ __forceinline__ void operator()(const f32x4 (&acc)[2][2][4][2], const pg8::Unit& u, int wr, int wc, int fr, int fq) const {
        const int z = u.z & 255, eo = u.z >> 8, pair = (z * 4 + u.pm) * 2 + u.pn;
        const int row0 = u.pm * 256 + wr * 64 + fr, col0 = u.pn * 256 + wc * 32 + 8 * fq;
        unsigned* flag = flags + pair * 16;
        if (eo) {
#pragma unroll
            for (int ai = 0; ai < 2; ++ai)
#pragma unroll
                for (int m = 0; m < 4; ++m)
#pragma unroll
                    for (int bj = 0; bj < 2; ++bj) { const int row = row0 + ai * 128 + m * 16, col = col0 + bj * 128;
                        *(u32x4*)(yf + ((size_t)z * SEQ + 1024 + row) * 512 + col) = pack8(acc[ai][bj][m][0] * (1.f / 512.f), acc[ai][bj][m][1] * (1.f / 512.f)); }
            asm volatile("s_waitcnt vmcnt(0)" ::: "memory");
            __syncthreads();
            if (threadIdx.x == 0) { __builtin_amdgcn_fence(__ATOMIC_RELEASE, "agent"); asm volatile("s_waitcnt vmcnt(0)" ::: "memory");
                __hip_atomic_store(flag, 1u, __ATOMIC_RELAXED, __HIP_MEMORY_SCOPE_AGENT); }
        } else {
            if (threadIdx.x == 0) { unsigned spins = 0;
                while (__hip_atomic_load(flag, __ATOMIC_RELAXED, __HIP_MEMORY_SCOPE_AGENT) == 0u && ++spins < (1u << 22)) __builtin_amdgcn_s_sleep(2);
                __builtin_amdgcn_fence(__ATOMIC_ACQUIRE, "agent"); asm volatile("s_waitcnt vmcnt(0)" ::: "memory"); }
            __syncthreads();
#pragma unroll
            for (int ai = 0; ai < 2; ++ai)
#pragma unroll
                for (int m = 0; m < 4; ++m) {
#pragma unroll
                    for (int bj = 0; bj < 2; ++bj) { const int row = row0 + ai * 128 + m * 16, col = col0 + bj * 128;
                        bf16* plo = yf + ((size_t)z * SEQ + row) * 512 + col; bf16* phi = plo + (size_t)1024 * 512;
                        const u32x4 o = *(const u32x4*)phi;
                        const f32x4 e0 = acc[ai][bj][m][0] * (1.f / 512.f), e1 = acc[ai][bj][m][1] * (1.f / 512.f);
                        f32x4 o0, o1; o0[0] = bflo(o.x); o0[1] = bfhi(o.x); o0[2] = bflo(o.y); o0[3] = bfhi(o.y); o1[0] = bflo(o.z); o1[1] = bfhi(o.z); o1[2] = bflo(o.w); o1[3] = bfhi(o.w);
                        *(u32x4*)plo = pack8(e0 + o0, e1 + o1); *(u32x4*)phi = pack8(e0 - o0, e1 - o1); }
                    asm volatile("" ::: "memory"); }
        }
    }
};
struct FYa {
    const bf16* ga;
    __device__ __forceinline__ void scale(const pg8::Unit&, int row, int col, f32x4& v0, f32x4& v1) const {
        const size_t o = (size_t)row * 1024 + col; const u32x4 g = *(const u32x4*)(ga + o);
        v0[0] *= bflo(g.x); v0[1] *= bfhi(g.x); v0[2] *= bflo(g.y); v0[3] *= bfhi(g.y); v1[0] *= bflo(g.z); v1[1] *= bfhi(g.z); v1[2] *= bflo(g.w); v1[3] *= bfhi(g.w);
    }
    __device__ __forceinline__ void operator()(const pg8::Unit&, int, int, f32x4, f32x4) const {}
};
struct FYb {
    const bf16* gbg; bf16* mrg;
    __device__ __forceinline__ void scale(const pg8::Unit&, int row, int col, f32x4& v0, f32x4& v1) const {
        const size_t o = (size_t)row * 1024 + col; const u32x4 h = *(const u32x4*)(gbg + o);
        v0[0] *= __builtin_amdgcn_rcpf(bflo(h.x)); v0[1] *= __builtin_amdgcn_rcpf(bfhi(h.x)); v0[2] *= __builtin_amdgcn_rcpf(bflo(h.y)); v0[3] *= __builtin_amdgcn_rcpf(bfhi(h.y));
        v1[0] *= __builtin_amdgcn_rcpf(bflo(h.z)); v1[1] *= __builtin_amdgcn_rcpf(bfhi(h.z)); v1[2] *= __builtin_amdgcn_rcpf(bflo(h.w)); v1[3] *= __builtin_amdgcn_rcpf(bfhi(h.w));
    }
    __device__ __forceinline__ void operator()(const pg8::Unit&, int row, int col, f32x4 v0, f32x4 v1) const {
        const size_t o = (size_t)row * 1024 + col; const u32x4 h = *(const u32x4*)(gbg + o);
        f32x4 a, b; a[0] = v0[0] * bflo(h.x); a[1] = v0[1] * bfhi(h.x); a[2] = v0[2] * bflo(h.y); a[3] = v0[3] * bfhi(h.y);
        b[0] = v1[0] * bflo(h.z); b[1] = v1[1] * bfhi(h.z); b[2] = v1[2] * bflo(h.w); b[3] = v1[3] * bfhi(h.w);
        *(u32x4*)(mrg + o) = pack8(a, b);
    }
};
struct FYab {
    const bf16* ga; const bf16* gbg;
    __device__ __forceinline__ void scale(const pg8::Unit&, int row, int col, f32x4& v0, f32x4& v1) const {
        const size_t o = (size_t)row * 1024 + col; const u32x4 g = *(const u32x4*)(ga + o), h = *(const u32x4*)(gbg + o);
        v0[0] *= bflo(g.x) * __builtin_amdgcn_rcpf(bflo(h.x)); v0[1] *= bfhi(g.x) * __builtin_amdgcn_rcpf(bfhi(h.x)); v0[2] *= bflo(g.y) * __builtin_amdgcn_rcpf(bflo(h.y)); v0[3] *= bfhi(g.y) * __builtin_amdgcn_rcpf(bfhi(h.y));
        v1[0] *= bflo(g.z) * __builtin_amdgcn_rcpf(bflo(h.z)); v1[1] *= bfhi(g.z) * __builtin_amdgcn_rcpf(bfhi(h.z)); v1[2] *= bflo(g.w) * __builtin_amdgcn_rcpf(bflo(h.w)); v1[3] *= bfhi(g.w) * __builtin_amdgcn_rcpf(bfhi(h.w));
    }
    __device__ __forceinline__ void operator()(const pg8::Unit&, int, int, f32x4, f32x4) const {}
};
struct FYaT {
    const bf16* ga; bf16* tmp;
    __device__ __forceinline__ void operator()(const pg8::Unit&, int row, int col, f32x4 v0, f32x4 v1) const {
        const size_t o = (size_t)row * 1024 + col; const u32x4 g = *(const u32x4*)(ga + o);
        f32x4 a, b; a[0] = v0[0] * bflo(g.x); a[1] = v0[1] * bfhi(g.x); a[2] = v0[2] * bflo(g.y); a[3] = v0[3] * bfhi(g.y);
        b[0] = v1[0] * bflo(g.z); b[1] = v1[1] * bfhi(g.z); b[2] = v1[2] * bflo(g.w); b[3] = v1[3] * bfhi(g.w);
        *(u32x4*)(tmp + o) = pack8(a, b);
    }
};
struct FYbT {
    const bf16* gbg; const bf16* tmp; bf16* mrg;
    __device__ __forceinline__ void operator()(const pg8::Unit&, int row, int col, f32x4 v0, f32x4 v1) const {
        const size_t o = (size_t)row * 1024 + col; const u32x4 g = *(const u32x4*)(gbg + o); const u32x4 t = *(const u32x4*)(tmp + o);
        f32x4 a, b; a[0] = bflo(t.x) + v0[0] * bflo(g.x); a[1] = bfhi(t.x) + v0[1] * bfhi(g.x); a[2] = bflo(t.y) + v0[2] * bflo(g.y); a[3] = bfhi(t.y) + v0[3] * bfhi(g.y);
        b[0] = bflo(t.z) + v1[0] * bflo(g.z); b[1] = bfhi(t.z) + v1[1] * bfhi(g.z); b[2] = bflo(t.w) + v1[2] * bflo(g.w); b[3] = bfhi(t.w) + v1[3] * bfhi(g.w);
        *(u32x4*)(mrg + o) = pack8(a, b);
    }
};
struct FRes {
    const float* src; float* dst; const float* mx; int mod;
    __device__ __forceinline__ void operator()(const pg8::Unit&, int row, int col, f32x4 v0, f32x4 v1) const {
        const size_t o = (size_t)row * 1024 + col; const float* m = mx + (size_t)(row >> 11) * (NMOD * DM) + mod * DM + col;
        const f32x4 m0 = *(const f32x4*)m, m1 = *(const f32x4*)(m + 4), s0 = *(const f32x4*)(src + o), s1 = *(const f32x4*)(src + o + 4);
        *(f32x4*)(dst + o) = s0 + m0 * v0; *(f32x4*)(dst + o + 4) = s1 + m1 * v1;
    }
};
struct FUp {
    bf16* z; int ld;
    __device__ __forceinline__ void operator()(const pg8::Unit&, int row, int col, f32x4 v0, f32x4 v1) const {
        *(u32x4*)(z + (size_t)row * ld + col) = pack8(v0, v1);
    }
};

struct EpiFinal {
    static constexpr bool PERM = true, AFTER_DRAIN = true;
    float* xio; const float* mx; const float* fg; float* slots; unsigned* flags;
    __device__ __forceinline__ void operator()(const f32x4 (&)[2][2][4][2], const pg8::Unit&, int, int, int, int) const {}
    __device__ __forceinline__ void fused(f32x4 (&acc)[2][2][4][2], const pg8::Unit& u, PG8_LAS unsigned char* ldsl) const {
        int t2_ = threadIdx.x; asm volatile("" : "+v"(t2_));
        const int tid = t2_, wid = __builtin_amdgcn_readfirstlane(tid >> 6), lane = tid & 63, wr = wid >> 2, wc = wid & 3, fr = lane & 15, fq = lane >> 4;
        PG8_LAS float* red = (PG8_LAS float*)ldsl;
        PG8_LAS float* rin = red + 1024;
        const int row0 = u.pm * 256 + wr * 64 + fr, col0 = u.pn * 256 + wc * 32 + 8 * fq;
        float ss[2][4];
#pragma unroll
        for (int ai = 0; ai < 2; ++ai)
#pragma unroll
            for (int m = 0; m < 4; ++m) ss[ai][m] = 0.f;
#pragma unroll
        for (int bj = 0; bj < 2; ++bj) { const int col = col0 + bj * 128;
            const float* mm = mx + (size_t)(u.pm >> 3) * (NMOD * DM) + 5 * DM + col;
            const f32x4 m0 = *(const f32x4*)mm, m1 = *(const f32x4*)(mm + 4);
#pragma unroll
            for (int ai = 0; ai < 2; ++ai)
#pragma unroll
                for (int m = 0; m < 4; ++m) { const size_t o = (size_t)(row0 + ai * 128 + m * 16) * 1024 + col;
                    const f32x4 x0 = *(const f32x4*)(xio + o), x1 = *(const f32x4*)(xio + o + 4);
                    const f32x4 v0 = x0 + m0 * acc[ai][bj][m][0], v1 = x1 + m1 * acc[ai][bj][m][1];
                    acc[ai][bj][m][0] = v0; acc[ai][bj][m][1] = v1;
                    ss[ai][m] += (v0[0] * v0[0] + v0[1] * v0[1]) + (v0[2] * v0[2] + v0[3] * v0[3]) + (v1[0] * v1[0] + v1[1] * v1[1]) + (v1[2] * v1[2] + v1[3] * v1[3]);
                    asm volatile("" ::: "memory"); } }
#pragma unroll
        for (int ai = 0; ai < 2; ++ai)
#pragma unroll
            for (int m = 0; m < 4; ++m) { float s = ss[ai][m]; s += __shfl_xor(s, 16); s += __shfl_xor(s, 32); ss[ai][m] = s; }
        if (fq == 0) {
#pragma unroll
            for (int ai = 0; ai < 2; ++ai)
#pragma unroll
                for (int m = 0; m < 4; ++m) red[(ai * 128 + wr * 64 + m * 16 + fr) * 4 + wc] = ss[ai][m]; }
        __syncthreads();
        float* myslot = slots + (size_t)(u.pm * 4 + u.pn) * 256;
        if (tid < 256) myslot[tid] = (red[tid * 4 + 0] + red[tid * 4 + 1]) + (red[tid * 4 + 2] + red[tid * 4 + 3]);
        asm volatile("s_waitcnt vmcnt(0)" ::: "memory");
        __syncthreads();
        unsigned* flag = flags + u.pm * 16;
        if (tid == 0) { __builtin_amdgcn_fence(__ATOMIC_RELEASE, "agent"); asm volatile("s_waitcnt vmcnt(0)" ::: "memory");
            __hip_atomic_fetch_add(flag, 1u, __ATOMIC_RELAXED, __HIP_MEMORY_SCOPE_AGENT);
            unsigned spins = 0;
            while (__hip_atomic_load(flag, __ATOMIC_RELAXED, __HIP_MEMORY_SCOPE_AGENT) < 4u && ++spins < (1u << 22)) __builtin_amdgcn_s_sleep(2);
            __builtin_amdgcn_fence(__ATOMIC_ACQUIRE, "agent"); asm volatile("s_waitcnt vmcnt(0)" ::: "memory"); }
        __syncthreads();
        if (tid < 256) { const float* sl = slots + (size_t)(u.pm * 4) * 256 + tid;
            const float tot = (sl[0] + sl[256]) + (sl[512] + sl[768]);
            rin[tid] = rsqrtf(tot * (1.f / DM) + EPSN); }
        __syncthreads();
#pragma unroll
        for (int bj = 0; bj < 2; ++bj) { const int col = col0 + bj * 128;
            const f32x4 g0 = *(const f32x4*)(fg + col), g1 = *(const f32x4*)(fg + col + 4);
#pragma unroll
            for (int ai = 0; ai < 2; ++ai)
#pragma unroll
                for (int m = 0; m < 4; ++m) { const float r = rin[ai * 128 + wr * 64 + m * 16 + fr]; const size_t o = (size_t)(row0 + ai * 128 + m * 16) * 1024 + col;
                    *(f32x4*)(xio + o) = acc[ai][bj][m][0] * r * g0; *(f32x4*)(xio + o + 4) = acc[ai][bj][m][1] * r * g1;
                    asm volatile("" ::: "memory"); } }
    }
};

__device__ __forceinline__ void transpose_item(const float* W, int K, int N, bf16* WT, LAS float* scr, int item, int lane) {
    const int nblk = N / 32, kb = item / nblk, nb = item % nblk, k0 = 64 * kb, n0 = 32 * nb;
#pragma unroll 8
    for (int i = 0; i < 32; ++i) { const int kk = 2 * i + (lane >> 5); scr[kk * 33 + (lane & 31)] = W[(size_t)(k0 + kk) * N + n0 + (lane & 31)]; }
    asm volatile("s_waitcnt lgkmcnt(0)" ::: "memory");
    const int c = lane & 7;
#pragma unroll
    for (int j = 0; j < 4; ++j) { const int n = (lane >> 3) + 8 * j; const LAS float* s = scr + (8 * c) * 33 + n;
        u32x4 o; o.x = pk2(s[0 * 33], s[1 * 33]); o.y = pk2(s[2 * 33], s[3 * 33]); o.z = pk2(s[4 * 33], s[5 * 33]); o.w = pk2(s[6 * 33], s[7 * 33]);
        *(u32x4*)(WT + (size_t)(n0 + n) * K + k0 + 8 * c) = o; }
    asm volatile("s_waitcnt lgkmcnt(0)" ::: "memory");
}

template <bool MOD>
__device__ __forceinline__ void norm_rows(const float* srcA, const float* srcB, int nA, const float* g, const float* mx, int shift_mod, int scale_mod,
                                          bf16* outb, float* outf, int r0, int nr, int lane) {
    f32x4 G[4], SH[4], cur[4], nxt[4];
    int curmod = -1;
    { const float* s0 = (r0 < nA) ? srcA + (size_t)r0 * DM : srcB + (size_t)(r0 - nA) * DM;
#pragma unroll
      for (int j = 0; j < 4; ++j) cur[j] = *(const f32x4*)(s0 + (lane + 64 * j) * 4); }
#pragma unroll 1
    for (int i = 0; i < nr; ++i) {
        const int m = r0 + i;
        if (i + 1 < nr) { const int m1 = m + 1; const float* s1 = (m1 < nA) ? srcA + (size_t)m1 * DM : srcB + (size_t)(m1 - nA) * DM;
#pragma unroll
            for (int j = 0; j < 4; ++j) nxt[j] = *(const f32x4*)(s1 + (lane + 64 * j) * 4); }
        const int mr = MOD ? ((m < nA) ? (m >> 11) : 8) : 0;
        if (mr != curmod) { curmod = mr;
#pragma unroll
            for (int j = 0; j < 4; ++j) { const int e = (lane + 64 * j) * 4; const f32x4 gg = *(const f32x4*)(g + e);
                if (MOD) { const f32x4 sc = *(const f32x4*)(mx + (size_t)mr * (NMOD * DM) + scale_mod * DM + e); SH[j] = *(const f32x4*)(mx + (size_t)mr * (NMOD * DM) + shift_mod * DM + e); G[j] = gg * (sc + 1.f); }
                else { G[j] = gg; SH[j] = (f32x4){0.f, 0.f, 0.f, 0.f}; } } }
        float s = 0.f;
#pragma unroll
        for (int j = 0; j < 4; ++j) s += (cur[j][0] * cur[j][0] + cur[j][1] * cur[j][1]) + (cur[j][2] * cur[j][2] + cur[j][3] * cur[j][3]);
        const float rinv = rsqrtf(wave_sum(s) * (1.f / DM) + EPSN);
#pragma unroll
        for (int j = 0; j < 4; ++j) { const int e = (lane + 64 * j) * 4; const f32x4 h = cur[j] * rinv * G[j] + SH[j];
            if (MOD) { u32x2 w; w.x = pk2(h[0], h[1]); w.y = pk2(h[2], h[3]); *(u32x2*)(outb + (size_t)m * DM + e) = w; }
            else *(f32x4*)(outf + (size_t)m * DM + e) = h; }
#pragma unroll
        for (int j = 0; j < 4; ++j) cur[j] = nxt[j];
    }
}

__device__ __forceinline__ void phase0(const Params& p, unsigned char* lds, int tid, int lane, int wave, int G, const int part) {
    float* ldsf = (float*)lds;
    float* mxo = (float*)(p.ws + WS_MX);
    if (part == 0) {
    for (int it = blockIdx.x; it < 192; it += G) {
        __syncthreads();
        {
            const float* c = p.in[1]; const float* cc = p.in[3]; const float* aw = p.in[4]; const float* ab = p.in[5];
            float* sc = ldsf;
            float* red = ldsf + 9 * 1024;
            for (int i = tid; i < 9 * 1024; i += NTHR) { const int r = i >> 10, k = i & 1023; const float cv = (r < 8) ? c[r * 1024 + k] : cc[k]; sc[i] = cv / (1.f + __expf(-cv)); }
            __syncthreads();
            const int n0 = it * 32, col = tid & 31, ks = tid >> 5;
            float a[9];
#pragma unroll
            for (int r = 0; r < 9; ++r) a[r] = 0.f;
            for (int k = ks * 64; k < ks * 64 + 64; ++k) { const float w = aw[(size_t)k * (NMOD * DM) + n0 + col];
#pragma unroll
                for (int r = 0; r < 9; ++r) a[r] += sc[r * 1024 + k] * w; }
#pragma unroll
            for (int r = 0; r < 9; ++r) red[(ks * 9 + r) * 32 + col] = a[r];
            __syncthreads();
            if (tid < 288) { const int r = tid >> 5, cl = tid & 31; float s = ab[n0 + cl];
                for (int k2 = 0; k2 < 16; ++k2) s += red[(k2 * 9 + r) * 32 + cl];
                mxo[r * (NMOD * DM) + n0 + cl] = s; }
        }
    }
    __syncthreads();
    { bf16* tch = (bf16*)(p.ws + WS_TCH); bf16* wfs = (bf16*)(p.ws + WS_WFS); const float* win = p.in[7];
      for (int i = blockIdx.x * NTHR + tid; i < 1024 * 64; i += G * NTHR) { const int n = i >> 6, c8 = (i & 63) * 8, gn = (n & 511) >> 7, j = n & 127; float vv[8];
#pragma unroll
          for (int e = 0; e < 8; ++e) { const int cp = c8 + e, idx = ((cp & 127) * j) & 127; const float ang = (float)idx * (1.f / 64.f);
              vv[e] = ((cp >> 7) == gn) ? ((n < 512) ? cospif(ang) : sinpif(ang)) : 0.f; }
          u32x4 w; w.x = pk2(vv[0], vv[1]); w.y = pk2(vv[2], vv[3]); w.z = pk2(vv[4], vv[5]); w.w = pk2(vv[6], vv[7]);
          *(u32x4*)(tch + (size_t)n * 512 + c8) = w;
          const f32x4 a = *(const f32x4*)(win + (size_t)n * INDIM + c8), b2 = *(const f32x4*)(win + (size_t)n * INDIM + c8 + 4);
          *(u32x4*)(wfs + (size_t)n * 512 + c8) = pack8(a, b2); } }
    }
    if (part == 0 && blockIdx.x == G - 1) { const float* hl = p.in[8]; float* lbo = (float*)(p.ws + WS_LB);
        if (tid < 512) { const float a = hl[tid], b = hl[512 + tid]; lbo[tid] = 1.f / (1.f + expf(b - a)); } }
    if (part == 0) return;
    { bf16* cs = (bf16*)(p.ws + WS_CS);
      for (int i = blockIdx.x * NTHR + tid; i < 2 * 1024 * 256; i += G * NTHR) { const int eo = i >> 18, l = (i >> 8) & 1023, kc = (i & 255) * 8; float vv[8];
#pragma unroll
          for (int e = 0; e < 8; ++e) { const int k = kc + e, sn = k >> 10, m = k & 1023;
              const float ang = eo ? (float)((l * (2 * m + 1)) & 2047) * (1.f / 1024.f) : (float)((l * m) & 1023) * (1.f / 512.f);
              vv[e] = sn ? -sinpif(ang) : cospif(ang); }
          u32x4 w; w.x = pk2(vv[0], vv[1]); w.y = pk2(vv[2], vv[3]); w.z = pk2(vv[4], vv[5]); w.w = pk2(vv[6], vv[7]);
          *(u32x4*)(cs + ((size_t)eo * 1024 + l) * 2048 + kc) = w; } }
    { LAS float* scr = (LAS float*)((LAS unsigned char*)lds + wave * 16384);
      const int gw = blockIdx.x * NWAVES + wave, NGW = G * NWAVES;
      constexpr int I_IN = 16 * 160, I_A = 8 * 32, I_B = 8 * 32, I_O = 16 * 32;
      for (int it = gw; it < ((G >= 192) ? I_IN : I_IN + I_A + I_B + I_O); it += NGW) { int r = it;
          if (r < I_IN) { transpose_item(p.in[7], 1024, INDIM, (bf16*)(p.ws + WS_WIN), scr, r, lane); continue; } r -= I_IN;
          if (r < I_A) { transpose_item(p.in[10], 512, 1024, (bf16*)(p.ws + WS_WA), scr, r, lane); continue; } r -= I_A;
          if (r < I_B) { transpose_item(p.in[11], 512, 1024, (bf16*)(p.ws + WS_WB), scr, r, lane); continue; } r -= I_B;
          transpose_item(p.in[12], 1024, 1024, (bf16*)(p.ws + WS_WOUT), scr, r, lane); } }
}

__device__ __forceinline__ void hgrn_mfma_item(const Params& p, unsigned char* lds, int item) {
    int tid_ = threadIdx.x; asm volatile("" : "+v"(tid_));
    const int tid = tid_, lane = tid & 63, w = __builtin_amdgcn_readfirstlane(tid >> 6), fr = lane & 15, fq = lane >> 4;
    const int vh = item & 1, dir = (item >> 1) & 1, h = (item >> 2) & 3, b = item >> 4;
    bf16* Qs = (bf16*)lds;
    bf16* Ks = Qs + 64 * 136;
    bf16* St = Ks + 64 * 136;
    bf16* Kh = St + 2 * 64 * 136;
    bf16* Vt = Kh + 128 * 72;
    bf16* Ps = Vt + 64 * 72;
    float* Et = (float*)(Ps + 64 * 72);
    float* Fr = Et + 128;
    float* Bt = Fr + 64 * 132;
    const int d = 16 * w + fr;
    const float* fL = p.out + (dir ? (size_t)MTOK * 512 : 0) + (size_t)b * SEQ * 512 + h * 128;
    const float* fC = (const float*)(p.ws + (dir ? WS_GBC : WS_GFC)) + (size_t)b * CTXL * 512 + h * 128;
    const bf16* qL = (const bf16*)(p.ws + WS_Q) + (size_t)b * SEQ * 512 + h * 128;
    const bf16* vL = (const bf16*)(p.ws + WS_V) + (size_t)b * SEQ * 512 + h * 128 + vh * 64;
    const bf16* vC = (const bf16*)(p.ws + WS_VC) + (size_t)b * CTXL * 512 + h * 128 + vh * 64;
    bf16* oL = (bf16*)(p.ws + (dir ? WS_OB : WS_OF)) + (size_t)b * SEQ * 512 + h * 128 + vh * 64;
    f32x4 Sa[4];
#pragma unroll
    for (int i = 0; i < 4; ++i) Sa[i] = (f32x4){0.f, 0.f, 0.f, 0.f};
    f32x2 fR2[8]; unsigned qR1[8]; u32x4 vR;
#define HG_LOAD(cc_) do { const int _cc = (cc_); const bool _lat = _cc >= 4; const int _c = _lat ? _cc - 4 : _cc, _n = _lat ? SEQ : CTXL; \
        const float* _f = _lat ? fL : fC; const bf16* _v = _lat ? vL : vC; \
        _Pragma("unroll") for (int i = 0; i < 8; ++i) { const int _s = _c * 64 + 8 * w + i, _pos = dir ? (_n - 1 - _s) : _s; fR2[i] = *(const f32x2*)(_f + (size_t)_pos * 512 + 2 * lane); \
            qR1[i] = _lat ? *(const unsigned*)(qL + (size_t)_pos * 512 + 2 * lane) : 0u; } \
        { const int _s = _c * 64 + lane, _pos = dir ? (_n - 1 - _s) : _s; vR = *(const u32x4*)(_v + (size_t)_pos * 512 + w * 8); } } while (0)
#define HG_BT() do { *(f32x2*)(Bt + w * 128 + 2 * lane) = ((fR2[0] * fR2[1]) * (fR2[2] * fR2[3])) * ((fR2[4] * fR2[5]) * (fR2[6] * fR2[7])); } while (0)
    HG_LOAD(0);
    HG_BT();
    __syncthreads();
    for (int cc = 0; cc < 36; ++cc) {
        const bool lat = cc >= 4; const int c = lat ? cc - 4 : cc;
        bf16* Scur = St + (cc & 1) * (64 * 136); bf16* Snxt = St + ((cc & 1) ^ 1) * (64 * 136);
        {
            f32x2 cum = (f32x2){1.f, 1.f};
            { f32x2 t[7];
#pragma unroll
              for (int i = 0; i < 7; ++i) t[i] = *(const f32x2*)(Bt + i * 128 + 2 * lane);
#pragma unroll
              for (int i = 0; i < 7; ++i) if (i < w) cum = cum * t[i]; }
            unsigned kp0[4], kp1[4];
#pragma unroll
            for (int i = 0; i < 8; i += 2) { float k0v[2], k1v[2];
#pragma unroll
                for (int u = 0; u < 2; ++u) { const int r = 8 * w + i + u; const f32x2 f = fR2[i + u]; cum = cum * f;
                    const float cm0 = fmaxf(cum[0], 1e-30f), cm1 = fmaxf(cum[1], 1e-30f);
                    const float kt0 = (1.f - f[0]) * __builtin_amdgcn_rcpf(cm0), kt1 = (1.f - f[1]) * __builtin_amdgcn_rcpf(cm1);
                    if (lat) { const unsigned qr = qR1[i + u];
                        *(unsigned*)(Qs + r * 136 + 2 * lane) = hwpk2(bflo(qr) * cm0, bfhi(qr) * cm1); *(unsigned*)(Ks + r * 136 + 2 * lane) = hwpk2(kt0, kt1); }
                    k0v[u] = kt0; k1v[u] = kt1; }
                kp0[i >> 1] = hwpk2(k0v[0], k0v[1]); kp1[i >> 1] = hwpk2(k1v[0], k1v[1]); }
            u32x4 q0; q0.x = kp0[0]; q0.y = kp0[1]; q0.z = kp0[2]; q0.w = kp0[3]; u32x4 q1; q1.x = kp1[0]; q1.y = kp1[1]; q1.z = kp1[2]; q1.w = kp1[3];
            *(u32x4*)(Kh + (2 * lane) * 72 + 8 * w) = q0; *(u32x4*)(Kh + (2 * lane + 1) * 72 + 8 * w) = q1;
            if (w == 7) *(f32x2*)(Et + 2 * lane) = cum;
            Vt[(8 * w + 0) * 72 + lane] = (bf16)(vR.x & 0xffffu); Vt[(8 * w + 1) * 72 + lane] = (bf16)(vR.x >> 16); Vt[(8 * w + 2) * 72 + lane] = (bf16)(vR.y & 0xffffu); Vt[(8 * w + 3) * 72 + lane] = (bf16)(vR.y >> 16);
            Vt[(8 * w + 4) * 72 + lane] = (bf16)(vR.z & 0xffffu); Vt[(8 * w + 5) * 72 + lane] = (bf16)(vR.z >> 16); Vt[(8 * w + 6) * 72 + lane] = (bf16)(vR.w & 0xffffu); Vt[(8 * w + 7) * 72 + lane] = (bf16)(vR.w >> 16);
        }
        if (cc + 1 < 36) HG_LOAD(cc + 1);
        __syncthreads();
        const int ti = w >> 1, x2 = 2 * (w & 1);
        pg8::bf16x8 bqf[4];
        if (lat) {
#pragma unroll
            for (int kk = 0; kk < 4; ++kk) bqf[kk] = *(const pg8::bf16x8*)(Qs + (ti * 16 + fr) * 136 + kk * 32 + fq * 8);
#pragma unroll
            for (int u2 = 0; u2 < 2; ++u2) { const int si = x2 + u2; f32x4 acc = (f32x4){0.f, 0.f, 0.f, 0.f};
                if (si <= ti) {
#pragma unroll
                    for (int kk = 0; kk < 4; ++kk) { const pg8::bf16x8 a = *(const pg8::bf16x8*)(Ks + (si * 16 + fr) * 136 + kk * 32 + fq * 8);
                        acc = __builtin_amdgcn_mfma_f32_16x16x32_bf16(a, bqf[kk], acc, 0, 0, 0); }
                    const bool diag = (si == ti);
#pragma unroll
                    for (int r = 0; r < 4; ++r) acc[r] = (diag && (4 * fq + r > fr)) ? 0.f : acc[r]; }
                u32x2 pw; pw.x = hwpk2(acc[0], acc[1]); pw.y = hwpk2(acc[2], acc[3]);
                *(u32x2*)(Ps + (ti * 16 + fr) * 72 + si * 16 + 4 * fq) = pw; }
        }
        pg8::bf16x8 kv0[2], kv1[2];
#pragma unroll
        for (int kk = 0; kk < 2; ++kk) { kv0[kk] = (pg8::bf16x8){0, 0, 0, 0, 0, 0, 0, 0}; kv1[kk] = kv0[kk]; }
        {
            const f32x4 et = *(const f32x4*)(Et + w * 16 + 4 * fq);
            pg8::bf16x8 ka[2];
#pragma unroll
            for (int kk = 0; kk < 2; ++kk) ka[kk] = *(const pg8::bf16x8*)(Kh + (w * 16 + fr) * 72 + kk * 32 + fq * 8);
#pragma unroll
            for (int vi = 0; vi < 4; ++vi) {
#pragma unroll
                for (int kk = 0; kk < 2; ++kk) { const pg8::bf16x8 bv = *(const pg8::bf16x8*)(Vt + (vi * 16 + fr) * 72 + kk * 32 + fq * 8);
                    if (vi == x2) kv0[kk] = bv;
                    if (vi == x2 + 1) kv1[kk] = bv;
                    Sa[vi] = __builtin_amdgcn_mfma_f32_16x16x32_bf16(ka[kk], bv, Sa[vi], 0, 0, 0); }
                Sa[vi] = Sa[vi] * et;
                u32x2 sw; sw.x = hwpk2(Sa[vi][0], Sa[vi][1]); sw.y = hwpk2(Sa[vi][2], Sa[vi][3]);
                *(u32x2*)(Snxt + (vi * 16 + fr) * 136 + w * 16 + 4 * fq) = sw; }
        }
        f32x4 Oa[2];
        Oa[0] = (f32x4){0.f, 0.f, 0.f, 0.f}; Oa[1] = (f32x4){0.f, 0.f, 0.f, 0.f};
        if (lat) {
#pragma unroll
            for (int kk = 0; kk < 4; ++kk) {
#pragma unroll
                for (int u2 = 0; u2 < 2; ++u2) { const pg8::bf16x8 a = *(const pg8::bf16x8*)(Scur + ((x2 + u2) * 16 + fr) * 136 + kk * 32 + fq * 8);
                    Oa[u2] = __builtin_amdgcn_mfma_f32_16x16x32_bf16(a, bqf[kk], Oa[u2], 0, 0, 0); } }
        }
        if (cc + 1 < 36) HG_BT();
        __syncthreads();
        if (lat) {
#pragma unroll
            for (int kk = 0; kk < 2; ++kk) { const pg8::bf16x8 bp = *(const pg8::bf16x8*)(Ps + (ti * 16 + fr) * 72 + kk * 32 + fq * 8);
#pragma unroll
                for (int u2 = 0; u2 < 2; ++u2) { const pg8::bf16x8 a = u2 ? kv1[kk] : kv0[kk];
                    Oa[u2] = __builtin_amdgcn_mfma_f32_16x16x32_bf16(a, bp, Oa[u2], 0, 0, 0); } }
            const int sg = c * 64 + ti * 16 + fr, pos = dir ? (SEQ - 1 - sg) : sg;
#pragma unroll
            for (int u2 = 0; u2 < 2; ++u2) { u32x2 ow; ow.x = hwpk2(Oa[u2][0], Oa[u2][1]); ow.y = hwpk2(Oa[u2][2], Oa[u2][3]);
                *(u32x2*)(oL + (size_t)pos * 512 + (x2 + u2) * 16 + 4 * fq) = ow; }
        }
    }
    __syncthreads();
#undef HG_LOAD
#undef HG_BT
}

__device__ __forceinline__ void phase_yh(const Params& p, int lane, int gw, int NGW) {
    const bf16* of = (const bf16*)(p.ws + WS_OF); const bf16* ob = (const bf16*)(p.ws + WS_OB); const bf16* og = (const bf16*)(p.ws + WS_OG);
    bf16* yh = (bf16*)(p.ws + WS_YH); const float* on = p.in[9];
    const f32x4 n0 = *(const f32x4*)(on + lane * 8), n1 = *(const f32x4*)(on + lane * 8 + 4);
    const int per = (MTOK + NGW - 1) / NGW, r0 = gw * per, nr = min(per, MTOK - r0);
    if (nr <= 0) return;
    u32x4 a = *(const u32x4*)(of + (size_t)r0 * 512 + lane * 8), b = *(const u32x4*)(ob + (size_t)r0 * 512 + lane * 8), gg = *(const u32x4*)(og + (size_t)r0 * 512 + lane * 8);
#pragma unroll 1
    for (int i = 0; i < nr; ++i) { const size_t o = (size_t)(r0 + i) * 512 + lane * 8;
        u32x4 a1 = a, b1 = b, g1 = gg;
        if (i + 1 < nr) { a1 = *(const u32x4*)(of + o + 512); b1 = *(const u32x4*)(ob + o + 512); g1 = *(const u32x4*)(og + o + 512); }
        float v[8]; v[0] = bflo(a.x) + bflo(b.x); v[1] = bfhi(a.x) + bfhi(b.x); v[2] = bflo(a.y) + bflo(b.y); v[3] = bfhi(a.y) + bfhi(b.y);
        v[4] = bflo(a.z) + bflo(b.z); v[5] = bfhi(a.z) + bfhi(b.z); v[6] = bflo(a.w) + bflo(b.w); v[7] = bfhi(a.w) + bfhi(b.w);
        float s = 0.f;
#pragma unroll
        for (int k = 0; k < 8; ++k) s += v[k] * v[k];
        s += __shfl_xor(s, 1); s += __shfl_xor(s, 2); s += __shfl_xor(s, 4); s += __shfl_xor(s, 8);
        const float rinv = rsqrtf(s * (1.f / 128.f) + EPSN);
        float gv[8]; gv[0] = bflo(gg.x); gv[1] = bfhi(gg.x); gv[2] = bflo(gg.y); gv[3] = bfhi(gg.y); gv[4] = bflo(gg.z); gv[5] = bfhi(gg.z); gv[6] = bflo(gg.w); gv[7] = bfhi(gg.w);
        f32x4 q0, q1;
#pragma unroll
        for (int k = 0; k < 4; ++k) { q0[k] = v[k] * rinv * n0[k] * gv[k]; q1[k] = v[4 + k] * rinv * n1[k] * gv[4 + k]; }
        *(u32x4*)(yh + o) = pack8(q0, q1);
        a = a1; b = b1; gg = g1; }
}

struct ConvRaw { u32x2 a[3], g[3]; };
__device__ __forceinline__ void conv_issue(const bf16* z, int tokbase, int r, int cc, int ch, ConvRaw& q) {
#pragma unroll
    for (int i = 0; i < 3; ++i) { const int rr = r + i - 1;
        if (rr >= 0 && rr < 32 && cc >= 0 && cc < 64) { const size_t zo = (size_t)(tokbase + rr * 64 + cc) * DFF2 + ch;
            q.a[i] = *(const u32x2*)(z + zo); q.g[i] = *(const u32x2*)(z + zo + DFF);
        } else { q.a[i] = (u32x2){0u, 0u}; q.g[i] = (u32x2){0u, 0u}; } }
}
__device__ __forceinline__ void phase_conv(const Params& p, int hf, int tid, int G) {
    const bf16* z = (const bf16*)(p.ws + WS_Z); bf16* a2 = (bf16*)(p.ws + WS_A2) + (size_t)hf * 8192 * DFF;
    const float* cw = p.in[15]; const float* cb = p.in[16];
    for (int it = blockIdx.x * NTHR + tid; it < 4 * 32 * 4 * 704; it += G * NTHR) {
        const int cg4 = it % 704, rest = it / 704, strip = rest & 3, r = (rest >> 2) & 31, img = rest >> 7, ch = cg4 * 4, c0 = strip * 16, tokbase = img * 2048;
        ConvRaw ring[3];
#pragma unroll
        for (int j = 0; j < 3; ++j) conv_issue(z, tokbase, r, c0 - 1 + j, ch, ring[j]);
        f32x2 w1[9][2], w2[9][2];
#pragma unroll
        for (int t = 0; t < 9; ++t) { const f32x4 a = *(const f32x4*)(cw + (size_t)t * DFF2 + ch), g = *(const f32x4*)(cw + (size_t)t * DFF2 + DFF + ch);
            w1[t][0] = (f32x2){a[0], a[1]}; w1[t][1] = (f32x2){a[2], a[3]}; w2[t][0] = (f32x2){g[0], g[1]}; w2[t][1] = (f32x2){g[2], g[3]}; }
        const f32x4 b1 = *(const f32x4*)(cb + ch), b2 = *(const f32x4*)(cb + DFF + ch);
        f32x2 W1[3][3][2], W2[3][3][2];
#pragma unroll
        for (int j = 0; j < 18; ++j) {
            const int sl = j % 3;
#pragma unroll
            for (int i = 0; i < 3; ++i) { const u32x2 a = ring[j % 3].a[i], g = ring[j % 3].g[i];
                W1[sl][i][0] = (f32x2){bflo(a.x), bfhi(a.x)}; W1[sl][i][1] = (f32x2){bflo(a.y), bfhi(a.y)};
                W2[sl][i][0] = (f32x2){bflo(g.x), bfhi(g.x)}; W2[sl][i][1] = (f32x2){bflo(g.y), bfhi(g.y)}; }
            if (j + 3 < 18) conv_issue(z, tokbase, r, c0 - 1 + j + 3, ch, ring[j % 3]);
            if (j >= 2) {
                const int sL = (j - 2) % 3, sC = (j - 1) % 3, sR = j % 3;
                f32x2 o1[2], o2[2];
                o1[0] = (f32x2){b1[0], b1[1]}; o1[1] = (f32x2){b1[2], b1[3]}; o2[0] = (f32x2){b2[0], b2[1]}; o2[1] = (f32x2){b2[2], b2[3]};
#pragma unroll
                for (int i = 0; i < 3; ++i)
#pragma unroll
                    for (int e = 0; e < 2; ++e) {
                        o1[e] = __builtin_elementwise_fma(W1[sL][i][e], w1[i * 3 + 0][e], o1[e]); o1[e] = __builtin_elementwise_fma(W1[sC][i][e], w1[i * 3 + 1][e], o1[e]); o1[e] = __builtin_elementwise_fma(W1[sR][i][e], w1[i * 3 + 2][e], o1[e]);
                        o2[e] = __builtin_elementwise_fma(W2[sL][i][e], w2[i * 3 + 0][e], o2[e]); o2[e] = __builtin_elementwise_fma(W2[sC][i][e], w2[i * 3 + 1][e], o2[e]); o2[e] = __builtin_elementwise_fma(W2[sR][i][e], w2[i * 3 + 2][e], o2[e]); }
                u32x2 ow; ow.x = pk2(siluf_(o1[0][0]) * o2[0][0], siluf_(o1[0][1]) * o2[0][1]); ow.y = pk2(siluf_(o1[1][0]) * o2[1][0], siluf_(o1[1][1]) * o2[1][1]);
                *(u32x2*)(a2 + (size_t)(tokbase + r * 64 + c0 + j - 2) * DFF + ch) = ow;
            }
        }
    }
}

__device__ __forceinline__ void phase_conv_lds(const Params& p, int hf, unsigned char* lds, int G) {
    int t_ = threadIdx.x; asm volatile("" : "+v"(t_));
    const int tid = t_;
    bf16* ring = (bf16*)lds;
    const bf16* z = (const bf16*)(p.ws + WS_Z); bf16* a2 = (bf16*)(p.ws + WS_A2) + (size_t)hf * 8192 * DFF;
    const float* cw = p.in[15]; const float* cb = p.in[16];
    const int ch4 = (tid & 15) * 4, c0 = (tid >> 4) * 2;
    __syncthreads();
    for (int i = tid; i < 4 * 2 * 80; i += NTHR) { const int slot = i / 160, rem = i % 160, side = rem / 80, wd = rem % 80;
        ((unsigned*)(ring + ((size_t)(slot * 66 + side * 65)) * 160))[wd] = 0u; }
    for (int seq = blockIdx.x; seq < 704; seq += G) {
        const int cbk = seq % 44, rest = seq / 44, rseg = rest & 3, img = rest >> 2, r0 = rseg * 8, tokbase = img * 2048, chb = cbk * 64;
        f32x2 w1[9][2], w2[9][2];
#pragma unroll
        for (int t = 0; t < 9; ++t) { const f32x4 a = *(const f32x4*)(cw + (size_t)t * DFF2 + chb + ch4), g = *(const f32x4*)(cw + (size_t)t * DFF2 + DFF + chb + ch4);
            w1[t][0] = (f32x2){a[0], a[1]}; w1[t][1] = (f32x2){a[2], a[3]}; w2[t][0] = (f32x2){g[0], g[1]}; w2[t][1] = (f32x2){g[2], g[3]}; }
        const f32x4 b1 = *(const f32x4*)(cb + chb + ch4), b2 = *(const f32x4*)(cb + DFF + chb + ch4);
        u32x4 stA[2], stB[2];
#define CV_LOAD(ST, row_) do { const int _r = (row_); _Pragma("unroll") for (int k_ = 0; k_ < 2; ++k_) { const int _q = tid + 512 * k_, _col = _q >> 4, _path = (_q >> 3) & 1, _c8 = (_q & 7) * 8; \
            ST[k_] = (_r >= 0 && _r < 32) ? *(const u32x4*)(z + (size_t)(tokbase + _r * 64 + _col) * DFF2 + _path * DFF + chb + _c8) : (u32x4){0u, 0u, 0u, 0u}; } } while (0)
#define CV_STORE(ST, slot_) do { const int _sl = (slot_); _Pragma("unroll") for (int k_ = 0; k_ < 2; ++k_) { const int _q = tid + 512 * k_, _col = _q >> 4, _path = (_q >> 3) & 1, _c8 = (_q & 7) * 8; \
            *(u32x4*)(ring + ((size_t)(_sl * 66 + _col + 1)) * 160 + _path * 64 + _c8) = ST[k_]; } } while (0)
#define CV_COMPUTE(i_) do { const int _i = (i_); \
            f32x2 o1[2][2], o2[2][2]; \
            _Pragma("unroll") for (int oc = 0; oc < 2; ++oc) { o1[oc][0] = (f32x2){b1[0], b1[1]}; o1[oc][1] = (f32x2){b1[2], b1[3]}; o2[oc][0] = (f32x2){b2[0], b2[1]}; o2[oc][1] = (f32x2){b2[2], b2[3]}; } \
            _Pragma("unroll") for (int rr = 0; rr < 3; ++rr) { const int slot = (_i + rr) & 3; \
                const bf16* base = ring + ((size_t)(slot * 66 + c0)) * 160 + ch4; \
                _Pragma("unroll") for (int cc = 0; cc < 4; ++cc) { const u32x2 a = *(const u32x2*)(base + cc * 160), g = *(const u32x2*)(base + cc * 160 + 64); \
                    const f32x2 a0 = (f32x2){bflo(a.x), bfhi(a.x)}, a1 = (f32x2){bflo(a.y), bfhi(a.y)}, g0 = (f32x2){bflo(g.x), bfhi(g.x)}, g1 = (f32x2){bflo(g.y), bfhi(g.y)}; \
                    _Pragma("unroll") for (int oc = 0; oc < 2; ++oc) { const int dj = cc - oc; \
                        if (dj >= 0 && dj < 3) { const int t = rr * 3 + dj; \
                            o1[oc][0] = __builtin_elementwise_fma(a0, w1[t][0], o1[oc][0]); o1[oc][1] = __builtin_elementwise_fma(a1, w1[t][1], o1[oc][1]); \
                            o2[oc][0] = __builtin_elementwise_fma(g0, w2[t][0], o2[oc][0]); o2[oc][1] = __builtin_elementwise_fma(g1, w2[t][1], o2[oc][1]); } } } } \
            _Pragma("unroll") for (int oc = 0; oc < 2; ++oc) { u32x2 ow; ow.x = pk2(siluf_(o1[oc][0][0]) * o2[oc][0][0], siluf_(o1[oc][0][1]) * o2[oc][0][1]); ow.y = pk2(siluf_(o1[oc][1][0]) * o2[oc][1][0], siluf_(o1[oc][1][1]) * o2[oc][1][1]); \
                *(u32x2*)(a2 + (size_t)(tokbase + (r0 + _i) * 64 + c0 + oc) * DFF + chb + ch4) = ow; } } while (0)
        __syncthreads();
        CV_LOAD(stA, r0 - 1); CV_STORE(stA, 0); CV_LOAD(stA, r0); CV_STORE(stA, 1); CV_LOAD(stA, r0 + 1); CV_STORE(stA, 2);
        CV_LOAD(stA, r0 + 2);
        __syncthreads();
#pragma unroll 1
        for (int i = 0; i < 8; i += 2) {
            CV_LOAD(stB, r0 + i + 3);
            CV_COMPUTE(i);
            CV_STORE(stA, (i + 3) & 3);
            __syncthreads();
            if (i + 2 < 8) CV_LOAD(stA, r0 + i + 4);
            CV_COMPUTE(i + 1);
            if (i + 1 < 7) CV_STORE(stB, (i + 4) & 3);
            __syncthreads();
        }
#undef CV_COMPUTE
#undef CV_LOAD
#undef CV_STORE
    }
}

__global__ void __launch_bounds__(NTHR, 2) fwd_mega(Params p) {
    extern __shared__ __attribute__((aligned(16))) unsigned char lds[];
    cg::grid_group grid = cg::this_grid();
    const int tid = threadIdx.x, lane = tid & 63, wave = __builtin_amdgcn_readfirstlane(tid >> 6);
    const int G = gridDim.x, gw = blockIdx.x * NWAVES + wave, NGW = G * NWAVES;
    PG8_LAS unsigned char* ldsl = (PG8_LAS unsigned char*)lds;
    unsigned char* ws = p.ws;
    const float* mx = (const float*)(ws + WS_MX);
    volatile LAS unsigned* misc = (volatile LAS unsigned*)((LAS unsigned char*)lds + MISC_OFF);
    if (tid < 16) misc[tid] = 0u;
    __syncthreads();
    const XcdBarrier xbar = xcd_barrier_post((unsigned*)(ws + WS_BAR), misc + 8);
    const unsigned long long t0_ = (PROBE_K >= 0) ? __builtin_amdgcn_s_memrealtime() : 0ull;
#define PROBE_POINT(k) do { if (PROBE_K == (k) && tid == 0) { const unsigned long long _n = __builtin_amdgcn_s_memrealtime(), _d = _n - t0_; while (__builtin_amdgcn_s_memrealtime() - _n < _d) __builtin_amdgcn_s_sleep(8); } } while (0)

    for (int rep_ = 0; rep_ < REPS(0); ++rep_) {
    phase0(p, lds, tid, lane, wave, G, 0);
    phase0(p, lds, tid, lane, wave, G, 1);
    xcd_barrier(xbar);
    if (G == 0x7fffffff) grid.sync();
    }
    for (int xs_ = 0; xs_ < EXTRA_SYNCS; ++xs_) xcd_barrier(xbar);
    PROBE_POINT(0);
    for (int rep_ = 0; rep_ < REPS(1); ++rep_) {
    if (blockIdx.x < 16 && G >= 16) {
        pg8::Gemm g{(const bf16*)(ws + WS_TCH), (const bf16*)(ws + WS_WFS), 512, 512, 512};
        pg8::StaticOrder S; S.init(4, 4, 16, blockIdx.x, 512, 512);
        pg8::Epi8<FUp> E{FUp{(bf16*)(ws + WS_WPQ), 1024}};
        pg8::gemm_phase<pg8::Epi8<FUp>, pg8::StaticOrder, true, true>(ldsl, g, S, E);
    }
    { const int skip = (G >= 32) ? 16 * NWAVES : 0, nw = NGW - skip, per = (MTOK + MCTX + nw - 1) / nw, r0 = (gw - skip) * per, nr = (gw < skip) ? 0 : min(per, MTOK + MCTX - r0);
      if (nr > 0) norm_rows<true>(p.in[0], p.in[2], MTOK, p.in[6], mx, 0, 1, (bf16*)(ws + WS_HX), nullptr, r0, nr, lane); }
    xcd_barrier(xbar);
    }
    PROBE_POINT(1);
    for (int rep_ = 0; rep_ < REPS(2); ++rep_) {
    {
        pg8::Gemm g{(const bf16*)(ws + WS_HX), (const bf16*)(ws + WS_WIN) + (size_t)512 * 1024, 1024, 1024, 1024};
        pg8::InOrder S; S.G = G; S.c = blockIdx.x; S.a_tile = (size_t)256 * 1024 * 2; S.b_tile = (size_t)256 * 1024 * 2;
        pg8::Epi8<FIn> E{FIn{ws, p.out}};
        pg8::gemm_phase<pg8::Epi8<FIn>, pg8::InOrder, true, true>(ldsl, g, S, E);
    }
    {
        pg8::Gemm g{(const bf16*)(ws + WS_WPQ), (const bf16*)(ws + WS_HX), 1024, 1024, 1024};
        pg8::StaticOrder S; S.init(4, 64, G, blockIdx.x, 1024, 1024);
        pg8::Epi8<FPQ> E{FPQ{(bf16*)(ws + WS_PQT)}};
        pg8::gemm_phase<pg8::Epi8<FPQ>, pg8::StaticOrder, true, true>(ldsl, g, S, E);
    }
    xcd_barrier(xbar);
    }
    PROBE_POINT(2);
    for (int rep_ = 0; rep_ < REPS(3); ++rep_) {
    if (blockIdx.x < 128 && G >= 192) {
        pg8::Gemm g{(const bf16*)(ws + WS_CS), (const bf16*)(ws + WS_PQT), 2048, 2048, 32768};
        pg8::DftOrder S; S.G = 128; S.c = blockIdx.x; S.a_tile = (size_t)256 * 2048 * 2; S.b_tile = (size_t)256 * 32768 * 2;
        EpiDft E{(bf16*)(ws + WS_YF), (unsigned*)(ws + WS_BAR + 16384)};
        pg8::gemm_phase<EpiDft, pg8::DftOrder, true, true>(ldsl, g, S, E);
        { int t2 = threadIdx.x; asm volatile("" : "+v"(t2));
          const int lane = t2 & 63, wave = __builtin_amdgcn_readfirstlane(t2 >> 6), gw = blockIdx.x * NWAVES + wave;
          LAS float* scr = (LAS float*)((LAS unsigned char*)lds + wave * 16384);
          constexpr int I_UP = 16 * 176, I_DN = 44 * 32;
          for (int it = gw; it < I_UP + I_DN; it += 128 * NWAVES) {
              if (it < I_UP) transpose_item(p.in[14], 1024, DFF2, (bf16*)(ws + WS_WUP), scr, it, lane);
              else transpose_item(p.in[17], DFF, 1024, (bf16*)(ws + WS_WDN), scr, it - I_UP, lane); }
          constexpr int I_A = 8 * 32, I_B = 8 * 32, I_O = 16 * 32;
          for (int it = gw; it < I_A + I_B + I_O; it += 128 * NWAVES) {
              if (it < I_A) transpose_item(p.in[10], 512, 1024, (bf16*)(ws + WS_WA), scr, it, lane);
              else if (it < I_A + I_B) transpose_item(p.in[11], 512, 1024, (bf16*)(ws + WS_WB), scr, it - I_A, lane);
              else transpose_item(p.in[12], 1024, 1024, (bf16*)(ws + WS_WOUT), scr, it - I_A - I_B, lane); } }
    } else if (G >= 192) {
        for (int it = blockIdx.x - 128; it < 128; it += G - 128) hgrn_mfma_item(p, lds, it);
    } else {
        pg8::Gemm g{(const bf16*)(ws + WS_CS), (const bf16*)(ws + WS_PQT), 2048, 2048, 32768};
        pg8::DftOrder S; S.G = G; S.c = blockIdx.x; S.a_tile = (size_t)256 * 2048 * 2; S.b_tile = (size_t)256 * 32768 * 2;
        EpiDft E{(bf16*)(ws + WS_YF), (unsigned*)(ws + WS_BAR + 16384)};
        pg8::gemm_phase<EpiDft, pg8::DftOrder, true, true>(ldsl, g, S, E);
        for (int it = blockIdx.x; it < 128; it += G) hgrn_mfma_item(p, lds, it);
    }
    xcd_barrier(xbar);
    }
    PROBE_POINT(3);
    for (int rep_ = 0; rep_ < REPS(4); ++rep_) {
    phase_yh(p, lane, gw, NGW);
    { LAS float* scr = (LAS float*)((LAS unsigned char*)lds + wave * 16384);
      constexpr int I_UP = 16 * 176, I_DN = 44 * 32;
      for (int it = (G >= 192) ? I_UP + I_DN : gw; it < I_UP + I_DN; it += NGW) {
          if (it < I_UP) transpose_item(p.in[14], 1024, DFF2, (bf16*)(ws + WS_WUP), scr, it, lane);
          else transpose_item(p.in[17], DFF, 1024, (bf16*)(ws + WS_WDN), scr, it - I_UP, lane); } }
    xcd_barrier(xbar);
    }
    PROBE_POINT(4);
    for (int rep_ = 0; rep_ < REPS(5); ++rep_) {
    if (G == 256) {
        pg8::f32x4 accm[2][2][4][2];
        {
            pg8::Gemm g{(const bf16*)(ws + WS_YF), (const bf16*)(ws + WS_WA), 512, 512, 512};
            pg8::StaticOrder S; S.init(64, 4, G, blockIdx.x, 512, 512);
            pg8::Epi8<FYab> E{FYab{(const bf16*)(ws + WS_GA), (const bf16*)(ws + WS_GBG)}};
            pg8::gemm_phase<pg8::Epi8<FYab>, pg8::StaticOrder, true, true, 1>(ldsl, g, S, E, &accm[0]);
        }
        {
            pg8::Gemm g{(const bf16*)(ws + WS_YH), (const bf16*)(ws + WS_WB), 512, 512, 512};
            pg8::StaticOrder S; S.init(64, 4, G, blockIdx.x, 512, 512);
            pg8::Epi8<FYb> E{FYb{(const bf16*)(ws + WS_GBG), (bf16*)(ws + WS_MRG)}};
            pg8::gemm_phase<pg8::Epi8<FYb>, pg8::StaticOrder, true, true, 2>(ldsl, g, S, E, &accm[0]);
        }
    } else {
    {
        pg8::Gemm g{(const bf16*)(ws + WS_YF), (const bf16*)(ws + WS_WA), 512, 512, 512};
        pg8::StaticOrder S; S.init(64, 4, G, blockIdx.x, 512, 512);
        pg8::Epi8<FYaT> E{FYaT{(const bf16*)(ws + WS_GA), (bf16*)(ws + WS_TMP)}};
        pg8::gemm_phase<pg8::Epi8<FYaT>, pg8::StaticOrder, true, true>(ldsl, g, S, E);
    }
    {
        pg8::Gemm g{(const bf16*)(ws + WS_YH), (const bf16*)(ws + WS_WB), 512, 512, 512};
        pg8::StaticOrder S; S.init(64, 4, G, blockIdx.x, 512, 512);
        pg8::Epi8<FYbT> E{FYbT{(const bf16*)(ws + WS_GBG), (const bf16*)(ws + WS_TMP), (bf16*)(ws + WS_MRG)}};
        pg8::gemm_phase<pg8::Epi8<FYbT>, pg8::StaticOrder, true, true>(ldsl, g, S, E);
    }
    }
    xcd_barrier(xbar);
    }
    PROBE_POINT(5);
    for (int rep_ = 0; rep_ < REPS(6); ++rep_) {
    {
        pg8::Gemm g{(const bf16*)(ws + WS_MRG), (const bf16*)(ws + WS_WOUT), 1024, 1024, 1024};
        pg8::StaticOrder S; S.init(64, 4, G, blockIdx.x, 1024, 1024);
        pg8::Epi8<FRes> E{FRes{p.in[0], p.out, mx, 2}};
        pg8::gemm_phase<pg8::Epi8<FRes>, pg8::StaticOrder, true, true>(ldsl, g, S, E);
    }
    xcd_barrier(xbar);
    }
    PROBE_POINT(6);
    for (int rep_ = 0; rep_ < REPS(7); ++rep_) {
    { const int per = (MTOK + NGW - 1) / NGW, r0 = gw * per, nr = min(per, MTOK - r0);
      if (nr > 0) norm_rows<true>(p.out, p.out, MTOK, p.in[13], mx, 3, 4, (bf16*)(ws + WS_H2), nullptr, r0, nr, lane); }
    xcd_barrier(xbar);
    }
    PROBE_POINT(7);
    {
    for (int hf = 0; hf < 2; ++hf) {
        for (int rep_ = 0; rep_ < REPS(8); ++rep_) {
            pg8::Gemm g{(const bf16*)(ws + WS_H2) + (size_t)hf * 8192 * 1024, (const bf16*)(ws + WS_WUP), 1024, 1024, 1024};
            pg8::StaticOrder S; S.init(32, 22, G, blockIdx.x, 1024, 1024);
            pg8::Epi8<FUp> E{FUp{(bf16*)(ws + WS_Z), DFF2}};
            pg8::gemm_phase<pg8::Epi8<FUp>, pg8::StaticOrder, true, true>(ldsl, g, S, E);
        xcd_barrier(xbar);
        }
        for (int rep_ = 0; rep_ < REPS(9); ++rep_) {
        phase_conv_lds(p, hf, lds, G);
        xcd_barrier(xbar);
        }
    }
    }
    PROBE_POINT(8);
    if (G == 256) {
        pg8::Gemm g{(const bf16*)(ws + WS_A2), (const bf16*)(ws + WS_WDN), DFF, DFF, DFF};
        pg8::StaticOrder S; S.init(64, 4, G, blockIdx.x, DFF, DFF);
        EpiFinal E{p.out, mx, p.in[18], (float*)(ws + WS_SLOT), (unsigned*)(ws + WS_BAR + 20480)};
        pg8::gemm_phase<EpiFinal, pg8::StaticOrder, true, true>(ldsl, g, S, E);
    } else {
    {
        pg8::Gemm g{(const bf16*)(ws + WS_A2), (const bf16*)(ws + WS_WDN), DFF, DFF, DFF};
        pg8::StaticOrder S; S.init(64, 4, G, blockIdx.x, DFF, DFF);
        pg8::Epi8<FRes> E{FRes{p.out, (float*)(ws + WS_XO), mx, 5}};
        pg8::gemm_phase<pg8::Epi8<FRes>, pg8::StaticOrder, true, true>(ldsl, g, S, E);
    }
    xcd_barrier(xbar);
    { const int per = (MTOK + NGW - 1) / NGW, r0 = gw * per, nr = min(per, MTOK - r0);
      if (nr > 0) norm_rows<false>((const float*)(ws + WS_XO), (const float*)(ws + WS_XO), MTOK, p.in[18], nullptr, 0, 0, nullptr, p.out, r0, nr, lane); }
    }
}

extern "C" void kernel_launch(void* const* d_in, const int* in_sizes, int n_in, void* d_out, int out_size, void* d_ws, size_t ws_size, hipStream_t stream) {
    static int grid = 0;
    if (grid == 0) {
        if (n_in != 19 || out_size != MTOK * DM || ws_size < WS_END) { fprintf(stderr, "kernel_launch: unexpected problem: n_in %d out %d ws %zu\n", n_in, out_size, ws_size); grid = -1; return; }
        int dev = 0, cus = 0, per_cu = 0;
        hipGetDevice(&dev);
        hipDeviceGetAttribute(&cus, hipDeviceAttributeMultiprocessorCount, dev);
        if (hipFuncSetAttribute((const void*)fwd_mega, hipFuncAttributeMaxDynamicSharedMemorySize, LDS_BYTES) != hipSuccess) { fprintf(stderr, "kernel_launch: hipFuncSetAttribute failed\n"); grid = -1; return; }
        if (hipOccupancyMaxActiveBlocksPerMultiprocessor(&per_cu, (const void*)fwd_mega, NTHR, LDS_BYTES) != hipSuccess || per_cu < 1) { fprintf(stderr, "kernel_launch: occupancy query says %d\n", per_cu); per_cu = 1; }
        (void)hipGetLastError();
        grid = cus * (per_cu > 1 ? 1 : per_cu);
        fprintf(stderr, "kernel_launch: grid %d (cus %d, per_cu %d), ws %zu\n", grid, cus, per_cu, ws_size);
    }
    if (grid < 0) return;
    Params p{};
    for (int i = 0; i < 19; ++i) p.in[i] = (const float*)d_in[i];
    p.out = (float*)d_out; p.ws = (unsigned char*)d_ws;
    if (hipMemsetAsync((char*)d_ws + WS_BAR, 0, BAR_BYTES, stream) != hipSuccess) { fprintf(stderr, "kernel_launch: memset failed\n"); return; }
    void* args[] = {&p};
    hipError_t e = hipLaunchCooperativeKernel((const void*)fwd_mega, dim3(grid), dim3(NTHR), args, LDS_BYTES, stream);
    if (e != hipSuccess) fprintf(stderr, "kernel_launch: cooperative launch failed: %s (grid %d)\n", hipGetErrorString(e), grid);
}
```

```cpp
#include <hip/hip_runtime.h>
#include <hip/hip_cooperative_groups.h>
#include <cstdio>
#include <cstdint>
namespace cg = cooperative_groups;

namespace pg8 {
#define PG8_LAS __attribute__((address_space(3)))
typedef unsigned short bf16_t;
typedef short bf16x8 __attribute__((ext_vector_type(8)));
typedef float f32x4 __attribute__((ext_vector_type(4)));
typedef unsigned u32x4 __attribute__((ext_vector_type(4)));
typedef unsigned u32x2 __attribute__((ext_vector_type(2)));
constexpr int BM = 256, BK = 64, HALF = 128, HTB = HALF * BK * 2  , STAGE_BYTES = 8 * HTB, NXCD = 8, WGM = 8;

__host__ __device__ __forceinline__ int lds_byte(int r, int c) { const int st = (r >> 4) * 2 + (c >> 5), rr = r & 15, cc = c & 31, ob = rr * 64 + cc * 2; return st * 1024 + (ob ^ (((ob >> 9) & 1) << 5)); }
__host__ __device__ __forceinline__ void stage_rc(int b, int& R, int& C) { const int st = b / 1024, sb = b % 1024, swz = sb ^ (((sb >> 9) & 1) << 5); R = (st >> 1) * 16 + swz / 64; C = (st & 1) * 32 + (swz % 64) / 2; }
__host__ __device__ __forceinline__ int perm32(int rho) { const int n = rho >> 4, i = rho & 15; return 8 * (i >> 2) + 4 * n + (i & 3); }

struct Unit { int pm, pn, z; };
struct Gemm { const bf16_t* A; const bf16_t* Bt; int K, lda, ldb; };

__device__ __forceinline__ void tile_of(int wgid, int nM, int nN, int& pm, int& pn) {
    const int nwg = nM * nN;
    { const int q = nwg / NXCD, r = nwg % NXCD, xcd = wgid % NXCD, off = wgid / NXCD; wgid = (xcd < r ? xcd * (q + 1) : r * (q + 1) + (xcd - r) * q) + off; }
    const int nig = WGM * nN, gid = wgid / nig, fm = gid * WGM, gsz = (nM - fm) < WGM ? (nM - fm) : WGM;
    pm = fm + ((wgid % nig) % gsz); pn = (wgid % nig) / gsz;
}
struct StaticOrder {
    int nM, nN, nwg, G, c; size_t a_tile, b_tile;
    __device__ __forceinline__ void init(int nM_, int nN_, int G_, int c_, int lda, int ldb) { nM = nM_; nN = nN_; nwg = nM * nN; G = G_; c = c_; a_tile = (size_t)BM * lda * 2; b_tile = (size_t)BM * ldb * 2; }
    __device__ __forceinline__ bool next(int i, Unit& u) const {
        const long L = (long)i * G + c; if (L >= nwg) return false;
        tile_of((int)L, nM, nN, u.pm, u.pn); u.z = 0; return true;
    }
    __device__ __forceinline__ size_t a_off(const Unit& u) const { return (size_t)u.pm * a_tile; }
    __device__ __forceinline__ size_t b_off(const Unit& u) const { return (size_t)u.pn * b_tile; }
};
struct OneOrder {
    int L, nM, nN; size_t a_tile, b_tile;
    __device__ __forceinline__ bool next(int i, Unit& u) const { if (i > 0) return false; tile_of(L, nM, nN, u.pm, u.pn); u.z = 0; return true; }
    __device__ __forceinline__ size_t a_off(const Unit& u) const { return (size_t)u.pm * a_tile; }
    __device__ __forceinline__ size_t b_off(const Unit& u) const { return (size_t)u.pn * b_tile; }
};
struct InOrder {
    int G, c; size_t a_tile, b_tile;
    __device__ __forceinline__ bool next(int i, Unit& u) const {
        const long L = (long)i * G + c; if (L >= 1152 + 48) return false;
        if (L < 1152) { tile_of((int)L, 64, 18, u.pm, u.pn); } else { const int j = (int)L - 1152; u.pm = 64 + (j & 7); u.pn = 2 + (j >> 3); }
        u.z = 0; return true;
    }
    __device__ __forceinline__ size_t a_off(const Unit& u) const { return (size_t)u.pm * a_tile; }
    __device__ __forceinline__ size_t b_off(const Unit& u) const { return (size_t)u.pn * b_tile; }
};
struct DftOrder {
    int G, c; size_t a_tile, b_tile;
    __device__ __forceinline__ bool next(int i, Unit& u) const {
        const long L = (long)i * G + c; if (L >= 128) return false;
        const int eo = (L < 64) ? 1 : 0, q = (int)L & 63;
        u.pn = q & 1; u.pm = (q >> 1) & 3; u.z = (q >> 3) | (eo << 8); return true;
    }
    __device__ __forceinline__ size_t a_off(const Unit& u) const { return (size_t)((u.z >> 8) * 4 + u.pm) * a_tile; }
    __device__ __forceinline__ size_t b_off(const Unit& u) const { return (size_t)u.pn * b_tile + ((size_t)(u.z & 255) * 4096 + (size_t)(u.z >> 8) * 2048) * 2; }
};

__device__ __forceinline__ unsigned cvt_pk_bf16(float lo, float hi) { unsigned r; asm volatile("v_cvt_pk_bf16_f32 %0, %1, %2" : "=v"(r) : "v"(lo), "v"(hi)); return r; }

template <class F> struct Epi8 {
    static constexpr bool PERM = true;
    F f;
    __device__ __forceinline__ void inplace(f32x4 (&acc)[2][2][4][2], const Unit& u, int wr, int wc, int fr, int fq) const {
        const int row0 = u.pm * BM + wr * 64 + fr, col0 = u.pn * BM + wc * 32 + 8 * fq;
#pragma unroll
        for (int ai = 0; ai < 2; ++ai)
#pragma unroll
            for (int m = 0; m < 4; ++m) {
#pragma unroll
                for (int bj = 0; bj < 2; ++bj) f.scale(u, row0 + ai * HALF + m * 16, col0 + bj * HALF, acc[ai][bj][m][0], acc[ai][bj][m][1]);
                asm volatile("" ::: "memory");
            }
    }
    __device__ __forceinline__ void operator()(const f32x4 (&acc)[2][2][4][2], const Unit& u, int wr, int wc, int fr, int fq) const {
        const int row0 = u.pm * BM + wr * 64 + fr, col0 = u.pn * BM + wc * 32 + 8 * fq;
#pragma unroll
        for (int ai = 0; ai < 2; ++ai)
#pragma unroll
            for (int m = 0; m < 4; ++m) {
#pragma unroll
                for (int bj = 0; bj < 2; ++bj) f(u, row0 + ai * HALF + m * 16, col0 + bj * HALF, acc[ai][bj][m][0], acc[ai][bj][m][1]);
                asm volatile("" ::: "memory");
            }
    }
};

template <class E, class = void> struct after_drain { static constexpr bool value = false; };
template <class E> struct after_drain<E, decltype((void)E::AFTER_DRAIN)> { static constexpr bool value = E::AFTER_DRAIN; };
template <class Epi, class Sched, bool ALIGN_EPI = false, bool SP2 = false, int EXTACC = 0>
__device__ __forceinline__ void gemm_phase(PG8_LAS unsigned char* lds, const Gemm g, const Sched& S, const Epi& E, f32x4 (*accx)[2][4][2] = nullptr) {
    int tid_ = threadIdx.x; asm volatile("" : "+v"(tid_));
    const int tid = tid_, wid = __builtin_amdgcn_readfirstlane(tid >> 6), lane = tid & 63, wr = wid >> 2, wc = wid & 3, fr = lane & 15, fq = lane >> 4;
    const int K = g.K, nt = K / BK;
    unsigned voffA[2], voffB[2];
#pragma unroll
    for (int i = 0; i < 2; ++i) { int R, C; stage_rc(tid * 16 + i * 8192, R, C); const int Rb = Epi::PERM ? ((R & ~31) + perm32(R & 31)) : R;
        voffA[i] = (unsigned)(R * g.lda + C) * 2u; voffB[i] = (unsigned)(Rb * g.ldb + C) * 2u; }
    const size_t kstep = (size_t)(BK * 2);
    const size_t hstepA = (size_t)HALF * g.lda * 2, hstepB = (size_t)HALF * g.ldb * 2;
    const unsigned ldsw = (unsigned)wid * 1024u;
    const int aoff = lds_byte(wr * 64 + fr, fq * 8), boff = lds_byte(wc * 32 + fr, fq * 8);
#define PG8_SA(b, h) (((b) * 2 + (h)) * HTB)
#define PG8_SB(b, h) ((4 + (b) * 2 + (h)) * HTB)
#define PG8_STAGE(bufoff, gbase, voff) do { _Pragma("unroll") for (int _i = 0; _i < 2; ++_i) \
        __builtin_amdgcn_global_load_lds((const unsigned*)((const char*)(gbase) + (voff)[_i]), (PG8_LAS unsigned*)(lds + (bufoff) + ldsw + _i * 8192), 16, 0, 0); } while (0)
#define PG8_LDA(dst, b, h) do { _Pragma("unroll") for (int m = 0; m < 4; ++m) _Pragma("unroll") for (int k = 0; k < 2; ++k) dst[m][k] = *(const PG8_LAS bf16x8*)(lds + PG8_SA(b, h) + aoff + m * 2048 + k * 1024); } while (0)
#define PG8_LDB(dst, b, h) do { _Pragma("unroll") for (int n = 0; n < 2; ++n) _Pragma("unroll") for (int k = 0; k < 2; ++k) dst[n][k] = *(const PG8_LAS bf16x8*)(lds + PG8_SB(b, h) + boff + n * 2048 + k * 1024); } while (0)
#define PG8_MMA(ai, bj, At, Bt) do { __builtin_amdgcn_s_setprio(1); _Pragma("unroll") for (int m = 0; m < 4; ++m) _Pragma("unroll") for (int n = 0; n < 2; ++n) _Pragma("unroll") for (int k = 0; k < 2; ++k) \
        acc[ai][bj][m][n] = __builtin_amdgcn_mfma_f32_16x16x32_bf16(Bt[n][k], At[m][k], acc[ai][bj][m][n], 0, 0, 0); __builtin_amdgcn_s_setprio(0); } while (0)
#define PG8_WAIT_V(n) asm volatile("s_waitcnt vmcnt(" #n ")" ::: "memory")
#define PG8_WAIT_L(n) asm volatile("s_waitcnt lgkmcnt(" #n ")" ::: "memory")
#define PG8_BAR __builtin_amdgcn_s_barrier()
#define PG8_SCHED __builtin_amdgcn_sched_barrier(0)
    Unit cur, nxt; int ui = 0;
    if (!S.next(0, cur)) return;
    f32x4 accl[2][2][4][2];
    f32x4 (&acc)[2][2][4][2] = *(EXTACC ? (f32x4 (*)[2][2][4][2])accx : &accl);
    if constexpr (EXTACC != 2) {
#pragma unroll
    for (int a = 0; a < 2; ++a)
#pragma unroll
        for (int b = 0; b < 2; ++b)
#pragma unroll
            for (int m = 0; m < 4; ++m)
#pragma unroll
                for (int n = 0; n < 2; ++n) acc[a][b][m][n] = (f32x4){0.f, 0.f, 0.f, 0.f};
    }
    bf16x8 At[4][2], B0[2][2], B1[2][2];
    const char* cA = (const char*)g.A + S.a_off(cur); const char* cB = (const char*)g.Bt + S.b_off(cur);
    if constexpr (SP2) {
        PG8_STAGE(PG8_SB(0, 0), cB, voffB); PG8_STAGE(PG8_SB(0, 1), cB + hstepB, voffB); PG8_STAGE(PG8_SA(0, 0), cA, voffA); PG8_STAGE(PG8_SA(0, 1), cA + hstepA, voffA);
        if (wr == 1) PG8_BAR;
        PG8_WAIT_V(2); PG8_BAR;
        PG8_STAGE(PG8_SB(1, 0), cB + kstep, voffB); PG8_STAGE(PG8_SA(1, 0), cA + kstep, voffA); PG8_STAGE(PG8_SB(1, 1), cB + hstepB + kstep, voffB);
        PG8_WAIT_V(6); PG8_BAR;
    } else {
        PG8_STAGE(PG8_SB(0, 0), cB, voffB); PG8_STAGE(PG8_SA(0, 0), cA, voffA); PG8_STAGE(PG8_SB(0, 1), cB + hstepB, voffB); PG8_STAGE(PG8_SA(0, 1), cA + hstepA, voffA);
        if (wr == 1) PG8_BAR;
        PG8_WAIT_V(4); PG8_BAR;
        PG8_STAGE(PG8_SB(1, 0), cB + kstep, voffB); PG8_STAGE(PG8_SA(1, 0), cA + kstep, voffA); PG8_STAGE(PG8_SB(1, 1), cB + hstepB + kstep, voffB);
        PG8_WAIT_V(6); PG8_BAR;
    }
    for (;;) {
        const bool has_next = S.next(ui + 1, nxt);
        const char* nA = has_next ? (const char*)g.A + S.a_off(nxt) : cA; const char* nB = has_next ? (const char*)g.Bt + S.b_off(nxt) : cB;
        for (int t = 0; t < nt; t += 2) {
            const bool last = (t == nt - 2);
            const char* a1 = cA + (size_t)(t + 1) * kstep;
            const char* a2 = last ? nA : cA + (size_t)(t + 2) * kstep; const char* b2 = last ? nB : cB + (size_t)(t + 2) * kstep;
            const char* a3 = a2 + kstep; const char* b3 = b2 + kstep;
            if constexpr (SP2) {
            PG8_LDB(B0, 0, 0); PG8_LDB(B1, 0, 1); PG8_SCHED; PG8_LDA(At, 0, 0); PG8_STAGE(PG8_SA(1, 1), a1 + hstepA, voffA);
            PG8_WAIT_V(8); PG8_WAIT_L(0); PG8_BAR; PG8_MMA(0, 0, At, B0); PG8_MMA(0, 1, At, B1); PG8_BAR; PG8_SCHED;
            PG8_LDA(At, 0, 1); PG8_STAGE(PG8_SB(0, 0), b2, voffB); PG8_STAGE(PG8_SB(0, 1), b2 + hstepB, voffB); PG8_STAGE(PG8_SA(0, 0), a2, voffA);
            PG8_WAIT_V(8); PG8_WAIT_L(0); PG8_BAR; PG8_MMA(1, 0, At, B0); PG8_MMA(1, 1, At, B1); PG8_BAR; PG8_SCHED;
            PG8_LDB(B0, 1, 0); PG8_LDB(B1, 1, 1); PG8_SCHED; PG8_LDA(At, 1, 0); PG8_STAGE(PG8_SA(0, 1), a2 + hstepA, voffA);
            PG8_WAIT_V(8); PG8_WAIT_L(0); PG8_BAR; PG8_MMA(0, 0, At, B0); PG8_MMA(0, 1, At, B1); PG8_BAR; PG8_SCHED;
            PG8_LDA(At, 1, 1); PG8_STAGE(PG8_SB(1, 0), b3, voffB); PG8_STAGE(PG8_SB(1, 1), b3 + hstepB, voffB); PG8_STAGE(PG8_SA(1, 0), a3, voffA);
            PG8_WAIT_V(8); PG8_WAIT_L(0); PG8_BAR; PG8_MMA(1, 0, At, B0); PG8_MMA(1, 1, At, B1); PG8_BAR; PG8_SCHED;
            } else {
            PG8_LDB(B0, 0, 0); PG8_SCHED; PG8_LDA(At, 0, 0); PG8_STAGE(PG8_SA(1, 1), a1 + hstepA, voffA);
            PG8_WAIT_L(8); PG8_BAR; PG8_WAIT_L(0); PG8_MMA(0, 0, At, B0); PG8_BAR; PG8_SCHED;
            PG8_LDB(B1, 0, 1); PG8_STAGE(PG8_SB(0, 0), b2, voffB);
            PG8_BAR; PG8_WAIT_L(0); PG8_MMA(0, 1, At, B1); PG8_BAR;
            PG8_LDA(At, 0, 1); PG8_STAGE(PG8_SA(0, 0), a2, voffA);
            PG8_BAR; PG8_WAIT_L(0); PG8_MMA(1, 0, At, B0); PG8_BAR; PG8_SCHED;
            PG8_STAGE(PG8_SB(0, 1), b2 + hstepB, voffB);
            PG8_WAIT_V(6); PG8_BAR; PG8_MMA(1, 1, At, B1); PG8_BAR;
            PG8_LDB(B0, 1, 0); PG8_SCHED; PG8_LDA(At, 1, 0); PG8_STAGE(PG8_SA(0, 1), a2 + hstepA, voffA);
            PG8_WAIT_L(8); PG8_BAR; PG8_WAIT_L(0); PG8_MMA(0, 0, At, B0); PG8_BAR; PG8_SCHED;
            PG8_LDB(B1, 1, 1); PG8_STAGE(PG8_SB(1, 0), b3, voffB);
            PG8_BAR; PG8_WAIT_L(0); PG8_MMA(0, 1, At, B1); PG8_BAR;
            PG8_LDA(At, 1, 1); PG8_STAGE(PG8_SA(1, 0), a3, voffA);
            PG8_BAR; PG8_WAIT_L(0); PG8_MMA(1, 0, At, B0); PG8_BAR; PG8_SCHED;
            PG8_STAGE(PG8_SB(1, 1), b3 + hstepB, voffB);
            PG8_WAIT_V(6); PG8_BAR; PG8_MMA(1, 1, At, B1); PG8_BAR;
            }
        }
        if constexpr (ALIGN_EPI) { if (wr == 0) PG8_BAR; }
        if constexpr (after_drain<Epi>::value) {   }
        else if constexpr (EXTACC == 1) E.inplace(acc, cur, wr, wc, fr, fq); else E(acc, cur, wr, wc, fr, fq);
        if (!has_next || EXTACC != 0 || after_drain<Epi>::value) break;
#pragma unroll
        for (int a = 0; a < 2; ++a)
#pragma unroll
            for (int b = 0; b < 2; ++b)
#pragma unroll
                for (int m = 0; m < 4; ++m)
#pragma unroll
                    for (int n = 0; n < 2; ++n) acc[a][b][m][n] = (f32x4){0.f, 0.f, 0.f, 0.f};
        cur = nxt; cA = nA; cB = nB; ++ui;
        if constexpr (ALIGN_EPI) { if (wr == 1) PG8_BAR; }
    }
    PG8_WAIT_V(0);
    if constexpr (!ALIGN_EPI) { if (wr == 0) PG8_BAR; }
    PG8_BAR;
    if constexpr (after_drain<Epi>::value) E.fused(acc, cur, lds);
#undef PG8_SA
#undef PG8_SB
#undef PG8_STAGE
#undef PG8_LDA
#undef PG8_LDB
#undef PG8_MMA
#undef PG8_WAIT_V
#undef PG8_WAIT_L
#undef PG8_BAR
#undef PG8_SCHED
}
}

constexpr int DM = 1024, NB = 8, SEQ = 2048, MTOK = NB * SEQ, CTXL = 256, MCTX = NB * CTXL;
constexpr int HGD = 512, DFF = 2816, DFF2 = 5632, INDIM = 5120, NMOD = 6;
constexpr float EPSN = 1e-6f;
constexpr int NWAVES = 8, NTHR = 512;
constexpr int LDS_BYTES = 147456;
#ifndef DUP_MASK
#define DUP_MASK 0
#endif
#define REPS(k) ((((DUP_MASK) >> (k)) & 1) ? 2 : 1)
#ifndef PROBE_K
#define PROBE_K -1
#endif
#ifndef EXTRA_SYNCS
#define EXTRA_SYNCS 0
#endif

constexpr size_t MiB = 1u << 20;
constexpr size_t WS_MX = 0;
constexpr size_t WS_LB = 256 * 1024;
constexpr size_t WS_SLOT = 1 * MiB;
constexpr size_t WS_WFS = 2 * MiB, WS_TCH = 3 * MiB;
constexpr size_t WS_BAR = 512 * 1024, BAR_BYTES = 32768;
constexpr int MISC_OFF = 147456 - 128;
constexpr size_t WS_WIN = 6 * MiB;
constexpr size_t WS_WPQ = 16 * MiB;
constexpr size_t WS_WA = 18 * MiB, WS_WB = 19 * MiB, WS_WOUT = 20 * MiB;
constexpr size_t WS_CS = 22 * MiB;
constexpr size_t WS_WUP = 6 * MiB;
constexpr size_t WS_WDN = 250 * MiB;
constexpr size_t WS_HX = 38 * MiB;
constexpr size_t WS_OF = 38 * MiB, WS_OB = 54 * MiB;
constexpr size_t WS_TMP = 38 * MiB;
constexpr size_t WS_H2 = 38 * MiB;
constexpr size_t WS_Q = 74 * MiB, WS_V = 90 * MiB, WS_OG = 106 * MiB, WS_GA = 122 * MiB, WS_GBG = 154 * MiB, WS_PQT = 186 * MiB;
constexpr size_t WS_GFC = 218 * MiB, WS_GBC = 222 * MiB, WS_VC = 226 * MiB;
constexpr size_t WS_YF = 228 * MiB;
constexpr size_t WS_YH = 74 * MiB;
constexpr size_t WS_MRG = 186 * MiB;
constexpr size_t WS_Z = 74 * MiB;
constexpr size_t WS_A2 = 162 * MiB;
constexpr size_t WS_XO = 38 * MiB;
constexpr size_t WS_END = 256 * MiB;

typedef unsigned short bf16;
typedef float f32x4 __attribute__((ext_vector_type(4)));
typedef unsigned u32x4 __attribute__((ext_vector_type(4)));
typedef unsigned u32x2 __attribute__((ext_vector_type(2)));
typedef float f32x2 __attribute__((ext_vector_type(2)));
#define LAS __attribute__((address_space(3)))

struct Params {
    const float* in[19];
    float* out;
    unsigned char* ws;
};

__device__ __forceinline__ float bf2f(unsigned short b) { return __uint_as_float(((unsigned)b) << 16); }
__device__ __forceinline__ float bflo(unsigned w) { return __uint_as_float(w << 16); }
__device__ __forceinline__ float bfhi(unsigned w) { return __uint_as_float(w & 0xffff0000u); }
__device__ __forceinline__ unsigned f2bf(float f) { unsigned u = __float_as_uint(f); return (u + 0x7fffu + ((u >> 16) & 1u)) >> 16; }
__device__ __forceinline__ unsigned pk2(float lo, float hi);
typedef __bf16 bf16x2_t __attribute__((ext_vector_type(2)));
__device__ __forceinline__ unsigned hwpk2(float lo, float hi) { const f32x2 v = {lo, hi}; const bf16x2_t r = __builtin_convertvector(v, bf16x2_t); return __builtin_bit_cast(unsigned, r); }
__device__ __forceinline__ unsigned pk2(float lo, float hi) { return hwpk2(lo, hi); }
__device__ __forceinline__ float sigmoidf_(float x) { return __builtin_amdgcn_rcpf(1.f + __expf(-x)); }
__device__ __forceinline__ float siluf_(float x) { return x * __builtin_amdgcn_rcpf(1.f + __expf(-x)); }
__device__ __forceinline__ float wave_sum(float v) {
#pragma unroll
    for (int o = 1; o < 64; o <<= 1) v += __shfl_xor(v, o);
    return v;
}
__device__ __forceinline__ u32x4 pack8(const f32x4 a, const f32x4 b) { u32x4 w; w.x = pk2(a[0], a[1]); w.y = pk2(a[2], a[3]); w.z = pk2(b[0], b[1]); w.w = pk2(b[2], b[3]); return w; }

typedef __attribute__((address_space(1))) unsigned gu32;
#define XB_TMO      128
#define XB_XCNT(j)  (256  + 64 * (j))
#define XB_XSUB(j)  (1280 + 64 * (j))
#define XB_XGEN(j)  (2304 + 64 * (j))
#define XB_TOP      3328
#define XB_TOPGEN   3392
#define XCD_BAR_WORDS 3456
#define XB_SPIN_CAP (1u << 18)

__device__ __forceinline__ unsigned xb_ld(unsigned* p)              { return __hip_atomic_load(p, __ATOMIC_RELAXED, __HIP_MEMORY_SCOPE_AGENT); }
__device__ __forceinline__ unsigned xb_add(unsigned* p, unsigned v) { return __hip_atomic_fetch_add(p, v, __ATOMIC_RELAXED, __HIP_MEMORY_SCOPE_AGENT); }
__device__ __forceinline__ unsigned xb_xcc_id() { return (unsigned)__builtin_amdgcn_s_getreg((3 << 11) | 20) & 0xFu; }
#define XB_SPIN(cond, bar) do { unsigned _sp = 0; while (cond) { __builtin_amdgcn_s_sleep(1); \
    if ((++_sp & 255u) == 0u) { if (xb_ld(&(bar)[XB_TMO])) break; if (_sp > XB_SPIN_CAP) { atomicAdd(&(bar)[XB_TMO], 1u); break; } } } } while (0)

struct XcdBarrier {
    unsigned* bar; unsigned x;
    volatile LAS unsigned* st;
};

__device__ __forceinline__ XcdBarrier xcd_barrier_post(unsigned* bar, volatile LAS unsigned* st) {
    XcdBarrier b; b.bar = bar; b.x = xb_xcc_id(); b.st = st;
    if (threadIdx.x == 0) (void)xb_add(&bar[XB_XCNT(b.x)], 1u);
    return b;
}
__device__ __forceinline__ void xcd_barrier_complete(unsigned* bar, unsigned x, unsigned& nloc, unsigned& nx) {
    const unsigned G = gridDim.x * gridDim.y * gridDim.z;
    unsigned sum, cnt, mine, sp = 0u;
    for (;;) {
        sum = 0u; cnt = 0u; mine = 0u;
#pragma unroll
        for (unsigned j = 0; j < 16; ++j) { const unsigned c = xb_ld(&bar[XB_XCNT(j)]); sum += c; cnt += (c > 0u) ? 1u : 0u; mine = (j == x) ? c : mine; }
        if (sum == G) break;
        __builtin_amdgcn_s_sleep(1);
        if ((++sp & 255u) == 0u) { if (xb_ld(&bar[XB_TMO])) break; if (sp > XB_SPIN_CAP) { atomicAdd(&bar[XB_TMO], 1u); break; } }
    }
    nloc = mine > 0u ? mine : 1u; nx = cnt > 0u ? cnt : 1u;
}

__device__ __forceinline__ void xcd_barrier(const XcdBarrier& b) {
    asm volatile("s_waitcnt vmcnt(0)" ::: "memory");
    __syncthreads();
    if (threadIdx.x == 0) {
        unsigned* bar = b.bar;
        __builtin_amdgcn_s_waitcnt(0);
        unsigned nloc = b.st[0], nx = b.st[1];
        if (nloc == 0u) { xcd_barrier_complete(bar, b.x, nloc, nx); b.st[0] = nloc; b.st[1] = nx; }
        const unsigned old = xb_add(&bar[XB_XSUB(b.x)], 1u);
        const unsigned gen = old / nloc;
        if (old + 1u == (gen + 1u) * nloc) {
            __builtin_amdgcn_fence(__ATOMIC_RELEASE, "agent");
            asm volatile("s_waitcnt vmcnt(0)" ::: "memory");
            const unsigned og = xb_add(&bar[XB_TOP], 1u);
            const unsigned tg = og / nx;
            if (og + 1u == (tg + 1u) * nx) xb_add(&bar[XB_TOPGEN], 1u);
            else XB_SPIN(xb_ld(&bar[XB_TOPGEN]) == tg, bar);
            __builtin_amdgcn_fence(__ATOMIC_ACQUIRE, "agent");
            xb_add(&bar[XB_XGEN(b.x)], 1u);
            asm volatile("s_waitcnt vmcnt(0)" ::: "memory");
        } else {
            XB_SPIN(xb_ld(&bar[XB_XGEN(b.x)]) == gen, bar);
            __builtin_amdgcn_fence(__ATOMIC_ACQUIRE, "agent");
            asm volatile("s_waitcnt vmcnt(0)" ::: "memory");
        }
    }
    __syncthreads();
}


struct FIn {
    unsigned char* ws; float* out;
    __device__ __forceinline__ void operator()(const pg8::Unit& u, int row, int col, f32x4 v0, f32x4 v1) const {
        const int seg = u.pn >> 1, c = col & 511;
        if (seg == 0 || seg == 4) { f32x4 a, b;
#pragma unroll
            for (int i = 0; i < 4; ++i) { a[i] = siluf_(v0[i]); b[i] = siluf_(v1[i]); }
            bf16* dst = (bf16*)(ws + (seg == 0 ? WS_Q : WS_OG));
            *(u32x4*)(dst + (size_t)row * 512 + c) = pack8(a, b);
        } else if (seg == 1 || seg == 2) {
            const float* lb = (const float*)(ws + WS_LB);
            const f32x4 l0 = *(const f32x4*)(lb + c), l1 = *(const f32x4*)(lb + c + 4); f32x4 a, b;
#pragma unroll
            for (int i = 0; i < 4; ++i) { a[i] = l0[i] + (1.f - l0[i]) * sigmoidf_(v0[i]); b[i] = l1[i] + (1.f - l1[i]) * sigmoidf_(v1[i]); }
            float* dst;
            if (u.pm < 64) dst = out + (seg == 1 ? (size_t)0 : (size_t)MTOK * 512) + (size_t)row * 512 + c;
            else dst = (float*)(ws + (seg == 1 ? WS_GFC : WS_GBC)) + (size_t)(row - MTOK) * 512 + c;
            *(f32x4*)dst = a; *(f32x4*)(dst + 4) = b;
        } else if (seg == 3) {
            bf16* dst;
            if (u.pm < 64) dst = (bf16*)(ws + WS_V) + (size_t)row * 512 + c; else dst = (bf16*)(ws + WS_VC) + (size_t)(row - MTOK) * 512 + c;
            *(u32x4*)dst = pack8(v0, v1);
        } else { f32x4 a, b;
#pragma unroll
            for (int i = 0; i < 4; ++i) { a[i] = sigmoidf_(v0[i]); b[i] = sigmoidf_(v1[i]); }
            bf16* dst = (seg < 7) ? ((bf16*)(ws + WS_GA) + (size_t)row * 1024 + (col - 5 * 512)) : ((bf16*)(ws + WS_GBG) + (size_t)row * 1024 + (col - 7 * 512));
            *(u32x4*)dst = pack8(a, b);
        }
    }
};
struct FPQ {
    bf16* pqt;
    __device__ __forceinline__ void operator()(const pg8::Unit&, int row, int col, f32x4 v0, f32x4 v1) const {
        bf16* dst = pqt + (size_t)(row & 511) * 32768 + (size_t)(col >> 11) * 4096 + (size_t)(row >> 9) * 1024 + ((col & 2047) >> 1);
        u32x2 ev, od; ev.x = pk2(v0[0], v0[2]); ev.y = pk2(v1[0], v1[2]); od.x = pk2(v0[1], v0[3]); od.y = pk2(v1[1], v1[3]);
        *(u32x2*)dst = ev; *(u32x2*)(dst + 2048) = od;
    }
};
struct EpiDft {
    static constexpr bool PERM = true;
    bf16* yf; unsigned* flags;
    __device__ __forceinline__ void operator()(const f32x4 (&acc)[2][2][4][2], const pg8::Unit& u, int wr, int wc, int fr, int fq) const {
        const int z = u.z & 255, eo = u.z >> 8, pair = (z * 4 + u.pm) * 2 + u.pn;
        const int row0 = u.pm * 256 + wr * 64 + fr, col0 = u.pn * 256 + wc * 32 + 8 * fq;
        unsigned* flag = flags + pair * 16;
        if (eo) {
#pragma unroll
            for (int ai = 0; ai < 2; ++ai)
#pragma unroll
                for (int m = 0; m < 4; ++m)
#pragma unroll
                    for (int bj = 0; bj < 2; ++bj) { const int row = row0 + ai * 128 + m * 16, col = col0 + bj * 128;
                        *(u32x4*)(yf + ((size_t)z * SEQ + 1024 + row) * 512 + col) = pack8(acc[ai][bj][m][0] * (1.f / 512.f), acc[ai][bj][m][1] * (1.f / 512.f)); }
            asm volatile("s_waitcnt vmcnt(0)" ::: "memory");
            __syncthreads();
            if (threadIdx.x == 0) { __builtin_amdgcn_fence(__ATOMIC_RELEASE, "agent"); asm volatile("s_waitcnt vmcnt(0)" ::: "memory");
                __hip_atomic_store(flag, 1u, __ATOMIC_RELAXED, __HIP_MEMORY_SCOPE_AGENT); }
        } else {
            if (threadIdx.x == 0) { unsigned spins = 0;
                while (__hip_atomic_load(flag, __ATOMIC_RELAXED, __HIP_MEMORY_SCOPE_AGENT) == 0u && ++spins < (1u << 22)) __builtin_amdgcn_s_sleep(2);
                __builtin_amdgcn_fence(__ATOMIC_ACQUIRE, "agent"); asm volatile("s_waitcnt vmcnt(0)" ::: "memory"); }
            __syncthreads();
#pragma unroll
            for (int ai = 0; ai < 2; ++ai)
#pragma unroll
                for (int m = 0; m < 4; ++m) {
#pragma unroll
                    for (int bj = 0; bj < 2; ++bj) { const int row = row0 + ai * 128 + m * 16, col = col0 + bj * 128;
                        bf16* plo = yf + ((size_t)z * SEQ + row) * 512 + col; bf16* phi = plo + (size_t)1024 * 512;
                        const u32x4 o = *(const u32x4*)phi;
                        const f32x4 e0 = acc[ai][bj][m][0] * (1.f / 512.f), e1 = acc[ai][bj][m][1] * (1.f / 512.f);
                        f32x4 o0, o1; o0[0] = bflo(o.x); o0[1] = bfhi(o.x); o0[2] = bflo(o.y); o0[3] = bfhi(o.y); o1[0] = bflo(o.z); o1[1] = bfhi(o.z); o1[2] = bflo(o.w); o1[3] = bfhi(o.w);
                        *(u32x4*)plo = pack8(e0 + o0, e1 + o1); *(u32x4*)phi = pack8(e0 - o0, e1 - o1); }
                    asm volatile("" ::: "memory"); }
        }
    }
};
struct FYa {
    const bf16* ga;
    __device__ __forceinline__ void scale(const pg8::Unit&, int row, int col, f32x4& v0, f32x4& v1) const {
        const size_t o = (size_t)row * 1024 + col; const u32x4 g = *(const u32x4*)(ga + o);
        v0[0] *= bflo(g.x); v0[1] *= bfhi(g.x); v0[2] *= bflo(g.y); v0[3] *= bfhi(g.y); v1[0] *= bflo(g.z); v1[1] *= bfhi(g.z); v1[2] *= bflo(g.w); v1[3] *= bfhi(g.w);
    }
    __device__ __forceinline__ void operator()(const pg8::Unit&, int, int, f32x4, f32x4) const {}
};
struct FYb {
    const bf16* gbg; bf16* mrg;
    __device__ __forceinline__ void scale(const pg8::Unit&, int row, int col, f32x4& v0, f32x4& v1) const {
        const size_t o = (size_t)row * 1024 + col; const u32x4 h = *(const u32x4*)(gbg + o);
        v0[0] *= __builtin_amdgcn_rcpf(bflo(h.x)); v0[1] *= __builtin_amdgcn_rcpf(bfhi(h.x)); v0[2] *= __builtin_amdgcn_rcpf(bflo(h.y)); v0[3] *= __builtin_amdgcn_rcpf(bfhi(h.y));
        v1[0] *= __builtin_amdgcn_rcpf(bflo(h.z)); v1[1] *= __builtin_amdgcn_rcpf(bfhi(h.z)); v1[2] *= __builtin_amdgcn_rcpf(bflo(h.w)); v1[3] *= __builtin_amdgcn_rcpf(bfhi(h.w));
    }
    __device__ __forceinline__ void operator()(const pg8::Unit&, int row, int col, f32x4 v0, f32x4 v1) const {
        const size_t o = (size_t)row * 1024 + col; const u32x4 h = *(const u32x4*)(gbg + o);
        f32x4 a, b; a[0] = v0[0] * bflo(h.x); a[1] = v0[1] * bfhi(h.x); a[2] = v0[2] * bflo(h.y); a[3] = v0[3] * bfhi(h.y);
        b[0] = v1[0] * bflo(h.z); b[1] = v1[1] * bfhi(h.z); b[2] = v1[2] * bflo(h.w); b[3] = v1[3] * bfhi(h.w);
        *(u32x4*)(mrg + o) = pack8(a, b);
    }
};
struct FYab {
    const bf16* ga; const bf16* gbg;
    __device__ __forceinline__ void scale(const pg8::Unit&, int row, int col, f32x4& v0, f32x4& v1) const {
        const size_t o = (size_t)row * 1024 + col; const u32x4 g = *(const u32x4*)(ga + o), h = *(const u32x4*)(gbg + o);
        v0[0] *= bflo(g.x) * __builtin_amdgcn_rcpf(bflo(h.x)); v0[1] *= bfhi(g.x) * __builtin_amdgcn_rcpf(bfhi(h.x)); v0[2] *= bflo(g.y) * __builtin_amdgcn_rcpf(bflo(h.y)); v0[3] *= bfhi(g.y) * __builtin_amdgcn_rcpf(bfhi(h.y));
        v1[0] *= bflo(g.z) * __builtin_amdgcn_rcpf(bflo(h.z)); v1[1] *= bfhi(g.z) * __builtin_amdgcn_rcpf(bfhi(h.z)); v1[2] *= bflo(g.w) * __builtin_amdgcn_rcpf(bflo(h.w)); v1[3] *= bfhi(g.w) * __builtin_amdgcn_rcpf(bfhi(h.w));
    }
    __device__ __forceinline__ void operator()(const pg8::Unit&, int, int, f32x4, f32x4) const {}
};
struct FYaT {
    const bf16* ga; bf16* tmp;
    __device__ __forceinline__ void operator()(const pg8::Unit&, int row, int col, f32x4 v0, f32x4 v1) const {
        const size_t o = (size_t)row * 1024 + col; const u32x4 g = *(const u32x4*)(ga + o);
        f32x4 a, b; a[0] = v0[0] * bflo(g.x); a[1] = v0[1] * bfhi(g.x); a[2] = v0[2] * bflo(g.y); a[3] = v0[3] * bfhi(g.y);
        b[0] = v1[0] * bflo(g.z); b[1] = v1[1] * bfhi(g.z); b[2] = v1[2] * bflo(g.w); b[3] = v1[3] * bfhi(g.w);
        *(u32x4*)(tmp + o) = pack8(a, b);
    }
};
struct FYbT {
    const bf16* gbg; const bf16* tmp; bf16* mrg;
    __device__ __forceinline__ void operator()(const pg8::Unit&, int row, int col, f32x4 v0, f32x4 v1) const {
        const size_t o = (size_t)row * 1024 + col; const u32x4 g = *(const u32x4*)(gbg + o); const u32x4 t = *(const u32x4*)(tmp + o);
        f32x4 a, b; a[0] = bflo(t.x) + v0[0] * bflo(g.x); a[1] = bfhi(t.x) + v0[1] * bfhi(g.x); a[2] = bflo(t.y) + v0[2] * bflo(g.y); a[3] = bfhi(t.y) + v0[3] * bfhi(g.y);
        b[0] = bflo(t.z) + v1[0] * bflo(g.z); b[1] = bfhi(t.z) + v1[1] * bfhi(g.z); b[2] = bflo(t.w) + v1[2] * bflo(g.w); b[3] = bfhi(t.w) + v1[3] * bfhi(g.w);
        *(u32x4*)(mrg + o) = pack8(a, b);
    }
};
struct FRes {
    const float* src; float* dst; const float* mx; int mod;
    __device__ __forceinline__ void operator()(const pg8::Unit&, int row, int col, f32x4 v0, f32x4 v1) const {
        const size_t o = (size_t)row * 1024 + col; const float* m = mx + (size_t)(row >> 11) * (NMOD * DM) + mod * DM + col;
        const f32x4 m0 = *(const f32x4*)m, m1 = *(const f32x4*)(m + 4), s0 = *(const f32x4*)(src + o), s1 = *(const f32x4*)(src + o + 4);
        *(f32x4*)(dst + o) = s0 + m0 * v0; *(f32x4*)(dst + o + 4) = s1 + m1 * v1;
    }
};
struct FUp {
    bf16* z; int ld;
    __device__ __forceinline__ void operator()(const pg8::Unit&, int row, int col, f32x4 v0, f32x4 v1) const {
        *(u32x4*)(z + (size_t)row * ld + col) = pack8(v0, v1);
    }
};

struct EpiFinal {
    static constexpr bool PERM = true, AFTER_DRAIN = true;
    float* xio; const float* mx; const float* fg; float* slots; unsigned* flags;
    __device__ __forceinline__ void operator()(const f32x4 (&)[2][2][4][2], const pg8::Unit&, int, int, int, int) const {}
    __device__ __forceinline__ void fused(f32x4 (&acc)[2][2][4][2], const pg8::Unit& u, PG8_LAS unsigned char* ldsl) const {
        int t2_ = threadIdx.x; asm volatile("" : "+v"(t2_));
        const int tid = t2_, wid = __builtin_amdgcn_readfirstlane(tid >> 6), lane = tid & 63, wr = wid >> 2, wc = wid & 3, fr = lane & 15, fq = lane >> 4;
        PG8_LAS float* red = (PG8_LAS float*)ldsl;
        PG8_LAS float* rin = red + 1024;
        const int row0 = u.pm * 256 + wr * 64 + fr, col0 = u.pn * 256 + wc * 32 + 8 * fq;
        float ss[2][4];
#pragma unroll
        for (int ai = 0; ai < 2; ++ai)
#pragma unroll
            for (int m = 0; m < 4; ++m) ss[ai][m] = 0.f;
#pragma unroll
        for (int bj = 0; bj < 2; ++bj) { const int col = col0 + bj * 128;
            const float* mm = mx + (size_t)(u.pm >> 3) * (NMOD * DM) + 5 * DM + col;
            const f32x4 m0 = *(const f32x4*)mm, m1 = *(const f32x4*)(mm + 4);
#pragma unroll
            for (int ai = 0; ai < 2; ++ai)
#pragma unroll
                for (int m = 0; m < 4; ++m) { const size_t o = (size_t)(row0 + ai * 128 + m * 16) * 1024 + col;
                    const f32x4 x0 = *(const f32x4*)(xio + o), x1 = *(const f32x4*)(xio + o + 4);
                    const f32x4 v0 = x0 + m0 * acc[ai][bj][m][0], v1 = x1 + m1 * acc[ai][bj][m][1];
                    acc[ai][bj][m][0] = v0; acc[ai][bj][m][1] = v1;
                    ss[ai][m] += (v0[0] * v0[0] + v0[1] * v0[1]) + (v0[2] * v0[2] + v0[3] * v0[3]) + (v1[0] * v1[0] + v1[1] * v1[1]) + (v1[2] * v1[2] + v1[3] * v1[3]);
                    asm volatile("" ::: "memory"); } }
#pragma unroll
        for (int ai = 0; ai < 2; ++ai)
#pragma unroll
            for (int m = 0; m < 4; ++m) { float s = ss[ai][m]; s += __shfl_xor(s, 16); s += __shfl_xor(s, 32); ss[ai][m] = s; }
        if (fq == 0) {
#pragma unroll
            for (int ai = 0; ai < 2; ++ai)
#pragma unroll
                for (int m = 0; m < 4; ++m) red[(ai * 128 + wr * 64 + m * 16 + fr) * 4 + wc] = ss[ai][m]; }
        __syncthreads();
        float* myslot = slots + (size_t)(u.pm * 4 + u.pn) * 256;
        if (tid < 256) myslot[tid] = (red[tid * 4 + 0] + red[tid * 4 + 1]) + (red[tid * 4 + 2] + red[tid * 4 + 3]);
        asm volatile("s_waitcnt vmcnt(0)" ::: "memory");
        __syncthreads();
        unsigned* flag = flags + u.pm * 16;
        if (tid == 0) { __builtin_amdgcn_fence(__ATOMIC_RELEASE, "agent"); asm volatile("s_waitcnt vmcnt(0)" ::: "memory");
            __hip_atomic_fetch_add(flag, 1u, __ATOMIC_RELAXED, __HIP_MEMORY_SCOPE_AGENT);
            unsigned spins = 0;
            while (__hip_atomic_load(flag, __ATOMIC_RELAXED, __HIP_MEMORY_SCOPE_AGENT) < 4u && ++spins < (1u << 22)) __builtin_amdgcn_s_sleep(2);
            __builtin_amdgcn_fence(__ATOMIC_ACQUIRE, "agent"); asm volatile("s_waitcnt vmcnt(0)" ::: "memory"); }
        __syncthreads();
        if (tid < 256) { const float* sl = slots + (size_t)(u.pm * 4) * 256 + tid;
            const float tot = (sl[0] + sl[256]) + (sl[512] + sl[768]);
            rin[tid] = rsqrtf(tot * (1.f / DM) + EPSN); }
        __syncthreads();
#pragma unroll
        for (int bj = 0; bj < 2; ++bj) { const int col = col0 + bj * 128;
            const f32x4 g0 = *(const f32x4*)(fg + col), g1 = *(const f32x4*)(fg + col + 4);
#pragma unroll
            for (int ai = 0; ai < 2; ++ai)
#pragma unroll
                for (int m = 0; m < 4; ++m) { const float r = rin[ai * 128 + wr * 64 + m * 16 + fr]; const size_t o = (size_t)(row0 + ai * 128 + m * 16) * 1024 + col;
                    *(f32x4*)(xio + o) = acc[ai][bj][m][0] * r * g0; *(f32x4*)(xio + o + 4) = acc[ai][bj][m][1] * r * g1;
                    asm volatile("" ::: "memory"); } }
    }
};

__device__ __forceinline__ void transpose_item(const float* W, int K, int N, bf16* WT, LAS float* scr, int item, int lane) {
    const int nblk = N / 32, kb = item / nblk, nb = item % nblk, k0 = 64 * kb, n0 = 32 * nb;
#pragma unroll 8
    for (int i = 0; i < 32; ++i) { const int kk = 2 * i + (lane >> 5); scr[kk * 33 + (lane & 31)] = W[(size_t)(k0 + kk) * N + n0 + (lane & 31)]; }
    asm volatile("s_waitcnt lgkmcnt(0)" ::: "memory");
    const int c = lane & 7;
#pragma unroll
    for (int j = 0; j < 4; ++j) { const int n = (lane >> 3) + 8 * j; const LAS float* s = scr + (8 * c) * 33 + n;
        u32x4 o; o.x = pk2(s[0 * 33], s[1 * 33]); o.y = pk2(s[2 * 33], s[3 * 33]); o.z = pk2(s[4 * 33], s[5 * 33]); o.w = pk2(s[6 * 33], s[7 * 33]);
        *(u32x4*)(WT + (size_t)(n0 + n) * K + k0 + 8 * c) = o; }
    asm volatile("s_waitcnt lgkmcnt(0)" ::: "memory");
}

template <bool MOD>
__device__ __forceinline__ void norm_rows(const float* srcA, const float* srcB, int nA, const float* g, const float* mx, int shift_mod, int scale_mod,
                                          bf16* outb, float* outf, int r0, int nr, int lane) {
    f32x4 G[4], SH[4], cur[4], nxt[4];
    int curmod = -1;
    { const float* s0 = (r0 < nA) ? srcA + (size_t)r0 * DM : srcB + (size_t)(r0 - nA) * DM;
#pragma unroll
      for (int j = 0; j < 4; ++j) cur[j] = *(const f32x4*)(s0 + (lane + 64 * j) * 4); }
#pragma unroll 1
    for (int i = 0; i < nr; ++i) {
        const int m = r0 + i;
        if (i + 1 < nr) { const int m1 = m + 1; const float* s1 = (m1 < nA) ? srcA + (size_t)m1 * DM : srcB + (size_t)(m1 - nA) * DM;
#pragma unroll
            for (int j = 0; j < 4; ++j) nxt[j] = *(const f32x4*)(s1 + (lane + 64 * j) * 4); }
        const int mr = MOD ? ((m < nA) ? (m >> 11) : 8) : 0;
        if (mr != curmod) { curmod = mr;
#pragma unroll
            for (int j = 0; j < 4; ++j) { const int e = (lane + 64 * j) * 4; const f32x4 gg = *(const f32x4*)(g + e);
                if (MOD) { const f32x4 sc = *(const f32x4*)(mx + (size_t)mr * (NMOD * DM) + scale_mod * DM + e); SH[j] = *(const f32x4*)(mx + (size_t)mr * (NMOD * DM) + shift_mod * DM + e); G[j] = gg * (sc + 1.f); }
                else { G[j] = gg; SH[j] = (f32x4){0.f, 0.f, 0.f, 0.f}; } } }
        float s = 0.f;
#pragma unroll
        for (int j = 0; j < 4; ++j) s += (cur[j][0] * cur[j][0] + cur[j][1] * cur[j][1]) + (cur[j][2] * cur[j][2] + cur[j][3] * cur[j][3]);
        const float rinv = rsqrtf(wave_sum(s) * (1.f / DM) + EPSN);
#pragma unroll
        for (int j = 0; j < 4; ++j) { const int e = (lane + 64 * j) * 4; const f32x4 h = cur[j] * rinv * G[j] + SH[j];
            if (MOD) { u32x2 w; w.x = pk2(h[0], h[1]); w.y = pk2(h[2], h[3]); *(u32x2*)(outb + (size_t)m * DM + e) = w; }
            else *(f32x4*)(outf + (size_t)m * DM + e) = h; }
#pragma unroll
        for (int j = 0; j < 4; ++j) cur[j] = nxt[j];
    }
}

__device__ __forceinline__ void phase0(const Params& p, unsigned char* lds, int tid, int lane, int wave, int G, const int part) {
    float* ldsf = (float*)lds;
    float* mxo = (float*)(p.ws + WS_MX);
    if (part == 0) {
    for (int it = blockIdx.x; it < 192; it += G) {
        __syncthreads();
        {
            const float* c = p.in[1]; const float* cc = p.in[3]; const float* aw = p.in[4]; const float* ab = p.in[5];
            float* sc = ldsf;
            float* red = ldsf + 9 * 1024;
            for (int i = tid; i < 9 * 1024; i += NTHR) { const int r = i >> 10, k = i & 1023; const float cv = (r < 8) ? c[r * 1024 + k] : cc[k]; sc[i] = cv / (1.f + __expf(-cv)); }
            __syncthreads();
            const int n0 = it * 32, col = tid & 31, ks = tid >> 5;
            float a[9];
#pragma unroll
            for (int r = 0; r < 9; ++r) a[r] = 0.f;
            for (int k = ks * 64; k < ks * 64 + 64; ++k) { const float w = aw[(size_t)k * (NMOD * DM) + n0 + col];
#pragma unroll
                for (int r = 0; r < 9; ++r) a[r] += sc[r * 1024 + k] * w; }
#pragma unroll
            for (int r = 0; r < 9; ++r) red[(ks * 9 + r) * 32 + col] = a[r];
            __syncthreads();
            if (tid < 288) { const int r = tid >> 5, cl = tid & 31; float s = ab[n0 + cl];
                for (int k2 = 0; k2 < 16; ++k2) s += red[(k2 * 9 + r) * 32 + cl];
                mxo[r * (NMOD * DM) + n0 + cl] = s; }
        }
    }
    __syncthreads();
    { bf16* tch = (bf16*)(p.ws + WS_TCH); bf16* wfs = (bf16*)(p.ws + WS_WFS); const float* win = p.in[7];
      for (int i = blockIdx.x * NTHR + tid; i < 1024 * 64; i += G * NTHR) { const int n = i >> 6, c8 = (i & 63) * 8, gn = (n & 511) >> 7, j = n & 127; float vv[8];
#pragma unroll
          for (int e = 0; e < 8; ++e) { const int cp = c8 + e, idx = ((cp & 127) * j) & 127; const float ang = (float)idx * (1.f / 64.f);
              vv[e] = ((cp >> 7) == gn) ? ((n < 512) ? cospif(ang) : sinpif(ang)) : 0.f; }
          u32x4 w; w.x = pk2(vv[0], vv[1]); w.y = pk2(vv[2], vv[3]); w.z = pk2(vv[4], vv[5]); w.w = pk2(vv[6], vv[7]);
          *(u32x4*)(tch + (size_t)n * 512 + c8) = w;
          const f32x4 a = *(const f32x4*)(win + (size_t)n * INDIM + c8), b2 = *(const f32x4*)(win + (size_t)n * INDIM + c8 + 4);
          *(u32x4*)(wfs + (size_t)n * 512 + c8) = pack8(a, b2); } }
    }
    if (part == 0 && blockIdx.x == G - 1) { const float* hl = p.in[8]; float* lbo = (float*)(p.ws + WS_LB);
        if (tid < 512) { const float a = hl[tid], b = hl[512 + tid]; lbo[tid] = 1.f / (1.f + expf(b - a)); } }
    if (part == 0) return;
    { bf16* cs = (bf16*)(p.ws + WS_CS);
      for (int i = blockIdx.x * NTHR + tid; i < 2 * 1024 * 256; i += G * NTHR) { const int eo = i >> 18, l = (i >> 8) & 1023, kc = (i & 255) * 8; float vv[8];
#pragma unroll
          for (int e = 0; e < 8; ++e) { const int k = kc + e, sn = k >> 10, m = k & 1023;
              const float ang = eo ? (float)((l * (2 * m + 1)) & 2047) * (1.f / 1024.f) : (float)((l * m) & 1023) * (1.f / 512.f);
              vv[e] = sn ? -sinpif(ang) : cospif(ang); }
          u32x4 w; w.x = pk2(vv[0], vv[1]); w.y = pk2(vv[2], vv[3]); w.z = pk2(vv[4], vv[5]); w.w = pk2(vv[6], vv[7]);
          *(u32x4*)(cs + ((size_t)eo * 1024 + l) * 2048 + kc) = w; } }
    { LAS float* scr = (LAS float*)((LAS unsigned char*)lds + wave * 16384);
      const int gw = blockIdx.x * NWAVES + wave, NGW = G * NWAVES;
      constexpr int I_IN = 16 * 160, I_A = 8 * 32, I_B = 8 * 32, I_O = 16 * 32;
      for (int it = gw; it < ((G >= 192) ? I_IN : I_IN + I_A + I_B + I_O); it += NGW) { int r = it;
          if (r < I_IN) { transpose_item(p.in[7], 1024, INDIM, (bf16*)(p.ws + WS_WIN), scr, r, lane); continue; } r -= I_IN;
          if (r < I_A) { transpose_item(p.in[10], 512, 1024, (bf16*)(p.ws + WS_WA), scr, r, lane); continue; } r -= I_A;
          if (r < I_B) { transpose_item(p.in[11], 512, 1024, (bf16*)(p.ws + WS_WB), scr, r, lane); continue; } r -= I_B;
          transpose_item(p.in[12], 1024, 1024, (bf16*)(p.ws + WS_WOUT), scr, r, lane); } }
}

__device__ __forceinline__ void hgrn_mfma_item(const Params& p, unsigned char* lds, int item) {
    int tid_ = threadIdx.x; asm volatile("" : "+v"(tid_));
    const int tid = tid_, lane = tid & 63, w = __builtin_amdgcn_readfirstlane(tid >> 6), fr = lane & 15, fq = lane >> 4;
    const int vh = item & 1, dir = (item >> 1) & 1, h = (item >> 2) & 3, b = item >> 4;
    bf16* Qs = (bf16*)lds;
    bf16* Ks = Qs + 64 * 136;
    bf16* St = Ks + 64 * 136;
    bf16* Kh = St + 2 * 64 * 136;
    bf16* Vt = Kh + 128 * 72;
    bf16* Ps = Vt + 64 * 72;
    float* Et = (float*)(Ps + 64 * 72);
    float* Fr = Et + 128;
    float* Bt = Fr + 64 * 132;
    const int d = 16 * w + fr;
    const float* fL = p.out + (dir ? (size_t)MTOK * 512 : 0) + (size_t)b * SEQ * 512 + h * 128;
    const float* fC = (const float*)(p.ws + (dir ? WS_GBC : WS_GFC)) + (size_t)b * CTXL * 512 + h * 128;
    const bf16* qL = (const bf16*)(p.ws + WS_Q) + (size_t)b * SEQ * 512 + h * 128;
    const bf16* vL = (const bf16*)(p.ws + WS_V) + (size_t)b * SEQ * 512 + h * 128 + vh * 64;
    const bf16* vC = (const bf16*)(p.ws + WS_VC) + (size_t)b * CTXL * 512 + h * 128 + vh * 64;
    bf16* oL = (bf16*)(p.ws + (dir ? WS_OB : WS_OF)) + (size_t)b * SEQ * 512 + h * 128 + vh * 64;
    f32x4 Sa[4];
#pragma unroll
    for (int i = 0; i < 4; ++i) Sa[i] = (f32x4){0.f, 0.f, 0.f, 0.f};
    f32x2 fR2[8]; unsigned qR1[8]; u32x4 vR;
#define HG_LOAD(cc_) do { const int _cc = (cc_); const bool _lat = _cc >= 4; const int _c = _lat ? _cc - 4 : _cc, _n = _lat ? SEQ : CTXL; \
        const float* _f = _lat ? fL : fC; const bf16* _v = _lat ? vL : vC; \
        _Pragma("unroll") for (int i = 0; i < 8; ++i) { const int _s = _c * 64 + 8 * w + i, _pos = dir ? (_n - 1 - _s) : _s; fR2[i] = *(const f32x2*)(_f + (size_t)_pos * 512 + 2 * lane); \
            qR1[i] = _lat ? *(const unsigned*)(qL + (size_t)_pos * 512 + 2 * lane) : 0u; } \
        { const int _s = _c * 64 + lane, _pos = dir ? (_n - 1 - _s) : _s; vR = *(const u32x4*)(_v + (size_t)_pos * 512 + w * 8); } } while (0)
#define HG_BT() do { *(f32x2*)(Bt + w * 128 + 2 * lane) = ((fR2[0] * fR2[1]) * (fR2[2] * fR2[3])) * ((fR2[4] * fR2[5]) * (fR2[6] * fR2[7])); } while (0)
    HG_LOAD(0);
    HG_BT();
    __syncthreads();
    for (int cc = 0; cc < 36; ++cc) {
        const bool lat = cc >= 4; const int c = lat ? cc - 4 : cc;
        bf16* Scur = St + (cc & 1) * (64 * 136); bf16* Snxt = St + ((cc & 1) ^ 1) * (64 * 136);
        {
            f32x2 cum = (f32x2){1.f, 1.f};
            { f32x2 t[7];
#pragma unroll
              for (int i = 0; i < 7; ++i) t[i] = *(const f32x2*)(Bt + i * 128 + 2 * lane);
#pragma unroll
              for (int i = 0; i < 7; ++i) if (i < w) cum = cum * t[i]; }
            unsigned kp0[4], kp1[4];
#pragma unroll
            for (int i = 0; i < 8; i += 2) { float k0v[2], k1v[2];
#pragma unroll
                for (int u = 0; u < 2; ++u) { const int r = 8 * w + i + u; const f32x2 f = fR2[i + u]; cum = cum * f;
                    const float cm0 = fmaxf(cum[0], 1e-30f), cm1 = fmaxf(cum[1], 1e-30f);
                    const float kt0 = (1.f - f[0]) * __builtin_amdgcn_rcpf(cm0), kt1 = (1.f - f[1]) * __builtin_amdgcn_rcpf(cm1);
                    if (lat) { const unsigned qr = qR1[i + u];
                        *(unsigned*)(Qs + r * 136 + 2 * lane) = hwpk2(bflo(qr) * cm0, bfhi(qr) * cm1); *(unsigned*)(Ks + r * 136 + 2 * lane) = hwpk2(kt0, kt1); }
                    k0v[u] = kt0; k1v[u] = kt1; }
                kp0[i >> 1] = hwpk2(k0v[0], k0v[1]); kp1[i >> 1] = hwpk2(k1v[0], k1v[1]); }
            u32x4 q0; q0.x = kp0[0]; q0.y = kp0[1]; q0.z = kp0[2]; q0.w = kp0[3]; u32x4 q1; q1.x = kp1[0]; q1.y = kp1[1]; q1.z = kp1[2]; q1.w = kp1[3];
            *(u32x4*)(Kh + (2 * lane) * 72 + 8 * w) = q0; *(u32x4*)(Kh + (2 * lane + 1) * 72 + 8 * w) = q1;
            if (w == 7) *(f32x2*)(Et + 2 * lane) = cum;
            Vt[(8 * w + 0) * 72 + lane] = (bf16)(vR.x & 0xffffu); Vt[(8 * w + 1) * 72 + lane] = (bf16)(vR.x >> 16); Vt[(8 * w + 2) * 72 + lane] = (bf16)(vR.y & 0xffffu); Vt[(8 * w + 3) * 72 + lane] = (bf16)(vR.y >> 16);
            Vt[(8 * w + 4) * 72 + lane] = (bf16)(vR.z & 0xffffu); Vt[(8 * w + 5) * 72 + lane] = (bf16)(vR.z >> 16); Vt[(8 * w + 6) * 72 + lane] = (bf16)(vR.w & 0xffffu); Vt[(8 * w + 7) * 72 + lane] = (bf16)(vR.w >> 16);
        }
        if (cc + 1 < 36) HG_LOAD(cc + 1);
        __syncthreads();
        const int ti = w >> 1, x2 = 2 * (w & 1);
        pg8::bf16x8 bqf[4];
        if (lat) {
#pragma unroll
            for (int kk = 0; kk < 4; ++kk) bqf[kk] = *(const pg8::bf16x8*)(Qs + (ti * 16 + fr) * 136 + kk * 32 + fq * 8);
#pragma unroll
            for (int u2 = 0; u2 < 2; ++u2) { const int si = x2 + u2; f32x4 acc = (f32x4){0.f, 0.f, 0.f, 0.f};
                if (si <= ti) {
#pragma unroll
                    for (int kk = 0; kk < 4; ++kk) { const pg8::bf16x8 a = *(const pg8::bf16x8*)(Ks + (si * 16 + fr) * 136 + kk * 32 + fq * 8);
                        acc = __builtin_amdgcn_mfma_f32_16x16x32_bf16(a, bqf[kk], acc, 0, 0, 0); }
                    const bool diag = (si == ti);
#pragma unroll
                    for (int r = 0; r < 4; ++r) acc[r] = (diag && (4 * fq + r > fr)) ? 0.f : acc[r]; }
                u32x2 pw; pw.x = hwpk2(acc[0], acc[1]); pw.y = hwpk2(acc[2], acc[3]);
                *(u32x2*)(Ps + (ti * 16 + fr) * 72 + si * 16 + 4 * fq) = pw; }
        }
        pg8::bf16x8 kv0[2], kv1[2];
#pragma unroll
        for (int kk = 0; kk < 2; ++kk) { kv0[kk] = (pg8::bf16x8){0, 0, 0, 0, 0, 0, 0, 0}; kv1[kk] = kv0[kk]; }
        {
            const f32x4 et = *(const f32x4*)(Et + w * 16 + 4 * fq);
            pg8::bf16x8 ka[2];
#pragma unroll
            for (int kk = 0; kk < 2; ++kk) ka[kk] = *(const pg8::bf16x8*)(Kh + (w * 16 + fr) * 72 + kk * 32 + fq * 8);
#pragma unroll
            for (int vi = 0; vi < 4; ++vi) {
#pragma unroll
                for (int kk = 0; kk < 2; ++kk) { const pg8::bf16x8 bv = *(const pg8::bf16x8*)(Vt + (vi * 16 + fr) * 72 + kk * 32 + fq * 8);
                    if (vi == x2) kv0[kk] = bv;
                    if (vi == x2 + 1) kv1[kk] = bv;
                    Sa[vi] = __builtin_amdgcn_mfma_f32_16x16x32_bf16(ka[kk], bv, Sa[vi], 0, 0, 0); }
                Sa[vi] = Sa[vi] * et;
                u32x2 sw; sw.x = hwpk2(Sa[vi][0], Sa[vi][1]); sw.y = hwpk2(Sa[vi][2], Sa[vi][3]);
                *(u32x2*)(Snxt + (vi * 16 + fr) * 136 + w * 16 + 4 * fq) = sw; }
        }
        f32x4 Oa[2];
        Oa[0] = (f32x4){0.f, 0.f, 0.f, 0.f}; Oa[1] = (f32x4){0.f, 0.f, 0.f, 0.f};
        if (lat) {
#pragma unroll
            for (int kk = 0; kk < 4; ++kk) {
#pragma unroll
                for (int u2 = 0; u2 < 2; ++u2) { const pg8::bf16x8 a = *(const pg8::bf16x8*)(Scur + ((x2 + u2) * 16 + fr) * 136 + kk * 32 + fq * 8);
                    Oa[u2] = __builtin_amdgcn_mfma_f32_16x16x32_bf16(a, bqf[kk], Oa[u2], 0, 0, 0); } }
        }
        if (cc + 1 < 36) HG_BT();
        __syncthreads();
        if (lat) {
#pragma unroll
            for (int kk = 0; kk < 2; ++kk) { const pg8::bf16x8 bp = *(const pg8::bf16x8*)(Ps + (ti * 16 + fr) * 72 + kk * 32 + fq * 8);
#pragma unroll
                for (int u2 = 0; u2 < 2; ++u2) { const pg8::bf16x8 a = u2 ? kv1[kk] : kv0[kk];
                    Oa[u2] = __builtin_amdgcn_mfma_f32_16x16x32_bf16(a, bp, Oa[u2], 0, 0, 0); } }
            const int sg = c * 64 + ti * 16 + fr, pos = dir ? (SEQ - 1 - sg) : sg;
#pragma unroll
            for (int u2 = 0; u2 < 2; ++u2) { u32x2 ow; ow.x = hwpk2(Oa[u2][0], Oa[u2][1]); ow.y = hwpk2(Oa[u2][2], Oa[u2][3]);
                *(u32x2*)(oL + (size_t)pos * 512 + (x2 + u2) * 16 + 4 * fq) = ow; }
        }
    }
    __syncthreads();
#undef HG_LOAD
#undef HG_BT
}

__device__ __forceinline__ void phase_yh(const Params& p, int lane, int gw, int NGW) {
    const bf16* of = (const bf16*)(p.ws + WS_OF); const bf16* ob = (const bf16*)(p.ws + WS_OB); const bf16* og = (const bf16*)(p.ws + WS_OG);
    bf16* yh = (bf16*)(p.ws + WS_YH); const float* on = p.in[9];
    const f32x4 n0 = *(const f32x4*)(on + lane * 8), n1 = *(const f32x4*)(on + lane * 8 + 4);
    const int per = (MTOK + NGW - 1) / NGW, r0 = gw * per, nr = min(per, MTOK - r0);
    if (nr <= 0) return;
    u32x4 a = *(const u32x4*)(of + (size_t)r0 * 512 + lane * 8), b = *(const u32x4*)(ob + (size_t)r0 * 512 + lane * 8), gg = *(const u32x4*)(og + (size_t)r0 * 512 + lane * 8);
#pragma unroll 1
    for (int i = 0; i < nr; ++i) { const size_t o = (size_t)(r0 + i) * 512 + lane * 8;
        u32x4 a1 = a, b1 = b, g1 = gg;
        if (i + 1 < nr) { a1 = *(const u32x4*)(of + o + 512); b1 = *(const u32x4*)(ob + o + 512); g1 = *(const u32x4*)(og + o + 512); }
        float v[8]; v[0] = bflo(a.x) + bflo(b.x); v[1] = bfhi(a.x) + bfhi(b.x); v[2] = bflo(a.y) + bflo(b.y); v[3] = bfhi(a.y) + bfhi(b.y);
        v[4] = bflo(a.z) + bflo(b.z); v[5] = bfhi(a.z) + bfhi(b.z); v[6] = bflo(a.w) + bflo(b.w); v[7] = bfhi(a.w) + bfhi(b.w);
        float s = 0.f;
#pragma unroll
        for (int k = 0; k < 8; ++k) s += v[k] * v[k];
        s += __shfl_xor(s, 1); s += __shfl_xor(s, 2); s += __shfl_xor(s, 4); s += __shfl_xor(s, 8);
        const float rinv = rsqrtf(s * (1.f / 128.f) + EPSN);
        float gv[8]; gv[0] = bflo(gg.x); gv[1] = bfhi(gg.x); gv[2] = bflo(gg.y); gv[3] = bfhi(gg.y); gv[4] = bflo(gg.z); gv[5] = bfhi(gg.z); gv[6] = bflo(gg.w); gv[7] = bfhi(gg.w);
        f32x4 q0, q1;
#pragma unroll
        for (int k = 0; k < 4; ++k) { q0[k] = v[k] * rinv * n0[k] * gv[k]; q1[k] = v[4 + k] * rinv * n1[k] * gv[4 + k]; }
        *(u32x4*)(yh + o) = pack8(q0, q1);
        a = a1; b = b1; gg = g1; }
}

struct ConvRaw { u32x2 a[3], g[3]; };
__device__ __forceinline__ void conv_issue(const bf16* z, int tokbase, int r, int cc, int ch, ConvRaw& q) {
#pragma unroll
    for (int i = 0; i < 3; ++i) { const int rr = r + i - 1;
        if (rr >= 0 && rr < 32 && cc >= 0 && cc < 64) { const size_t zo = (size_t)(tokbase + rr * 64 + cc) * DFF2 + ch;
            q.a[i] = *(const u32x2*)(z + zo); q.g[i] = *(const u32x2*)(z + zo + DFF);
        } else { q.a[i] = (u32x2){0u, 0u}; q.g[i] = (u32x2){0u, 0u}; } }
}
__device__ __forceinline__ void phase_conv(const Params& p, int hf, int tid, int G) {
    const bf16* z = (const bf16*)(p.ws + WS_Z); bf16* a2 = (bf16*)(p.ws + WS_A2) + (size_t)hf * 8192 * DFF;
    const float* cw = p.in[15]; const float* cb = p.in[16];
    for (int it = blockIdx.x * NTHR + tid; it < 4 * 32 * 4 * 704; it += G * NTHR) {
        const int cg4 = it % 704, rest = it / 704, strip = rest & 3, r = (rest >> 2) & 31, img = rest >> 7, ch = cg4 * 4, c0 = strip * 16, tokbase = img * 2048;
        ConvRaw ring[3];
#pragma unroll
        for (int j = 0; j < 3; ++j) conv_issue(z, tokbase, r, c0 - 1 + j, ch, ring[j]);
        f32x2 w1[9][2], w2[9][2];
#pragma unroll
        for (int t = 0; t < 9; ++t) { const f32x4 a = *(const f32x4*)(cw + (size_t)t * DFF2 + ch), g = *(const f32x4*)(cw + (size_t)t * DFF2 + DFF + ch);
            w1[t][0] = (f32x2){a[0], a[1]}; w1[t][1] = (f32x2){a[2], a[3]}; w2[t][0] = (f32x2){g[0], g[1]}; w2[t][1] = (f32x2){g[2], g[3]}; }
        const f32x4 b1 = *(const f32x4*)(cb + ch), b2 = *(const f32x4*)(cb + DFF + ch);
        f32x2 W1[3][3][2], W2[3][3][2];
#pragma unroll
        for (int j = 0; j < 18; ++j) {
            const int sl = j % 3;
#pragma unroll
            for (int i = 0; i < 3; ++i) { const u32x2 a = ring[j % 3].a[i], g = ring[j % 3].g[i];
                W1[sl][i][0] = (f32x2){bflo(a.x), bfhi(a.x)}; W1[sl][i][1] = (f32x2){bflo(a.y), bfhi(a.y)};
                W2[sl][i][0] = (f32x2){bflo(g.x), bfhi(g.x)}; W2[sl][i][1] = (f32x2){bflo(g.y), bfhi(g.y)}; }
            if (j + 3 < 18) conv_issue(z, tokbase, r, c0 - 1 + j + 3, ch, ring[j % 3]);
            if (j >= 2) {
                const int sL = (j - 2) % 3, sC = (j - 1) % 3, sR = j % 3;
                f32x2 o1[2], o2[2];
                o1[0] = (f32x2){b1[0], b1[1]}; o1[1] = (f32x2){b1[2], b1[3]}; o2[0] = (f32x2){b2[0], b2[1]}; o2[1] = (f32x2){b2[2], b2[3]};
#pragma unroll
                for (int i = 0; i < 3; ++i)
#pragma unroll
                    for (int e = 0; e < 2; ++e) {
                        o1[e] = __builtin_elementwise_fma(W1[sL][i][e], w1[i * 3 + 0][e], o1[e]); o1[e] = __builtin_elementwise_fma(W1[sC][i][e], w1[i * 3 + 1][e], o1[e]); o1[e] = __builtin_elementwise_fma(W1[sR][i][e], w1[i * 3 + 2][e], o1[e]);
                        o2[e] = __builtin_elementwise_fma(W2[sL][i][e], w2[i * 3 + 0][e], o2[e]); o2[e] = __builtin_elementwise_fma(W2[sC][i][e], w2[i * 3 + 1][e], o2[e]); o2[e] = __builtin_elementwise_fma(W2[sR][i][e], w2[i * 3 + 2][e], o2[e]); }
                u32x2 ow; ow.x = pk2(siluf_(o1[0][0]) * o2[0][0], siluf_(o1[0][1]) * o2[0][1]); ow.y = pk2(siluf_(o1[1][0]) * o2[1][0], siluf_(o1[1][1]) * o2[1][1]);
                *(u32x2*)(a2 + (size_t)(tokbase + r * 64 + c0 + j - 2) * DFF + ch) = ow;
            }
        }
    }
}

__device__ __forceinline__ void phase_conv_lds(const Params& p, int hf, unsigned char* lds, int G) {
    int t_ = threadIdx.x; asm volatile("" : "+v"(t_));
    const int tid = t_;
    bf16* ring = (bf16*)lds;
    const bf16* z = (const bf16*)(p.ws + WS_Z); bf16* a2 = (bf16*)(p.ws + WS_A2) + (size_t)hf * 8192 * DFF;
    const float* cw = p.in[15]; const float* cb = p.in[16];
    const int ch4 = (tid & 15) * 4, c0 = (tid >> 4) * 2;
    __syncthreads();
    for (int i = tid; i < 4 * 2 * 80; i += NTHR) { const int slot = i / 160, rem = i % 160, side = rem / 80, wd = rem % 80;
        ((unsigned*)(ring + ((size_t)(slot * 66 + side * 65)) * 160))[wd] = 0u; }
    const int per = (5632 + G - 1) / G; int ucur = blockIdx.x * per; const int uend = min(ucur + per, 5632);
    while (ucur < uend) {
        const int colid = ucur >> 5, r0 = ucur & 31, n = min(32 - r0, uend - ucur), cbk = colid % 44, img = colid / 44, tokbase = img * 2048, chb = cbk * 64;
        ucur += n;
        f32x2 w1[9][2], w2[9][2];
#pragma unroll
        for (int t = 0; t < 9; ++t) { const f32x4 a = *(const f32x4*)(cw + (size_t)t * DFF2 + chb + ch4), g = *(const f32x4*)(cw + (size_t)t * DFF2 + DFF + chb + ch4);
            w1[t][0] = (f32x2){a[0], a[1]}; w1[t][1] = (f32x2){a[2], a[3]}; w2[t][0] = (f32x2){g[0], g[1]}; w2[t][1] = (f32x2){g[2], g[3]}; }
        const f32x4 b1 = *(const f32x4*)(cb + chb + ch4), b2 = *(const f32x4*)(cb + DFF + chb + ch4);
        u32x4 stA[2], stB[2];
#define CV_LOAD(ST, row_) do { const int _r = (row_); _Pragma("unroll") for (int k_ = 0; k_ < 2; ++k_) { const int _q = tid + 512 * k_, _col = _q >> 4, _path = (_q >> 3) & 1, _c8 = (_q & 7) * 8; \
            ST[k_] = (_r >= 0 && _r < 32) ? *(const u32x4*)(z + (size_t)(tokbase + _r * 64 + _col) * DFF2 + _path * DFF + chb + _c8) : (u32x4){0u, 0u, 0u, 0u}; } } while (0)
#define CV_STORE(ST, slot_) do { const int _sl = (slot_); _Pragma("unroll") for (int k_ = 0; k_ < 2; ++k_) { const int _q = tid + 512 * k_, _col = _q >> 4, _path = (_q >> 3) & 1, _c8 = (_q & 7) * 8; \
            *(u32x4*)(ring + ((size_t)(_sl * 66 + _col + 1)) * 160 + _path * 64 + _c8) = ST[k_]; } } while (0)
#define CV_COMPUTE(i_) do { const int _i = (i_); \
            f32x2 o1[2][2], o2[2][2]; \
            _Pragma("unroll") for (int oc = 0; oc < 2; ++oc) { o1[oc][0] = (f32x2){b1[0], b1[1]}; o1[oc][1] = (f32x2){b1[2], b1[3]}; o2[oc][0] = (f32x2){b2[0], b2[1]}; o2[oc][1] = (f32x2){b2[2], b2[3]}; } \
            _Pragma("unroll") for (int rr = 0; rr < 3; ++rr) { const int slot = (_i + rr) & 3; \
                const bf16* base = ring + ((size_t)(slot * 66 + c0)) * 160 + ch4; \
                _Pragma("unroll") for (int cc = 0; cc < 4; ++cc) { const u32x2 a = *(const u32x2*)(base + cc * 160), g = *(const u32x2*)(base + cc * 160 + 64); \
                    const f32x2 a0 = (f32x2){bflo(a.x), bfhi(a.x)}, a1 = (f32x2){bflo(a.y), bfhi(a.y)}, g0 = (f32x2){bflo(g.x), bfhi(g.x)}, g1 = (f32x2){bflo(g.y), bfhi(g.y)}; \
                    _Pragma("unroll") for (int oc = 0; oc < 2; ++oc) { const int dj = cc - oc; \
                        if (dj >= 0 && dj < 3) { const int t = rr * 3 + dj; \
                            o1[oc][0] = __builtin_elementwise_fma(a0, w1[t][0], o1[oc][0]); o1[oc][1] = __builtin_elementwise_fma(a1, w1[t][1], o1[oc][1]); \
                            o2[oc][0] = __builtin_elementwise_fma(g0, w2[t][0], o2[oc][0]); o2[oc][1] = __builtin_elementwise_fma(g1, w2[t][1], o2[oc][1]); } } } } \
            _Pragma("unroll") for (int oc = 0; oc < 2; ++oc) { u32x2 ow; ow.x = pk2(siluf_(o1[oc][0][0]) * o2[oc][0][0], siluf_(o1[oc][0][1]) * o2[oc][0][1]); ow.y = pk2(siluf_(o1[oc][1][0]) * o2[oc][1][0], siluf_(o1[oc][1][1]) * o2[oc][1][1]); \
                *(u32x2*)(a2 + (size_t)(tokbase + (r0 + _i) * 64 + c0 + oc) * DFF + chb + ch4) = ow; } } while (0)
        __syncthreads();
        CV_LOAD(stA, r0 - 1); CV_STORE(stA, 0); CV_LOAD(stA, r0); CV_STORE(stA, 1); CV_LOAD(stA, r0 + 1); CV_STORE(stA, 2);
        CV_LOAD(stA, r0 + 2);
        __syncthreads();
#pragma unroll 1
        for (int i = 0; i < n; i += 2) {
            CV_LOAD(stB, r0 + i + 3);
            CV_COMPUTE(i);
            CV_STORE(stA, (i + 3) & 3);
            __syncthreads();
            if (i + 1 < n) {
                CV_LOAD(stA, r0 + i + 4);
                CV_COMPUTE(i + 1);
                CV_STORE(stB, (i + 4) & 3);
                __syncthreads();
            }
        }
#undef CV_COMPUTE
#undef CV_LOAD
#undef CV_STORE
    }
}

__global__ void __launch_bounds__(NTHR, 2) fwd_mega(Params p) {
    extern __shared__ __attribute__((aligned(16))) unsigned char lds[];
    cg::grid_group grid = cg::this_grid();
    const int tid = threadIdx.x, lane = tid & 63, wave = __builtin_amdgcn_readfirstlane(tid >> 6);
    const int G = gridDim.x, gw = blockIdx.x * NWAVES + wave, NGW = G * NWAVES;
    PG8_LAS unsigned char* ldsl = (PG8_LAS unsigned char*)lds;
    unsigned char* ws = p.ws;
    const float* mx = (const float*)(ws + WS_MX);
    volatile LAS unsigned* misc = (volatile LAS unsigned*)((LAS unsigned char*)lds + MISC_OFF);
    if (tid < 16) misc[tid] = 0u;
    __syncthreads();
    const XcdBarrier xbar = xcd_barrier_post((unsigned*)(ws + WS_BAR), misc + 8);
    const unsigned long long t0_ = (PROBE_K >= 0) ? __builtin_amdgcn_s_memrealtime() : 0ull;
#define PROBE_POINT(k) do { if (PROBE_K == (k) && tid == 0) { const unsigned long long _n = __builtin_amdgcn_s_memrealtime(), _d = _n - t0_; while (__builtin_amdgcn_s_memrealtime() - _n < _d) __builtin_amdgcn_s_sleep(8); } } while (0)

    for (int rep_ = 0; rep_ < REPS(0); ++rep_) {
    phase0(p, lds, tid, lane, wave, G, 0);
    phase0(p, lds, tid, lane, wave, G, 1);
    xcd_barrier(xbar);
    if (G == 0x7fffffff) grid.sync();
    }
    for (int xs_ = 0; xs_ < EXTRA_SYNCS; ++xs_) xcd_barrier(xbar);
    PROBE_POINT(0);
    for (int rep_ = 0; rep_ < REPS(1); ++rep_) {
    if (blockIdx.x < 16 && G >= 16) {
        pg8::Gemm g{(const bf16*)(ws + WS_TCH), (const bf16*)(ws + WS_WFS), 512, 512, 512};
        pg8::StaticOrder S; S.init(4, 4, 16, blockIdx.x, 512, 512);
        pg8::Epi8<FUp> E{FUp{(bf16*)(ws + WS_WPQ), 1024}};
        pg8::gemm_phase<pg8::Epi8<FUp>, pg8::StaticOrder, true, true>(ldsl, g, S, E);
    }
    { const int skip = (G >= 32) ? 16 * NWAVES : 0, nw = NGW - skip, per = (MTOK + MCTX + nw - 1) / nw, r0 = (gw - skip) * per, nr = (gw < skip) ? 0 : min(per, MTOK + MCTX - r0);
      if (nr > 0) norm_rows<true>(p.in[0], p.in[2], MTOK, p.in[6], mx, 0, 1, (bf16*)(ws + WS_HX), nullptr, r0, nr, lane); }
    xcd_barrier(xbar);
    }
    PROBE_POINT(1);
    for (int rep_ = 0; rep_ < REPS(2); ++rep_) {
    {
        pg8::Gemm g{(const bf16*)(ws + WS_HX), (const bf16*)(ws + WS_WIN) + (size_t)512 * 1024, 1024, 1024, 1024};
        pg8::InOrder S; S.G = G; S.c = blockIdx.x; S.a_tile = (size_t)256 * 1024 * 2; S.b_tile = (size_t)256 * 1024 * 2;
        pg8::Epi8<FIn> E{FIn{ws, p.out}};
        pg8::gemm_phase<pg8::Epi8<FIn>, pg8::InOrder, true, true>(ldsl, g, S, E);
    }
    {
        pg8::Gemm g{(const bf16*)(ws + WS_WPQ), (const bf16*)(ws + WS_HX), 1024, 1024, 1024};
        pg8::StaticOrder S; S.init(4, 64, G, blockIdx.x, 1024, 1024);
        pg8::Epi8<FPQ> E{FPQ{(bf16*)(ws + WS_PQT)}};
        pg8::gemm_phase<pg8::Epi8<FPQ>, pg8::StaticOrder, true, true>(ldsl, g, S, E);
    }
    xcd_barrier(xbar);
    }
    PROBE_POINT(2);
    for (int rep_ = 0; rep_ < REPS(3); ++rep_) {
    if (blockIdx.x < 128 && G >= 192) {
        pg8::Gemm g{(const bf16*)(ws + WS_CS), (const bf16*)(ws + WS_PQT), 2048, 2048, 32768};
        pg8::DftOrder S; S.G = 128; S.c = blockIdx.x; S.a_tile = (size_t)256 * 2048 * 2; S.b_tile = (size_t)256 * 32768 * 2;
        EpiDft E{(bf16*)(ws + WS_YF), (unsigned*)(ws + WS_BAR + 16384)};
        pg8::gemm_phase<EpiDft, pg8::DftOrder, true, true>(ldsl, g, S, E);
        { int t2 = threadIdx.x; asm volatile("" : "+v"(t2));
          const int lane = t2 & 63, wave = __builtin_amdgcn_readfirstlane(t2 >> 6), gw = blockIdx.x * NWAVES + wave;
          LAS float* scr = (LAS float*)((LAS unsigned char*)lds + wave * 16384);
          constexpr int I_UP = 16 * 176, I_DN = 44 * 32;
          for (int it = gw; it < I_UP + I_DN; it += 128 * NWAVES) {
              if (it < I_UP) transpose_item(p.in[14], 1024, DFF2, (bf16*)(ws + WS_WUP), scr, it, lane);
              else transpose_item(p.in[17], DFF, 1024, (bf16*)(ws + WS_WDN), scr, it - I_UP, lane); }
          constexpr int I_A = 8 * 32, I_B = 8 * 32, I_O = 16 * 32;
          for (int it = gw; it < I_A + I_B + I_O; it += 128 * NWAVES) {
              if (it < I_A) transpose_item(p.in[10], 512, 1024, (bf16*)(ws + WS_WA), scr, it, lane);
              else if (it < I_A + I_B) transpose_item(p.in[11], 512, 1024, (bf16*)(ws + WS_WB), scr, it - I_A, lane);
              else transpose_item(p.in[12], 1024, 1024, (bf16*)(ws + WS_WOUT), scr, it - I_A - I_B, lane); } }
    } else if (G >= 192) {
        for (int it = blockIdx.x - 128; it < 128; it += G - 128) hgrn_mfma_item(p, lds, it);
    } else {
        pg8::Gemm g{(const bf16*)(ws + WS_CS), (const bf16*)(ws + WS_PQT), 2048, 2048, 32768};
        pg8::DftOrder S; S.G = G; S.c = blockIdx.x; S.a_tile = (size_t)256 * 2048 * 2; S.b_tile = (size_t)256 * 32768 * 2;
        EpiDft E{(bf16*)(ws + WS_YF), (unsigned*)(ws + WS_BAR + 16384)};
        pg8::gemm_phase<EpiDft, pg8::DftOrder, true, true>(ldsl, g, S, E);
        for (int it = blockIdx.x; it < 128; it += G) hgrn_mfma_item(p, lds, it);
    }
    xcd_barrier(xbar);
    }
    PROBE_POINT(3);
    for (int rep_ = 0; rep_ < REPS(4); ++rep_) {
    phase_yh(p, lane, gw, NGW);
    { LAS float* scr = (LAS float*)((LAS unsigned char*)lds + wave * 16384);
      constexpr int I_UP = 16 * 176, I_DN = 44 * 32;
      for (int it = (G >= 192) ? I_UP + I_DN : gw; it < I_UP + I_DN; it += NGW) {
          if (it < I_UP) transpose_item(p.in[14], 1024, DFF2, (bf16*)(ws + WS_WUP), scr, it, lane);
          else transpose_item(p.in[17], DFF, 1024, (bf16*)(ws + WS_WDN), scr, it - I_UP, lane); } }
    xcd_barrier(xbar);
    }
    PROBE_POINT(4);
    for (int rep_ = 0; rep_ < REPS(5); ++rep_) {
    if (G == 256) {
        pg8::f32x4 accm[2][2][4][2];
        {
            pg8::Gemm g{(const bf16*)(ws + WS_YF), (const bf16*)(ws + WS_WA), 512, 512, 512};
            pg8::StaticOrder S; S.init(64, 4, G, blockIdx.x, 512, 512);
            pg8::Epi8<FYab> E{FYab{(const bf16*)(ws + WS_GA), (const bf16*)(ws + WS_GBG)}};
            pg8::gemm_phase<pg8::Epi8<FYab>, pg8::StaticOrder, true, true, 1>(ldsl, g, S, E, &accm[0]);
        }
        {
            pg8::Gemm g{(const bf16*)(ws + WS_YH), (const bf16*)(ws + WS_WB), 512, 512, 512};
            pg8::StaticOrder S; S.init(64, 4, G, blockIdx.x, 512, 512);
            pg8::Epi8<FYb> E{FYb{(const bf16*)(ws + WS_GBG), (bf16*)(ws + WS_MRG)}};
            pg8::gemm_phase<pg8::Epi8<FYb>, pg8::StaticOrder, true, true, 2>(ldsl, g, S, E, &accm[0]);
        }
    } else {
    {
        pg8::Gemm g{(const bf16*)(ws + WS_YF), (const bf16*)(ws + WS_WA), 512, 512, 512};
        pg8::StaticOrder S; S.init(64, 4, G, blockIdx.x, 512, 512);
        pg8::Epi8<FYaT> E{FYaT{(const bf16*)(ws + WS_GA), (bf16*)(ws + WS_TMP)}};
        pg8::gemm_phase<pg8::Epi8<FYaT>, pg8::StaticOrder, true, true>(ldsl, g, S, E);
    }
    {
        pg8::Gemm g{(const bf16*)(ws + WS_YH), (const bf16*)(ws + WS_WB), 512, 512, 512};
        pg8::StaticOrder S; S.init(64, 4, G, blockIdx.x, 512, 512);
        pg8::Epi8<FYbT> E{FYbT{(const bf16*)(ws + WS_GBG), (const bf16*)(ws + WS_TMP), (bf16*)(ws + WS_MRG)}};
        pg8::gemm_phase<pg8::Epi8<FYbT>, pg8::StaticOrder, true, true>(ldsl, g, S, E);
    }
    }
    xcd_barrier(xbar);
    }
    PROBE_POINT(5);
    for (int rep_ = 0; rep_ < REPS(6); ++rep_) {
    {
        pg8::Gemm g{(const bf16*)(ws + WS_MRG), (const bf16*)(ws + WS_WOUT), 1024, 1024, 1024};
        pg8::StaticOrder S; S.init(64, 4, G, blockIdx.x, 1024, 1024);
        pg8::Epi8<FRes> E{FRes{p.in[0], p.out, mx, 2}};
        pg8::gemm_phase<pg8::Epi8<FRes>, pg8::StaticOrder, true, true>(ldsl, g, S, E);
    }
    xcd_barrier(xbar);
    }
    PROBE_POINT(6);
    for (int rep_ = 0; rep_ < REPS(7); ++rep_) {
    { const int per = (MTOK + NGW - 1) / NGW, r0 = gw * per, nr = min(per, MTOK - r0);
      if (nr > 0) norm_rows<true>(p.out, p.out, MTOK, p.in[13], mx, 3, 4, (bf16*)(ws + WS_H2), nullptr, r0, nr, lane); }
    xcd_barrier(xbar);
    }
    PROBE_POINT(7);
    {
    for (int hf = 0; hf < 2; ++hf) {
        for (int rep_ = 0; rep_ < REPS(8); ++rep_) {
            pg8::Gemm g{(const bf16*)(ws + WS_H2) + (size_t)hf * 8192 * 1024, (const bf16*)(ws + WS_WUP), 1024, 1024, 1024};
            pg8::StaticOrder S; S.init(32, 22, G, blockIdx.x, 1024, 1024);
            pg8::Epi8<FUp> E{FUp{(bf16*)(ws + WS_Z), DFF2}};
            pg8::gemm_phase<pg8::Epi8<FUp>, pg8::StaticOrder, true, true>(ldsl, g, S, E);
        xcd_barrier(xbar);
        }
        for (int rep_ = 0; rep_ < REPS(9); ++rep_) {
        phase_conv_lds(p, hf, lds, G);
        xcd_barrier(xbar);
        }
    }
    }
    PROBE_POINT(8);
    if (G == 256) {
        pg8::Gemm g{(const bf16*)(ws + WS_A2), (const bf16*)(ws + WS_WDN), DFF, DFF, DFF};
        pg8::StaticOrder S; S.init(64, 4, G, blockIdx.x, DFF, DFF);
        EpiFinal E{p.out, mx, p.in[18], (float*)(ws + WS_SLOT), (unsigned*)(ws + WS_BAR + 20480)};
        pg8::gemm_phase<EpiFinal, pg8::StaticOrder, true, true>(ldsl, g, S, E);
    } else {
    {
        pg8::Gemm g{(const bf16*)(ws + WS_A2), (const bf16*)(ws + WS_WDN), DFF, DFF, DFF};
        pg8::StaticOrder S; S.init(64, 4, G, blockIdx.x, DFF, DFF);
        pg8::Epi8<FRes> E{FRes{p.out, (float*)(ws + WS_XO), mx, 5}};
        pg8::gemm_phase<pg8::Epi8<FRes>, pg8::StaticOrder, true, true>(ldsl, g, S, E);
    }
    xcd_barrier(xbar);
    { const int per = (MTOK + NGW - 1) / NGW, r0 = gw * per, nr = min(per, MTOK - r0);
      if (nr > 0) norm_rows<false>((const float*)(ws + WS_XO), (const float*)(ws + WS_XO), MTOK, p.in[18], nullptr, 0, 0, nullptr, p.out, r0, nr, lane); }
    }
}

extern "C" void kernel_launch(void* const* d_in, const int* in_sizes, int n_in, void* d_out, int out_size, void* d_ws, size_t ws_size, hipStream_t stream) {
    static int grid = 0;
    if (grid == 0) {
        if (n_in != 19 || out_size != MTOK * DM || ws_size < WS_END) { fprintf(stderr, "kernel_launch: unexpected problem: n_in %d out %d ws %zu\n", n_in, out_size, ws_size); grid = -1; return; }
        int dev = 0, cus = 0, per_cu = 0;
        hipGetDevice(&dev);
        hipDeviceGetAttribute(&cus, hipDeviceAttributeMultiprocessorCount, dev);
        if (hipFuncSetAttribute((const void*)fwd_mega, hipFuncAttributeMaxDynamicSharedMemorySize, LDS_BYTES) != hipSuccess) { fprintf(stderr, "kernel_launch: hipFuncSetAttribute failed\n"); grid = -1; return; }
        if (hipOccupancyMaxActiveBlocksPerMultiprocessor(&per_cu, (const void*)fwd_mega, NTHR, LDS_BYTES) != hipSuccess || per_cu < 1) { fprintf(stderr, "kernel_launch: occupancy query says %d\n", per_cu); per_cu = 1; }
        (void)hipGetLastError();
        grid = cus * (per_cu > 1 ? 1 : per_cu);
        fprintf(stderr, "kernel_launch: grid %d (cus %d, per_cu %d), ws %zu\n", grid, cus, per_cu, ws_size);
    }
    if (grid < 0) return;
    Params p{};
    for (int i = 0; i < 19; ++i) p.in[i] = (const float*)d_in[i];
    p.out = (float*)d_out; p.ws = (unsigned char*)d_ws;
    if (hipMemsetAsync((char*)d_ws + WS_BAR, 0, BAR_BYTES, stream) != hipSuccess) { fprintf(stderr, "kernel_launch: memset failed\n"); return; }
    void* args[] = {&p};
    hipError_t e = hipLaunchCooperativeKernel((const void*)fwd_mega, dim3(grid), dim3(NTHR), args, LDS_BYTES, stream);
    if (e != hipSuccess) fprintf(stderr, "kernel_launch: cooperative launch failed: %s (grid %d)\n", hipGetErrorString(e), grid);
}
```

```cpp
#include <hip/hip_runtime.h>
#include <hip/hip_cooperative_groups.h>
#include <cstdio>
#include <cstdint>
namespace cg = cooperative_groups;

namespace pg8 {
#define PG8_LAS __attribute__((address_space(3)))
typedef unsigned short bf16_t;
typedef short bf16x8 __attribute__((ext_vector_type(8)));
typedef float f32x4 __attribute__((ext_vector_type(4)));
typedef unsigned u32x4 __attribute__((ext_vector_type(4)));
typedef unsigned u32x2 __attribute__((ext_vector_type(2)));
constexpr int BM = 256, BK = 64, HALF = 128, HTB = HALF * BK * 2  , STAGE_BYTES = 8 * HTB, NXCD = 8, WGM = 8;

__host__ __device__ __forceinline__ int lds_byte(int r, int c) { const int st = (r >> 4) * 2 + (c >> 5), rr = r & 15, cc = c & 31, ob = rr * 64 + cc * 2; return st * 1024 + (ob ^ (((ob >> 9) & 1) << 5)); }
__host__ __device__ __forceinline__ void stage_rc(int b, int& R, int& C) { const int st = b / 1024, sb = b % 1024, swz = sb ^ (((sb >> 9) & 1) << 5); R = (st >> 1) * 16 + swz / 64; C = (st & 1) * 32 + (swz % 64) / 2; }
__host__ __device__ __forceinline__ int perm32(int rho) { const int n = rho >> 4, i = rho & 15; return 8 * (i >> 2) + 4 * n + (i & 3); }

struct Unit { int pm, pn, z; };
struct Gemm { const bf16_t* A; const bf16_t* Bt; int K, lda, ldb; };

__device__ __forceinline__ void tile_of(int wgid, int nM, int nN, int& pm, int& pn) {
    const int nwg = nM * nN;
    { const int q = nwg / NXCD, r = nwg % NXCD, xcd = wgid % NXCD, off = wgid / NXCD; wgid = (xcd < r ? xcd * (q + 1) : r * (q + 1) + (xcd - r) * q) + off; }
    const int nig = WGM * nN, gid = wgid / nig, fm = gid * WGM, gsz = (nM - fm) < WGM ? (nM - fm) : WGM;
    pm = fm + ((wgid % nig) % gsz); pn = (wgid % nig) / gsz;
}
struct StaticOrder {
    int nM, nN, nwg, G, c; size_t a_tile, b_tile;
    __device__ __forceinline__ void init(int nM_, int nN_, int G_, int c_, int lda, int ldb) { nM = nM_; nN = nN_; nwg = nM * nN; G = G_; c = c_; a_tile = (size_t)BM * lda * 2; b_tile = (size_t)BM * ldb * 2; }
    __device__ __forceinline__ bool next(int i, Unit& u) const {
        const long L = (long)i * G + c; if (L >= nwg) return false;
        tile_of((int)L, nM, nN, u.pm, u.pn); u.z = 0; return true;
    }
    __device__ __forceinline__ size_t a_off(const Unit& u) const { return (size_t)u.pm * a_tile; }
    __device__ __forceinline__ size_t b_off(const Unit& u) const { return (size_t)u.pn * b_tile; }
};
struct OneOrder {
    int L, nM, nN; size_t a_tile, b_tile;
    __device__ __forceinline__ bool next(int i, Unit& u) const { if (i > 0) return false; tile_of(L, nM, nN, u.pm, u.pn); u.z = 0; return true; }
    __device__ __forceinline__ size_t a_off(const Unit& u) const { return (size_t)u.pm * a_tile; }
    __device__ __forceinline__ size_t b_off(const Unit& u) const { return (size_t)u.pn * b_tile; }
};
struct InOrder {
    int G, c; size_t a_tile, b_tile;
    __device__ __forceinline__ bool next(int i, Unit& u) const {
        const long L = (long)i * G + c; if (L >= 1152 + 48) return false;
        if (L < 1152) { tile_of((int)L, 64, 18, u.pm, u.pn); } else { const int j = (int)L - 1152; u.pm = 64 + (j & 7); u.pn = 2 + (j >> 3); }
        u.z = 0; return true;
    }
    __device__ __forceinline__ size_t a_off(const Unit& u) const { return (size_t)u.pm * a_tile; }
    __device__ __forceinline__ size_t b_off(const Unit& u) const { return (size_t)u.pn * b_tile; }
};
struct DftOrder {
    int G, c; size_t a_tile, b_tile;
    __device__ __forceinline__ bool next(int i, Unit& u) const {
        const long L = (long)i * G + c; if (L >= 128) return false;
        const int eo = (L < 64) ? 1 : 0, q = (int)L & 63;
        u.pn = q & 1; u.pm = (q >> 1) & 3; u.z = (q >> 3) | (eo << 8); return true;
    }
    __device__ __forceinline__ size_t a_off(const Unit& u) const { return (size_t)((u.z >> 8) * 4 + u.pm) * a_tile; }
    __device__ __forceinline__ size_t b_off(const Unit& u) const { return (size_t)u.pn * b_tile + ((size_t)(u.z & 255) * 4096 + (size_t)(u.z >> 8) * 2048) * 2; }
};

__device__ __forceinline__ unsigned cvt_pk_bf16(float lo, float hi) { unsigned r; asm volatile("v_cvt_pk_bf16_f32 %0, %1, %2" : "=v"(r) : "v"(lo), "v"(hi)); return r; }

template <class F> struct Epi8 {
    static constexpr bool PERM = true;
    F f;
    __device__ __forceinline__ void inplace(f32x4 (&acc)[2][2][4][2], const Unit& u, int wr, int wc, int fr, int fq) const {
        const int row0 = u.pm * BM + wr * 64 + fr, col0 = u.pn * BM + wc * 32 + 8 * fq;
#pragma unroll
        for (int ai = 0; ai < 2; ++ai)
#pragma unroll
            for (int m = 0; m < 4; ++m) {
#pragma unroll
                for (int bj = 0; bj < 2; ++bj) f.scale(u, row0 + ai * HALF + m * 16, col0 + bj * HALF, acc[ai][bj][m][0], acc[ai][bj][m][1]);
                asm volatile("" ::: "memory");
            }
    }
    __device__ __forceinline__ void operator()(const f32x4 (&acc)[2][2][4][2], const Unit& u, int wr, int wc, int fr, int fq) const {
        const int row0 = u.pm * BM + wr * 64 + fr, col0 = u.pn * BM + wc * 32 + 8 * fq;
#pragma unroll
        for (int ai = 0; ai < 2; ++ai)
#pragma unroll
            for (int m = 0; m < 4; ++m) {
#pragma unroll
                for (int bj = 0; bj < 2; ++bj) f(u, row0 + ai * HALF + m * 16, col0 + bj * HALF, acc[ai][bj][m][0], acc[ai][bj][m][1]);
                asm volatile("" ::: "memory");
            }
    }
};

template <class E, class = void> struct after_drain { static constexpr bool value = false; };
template <class E> struct after_drain<E, decltype((void)E::AFTER_DRAIN)> { static constexpr bool value = E::AFTER_DRAIN; };
template <class Epi, class Sched, bool ALIGN_EPI = false, bool SP2 = false, int EXTACC = 0>
__device__ __forceinline__ void gemm_phase(PG8_LAS unsigned char* lds, const Gemm g, const Sched& S, const Epi& E, f32x4 (*accx)[2][4][2] = nullptr) {
    int tid_ = threadIdx.x; asm volatile("" : "+v"(tid_));
    const int tid = tid_, wid = __builtin_amdgcn_readfirstlane(tid >> 6), lane = tid & 63, wr = wid >> 2, wc = wid & 3, fr = lane & 15, fq = lane >> 4;
    const int K = g.K, nt = K / BK;
    unsigned voffA[2], voffB[2];
#pragma unroll
    for (int i = 0; i < 2; ++i) { int R, C; stage_rc(tid * 16 + i * 8192, R, C); const int Rb = Epi::PERM ? ((R & ~31) + perm32(R & 31)) : R;
        voffA[i] = (unsigned)(R * g.lda + C) * 2u; voffB[i] = (unsigned)(Rb * g.ldb + C) * 2u; }
    const size_t kstep = (size_t)(BK * 2);
    const size_t hstepA = (size_t)HALF * g.lda * 2, hstepB = (size_t)HALF * g.ldb * 2;
    const unsigned ldsw = (unsigned)wid * 1024u;
    const int aoff = lds_byte(wr * 64 + fr, fq * 8), boff = lds_byte(wc * 32 + fr, fq * 8);
#define PG8_SA(b, h) (((b) * 2 + (h)) * HTB)
#define PG8_SB(b, h) ((4 + (b) * 2 + (h)) * HTB)
#define PG8_STAGE(bufoff, gbase, voff) do { _Pragma("unroll") for (int _i = 0; _i < 2; ++_i) \
        __builtin_amdgcn_global_load_lds((const unsigned*)((const char*)(gbase) + (voff)[_i]), (PG8_LAS unsigned*)(lds + (bufoff) + ldsw + _i * 8192), 16, 0, 0); } while (0)
#define PG8_LDA(dst, b, h) do { _Pragma("unroll") for (int m = 0; m < 4; ++m) _Pragma("unroll") for (int k = 0; k < 2; ++k) dst[m][k] = *(const PG8_LAS bf16x8*)(lds + PG8_SA(b, h) + aoff + m * 2048 + k * 1024); } while (0)
#define PG8_LDB(dst, b, h) do { _Pragma("unroll") for (int n = 0; n < 2; ++n) _Pragma("unroll") for (int k = 0; k < 2; ++k) dst[n][k] = *(const PG8_LAS bf16x8*)(lds + PG8_SB(b, h) + boff + n * 2048 + k * 1024); } while (0)
#define PG8_MMA(ai, bj, At, Bt) do { __builtin_amdgcn_s_setprio(1); _Pragma("unroll") for (int m = 0; m < 4; ++m) _Pragma("unroll") for (int n = 0; n < 2; ++n) _Pragma("unroll") for (int k = 0; k < 2; ++k) \
        acc[ai][bj][m][n] = __builtin_amdgcn_mfma_f32_16x16x32_bf16(Bt[n][k], At[m][k], acc[ai][bj][m][n], 0, 0, 0); __builtin_amdgcn_s_setprio(0); } while (0)
#define PG8_WAIT_V(n) asm volatile("s_waitcnt vmcnt(" #n ")" ::: "memory")
#define PG8_WAIT_L(n) asm volatile("s_waitcnt lgkmcnt(" #n ")" ::: "memory")
#define PG8_BAR __builtin_amdgcn_s_barrier()
#define PG8_SCHED __builtin_amdgcn_sched_barrier(0)
    Unit cur, nxt; int ui = 0;
    if (!S.next(0, cur)) return;
    f32x4 accl[2][2][4][2];
    f32x4 (&acc)[2][2][4][2] = *(EXTACC ? (f32x4 (*)[2][2][4][2])accx : &accl);
    if constexpr (EXTACC != 2) {
#pragma unroll
    for (int a = 0; a < 2; ++a)
#pragma unroll
        for (int b = 0; b < 2; ++b)
#pragma unroll
            for (int m = 0; m < 4; ++m)
#pragma unroll
                for (int n = 0; n < 2; ++n) acc[a][b][m][n] = (f32x4){0.f, 0.f, 0.f, 0.f};
    }
    bf16x8 At[4][2], B0[2][2], B1[2][2];
    const char* cA = (const char*)g.A + S.a_off(cur); const char* cB = (const char*)g.Bt + S.b_off(cur);
    if constexpr (SP2) {
        PG8_STAGE(PG8_SB(0, 0), cB, voffB); PG8_STAGE(PG8_SB(0, 1), cB + hstepB, voffB); PG8_STAGE(PG8_SA(0, 0), cA, voffA); PG8_STAGE(PG8_SA(0, 1), cA + hstepA, voffA);
        if (wr == 1) PG8_BAR;
        PG8_WAIT_V(2); PG8_BAR;
        PG8_STAGE(PG8_SB(1, 0), cB + kstep, voffB); PG8_STAGE(PG8_SA(1, 0), cA + kstep, voffA); PG8_STAGE(PG8_SB(1, 1), cB + hstepB + kstep, voffB);
        PG8_WAIT_V(6); PG8_BAR;
    } else {
        PG8_STAGE(PG8_SB(0, 0), cB, voffB); PG8_STAGE(PG8_SA(0, 0), cA, voffA); PG8_STAGE(PG8_SB(0, 1), cB + hstepB, voffB); PG8_STAGE(PG8_SA(0, 1), cA + hstepA, voffA);
        if (wr == 1) PG8_BAR;
        PG8_WAIT_V(4); PG8_BAR;
        PG8_STAGE(PG8_SB(1, 0), cB + kstep, voffB); PG8_STAGE(PG8_SA(1, 0), cA + kstep, voffA); PG8_STAGE(PG8_SB(1, 1), cB + hstepB + kstep, voffB);
        PG8_WAIT_V(6); PG8_BAR;
    }
    for (;;) {
        const bool has_next = S.next(ui + 1, nxt);
        const char* nA = has_next ? (const char*)g.A + S.a_off(nxt) : cA; const char* nB = has_next ? (const char*)g.Bt + S.b_off(nxt) : cB;
        for (int t = 0; t < nt; t += 2) {
            const bool last = (t == nt - 2);
            const char* a1 = cA + (size_t)(t + 1) * kstep;
            const char* a2 = last ? nA : cA + (size_t)(t + 2) * kstep; const char* b2 = last ? nB : cB + (size_t)(t + 2) * kstep;
            const char* a3 = a2 + kstep; const char* b3 = b2 + kstep;
            if constexpr (SP2) {
            PG8_LDB(B0, 0, 0); PG8_LDB(B1, 0, 1); PG8_SCHED; PG8_LDA(At, 0, 0); PG8_STAGE(PG8_SA(1, 1), a1 + hstepA, voffA);
            PG8_WAIT_V(8); PG8_WAIT_L(0); PG8_BAR; PG8_MMA(0, 0, At, B0); PG8_MMA(0, 1, At, B1); PG8_BAR; PG8_SCHED;
            PG8_LDA(At, 0, 1); PG8_STAGE(PG8_SB(0, 0), b2, voffB); PG8_STAGE(PG8_SB(0, 1), b2 + hstepB, voffB); PG8_STAGE(PG8_SA(0, 0), a2, voffA);
            PG8_WAIT_V(8); PG8_WAIT_L(0); PG8_BAR; PG8_MMA(1, 0, At, B0); PG8_MMA(1, 1, At, B1); PG8_BAR; PG8_SCHED;
            PG8_LDB(B0, 1, 0); PG8_LDB(B1, 1, 1); PG8_SCHED; PG8_LDA(At, 1, 0); PG8_STAGE(PG8_SA(0, 1), a2 + hstepA, voffA);
            PG8_WAIT_V(8); PG8_WAIT_L(0); PG8_BAR; PG8_MMA(0, 0, At, B0); PG8_MMA(0, 1, At, B1); PG8_BAR; PG8_SCHED;
            PG8_LDA(At, 1, 1); PG8_STAGE(PG8_SB(1, 0), b3, voffB); PG8_STAGE(PG8_SB(1, 1), b3 + hstepB, voffB); PG8_STAGE(PG8_SA(1, 0), a3, voffA);
            PG8_WAIT_V(8); PG8_WAIT_L(0); PG8_BAR; PG8_MMA(1, 0, At, B0); PG8_MMA(1, 1, At, B1); PG8_BAR; PG8_SCHED;
            } else {
            PG8_LDB(B0, 0, 0); PG8_SCHED; PG8_LDA(At, 0, 0); PG8_STAGE(PG8_SA(1, 1), a1 + hstepA, voffA);
            PG8_WAIT_L(8); PG8_BAR; PG8_WAIT_L(0); PG8_MMA(0, 0, At, B0); PG8_BAR; PG8_SCHED;
            PG8_LDB(B1, 0, 1); PG8_STAGE(PG8_SB(0, 0), b2, voffB);
            PG8_BAR; PG8_WAIT_L(0); PG8_MMA(0, 1, At, B1); PG8_BAR;
            PG8_LDA(At, 0, 1); PG8_STAGE(PG8_SA(0, 0), a2, voffA);
            PG8_BAR; PG8_WAIT_L(0); PG8_MMA(1, 0, At, B0); PG8_BAR; PG8_SCHED;
            PG8_STAGE(PG8_SB(0, 1), b2 + hstepB, voffB);
            PG8_WAIT_V(6); PG8_BAR; PG8_MMA(1, 1, At, B1); PG8_BAR;
            PG8_LDB(B0, 1, 0); PG8_SCHED; PG8_LDA(At, 1, 0); PG8_STAGE(PG8_SA(0, 1), a2 + hstepA, voffA);
            PG8_WAIT_L(8); PG8_BAR; PG8_WAIT_L(0); PG8_MMA(0, 0, At, B0); PG8_BAR; PG8_SCHED;
            PG8_LDB(B1, 1, 1); PG8_STAGE(PG8_SB(1, 0), b3, voffB);
            PG8_BAR; PG8_WAIT_L(0); PG8_MMA(0, 1, At, B1); PG8_BAR;
            PG8_LDA(At, 1, 1); PG8_STAGE(PG8_SA(1, 0), a3, voffA);
            PG8_BAR; PG8_WAIT_L(0); PG8_MMA(1, 0, At, B0); PG8_BAR; PG8_SCHED;
            PG8_STAGE(PG8_SB(1, 1), b3 + hstepB, voffB);
            PG8_WAIT_V(6); PG8_BAR; PG8_MMA(1, 1, At, B1); PG8_BAR;
            }
        }
        if constexpr (ALIGN_EPI) { if (wr == 0) PG8_BAR; }
        if constexpr (after_drain<Epi>::value) {   }
        else if constexpr (EXTACC == 1) E.inplace(acc, cur, wr, wc, fr, fq); else E(acc, cur, wr, wc, fr, fq);
        if (!has_next || EXTACC != 0 || after_drain<Epi>::value) break;
#pragma unroll
        for (int a = 0; a < 2; ++a)
#pragma unroll
            for (int b = 0; b < 2; ++b)
#pragma unroll
                for (int m = 0; m < 4; ++m)
#pragma unroll
                    for (int n = 0; n < 2; ++n) acc[a][b][m][n] = (f32x4){0.f, 0.f, 0.f, 0.f};
        cur = nxt; cA = nA; cB = nB; ++ui;
        if constexpr (ALIGN_EPI) { if (wr == 1) PG8_BAR; }
    }
    PG8_WAIT_V(0);
    if constexpr (!ALIGN_EPI) { if (wr == 0) PG8_BAR; }
    PG8_BAR;
    if constexpr (after_drain<Epi>::value) E.fused(acc, cur, lds);
#undef PG8_SA
#undef PG8_SB
#undef PG8_STAGE
#undef PG8_LDA
#undef PG8_LDB
#undef PG8_MMA
#undef PG8_WAIT_V
#undef PG8_WAIT_L
#undef PG8_BAR
#undef PG8_SCHED
}
}

constexpr int DM = 1024, NB = 8, SEQ = 2048, MTOK = NB * SEQ, CTXL = 256, MCTX = NB * CTXL;
constexpr int HGD = 512, DFF = 2816, DFF2 = 5632, INDIM = 5120, NMOD = 6;
constexpr float EPSN = 1e-6f;
constexpr int NWAVES = 8, NTHR = 512;
constexpr int LDS_BYTES = 147456;
#ifndef DUP_MASK
#define DUP_MASK 0
#endif
#define REPS(k) ((((DUP_MASK) >> (k)) & 1) ? 2 : 1)
#ifndef PROBE_K
#define PROBE_K -1
#endif
#ifndef EXTRA_SYNCS
#define EXTRA_SYNCS 0
#endif

constexpr size_t MiB = 1u << 20;
constexpr size_t WS_MX = 0;
constexpr size_t WS_LB = 256 * 1024;
constexpr size_t WS_SLOT = 1 * MiB;
constexpr size_t WS_WFS = 2 * MiB, WS_TCH = 3 * MiB;
constexpr size_t WS_BAR = 512 * 1024, BAR_BYTES = 32768;
constexpr int MISC_OFF = 147456 - 128;
constexpr size_t WS_WIN = 6 * MiB;
constexpr size_t WS_WPQ = 16 * MiB;
constexpr size_t WS_WA = 18 * MiB, WS_WB = 19 * MiB, WS_WOUT = 20 * MiB;
constexpr size_t WS_CS = 22 * MiB;
constexpr size_t WS_WUP = 6 * MiB;
constexpr size_t WS_WDN = 250 * MiB;
constexpr size_t WS_HX = 38 * MiB;
constexpr size_t WS_OF = 38 * MiB, WS_OB = 54 * MiB;
constexpr size_t WS_TMP = 38 * MiB;
constexpr size_t WS_H2 = 38 * MiB;
constexpr size_t WS_Q = 74 * MiB, WS_V = 90 * MiB, WS_OG = 106 * MiB, WS_GA = 122 * MiB, WS_GBG = 154 * MiB, WS_PQT = 186 * MiB;
constexpr size_t WS_GFC = 218 * MiB, WS_GBC = 222 * MiB, WS_VC = 226 * MiB;
constexpr size_t WS_YF = 228 * MiB;
constexpr size_t WS_YH = 74 * MiB;
constexpr size_t WS_MRG = 186 * MiB;
constexpr size_t WS_Z = 74 * MiB;
constexpr size_t WS_A2 = 162 * MiB;
constexpr size_t WS_XO = 38 * MiB;
constexpr size_t WS_END = 256 * MiB;

typedef unsigned short bf16;
typedef float f32x4 __attribute__((ext_vector_type(4)));
typedef unsigned u32x4 __attribute__((ext_vector_type(4)));
typedef unsigned u32x2 __attribute__((ext_vector_type(2)));
typedef float f32x2 __attribute__((ext_vector_type(2)));
#define LAS __attribute__((address_space(3)))

struct Params {
    const float* in[19];
    float* out;
    unsigned char* ws;
};

__device__ __forceinline__ float bf2f(unsigned short b) { return __uint_as_float(((unsigned)b) << 16); }
__device__ __forceinline__ float bflo(unsigned w) { return __uint_as_float(w << 16); }
__device__ __forceinline__ float bfhi(unsigned w) { return __uint_as_float(w & 0xffff0000u); }
__device__ __forceinline__ unsigned f2bf(float f) { unsigned u = __float_as_uint(f); return (u + 0x7fffu + ((u >> 16) & 1u)) >> 16; }
__device__ __forceinline__ unsigned pk2(float lo, float hi);
typedef __bf16 bf16x2_t __attribute__((ext_vector_type(2)));
__device__ __forceinline__ unsigned hwpk2(float lo, float hi) { const f32x2 v = {lo, hi}; const bf16x2_t r = __builtin_convertvector(v, bf16x2_t); return __builtin_bit_cast(unsigned, r); }
__device__ __forceinline__ unsigned pk2(float lo, float hi) { return hwpk2(lo, hi); }
__device__ __forceinline__ float sigmoidf_(float x) { return __builtin_amdgcn_rcpf(1.f + __expf(-x)); }
__device__ __forceinline__ float siluf_(float x) { return x * __builtin_amdgcn_rcpf(1.f + __expf(-x)); }
__device__ __forceinline__ float wave_sum(float v) {
#pragma unroll
    for (int o = 1; o < 64; o <<= 1) v += __shfl_xor(v, o);
    return v;
}
__device__ __forceinline__ u32x4 pack8(const f32x4 a, const f32x4 b) { u32x4 w; w.x = pk2(a[0], a[1]); w.y = pk2(a[2], a[3]); w.z = pk2(b[0], b[1]); w.w = pk2(b[2], b[3]); return w; }

typedef __attribute__((address_space(1))) unsigned gu32;
#define XB_TMO      128
#define XB_XCNT(j)  (256  + 64 * (j))
#define XB_XSUB(j)  (1280 + 64 * (j))
#define XB_XGEN(j)  (2304 + 64 * (j))
#define XB_TOP      3328
#define XB_TOPGEN   3392
#define XCD_BAR_WORDS 3456
#define XB_SPIN_CAP (1u << 18)

__device__ __forceinline__ unsigned xb_ld(unsigned* p)              { return __hip_atomic_load(p, __ATOMIC_RELAXED, __HIP_MEMORY_SCOPE_AGENT); }
__device__ __forceinline__ unsigned xb_add(unsigned* p, unsigned v) { return __hip_atomic_fetch_add(p, v, __ATOMIC_RELAXED, __HIP_MEMORY_SCOPE_AGENT); }
__device__ __forceinline__ unsigned xb_xcc_id() { return (unsigned)__builtin_amdgcn_s_getreg((3 << 11) | 20) & 0xFu; }
#define XB_SPIN(cond, bar) do { unsigned _sp = 0; while (cond) { __builtin_amdgcn_s_sleep(1); \
    if ((++_sp & 255u) == 0u) { if (xb_ld(&(bar)[XB_TMO])) break; if (_sp > XB_SPIN_CAP) { atomicAdd(&(bar)[XB_TMO], 1u); break; } } } } while (0)

struct XcdBarrier {
    unsigned* bar; unsigned x;
    volatile LAS unsigned* st;
};

__device__ __forceinline__ XcdBarrier xcd_barrier_post(unsigned* bar, volatile LAS unsigned* st) {
    XcdBarrier b; b.bar = bar; b.x = xb_xcc_id(); b.st = st;
    if (threadIdx.x == 0) (void)xb_add(&bar[XB_XCNT(b.x)], 1u);
    return b;
}
__device__ __forceinline__ void xcd_barrier_complete(unsigned* bar, unsigned x, unsigned& nloc, unsigned& nx) {
    const unsigned G = gridDim.x * gridDim.y * gridDim.z;
    unsigned sum, cnt, mine, sp = 0u;
    for (;;) {
        sum = 0u; cnt = 0u; mine = 0u;
#pragma unroll
        for (unsigned j = 0; j < 16; ++j) { const unsigned c = xb_ld(&bar[XB_XCNT(j)]); sum += c; cnt += (c > 0u) ? 1u : 0u; mine = (j == x) ? c : mine; }
        if (sum == G) break;
        __builtin_amdgcn_s_sleep(1);
        if ((++sp & 255u) == 0u) { if (xb_ld(&bar[XB_TMO])) break; if (sp > XB_SPIN_CAP) { atomicAdd(&bar[XB_TMO], 1u); break; } }
    }
    nloc = mine > 0u ? mine : 1u; nx = cnt > 0u ? cnt : 1u;
}

__device__ __forceinline__ void xcd_barrier(const XcdBarrier& b) {
    asm volatile("s_waitcnt vmcnt(0)" ::: "memory");
    __syncthreads();
    if (threadIdx.x == 0) {
        unsigned* bar = b.bar;
        __builtin_amdgcn_s_waitcnt(0);
        unsigned nloc = b.st[0], nx = b.st[1];
        if (nloc == 0u) { xcd_barrier_complete(bar, b.x, nloc, nx); b.st[0] = nloc; b.st[1] = nx; }
        const unsigned old = xb_add(&bar[XB_XSUB(b.x)], 1u);
        const unsigned gen = old / nloc;
        if (old + 1u == (gen + 1u) * nloc) {
            __builtin_amdgcn_fence(__ATOMIC_RELEASE, "agent");
            asm volatile("s_waitcnt vmcnt(0)" ::: "memory");
            const unsigned og = xb_add(&bar[XB_TOP], 1u);
            const unsigned tg = og / nx;
            if (og + 1u == (tg + 1u) * nx) xb_add(&bar[XB_TOPGEN], 1u);
            else XB_SPIN(xb_ld(&bar[XB_TOPGEN]) == tg, bar);
            __builtin_amdgcn_fence(__ATOMIC_ACQUIRE, "agent");
            xb_add(&bar[XB_XGEN(b.x)], 1u);
            asm volatile("s_waitcnt vmcnt(0)" ::: "memory");
        } else {
            XB_SPIN(xb_ld(&bar[XB_XGEN(b.x)]) == gen, bar);
            __builtin_amdgcn_fence(__ATOMIC_ACQUIRE, "agent");
            asm volatile("s_waitcnt vmcnt(0)" ::: "memory");
        }
    }
    __syncthreads();
}


struct FIn {
    unsigned char* ws; float* out;
    __device__ __forceinline__ void operator()(const pg8::Unit& u, int row, int col, f32x4 v0, f32x4 v1) const {
        const int seg = u.pn >> 1, c = col & 511;
        if (seg == 0 || seg == 4) { f32x4 a, b;
#pragma unroll
            for (int i = 0; i < 4; ++i) { a[i] = siluf_(v0[i]); b[i] = siluf_(v1[i]); }
            bf16* dst = (bf16*)(ws + (seg == 0 ? WS_Q : WS_OG));
            *(u32x4*)(dst + (size_t)row * 512 + c) = pack8(a, b);
        } else if (seg == 1 || seg == 2) {
            const float* lb = (const float*)(ws + WS_LB);
            const f32x4 l0 = *(const f32x4*)(lb + c), l1 = *(const f32x4*)(lb + c + 4); f32x4 a, b;
#pragma unroll
            for (int i = 0; i < 4; ++i) { a[i] = l0[i] + (1.f - l0[i]) * sigmoidf_(v0[i]); b[i] = l1[i] + (1.f - l1[i]) * sigmoidf_(v1[i]); }
            float* dst;
            if (u.pm < 64) dst = out + (seg == 1 ? (size_t)0 : (size_t)MTOK * 512) + (size_t)row * 512 + c;
            else dst = (float*)(ws + (seg == 1 ? WS_GFC : WS_GBC)) + (size_t)(row - MTOK) * 512 + c;
            *(f32x4*)dst = a; *(f32x4*)(dst + 4) = b;
        } else if (seg == 3) {
            bf16* dst;
            if (u.pm < 64) dst = (bf16*)(ws + WS_V) + (size_t)row * 512 + c; else dst = (bf16*)(ws + WS_VC) + (size_t)(row - MTOK) * 512 + c;
            *(u32x4*)dst = pack8(v0, v1);
        } else { f32x4 a, b;
#pragma unroll
            for (int i = 0; i < 4; ++i) { a[i] = sigmoidf_(v0[i]); b[i] = sigmoidf_(v1[i]); }
            bf16* dst = (seg < 7) ? ((bf16*)(ws + WS_GA) + (size_t)row * 1024 + (col - 5 * 512)) : ((bf16*)(ws + WS_GBG) + (size_t)row * 1024 + (col - 7 * 512));
            *(u32x4*)dst = pack8(a, b);
        }
    }
};
struct FPQ {
    bf16* pqt;
    __device__ __forceinline__ void operator()(const pg8::Unit&, int row, int col, f32x4 v0, f32x4 v1) const {
        bf16* dst = pqt + (size_t)(row & 511) * 32768 + (size_t)(col >> 11) * 4096 + (size_t)(row >> 9) * 1024 + ((col & 2047) >> 1);
        u32x2 ev, od; ev.x = pk2(v0[0], v0[2]); ev.y = pk2(v1[0], v1[2]); od.x = pk2(v0[1], v0[3]); od.y = pk2(v1[1], v1[3]);
        *(u32x2*)dst = ev; *(u32x2*)(dst + 2048) = od;
    }
};
struct EpiDft {
    static constexpr bool PERM = true;
    bf16* yf; unsigned* flags;
    __device__ __forceinline__ void operator()(const f32x4 (&acc)[2][2][4][2], const pg8::Unit& u, int wr, int wc, int fr, int fq) const {
        const int z = u.z & 255, eo = u.z >> 8, pair = (z * 4 + u.pm) * 2 + u.pn;
        const int row0 = u.pm * 256 + wr * 64 + fr, col0 = u.pn * 256 + wc * 32 + 8 * fq;
        unsigned* flag = flags + pair * 16;
        if (eo) {
#pragma unroll
            for (int ai = 0; ai < 2; ++ai)
#pragma unroll
                for (int m = 0; m < 4; ++m)
#pragma unroll
                    for (int bj = 0; bj < 2; ++bj) { const int row = row0 + ai * 128 + m * 16, col = col0 + bj * 128;
                        *(u32x4*)(yf + ((size_t)z * SEQ + 1024 + row) * 512 + col) = pack8(acc[ai][bj][m][0] * (1.f / 512.f), acc[ai][bj][m][1] * (1.f / 512.f)); }
            asm volatile("s_waitcnt vmcnt(0)" ::: "memory");
            __syncthreads();
            if (threadIdx.x == 0) { __builtin_amdgcn_fence(__ATOMIC_RELEASE, "agent"); asm volatile("s_waitcnt vmcnt(0)" ::: "memory");
                __hip_atomic_store(flag, 1u, __ATOMIC_RELAXED, __HIP_MEMORY_SCOPE_AGENT); }
        } else {
            if (threadIdx.x == 0) { unsigned spins = 0;
                while (__hip_atomic_load(flag, __ATOMIC_RELAXED, __HIP_MEMORY_SCOPE_AGENT) == 0u && ++spins < (1u << 22)) __builtin_amdgcn_s_sleep(2);
                __builtin_amdgcn_fence(__ATOMIC_ACQUIRE, "agent"); asm volatile("s_waitcnt vmcnt(0)" ::: "memory"); }
            __syncthreads();
#pragma unroll
            for (int ai = 0; ai < 2; ++ai)
#pragma unroll
                for (int m = 0; m < 4; ++m) {
#pragma unroll
                    for (int bj = 0; bj < 2; ++bj) { const int row = row0 + ai * 128 + m * 16, col = col0 + bj * 128;
                        bf16* plo = yf + ((size_t)z * SEQ + row) * 512 + col; bf16* phi = plo + (size_t)1024 * 512;
                        const u32x4 o = *(const u32x4*)phi;
                        const f32x4 e0 = acc[ai][bj][m][0] * (1.f / 512.f), e1 = acc[ai][bj][m][1] * (1.f / 512.f);
                        f32x4 o0, o1; o0[0] = bflo(o.x); o0[1] = bfhi(o.x); o0[2] = bflo(o.y); o0[3] = bfhi(o.y); o1[0] = bflo(o.z); o1[1] = bfhi(o.z); o1[2] = bflo(o.w); o1[3] = bfhi(o.w);
                        *(u32x4*)plo = pack8(e0 + o0, e1 + o1); *(u32x4*)phi = pack8(e0 - o0, e1 - o1); }
                    asm volatile("" ::: "memory"); }
        }
    }
};
struct FYa {
    const bf16* ga;
    __device__ __forceinline__ void scale(const pg8::Unit&, int row, int col, f32x4& v0, f32x4& v1) const {
        const size_t o = (size_t)row * 1024 + col; const u32x4 g = *(const u32x4*)(ga + o);
        v0[0] *= bflo(g.x); v0[1] *= bfhi(g.x); v0[2] *= bflo(g.y); v0[3] *= bfhi(g.y); v1[0] *= bflo(g.z); v1[1] *= bfhi(g.z); v1[2] *= bflo(g.w); v1[3] *= bfhi(g.w);
    }
    __device__ __forceinline__ void operator()(const pg8::Unit&, int, int, f32x4, f32x4) const {}
};
struct FYb {
    const bf16* gbg; bf16* mrg;
    __device__ __forceinline__ void scale(const pg8::Unit&, int row, int col, f32x4& v0, f32x4& v1) const {
        const size_t o = (size_t)row * 1024 + col; const u32x4 h = *(const u32x4*)(gbg + o);
        v0[0] *= __builtin_amdgcn_rcpf(bflo(h.x)); v0[1] *= __builtin_amdgcn_rcpf(bfhi(h.x)); v0[2] *= __builtin_amdgcn_rcpf(bflo(h.y)); v0[3] *= __builtin_amdgcn_rcpf(bfhi(h.y));
        v1[0] *= __builtin_amdgcn_rcpf(bflo(h.z)); v1[1] *= __builtin_amdgcn_rcpf(bfhi(h.z)); v1[2] *= __builtin_amdgcn_rcpf(bflo(h.w)); v1[3] *= __builtin_amdgcn_rcpf(bfhi(h.w));
    }
    __device__ __forceinline__ void operator()(const pg8::Unit&, int row, int col, f32x4 v0, f32x4 v1) const {
        const size_t o = (size_t)row * 1024 + col; const u32x4 h = *(const u32x4*)(gbg + o);
        f32x4 a, b; a[0] = v0[0] * bflo(h.x); a[1] = v0[1] * bfhi(h.x); a[2] = v0[2] * bflo(h.y); a[3] = v0[3] * bfhi(h.y);
        b[0] = v1[0] * bflo(h.z); b[1] = v1[1] * bfhi(h.z); b[2] = v1[2] * bflo(h.w); b[3] = v1[3] * bfhi(h.w);
        *(u32x4*)(mrg + o) = pack8(a, b);
    }
};
struct FYab {
    const bf16* ga; const bf16* gbg;
    __device__ __forceinline__ void scale(const pg8::Unit&, int row, int col, f32x4& v0, f32x4& v1) const {
        const size_t o = (size_t)row * 1024 + col; const u32x4 g = *(const u32x4*)(ga + o), h = *(const u32x4*)(gbg + o);
        v0[0] *= bflo(g.x) * __builtin_amdgcn_rcpf(bflo(h.x)); v0[1] *= bfhi(g.x) * __builtin_amdgcn_rcpf(bfhi(h.x)); v0[2] *= bflo(g.y) * __builtin_amdgcn_rcpf(bflo(h.y)); v0[3] *= bfhi(g.y) * __builtin_amdgcn_rcpf(bfhi(h.y));
        v1[0] *= bflo(g.z) * __builtin_amdgcn_rcpf(bflo(h.z)); v1[1] *= bfhi(g.z) * __builtin_amdgcn_rcpf(bfhi(h.z)); v1[2] *= bflo(g.w) * __builtin_amdgcn_rcpf(bflo(h.w)); v1[3] *= bfhi(g.w) * __builtin_amdgcn_rcpf(bfhi(h.w));
    }
    __device__ __forceinline__ void operator()(const pg8::Unit&, int, int, f32x4, f32x4) const {}
};
struct FYaT {
    const bf16* ga; bf16* tmp;
    __device__ __forceinline__ void operator()(const pg8::Unit&, int row, int col, f32x4 v0, f32x4 v1) const {
        const size_t o = (size_t)row * 1024 + col; const u32x4 g = *(const u32x4*)(ga + o);
        f32x4 a, b; a[0] = v0[0] * bflo(g.x); a[1] = v0[1] * bfhi(g.x); a[2] = v0[2] * bflo(g.y); a[3] = v0[3] * bfhi(g.y);
        b[0] = v1[0] * bflo(g.z); b[1] = v1[1] * bfhi(g.z); b[2] = v1[2] * bflo(g.w); b[3] = v1[3] * bfhi(g.w);
        *(u32x4*)(tmp + o) = pack8(a, b);
    }
};
struct FYbT {
    const bf16* gbg; const bf16* tmp; bf16* mrg;
    __device__ __forceinline__ void operator()(const pg8::Unit&, int row, int col, f32x4 v0, f32x4 v1) const {
        const size_t o = (size_t)row * 1024 + col; const u32x4 g = *(const u32x4*)(gbg + o); const u32x4 t = *(const u32x4*)(tmp + o);
        f32x4 a, b; a[0] = bflo(t.x) + v0[0] * bflo(g.x); a[1] = bfhi(t.x) + v0[1] * bfhi(g.x); a[2] = bflo(t.y) + v0[2] * bflo(g.y); a[3] = bfhi(t.y) + v0[3] * bfhi(g.y);
        b[0] = bflo(t.z) + v1[0] * bflo(g.z); b[1] = bfhi(t.z) + v1[1] * bfhi(g.z); b[2] = bflo(t.w) + v1[2] * bflo(g.w); b[3] = bfhi(t.w) + v1[3] * bfhi(g.w);
        *(u32x4*)(mrg + o) = pack8(a, b);
    }
};
struct FRes {
    const float* src; float* dst; const float* mx; int mod;
    __device__ __forceinline__ void operator()(const pg8::Unit&, int row, int col, f32x4 v0, f32x4 v1) const {
        const size_t o = (size_t)row * 1024 + col; const float* m = mx + (size_t)(row >> 11) * (NMOD * DM) + mod * DM + col;
        const f32x4 m0 = *(const f32x4*)m, m1 = *(const f32x4*)(m + 4), s0 = *(const f32x4*)(src + o), s1 = *(const f32x4*)(src + o + 4);
        *(f32x4*)(dst + o) = s0 + m0 * v0; *(f32x4*)(dst + o + 4) = s1 + m1 * v1;
    }
};
struct FUp {
    bf16* z; int ld;
    __device__ __forceinline__ void operator()(const pg8::Unit&, int row, int col, f32x4 v0, f32x4 v1) const {
        *(u32x4*)(z + (size_t)row * ld + col) = pack8(v0, v1);
    }
};

struct EpiFinal {
    static constexpr bool PERM = true, AFTER_DRAIN = true;
    float* xio; const float* mx; const float* fg; float* slots; unsigned* flags;
    __device__ __forceinline__ void operator()(const f32x4 (&)[2][2][4][2], const pg8::Unit&, int, int, int, int) const {}
    __device__ __forceinline__ void fused(f32x4 (&acc)[2][2][4][2], const pg8::Unit& u, PG8_LAS unsigned char* ldsl) const {
        int t2_ = threadIdx.x; asm volatile("" : "+v"(t2_));
        const int tid = t2_, wid = __builtin_amdgcn_readfirstlane(tid >> 6), lane = tid & 63, wr = wid >> 2, wc = wid & 3, fr = lane & 15, fq = lane >> 4;
        PG8_LAS float* red = (PG8_LAS float*)ldsl;
        PG8_LAS float* rin = red + 1024;
        const int row0 = u.pm * 256 + wr * 64 + fr, col0 = u.pn * 256 + wc * 32 + 8 * fq;
        float ss[2][4];
#pragma unroll
        for (int ai = 0; ai < 2; ++ai)
#pragma unroll
            for (int m = 0; m < 4; ++m) ss[ai][m] = 0.f;
#pragma unroll
        for (int bj = 0; bj < 2; ++bj) { const int col = col0 + bj * 128;
            const float* mm = mx + (size_t)(u.pm >> 3) * (NMOD * DM) + 5 * DM + col;
            const f32x4 m0 = *(const f32x4*)mm, m1 = *(const f32x4*)(mm + 4);
#pragma unroll
            for (int ai = 0; ai < 2; ++ai)
#pragma unroll
                for (int m = 0; m < 4; ++m) { const size_t o = (size_t)(row0 + ai * 128 + m * 16) * 1024 + col;
                    const f32x4 x0 = *(const f32x4*)(xio + o), x1 = *(const f32x4*)(xio + o + 4);
                    const f32x4 v0 = x0 + m0 * acc[ai][bj][m][0], v1 = x1 + m1 * acc[ai][bj][m][1];
                    acc[ai][bj][m][0] = v0; acc[ai][bj][m][1] = v1;
                    ss[ai][m] += (v0[0] * v0[0] + v0[1] * v0[1]) + (v0[2] * v0[2] + v0[3] * v0[3]) + (v1[0] * v1[0] + v1[1] * v1[1]) + (v1[2] * v1[2] + v1[3] * v1[3]);
                    asm volatile("" ::: "memory"); } }
#pragma unroll
        for (int ai = 0; ai < 2; ++ai)
#pragma unroll
            for (int m = 0; m < 4; ++m) { float s = ss[ai][m]; s += __shfl_xor(s, 16); s += __shfl_xor(s, 32); ss[ai][m] = s; }
        if (fq == 0) {
#pragma unroll
            for (int ai = 0; ai < 2; ++ai)
#pragma unroll
                for (int m = 0; m < 4; ++m) red[(ai * 128 + wr * 64 + m * 16 + fr) * 4 + wc] = ss[ai][m]; }
        __syncthreads();
        float* myslot = slots + (size_t)(u.pm * 4 + u.pn) * 256;
        if (tid < 256) myslot[tid] = (red[tid * 4 + 0] + red[tid * 4 + 1]) + (red[tid * 4 + 2] + red[tid * 4 + 3]);
        asm volatile("s_waitcnt vmcnt(0)" ::: "memory");
        __syncthreads();
        unsigned* flag = flags + u.pm * 16;
        if (tid == 0) { __builtin_amdgcn_fence(__ATOMIC_RELEASE, "agent"); asm volatile("s_waitcnt vmcnt(0)" ::: "memory");
            __hip_atomic_fetch_add(flag, 1u, __ATOMIC_RELAXED, __HIP_MEMORY_SCOPE_AGENT);
            unsigned spins = 0;
            while (__hip_atomic_load(flag, __ATOMIC_RELAXED, __HIP_MEMORY_SCOPE_AGENT) < 4u && ++spins < (1u << 22)) __builtin_amdgcn_s_sleep(2);
            __builtin_amdgcn_fence(__ATOMIC_ACQUIRE, "agent"); asm volatile("s_waitcnt vmcnt(0)" ::: "memory"); }
        __syncthreads();
        if (tid < 256) { const float* sl = slots + (size_t)(u.pm * 4) * 256 + tid;
            const float tot = (sl[0] + sl[256]) + (sl[512] + sl[768]);
            rin[tid] = rsqrtf(tot * (1.f / DM) + EPSN); }
        __syncthreads();
#pragma unroll
        for (int bj = 0; bj < 2; ++bj) { const int col = col0 + bj * 128;
            const f32x4 g0 = *(const f32x4*)(fg + col), g1 = *(const f32x4*)(fg + col + 4);
#pragma unroll
            for (int ai = 0; ai < 2; ++ai)
#pragma unroll
                for (int m = 0; m < 4; ++m) { const float r = rin[ai * 128 + wr * 64 + m * 16 + fr]; const size_t o = (size_t)(row0 + ai * 128 + m * 16) * 1024 + col;
                    *(f32x4*)(xio + o) = acc[ai][bj][m][0] * r * g0; *(f32x4*)(xio + o + 4) = acc[ai][bj][m][1] * r * g1;
                    asm volatile("" ::: "memory"); } }
    }
};

__device__ __forceinline__ void transpose_item(const float* W, int K, int N, bf16* WT, LAS float* scr, int item, int lane) {
    const int nblk = N / 32, kb = item / nblk, nb = item % nblk, k0 = 64 * kb, n0 = 32 * nb;
#pragma unroll 8
    for (int i = 0; i < 32; ++i) { const int kk = 2 * i + (lane >> 5); scr[kk * 33 + (lane & 31)] = W[(size_t)(k0 + kk) * N + n0 + (lane & 31)]; }
    asm volatile("s_waitcnt lgkmcnt(0)" ::: "memory");
    const int c = lane & 7;
#pragma unroll
    for (int j = 0; j < 4; ++j) { const int n = (lane >> 3) + 8 * j; const LAS float* s = scr + (8 * c) * 33 + n;
        u32x4 o; o.x = pk2(s[0 * 33], s[1 * 33]); o.y = pk2(s[2 * 33], s[3 * 33]); o.z = pk2(s[4 * 33], s[5 * 33]); o.w = pk2(s[6 * 33], s[7 * 33]);
        *(u32x4*)(WT + (size_t)(n0 + n) * K + k0 + 8 * c) = o; }
    asm volatile("s_waitcnt lgkmcnt(0)" ::: "memory");
}

template <bool MOD>
__device__ __forceinline__ void norm_rows(const float* srcA, const float* srcB, int nA, const float* g, const float* mx, int shift_mod, int scale_mod,
                                          bf16* outb, float* outf, int r0, int nr, int lane) {
    f32x4 G[4], SH[4], cur[4], nxt[4];
    int curmod = -1;
    { const float* s0 = (r0 < nA) ? srcA + (size_t)r0 * DM : srcB + (size_t)(r0 - nA) * DM;
#pragma unroll
      for (int j = 0; j < 4; ++j) cur[j] = *(const f32x4*)(s0 + (lane + 64 * j) * 4); }
#pragma unroll 1
    for (int i = 0; i < nr; ++i) {
        const int m = r0 + i;
        if (i + 1 < nr) { const int m1 = m + 1; const float* s1 = (m1 < nA) ? srcA + (size_t)m1 * DM : srcB + (size_t)(m1 - nA) * DM;
#pragma unroll
            for (int j = 0; j < 4; ++j) nxt[j] = *(const f32x4*)(s1 + (lane + 64 * j) * 4); }
        const int mr = MOD ? ((m < nA) ? (m >> 11) : 8) : 0;
        if (mr != curmod) { curmod = mr;
#pragma unroll
            for (int j = 0; j < 4; ++j) { const int e = (lane + 64 * j) * 4; const f32x4 gg = *(const f32x4*)(g + e);
                if (MOD) { const f32x4 sc = *(const f32x4*)(mx + (size_t)mr * (NMOD * DM) + scale_mod * DM + e); SH[j] = *(const f32x4*)(mx + (size_t)mr * (NMOD * DM) + shift_mod * DM + e); G[j] = gg * (sc + 1.f); }
                else { G[j] = gg; SH[j] = (f32x4){0.f, 0.f, 0.f, 0.f}; } } }
        float s = 0.f;
#pragma unroll
        for (int j = 0; j < 4; ++j) s += (cur[j][0] * cur[j][0] + cur[j][1] * cur[j][1]) + (cur[j][2] * cur[j][2] + cur[j][3] * cur[j][3]);
        const float rinv = rsqrtf(wave_sum(s) * (1.f / DM) + EPSN);
#pragma unroll
        for (int j = 0; j < 4; ++j) { const int e = (lane + 64 * j) * 4; const f32x4 h = cur[j] * rinv * G[j] + SH[j];
            if (MOD) { u32x2 w; w.x = pk2(h[0], h[1]); w.y = pk2(h[2], h[3]); *(u32x2*)(outb + (size_t)m * DM + e) = w; }
            else *(f32x4*)(outf + (size_t)m * DM + e) = h; }
#pragma unroll
        for (int j = 0; j < 4; ++j) cur[j] = nxt[j];
    }
}

__device__ __forceinline__ void phase0(const Params& p, unsigned char* lds, int tid, int lane, int wave, int G, const int part) {
    float* ldsf = (float*)lds;
    float* mxo = (float*)(p.ws + WS_MX);
    if (part == 0) {
    for (int it = blockIdx.x; it < 192; it += G) {
        __syncthreads();
        {
            const float* c = p.in[1]; const float* cc = p.in[3]; const float* aw = p.in[4]; const float* ab = p.in[5];
            float* sc = ldsf;
            float* red = ldsf + 9 * 1024;
            for (int i = tid; i < 9 * 1024; i += NTHR) { const int r = i >> 10, k = i & 1023; const float cv = (r < 8) ? c[r * 1024 + k] : cc[k]; sc[i] = cv / (1.f + __expf(-cv)); }
            __syncthreads();
            const int n0 = it * 32, col = tid & 31, ks = tid >> 5;
            float a[9];
#pragma unroll
            for (int r = 0; r < 9; ++r) a[r] = 0.f;
            for (int k = ks * 64; k < ks * 64 + 64; ++k) { const float w = aw[(size_t)k * (NMOD * DM) + n0 + col];
#pragma unroll
                for (int r = 0; r < 9; ++r) a[r] += sc[r * 1024 + k] * w; }
#pragma unroll
            for (int r = 0; r < 9; ++r) red[(ks * 9 + r) * 32 + col] = a[r];
            __syncthreads();
            if (tid < 288) { const int r = tid >> 5, cl = tid & 31; float s = ab[n0 + cl];
                for (int k2 = 0; k2 < 16; ++k2) s += red[(k2 * 9 + r) * 32 + cl];
                mxo[r * (NMOD * DM) + n0 + cl] = s; }
        }
    }
    __syncthreads();
    { bf16* tch = (bf16*)(p.ws + WS_TCH); bf16* wfs = (bf16*)(p.ws + WS_WFS); const float* win = p.in[7];
      for (int i = blockIdx.x * NTHR + tid; i < 1024 * 64; i += G * NTHR) { const int n = i >> 6, c8 = (i & 63) * 8, gn = (n & 511) >> 7, j = n & 127; float vv[8];
#pragma unroll
          for (int e = 0; e < 8; ++e) { const int cp = c8 + e, idx = ((cp & 127) * j) & 127; const float ang = (float)idx * (1.f / 64.f);
              vv[e] = ((cp >> 7) == gn) ? ((n < 512) ? cospif(ang) : sinpif(ang)) : 0.f; }
          u32x4 w; w.x = pk2(vv[0], vv[1]); w.y = pk2(vv[2], vv[3]); w.z = pk2(vv[4], vv[5]); w.w = pk2(vv[6], vv[7]);
          *(u32x4*)(tch + (size_t)n * 512 + c8) = w;
          const f32x4 a = *(const f32x4*)(win + (size_t)n * INDIM + c8), b2 = *(const f32x4*)(win + (size_t)n * INDIM + c8 + 4);
          *(u32x4*)(wfs + (size_t)n * 512 + c8) = pack8(a, b2); } }
    }
    if (part == 0 && blockIdx.x == G - 1) { const float* hl = p.in[8]; float* lbo = (float*)(p.ws + WS_LB);
        if (tid < 512) { const float a = hl[tid], b = hl[512 + tid]; lbo[tid] = 1.f / (1.f + expf(b - a)); } }
    if (part == 0) return;
    { bf16* cs = (bf16*)(p.ws + WS_CS);
      for (int i = blockIdx.x * NTHR + tid; i < 2 * 1024 * 256; i += G * NTHR) { const int eo = i >> 18, l = (i >> 8) & 1023, kc = (i & 255) * 8; float vv[8];
#pragma unroll
          for (int e = 0; e < 8; ++e) { const int k = kc + e, sn = k >> 10, m = k & 1023;
              const float ang = eo ? (float)((l * (2 * m + 1)) & 2047) * (1.f / 1024.f) : (float)((l * m) & 1023) * (1.f / 512.f);
              vv[e] = sn ? -sinpif(ang) : cospif(ang); }
          u32x4 w; w.x = pk2(vv[0], vv[1]); w.y = pk2(vv[2], vv[3]); w.z = pk2(vv[4], vv[5]); w.w = pk2(vv[6], vv[7]);
          *(u32x4*)(cs + ((size_t)eo * 1024 + l) * 2048 + kc) = w; } }
    { LAS float* scr = (LAS float*)((LAS unsigned char*)lds + wave * 16384);
      const int gw = blockIdx.x * NWAVES + wave, NGW = G * NWAVES;
      constexpr int I_IN = 16 * 160, I_A = 8 * 32, I_B = 8 * 32, I_O = 16 * 32;
      for (int it = gw; it < ((G >= 192) ? I_IN : I_IN + I_A + I_B + I_O); it += NGW) { int r = it;
          if (r < I_IN) { transpose_item(p.in[7], 1024, INDIM, (bf16*)(p.ws + WS_WIN), scr, r, lane); continue; } r -= I_IN;
          if (r < I_A) { transpose_item(p.in[10], 512, 1024, (bf16*)(p.ws + WS_WA), scr, r, lane); continue; } r -= I_A;
          if (r < I_B) { transpose_item(p.in[11], 512, 1024, (bf16*)(p.ws + WS_WB), scr, r, lane); continue; } r -= I_B;
          transpose_item(p.in[12], 1024, 1024, (bf16*)(p.ws + WS_WOUT), scr, r, lane); } }
}

__device__ __forceinline__ void hgrn_mfma_item(const Params& p, unsigned char* lds, int item) {
    int tid_ = threadIdx.x; asm volatile("" : "+v"(tid_));
    const int tid = tid_, lane = tid & 63, w = __builtin_amdgcn_readfirstlane(tid >> 6), fr = lane & 15, fq = lane >> 4;
    const int vh = item & 1, dir = (item >> 1) & 1, h = (item >> 2) & 3, b = item >> 4;
    bf16* Qs = (bf16*)lds;
    bf16* Ks = Qs + 64 * 136;
    bf16* St = Ks + 64 * 136;
    bf16* Kh = St + 2 * 64 * 136;
    bf16* Vt = Kh + 128 * 72;
    bf16* Ps = Vt + 64 * 72;
    float* Et = (float*)(Ps + 64 * 72);
    float* Fr = Et + 128;
    float* Bt = Fr + 64 * 132;
    const int d = 16 * w + fr;
    const float* fL = p.out + (dir ? (size_t)MTOK * 512 : 0) + (size_t)b * SEQ * 512 + h * 128;
    const float* fC = (const float*)(p.ws + (dir ? WS_GBC : WS_GFC)) + (size_t)b * CTXL * 512 + h * 128;
    const bf16* qL = (const bf16*)(p.ws + WS_Q) + (size_t)b * SEQ * 512 + h * 128;
    const bf16* vL = (const bf16*)(p.ws + WS_V) + (size_t)b * SEQ * 512 + h * 128 + vh * 64;
    const bf16* vC = (const bf16*)(p.ws + WS_VC) + (size_t)b * CTXL * 512 + h * 128 + vh * 64;
    bf16* oL = (bf16*)(p.ws + (dir ? WS_OB : WS_OF)) + (size_t)b * SEQ * 512 + h * 128 + vh * 64;
    f32x4 Sa[4];
#pragma unroll
    for (int i = 0; i < 4; ++i) Sa[i] = (f32x4){0.f, 0.f, 0.f, 0.f};
    f32x2 fR2[8]; unsigned qR1[8]; u32x4 vR;
#define HG_LOAD(cc_) do { const int _cc = (cc_); const bool _lat = _cc >= 4; const int _c = _lat ? _cc - 4 : _cc, _n = _lat ? SEQ : CTXL; \
        const float* _f = _lat ? fL : fC; const bf16* _v = _lat ? vL : vC; \
        _Pragma("unroll") for (int i = 0; i < 8; ++i) { const int _s = _c * 64 + 8 * w + i, _pos = dir ? (_n - 1 - _s) : _s; fR2[i] = *(const f32x2*)(_f + (size_t)_pos * 512 + 2 * lane); \
            qR1[i] = _lat ? *(const unsigned*)(qL + (size_t)_pos * 512 + 2 * lane) : 0u; } \
        { const int _s = _c * 64 + lane, _pos = dir ? (_n - 1 - _s) : _s; vR = *(const u32x4*)(_v + (size_t)_pos * 512 + w * 8); } } while (0)
#define HG_BT() do { *(f32x2*)(Bt + w * 128 + 2 * lane) = ((fR2[0] * fR2[1]) * (fR2[2] * fR2[3])) * ((fR2[4] * fR2[5]) * (fR2[6] * fR2[7])); } while (0)
    HG_LOAD(0);
    HG_BT();
    __syncthreads();
    for (int cc = 0; cc < 36; ++cc) {
        const bool lat = cc >= 4; const int c = lat ? cc - 4 : cc;
        bf16* Scur = St + (cc & 1) * (64 * 136); bf16* Snxt = St + ((cc & 1) ^ 1) * (64 * 136);
        {
            f32x2 cum = (f32x2){1.f, 1.f};
            { f32x2 t[7];
#pragma unroll
              for (int i = 0; i < 7; ++i) t[i] = *(const f32x2*)(Bt + i * 128 + 2 * lane);
#pragma unroll
              for (int i = 0; i < 7; ++i) if (i < w) cum = cum * t[i]; }
            unsigned kp0[4], kp1[4];
#pragma unroll
            for (int i = 0; i < 8; i += 2) { float k0v[2], k1v[2];
#pragma unroll
                for (int u = 0; u < 2; ++u) { const int r = 8 * w + i + u; const f32x2 f = fR2[i + u]; cum = cum * f;
                    const float cm0 = fmaxf(cum[0], 1e-30f), cm1 = fmaxf(cum[1], 1e-30f);
                    const float kt0 = (1.f - f[0]) * __builtin_amdgcn_rcpf(cm0), kt1 = (1.f - f[1]) * __builtin_amdgcn_rcpf(cm1);
                    if (lat) { const unsigned qr = qR1[i + u];
                        *(unsigned*)(Qs + r * 136 + 2 * lane) = hwpk2(bflo(qr) * cm0, bfhi(qr) * cm1); *(unsigned*)(Ks + r * 136 + 2 * lane) = hwpk2(kt0, kt1); }
                    k0v[u] = kt0; k1v[u] = kt1; }
                kp0[i >> 1] = hwpk2(k0v[0], k0v[1]); kp1[i >> 1] = hwpk2(k1v[0], k1v[1]); }
            u32x4 q0; q0.x = kp0[0]; q0.y = kp0[1]; q0.z = kp0[2]; q0.w = kp0[3]; u32x4 q1; q1.x = kp1[0]; q1.y = kp1[1]; q1.z = kp1[2]; q1.w = kp1[3];
            *(u32x4*)(Kh + (2 * lane) * 72 + 8 * w) = q0; *(u32x4*)(Kh + (2 * lane + 1) * 72 + 8 * w) = q1;
            if (w == 7) *(f32x2*)(Et + 2 * lane) = cum;
            Vt[(8 * w + 0) * 72 + lane] = (bf16)(vR.x & 0xffffu); Vt[(8 * w + 1) * 72 + lane] = (bf16)(vR.x >> 16); Vt[(8 * w + 2) * 72 + lane] = (bf16)(vR.y & 0xffffu); Vt[(8 * w + 3) * 72 + lane] = (bf16)(vR.y >> 16);
            Vt[(8 * w + 4) * 72 + lane] = (bf16)(vR.z & 0xffffu); Vt[(8 * w + 5) * 72 + lane] = (bf16)(vR.z >> 16); Vt[(8 * w + 6) * 72 + lane] = (bf16)(vR.w & 0xffffu); Vt[(8 * w + 7) * 72 + lane] = (bf16)(vR.w >> 16);
        }
        if (cc + 1 < 36) HG_LOAD(cc + 1);
        __syncthreads();
        const int ti = w >> 1, x2 = 2 * (w & 1);
        pg8::bf16x8 bqf[4], kf[2][4], sf[2][4], ka[2], bvf[4][2];
        const f32x4 et = *(const f32x4*)(Et + w * 16 + 4 * fq);
#pragma unroll
        for (int kk = 0; kk < 2; ++kk) ka[kk] = *(const pg8::bf16x8*)(Kh + (w * 16 + fr) * 72 + kk * 32 + fq * 8);
        if (lat) {
#pragma unroll
            for (int kk = 0; kk < 4; ++kk) { bqf[kk] = *(const pg8::bf16x8*)(Qs + (ti * 16 + fr) * 136 + kk * 32 + fq * 8);
#pragma unroll
                for (int u2 = 0; u2 < 2; ++u2) kf[u2][kk] = *(const pg8::bf16x8*)(Ks + ((x2 + u2) * 16 + fr) * 136 + kk * 32 + fq * 8); }
        }
#pragma unroll
        for (int vi = 0; vi < 4; ++vi)
#pragma unroll
            for (int kk = 0; kk < 2; ++kk) bvf[vi][kk] = *(const pg8::bf16x8*)(Vt + (vi * 16 + fr) * 72 + kk * 32 + fq * 8);
        if (lat) {
#pragma unroll
            for (int kk = 0; kk < 4; ++kk)
#pragma unroll
                for (int u2 = 0; u2 < 2; ++u2) sf[u2][kk] = *(const pg8::bf16x8*)(Scur + ((x2 + u2) * 16 + fr) * 136 + kk * 32 + fq * 8);
        }
        if (lat) {
#pragma unroll
            for (int u2 = 0; u2 < 2; ++u2) { const int si = x2 + u2; f32x4 acc = (f32x4){0.f, 0.f, 0.f, 0.f};
                if (si <= ti) {
#pragma unroll
                    for (int kk = 0; kk < 4; ++kk) acc = __builtin_amdgcn_mfma_f32_16x16x32_bf16(kf[u2][kk], bqf[kk], acc, 0, 0, 0);
                    const bool diag = (si == ti);
#pragma unroll
                    for (int r = 0; r < 4; ++r) acc[r] = (diag && (4 * fq + r > fr)) ? 0.f : acc[r]; }
                u32x2 pw; pw.x = hwpk2(acc[0], acc[1]); pw.y = hwpk2(acc[2], acc[3]);
                *(u32x2*)(Ps + (ti * 16 + fr) * 72 + si * 16 + 4 * fq) = pw; }
        }
        pg8::bf16x8 kv0[2], kv1[2];
#pragma unroll
        for (int kk = 0; kk < 2; ++kk) { kv0[kk] = bvf[0][kk]; kv1[kk] = bvf[1][kk]; }
#pragma unroll
        for (int kk = 0; kk < 2; ++kk) { if (x2) kv0[kk] = bvf[2][kk]; if (x2) kv1[kk] = bvf[3][kk]; }
#pragma unroll
        for (int vi = 0; vi < 4; ++vi) {
#pragma unroll
            for (int kk = 0; kk < 2; ++kk) Sa[vi] = __builtin_amdgcn_mfma_f32_16x16x32_bf16(ka[kk], bvf[vi][kk], Sa[vi], 0, 0, 0);
            Sa[vi] = Sa[vi] * et;
            u32x2 sw; sw.x = hwpk2(Sa[vi][0], Sa[vi][1]); sw.y = hwpk2(Sa[vi][2], Sa[vi][3]);
            *(u32x2*)(Snxt + (vi * 16 + fr) * 136 + w * 16 + 4 * fq) = sw; }
        f32x4 Oa[2];
        Oa[0] = (f32x4){0.f, 0.f, 0.f, 0.f}; Oa[1] = (f32x4){0.f, 0.f, 0.f, 0.f};
        if (lat) {
#pragma unroll
            for (int kk = 0; kk < 4; ++kk)
#pragma unroll
                for (int u2 = 0; u2 < 2; ++u2) Oa[u2] = __builtin_amdgcn_mfma_f32_16x16x32_bf16(sf[u2][kk], bqf[kk], Oa[u2], 0, 0, 0);
        }
        if (cc + 1 < 36) HG_BT();
        __syncthreads();
        if (lat) {
#pragma unroll
            for (int kk = 0; kk < 2; ++kk) { const pg8::bf16x8 bp = *(const pg8::bf16x8*)(Ps + (ti * 16 + fr) * 72 + kk * 32 + fq * 8);
#pragma unroll
                for (int u2 = 0; u2 < 2; ++u2) { const pg8::bf16x8 a = u2 ? kv1[kk] : kv0[kk];
                    Oa[u2] = __builtin_amdgcn_mfma_f32_16x16x32_bf16(a, bp, Oa[u2], 0, 0, 0); } }
            const int sg = c * 64 + ti * 16 + fr, pos = dir ? (SEQ - 1 - sg) : sg;
#pragma unroll
            for (int u2 = 0; u2 < 2; ++u2) { u32x2 ow; ow.x = hwpk2(Oa[u2][0], Oa[u2][1]); ow.y = hwpk2(Oa[u2][2], Oa[u2][3]);
                *(u32x2*)(oL + (size_t)pos * 512 + (x2 + u2) * 16 + 4 * fq) = ow; }
        }
    }
    __syncthreads();
#undef HG_LOAD
#undef HG_BT
}

__device__ __forceinline__ void phase_yh(const Params& p, int lane, int gw, int NGW) {
    const bf16* of = (const bf16*)(p.ws + WS_OF); const bf16* ob = (const bf16*)(p.ws + WS_OB); const bf16* og = (const bf16*)(p.ws + WS_OG);
    bf16* yh = (bf16*)(p.ws + WS_YH); const float* on = p.in[9];
    const f32x4 n0 = *(const f32x4*)(on + lane * 8), n1 = *(const f32x4*)(on + lane * 8 + 4);
    const int per = (MTOK + NGW - 1) / NGW, r0 = gw * per, nr = min(per, MTOK - r0);
    if (nr <= 0) return;
    u32x4 a = *(const u32x4*)(of + (size_t)r0 * 512 + lane * 8), b = *(const u32x4*)(ob + (size_t)r0 * 512 + lane * 8), gg = *(const u32x4*)(og + (size_t)r0 * 512 + lane * 8);
#pragma unroll 1
    for (int i = 0; i < nr; ++i) { const size_t o = (size_t)(r0 + i) * 512 + lane * 8;
        u32x4 a1 = a, b1 = b, g1 = gg;
        if (i + 1 < nr) { a1 = *(const u32x4*)(of + o + 512); b1 = *(const u32x4*)(ob + o + 512); g1 = *(const u32x4*)(og + o + 512); }
        float v[8]; v[0] = bflo(a.x) + bflo(b.x); v[1] = bfhi(a.x) + bfhi(b.x); v[2] = bflo(a.y) + bflo(b.y); v[3] = bfhi(a.y) + bfhi(b.y);
        v[4] = bflo(a.z) + bflo(b.z); v[5] = bfhi(a.z) + bfhi(b.z); v[6] = bflo(a.w) + bflo(b.w); v[7] = bfhi(a.w) + bfhi(b.w);
        float s = 0.f;
#pragma unroll
        for (int k = 0; k < 8; ++k) s += v[k] * v[k];
        s += __shfl_xor(s, 1); s += __shfl_xor(s, 2); s += __shfl_xor(s, 4); s += __shfl_xor(s, 8);
        const float rinv = rsqrtf(s * (1.f / 128.f) + EPSN);
        float gv[8]; gv[0] = bflo(gg.x); gv[1] = bfhi(gg.x); gv[2] = bflo(gg.y); gv[3] = bfhi(gg.y); gv[4] = bflo(gg.z); gv[5] = bfhi(gg.z); gv[6] = bflo(gg.w); gv[7] = bfhi(gg.w);
        f32x4 q0, q1;
#pragma unroll
        for (int k = 0; k < 4; ++k) { q0[k] = v[k] * rinv * n0[k] * gv[k]; q1[k] = v[4 + k] * rinv * n1[k] * gv[4 + k]; }
        *(u32x4*)(yh + o) = pack8(q0, q1);
        a = a1; b = b1; gg = g1; }
}

struct ConvRaw { u32x2 a[3], g[3]; };
__device__ __forceinline__ void conv_issue(const bf16* z, int tokbase, int r, int cc, int ch, ConvRaw& q) {
#pragma unroll
    for (int i = 0; i < 3; ++i) { const int rr = r + i - 1;
        if (rr >= 0 && rr < 32 && cc >= 0 && cc < 64) { const size_t zo = (size_t)(tokbase + rr * 64 + cc) * DFF2 + ch;
            q.a[i] = *(const u32x2*)(z + zo); q.g[i] = *(const u32x2*)(z + zo + DFF);
        } else { q.a[i] = (u32x2){0u, 0u}; q.g[i] = (u32x2){0u, 0u}; } }
}
__device__ __forceinline__ void phase_conv(const Params& p, int hf, int tid, int G) {
    const bf16* z = (const bf16*)(p.ws + WS_Z); bf16* a2 = (bf16*)(p.ws + WS_A2) + (size_t)hf * 8192 * DFF;
    const float* cw = p.in[15]; const float* cb = p.in[16];
    for (int it = blockIdx.x * NTHR + tid; it < 4 * 32 * 4 * 704; it += G * NTHR) {
        const int cg4 = it % 704, rest = it / 704, strip = rest & 3, r = (rest >> 2) & 31, img = rest >> 7, ch = cg4 * 4, c0 = strip * 16, tokbase = img * 2048;
        ConvRaw ring[3];
#pragma unroll
        for (int j = 0; j < 3; ++j) conv_issue(z, tokbase, r, c0 - 1 + j, ch, ring[j]);
        f32x2 w1[9][2], w2[9][2];
#pragma unroll
        for (int t = 0; t < 9; ++t) { const f32x4 a = *(const f32x4*)(cw + (size_t)t * DFF2 + ch), g = *(const f32x4*)(cw + (size_t)t * DFF2 + DFF + ch);
            w1[t][0] = (f32x2){a[0], a[1]}; w1[t][1] = (f32x2){a[2], a[3]}; w2[t][0] = (f32x2){g[0], g[1]}; w2[t][1] = (f32x2){g[2], g[3]}; }
        const f32x4 b1 = *(const f32x4*)(cb + ch), b2 = *(const f32x4*)(cb + DFF + ch);
        f32x2 W1[3][3][2], W2[3][3][2];
#pragma unroll
        for (int j = 0; j < 18; ++j) {
            const int sl = j % 3;
#pragma unroll
            for (int i = 0; i < 3; ++i) { const u32x2 a = ring[j % 3].a[i], g = ring[j % 3].g[i];
                W1[sl][i][0] = (f32x2){bflo(a.x), bfhi(a.x)}; W1[sl][i][1] = (f32x2){bflo(a.y), bfhi(a.y)};
                W2[sl][i][0] = (f32x2){bflo(g.x), bfhi(g.x)}; W2[sl][i][1] = (f32x2){bflo(g.y), bfhi(g.y)}; }
            if (j + 3 < 18) conv_issue(z, tokbase, r, c0 - 1 + j + 3, ch, ring[j % 3]);
            if (j >= 2) {
                const int sL = (j - 2) % 3, sC = (j - 1) % 3, sR = j % 3;
                f32x2 o1[2], o2[2];
                o1[0] = (f32x2){b1[0], b1[1]}; o1[1] = (f32x2){b1[2], b1[3]}; o2[0] = (f32x2){b2[0], b2[1]}; o2[1] = (f32x2){b2[2], b2[3]};
#pragma unroll
                for (int i = 0; i < 3; ++i)
#pragma unroll
                    for (int e = 0; e < 2; ++e) {
                        o1[e] = __builtin_elementwise_fma(W1[sL][i][e], w1[i * 3 + 0][e], o1[e]); o1[e] = __builtin_elementwise_fma(W1[sC][i][e], w1[i * 3 + 1][e], o1[e]); o1[e] = __builtin_elementwise_fma(W1[sR][i][e], w1[i * 3 + 2][e], o1[e]);
                        o2[e] = __builtin_elementwise_fma(W2[sL][i][e], w2[i * 3 + 0][e], o2[e]); o2[e] = __builtin_elementwise_fma(W2[sC][i][e], w2[i * 3 + 1][e], o2[e]); o2[e] = __builtin_elementwise_fma(W2[sR][i][e], w2[i * 3 + 2][e], o2[e]); }
                u32x2 ow; ow.x = pk2(siluf_(o1[0][0]) * o2[0][0], siluf_(o1[0][1]) * o2[0][1]); ow.y = pk2(siluf_(o1[1][0]) * o2[1][0], siluf_(o1[1][1]) * o2[1][1]);
                *(u32x2*)(a2 + (size_t)(tokbase + r * 64 + c0 + j - 2) * DFF + ch) = ow;
            }
        }
    }
}

__device__ __forceinline__ void phase_conv_lds(const Params& p, int hf, unsigned char* lds, int G) {
    int t_ = threadIdx.x; asm volatile("" : "+v"(t_));
    const int tid = t_;
    bf16* ring = (bf16*)lds;
    const bf16* z = (const bf16*)(p.ws + WS_Z); bf16* a2 = (bf16*)(p.ws + WS_A2) + (size_t)hf * 8192 * DFF;
    const float* cw = p.in[15]; const float* cb = p.in[16];
    const int ch4 = (tid & 15) * 4, c0 = (tid >> 4) * 2;
    __syncthreads();
    for (int i = tid; i < 4 * 2 * 80; i += NTHR) { const int slot = i / 160, rem = i % 160, side = rem / 80, wd = rem % 80;
        ((unsigned*)(ring + ((size_t)(slot * 66 + side * 65)) * 160))[wd] = 0u; }
    const int per = (5632 + G - 1) / G; int ucur = blockIdx.x * per; const int uend = min(ucur + per, 5632);
    while (ucur < uend) {
        const int colid = ucur >> 5, r0 = ucur & 31, n = min(32 - r0, uend - ucur), cbk = colid % 44, img = colid / 44, tokbase = img * 2048, chb = cbk * 64;
        ucur += n;
        f32x2 w1[9][2], w2[9][2];
#pragma unroll
        for (int t = 0; t < 9; ++t) { const f32x4 a = *(const f32x4*)(cw + (size_t)t * DFF2 + chb + ch4), g = *(const f32x4*)(cw + (size_t)t * DFF2 + DFF + chb + ch4);
            w1[t][0] = (f32x2){a[0], a[1]}; w1[t][1] = (f32x2){a[2], a[3]}; w2[t][0] = (f32x2){g[0], g[1]}; w2[t][1] = (f32x2){g[2], g[3]}; }
        const f32x4 b1 = *(const f32x4*)(cb + chb + ch4), b2 = *(const f32x4*)(cb + DFF + chb + ch4);
        u32x4 stA[2], stB[2];
#define CV_LOAD(ST, row_) do { const int _r = (row_); _Pragma("unroll") for (int k_ = 0; k_ < 2; ++k_) { const int _q = tid + 512 * k_, _col = _q >> 4, _path = (_q >> 3) & 1, _c8 = (_q & 7) * 8; \
            ST[k_] = (_r >= 0 && _r < 32) ? *(const u32x4*)(z + (size_t)(tokbase + _r * 64 + _col) * DFF2 + _path * DFF + chb + _c8) : (u32x4){0u, 0u, 0u, 0u}; } } while (0)
#define CV_STORE(ST, slot_) do { const int _sl = (slot_); _Pragma("unroll") for (int k_ = 0; k_ < 2; ++k_) { const int _q = tid + 512 * k_, _col = _q >> 4, _path = (_q >> 3) & 1, _c8 = (_q & 7) * 8; \
            *(u32x4*)(ring + ((size_t)(_sl * 66 + _col + 1)) * 160 + _path * 64 + _c8) = ST[k_]; } } while (0)
#define CV_COMPUTE(i_) do { const int _i = (i_); \
            f32x2 o1[2][2], o2[2][2]; \
            _Pragma("unroll") for (int oc = 0; oc < 2; ++oc) { o1[oc][0] = (f32x2){b1[0], b1[1]}; o1[oc][1] = (f32x2){b1[2], b1[3]}; o2[oc][0] = (f32x2){b2[0], b2[1]}; o2[oc][1] = (f32x2){b2[2], b2[3]}; } \
            _Pragma("unroll") for (int rr = 0; rr < 3; ++rr) { const int slot = (_i + rr) & 3; \
                const bf16* base = ring + ((size_t)(slot * 66 + c0)) * 160 + ch4; \
                _Pragma("unroll") for (int cc = 0; cc < 4; ++cc) { const u32x2 a = *(const u32x2*)(base + cc * 160), g = *(const u32x2*)(base + cc * 160 + 64); \
                    const f32x2 a0 = (f32x2){bflo(a.x), bfhi(a.x)}, a1 = (f32x2){bflo(a.y), bfhi(a.y)}, g0 = (f32x2){bflo(g.x), bfhi(g.x)}, g1 = (f32x2){bflo(g.y), bfhi(g.y)}; \
                    _Pragma("unroll") for (int oc = 0; oc < 2; ++oc) { const int dj = cc - oc; \
                        if (dj >= 0 && dj < 3) { const int t = rr * 3 + dj; \
                            o1[oc][0] = __builtin_elementwise_fma(a0, w1[t][0], o1[oc][0]); o1[oc][1] = __builtin_elementwise_fma(a1, w1[t][1], o1[oc][1]); \
                            o2[oc][0] = __builtin_elementwise_fma(g0, w2[t][0], o2[oc][0]); o2[oc][1] = __builtin_elementwise_fma(g1, w2[t][1], o2[oc][1]); } } } } \
            _Pragma("unroll") for (int oc = 0; oc < 2; ++oc) { u32x2 ow; ow.x = pk2(siluf_(o1[oc][0][0]) * o2[oc][0][0], siluf_(o1[oc][0][1]) * o2[oc][0][1]); ow.y = pk2(siluf_(o1[oc][1][0]) * o2[oc][1][0], siluf_(o1[oc][1][1]) * o2[oc][1][1]); \
                *(u32x2*)(a2 + (size_t)(tokbase + (r0 + _i) * 64 + c0 + oc) * DFF + chb + ch4) = ow; } } while (0)
        __syncthreads();
        CV_LOAD(stA, r0 - 1); CV_STORE(stA, 0); CV_LOAD(stA, r0); CV_STORE(stA, 1); CV_LOAD(stA, r0 + 1); CV_STORE(stA, 2);
        CV_LOAD(stA, r0 + 2);
        __syncthreads();
#pragma unroll 1
        for (int i = 0; i < n; i += 2) {
            CV_LOAD(stB, r0 + i + 3);
            CV_COMPUTE(i);
            CV_STORE(stA, (i + 3) & 3);
            __syncthreads();
            if (i + 1 < n) {
                CV_LOAD(stA, r0 + i + 4);
                CV_COMPUTE(i + 1);
                CV_STORE(stB, (i + 4) & 3);
                __syncthreads();
            }
        }
#undef CV_COMPUTE
#undef CV_LOAD
#undef CV_STORE
    }
}

__global__ void __launch_bounds__(NTHR, 2) fwd_mega(Params p) {
    extern __shared__ __attribute__((aligned(16))) unsigned char lds[];
    cg::grid_group grid = cg::this_grid();
    const int tid = threadIdx.x, lane = tid & 63, wave = __builtin_amdgcn_readfirstlane(tid >> 6);
    const int G = gridDim.x, gw = blockIdx.x * NWAVES + wave, NGW = G * NWAVES;
    PG8_LAS unsigned char* ldsl = (PG8_LAS unsigned char*)lds;
    unsigned char* ws = p.ws;
    const float* mx = (const float*)(ws + WS_MX);
    volatile LAS unsigned* misc = (volatile LAS unsigned*)((LAS unsigned char*)lds + MISC_OFF);
    if (tid < 16) misc[tid] = 0u;
    __syncthreads();
    const XcdBarrier xbar = xcd_barrier_post((unsigned*)(ws + WS_BAR), misc + 8);
    const unsigned long long t0_ = (PROBE_K >= 0) ? __builtin_amdgcn_s_memrealtime() : 0ull;
#define PROBE_POINT(k) do { if (PROBE_K == (k) && tid == 0) { const unsigned long long _n = __builtin_amdgcn_s_memrealtime(), _d = _n - t0_; while (__builtin_amdgcn_s_memrealtime() - _n < _d) __builtin_amdgcn_s_sleep(8); } } while (0)

    for (int rep_ = 0; rep_ < REPS(0); ++rep_) {
    phase0(p, lds, tid, lane, wave, G, 0);
    phase0(p, lds, tid, lane, wave, G, 1);
    xcd_barrier(xbar);
    if (G == 0x7fffffff) grid.sync();
    }
    for (int xs_ = 0; xs_ < EXTRA_SYNCS; ++xs_) xcd_barrier(xbar);
    PROBE_POINT(0);
    for (int rep_ = 0; rep_ < REPS(1); ++rep_) {
    if (blockIdx.x < 16 && G >= 16) {
        pg8::Gemm g{(const bf16*)(ws + WS_TCH), (const bf16*)(ws + WS_WFS), 512, 512, 512};
        pg8::StaticOrder S; S.init(4, 4, 16, blockIdx.x, 512, 512);
        pg8::Epi8<FUp> E{FUp{(bf16*)(ws + WS_WPQ), 1024}};
        pg8::gemm_phase<pg8::Epi8<FUp>, pg8::StaticOrder, true, true>(ldsl, g, S, E);
    }
    { const int skip = (G >= 32) ? 16 * NWAVES : 0, nw = NGW - skip, per = (MTOK + MCTX + nw - 1) / nw, r0 = (gw - skip) * per, nr = (gw < skip) ? 0 : min(per, MTOK + MCTX - r0);
      if (nr > 0) norm_rows<true>(p.in[0], p.in[2], MTOK, p.in[6], mx, 0, 1, (bf16*)(ws + WS_HX), nullptr, r0, nr, lane); }
    xcd_barrier(xbar);
    }
    PROBE_POINT(1);
    for (int rep_ = 0; rep_ < REPS(2); ++rep_) {
    {
        pg8::Gemm g{(const bf16*)(ws + WS_HX), (const bf16*)(ws + WS_WIN) + (size_t)512 * 1024, 1024, 1024, 1024};
        pg8::InOrder S; S.G = G; S.c = blockIdx.x; S.a_tile = (size_t)256 * 1024 * 2; S.b_tile = (size_t)256 * 1024 * 2;
        pg8::Epi8<FIn> E{FIn{ws, p.out}};
        pg8::gemm_phase<pg8::Epi8<FIn>, pg8::InOrder, true, true>(ldsl, g, S, E);
    }
    {
        pg8::Gemm g{(const bf16*)(ws + WS_WPQ), (const bf16*)(ws + WS_HX), 1024, 1024, 1024};
        pg8::StaticOrder S; S.init(4, 64, G, blockIdx.x, 1024, 1024);
        pg8::Epi8<FPQ> E{FPQ{(bf16*)(ws + WS_PQT)}};
        pg8::gemm_phase<pg8::Epi8<FPQ>, pg8::StaticOrder, true, true>(ldsl, g, S, E);
    }
    xcd_barrier(xbar);
    }
    PROBE_POINT(2);
    for (int rep_ = 0; rep_ < REPS(3); ++rep_) {
    if (blockIdx.x < 128 && G >= 192) {
        pg8::Gemm g{(const bf16*)(ws + WS_CS), (const bf16*)(ws + WS_PQT), 2048, 2048, 32768};
        pg8::DftOrder S; S.G = 128; S.c = blockIdx.x; S.a_tile = (size_t)256 * 2048 * 2; S.b_tile = (size_t)256 * 32768 * 2;
        EpiDft E{(bf16*)(ws + WS_YF), (unsigned*)(ws + WS_BAR + 16384)};
        pg8::gemm_phase<EpiDft, pg8::DftOrder, true, true>(ldsl, g, S, E);
        { int t2 = threadIdx.x; asm volatile("" : "+v"(t2));
          const int lane = t2 & 63, wave = __builtin_amdgcn_readfirstlane(t2 >> 6), gw = blockIdx.x * NWAVES + wave;
          LAS float* scr = (LAS float*)((LAS unsigned char*)lds + wave * 16384);
          constexpr int I_UP = 16 * 176, I_DN = 44 * 32;
          for (int it = gw; it < I_UP + I_DN; it += 128 * NWAVES) {
              if (it < I_UP) transpose_item(p.in[14], 1024, DFF2, (bf16*)(ws + WS_WUP), scr, it, lane);
              else transpose_item(p.in[17], DFF, 1024, (bf16*)(ws + WS_WDN), scr, it - I_UP, lane); }
          constexpr int I_A = 8 * 32, I_B = 8 * 32, I_O = 16 * 32;
          for (int it = gw; it < I_A + I_B + I_O; it += 128 * NWAVES) {
              if (it < I_A) transpose_item(p.in[10], 512, 1024, (bf16*)(ws + WS_WA), scr, it, lane);
              else if (it < I_A + I_B) transpose_item(p.in[11], 512, 1024, (bf16*)(ws + WS_WB), scr, it - I_A, lane);
              else transpose_item(p.in[12], 1024, 1024, (bf16*)(ws + WS_WOUT), scr, it - I_A - I_B, lane); } }
    } else if (G >= 192) {
        for (int it = blockIdx.x - 128; it < 128; it += G - 128) hgrn_mfma_item(p, lds, it);
    } else {
        pg8::Gemm g{(const bf16*)(ws + WS_CS), (const bf16*)(ws + WS_PQT), 2048, 2048, 32768};
        pg8::DftOrder S; S.G = G; S.c = blockIdx.x; S.a_tile = (size_t)256 * 2048 * 2; S.b_tile = (size_t)256 * 32768 * 2;
        EpiDft E{(bf16*)(ws + WS_YF), (unsigned*)(ws + WS_BAR + 16384)};
        pg8::gemm_phase<EpiDft, pg8::DftOrder, true, true>(ldsl, g, S, E);
        for (int it = blockIdx.x; it < 128; it += G) hgrn_mfma_item(p, lds, it);
    }
    xcd_barrier(xbar);
    }
    PROBE_POINT(3);
    for (int rep_ = 0; rep_ < REPS(4); ++rep_) {
    phase_yh(p, lane, gw, NGW);
    { LAS float* scr = (LAS float*)((LAS unsigned char*)lds + wave * 16384);
      constexpr int I_UP = 16 * 176, I_DN = 44 * 32;
      for (int it = (G >= 192) ? I_UP + I_DN : gw; it < I_UP + I_DN; it += NGW) {
          if (it < I_UP) transpose_item(p.in[14], 1024, DFF2, (bf16*)(ws + WS_WUP), scr, it, lane);
          else transpose_item(p.in[17], DFF, 1024, (bf16*)(ws + WS_WDN), scr, it - I_UP, lane); } }
    xcd_barrier(xbar);
    }
    PROBE_POINT(4);
    for (int rep_ = 0; rep_ < REPS(5); ++rep_) {
    if (G == 256) {
        pg8::f32x4 accm[2][2][4][2];
        {
            pg8::Gemm g{(const bf16*)(ws + WS_YF), (const bf16*)(ws + WS_WA), 512, 512, 512};
            pg8::StaticOrder S; S.init(64, 4, G, blockIdx.x, 512, 512);
            pg8::Epi8<FYab> E{FYab{(const bf16*)(ws + WS_GA), (const bf16*)(ws + WS_GBG)}};
            pg8::gemm_phase<pg8::Epi8<FYab>, pg8::StaticOrder, true, true, 1>(ldsl, g, S, E, &accm[0]);
        }
        {
            pg8::Gemm g{(const bf16*)(ws + WS_YH), (const bf16*)(ws + WS_WB), 512, 512, 512};
            pg8::StaticOrder S; S.init(64, 4, G, blockIdx.x, 512, 512);
            pg8::Epi8<FYb> E{FYb{(const bf16*)(ws + WS_GBG), (bf16*)(ws + WS_MRG)}};
            pg8::gemm_phase<pg8::Epi8<FYb>, pg8::StaticOrder, true, true, 2>(ldsl, g, S, E, &accm[0]);
        }
    } else {
    {
        pg8::Gemm g{(const bf16*)(ws + WS_YF), (const bf16*)(ws + WS_WA), 512, 512, 512};
        pg8::StaticOrder S; S.init(64, 4, G, blockIdx.x, 512, 512);
        pg8::Epi8<FYaT> E{FYaT{(const bf16*)(ws + WS_GA), (bf16*)(ws + WS_TMP)}};
        pg8::gemm_phase<pg8::Epi8<FYaT>, pg8::StaticOrder, true, true>(ldsl, g, S, E);
    }
    {
        pg8::Gemm g{(const bf16*)(ws + WS_YH), (const bf16*)(ws + WS_WB), 512, 512, 512};
        pg8::StaticOrder S; S.init(64, 4, G, blockIdx.x, 512, 512);
        pg8::Epi8<FYbT> E{FYbT{(const bf16*)(ws + WS_GBG), (const bf16*)(ws + WS_TMP), (bf16*)(ws + WS_MRG)}};
        pg8::gemm_phase<pg8::Epi8<FYbT>, pg8::StaticOrder, true, true>(ldsl, g, S, E);
    }
    }
    xcd_barrier(xbar);
    }
    PROBE_POINT(5);
    for (int rep_ = 0; rep_ < REPS(6); ++rep_) {
    {
        pg8::Gemm g{(const bf16*)(ws + WS_MRG), (const bf16*)(ws + WS_WOUT), 1024, 1024, 1024};
        pg8::StaticOrder S; S.init(64, 4, G, blockIdx.x, 1024, 1024);
        pg8::Epi8<FRes> E{FRes{p.in[0], p.out, mx, 2}};
        pg8::gemm_phase<pg8::Epi8<FRes>, pg8::StaticOrder, true, true>(ldsl, g, S, E);
    }
    xcd_barrier(xbar);
    }
    PROBE_POINT(6);
    for (int rep_ = 0; rep_ < REPS(7); ++rep_) {
    { const int per = (MTOK + NGW - 1) / NGW, r0 = gw * per, nr = min(per, MTOK - r0);
      if (nr > 0) norm_rows<true>(p.out, p.out, MTOK, p.in[13], mx, 3, 4, (bf16*)(ws + WS_H2), nullptr, r0, nr, lane); }
    xcd_barrier(xbar);
    }
    PROBE_POINT(7);
    {
    for (int hf = 0; hf < 2; ++hf) {
        for (int rep_ = 0; rep_ < REPS(8); ++rep_) {
            pg8::Gemm g{(const bf16*)(ws + WS_H2) + (size_t)hf * 8192 * 1024, (const bf16*)(ws + WS_WUP), 1024, 1024, 1024};
            pg8::StaticOrder S; S.init(32, 22, G, blockIdx.x, 1024, 1024);
            pg8::Epi8<FUp> E{FUp{(bf16*)(ws + WS_Z), DFF2}};
            pg8::gemm_phase<pg8::Epi8<FUp>, pg8::StaticOrder, true, true>(ldsl, g, S, E);
        xcd_barrier(xbar);
        }
        for (int rep_ = 0; rep_ < REPS(9); ++rep_) {
        phase_conv_lds(p, hf, lds, G);
        xcd_barrier(xbar);
        }
    }
    }
    PROBE_POINT(8);
    if (G == 256) {
        pg8::Gemm g{(const bf16*)(ws + WS_A2), (const bf16*)(ws + WS_WDN), DFF, DFF, DFF};
        pg8::StaticOrder S; S.init(64, 4, G, blockIdx.x, DFF, DFF);
        EpiFinal E{p.out, mx, p.in[18], (float*)(ws + WS_SLOT), (unsigned*)(ws + WS_BAR + 20480)};
        pg8::gemm_phase<EpiFinal, pg8::StaticOrder, true, true>(ldsl, g, S, E);
    } else {
    {
        pg8::Gemm g{(const bf16*)(ws + WS_A2), (const bf16*)(ws + WS_WDN), DFF, DFF, DFF};
        pg8::StaticOrder S; S.init(64, 4, G, blockIdx.x, DFF, DFF);
        pg8::Epi8<FRes> E{FRes{p.out, (float*)(ws + WS_XO), mx, 5}};
        pg8::gemm_phase<pg8::Epi8<FRes>, pg8::StaticOrder, true, true>(ldsl, g, S, E);
    }
    xcd_barrier(xbar);
    { const int per = (MTOK + NGW - 1) / NGW, r0 = gw * per, nr = min(per, MTOK - r0);
      if (nr > 0) norm_rows<false>((const float*)(ws + WS_XO), (const float*)(ws + WS_XO), MTOK, p.in[18], nullptr, 0, 0, nullptr, p.out, r0, nr, lane); }
    }
}

extern "C" void kernel_launch(void* const* d_in, const int* in_sizes, int n_in, void* d_out, int out_size, void* d_ws, size_t ws_size, hipStream_t stream) {
    static int grid = 0;
    if (grid == 0) {
        if (n_in != 19 || out_size != MTOK * DM || ws_size < WS_END) { fprintf(stderr, "kernel_launch: unexpected problem: n_in %d out %d ws %zu\n", n_in, out_size, ws_size); grid = -1; return; }
        int dev = 0, cus = 0, per_cu = 0;
        hipGetDevice(&dev);
        hipDeviceGetAttribute(&cus, hipDeviceAttributeMultiprocessorCount, dev);
        if (hipFuncSetAttribute((const void*)fwd_mega, hipFuncAttributeMaxDynamicSharedMemorySize, LDS_BYTES) != hipSuccess) { fprintf(stderr, "kernel_launch: hipFuncSetAttribute failed\n"); grid = -1; return; }
        if (hipOccupancyMaxActiveBlocksPerMultiprocessor(&per_cu, (const void*)fwd_mega, NTHR, LDS_BYTES) != hipSuccess || per_cu < 1) { fprintf(stderr, "kernel_launch: occupancy query says %d\n", per_cu); per_cu = 1; }
        (void)hipGetLastError();
        grid = cus * (per_cu > 1 ? 1 : per_cu);
        fprintf(stderr, "kernel_launch: grid %d (cus %d, per_cu %d), ws %zu\n", grid, cus, per_cu, ws_size);
    }
    if (grid < 0) return;
    Params p{};
    for (int i = 0; i < 19; ++i) p.in[i] = (const float*)d_in[i];
    p.out = (float*)d_out; p.ws = (unsigned char*)d_ws;
    if (hipMemsetAsync((char*)d_ws + WS_BAR, 0, BAR_BYTES, stream) != hipSuccess) { fprintf(stderr, "kernel_launch: memset failed\n"); return; }
    void* args[] = {&p};
    hipError_t e = hipLaunchCooperativeKernel((const void*)fwd_mega, dim3(grid), dim3(NTHR), args, LDS_BYTES, stream);
    if (e != hipSuccess) fprintf(stderr, "kernel_launch: cooperative launch failed: %s (grid %d)\n", hipGetErrorString(e), grid);
}
```
